# Optimizing an MI355X kernel written in HIP

```python
import math
import jax, jax.numpy as jnp
from jax import lax
import numpy as np

D_MODEL = 1024
BATCH = 32
SEQ = 256
DEPTH = 4
DEC_BATCH = 8
DEC_SEQ = 4096
PAST_LEN = 256

GRID_W = 64
HEAD_DIM = 64
GQA_HEADS = 8
GQA_KV_HEADS = 2
GQA_GROUP = GQA_HEADS // GQA_KV_HEADS
GQA_WIDTH = GQA_HEADS * HEAD_DIM
CONV_WIDTH = D_MODEL // 4
DIFF_HEADS = 4
DIFF_QK_DIM = 32
DIFF_V_DIM = 2 * DIFF_QK_DIM
DIFF_WIDTH = DIFF_HEADS * DIFF_V_DIM
MIX_WIDTH = GQA_WIDTH + CONV_WIDTH + DIFF_WIDTH
IN_SIZES = (GQA_WIDTH, GQA_KV_HEADS * HEAD_DIM, GQA_KV_HEADS * HEAD_DIM,
            CONV_WIDTH, CONV_WIDTH, CONV_WIDTH,
            DIFF_HEADS * 2 * DIFF_QK_DIM, DIFF_HEADS * 2 * DIFF_QK_DIM, DIFF_WIDTH)
IN_WIDTH = sum(IN_SIZES)
D_FF = 2816
CONV_W = 3
Q_BLOCK = 128
ROPE_THETA = 10000.0
NORM_EPS = 1e-6
N_MOD = 6

kernel_name = 'hybrid_prefix_dit_step'


def rms_norm(x, g):
    xf = x.astype(jnp.float32)
    y = xf * lax.rsqrt(jnp.mean(xf * xf, axis=-1, keepdims=True) + NORM_EPS)
    return (y * g.astype(jnp.float32)).astype(x.dtype)


def split_cols(z, sizes):
    out, s = [], 0
    for n in sizes:
        out.append(z[..., s:s + n])
        s += n
    return out


def dwconv3(x, w, b):
    t = x.shape[1]
    xp = jnp.pad(x, ((0, 0), (1, 1), (0, 0)))
    return xp[:, :t] * w[0] + xp[:, 1:t + 1] * w[1] + xp[:, 2:] * w[2] + b


def axial_rope_tables(n_rows, dim):
    row = jnp.repeat(jnp.arange(n_rows), GRID_W).astype(jnp.float32)
    col = jnp.tile(jnp.arange(GRID_W), n_rows).astype(jnp.float32)
    nf = dim // 4
    freqs = ROPE_THETA ** (-jnp.arange(nf, dtype=jnp.float32) / nf)
    ar = row[:, None] * freqs[None, :]
    ac = col[:, None] * freqs[None, :]
    ang = jnp.concatenate([ar, ar, ac, ac], axis=-1)
    return jnp.cos(ang), jnp.sin(ang)


def apply_rope(x, cos, sin):
    d = x.shape[-1]
    xr = x.reshape(*x.shape[:-1], 2, 2, d // 4)
    rot = jnp.stack([-xr[..., 1, :], xr[..., 0, :]], axis=-2).reshape(x.shape)
    bshape = (1, x.shape[1]) + (1,) * (x.ndim - 3) + (d,)
    return (x * cos.reshape(bshape) + rot * sin.reshape(bshape)).astype(x.dtype)


def over_query_blocks(fn, q):
    b, t = q.shape[:2]
    nb = t // Q_BLOCK
    qb = jnp.moveaxis(q.reshape(b, nb, Q_BLOCK, *q.shape[2:]), 1, 0)
    out = lax.map(fn, qb)
    return jnp.moveaxis(out, 0, 1).reshape(b, t, *out.shape[3:])


def gqa_attend(q, k, v):
    b, t = q.shape[:2]
    q5 = q.reshape(b, t, GQA_KV_HEADS, GQA_GROUP, HEAD_DIM)
    scale = HEAD_DIM ** -0.5

    def blk(qb):
        s = jnp.einsum('bqkgd,bskd->bkgqs', qb, k).astype(jnp.float32) * scale
        p = jax.nn.softmax(s, axis=-1).astype(v.dtype)
        return jnp.einsum('bkgqs,bskd->bqkgd', p, v)

    return over_query_blocks(blk, q5).reshape(b, t, GQA_WIDTH)


def diff_attend(q, k, v, lam):
    scale = DIFF_QK_DIM ** -0.5

    def blk(qb):
        s = jnp.einsum('bqhcd,bshcd->bhcqs', qb, k).astype(jnp.float32) * scale
        p = jax.nn.softmax(s, axis=-1)
        a = (p[:, :, 0] - lam * p[:, :, 1]).astype(v.dtype)
        return jnp.einsum('bhqs,bshd->bqhd', a, v)

    return over_query_blocks(blk, q)


def trunk_layer(x, cond, lam_init, rope, ctx, w_mod, b_mod, norm1_g, w_in, gqa_qn_g, gqa_kn_g,
                conv_w, conv_b, diff_qn_g, diff_kn_g, diff_lambda, diff_subln_g, w_out,
                norm2_g, ffn_up, ffn_conv_w, ffn_conv_b, ffn_down):
    b, t = x.shape[:2]
    mods = (jax.nn.silu(cond) @ w_mod + b_mod).reshape(cond.shape[0], 1, N_MOD, D_MODEL)
    sh1, sc1, g1, sh2, sc2, g2 = [mods[:, :, i] for i in range(N_MOD)]

    h = rms_norm(x, norm1_g) * (1 + sc1) + sh1
    z = h @ w_in
    qg, kg, vg, cb, cc, cu, qd, kd, vd = split_cols(z, IN_SIZES)
    qg = rms_norm(qg.reshape(b, t, GQA_HEADS, HEAD_DIM), gqa_qn_g)
    kg = rms_norm(kg.reshape(b, t, GQA_KV_HEADS, HEAD_DIM), gqa_kn_g)
    vg = vg.reshape(b, t, GQA_KV_HEADS, HEAD_DIM)
    qd = rms_norm(qd.reshape(b, t, DIFF_HEADS, 2, DIFF_QK_DIM), diff_qn_g)
    kd = rms_norm(kd.reshape(b, t, DIFF_HEADS, 2, DIFF_QK_DIM), diff_kn_g)
    vd = vd.reshape(b, t, DIFF_HEADS, DIFF_V_DIM)
    own = (kg, vg, kd, vd)

    if rope is None:
        kg_all, vg_all, kd_all, vd_all = kg, vg, kd, vd
    else:
        cos64, sin64, cos32, sin32 = rope
        qg = apply_rope(qg, cos64, sin64)
        qd = apply_rope(qd, cos32, sin32)
        ck_g, cv_g, ck_d, cv_d = ctx
        kg_all = jnp.concatenate([apply_rope(kg, cos64, sin64), ck_g.astype(kg.dtype)], axis=1)
        vg_all = jnp.concatenate([vg, cv_g.astype(vg.dtype)], axis=1)
        kd_all = jnp.concatenate([apply_rope(kd, cos32, sin32), ck_d.astype(kd.dtype)], axis=1)
        vd_all = jnp.concatenate([vd, cv_d.astype(vd.dtype)], axis=1)

    o_g = gqa_attend(qg, kg_all, vg_all)
    o_c = cb * dwconv3(cc * cu, conv_w, conv_b)
    lf = diff_lambda.astype(jnp.float32)
    lam = jnp.exp(jnp.sum(lf[0] * lf[1])) - jnp.exp(jnp.sum(lf[2] * lf[3])) + lam_init
    o_d = diff_attend(qd, kd_all, vd_all, lam)
    o_d = (rms_norm(o_d, diff_subln_g) * (1.0 - lam_init)).reshape(b, t, DIFF_WIDTH)
    x = x + g1 * (jnp.concatenate([o_g, o_c, o_d], axis=-1) @ w_out)

    h = rms_norm(x, norm2_g) * (1 + sc2) + sh2
    a, u = jnp.split(h @ ffn_up, 2, axis=-1)
    f = jax.nn.silu(dwconv3(a, ffn_conv_w, ffn_conv_b)) * u
    x = x + g2 * (f @ ffn_down)
    return x, own


def setup_inputs(seed: int = 0) -> dict:
    key = jax.random.key(seed)
    ks = jax.random.split(key, 32)
    f32 = jnp.float32
    nrm = lambda k, shape, s: jax.random.normal(k, shape, f32) * s
    return {
        'x_prompt': nrm(ks[0], (BATCH, SEQ, D_MODEL), 1.0),
        'x_sample': nrm(ks[1], (DEC_BATCH, DEC_SEQ, D_MODEL), 1.0),
        'cache_gqa_k': nrm(ks[2], (DEC_BATCH, DEPTH, PAST_LEN, GQA_KV_HEADS, HEAD_DIM), 1.0),
        'cache_gqa_v': nrm(ks[3], (DEC_BATCH, DEPTH, PAST_LEN, GQA_KV_HEADS, HEAD_DIM), 1.0),
        'cache_diff_k': nrm(ks[4], (DEC_BATCH, DEPTH, PAST_LEN, DIFF_HEADS, 2, DIFF_QK_DIM), 1.0),
        'cache_diff_v': nrm(ks[5], (DEC_BATCH, DEPTH, PAST_LEN, DIFF_HEADS, DIFF_V_DIM), 1.0),
        'c': nrm(ks[6], (DEC_BATCH, D_MODEL), 1.0),
        'c_ctx': nrm(ks[7], (D_MODEL,), 1.0),
        'w_mod': nrm(ks[8], (DEPTH, D_MODEL, N_MOD * D_MODEL), 0.5 * D_MODEL ** -0.5),
        'b_mod': nrm(ks[9], (DEPTH, N_MOD * D_MODEL), 0.01),
        'norm1_g': 1.0 + nrm(ks[10], (DEPTH, D_MODEL), 0.02),
        'w_in': nrm(ks[11], (DEPTH, D_MODEL, IN_WIDTH), D_MODEL ** -0.5),
        'gqa_qn_g': 1.0 + nrm(ks[12], (DEPTH, HEAD_DIM), 0.02),
        'gqa_kn_g': 1.0 + nrm(ks[13], (DEPTH, HEAD_DIM), 0.02),
        'conv_w': nrm(ks[14], (DEPTH, CONV_W, CONV_WIDTH), CONV_W ** -0.5),
        'conv_b': nrm(ks[15], (DEPTH, CONV_WIDTH), 0.01),
        'diff_qn_g': 1.0 + nrm(ks[16], (DEPTH, DIFF_QK_DIM), 0.02),
        'diff_kn_g': 1.0 + nrm(ks[17], (DEPTH, DIFF_QK_DIM), 0.02),
        'diff_lambda': nrm(ks[18], (DEPTH, 4, DIFF_QK_DIM), 0.1),
        'diff_subln_g': 1.0 + nrm(ks[19], (DEPTH, DIFF_V_DIM), 0.02),
        'w_out': nrm(ks[20], (DEPTH, MIX_WIDTH, D_MODEL), MIX_WIDTH ** -0.5),
        'norm2_g': 1.0 + nrm(ks[21], (DEPTH, D_MODEL), 0.02),
        'ffn_up': nrm(ks[22], (DEPTH, D_MODEL, 2 * D_FF), D_MODEL ** -0.5),
        'ffn_conv_w': nrm(ks[23], (DEPTH, CONV_W, D_FF), CONV_W ** -0.5),
        'ffn_conv_b': nrm(ks[24], (DEPTH, D_FF), 0.01),
        'ffn_down': nrm(ks[25], (DEPTH, D_FF, D_MODEL), D_FF ** -0.5),
    }


def reference(x_prompt, x_sample, cache_gqa_k, cache_gqa_v, cache_diff_k, cache_diff_v, c, c_ctx,
              w_mod, b_mod, norm1_g, w_in, gqa_qn_g, gqa_kn_g, conv_w, conv_b, diff_qn_g,
              diff_kn_g, diff_lambda, diff_subln_g, w_out, norm2_g, ffn_up, ffn_conv_w,
              ffn_conv_b, ffn_down):
    def layer_weights(l):
        return (w_mod[l], b_mod[l], norm1_g[l], w_in[l], gqa_qn_g[l], gqa_kn_g[l], conv_w[l],
                conv_b[l], diff_qn_g[l], diff_kn_g[l], diff_lambda[l], diff_subln_g[l], w_out[l],
                norm2_g[l], ffn_up[l], ffn_conv_w[l], ffn_conv_b[l], ffn_down[l])

    xp = x_prompt
    cond_ctx = c_ctx[None, :]
    ks_g, vs_g, ks_d, vs_d = [], [], [], []
    for l in range(DEPTH):
        lam_init = 0.8 - 0.6 * math.exp(-0.3 * l)
        xp, (kg, vg, kd, vd) = trunk_layer(xp, cond_ctx, lam_init, None, None, *layer_weights(l))
        ks_g.append(kg)
        vs_g.append(vg)
        ks_d.append(kd)
        vs_d.append(vd)
    new_gqa_k = jnp.stack(ks_g, axis=1)
    new_gqa_v = jnp.stack(vs_g, axis=1)
    new_diff_k = jnp.stack(ks_d, axis=1)
    new_diff_v = jnp.stack(vs_d, axis=1)

    n_rows = x_sample.shape[1] // GRID_W
    cos64, sin64 = axial_rope_tables(n_rows, HEAD_DIM)
    cos32, sin32 = axial_rope_tables(n_rows, DIFF_QK_DIM)
    rope = (cos64, sin64, cos32, sin32)
    xs = x_sample
    for l in range(DEPTH):
        lam_init = 0.8 - 0.6 * math.exp(-0.3 * l)
        ctx = (cache_gqa_k[:, l], cache_gqa_v[:, l], cache_diff_k[:, l], cache_diff_v[:, l])
        xs, _ = trunk_layer(xs, c, lam_init, rope, ctx, *layer_weights(l))

    return (xp, xs, new_gqa_k, new_gqa_v, new_diff_k, new_diff_v)
```

```cpp
#include <hip/hip_runtime.h>
#include <hip/hip_cooperative_groups.h>
#include <cstdio>
#include <cstdint>
#include <cmath>
namespace cg = cooperative_groups;

#define LAS __attribute__((address_space(3)))
#define GAS __attribute__((address_space(1)))
typedef unsigned short bf16_t;
typedef short bf16x8 __attribute__((ext_vector_type(8)));
typedef short s16x4 __attribute__((ext_vector_type(4)));
typedef float f32x4 __attribute__((ext_vector_type(4)));
typedef float f32x16 __attribute__((ext_vector_type(16)));
typedef unsigned u32x4 __attribute__((ext_vector_type(4)));
typedef unsigned u32x2 __attribute__((ext_vector_type(2)));
typedef float f32x2 __attribute__((ext_vector_type(2)));
typedef __bf16 bf16x2_t __attribute__((ext_vector_type(2)));

__device__ __forceinline__ unsigned cvtpk(float lo, float hi) { f32x2 v = {lo, hi}; bf16x2_t b = __builtin_convertvector(v, bf16x2_t); return __builtin_bit_cast(unsigned, b); }
__device__ __forceinline__ int opaque_tid() { int t = threadIdx.x; asm volatile("" : "+v"(t)); return t; }
__device__ __forceinline__ float bf2f(unsigned short u) { return __uint_as_float(((unsigned)u) << 16); }

constexpr int DM = 1024, DEPTH = 4, NCOND = 9;
constexpr int M_CTX = 8192, M_ALL = 40960, NTM = 160;
constexpr int INW = 2304, DFF = 2816, UPW = 5632;
constexpr int SLAT = 4352;
constexpr float EPS = 1e-6f;
constexpr float LOG2E = 1.4426950408889634f;
constexpr float QSCALE_G = 0.125f * LOG2E;
constexpr float QSCALE_D = 0.17677669529663687f * LOG2E;
constexpr size_t OUT_GK = 41943040, OUT_GV = OUT_GK + 4194304, OUT_DK = OUT_GV + 4194304, OUT_DV = OUT_DK + 8388608;
constexpr size_t MiB = 1u << 20;
constexpr size_t WS_MODS = 1 * MiB;
constexpr size_t WS_MISC = 2 * MiB;
constexpr size_t WS_EDGE = 3 * MiB;
constexpr size_t EDGE_ELEMS = (size_t)NTM * 2 * DFF;
constexpr size_t WS_WIN = 16 * MiB;
constexpr size_t WS_WOUT = 34 * MiB;
constexpr size_t WS_WUP = 42 * MiB;
constexpr size_t WS_WDN = 86 * MiB;
constexpr size_t WS_XN = 108 * MiB;
constexpr size_t WS_U = 188 * MiB;
constexpr size_t WS_QG = WS_U, WS_QD = WS_QG + (size_t)M_ALL * 512 * 2, WS_KG = WS_QD + (size_t)M_ALL * 256 * 2;
constexpr size_t KROWS = 8192 + 8 * SLAT;
constexpr size_t WS_VG = WS_KG + KROWS * 128 * 2, WS_KD = WS_VG + KROWS * 128 * 2, WS_VD = WS_KD + KROWS * 256 * 2;
constexpr size_t WS_CB = WS_VD + KROWS * 256 * 2, WS_PB = WS_CB + (size_t)M_ALL * 256 * 2, WS_UEND = WS_PB + (size_t)M_ALL * 256 * 2;
constexpr size_t WS_END = WS_U + (size_t)M_ALL * DFF * 2;
static_assert(WS_UEND <= WS_END, "union");
constexpr int MI_LAM = 0, MI_R64C = 64, MI_R64S = MI_R64C + 1024, MI_R32C = MI_R64S + 1024, MI_R32S = MI_R32C + 512;

constexpr int RING_BYTES = 131072, XCH_OFF = RING_BYTES, MISC_OFF = RING_BYTES + 4096, LDS_BYTES = RING_BYTES + 4096 + 256;
constexpr size_t WS_CTL = 0, CTL_ZERO_BYTES = 65536;

struct TileInfo {
    int lat, seq, t0, ci, S; long R;
    __device__ __forceinline__ TileInfo(int pm) {
        if (pm < 32) { lat = 0; seq = pm; t0 = 0; ci = 0; S = 256; R = 256L * pm; }
        else { const int b = (pm - 32) >> 4; lat = 1; seq = b; t0 = ((pm - 32) & 15) * 256; ci = 1 + b; S = SLAT; R = 8192L + (long)SLAT * b; }
    }
};

namespace pg8 {
constexpr int BM = 256, BK = 64, HALF = 128, HTB = HALF * BK * 2, NXCD = 8, WGM = 8;
__host__ __device__ __forceinline__ int lds_byte(int r, int c) { const int st = (r >> 4) * 2 + (c >> 5), rr = r & 15, cc = c & 31, ob = rr * 64 + cc * 2; return st * 1024 + (ob ^ (((ob >> 9) & 1) << 5)); }
__host__ __device__ __forceinline__ void stage_rc(int b, int& R, int& C) { const int st = b / 1024, sb = b % 1024, swz = sb ^ (((sb >> 9) & 1) << 5); R = (st >> 1) * 16 + swz / 64; C = (st & 1) * 32 + (swz % 64) / 2; }
struct Unit { int pm, pn; };
struct Gemm { const bf16_t* A; const bf16_t* Bt; int M, N, K; };
struct StaticOrder {
    int nM, nN, nwg, G, c;
    __device__ void init(int M, int N, int G_, int c_) { nM = M / BM; nN = N / BM; nwg = nM * nN; G = G_; c = c_; }
    __device__ bool next(int i, Unit& u) const {
        const long L = (long)i * G + c; if (L >= nwg) return false;
        int wgid = (int)L; { const int q = nwg / NXCD, r = nwg % NXCD, xcd = wgid % NXCD, off = wgid / NXCD; wgid = (xcd < r ? xcd * (q + 1) : r * (q + 1) + (xcd - r) * q) + off; }
        const int nig = WGM * nN, gid = wgid / nig, fm = gid * WGM, gsz = (nM - fm) < WGM ? (nM - fm) : WGM;
        u.pm = fm + ((wgid % nig) % gsz); u.pn = (wgid % nig) / gsz; return true;
    }
};
template <class Epi>
__device__ __forceinline__ void gemm_phase(LAS unsigned char* lds, LAS unsigned char* xlds, const Gemm g, const StaticOrder& S, const Epi& E) {
    const int tid = opaque_tid(), wid = __builtin_amdgcn_readfirstlane(tid >> 6), lane = tid & 63, wr = wid >> 2, wc = wid & 3, fr = lane & 15, fq = lane >> 4;
    const int K = g.K, nt = K / BK;
    unsigned voffA[2];
#pragma unroll
    for (int i = 0; i < 2; ++i) { int R, C; stage_rc(tid * 16 + i * 8192, R, C); voffA[i] = (unsigned)(R * K + C) * 2u; }
    const size_t kstep = (size_t)(BK * 2);
    const size_t hstep = (size_t)HALF * K * 2;
    const size_t tstep = 2 * hstep;
    const unsigned ldsw = (unsigned)wid * 1024u;
    const int aoff = lds_byte(wr * 64 + fr, fq * 8), boff = lds_byte(wc * 32 + fr, fq * 8);
#define PG8_SA(b, h) (((b) * 2 + (h)) * HTB)
#define PG8_SB(b, h) ((4 + (b) * 2 + (h)) * HTB)
#define PG8_STAGE(bufoff, gbase) do { _Pragma("unroll") for (int _i = 0; _i < 2; ++_i) \
        __builtin_amdgcn_global_load_lds((const unsigned*)((const char*)(gbase) + voffA[_i]), (LAS unsigned*)(lds + (bufoff) + ldsw + _i * 8192), 16, 0, 0); } while (0)
#define PG8_LDA(dst, b, h) do { _Pragma("unroll") for (int m = 0; m < 4; ++m) _Pragma("unroll") for (int k = 0; k < 2; ++k) dst[m][k] = *(const LAS bf16x8*)(lds + PG8_SA(b, h) + aoff + m * 2048 + k * 1024); } while (0)
#define PG8_LDB(dst, b, h) do { _Pragma("unroll") for (int n = 0; n < 2; ++n) _Pragma("unroll") for (int k = 0; k < 2; ++k) dst[n][k] = *(const LAS bf16x8*)(lds + PG8_SB(b, h) + boff + n * 2048 + k * 1024); } while (0)
#define PG8_MMA(ai, bj, At, Bt) do { __builtin_amdgcn_s_setprio(1); _Pragma("unroll") for (int m = 0; m < 4; ++m) _Pragma("unroll") for (int n = 0; n < 2; ++n) _Pragma("unroll") for (int k = 0; k < 2; ++k) \
        acc[ai][bj][m][n] = __builtin_amdgcn_mfma_f32_16x16x32_bf16(Bt[n][k], At[m][k], acc[ai][bj][m][n], 0, 0, 0); __builtin_amdgcn_s_setprio(0); } while (0)
#define PG8_WAIT_V(n) asm volatile("s_waitcnt vmcnt(" #n ")" ::: "memory")
#define PG8_WAIT_L(n) asm volatile("s_waitcnt lgkmcnt(" #n ")" ::: "memory")
#define PG8_BAR __builtin_amdgcn_s_barrier()
#define PG8_SCHED __builtin_amdgcn_sched_barrier(0)
    Unit cur, nxt; int ui = 0;
    if (!S.next(0, cur)) return;
    f32x4 acc[2][2][4][2];
#pragma unroll
    for (int a = 0; a < 2; ++a)
#pragma unroll
        for (int b = 0; b < 2; ++b)
#pragma unroll
            for (int m = 0; m < 4; ++m)
#pragma unroll
                for (int n = 0; n < 2; ++n) acc[a][b][m][n] = (f32x4){0.f, 0.f, 0.f, 0.f};
    bf16x8 At[4][2], B0[2][2], B1[2][2];
    const char* cA = (const char*)g.A + (size_t)cur.pm * tstep; const char* cB = (const char*)g.Bt + (size_t)cur.pn * tstep;
    PG8_STAGE(PG8_SB(0, 0), cB); PG8_STAGE(PG8_SB(0, 1), cB + hstep); PG8_STAGE(PG8_SA(0, 0), cA); PG8_STAGE(PG8_SA(0, 1), cA + hstep);
    if (wr == 1) PG8_BAR;
    PG8_WAIT_V(2); PG8_BAR;
    PG8_STAGE(PG8_SB(1, 0), cB + kstep); PG8_STAGE(PG8_SA(1, 0), cA + kstep); PG8_STAGE(PG8_SB(1, 1), cB + hstep + kstep);
    PG8_WAIT_V(6); PG8_BAR;
    for (;;) {
        const bool has_next = S.next(ui + 1, nxt);
        const char* nA = has_next ? (const char*)g.A + (size_t)nxt.pm * tstep : cA; const char* nB = has_next ? (const char*)g.Bt + (size_t)nxt.pn * tstep : cB;
        for (int t = 0; t < nt; t += 2) {
            const bool last = (t == nt - 2);
            const char* a1 = cA + (size_t)(t + 1) * kstep;
            const char* a2 = last ? nA : cA + (size_t)(t + 2) * kstep; const char* b2 = last ? nB : cB + (size_t)(t + 2) * kstep;
            const char* a3 = a2 + kstep; const char* b3 = b2 + kstep;
            PG8_LDB(B0, 0, 0); PG8_LDB(B1, 0, 1); PG8_SCHED; PG8_LDA(At, 0, 0); PG8_STAGE(PG8_SA(1, 1), a1 + hstep);
            PG8_WAIT_V(8); PG8_WAIT_L(0); PG8_BAR; PG8_MMA(0, 0, At, B0); PG8_MMA(0, 1, At, B1); PG8_BAR; PG8_SCHED;
            PG8_LDA(At, 0, 1); PG8_STAGE(PG8_SB(0, 0), b2); PG8_STAGE(PG8_SB(0, 1), b2 + hstep); PG8_STAGE(PG8_SA(0, 0), a2);
            PG8_WAIT_V(8); PG8_WAIT_L(0); PG8_BAR; PG8_MMA(1, 0, At, B0); PG8_MMA(1, 1, At, B1); PG8_BAR; PG8_SCHED;
            PG8_LDB(B0, 1, 0); PG8_LDB(B1, 1, 1); PG8_SCHED; PG8_LDA(At, 1, 0); PG8_STAGE(PG8_SA(0, 1), a2 + hstep);
            PG8_WAIT_V(8); PG8_WAIT_L(0); PG8_BAR; PG8_MMA(0, 0, At, B0); PG8_MMA(0, 1, At, B1); PG8_BAR; PG8_SCHED;
            PG8_LDA(At, 1, 1); PG8_STAGE(PG8_SB(1, 0), b3); PG8_STAGE(PG8_SB(1, 1), b3 + hstep); PG8_STAGE(PG8_SA(1, 0), a3);
            PG8_WAIT_V(8); PG8_WAIT_L(0); PG8_BAR; PG8_MMA(1, 0, At, B0); PG8_MMA(1, 1, At, B1); PG8_BAR; PG8_SCHED;
        }
        if (wr == 0) PG8_BAR;
        { int fr_ = fr, fq_ = fq; asm volatile("" : "+v"(fr_), "+v"(fq_)); E(acc, cur, wr, wc, fr_, fq_, xlds); }
        if (!has_next) break;
#pragma unroll
        for (int a = 0; a < 2; ++a)
#pragma unroll
            for (int b = 0; b < 2; ++b)
#pragma unroll
                for (int m = 0; m < 4; ++m)
#pragma unroll
                    for (int n = 0; n < 2; ++n) acc[a][b][m][n] = (f32x4){0.f, 0.f, 0.f, 0.f};
        cur = nxt; cA = nA; cB = nB; ++ui;
        if (wr == 1) PG8_BAR;
    }
    PG8_WAIT_V(0);
    PG8_BAR;
#undef PG8_SA
#undef PG8_SB
#undef PG8_STAGE
#undef PG8_LDA
#undef PG8_LDB
#undef PG8_MMA
#undef PG8_WAIT_V
#undef PG8_WAIT_L
#undef PG8_BAR
#undef PG8_SCHED
}
}

typedef f32x4 Acc[2][2][4][2];

struct EpiRes {
    const float* xin_ctx; const float* xin_lat; float* xout; const float* gate;
    __device__ __forceinline__ void operator()(const Acc& acc, const pg8::Unit& u, int wr, int wc, int fr, int fq, LAS unsigned char*) const {
        const TileInfo ti(u.pm);
        const int col0 = u.pn * 256 + wc * 32 + 8 * fq;
        const float* gp = gate + ti.ci * 6144 + col0;
        f32x4 g4[2][2];
#pragma unroll
        for (int bj = 0; bj < 2; ++bj)
#pragma unroll
            for (int n = 0; n < 2; ++n) g4[bj][n] = *(const GAS f32x4*)(gp + bj * 128 + n * 4);
        const float* xin = ti.lat ? xin_lat + (size_t)(u.pm * 256 - M_CTX) * DM : xin_ctx + (size_t)(u.pm * 256) * DM;
        float* xo = xout + (size_t)(u.pm * 256) * DM;
#pragma unroll
        for (int ai = 0; ai < 2; ++ai)
#pragma unroll
            for (int m = 0; m < 4; ++m) {
                const size_t off = (size_t)(ai * 128 + wr * 64 + m * 16 + fr) * DM + col0;
#pragma unroll
                for (int bj = 0; bj < 2; ++bj)
#pragma unroll
                    for (int n = 0; n < 2; ++n) {
                        const f32x4 x4 = *(const GAS f32x4*)(xin + off + bj * 128 + n * 4);
                        *(GAS f32x4*)(xo + off + bj * 128 + n * 4) = x4 + g4[bj][n] * acc[ai][bj][m][n];
                    }
                if (m & 1) asm volatile("" ::: "memory");
            }
    }
};

struct EpiIn {
    int layer;
    const float *qn_g, *kn_g, *dqn_g, *dkn_g;
    const float *r64c, *r64s, *r32c, *r32s;
    bf16_t *QG, *QD, *KG, *VG, *KD, *VD, *CB, *PB;
    float* out;
    __device__ __forceinline__ void operator()(const Acc& acc, const pg8::Unit& u, int wr, int wc, int fr, int fq, LAS unsigned char*) const {
        const TileInfo ti(u.pm);
        const int pn = u.pn;
        const int rbase = wr * 64 + fr;
        if (pn < 2 || (pn == 2 && wc < 2)) {
            const bool isq = pn < 2;
            const float* gsrc = (isq ? qn_g : kn_g) + 4 * fq;
            const int head = isq ? 4 * pn + wc : wc;
#pragma unroll
            for (int ai = 0; ai < 2; ++ai)
#pragma unroll
                for (int m = 0; m < 4; ++m) {
                    const int rt = ai * 128 + m * 16 + rbase; const int t = ti.t0 + rt;
                    float ss = 0.f;
#pragma unroll
                    for (int bj = 0; bj < 2; ++bj)
#pragma unroll
                        for (int n = 0; n < 2; ++n) { const f32x4 v = acc[ai][bj][m][n]; ss += (v[0] * v[0] + v[1] * v[1]) + (v[2] * v[2] + v[3] * v[3]); }
                    ss += __shfl_xor(ss, 16); ss += __shfl_xor(ss, 32);
                    const float rstd = rsqrtf(ss * (1.f / 64.f) + EPS);
                    bf16_t* dst = isq ? QG + ((size_t)u.pm * 256 + rt) * 512 + head * 64 + 4 * fq : KG + ((ti.R * 2 + (long)head * ti.S + t) * 64) + 4 * fq;
                    float* o = out + OUT_GK + ((size_t)(ti.seq * 4 + layer) * 256 + t) * 128 + head * 64 + 4 * fq;
#pragma unroll
                    for (int bj = 0; bj < 2; ++bj) {
                        f32x4 y0 = acc[ai][bj][m][0] * rstd * *(const GAS f32x4*)(gsrc + 32 * bj), y1 = acc[ai][bj][m][1] * rstd * *(const GAS f32x4*)(gsrc + 32 * bj + 16);
                        if (!isq && !ti.lat) { *(GAS f32x4*)(o + 32 * bj) = y0; *(GAS f32x4*)(o + 32 * bj + 16) = y1; }
                        if (ti.lat) {
                            const int pos = bj ? (t & 63) : (t >> 6);
                            const f32x4 c4 = *(const GAS f32x4*)(r64c + pos * 16 + 4 * fq), s4 = *(const GAS f32x4*)(r64s + pos * 16 + 4 * fq);
                            const f32x4 o0 = y0 * c4 - y1 * s4, o1 = y1 * c4 + y0 * s4; y0 = o0; y1 = o1;
                        }
                        if (isq) { y0 = y0 * QSCALE_G; y1 = y1 * QSCALE_G; }
                        u32x2 w0, w1; w0.x = cvtpk(y0[0], y0[1]); w0.y = cvtpk(y0[2], y0[3]); w1.x = cvtpk(y1[0], y1[1]); w1.y = cvtpk(y1[2], y1[3]);
                        *(GAS u32x2*)(dst + 32 * bj) = w0; *(GAS u32x2*)(dst + 32 * bj + 16) = w1;
                    }
                    asm volatile("" ::: "memory");
                }
        } else if (pn == 2) {
            const int head = wc - 2;
#pragma unroll
            for (int ai = 0; ai < 2; ++ai)
#pragma unroll
                for (int m = 0; m < 4; ++m) {
                    const int rt = ai * 128 + m * 16 + rbase; const int t = ti.t0 + rt;
                    if (!ti.lat) {
                        float* o = out + OUT_GV + ((size_t)(ti.seq * 4 + layer) * 256 + t) * 128 + head * 64 + 4 * fq;
#pragma unroll
                        for (int bj = 0; bj < 2; ++bj)
#pragma unroll
                            for (int n = 0; n < 2; ++n) *(GAS f32x4*)(o + 32 * bj + 16 * n) = acc[ai][bj][m][n];
                    }
                    bf16_t* vp = VG + ((ti.R * 2 + (long)head * ti.S + t) * 64) + 4 * fq;
#pragma unroll
                    for (int bj = 0; bj < 2; ++bj)
#pragma unroll
                        for (int n = 0; n < 2; ++n) { const f32x4 v = acc[ai][bj][m][n]; u32x2 w; w.x = cvtpk(v[0], v[1]); w.y = cvtpk(v[2], v[3]); *(GAS u32x2*)(vp + 32 * bj + 16 * n) = w; }
                }
        } else if (pn == 3) {
#pragma unroll
            for (int ai = 0; ai < 2; ++ai)
#pragma unroll
                for (int m = 0; m < 4; ++m) {
                    const size_t grow = (size_t)u.pm * 256 + ai * 128 + m * 16 + rbase;
                    bf16_t* p = CB + grow * 256 + 32 * wc + 8 * fq;
#pragma unroll
                    for (int bj = 0; bj < 2; ++bj) { const f32x4 a = acc[ai][bj][m][0], b = acc[ai][bj][m][1]; u32x4 w; w.x = cvtpk(a[0], a[1]); w.y = cvtpk(a[2], a[3]); w.z = cvtpk(b[0], b[1]); w.w = cvtpk(b[2], b[3]); *(GAS u32x4*)(p + 128 * bj) = w; }
                }
        } else if (pn < 6) {
#pragma unroll
            for (int ai = 0; ai < 2; ++ai)
#pragma unroll
                for (int m = 0; m < 4; ++m) {
                    const size_t grow = (size_t)u.pm * 256 + ai * 128 + m * 16 + rbase;
                    bf16_t* p = PB + grow * 256 + 128 * (pn - 4) + 32 * wc + 8 * fq;
                    const f32x4 a = acc[ai][0][m][0] * acc[ai][1][m][0], b = acc[ai][0][m][1] * acc[ai][1][m][1];
                    u32x4 w; w.x = cvtpk(a[0], a[1]); w.y = cvtpk(a[2], a[3]); w.z = cvtpk(b[0], b[1]); w.w = cvtpk(b[2], b[3]); *(GAS u32x4*)p = w;
                }
        } else if (pn < 8) {
            const bool isq = pn == 6;
            const float* gsrc = isq ? dqn_g : dkn_g;
            const int a_ax = fq >> 1, ib = 4 * (fq & 1);
            const float* gp = gsrc + 16 * a_ax + ib;
            const int head = wc;
#pragma unroll
            for (int ai = 0; ai < 2; ++ai)
#pragma unroll
                for (int m = 0; m < 4; ++m) {
                    const int rt = ai * 128 + m * 16 + rbase; const int t = ti.t0 + rt; const size_t grow = (size_t)u.pm * 256 + rt;
#pragma unroll
                    for (int bj = 0; bj < 2; ++bj) {
                        float ss = 0.f;
#pragma unroll
                        for (int n = 0; n < 2; ++n) { const f32x4 v = acc[ai][bj][m][n]; ss += (v[0] * v[0] + v[1] * v[1]) + (v[2] * v[2] + v[3] * v[3]); }
                        ss += __shfl_xor(ss, 16); ss += __shfl_xor(ss, 32);
                        const float rstd = rsqrtf(ss * (1.f / 32.f) + EPS);
                        f32x4 y0 = acc[ai][bj][m][0] * rstd * *(const GAS f32x4*)gp, y1 = acc[ai][bj][m][1] * rstd * *(const GAS f32x4*)(gp + 8);
                        if (!isq && !ti.lat) {
                            float* o = out + OUT_DK + ((size_t)(ti.seq * 4 + layer) * 256 + t) * 256 + head * 64 + bj * 32 + 16 * a_ax + ib;
                            *(GAS f32x4*)(o) = y0; *(GAS f32x4*)(o + 8) = y1;
                        }
                        if (ti.lat) {
                            const int pos = a_ax ? (t & 63) : (t >> 6);
                            const f32x4 c4 = *(const GAS f32x4*)(r32c + pos * 8 + ib), s4 = *(const GAS f32x4*)(r32s + pos * 8 + ib);
                            const f32x4 o0 = y0 * c4 - y1 * s4, o1 = y1 * c4 + y0 * s4; y0 = o0; y1 = o1;
                        }
                        bf16_t* dst;
                        if (isq) { y0 = y0 * QSCALE_D; y1 = y1 * QSCALE_D; dst = QD + grow * 256 + head * 64 + bj * 32 + 16 * a_ax + ib; }
                        else dst = KD + ((ti.R * 8 + (long)(head * 2 + bj) * ti.S + t) * 32) + 16 * a_ax + ib;
                        u32x2 w0, w1; w0.x = cvtpk(y0[0], y0[1]); w0.y = cvtpk(y0[2], y0[3]); w1.x = cvtpk(y1[0], y1[1]); w1.y = cvtpk(y1[2], y1[3]);
                        *(GAS u32x2*)dst = w0; *(GAS u32x2*)(dst + 8) = w1;
                    }
                    asm volatile("" ::: "memory");
                }
        } else {
            const int head = wc;
#pragma unroll
            for (int ai = 0; ai < 2; ++ai)
#pragma unroll
                for (int m = 0; m < 4; ++m) {
                    const int rt = ai * 128 + m * 16 + rbase; const int t = ti.t0 + rt;
                    if (!ti.lat) {
                        float* o = out + OUT_DV + ((size_t)(ti.seq * 4 + layer) * 256 + t) * 256 + head * 64 + 8 * fq;
#pragma unroll
                        for (int bj = 0; bj < 2; ++bj) { *(GAS f32x4*)(o + 32 * bj) = acc[ai][bj][m][0]; *(GAS f32x4*)(o + 32 * bj + 4) = acc[ai][bj][m][1]; }
                    }
                    bf16_t* vp = VD + ((ti.R * 4 + (long)head * ti.S + t) * 64) + 8 * fq;
#pragma unroll
                    for (int bj = 0; bj < 2; ++bj) { const f32x4 a = acc[ai][bj][m][0], b = acc[ai][bj][m][1]; u32x4 w; w.x = cvtpk(a[0], a[1]); w.y = cvtpk(a[2], a[3]); w.z = cvtpk(b[0], b[1]); w.w = cvtpk(b[2], b[3]); *(GAS u32x4*)(vp + 32 * bj) = w; }
                }
        }
    }
};

__device__ __forceinline__ float dpp_ror1(float x) { return __int_as_float(__builtin_amdgcn_update_dpp(0, __float_as_int(x), 0x121, 0xf, 0xf, false)); }
__device__ __forceinline__ float dpp_ror15(float x) { return __int_as_float(__builtin_amdgcn_update_dpp(0, __float_as_int(x), 0x12F, 0xf, 0xf, false)); }
__device__ __forceinline__ float silu_f(float x) { return x * __builtin_amdgcn_rcpf(1.f + __builtin_amdgcn_exp2f(-x * LOG2E)); }
struct EpiUp {
    const float* cw; const float* cbias; bf16_t* F; float* EP; float* EA; float* EU;
    __device__ __forceinline__ void operator()(const Acc& acc, const pg8::Unit& u, int wr, int wc, int fr, int fq, LAS unsigned char* xlds) const {
        const TileInfo ti(u.pm);
        const int c0 = u.pn * 128 + wc * 32 + 8 * fq;
        LAS float* X = (LAS float*)xlds;
#pragma unroll
        for (int ai = 0; ai < 2; ++ai) {
            if (fr == 0) { LAS float* p = X + ((((ai * 2 + wr) * 4 + wc) * 2 + 0) * 4 + fq) * 8; *(LAS f32x4*)p = acc[ai][0][0][0]; *(LAS f32x4*)(p + 4) = acc[ai][0][0][1]; }
            if (fr == 15) { LAS float* p = X + ((((ai * 2 + wr) * 4 + wc) * 2 + 1) * 4 + fq) * 8; *(LAS f32x4*)p = acc[ai][0][3][0]; *(LAS f32x4*)(p + 4) = acc[ai][0][3][1]; }
        }
        asm volatile("s_waitcnt lgkmcnt(0)" ::: "memory"); __builtin_amdgcn_s_barrier(); asm volatile("" ::: "memory");
        f32x4 w0[2], w1[2], w2[2], bb[2];
#pragma unroll
        for (int n = 0; n < 2; ++n) { w0[n] = *(const GAS f32x4*)(cw + c0 + 4 * n); w1[n] = *(const GAS f32x4*)(cw + DFF + c0 + 4 * n); w2[n] = *(const GAS f32x4*)(cw + 2 * DFF + c0 + 4 * n); bb[n] = *(const GAS f32x4*)(cbias + c0 + 4 * n); }
        const bool has_prev = ti.lat && ti.t0 > 0, has_next = ti.lat && ti.t0 < 4096 - 256;
#pragma unroll
        for (int ai = 0; ai < 2; ++ai) {
            f32x4 pb[2] = {(f32x4){0.f, 0.f, 0.f, 0.f}, (f32x4){0.f, 0.f, 0.f, 0.f}}, nb[2] = {(f32x4){0.f, 0.f, 0.f, 0.f}, (f32x4){0.f, 0.f, 0.f, 0.f}};
            { const int seg = ai * 2 + wr;
              if (seg > 0) { const int ps = seg - 1; LAS float* p = X + ((((ps >> 1) * 2 + (ps & 1)) * 4 + wc) * 2 + 1) * 32 + fq * 8; pb[0] = *(LAS f32x4*)p; pb[1] = *(LAS f32x4*)(p + 4); }
              if (seg < 3) { const int ns = seg + 1; LAS float* p = X + ((((ns >> 1) * 2 + (ns & 1)) * 4 + wc) * 2 + 0) * 32 + fq * 8; nb[0] = *(LAS f32x4*)p; nb[1] = *(LAS f32x4*)(p + 4); } }
#pragma unroll
            for (int m = 0; m < 4; ++m) {
                const int rt = ai * 128 + wr * 64 + m * 16 + fr; const size_t grow = (size_t)u.pm * 256 + rt;
                f32x4 fo[2], cv[2];
#pragma unroll
                for (int n = 0; n < 2; ++n) {
                    const f32x4 a = acc[ai][0][m][n];
                    const f32x4 up = (m > 0) ? acc[ai][0][m > 0 ? m - 1 : 0][n] : pb[n];
                    const f32x4 dn = (m < 3) ? acc[ai][0][m < 3 ? m + 1 : 3][n] : nb[n];
                    f32x4 pv, nx;
#pragma unroll
                    for (int e = 0; e < 4; ++e) {
                        pv[e] = dpp_ror1(fr == 15 ? up[e] : a[e]);
                        nx[e] = dpp_ror15(fr == 0 ? dn[e] : a[e]);
                    }
                    const f32x4 c = w0[n] * pv + w1[n] * a + w2[n] * nx + bb[n];
                    cv[n] = c;
                    const f32x4 uu = acc[ai][1][m][n];
#pragma unroll
                    for (int e = 0; e < 4; ++e) fo[n][e] = silu_f(c[e]) * uu[e];
                }
                u32x4 w; w.x = cvtpk(fo[0][0], fo[0][1]); w.y = cvtpk(fo[0][2], fo[0][3]); w.z = cvtpk(fo[1][0], fo[1][1]); w.w = cvtpk(fo[1][2], fo[1][3]);
                *(GAS u32x4*)(F + grow * DFF + c0) = w;
                if (ai == 0 && m == 0) { if (has_prev && rt == 0) { const size_t eo = ((size_t)u.pm * 2 + 0) * DFF + c0;
                        *(GAS f32x4*)(EP + eo) = cv[0]; *(GAS f32x4*)(EP + eo + 4) = cv[1]; *(GAS f32x4*)(EA + eo) = acc[0][0][0][0]; *(GAS f32x4*)(EA + eo + 4) = acc[0][0][0][1]; *(GAS f32x4*)(EU + eo) = acc[0][1][0][0]; *(GAS f32x4*)(EU + eo + 4) = acc[0][1][0][1]; } }
                if (ai == 1 && m == 3) { if (has_next && rt == 255) { const size_t eo = ((size_t)u.pm * 2 + 1) * DFF + c0;
                        *(GAS f32x4*)(EP + eo) = cv[0]; *(GAS f32x4*)(EP + eo + 4) = cv[1]; *(GAS f32x4*)(EA + eo) = acc[1][0][3][0]; *(GAS f32x4*)(EA + eo + 4) = acc[1][0][3][1]; *(GAS f32x4*)(EU + eo) = acc[1][1][3][0]; *(GAS f32x4*)(EU + eo + 4) = acc[1][1][3][1]; } }
            }
        }
        asm volatile("s_waitcnt lgkmcnt(0)" ::: "memory"); __builtin_amdgcn_s_barrier(); asm volatile("" ::: "memory");
    }
};

typedef short v4i16_t __attribute__((ext_vector_type(4)));
__device__ __forceinline__ s16x4 vtr(LAS const char* p) { return __builtin_bit_cast(s16x4, __builtin_amdgcn_ds_read_tr16_b64_v4i16((LAS v4i16_t*)p)); }
__device__ __forceinline__ float xhalf_max(float m) { auto rr = __builtin_amdgcn_permlane32_swap(__float_as_uint(m), __float_as_uint(m), false, false); return fmaxf(__uint_as_float(rr[0]), __uint_as_float(rr[1])); }
__device__ __forceinline__ float xhalf_sum(float m) { auto rr = __builtin_amdgcn_permlane32_swap(__float_as_uint(m), __float_as_uint(m), false, false); return __uint_as_float(rr[0]) + __uint_as_float(rr[1]); }

constexpr int ATT_VS = 192;
constexpr float ATT_THR = 8.f;
#define MX3(a, b, c) __builtin_fmaxf(__builtin_fmaxf((a), (b)), (c))
template <int DQK, bool YORD>
__device__ __forceinline__ void flash_pass(const bf16_t* __restrict__ Qw, int qpitch, const bf16_t* __restrict__ Kg, const bf16_t* __restrict__ Vg, int NT, int tst,
                                           LAS char* lds, f32x16 (&o)[2], float& lsum) {
#define ATT_TI(T) (((T) + tst) < NT ? ((T) + tst) : ((T) + tst - NT))
    constexpr int KS = DQK * 2 + 16, KBUF = 64 * KS, VBUF = 64 * ATT_VS, NDS = DQK / 16;
    constexpr int KROWB = DQK * 2;
    const int tid = opaque_tid(), lane = tid & 63, r32 = lane & 31, h = lane >> 5;
    LAS char* Kb = lds; LAS char* Vb = lds + 2 * KBUF;
    bf16x8 qf[NDS];
#pragma unroll
    for (int ds = 0; ds < NDS; ++ds) qf[ds] = *(const GAS bf16x8*)(Qw + (size_t)r32 * qpitch + 16 * ds + 8 * h);
    const bool kload = (tid * 16) < 64 * KROWB;
    const int krow = (tid * 16) / KROWB, kcb = (tid * 16) % KROWB;
    const int kdst = krow * KS + kcb, vdst = (tid >> 3) * ATT_VS + (tid & 7) * 16;
    const char* kg = (const char*)Kg + tid * 16; const char* vg = (const char*)Vg + tid * 16;
    u32x4 kreg = {0, 0, 0, 0}, vreg;
    {
        u32x4 k1 = {0, 0, 0, 0};
        if (kload) { kreg = *(const GAS u32x4*)(kg + (size_t)ATT_TI(0) * 64 * KROWB); k1 = *(const GAS u32x4*)(kg + (size_t)ATT_TI(1) * 64 * KROWB); }
        vreg = *(const GAS u32x4*)(vg + (size_t)ATT_TI(0) * 64 * 128);
        if (kload) { *(LAS u32x4*)(Kb + kdst) = kreg; *(LAS u32x4*)(Kb + KBUF + kdst) = k1; }
        *(LAS u32x4*)(Vb + vdst) = vreg;
        *(LAS u32x4*)(Vb + 2 * VBUF + vdst) = (u32x4){0, 0, 0, 0};
    }
    __syncthreads();
    const int kfo = r32 * KS + h * 16;
    const int vfo = (4 * h + ((lane & 15) >> 2)) * ATT_VS + (((lane >> 4) & 1) * 16 + (lane & 3) * 4) * 2;
    f32x16 p0 = (f32x16){}, p1 = (f32x16){};
#pragma unroll
    for (int ds = 0; ds < NDS; ++ds) {
        const bf16x8 k0 = *(LAS const bf16x8*)(Kb + kfo + ds * 32), k1 = *(LAS const bf16x8*)(Kb + kfo + 32 * KS + ds * 32);
        p0 = __builtin_amdgcn_mfma_f32_32x32x16_bf16(k0, qf[ds], p0, 0, 0, 0);
        p1 = __builtin_amdgcn_mfma_f32_32x32x16_bf16(k1, qf[ds], p1, 0, 0, 0);
    }
    __syncthreads();
    float mref, l = 0.f;
    {
        float a = MX3(p0[0], p0[1], p1[0]), b = MX3(p0[2], p0[3], p1[1]); a = MX3(a, p1[2], p1[3]);
#pragma unroll
        for (int r = 4; r < 16; r += 4) { a = MX3(a, p0[r], p0[r + 1]); b = MX3(b, p0[r + 2], p0[r + 3]); a = MX3(a, p1[r], p1[r + 1]); b = MX3(b, p1[r + 2], p1[r + 3]); }
        mref = xhalf_max(fmaxf(a, b));
#pragma unroll
        for (int r = 0; r < 16; ++r) { p0[r] -= mref; p1[r] -= mref; }
    }
    f32x16 negm;
#pragma unroll
    for (int r = 0; r < 16; ++r) negm[r] = -mref;
    asm volatile("" : "+v"(negm));
    o[0] = (f32x16){}; o[1] = (f32x16){};
    bf16x8 pk[4] = {};
    int vs_prev = 2 * VBUF, vs_cur = 0, vs_next = VBUF;
#define ATT_MPART(N0, N1, T) do { \
        LAS const char* kb_ = Kb + ((((T) + 1) & 1) * KBUF) + kfo; LAS const char* vb_ = Vb + vs_prev + vfo; \
        bf16x8 kf_[2 * NDS]; s16x4 vl_[8], vh_[8]; \
        _Pragma("unroll") for (int ds = 0; ds < NDS; ++ds) { kf_[2 * ds] = *(LAS const bf16x8*)(kb_ + ds * 32); kf_[2 * ds + 1] = *(LAS const bf16x8*)(kb_ + 32 * KS + ds * 32); } \
        _Pragma("unroll") for (int s_ = 0; s_ < 4; ++s_) { _Pragma("unroll") for (int db_ = 0; db_ < 2; ++db_) { \
            vl_[2 * s_ + db_] = vtr(vb_ + (16 * s_) * ATT_VS + db_ * 64); vh_[2 * s_ + db_] = vtr(vb_ + (16 * s_ + 8) * ATT_VS + db_ * 64); } } \
        N0 = __builtin_amdgcn_mfma_f32_32x32x16_bf16(kf_[0], qf[0], negm, 0, 0, 0); N1 = __builtin_amdgcn_mfma_f32_32x32x16_bf16(kf_[1], qf[0], negm, 0, 0, 0); \
        _Pragma("unroll") for (int ds = 1; ds < NDS; ++ds) { \
            N0 = __builtin_amdgcn_mfma_f32_32x32x16_bf16(kf_[2 * ds], qf[ds], N0, 0, 0, 0); N1 = __builtin_amdgcn_mfma_f32_32x32x16_bf16(kf_[2 * ds + 1], qf[ds], N1, 0, 0, 0); } \
        _Pragma("unroll") for (int s_ = 0; s_ < 4; ++s_) { _Pragma("unroll") for (int db_ = 0; db_ < 2; ++db_) { \
            const bf16x8 vf_ = __builtin_shufflevector(vl_[2 * s_ + db_], vh_[2 * s_ + db_], 0, 1, 2, 3, 4, 5, 6, 7); \
            o[db_] = __builtin_amdgcn_mfma_f32_32x32x16_bf16(vf_, pk[s_], o[db_], 0, 0, 0); } } \
        __builtin_amdgcn_sched_group_barrier(0x100, 2 * NDS + 8, 0); __builtin_amdgcn_sched_group_barrier(0x008, 2 * NDS, 0); \
        __builtin_amdgcn_sched_group_barrier(0x100, 8, 0); __builtin_amdgcn_sched_group_barrier(0x008, 8, 0); } while (0)
#define ATT_VPART(P0, P1, N0, N1) do { \
        float a = MX3(P0[0], P0[1], P1[0]), b = MX3(P0[2], P0[3], P1[1]); a = MX3(a, P1[2], P1[3]); \
        _Pragma("unroll") for (int r = 4; r < 16; r += 4) { a = MX3(a, P0[r], P0[r + 1]); b = MX3(b, P0[r + 2], P0[r + 3]); a = MX3(a, P1[r], P1[r + 1]); b = MX3(b, P1[r + 2], P1[r + 3]); } \
        const float mt = xhalf_max(fmaxf(a, b)); \
        resc = __any(mt > ATT_THR); \
        if (__builtin_expect(resc, 0)) { \
            const float dl = fmaxf(mt, 0.f); mref += dl; fsc = __builtin_amdgcn_exp2f(-dl); l *= fsc; \
            _Pragma("unroll") for (int r = 0; r < 16; ++r) { P0[r] -= dl; P1[r] -= dl; } \
            if (!YORD) { _Pragma("unroll") for (int r = 0; r < 16; ++r) { N0[r] -= dl; N1[r] -= dl; o[0][r] *= fsc; o[1][r] *= fsc; } } \
            _Pragma("unroll") for (int r = 0; r < 16; ++r) negm[r] = -mref; \
            asm volatile("" : "+v"(negm)); } \
        float ps0 = 0.f, ps1 = 0.f; \
        _Pragma("unroll") for (int r = 0; r < 16; ++r) { P0[r] = __builtin_amdgcn_exp2f(P0[r]); P1[r] = __builtin_amdgcn_exp2f(P1[r]); ps0 += P0[r]; ps1 += P1[r]; } \
        l += ps0 + ps1; \
        _Pragma("unroll") for (int s = 0; s < 2; ++s) { u32x4 a4, b4; \
            a4.x = cvtpk(P0[8 * s + 0], P0[8 * s + 1]); a4.y = cvtpk(P0[8 * s + 2], P0[8 * s + 3]); a4.z = cvtpk(P0[8 * s + 4], P0[8 * s + 5]); a4.w = cvtpk(P0[8 * s + 6], P0[8 * s + 7]); \
            b4.x = cvtpk(P1[8 * s + 0], P1[8 * s + 1]); b4.y = cvtpk(P1[8 * s + 2], P1[8 * s + 3]); b4.z = cvtpk(P1[8 * s + 4], P1[8 * s + 5]); b4.w = cvtpk(P1[8 * s + 6], P1[8 * s + 7]); \
            pkn[s] = __builtin_bit_cast(bf16x8, a4); pkn[2 + s] = __builtin_bit_cast(bf16x8, b4); } } while (0)
#define ATT_STEP(P0, P1, N0, N1, T) do { \
        const bool more = (T) + 1 < NT, more2 = (T) + 2 < NT; \
        if (more2 && kload) kreg = *(const GAS u32x4*)(kg + (size_t)ATT_TI((T) + 2) * 64 * KROWB); \
        if (more) vreg = *(const GAS u32x4*)(vg + (size_t)ATT_TI((T) + 1) * 64 * 128); \
        float fsc = 1.f; bool resc; bf16x8 pkn[4]; \
        if (!YORD) { ATT_MPART(N0, N1, T); __builtin_amdgcn_sched_barrier(0); ATT_VPART(P0, P1, N0, N1); } \
        else { ATT_VPART(P0, P1, N0, N1); __builtin_amdgcn_sched_barrier(0); ATT_MPART(N0, N1, T); \
            if (__builtin_expect(resc, 0)) { _Pragma("unroll") for (int r = 0; r < 16; ++r) { o[0][r] *= fsc; o[1][r] *= fsc; } } } \
        _Pragma("unroll") for (int s = 0; s < 4; ++s) pk[s] = pkn[s]; \
        if (more2 && kload) *(LAS u32x4*)(Kb + ((T) & 1) * KBUF + kdst) = kreg; \
        if (more) *(LAS u32x4*)(Vb + vs_next + vdst) = vreg; \
        __syncthreads(); \
        vs_prev = vs_cur; vs_cur = vs_next; vs_next = (vs_next == 2 * VBUF) ? 0 : vs_next + VBUF; } while (0)
    f32x16 n0, n1;
    for (int t = 0; t < NT; t += 2) {
        ATT_STEP(p0, p1, n0, n1, t);
        ATT_STEP(n0, n1, p0, p1, t + 1);
    }
    {
        LAS const char* vb_ = Vb + vs_prev + vfo;
#pragma unroll
        for (int s_ = 0; s_ < 4; ++s_) {
#pragma unroll
            for (int db_ = 0; db_ < 2; ++db_) {
                const s16x4 lo_ = vtr(vb_ + (16 * s_) * ATT_VS + db_ * 64), hi_ = vtr(vb_ + (16 * s_ + 8) * ATT_VS + db_ * 64);
                const bf16x8 vf_ = __builtin_shufflevector(lo_, hi_, 0, 1, 2, 3, 4, 5, 6, 7);
                o[db_] = __builtin_amdgcn_mfma_f32_32x32x16_bf16(vf_, pk[s_], o[db_], 0, 0, 0);
            }
        }
    }
    __syncthreads();
#undef ATT_STEP
#undef ATT_TI
#undef ATT_VPART
#undef ATT_MPART
    lsum = xhalf_sum(l);
}

__device__ __forceinline__ void store_ot(const f32x16 (&o)[2], bf16_t* dst  , int h) {
#pragma unroll
    for (int db = 0; db < 2; ++db)
#pragma unroll
        for (int g = 0; g < 4; ++g) { u32x2 w; w.x = cvtpk(o[db][4 * g], o[db][4 * g + 1]); w.y = cvtpk(o[db][4 * g + 2], o[db][4 * g + 3]); *(GAS u32x2*)(dst + 32 * db + 8 * g + 4 * h) = w; }
}

struct AttnArgs { const bf16_t *QG, *QD, *KG, *VG, *KD, *VD, *CB, *PB; bf16_t* MIX; const float* conv_w; const float* conv_b; const float* subln_g; float lam, lam_init; };

__device__ __forceinline__ void attn_gqa_unit(const AttnArgs& A, LAS char* lds, int lat, int seq, int qh, int qb) {
    const int tid_ = opaque_tid(); const int wave = __builtin_amdgcn_readfirstlane(tid_ >> 6), lane = tid_ & 63, r32 = lane & 31, h = lane >> 5;
    const long R = lat ? 8192L + (long)SLAT * seq : 256L * seq; const int S = lat ? SLAT : 256;
    const size_t grow0 = (lat ? 8192 + (size_t)4096 * seq : (size_t)256 * seq) + 256 * qb + 32 * wave;
    const int kvh = qh >> 2;
    f32x16 o[2]; float ls;
    int NT = S / 64; asm volatile("" : "+s"(NT)); const int tst = (int)((((blockIdx.x >> 3) & 31) * NT) >> 5);
    if (wave < 4) flash_pass<64, false>(A.QG + grow0 * 512 + 64 * qh, 512, A.KG + (R * 2 + (long)kvh * S) * 64, A.VG + (R * 2 + (long)kvh * S) * 64, NT, tst, lds, o, ls);
    else flash_pass<64, true>(A.QG + grow0 * 512 + 64 * qh, 512, A.KG + (R * 2 + (long)kvh * S) * 64, A.VG + (R * 2 + (long)kvh * S) * 64, NT, tst, lds, o, ls);
    const float inv = 1.f / ls;
#pragma unroll
    for (int r = 0; r < 16; ++r) { o[0][r] *= inv; o[1][r] *= inv; }
    store_ot(o, A.MIX + (grow0 + r32) * 1024 + 64 * qh, h);
}
__device__ __forceinline__ void attn_diff_unit(const AttnArgs& A, LAS char* lds, int lat, int seq, int hd, int qb) {
    const int tid_ = opaque_tid(); const int wave = __builtin_amdgcn_readfirstlane(tid_ >> 6), lane = tid_ & 63, r32 = lane & 31, h = lane >> 5;
    const long R = lat ? 8192L + (long)SLAT * seq : 256L * seq; const int S = lat ? SLAT : 256;
    const size_t grow0 = (lat ? 8192 + (size_t)4096 * seq : (size_t)256 * seq) + 256 * qb + 32 * wave;
    f32x16 o0[2], o1[2]; float l0, l1;
    const bf16_t* V = A.VD + (R * 4 + (long)hd * S) * 64;
    int NT = S / 64; asm volatile("" : "+s"(NT)); const int tst = (int)((((blockIdx.x >> 3) & 31) * NT) >> 5);
    if (wave < 4) { flash_pass<32, false>(A.QD + grow0 * 256 + 64 * hd, 256, A.KD + (R * 8 + (long)(hd * 2) * S) * 32, V, NT, tst, lds, o0, l0);
        flash_pass<32, false>(A.QD + grow0 * 256 + 64 * hd + 32, 256, A.KD + (R * 8 + (long)(hd * 2 + 1) * S) * 32, V, NT, tst, lds, o1, l1); }
    else { flash_pass<32, true>(A.QD + grow0 * 256 + 64 * hd, 256, A.KD + (R * 8 + (long)(hd * 2) * S) * 32, V, NT, tst, lds, o0, l0);
        flash_pass<32, true>(A.QD + grow0 * 256 + 64 * hd + 32, 256, A.KD + (R * 8 + (long)(hd * 2 + 1) * S) * 32, V, NT, tst, lds, o1, l1); }
    const float i0 = 1.f / l0, i1 = A.lam / l1;
    float ss = 0.f;
#pragma unroll
    for (int db = 0; db < 2; ++db)
#pragma unroll
        for (int r = 0; r < 16; ++r) { const float v = o0[db][r] * i0 - o1[db][r] * i1; o0[db][r] = v; ss += v * v; }
    ss = xhalf_sum(ss);
    const float rstd = rsqrtf(ss * (1.f / 64.f) + EPS) * (1.f - A.lam_init);
#pragma unroll
    for (int db = 0; db < 2; ++db)
#pragma unroll
        for (int g = 0; g < 4; ++g) { const f32x4 g4 = *(const GAS f32x4*)(A.subln_g + 32 * db + 8 * g + 4 * h);
#pragma unroll
            for (int e = 0; e < 4; ++e) o0[db][4 * g + e] *= rstd * g4[e]; }
    store_ot(o0, A.MIX + (grow0 + r32) * 1024 + 768 + 64 * hd, h);
}

__device__ __forceinline__ void attn_phase(const AttnArgs& A, LAS char* lds, int G) {
    if ((opaque_tid() >> 6) >= 4) __builtin_amdgcn_s_setprio(1);
    for (int u = blockIdx.x; u < 1920; u += G) {
        if (u < 512) { const int b = u & 7, r = u >> 3; attn_diff_unit(A, lds, 1, b, r >> 4, r & 15); }
        else if (u < 1536) { const int v = u - 512, b = v & 7, r = v >> 3; attn_gqa_unit(A, lds, 1, b, r & 7, r >> 3); }
        else if (u < 1664) { const int w = u - 1536; attn_diff_unit(A, lds, 0, w >> 2, w & 3, 0); }
        else { const int w = u - 1664; attn_gqa_unit(A, lds, 0, w >> 3, w & 7, 0); }
    }
    __builtin_amdgcn_s_setprio(0);
    const int tid_c = opaque_tid();
    for (int idx = blockIdx.x * 512 + tid_c; idx < M_ALL * 32; idx += G * 512) {
        const int row = idx >> 5, c8 = (idx & 31) * 8;
        int t, S; if (row < M_CTX) { t = row & 255; S = 256; } else { t = (row - M_CTX) & 4095; S = 4096; }
        const u32x4 z = {0, 0, 0, 0};
        const u32x4 pc = *(const GAS u32x4*)(A.PB + (size_t)row * 256 + c8);
        const u32x4 pp = t > 0 ? *(const GAS u32x4*)(A.PB + (size_t)(row - 1) * 256 + c8) : z;
        const u32x4 pn = t < S - 1 ? *(const GAS u32x4*)(A.PB + (size_t)(row + 1) * 256 + c8) : z;
        const u32x4 cb = *(const GAS u32x4*)(A.CB + (size_t)row * 256 + c8);
        float res[8];
#pragma unroll
        for (int j = 0; j < 8; ++j) {
            const int sh = (j & 1) * 16;
            const float a = __uint_as_float(((pp[j >> 1] >> sh) & 0xffffu) << 16), b = __uint_as_float(((pc[j >> 1] >> sh) & 0xffffu) << 16), c = __uint_as_float(((pn[j >> 1] >> sh) & 0xffffu) << 16);
            const float g = __uint_as_float(((cb[j >> 1] >> sh) & 0xffffu) << 16);
            const int cc = c8 + j;
            res[j] = g * (A.conv_w[cc] * a + A.conv_w[256 + cc] * b + A.conv_w[512 + cc] * c + A.conv_b[cc]);
        }
        u32x4 w; w.x = cvtpk(res[0], res[1]); w.y = cvtpk(res[2], res[3]); w.z = cvtpk(res[4], res[5]); w.w = cvtpk(res[6], res[7]);
        *(GAS u32x4*)(A.MIX + (size_t)row * 1024 + 512 + c8) = w;
    }
}

__device__ __forceinline__ int sigma_map(int type, int i) {
    if (type == 1) return 8 * ((i >> 2) & 3) + 4 * (i >> 4) + (i & 3);
    if (type == 2) return 16 * ((i >> 3) & 1) + 8 * (i >> 4) + (i & 7);
    return i;
}
__device__ __forceinline__ void in_group(int g, int& Lbase, int& type) {
    const int pn = g >> 3, bj = (g >> 2) & 1, wc = g & 3;
    if (pn < 2) { Lbase = 64 * (4 * pn + wc) + 32 * bj; type = 0; }
    else if (pn == 2) { Lbase = (wc < 2 ? 512 + 64 * wc : 640 + 64 * (wc - 2)) + 32 * bj; type = 0; }
    else if (pn == 3) { Lbase = 768 + 128 * bj + 32 * wc; type = 1; }
    else if (pn < 6) { Lbase = 1024 + 256 * bj + 128 * (pn - 4) + 32 * wc; type = 1; }
    else if (pn < 8) { Lbase = (pn == 6 ? 1536 : 1792) + 64 * wc + 32 * bj; type = 2; }
    else { Lbase = 2048 + 64 * wc + 32 * bj; type = 1; }
}
__device__ __forceinline__ void transpose_item(const float* W, int K, int N, bf16_t* WT, int k0, int nphys0, int Lbase, int type, LAS float* scr, int lane) {
#pragma unroll 8
    for (int i = 0; i < 32; ++i) { const int kk = 2 * i + (lane >> 5); scr[kk * 33 + (lane & 31)] = ((const GAS float*)W)[(size_t)(k0 + kk) * N + Lbase + (lane & 31)]; }
    asm volatile("s_waitcnt lgkmcnt(0)" ::: "memory");
    const int c = lane & 7;
#pragma unroll
    for (int j = 0; j < 4; ++j) { const int n = (lane >> 3) + 8 * j; const LAS float* s = scr + (8 * c) * 33 + sigma_map(type, n);
        u32x4 o; o.x = cvtpk(s[0 * 33], s[1 * 33]); o.y = cvtpk(s[2 * 33], s[3 * 33]); o.z = cvtpk(s[4 * 33], s[5 * 33]); o.w = cvtpk(s[6 * 33], s[7 * 33]);
        *(GAS u32x4*)(WT + (size_t)(nphys0 + n) * K + k0 + 8 * c) = o; }
    asm volatile("s_waitcnt lgkmcnt(0)" ::: "memory");
}

struct Params {
    const float *x_prompt, *x_sample, *cache_gk, *cache_gv, *cache_dk, *cache_dv, *c, *c_ctx;
    const float *w_mod, *b_mod, *norm1_g, *w_in, *gqa_qn_g, *gqa_kn_g, *conv_w, *conv_b, *diff_qn_g, *diff_kn_g, *diff_lambda, *diff_subln_g, *w_out, *norm2_g, *ffn_up, *ffn_conv_w, *ffn_conv_b, *ffn_down;
    float* out; unsigned char* ws;
    float lam_init[4];
    int ph_lo, ph_hi;
};

__device__ __forceinline__ void prologue(const Params& P, LAS unsigned char* lds, int G) {
    const int tid = opaque_tid(), lane = tid & 63, wave = __builtin_amdgcn_readfirstlane(tid >> 6);
    float* MODS = (float*)(P.ws + WS_MODS); float* MISC = (float*)(P.ws + WS_MISC);
    if ((int)blockIdx.x < 384) {
        LAS float* sc = (LAS float*)lds;
        LAS float* part = (LAS float*)(lds + 49152);
        for (int i = tid; i < NCOND * 1024; i += 512) { const int ci = i >> 10, k = i & 1023; const float v = ci == 0 ? P.c_ctx[k] : P.c[(ci - 1) * 1024 + k]; sc[k * 12 + ci] = v / (1.f + __expf(-v)); }
        __syncthreads();
        for (int it = blockIdx.x; it < 384; it += G) {
            const int l = it / 96, col = (it % 96) * 64 + lane;
            const float* w = P.w_mod + (size_t)l * 1024 * 6144 + col;
            float acc[NCOND];
#pragma unroll
            for (int ci = 0; ci < NCOND; ++ci) acc[ci] = 0.f;
#pragma unroll 8
            for (int kk = 0; kk < 128; ++kk) { const int k = wave * 128 + kk; const float wv = ((const GAS float*)w)[(size_t)k * 6144];
                const f32x4 s0 = *(LAS f32x4*)(sc + k * 12), s1 = *(LAS f32x4*)(sc + k * 12 + 4); const float s8 = sc[k * 12 + 8];
                acc[0] += s0[0] * wv; acc[1] += s0[1] * wv; acc[2] += s0[2] * wv; acc[3] += s0[3] * wv; acc[4] += s1[0] * wv; acc[5] += s1[1] * wv; acc[6] += s1[2] * wv; acc[7] += s1[3] * wv; acc[8] += s8 * wv; }
#pragma unroll
            for (int ci = 0; ci < NCOND; ++ci) part[(wave * NCOND + ci) * 64 + lane] = acc[ci];
            __syncthreads();
            for (int i = tid; i < NCOND * 64; i += 512) { const int ci = i >> 6, cc = i & 63; float s = 0.f;
#pragma unroll
                for (int w8 = 0; w8 < 8; ++w8) s += part[(w8 * NCOND + ci) * 64 + cc];
                const int j = (it % 96) * 64 + cc; MODS[((size_t)l * NCOND + ci) * 6144 + j] = s + P.b_mod[l * 6144 + j]; }
            __syncthreads();
        }
    }
    if ((int)blockIdx.x == G - 1) {
        if (tid < 4) { const float* lf = P.diff_lambda + tid * 128; float s1 = 0.f, s2 = 0.f; for (int i = 0; i < 32; ++i) { s1 += lf[i] * lf[32 + i]; s2 += lf[64 + i] * lf[96 + i]; }
            MISC[MI_LAM + tid] = expf(s1) - expf(s2) + P.lam_init[tid]; }
        for (int i = tid; i < 1024; i += 512) { const int pos = i >> 4, idx = i & 15; const float fr = powf(10000.f, -(float)idx / 16.f); const float ang = (float)pos * fr; MISC[MI_R64C + i] = cosf(ang); MISC[MI_R64S + i] = sinf(ang); }
        for (int i = tid; i < 512; i += 512) { const int pos = i >> 3, idx = i & 7; const float fr = powf(10000.f, -(float)idx / 8.f); const float ang = (float)pos * fr; MISC[MI_R32C + i] = cosf(ang); MISC[MI_R32S + i] = sinf(ang); }
    }
    __syncthreads();
    LAS float* scr = (LAS float*)(lds + wave * 16384);
    const int gw = blockIdx.x * 8 + wave, NGW = G * 8;
    constexpr int I_IN = 16 * 72, I_OUT = 16 * 32, I_UP = 16 * 176, I_DN = 44 * 32, I_L = I_IN + I_OUT + I_UP + I_DN;
    for (int it = gw; it < DEPTH * I_L; it += NGW) {
        const int l = it / I_L; int r = it % I_L;
        if (r < I_IN) { const int kb = r / 72, g = r % 72; int Lb, ty; in_group(g, Lb, ty);
            transpose_item(P.w_in + (size_t)l * 1024 * INW, 1024, INW, (bf16_t*)(P.ws + WS_WIN) + (size_t)l * INW * 1024, kb * 64, g * 32, Lb, ty, scr, lane); continue; }
        r -= I_IN;
        if (r < I_OUT) { const int kb = r / 32, g = r % 32;
            transpose_item(P.w_out + (size_t)l * 1024 * 1024, 1024, 1024, (bf16_t*)(P.ws + WS_WOUT) + (size_t)l * 1024 * 1024, kb * 64, g * 32, g * 32, 1, scr, lane); continue; }
        r -= I_OUT;
        if (r < I_UP) { const int kb = r / 176, g = r % 176; const int pn = g >> 3, bj = (g >> 2) & 1, wc = g & 3;
            transpose_item(P.ffn_up + (size_t)l * 1024 * UPW, 1024, UPW, (bf16_t*)(P.ws + WS_WUP) + (size_t)l * UPW * 1024, kb * 64, g * 32, bj * DFF + 128 * pn + 32 * wc, 1, scr, lane); continue; }
        r -= I_UP;
        { const int kb = r / 32, g = r % 32;
            transpose_item(P.ffn_down + (size_t)l * DFF * 1024, DFF, 1024, (bf16_t*)(P.ws + WS_WDN) + (size_t)l * 1024 * DFF, kb * 64, g * 32, g * 32, 1, scr, lane); }
    }
}

__device__ __forceinline__ void norm_phase(const float* xin_ctx, const float* xin_lat, const float* ng, const float* mods_l  , int sh_idx, bf16_t* XN, int G) {
    const int tid_ = opaque_tid(); const int lane = tid_ & 63, wave = __builtin_amdgcn_readfirstlane(tid_ >> 6);
    const int nw = G * 8, gw = blockIdx.x * 8 + wave;
    const int per = (M_ALL + nw - 1) / nw;
    const int r0 = gw * per, r1 = min(r0 + per, M_ALL);
    int cur_ci = -1; f32x4 Aa[4], Bb[4];
    for (int row = r0; row < r1; ++row) {
        const int ci = row < M_CTX ? 0 : 1 + ((row - M_CTX) >> 12);
        if (ci != cur_ci) { cur_ci = ci; const float* sh = mods_l + ci * 6144 + sh_idx * 1024; const float* sc = sh + 1024;
#pragma unroll
            for (int j = 0; j < 4; ++j) { const int c = 4 * lane + 256 * j; const f32x4 g4 = *(const GAS f32x4*)(ng + c), s4 = *(const GAS f32x4*)(sc + c); Aa[j] = g4 * (1.f + s4); Bb[j] = *(const GAS f32x4*)(sh + c); } }
        const float* xr = row < M_CTX ? xin_ctx + (size_t)row * DM : xin_lat + (size_t)(row - M_CTX) * DM;
        f32x4 v[4]; float s = 0.f;
#pragma unroll
        for (int j = 0; j < 4; ++j) { v[j] = *(const GAS f32x4*)(xr + 4 * lane + 256 * j); s += (v[j][0] * v[j][0] + v[j][1] * v[j][1]) + (v[j][2] * v[j][2] + v[j][3] * v[j][3]); }
#pragma unroll
        for (int o = 1; o < 64; o <<= 1) s += __shfl_xor(s, o);
        const float rstd = rsqrtf(s * (1.f / DM) + EPS);
#pragma unroll
        for (int j = 0; j < 4; ++j) { const f32x4 y = v[j] * rstd * Aa[j] + Bb[j]; u32x2 w; w.x = cvtpk(y[0], y[1]); w.y = cvtpk(y[2], y[3]); *(GAS u32x2*)(XN + (size_t)row * DM + 4 * lane + 256 * j) = w; }
    }
}

__device__ __forceinline__ void cache_phase(const Params& P, int l, int G) {
    bf16_t* KG = (bf16_t*)(P.ws + WS_KG); bf16_t* VG = (bf16_t*)(P.ws + WS_VG); bf16_t* KD = (bf16_t*)(P.ws + WS_KD); bf16_t* VD = (bf16_t*)(P.ws + WS_VD);
    const int tid_ = opaque_tid();
    for (int i = blockIdx.x * 512 + tid_; i < 65536; i += G * 512) {
        const int d4 = (i & 15) * 4, kvh = (i >> 4) & 1, p = (i >> 5) & 255, b = i >> 13;
        const size_t src = ((((size_t)b * 4 + l) * 256 + p) * 2 + kvh) * 64 + d4;
        const size_t dst = (((8192L + (long)SLAT * b) * 2 + (long)kvh * SLAT + 4096 + p) * 64) + d4;
        const f32x4 k = *(const GAS f32x4*)(P.cache_gk + src), v = *(const GAS f32x4*)(P.cache_gv + src);
        u32x2 wk, wv; wk.x = cvtpk(k[0], k[1]); wk.y = cvtpk(k[2], k[3]); wv.x = cvtpk(v[0], v[1]); wv.y = cvtpk(v[2], v[3]);
        *(GAS u32x2*)(KG + dst) = wk; *(GAS u32x2*)(VG + dst) = wv;
    }
    for (int i = blockIdx.x * 512 + tid_; i < 131072; i += G * 512) {
        { const int d4 = (i & 7) * 4, hc = (i >> 3) & 7, p = (i >> 6) & 255, b = i >> 14;
          const size_t src = ((((size_t)b * 4 + l) * 256 + p) * 8 + hc) * 32 + d4;
          const size_t dst = (((8192L + (long)SLAT * b) * 8 + (long)hc * SLAT + 4096 + p) * 32) + d4;
          const f32x4 k = *(const GAS f32x4*)(P.cache_dk + src); u32x2 w; w.x = cvtpk(k[0], k[1]); w.y = cvtpk(k[2], k[3]); *(GAS u32x2*)(KD + dst) = w; }
        { const int d4 = (i & 15) * 4, hh = (i >> 4) & 3, p = (i >> 6) & 255, b = i >> 14;
          const size_t src = ((((size_t)b * 4 + l) * 256 + p) * 4 + hh) * 64 + d4;
          const size_t dst = (((8192L + (long)SLAT * b) * 4 + (long)hh * SLAT + 4096 + p) * 64) + d4;
          const f32x4 v = *(const GAS f32x4*)(P.cache_dv + src); u32x2 w; w.x = cvtpk(v[0], v[1]); w.y = cvtpk(v[2], v[3]); *(GAS u32x2*)(VD + dst) = w; }
    }
}

__device__ __forceinline__ void fixup_phase(const float* cw, bf16_t* F, const float* EP, const float* EA, const float* EU, int G) {
    const int tid_ = opaque_tid();
    for (int i = blockIdx.x * 512 + tid_; i < 128 * 2 * DFF; i += G * 512) {
        const int c = i % DFF, e = (i / DFF) & 1, pm = 32 + i / (2 * DFF); const int j = (pm - 32) & 15;
        if (e == 0 ? j == 0 : j == 15) continue;
        const size_t eo = ((size_t)pm * 2 + e) * DFF + c;
        float conv;
        if (e == 0) conv = EP[eo] + cw[c] * EA[((size_t)(pm - 1) * 2 + 1) * DFF + c];
        else conv = EP[eo] + cw[2 * DFF + c] * EA[((size_t)(pm + 1) * 2 + 0) * DFF + c];
        const float f = silu_f(conv) * EU[eo];
        const size_t row = (size_t)pm * 256 + (e ? 255 : 0);
        F[row * DFF + c] = (bf16_t)(cvtpk(f, 0.f) & 0xffffu);
    }
}


#define XB_TMO      128
#define XB_XCNT(j)  (256  + 64 * (j))
#define XB_XSUB(j)  (1280 + 64 * (j))
#define XB_XGEN(j)  (2304 + 64 * (j))
#define XB_TOP      3328
#define XB_TOPGEN   3392
#define XCD_BAR_WORDS 3456
#define XB_SPIN_CAP (1u << 22)
__device__ __forceinline__ unsigned xb_ld(unsigned* p)              { return __hip_atomic_load(p, __ATOMIC_RELAXED, __HIP_MEMORY_SCOPE_AGENT); }
__device__ __forceinline__ unsigned xb_add(unsigned* p, unsigned v) { return __hip_atomic_fetch_add(p, v, __ATOMIC_RELAXED, __HIP_MEMORY_SCOPE_AGENT); }
__device__ __forceinline__ unsigned xb_xcc_id() { return (unsigned)__builtin_amdgcn_s_getreg((3 << 11) | 20) & 0xFu; }
#define XB_SPIN(cond, bar) do { unsigned _sp = 0; while (cond) { __builtin_amdgcn_s_sleep(1); \
    if ((++_sp & 255u) == 0u) { if (xb_ld(&(bar)[XB_TMO])) break; if (_sp > XB_SPIN_CAP) { atomicAdd(&(bar)[XB_TMO], 1u); break; } } } } while (0)
struct XcdBarrier { unsigned* bar; unsigned x; volatile LAS unsigned* st; };
__device__ __forceinline__ XcdBarrier xcd_barrier_post(unsigned* bar, volatile LAS unsigned* st) {
    XcdBarrier b; b.bar = bar; b.x = xb_xcc_id(); b.st = st;
    if (threadIdx.x == 0) (void)xb_add(&bar[XB_XCNT(b.x)], 1u);
    return b;
}
__device__ __forceinline__ void xcd_barrier_complete(unsigned* bar, unsigned x, unsigned& nloc, unsigned& nx) {
    const unsigned G = gridDim.x * gridDim.y * gridDim.z;
    unsigned sum, cnt, mine, sp = 0u;
    for (;;) {
        sum = 0u; cnt = 0u; mine = 0u;
#pragma unroll
        for (unsigned j = 0; j < 16; ++j) { const unsigned c = xb_ld(&bar[XB_XCNT(j)]); sum += c; cnt += (c > 0u) ? 1u : 0u; mine = (j == x) ? c : mine; }
        if (sum == G) break;
        __builtin_amdgcn_s_sleep(1);
        if ((++sp & 255u) == 0u) { if (xb_ld(&bar[XB_TMO])) break; if (sp > XB_SPIN_CAP) { atomicAdd(&bar[XB_TMO], 1u); break; } }
    }
    nloc = mine > 0u ? mine : 1u; nx = cnt > 0u ? cnt : 1u;
}
__device__ __forceinline__ void xcd_barrier(const XcdBarrier& b) {
    asm volatile("s_waitcnt vmcnt(0)" ::: "memory");
    __syncthreads();
    if (threadIdx.x == 0) {
        unsigned* bar = b.bar;
        __builtin_amdgcn_s_waitcnt(0);
        unsigned nloc = b.st[0], nx = b.st[1];
        if (nloc == 0u) { xcd_barrier_complete(bar, b.x, nloc, nx); b.st[0] = nloc; b.st[1] = nx; }
        const unsigned old = xb_add(&bar[XB_XSUB(b.x)], 1u);
        const unsigned gen = old / nloc;
        if (old + 1u == (gen + 1u) * nloc) {
            __builtin_amdgcn_fence(__ATOMIC_RELEASE, "agent");
            asm volatile("s_waitcnt vmcnt(0)" ::: "memory");
            const unsigned og = xb_add(&bar[XB_TOP], 1u);
            const unsigned tg = og / nx;
            if (og + 1u == (tg + 1u) * nx) xb_add(&bar[XB_TOPGEN], 1u);
            else XB_SPIN(xb_ld(&bar[XB_TOPGEN]) == tg, bar);
            __builtin_amdgcn_fence(__ATOMIC_ACQUIRE, "agent");
            xb_add(&bar[XB_XGEN(b.x)], 1u);
            asm volatile("s_waitcnt vmcnt(0)" ::: "memory");
        } else {
            XB_SPIN(xb_ld(&bar[XB_XGEN(b.x)]) == gen, bar);
            __builtin_amdgcn_fence(__ATOMIC_ACQUIRE, "agent");
            asm volatile("s_waitcnt vmcnt(0)" ::: "memory");
        }
    }
    __syncthreads();
}

__global__ void __launch_bounds__(512, 2) fwd_kernel(Params P) {
    extern __shared__ __attribute__((aligned(16))) unsigned char lds_raw[];
    LAS unsigned char* lds = (LAS unsigned char*)lds_raw;
    cg::grid_group grid = cg::this_grid();
    const int G = gridDim.x;
    volatile LAS unsigned* bst = (volatile LAS unsigned*)(lds + MISC_OFF);
    if (threadIdx.x < 2) bst[threadIdx.x] = 0u;
    __syncthreads();
    XcdBarrier bar = xcd_barrier_post((unsigned*)(P.ws + WS_CTL), bst);
    int ph = 0;
#define PHASE_BEGIN if (ph >= P.ph_lo && ph < P.ph_hi) { unsigned char* ws = P.ws; float* outp = P.out; asm volatile("" : "+s"(ws), "+s"(outp));
#define PHASE_END   if (ph + 1 < P.ph_hi) { if (ph == 0) grid.sync(); else xcd_barrier(bar); } } ++ph;
    PHASE_BEGIN
#ifndef SKIP_PRO
        prologue(P, lds, G);
#endif
    PHASE_END
    for (int l = 0; l < DEPTH; ++l) {
        PHASE_BEGIN
            const float* xin_ctx = l == 0 ? P.x_prompt : outp; const float* xin_lat = l == 0 ? P.x_sample : outp + (size_t)M_CTX * DM;
            norm_phase(xin_ctx, xin_lat, P.norm1_g + l * DM, (const float*)(ws + WS_MODS) + (size_t)l * NCOND * 6144, 0, (bf16_t*)(ws + WS_XN), G);
            cache_phase(P, l, G);
        PHASE_END
        PHASE_BEGIN {
            const float* MISC = (const float*)(ws + WS_MISC);
            pg8::Gemm g{(const bf16_t*)(ws + WS_XN), (const bf16_t*)(ws + WS_WIN) + (size_t)l * INW * 1024, M_ALL, INW, 1024}; pg8::StaticOrder S; S.init(M_ALL, INW, G, blockIdx.x);
            EpiIn E{l, P.gqa_qn_g + l * 64, P.gqa_kn_g + l * 64, P.diff_qn_g + l * 32, P.diff_kn_g + l * 32, MISC + MI_R64C, MISC + MI_R64S, MISC + MI_R32C, MISC + MI_R32S,
                    (bf16_t*)(ws + WS_QG), (bf16_t*)(ws + WS_QD), (bf16_t*)(ws + WS_KG), (bf16_t*)(ws + WS_VG), (bf16_t*)(ws + WS_KD), (bf16_t*)(ws + WS_VD), (bf16_t*)(ws + WS_CB), (bf16_t*)(ws + WS_PB), outp};
#ifndef SKIP_IN
            pg8::gemm_phase(lds, lds + XCH_OFF, g, S, E);
#endif
        } PHASE_END
        PHASE_BEGIN {
            const float* MISC = (const float*)(ws + WS_MISC);
            AttnArgs A{(const bf16_t*)(ws + WS_QG), (const bf16_t*)(ws + WS_QD), (const bf16_t*)(ws + WS_KG), (const bf16_t*)(ws + WS_VG), (const bf16_t*)(ws + WS_KD), (const bf16_t*)(ws + WS_VD),
                       (const bf16_t*)(ws + WS_CB), (const bf16_t*)(ws + WS_PB), (bf16_t*)(ws + WS_XN), P.conv_w + l * 768, P.conv_b + l * 256, P.diff_subln_g + l * 64, MISC[MI_LAM + l], P.lam_init[l]};
#ifndef SKIP_ATT
            attn_phase(A, (LAS char*)lds, G);
#endif
        } PHASE_END
        PHASE_BEGIN {
            const float* xin_ctx = l == 0 ? P.x_prompt : outp; const float* xin_lat = l == 0 ? P.x_sample : outp + (size_t)M_CTX * DM;
            pg8::Gemm g{(const bf16_t*)(ws + WS_XN), (const bf16_t*)(ws + WS_WOUT) + (size_t)l * 1024 * 1024, M_ALL, 1024, 1024}; pg8::StaticOrder S; S.init(M_ALL, 1024, G, blockIdx.x);
            EpiRes E{xin_ctx, xin_lat, outp, (const float*)(ws + WS_MODS) + (size_t)l * NCOND * 6144 + 2 * 1024};
#ifndef SKIP_RES
            pg8::gemm_phase(lds, lds + XCH_OFF, g, S, E);
#endif
        } PHASE_END
        PHASE_BEGIN
            norm_phase(outp, outp + (size_t)M_CTX * DM, P.norm2_g + l * DM, (const float*)(ws + WS_MODS) + (size_t)l * NCOND * 6144, 3, (bf16_t*)(ws + WS_XN), G);
        PHASE_END
        PHASE_BEGIN {
            float* EPb = (float*)(ws + WS_EDGE);
            pg8::Gemm g{(const bf16_t*)(ws + WS_XN), (const bf16_t*)(ws + WS_WUP) + (size_t)l * UPW * 1024, M_ALL, UPW, 1024}; pg8::StaticOrder S; S.init(M_ALL, UPW, G, blockIdx.x);
            EpiUp E{P.ffn_conv_w + (size_t)l * 3 * DFF, P.ffn_conv_b + (size_t)l * DFF, (bf16_t*)(ws + WS_U), EPb, EPb + EDGE_ELEMS, EPb + 2 * EDGE_ELEMS};
#ifndef SKIP_UP
            pg8::gemm_phase(lds, lds + XCH_OFF, g, S, E);
#endif
        } PHASE_END
        PHASE_BEGIN {
            float* EPb = (float*)(ws + WS_EDGE);
            fixup_phase(P.ffn_conv_w + (size_t)l * 3 * DFF, (bf16_t*)(ws + WS_U), EPb, EPb + EDGE_ELEMS, EPb + 2 * EDGE_ELEMS, G);
        } PHASE_END
        PHASE_BEGIN {
            pg8::Gemm g{(const bf16_t*)(ws + WS_U), (const bf16_t*)(ws + WS_WDN) + (size_t)l * 1024 * DFF, M_ALL, 1024, DFF}; pg8::StaticOrder S; S.init(M_ALL, 1024, G, blockIdx.x);
            EpiRes E{outp, outp + (size_t)M_CTX * DM, outp, (const float*)(ws + WS_MODS) + (size_t)l * NCOND * 6144 + 5 * 1024};
#ifndef SKIP_RES
            pg8::gemm_phase(lds, lds + XCH_OFF, g, S, E);
#endif
        } PHASE_END
    }
}

constexpr int N_PHASES = 1 + DEPTH * 8;
#ifndef N_LAUNCH_SPLIT
#define N_LAUNCH_SPLIT 0
#endif

extern "C" void kernel_launch(void* const* d_in, const int* in_sizes, int n_in, void* d_out, int out_size, void* d_ws, size_t ws_size, hipStream_t stream) {
    static int grid = 0;
    if (grid == 0) {
        if (n_in != 26 || ws_size < WS_END) { fprintf(stderr, "kernel_launch: unexpected n_in %d or ws_size %zu (< %zu)\n", n_in, ws_size, (size_t)WS_END); grid = -1; return; }
        int dev = 0, cus = 0, per_cu = 0;
        hipGetDevice(&dev); hipDeviceGetAttribute(&cus, hipDeviceAttributeMultiprocessorCount, dev);
        hipFuncSetAttribute((const void*)fwd_kernel, hipFuncAttributeMaxDynamicSharedMemorySize, LDS_BYTES);
        hipOccupancyMaxActiveBlocksPerMultiprocessor(&per_cu, (const void*)fwd_kernel, 512, LDS_BYTES);
        if (per_cu < 1) { fprintf(stderr, "kernel_launch: occupancy query gives %d\n", per_cu); per_cu = 1; }
        (void)hipGetLastError();
        grid = cus * 1;
    }
    if (grid < 0) return;
    Params p{};
    const float** pp = (const float**)&p;
    for (int i = 0; i < 26; ++i) pp[i] = (const float*)d_in[i];
    p.out = (float*)d_out; p.ws = (unsigned char*)d_ws;
    for (int l = 0; l < 4; ++l) p.lam_init[l] = (float)(0.8 - 0.6 * exp(-0.3 * (double)l));
#if N_LAUNCH_SPLIT
    for (int ph = 0; ph < N_PHASES; ++ph) { p.ph_lo = ph; p.ph_hi = ph + 1; hipLaunchKernelGGL(fwd_kernel, dim3(grid), dim3(512), LDS_BYTES, stream, p); }
#else
    p.ph_lo = 0; p.ph_hi = N_PHASES;
    if (hipMemsetAsync((char*)d_ws + WS_CTL, 0, CTL_ZERO_BYTES, stream) != hipSuccess) { fprintf(stderr, "kernel_launch: memset failed\n"); return; }
    void* args[] = {&p};
    hipError_t e = hipLaunchCooperativeKernel((const void*)fwd_kernel, dim3(grid), dim3(512), args, LDS_BYTES, stream);
    if (e != hipSuccess) fprintf(stderr, "cooperative launch failed: %s (grid %d)\n", hipGetErrorString(e), grid);
#endif
}
```

```cpp
#include <hip/hip_runtime.h>
#include <hip/hip_cooperative_groups.h>
#include <cstdio>
#include <cstdint>
#include <cmath>
namespace cg = cooperative_groups;

#define LAS __attribute__((address_space(3)))
#define GAS __attribute__((address_space(1)))
typedef unsigned short bf16_t;
typedef short bf16x8 __attribute__((ext_vector_type(8)));
typedef short s16x4 __attribute__((ext_vector_type(4)));
typedef float f32x4 __attribute__((ext_vector_type(4)));
typedef float f32x16 __attribute__((ext_vector_type(16)));
typedef unsigned u32x4 __attribute__((ext_vector_type(4)));
typedef unsigned u32x2 __attribute__((ext_vector_type(2)));
typedef float f32x2 __attribute__((ext_vector_type(2)));
typedef __bf16 bf16x2_t __attribute__((ext_vector_type(2)));

__device__ __forceinline__ unsigned cvtpk(float lo, float hi) { f32x2 v = {lo, hi}; bf16x2_t b = __builtin_convertvector(v, bf16x2_t); return __builtin_bit_cast(unsigned, b); }
__device__ __forceinline__ int opaque_tid() { int t = threadIdx.x; asm volatile("" : "+v"(t)); return t; }
__device__ __forceinline__ float bf2f(unsigned short u) { return __uint_as_float(((unsigned)u) << 16); }

constexpr int DM = 1024, DEPTH = 4, NCOND = 9;
constexpr int M_CTX = 8192, M_ALL = 40960, NTM = 160;
constexpr int INW = 2304, DFF = 2816, UPW = 5632;
constexpr int SLAT = 4352;
constexpr float EPS = 1e-6f;
constexpr float LOG2E = 1.4426950408889634f;
constexpr float QSCALE_G = 0.125f * LOG2E;
constexpr float QSCALE_D = 0.17677669529663687f * LOG2E;
constexpr size_t OUT_GK = 41943040, OUT_GV = OUT_GK + 4194304, OUT_DK = OUT_GV + 4194304, OUT_DV = OUT_DK + 8388608;
constexpr size_t MiB = 1u << 20;
constexpr size_t WS_MODS = 1 * MiB;
constexpr size_t WS_MISC = 2 * MiB;
constexpr size_t WS_EDGE = 3 * MiB;
constexpr size_t EDGE_ELEMS = (size_t)NTM * 2 * DFF;
constexpr size_t WS_WIN = 16 * MiB;
constexpr size_t WS_WOUT = 34 * MiB;
constexpr size_t WS_WUP = 42 * MiB;
constexpr size_t WS_WDN = 86 * MiB;
constexpr size_t WS_XN = 108 * MiB;
constexpr size_t WS_U = 188 * MiB;
constexpr size_t WS_QG = WS_U, WS_QD = WS_QG + (size_t)M_ALL * 512 * 2, WS_KG = WS_QD + (size_t)M_ALL * 256 * 2;
constexpr size_t KROWS = 8192 + 8 * SLAT;
constexpr size_t WS_VG = WS_KG + KROWS * 128 * 2, WS_KD = WS_VG + KROWS * 128 * 2, WS_VD = WS_KD + KROWS * 256 * 2;
constexpr size_t WS_CB = WS_VD + KROWS * 256 * 2, WS_PB = WS_CB + (size_t)M_ALL * 256 * 2, WS_UEND = WS_PB + (size_t)M_ALL * 256 * 2;
constexpr size_t WS_END = WS_U + (size_t)M_ALL * DFF * 2;
static_assert(WS_UEND <= WS_END, "union");
constexpr int MI_LAM = 0, MI_R64C = 64, MI_R64S = MI_R64C + 1024, MI_R32C = MI_R64S + 1024, MI_R32S = MI_R32C + 512;

constexpr int RING_BYTES = 131072, XCH_OFF = RING_BYTES, MISC_OFF = RING_BYTES + 4096, LDS_BYTES = RING_BYTES + 4096 + 256;
constexpr size_t WS_CTL = 0, CTL_ZERO_BYTES = 65536;

struct TileInfo {
    int lat, seq, t0, ci, S; long R;
    __device__ __forceinline__ TileInfo(int pm) {
        if (pm < 32) { lat = 0; seq = pm; t0 = 0; ci = 0; S = 256; R = 256L * pm; }
        else { const int b = (pm - 32) >> 4; lat = 1; seq = b; t0 = ((pm - 32) & 15) * 256; ci = 1 + b; S = SLAT; R = 8192L + (long)SLAT * b; }
    }
};

namespace pg8 {
constexpr int BM = 256, BK = 64, HALF = 128, HTB = HALF * BK * 2, NXCD = 8, WGM = 8;
__host__ __device__ __forceinline__ int lds_byte(int r, int c) { const int st = (r >> 4) * 2 + (c >> 5), rr = r & 15, cc = c & 31, ob = rr * 64 + cc * 2; return st * 1024 + (ob ^ (((ob >> 9) & 1) << 5)); }
__host__ __device__ __forceinline__ void stage_rc(int b, int& R, int& C) { const int st = b / 1024, sb = b % 1024, swz = sb ^ (((sb >> 9) & 1) << 5); R = (st >> 1) * 16 + swz / 64; C = (st & 1) * 32 + (swz % 64) / 2; }
struct Unit { int pm, pn; };
struct Gemm { const bf16_t* A; const bf16_t* Bt; int M, N, K; };
struct StaticOrder {
    int nM, nN, nwg, G, c;
    __device__ void init(int M, int N, int G_, int c_) { nM = M / BM; nN = N / BM; nwg = nM * nN; G = G_; c = c_; }
    __device__ bool next(int i, Unit& u) const {
        const long L = (long)i * G + c; if (L >= nwg) return false;
        int wgid = (int)L; { const int q = nwg / NXCD, r = nwg % NXCD, xcd = wgid % NXCD, off = wgid / NXCD; wgid = (xcd < r ? xcd * (q + 1) : r * (q + 1) + (xcd - r) * q) + off; }
        const int nig = WGM * nN, gid = wgid / nig, fm = gid * WGM, gsz = (nM - fm) < WGM ? (nM - fm) : WGM;
        u.pm = fm + ((wgid % nig) % gsz); u.pn = (wgid % nig) / gsz; return true;
    }
};
template <class Epi>
__device__ __forceinline__ void gemm_phase(LAS unsigned char* lds, LAS unsigned char* xlds, const Gemm g, const StaticOrder& S, const Epi& E) {
    const int tid = opaque_tid(), wid = __builtin_amdgcn_readfirstlane(tid >> 6), lane = tid & 63, wr = wid >> 2, wc = wid & 3, fr = lane & 15, fq = lane >> 4;
    const int K = g.K, nt = K / BK;
    unsigned voffA[2];
#pragma unroll
    for (int i = 0; i < 2; ++i) { int R, C; stage_rc(tid * 16 + i * 8192, R, C); voffA[i] = (unsigned)(R * K + C) * 2u; }
    const size_t kstep = (size_t)(BK * 2);
    const size_t hstep = (size_t)HALF * K * 2;
    const size_t tstep = 2 * hstep;
    const unsigned ldsw = (unsigned)wid * 1024u;
    const int aoff = lds_byte(wr * 64 + fr, fq * 8), boff = lds_byte(wc * 32 + fr, fq * 8);
#define PG8_SA(b, h) (((b) * 2 + (h)) * HTB)
#define PG8_SB(b, h) ((4 + (b) * 2 + (h)) * HTB)
#define PG8_STAGE(bufoff, gbase) do { _Pragma("unroll") for (int _i = 0; _i < 2; ++_i) \
        __builtin_amdgcn_global_load_lds((const unsigned*)((const char*)(gbase) + voffA[_i]), (LAS unsigned*)(lds + (bufoff) + ldsw + _i * 8192), 16, 0, 0); } while (0)
#define PG8_LDA(dst, b, h) do { _Pragma("unroll") for (int m = 0; m < 4; ++m) _Pragma("unroll") for (int k = 0; k < 2; ++k) dst[m][k] = *(const LAS bf16x8*)(lds + PG8_SA(b, h) + aoff + m * 2048 + k * 1024); } while (0)
#define PG8_LDB(dst, b, h) do { _Pragma("unroll") for (int n = 0; n < 2; ++n) _Pragma("unroll") for (int k = 0; k < 2; ++k) dst[n][k] = *(const LAS bf16x8*)(lds + PG8_SB(b, h) + boff + n * 2048 + k * 1024); } while (0)
#define PG8_MMA(ai, bj, At, Bt) do { __builtin_amdgcn_s_setprio(1); _Pragma("unroll") for (int m = 0; m < 4; ++m) _Pragma("unroll") for (int n = 0; n < 2; ++n) _Pragma("unroll") for (int k = 0; k < 2; ++k) \
        acc[ai][bj][m][n] = __builtin_amdgcn_mfma_f32_16x16x32_bf16(Bt[n][k], At[m][k], acc[ai][bj][m][n], 0, 0, 0); __builtin_amdgcn_s_setprio(0); } while (0)
#define PG8_WAIT_V(n) asm volatile("s_waitcnt vmcnt(" #n ")" ::: "memory")
#define PG8_WAIT_L(n) asm volatile("s_waitcnt lgkmcnt(" #n ")" ::: "memory")
#define PG8_BAR __builtin_amdgcn_s_barrier()
#define PG8_SCHED __builtin_amdgcn_sched_barrier(0)
    Unit cur, nxt; int ui = 0;
    if (!S.next(0, cur)) return;
    f32x4 acc[2][2][4][2];
#pragma unroll
    for (int a = 0; a < 2; ++a)
#pragma unroll
        for (int b = 0; b < 2; ++b)
#pragma unroll
            for (int m = 0; m < 4; ++m)
#pragma unroll
                for (int n = 0; n < 2; ++n) acc[a][b][m][n] = (f32x4){0.f, 0.f, 0.f, 0.f};
    bf16x8 At[4][2], B0[2][2], B1[2][2];
    const char* cA = (const char*)g.A + (size_t)cur.pm * tstep; const char* cB = (const char*)g.Bt + (size_t)cur.pn * tstep;
    PG8_STAGE(PG8_SB(0, 0), cB); PG8_STAGE(PG8_SB(0, 1), cB + hstep); PG8_STAGE(PG8_SA(0, 0), cA); PG8_STAGE(PG8_SA(0, 1), cA + hstep);
    if (wr == 1) PG8_BAR;
    PG8_WAIT_V(2); PG8_BAR;
    PG8_STAGE(PG8_SB(1, 0), cB + kstep); PG8_STAGE(PG8_SA(1, 0), cA + kstep); PG8_STAGE(PG8_SB(1, 1), cB + hstep + kstep);
    PG8_WAIT_V(6); PG8_BAR;
    for (;;) {
        const bool has_next = S.next(ui + 1, nxt);
        const char* nA = has_next ? (const char*)g.A + (size_t)nxt.pm * tstep : cA; const char* nB = has_next ? (const char*)g.Bt + (size_t)nxt.pn * tstep : cB;
        for (int t = 0; t < nt; t += 2) {
            const bool last = (t == nt - 2);
            const char* a1 = cA + (size_t)(t + 1) * kstep;
            const char* a2 = last ? nA : cA + (size_t)(t + 2) * kstep; const char* b2 = last ? nB : cB + (size_t)(t + 2) * kstep;
            const char* a3 = a2 + kstep; const char* b3 = b2 + kstep;
            PG8_LDB(B0, 0, 0); PG8_LDB(B1, 0, 1); PG8_SCHED; PG8_LDA(At, 0, 0); PG8_STAGE(PG8_SA(1, 1), a1 + hstep);
            PG8_WAIT_V(8); PG8_WAIT_L(0); PG8_BAR; PG8_MMA(0, 0, At, B0); PG8_MMA(0, 1, At, B1); PG8_BAR; PG8_SCHED;
            PG8_LDA(At, 0, 1); PG8_STAGE(PG8_SB(0, 0), b2); PG8_STAGE(PG8_SB(0, 1), b2 + hstep); PG8_STAGE(PG8_SA(0, 0), a2);
            PG8_WAIT_V(8); PG8_WAIT_L(0); PG8_BAR; PG8_MMA(1, 0, At, B0); PG8_MMA(1, 1, At, B1); PG8_BAR; PG8_SCHED;
            PG8_LDB(B0, 1, 0); PG8_LDB(B1, 1, 1); PG8_SCHED; PG8_LDA(At, 1, 0); PG8_STAGE(PG8_SA(0, 1), a2 + hstep);
            PG8_WAIT_V(8); PG8_WAIT_L(0); PG8_BAR; PG8_MMA(0, 0, At, B0); PG8_MMA(0, 1, At, B1); PG8_BAR; PG8_SCHED;
            PG8_LDA(At, 1, 1); PG8_STAGE(PG8_SB(1, 0), b3); PG8_STAGE(PG8_SB(1, 1), b3 + hstep); PG8_STAGE(PG8_SA(1, 0), a3);
            PG8_WAIT_V(8); PG8_WAIT_L(0); PG8_BAR; PG8_MMA(1, 0, At, B0); PG8_MMA(1, 1, At, B1); PG8_BAR; PG8_SCHED;
        }
        if (wr == 0) PG8_BAR;
        { int fr_ = fr, fq_ = fq; asm volatile("" : "+v"(fr_), "+v"(fq_)); E(acc, cur, wr, wc, fr_, fq_, xlds); }
        if (!has_next) break;
#pragma unroll
        for (int a = 0; a < 2; ++a)
#pragma unroll
            for (int b = 0; b < 2; ++b)
#pragma unroll
                for (int m = 0; m < 4; ++m)
#pragma unroll
                    for (int n = 0; n < 2; ++n) acc[a][b][m][n] = (f32x4){0.f, 0.f, 0.f, 0.f};
        cur = nxt; cA = nA; cB = nB; ++ui;
        if (wr == 1) PG8_BAR;
    }
    PG8_WAIT_V(0);
    PG8_BAR;
#undef PG8_SA
#undef PG8_SB
#undef PG8_STAGE
#undef PG8_LDA
#undef PG8_LDB
#undef PG8_MMA
#undef PG8_WAIT_V
#undef PG8_WAIT_L
#undef PG8_BAR
#undef PG8_SCHED
}
}

typedef f32x4 Acc[2][2][4][2];

struct EpiRes {
    const float* xin_ctx; const float* xin_lat; float* xout; const float* gate;
    __device__ __forceinline__ void operator()(const Acc& acc, const pg8::Unit& u, int wr, int wc, int fr, int fq, LAS unsigned char*) const {
        const TileInfo ti(u.pm);
        const int col0 = u.pn * 256 + wc * 32 + 4 * fq;
        const float* gp = gate + ti.ci * 6144 + col0;
        f32x4 g4[2][2];
#pragma unroll
        for (int bj = 0; bj < 2; ++bj)
#pragma unroll
            for (int n = 0; n < 2; ++n) g4[bj][n] = *(const GAS f32x4*)(gp + bj * 128 + n * 16);
        const float* xin = ti.lat ? xin_lat + (size_t)(u.pm * 256 - M_CTX) * DM : xin_ctx + (size_t)(u.pm * 256) * DM;
        float* xo = xout + (size_t)(u.pm * 256) * DM;
#pragma unroll
        for (int ai = 0; ai < 2; ++ai) {
            f32x4 xv[4][2][2];
#pragma unroll
            for (int m = 0; m < 4; ++m) {
                const size_t off = (size_t)(ai * 128 + wr * 64 + m * 16 + fr) * DM + col0;
#pragma unroll
                for (int bj = 0; bj < 2; ++bj)
#pragma unroll
                    for (int n = 0; n < 2; ++n) xv[m][bj][n] = *(const GAS f32x4*)(xin + off + bj * 128 + n * 16);
            }
#pragma unroll
            for (int m = 0; m < 4; ++m) {
                const size_t off = (size_t)(ai * 128 + wr * 64 + m * 16 + fr) * DM + col0;
#pragma unroll
                for (int bj = 0; bj < 2; ++bj)
#pragma unroll
                    for (int n = 0; n < 2; ++n) *(GAS f32x4*)(xo + off + bj * 128 + n * 16) = xv[m][bj][n] + g4[bj][n] * acc[ai][bj][m][n];
            }
            __builtin_amdgcn_sched_group_barrier(0x020, 16, 0);
            asm volatile("" ::: "memory");
            __builtin_amdgcn_sched_barrier(0);
        }
    }
};

struct EpiIn {
    int layer;
    const float *qn_g, *kn_g, *dqn_g, *dkn_g;
    const float *r64c, *r64s, *r32c, *r32s;
    bf16_t *QG, *QD, *KG, *VG, *KD, *VD, *CB, *PB;
    float* out;
    __device__ __forceinline__ void operator()(const Acc& acc, const pg8::Unit& u, int wr, int wc, int fr, int fq, LAS unsigned char*) const {
        const TileInfo ti(u.pm);
        const int pn = u.pn;
        const int rbase = wr * 64 + fr;
        if (pn < 2 || (pn == 2 && wc < 2)) {
            const bool isq = pn < 2;
            const float* gsrc = (isq ? qn_g : kn_g) + 4 * fq;
            const int head = isq ? 4 * pn + wc : wc;
#pragma unroll
            for (int ai = 0; ai < 2; ++ai)
#pragma unroll
                for (int m = 0; m < 4; ++m) {
                    const int rt = ai * 128 + m * 16 + rbase; const int t = ti.t0 + rt;
                    float ss = 0.f;
#pragma unroll
                    for (int bj = 0; bj < 2; ++bj)
#pragma unroll
                        for (int n = 0; n < 2; ++n) { const f32x4 v = acc[ai][bj][m][n]; ss += (v[0] * v[0] + v[1] * v[1]) + (v[2] * v[2] + v[3] * v[3]); }
                    ss += __shfl_xor(ss, 16); ss += __shfl_xor(ss, 32);
                    const float rstd = rsqrtf(ss * (1.f / 64.f) + EPS);
                    bf16_t* dst = isq ? QG + ((size_t)u.pm * 256 + rt) * 512 + head * 64 + 4 * fq : KG + ((ti.R * 2 + (long)head * ti.S + t) * 64) + 4 * fq;
                    float* o = out + OUT_GK + ((size_t)(ti.seq * 4 + layer) * 256 + t) * 128 + head * 64 + 4 * fq;
#pragma unroll
                    for (int bj = 0; bj < 2; ++bj) {
                        f32x4 y0 = acc[ai][bj][m][0] * rstd * *(const GAS f32x4*)(gsrc + 32 * bj), y1 = acc[ai][bj][m][1] * rstd * *(const GAS f32x4*)(gsrc + 32 * bj + 16);
                        if (!isq && !ti.lat) { *(GAS f32x4*)(o + 32 * bj) = y0; *(GAS f32x4*)(o + 32 * bj + 16) = y1; }
                        if (ti.lat) {
                            const int pos = bj ? (t & 63) : (t >> 6);
                            const f32x4 c4 = *(const GAS f32x4*)(r64c + pos * 16 + 4 * fq), s4 = *(const GAS f32x4*)(r64s + pos * 16 + 4 * fq);
                            const f32x4 o0 = y0 * c4 - y1 * s4, o1 = y1 * c4 + y0 * s4; y0 = o0; y1 = o1;
                        }
                        if (isq) { y0 = y0 * QSCALE_G; y1 = y1 * QSCALE_G; }
                        u32x2 w0, w1; w0.x = cvtpk(y0[0], y0[1]); w0.y = cvtpk(y0[2], y0[3]); w1.x = cvtpk(y1[0], y1[1]); w1.y = cvtpk(y1[2], y1[3]);
                        *(GAS u32x2*)(dst + 32 * bj) = w0; *(GAS u32x2*)(dst + 32 * bj + 16) = w1;
                    }
                    asm volatile("" ::: "memory");
                }
        } else if (pn == 2) {
            const int head = wc - 2;
#pragma unroll
            for (int ai = 0; ai < 2; ++ai)
#pragma unroll
                for (int m = 0; m < 4; ++m) {
                    const int rt = ai * 128 + m * 16 + rbase; const int t = ti.t0 + rt;
                    if (!ti.lat) {
                        float* o = out + OUT_GV + ((size_t)(ti.seq * 4 + layer) * 256 + t) * 128 + head * 64 + 4 * fq;
#pragma unroll
                        for (int bj = 0; bj < 2; ++bj)
#pragma unroll
                            for (int n = 0; n < 2; ++n) *(GAS f32x4*)(o + 32 * bj + 16 * n) = acc[ai][bj][m][n];
                    }
                    bf16_t* vp = VG + ((ti.R * 2 + (long)head * ti.S + t) * 64) + 4 * fq;
#pragma unroll
                    for (int bj = 0; bj < 2; ++bj)
#pragma unroll
                        for (int n = 0; n < 2; ++n) { const f32x4 v = acc[ai][bj][m][n]; u32x2 w; w.x = cvtpk(v[0], v[1]); w.y = cvtpk(v[2], v[3]); *(GAS u32x2*)(vp + 32 * bj + 16 * n) = w; }
                }
        } else if (pn == 3) {
#pragma unroll
            for (int ai = 0; ai < 2; ++ai)
#pragma unroll
                for (int m = 0; m < 4; ++m) {
                    const size_t grow = (size_t)u.pm * 256 + ai * 128 + m * 16 + rbase;
                    bf16_t* p = CB + grow * 256 + 32 * wc + 8 * fq;
#pragma unroll
                    for (int bj = 0; bj < 2; ++bj) { const f32x4 a = acc[ai][bj][m][0], b = acc[ai][bj][m][1]; u32x4 w; w.x = cvtpk(a[0], a[1]); w.y = cvtpk(a[2], a[3]); w.z = cvtpk(b[0], b[1]); w.w = cvtpk(b[2], b[3]); *(GAS u32x4*)(p + 128 * bj) = w; }
                }
        } else if (pn < 6) {
#pragma unroll
            for (int ai = 0; ai < 2; ++ai)
#pragma unroll
                for (int m = 0; m < 4; ++m) {
                    const size_t grow = (size_t)u.pm * 256 + ai * 128 + m * 16 + rbase;
                    bf16_t* p = PB + grow * 256 + 128 * (pn - 4) + 32 * wc + 8 * fq;
                    const f32x4 a = acc[ai][0][m][0] * acc[ai][1][m][0], b = acc[ai][0][m][1] * acc[ai][1][m][1];
                    u32x4 w; w.x = cvtpk(a[0], a[1]); w.y = cvtpk(a[2], a[3]); w.z = cvtpk(b[0], b[1]); w.w = cvtpk(b[2], b[3]); *(GAS u32x4*)p = w;
                }
        } else if (pn < 8) {
            const bool isq = pn == 6;
            const float* gsrc = isq ? dqn_g : dkn_g;
            const int a_ax = fq >> 1, ib = 4 * (fq & 1);
            const float* gp = gsrc + 16 * a_ax + ib;
            const int head = wc;
#pragma unroll
            for (int ai = 0; ai < 2; ++ai)
#pragma unroll
                for (int m = 0; m < 4; ++m) {
                    const int rt = ai * 128 + m * 16 + rbase; const int t = ti.t0 + rt; const size_t grow = (size_t)u.pm * 256 + rt;
#pragma unroll
                    for (int bj = 0; bj < 2; ++bj) {
                        float ss = 0.f;
#pragma unroll
                        for (int n = 0; n < 2; ++n) { const f32x4 v = acc[ai][bj][m][n]; ss += (v[0] * v[0] + v[1] * v[1]) + (v[2] * v[2] + v[3] * v[3]); }
                        ss += __shfl_xor(ss, 16); ss += __shfl_xor(ss, 32);
                        const float rstd = rsqrtf(ss * (1.f / 32.f) + EPS);
                        f32x4 y0 = acc[ai][bj][m][0] * rstd * *(const GAS f32x4*)gp, y1 = acc[ai][bj][m][1] * rstd * *(const GAS f32x4*)(gp + 8);
                        if (!isq && !ti.lat) {
                            float* o = out + OUT_DK + ((size_t)(ti.seq * 4 + layer) * 256 + t) * 256 + head * 64 + bj * 32 + 16 * a_ax + ib;
                            *(GAS f32x4*)(o) = y0; *(GAS f32x4*)(o + 8) = y1;
                        }
                        if (ti.lat) {
                            const int pos = a_ax ? (t & 63) : (t >> 6);
                            const f32x4 c4 = *(const GAS f32x4*)(r32c + pos * 8 + ib), s4 = *(const GAS f32x4*)(r32s + pos * 8 + ib);
                            const f32x4 o0 = y0 * c4 - y1 * s4, o1 = y1 * c4 + y0 * s4; y0 = o0; y1 = o1;
                        }
                        bf16_t* dst;
                        if (isq) { y0 = y0 * QSCALE_D; y1 = y1 * QSCALE_D; dst = QD + grow * 256 + head * 64 + bj * 32 + 16 * a_ax + ib; }
                        else dst = KD + ((ti.R * 8 + (long)(head * 2 + bj) * ti.S + t) * 32) + 16 * a_ax + ib;
                        u32x2 w0, w1; w0.x = cvtpk(y0[0], y0[1]); w0.y = cvtpk(y0[2], y0[3]); w1.x = cvtpk(y1[0], y1[1]); w1.y = cvtpk(y1[2], y1[3]);
                        *(GAS u32x2*)dst = w0; *(GAS u32x2*)(dst + 8) = w1;
                    }
                    asm volatile("" ::: "memory");
                }
        } else {
            const int head = wc;
#pragma unroll
            for (int ai = 0; ai < 2; ++ai)
#pragma unroll
                for (int m = 0; m < 4; ++m) {
                    const int rt = ai * 128 + m * 16 + rbase; const int t = ti.t0 + rt;
                    if (!ti.lat) {
                        float* o = out + OUT_DV + ((size_t)(ti.seq * 4 + layer) * 256 + t) * 256 + head * 64 + 8 * fq;
#pragma unroll
                        for (int bj = 0; bj < 2; ++bj) { *(GAS f32x4*)(o + 32 * bj) = acc[ai][bj][m][0]; *(GAS f32x4*)(o + 32 * bj + 4) = acc[ai][bj][m][1]; }
                    }
                    bf16_t* vp = VD + ((ti.R * 4 + (long)head * ti.S + t) * 64) + 8 * fq;
#pragma unroll
                    for (int bj = 0; bj < 2; ++bj) { const f32x4 a = acc[ai][bj][m][0], b = acc[ai][bj][m][1]; u32x4 w; w.x = cvtpk(a[0], a[1]); w.y = cvtpk(a[2], a[3]); w.z = cvtpk(b[0], b[1]); w.w = cvtpk(b[2], b[3]); *(GAS u32x4*)(vp + 32 * bj) = w; }
                }
        }
    }
};

__device__ __forceinline__ float dpp_ror1(float x) { return __int_as_float(__builtin_amdgcn_update_dpp(0, __float_as_int(x), 0x121, 0xf, 0xf, false)); }
__device__ __forceinline__ float dpp_ror15(float x) { return __int_as_float(__builtin_amdgcn_update_dpp(0, __float_as_int(x), 0x12F, 0xf, 0xf, false)); }
__device__ __forceinline__ float silu_f(float x) { return x * __builtin_amdgcn_rcpf(1.f + __builtin_amdgcn_exp2f(-x * LOG2E)); }
struct EpiUp {
    const float* cw; const float* cbias; bf16_t* F; float* EP; float* EA; float* EU;
    __device__ __forceinline__ void operator()(const Acc& acc, const pg8::Unit& u, int wr, int wc, int fr, int fq, LAS unsigned char* xlds) const {
        const TileInfo ti(u.pm);
        const int c0 = u.pn * 128 + wc * 32 + 8 * fq;
        LAS float* X = (LAS float*)xlds;
#pragma unroll
        for (int ai = 0; ai < 2; ++ai) {
            if (fr == 0) { LAS float* p = X + ((((ai * 2 + wr) * 4 + wc) * 2 + 0) * 4 + fq) * 8; *(LAS f32x4*)p = acc[ai][0][0][0]; *(LAS f32x4*)(p + 4) = acc[ai][0][0][1]; }
            if (fr == 15) { LAS float* p = X + ((((ai * 2 + wr) * 4 + wc) * 2 + 1) * 4 + fq) * 8; *(LAS f32x4*)p = acc[ai][0][3][0]; *(LAS f32x4*)(p + 4) = acc[ai][0][3][1]; }
        }
        asm volatile("s_waitcnt lgkmcnt(0)" ::: "memory"); __builtin_amdgcn_s_barrier(); asm volatile("" ::: "memory");
        f32x4 w0[2], w1[2], w2[2], bb[2];
#pragma unroll
        for (int n = 0; n < 2; ++n) { w0[n] = *(const GAS f32x4*)(cw + c0 + 4 * n); w1[n] = *(const GAS f32x4*)(cw + DFF + c0 + 4 * n); w2[n] = *(const GAS f32x4*)(cw + 2 * DFF + c0 + 4 * n); bb[n] = *(const GAS f32x4*)(cbias + c0 + 4 * n); }
        const bool has_prev = ti.lat && ti.t0 > 0, has_next = ti.lat && ti.t0 < 4096 - 256;
#pragma unroll
        for (int ai = 0; ai < 2; ++ai) {
            f32x4 pb[2] = {(f32x4){0.f, 0.f, 0.f, 0.f}, (f32x4){0.f, 0.f, 0.f, 0.f}}, nb[2] = {(f32x4){0.f, 0.f, 0.f, 0.f}, (f32x4){0.f, 0.f, 0.f, 0.f}};
            { const int seg = ai * 2 + wr;
              if (seg > 0) { const int ps = seg - 1; LAS float* p = X + ((((ps >> 1) * 2 + (ps & 1)) * 4 + wc) * 2 + 1) * 32 + fq * 8; pb[0] = *(LAS f32x4*)p; pb[1] = *(LAS f32x4*)(p + 4); }
              if (seg < 3) { const int ns = seg + 1; LAS float* p = X + ((((ns >> 1) * 2 + (ns & 1)) * 4 + wc) * 2 + 0) * 32 + fq * 8; nb[0] = *(LAS f32x4*)p; nb[1] = *(LAS f32x4*)(p + 4); } }
#pragma unroll
            for (int m = 0; m < 4; ++m) {
                const int rt = ai * 128 + wr * 64 + m * 16 + fr; const size_t grow = (size_t)u.pm * 256 + rt;
                f32x4 fo[2], cv[2];
#pragma unroll
                for (int n = 0; n < 2; ++n) {
                    const f32x4 a = acc[ai][0][m][n];
                    const f32x4 up = (m > 0) ? acc[ai][0][m > 0 ? m - 1 : 0][n] : pb[n];
                    const f32x4 dn = (m < 3) ? acc[ai][0][m < 3 ? m + 1 : 3][n] : nb[n];
                    f32x4 pv, nx;
#pragma unroll
                    for (int e = 0; e < 4; ++e) {
                        pv[e] = dpp_ror1(fr == 15 ? up[e] : a[e]);
                        nx[e] = dpp_ror15(fr == 0 ? dn[e] : a[e]);
                    }
                    const f32x4 c = w0[n] * pv + w1[n] * a + w2[n] * nx + bb[n];
                    cv[n] = c;
                    const f32x4 uu = acc[ai][1][m][n];
#pragma unroll
                    for (int e = 0; e < 4; ++e) fo[n][e] = silu_f(c[e]) * uu[e];
                }
                u32x4 w; w.x = cvtpk(fo[0][0], fo[0][1]); w.y = cvtpk(fo[0][2], fo[0][3]); w.z = cvtpk(fo[1][0], fo[1][1]); w.w = cvtpk(fo[1][2], fo[1][3]);
                *(GAS u32x4*)(F + grow * DFF + c0) = w;
                if (ai == 0 && m == 0) { if (has_prev && rt == 0) { const size_t eo = ((size_t)u.pm * 2 + 0) * DFF + c0;
                        *(GAS f32x4*)(EP + eo) = cv[0]; *(GAS f32x4*)(EP + eo + 4) = cv[1]; *(GAS f32x4*)(EA + eo) = acc[0][0][0][0]; *(GAS f32x4*)(EA + eo + 4) = acc[0][0][0][1]; *(GAS f32x4*)(EU + eo) = acc[0][1][0][0]; *(GAS f32x4*)(EU + eo + 4) = acc[0][1][0][1]; } }
                if (ai == 1 && m == 3) { if (has_next && rt == 255) { const size_t eo = ((size_t)u.pm * 2 + 1) * DFF + c0;
                        *(GAS f32x4*)(EP + eo) = cv[0]; *(GAS f32x4*)(EP + eo + 4) = cv[1]; *(GAS f32x4*)(EA + eo) = acc[1][0][3][0]; *(GAS f32x4*)(EA + eo + 4) = acc[1][0][3][1]; *(GAS f32x4*)(EU + eo) = acc[1][1][3][0]; *(GAS f32x4*)(EU + eo + 4) = acc[1][1][3][1]; } }
            }
        }
        asm volatile("s_waitcnt lgkmcnt(0)" ::: "memory"); __builtin_amdgcn_s_barrier(); asm volatile("" ::: "memory");
    }
};

typedef short v4i16_t __attribute__((ext_vector_type(4)));
__device__ __forceinline__ s16x4 vtr(LAS const char* p) { return __builtin_bit_cast(s16x4, __builtin_amdgcn_ds_read_tr16_b64_v4i16((LAS v4i16_t*)p)); }
__device__ __forceinline__ float xhalf_max(float m) { auto rr = __builtin_amdgcn_permlane32_swap(__float_as_uint(m), __float_as_uint(m), false, false); return fmaxf(__uint_as_float(rr[0]), __uint_as_float(rr[1])); }
__device__ __forceinline__ float xhalf_sum(float m) { auto rr = __builtin_amdgcn_permlane32_swap(__float_as_uint(m), __float_as_uint(m), false, false); return __uint_as_float(rr[0]) + __uint_as_float(rr[1]); }

constexpr int ATT_VS = 192;
constexpr float ATT_THR = 8.f;
#define MX3(a, b, c) __builtin_fmaxf(__builtin_fmaxf((a), (b)), (c))
template <int DQK, bool YORD>
__device__ __forceinline__ void flash_pass(const bf16_t* __restrict__ Qw, int qpitch, const bf16_t* __restrict__ Kg, const bf16_t* __restrict__ Vg, int NT, int tst,
                                           LAS char* lds, f32x16 (&o)[2], float& lsum) {
#define ATT_TI(T) (((T) + tst) < NT ? ((T) + tst) : ((T) + tst - NT))
    constexpr int KS = DQK * 2 + 16, KBUF = 64 * KS, VBUF = 64 * ATT_VS, NDS = DQK / 16;
    constexpr int KROWB = DQK * 2;
    const int tid = opaque_tid(), lane = tid & 63, r32 = lane & 31, h = lane >> 5;
    LAS char* Kb = lds; LAS char* Vb = lds + 2 * KBUF;
    bf16x8 qf[NDS];
#pragma unroll
    for (int ds = 0; ds < NDS; ++ds) qf[ds] = *(const GAS bf16x8*)(Qw + (size_t)r32 * qpitch + 16 * ds + 8 * h);
    const bool kload = (tid * 16) < 64 * KROWB;
    const int krow = (tid * 16) / KROWB, kcb = (tid * 16) % KROWB;
    const int kdst = krow * KS + kcb, vdst = (tid >> 3) * ATT_VS + (tid & 7) * 16;
    const char* kg = (const char*)Kg + tid * 16; const char* vg = (const char*)Vg + tid * 16;
    u32x4 kreg = {0, 0, 0, 0}, vreg;
    {
        u32x4 k1 = {0, 0, 0, 0};
        if (kload) { kreg = *(const GAS u32x4*)(kg + (size_t)ATT_TI(0) * 64 * KROWB); k1 = *(const GAS u32x4*)(kg + (size_t)ATT_TI(1) * 64 * KROWB); }
        vreg = *(const GAS u32x4*)(vg + (size_t)ATT_TI(0) * 64 * 128);
        if (kload) { *(LAS u32x4*)(Kb + kdst) = kreg; *(LAS u32x4*)(Kb + KBUF + kdst) = k1; }
        *(LAS u32x4*)(Vb + vdst) = vreg;
        *(LAS u32x4*)(Vb + 2 * VBUF + vdst) = (u32x4){0, 0, 0, 0};
    }
    __syncthreads();
    const int kfo = r32 * KS + h * 16;
    const int vfo = (4 * h + ((lane & 15) >> 2)) * ATT_VS + (((lane >> 4) & 1) * 16 + (lane & 3) * 4) * 2;
    f32x16 p0 = (f32x16){}, p1 = (f32x16){};
#pragma unroll
    for (int ds = 0; ds < NDS; ++ds) {
        const bf16x8 k0 = *(LAS const bf16x8*)(Kb + kfo + ds * 32), k1 = *(LAS const bf16x8*)(Kb + kfo + 32 * KS + ds * 32);
        p0 = __builtin_amdgcn_mfma_f32_32x32x16_bf16(k0, qf[ds], p0, 0, 0, 0);
        p1 = __builtin_amdgcn_mfma_f32_32x32x16_bf16(k1, qf[ds], p1, 0, 0, 0);
    }
    __syncthreads();
    float mref, l = 0.f;
    {
        float a = MX3(p0[0], p0[1], p1[0]), b = MX3(p0[2], p0[3], p1[1]); a = MX3(a, p1[2], p1[3]);
#pragma unroll
        for (int r = 4; r < 16; r += 4) { a = MX3(a, p0[r], p0[r + 1]); b = MX3(b, p0[r + 2], p0[r + 3]); a = MX3(a, p1[r], p1[r + 1]); b = MX3(b, p1[r + 2], p1[r + 3]); }
        mref = xhalf_max(fmaxf(a, b));
#pragma unroll
        for (int r = 0; r < 16; ++r) { p0[r] -= mref; p1[r] -= mref; }
    }
    f32x16 negm;
#pragma unroll
    for (int r = 0; r < 16; ++r) negm[r] = -mref;
    asm volatile("" : "+v"(negm));
    o[0] = (f32x16){}; o[1] = (f32x16){};
    bf16x8 pk[4] = {};
    int vs_prev = 2 * VBUF, vs_cur = 0, vs_next = VBUF;
#define ATT_MPART(N0, N1, T) do { \
        LAS const char* kb_ = Kb + ((((T) + 1) & 1) * KBUF) + kfo; LAS const char* vb_ = Vb + vs_prev + vfo; \
        bf16x8 kf_[2 * NDS]; s16x4 vl_[8], vh_[8]; \
        _Pragma("unroll") for (int ds = 0; ds < NDS; ++ds) { kf_[2 * ds] = *(LAS const bf16x8*)(kb_ + ds * 32); kf_[2 * ds + 1] = *(LAS const bf16x8*)(kb_ + 32 * KS + ds * 32); } \
        _Pragma("unroll") for (int s_ = 0; s_ < 4; ++s_) { _Pragma("unroll") for (int db_ = 0; db_ < 2; ++db_) { \
            vl_[2 * s_ + db_] = vtr(vb_ + (16 * s_) * ATT_VS + db_ * 64); vh_[2 * s_ + db_] = vtr(vb_ + (16 * s_ + 8) * ATT_VS + db_ * 64); } } \
        N0 = __builtin_amdgcn_mfma_f32_32x32x16_bf16(kf_[0], qf[0], negm, 0, 0, 0); N1 = __builtin_amdgcn_mfma_f32_32x32x16_bf16(kf_[1], qf[0], negm, 0, 0, 0); \
        _Pragma("unroll") for (int ds = 1; ds < NDS; ++ds) { \
            N0 = __builtin_amdgcn_mfma_f32_32x32x16_bf16(kf_[2 * ds], qf[ds], N0, 0, 0, 0); N1 = __builtin_amdgcn_mfma_f32_32x32x16_bf16(kf_[2 * ds + 1], qf[ds], N1, 0, 0, 0); } \
        _Pragma("unroll") for (int s_ = 0; s_ < 4; ++s_) { _Pragma("unroll") for (int db_ = 0; db_ < 2; ++db_) { \
            const bf16x8 vf_ = __builtin_shufflevector(vl_[2 * s_ + db_], vh_[2 * s_ + db_], 0, 1, 2, 3, 4, 5, 6, 7); \
            o[db_] = __builtin_amdgcn_mfma_f32_32x32x16_bf16(vf_, pk[s_], o[db_], 0, 0, 0); } } \
        __builtin_amdgcn_sched_group_barrier(0x100, 2 * NDS + 8, 0); __builtin_amdgcn_sched_group_barrier(0x008, 2 * NDS, 0); \
        __builtin_amdgcn_sched_group_barrier(0x100, 8, 0); __builtin_amdgcn_sched_group_barrier(0x008, 8, 0); } while (0)
#define ATT_VPART(P0, P1, N0, N1) do { \
        float a = MX3(P0[0], P0[1], P1[0]), b = MX3(P0[2], P0[3], P1[1]); a = MX3(a, P1[2], P1[3]); \
        _Pragma("unroll") for (int r = 4; r < 16; r += 4) { a = MX3(a, P0[r], P0[r + 1]); b = MX3(b, P0[r + 2], P0[r + 3]); a = MX3(a, P1[r], P1[r + 1]); b = MX3(b, P1[r + 2], P1[r + 3]); } \
        const float mt = xhalf_max(fmaxf(a, b)); \
        resc = __any(mt > ATT_THR); \
        if (__builtin_expect(resc, 0)) { \
            const float dl = fmaxf(mt, 0.f); mref += dl; fsc = __builtin_amdgcn_exp2f(-dl); l *= fsc; \
            _Pragma("unroll") for (int r = 0; r < 16; ++r) { P0[r] -= dl; P1[r] -= dl; } \
            if (!YORD) { _Pragma("unroll") for (int r = 0; r < 16; ++r) { N0[r] -= dl; N1[r] -= dl; o[0][r] *= fsc; o[1][r] *= fsc; } } \
            _Pragma("unroll") for (int r = 0; r < 16; ++r) negm[r] = -mref; \
            asm volatile("" : "+v"(negm)); } \
        float ps0 = 0.f, ps1 = 0.f; \
        _Pragma("unroll") for (int r = 0; r < 16; ++r) { P0[r] = __builtin_amdgcn_exp2f(P0[r]); P1[r] = __builtin_amdgcn_exp2f(P1[r]); ps0 += P0[r]; ps1 += P1[r]; } \
        l += ps0 + ps1; \
        _Pragma("unroll") for (int s = 0; s < 2; ++s) { u32x4 a4, b4; \
            a4.x = cvtpk(P0[8 * s + 0], P0[8 * s + 1]); a4.y = cvtpk(P0[8 * s + 2], P0[8 * s + 3]); a4.z = cvtpk(P0[8 * s + 4], P0[8 * s + 5]); a4.w = cvtpk(P0[8 * s + 6], P0[8 * s + 7]); \
            b4.x = cvtpk(P1[8 * s + 0], P1[8 * s + 1]); b4.y = cvtpk(P1[8 * s + 2], P1[8 * s + 3]); b4.z = cvtpk(P1[8 * s + 4], P1[8 * s + 5]); b4.w = cvtpk(P1[8 * s + 6], P1[8 * s + 7]); \
            pkn[s] = __builtin_bit_cast(bf16x8, a4); pkn[2 + s] = __builtin_bit_cast(bf16x8, b4); } } while (0)
#define ATT_STEP(P0, P1, N0, N1, T) do { \
        const bool more = (T) + 1 < NT, more2 = (T) + 2 < NT; \
        if (more2 && kload) kreg = *(const GAS u32x4*)(kg + (size_t)ATT_TI((T) + 2) * 64 * KROWB); \
        if (more) vreg = *(const GAS u32x4*)(vg + (size_t)ATT_TI((T) + 1) * 64 * 128); \
        float fsc = 1.f; bool resc; bf16x8 pkn[4]; \
        if (!YORD) { ATT_MPART(N0, N1, T); __builtin_amdgcn_sched_barrier(0); ATT_VPART(P0, P1, N0, N1); } \
        else { ATT_VPART(P0, P1, N0, N1); __builtin_amdgcn_sched_barrier(0); ATT_MPART(N0, N1, T); \
            if (__builtin_expect(resc, 0)) { _Pragma("unroll") for (int r = 0; r < 16; ++r) { o[0][r] *= fsc; o[1][r] *= fsc; } } } \
        _Pragma("unroll") for (int s = 0; s < 4; ++s) pk[s] = pkn[s]; \
        if (more2 && kload) *(LAS u32x4*)(Kb + ((T) & 1) * KBUF + kdst) = kreg; \
        if (more) *(LAS u32x4*)(Vb + vs_next + vdst) = vreg; \
        __syncthreads(); \
        vs_prev = vs_cur; vs_cur = vs_next; vs_next = (vs_next == 2 * VBUF) ? 0 : vs_next + VBUF; } while (0)
    f32x16 n0, n1;
    for (int t = 0; t < NT; t += 2) {
        ATT_STEP(p0, p1, n0, n1, t);
        ATT_STEP(n0, n1, p0, p1, t + 1);
    }
    {
        LAS const char* vb_ = Vb + vs_prev + vfo;
#pragma unroll
        for (int s_ = 0; s_ < 4; ++s_) {
#pragma unroll
            for (int db_ = 0; db_ < 2; ++db_) {
                const s16x4 lo_ = vtr(vb_ + (16 * s_) * ATT_VS + db_ * 64), hi_ = vtr(vb_ + (16 * s_ + 8) * ATT_VS + db_ * 64);
                const bf16x8 vf_ = __builtin_shufflevector(lo_, hi_, 0, 1, 2, 3, 4, 5, 6, 7);
                o[db_] = __builtin_amdgcn_mfma_f32_32x32x16_bf16(vf_, pk[s_], o[db_], 0, 0, 0);
            }
        }
    }
    __syncthreads();
#undef ATT_STEP
#undef ATT_TI
#undef ATT_VPART
#undef ATT_MPART
    lsum = xhalf_sum(l);
}

__device__ __forceinline__ void store_ot(const f32x16 (&o)[2], bf16_t* dst  , int h) {
#pragma unroll
    for (int db = 0; db < 2; ++db)
#pragma unroll
        for (int g = 0; g < 4; ++g) { u32x2 w; w.x = cvtpk(o[db][4 * g], o[db][4 * g + 1]); w.y = cvtpk(o[db][4 * g + 2], o[db][4 * g + 3]); *(GAS u32x2*)(dst + 32 * db + 8 * g + 4 * h) = w; }
}

struct AttnArgs { const bf16_t *QG, *QD, *KG, *VG, *KD, *VD, *CB, *PB; bf16_t* MIX; const float* conv_w; const float* conv_b; const float* subln_g; float lam, lam_init; };

__device__ __forceinline__ void attn_gqa_unit(const AttnArgs& A, LAS char* lds, int lat, int seq, int qh, int qb) {
    const int tid_ = opaque_tid(); const int wave = __builtin_amdgcn_readfirstlane(tid_ >> 6), lane = tid_ & 63, r32 = lane & 31, h = lane >> 5;
    const long R = lat ? 8192L + (long)SLAT * seq : 256L * seq; const int S = lat ? SLAT : 256;
    const size_t grow0 = (lat ? 8192 + (size_t)4096 * seq : (size_t)256 * seq) + 256 * qb + 32 * wave;
    const int kvh = qh >> 2;
    f32x16 o[2]; float ls;
    int NT = S / 64; asm volatile("" : "+s"(NT)); const int tst = (int)((((blockIdx.x >> 3) & 31) * NT) >> 5);
    if (wave < 4) flash_pass<64, false>(A.QG + grow0 * 512 + 64 * qh, 512, A.KG + (R * 2 + (long)kvh * S) * 64, A.VG + (R * 2 + (long)kvh * S) * 64, NT, tst, lds, o, ls);
    else flash_pass<64, true>(A.QG + grow0 * 512 + 64 * qh, 512, A.KG + (R * 2 + (long)kvh * S) * 64, A.VG + (R * 2 + (long)kvh * S) * 64, NT, tst, lds, o, ls);
    const float inv = 1.f / ls;
#pragma unroll
    for (int r = 0; r < 16; ++r) { o[0][r] *= inv; o[1][r] *= inv; }
    store_ot(o, A.MIX + (grow0 + r32) * 1024 + 64 * qh, h);
}
__device__ __forceinline__ void attn_diff_unit(const AttnArgs& A, LAS char* lds, int lat, int seq, int hd, int qb) {
    const int tid_ = opaque_tid(); const int wave = __builtin_amdgcn_readfirstlane(tid_ >> 6), lane = tid_ & 63, r32 = lane & 31, h = lane >> 5;
    const long R = lat ? 8192L + (long)SLAT * seq : 256L * seq; const int S = lat ? SLAT : 256;
    const size_t grow0 = (lat ? 8192 + (size_t)4096 * seq : (size_t)256 * seq) + 256 * qb + 32 * wave;
    f32x16 o0[2], o1[2]; float l0, l1;
    const bf16_t* V = A.VD + (R * 4 + (long)hd * S) * 64;
    int NT = S / 64; asm volatile("" : "+s"(NT)); const int tst = (int)((((blockIdx.x >> 3) & 31) * NT) >> 5);
    if (wave < 4) { flash_pass<32, false>(A.QD + grow0 * 256 + 64 * hd, 256, A.KD + (R * 8 + (long)(hd * 2) * S) * 32, V, NT, tst, lds, o0, l0);
        flash_pass<32, false>(A.QD + grow0 * 256 + 64 * hd + 32, 256, A.KD + (R * 8 + (long)(hd * 2 + 1) * S) * 32, V, NT, tst, lds, o1, l1); }
    else { flash_pass<32, true>(A.QD + grow0 * 256 + 64 * hd, 256, A.KD + (R * 8 + (long)(hd * 2) * S) * 32, V, NT, tst, lds, o0, l0);
        flash_pass<32, true>(A.QD + grow0 * 256 + 64 * hd + 32, 256, A.KD + (R * 8 + (long)(hd * 2 + 1) * S) * 32, V, NT, tst, lds, o1, l1); }
    const float i0 = 1.f / l0, i1 = A.lam / l1;
    float ss = 0.f;
#pragma unroll
    for (int db = 0; db < 2; ++db)
#pragma unroll
        for (int r = 0; r < 16; ++r) { const float v = o0[db][r] * i0 - o1[db][r] * i1; o0[db][r] = v; ss += v * v; }
    ss = xhalf_sum(ss);
    const float rstd = rsqrtf(ss * (1.f / 64.f) + EPS) * (1.f - A.lam_init);
#pragma unroll
    for (int db = 0; db < 2; ++db)
#pragma unroll
        for (int g = 0; g < 4; ++g) { const f32x4 g4 = *(const GAS f32x4*)(A.subln_g + 32 * db + 8 * g + 4 * h);
#pragma unroll
            for (int e = 0; e < 4; ++e) o0[db][4 * g + e] *= rstd * g4[e]; }
    store_ot(o0, A.MIX + (grow0 + r32) * 1024 + 768 + 64 * hd, h);
}

__device__ __forceinline__ void attn_phase(const AttnArgs& A, LAS char* lds, int G) {
    for (int u = blockIdx.x; u < 1920; u += G) {
        if (u < 512) { const int b = u & 7, r = u >> 3; attn_diff_unit(A, lds, 1, b, r >> 4, r & 15); }
        else if (u < 1536) { const int v = u - 512, b = v & 7, r = v >> 3; attn_gqa_unit(A, lds, 1, b, r & 7, r >> 3); }
        else if (u < 1664) { const int w = u - 1536; attn_diff_unit(A, lds, 0, w >> 2, w & 3, 0); }
        else { const int w = u - 1664; attn_gqa_unit(A, lds, 0, w >> 3, w & 7, 0); }
    }
    const int tid_c = opaque_tid();
    for (int idx = blockIdx.x * 512 + tid_c; idx < M_ALL * 32; idx += G * 512) {
        const int row = idx >> 5, c8 = (idx & 31) * 8;
        int t, S; if (row < M_CTX) { t = row & 255; S = 256; } else { t = (row - M_CTX) & 4095; S = 4096; }
        const u32x4 z = {0, 0, 0, 0};
        const u32x4 pc = *(const GAS u32x4*)(A.PB + (size_t)row * 256 + c8);
        const u32x4 pp = t > 0 ? *(const GAS u32x4*)(A.PB + (size_t)(row - 1) * 256 + c8) : z;
        const u32x4 pn = t < S - 1 ? *(const GAS u32x4*)(A.PB + (size_t)(row + 1) * 256 + c8) : z;
        const u32x4 cb = *(const GAS u32x4*)(A.CB + (size_t)row * 256 + c8);
        float res[8];
#pragma unroll
        for (int j = 0; j < 8; ++j) {
            const int sh = (j & 1) * 16;
            const float a = __uint_as_float(((pp[j >> 1] >> sh) & 0xffffu) << 16), b = __uint_as_float(((pc[j >> 1] >> sh) & 0xffffu) << 16), c = __uint_as_float(((pn[j >> 1] >> sh) & 0xffffu) << 16);
            const float g = __uint_as_float(((cb[j >> 1] >> sh) & 0xffffu) << 16);
            const int cc = c8 + j;
            res[j] = g * (A.conv_w[cc] * a + A.conv_w[256 + cc] * b + A.conv_w[512 + cc] * c + A.conv_b[cc]);
        }
        u32x4 w; w.x = cvtpk(res[0], res[1]); w.y = cvtpk(res[2], res[3]); w.z = cvtpk(res[4], res[5]); w.w = cvtpk(res[6], res[7]);
        *(GAS u32x4*)(A.MIX + (size_t)row * 1024 + 512 + c8) = w;
    }
}

__device__ __forceinline__ int sigma_map(int type, int i) {
    if (type == 1) return 8 * ((i >> 2) & 3) + 4 * (i >> 4) + (i & 3);
    if (type == 2) return 16 * ((i >> 3) & 1) + 8 * (i >> 4) + (i & 7);
    return i;
}
__device__ __forceinline__ void in_group(int g, int& Lbase, int& type) {
    const int pn = g >> 3, bj = (g >> 2) & 1, wc = g & 3;
    if (pn < 2) { Lbase = 64 * (4 * pn + wc) + 32 * bj; type = 0; }
    else if (pn == 2) { Lbase = (wc < 2 ? 512 + 64 * wc : 640 + 64 * (wc - 2)) + 32 * bj; type = 0; }
    else if (pn == 3) { Lbase = 768 + 128 * bj + 32 * wc; type = 1; }
    else if (pn < 6) { Lbase = 1024 + 256 * bj + 128 * (pn - 4) + 32 * wc; type = 1; }
    else if (pn < 8) { Lbase = (pn == 6 ? 1536 : 1792) + 64 * wc + 32 * bj; type = 2; }
    else { Lbase = 2048 + 64 * wc + 32 * bj; type = 1; }
}
__device__ __forceinline__ void transpose_item(const float* W, int K, int N, bf16_t* WT, int k0, int nphys0, int Lbase, int type, LAS float* scr, int lane) {
#pragma unroll 8
    for (int i = 0; i < 32; ++i) { const int kk = 2 * i + (lane >> 5); scr[kk * 33 + (lane & 31)] = ((const GAS float*)W)[(size_t)(k0 + kk) * N + Lbase + (lane & 31)]; }
    asm volatile("s_waitcnt lgkmcnt(0)" ::: "memory");
    const int c = lane & 7;
#pragma unroll
    for (int j = 0; j < 4; ++j) { const int n = (lane >> 3) + 8 * j; const LAS float* s = scr + (8 * c) * 33 + sigma_map(type, n);
        u32x4 o; o.x = cvtpk(s[0 * 33], s[1 * 33]); o.y = cvtpk(s[2 * 33], s[3 * 33]); o.z = cvtpk(s[4 * 33], s[5 * 33]); o.w = cvtpk(s[6 * 33], s[7 * 33]);
        *(GAS u32x4*)(WT + (size_t)(nphys0 + n) * K + k0 + 8 * c) = o; }
    asm volatile("s_waitcnt lgkmcnt(0)" ::: "memory");
}

struct Params {
    const float *x_prompt, *x_sample, *cache_gk, *cache_gv, *cache_dk, *cache_dv, *c, *c_ctx;
    const float *w_mod, *b_mod, *norm1_g, *w_in, *gqa_qn_g, *gqa_kn_g, *conv_w, *conv_b, *diff_qn_g, *diff_kn_g, *diff_lambda, *diff_subln_g, *w_out, *norm2_g, *ffn_up, *ffn_conv_w, *ffn_conv_b, *ffn_down;
    float* out; unsigned char* ws;
    float lam_init[4];
    int ph_lo, ph_hi;
};

__device__ __forceinline__ void prologue(const Params& P, LAS unsigned char* lds, int G) {
    const int tid = opaque_tid(), lane = tid & 63, wave = __builtin_amdgcn_readfirstlane(tid >> 6);
    float* MODS = (float*)(P.ws + WS_MODS); float* MISC = (float*)(P.ws + WS_MISC);
    if ((int)blockIdx.x < 384) {
        LAS float* sc = (LAS float*)lds;
        LAS float* part = (LAS float*)(lds + 49152);
        for (int i = tid; i < NCOND * 1024; i += 512) { const int ci = i >> 10, k = i & 1023; const float v = ci == 0 ? P.c_ctx[k] : P.c[(ci - 1) * 1024 + k]; sc[k * 12 + ci] = v / (1.f + __expf(-v)); }
        __syncthreads();
        for (int it = blockIdx.x; it < 384; it += G) {
            const int l = it / 96, col = (it % 96) * 64 + lane;
            const float* w = P.w_mod + (size_t)l * 1024 * 6144 + col;
            float acc[NCOND];
#pragma unroll
            for (int ci = 0; ci < NCOND; ++ci) acc[ci] = 0.f;
#pragma unroll 8
            for (int kk = 0; kk < 128; ++kk) { const int k = wave * 128 + kk; const float wv = ((const GAS float*)w)[(size_t)k * 6144];
                const f32x4 s0 = *(LAS f32x4*)(sc + k * 12), s1 = *(LAS f32x4*)(sc + k * 12 + 4); const float s8 = sc[k * 12 + 8];
                acc[0] += s0[0] * wv; acc[1] += s0[1] * wv; acc[2] += s0[2] * wv; acc[3] += s0[3] * wv; acc[4] += s1[0] * wv; acc[5] += s1[1] * wv; acc[6] += s1[2] * wv; acc[7] += s1[3] * wv; acc[8] += s8 * wv; }
#pragma unroll
            for (int ci = 0; ci < NCOND; ++ci) part[(wave * NCOND + ci) * 64 + lane] = acc[ci];
            __syncthreads();
            for (int i = tid; i < NCOND * 64; i += 512) { const int ci = i >> 6, cc = i & 63; float s = 0.f;
#pragma unroll
                for (int w8 = 0; w8 < 8; ++w8) s += part[(w8 * NCOND + ci) * 64 + cc];
                const int j = (it % 96) * 64 + cc; MODS[((size_t)l * NCOND + ci) * 6144 + j] = s + P.b_mod[l * 6144 + j]; }
            __syncthreads();
        }
    }
    if ((int)blockIdx.x == G - 1) {
        if (tid < 4) { const float* lf = P.diff_lambda + tid * 128; float s1 = 0.f, s2 = 0.f; for (int i = 0; i < 32; ++i) { s1 += lf[i] * lf[32 + i]; s2 += lf[64 + i] * lf[96 + i]; }
            MISC[MI_LAM + tid] = expf(s1) - expf(s2) + P.lam_init[tid]; }
        for (int i = tid; i < 1024; i += 512) { const int pos = i >> 4, idx = i & 15; const float fr = powf(10000.f, -(float)idx / 16.f); const float ang = (float)pos * fr; MISC[MI_R64C + i] = cosf(ang); MISC[MI_R64S + i] = sinf(ang); }
        for (int i = tid; i < 512; i += 512) { const int pos = i >> 3, idx = i & 7; const float fr = powf(10000.f, -(float)idx / 8.f); const float ang = (float)pos * fr; MISC[MI_R32C + i] = cosf(ang); MISC[MI_R32S + i] = sinf(ang); }
    }
    __syncthreads();
    LAS float* scr = (LAS float*)(lds + wave * 16384);
    const int gw = blockIdx.x * 8 + wave, NGW = G * 8;
    constexpr int I_IN = 16 * 72, I_OUT = 16 * 32, I_UP = 16 * 176, I_DN = 44 * 32, I_L = I_IN + I_OUT + I_UP + I_DN;
    for (int it = gw; it < DEPTH * I_L; it += NGW) {
        const int l = it / I_L; int r = it % I_L;
        if (r < I_IN) { const int kb = r / 72, g = r % 72; int Lb, ty; in_group(g, Lb, ty);
            transpose_item(P.w_in + (size_t)l * 1024 * INW, 1024, INW, (bf16_t*)(P.ws + WS_WIN) + (size_t)l * INW * 1024, kb * 64, g * 32, Lb, ty, scr, lane); continue; }
        r -= I_IN;
        if (r < I_OUT) { const int kb = r / 32, g = r % 32;
            transpose_item(P.w_out + (size_t)l * 1024 * 1024, 1024, 1024, (bf16_t*)(P.ws + WS_WOUT) + (size_t)l * 1024 * 1024, kb * 64, g * 32, g * 32, 0, scr, lane); continue; }
        r -= I_OUT;
        if (r < I_UP) { const int kb = r / 176, g = r % 176; const int pn = g >> 3, bj = (g >> 2) & 1, wc = g & 3;
            transpose_item(P.ffn_up + (size_t)l * 1024 * UPW, 1024, UPW, (bf16_t*)(P.ws + WS_WUP) + (size_t)l * UPW * 1024, kb * 64, g * 32, bj * DFF + 128 * pn + 32 * wc, 1, scr, lane); continue; }
        r -= I_UP;
        { const int kb = r / 32, g = r % 32;
            transpose_item(P.ffn_down + (size_t)l * DFF * 1024, DFF, 1024, (bf16_t*)(P.ws + WS_WDN) + (size_t)l * 1024 * DFF, kb * 64, g * 32, g * 32, 0, scr, lane); }
    }
}

__device__ __forceinline__ void norm_phase(const float* xin_ctx, const float* xin_lat, const float* ng, const float* mods_l  , int sh_idx, bf16_t* XN, int G) {
    const int tid_ = opaque_tid(); const int lane = tid_ & 63, wave = __builtin_amdgcn_readfirstlane(tid_ >> 6);
    const int nw = G * 8, gw = blockIdx.x * 8 + wave;
    const int per = (M_ALL + nw - 1) / nw;
    const int r0 = gw * per, r1 = min(r0 + per, M_ALL);
    int cur_ci = -1; f32x4 Aa[4], Bb[4];
    for (int row = r0; row < r1; ++row) {
        const int ci = row < M_CTX ? 0 : 1 + ((row - M_CTX) >> 12);
        if (ci != cur_ci) { cur_ci = ci; const float* sh = mods_l + ci * 6144 + sh_idx * 1024; const float* sc = sh + 1024;
#pragma unroll
            for (int j = 0; j < 4; ++j) { const int c = 4 * lane + 256 * j; const f32x4 g4 = *(const GAS f32x4*)(ng + c), s4 = *(const GAS f32x4*)(sc + c); Aa[j] = g4 * (1.f + s4); Bb[j] = *(const GAS f32x4*)(sh + c); } }
        const float* xr = row < M_CTX ? xin_ctx + (size_t)row * DM : xin_lat + (size_t)(row - M_CTX) * DM;
        f32x4 v[4]; float s = 0.f;
#pragma unroll
        for (int j = 0; j < 4; ++j) { v[j] = *(const GAS f32x4*)(xr + 4 * lane + 256 * j); s += (v[j][0] * v[j][0] + v[j][1] * v[j][1]) + (v[j][2] * v[j][2] + v[j][3] * v[j][3]); }
#pragma unroll
        for (int o = 1; o < 64; o <<= 1) s += __shfl_xor(s, o);
        const float rstd = rsqrtf(s * (1.f / DM) + EPS);
#pragma unroll
        for (int j = 0; j < 4; ++j) { const f32x4 y = v[j] * rstd * Aa[j] + Bb[j]; u32x2 w; w.x = cvtpk(y[0], y[1]); w.y = cvtpk(y[2], y[3]); *(GAS u32x2*)(XN + (size_t)row * DM + 4 * lane + 256 * j) = w; }
    }
}

__device__ __forceinline__ void cache_phase(const Params& P, int l, int G) {
    bf16_t* KG = (bf16_t*)(P.ws + WS_KG); bf16_t* VG = (bf16_t*)(P.ws + WS_VG); bf16_t* KD = (bf16_t*)(P.ws + WS_KD); bf16_t* VD = (bf16_t*)(P.ws + WS_VD);
    const int tid_ = opaque_tid();
    for (int i = blockIdx.x * 512 + tid_; i < 65536; i += G * 512) {
        const int d4 = (i & 15) * 4, kvh = (i >> 4) & 1, p = (i >> 5) & 255, b = i >> 13;
        const size_t src = ((((size_t)b * 4 + l) * 256 + p) * 2 + kvh) * 64 + d4;
        const size_t dst = (((8192L + (long)SLAT * b) * 2 + (long)kvh * SLAT + 4096 + p) * 64) + d4;
        const f32x4 k = *(const GAS f32x4*)(P.cache_gk + src), v = *(const GAS f32x4*)(P.cache_gv + src);
        u32x2 wk, wv; wk.x = cvtpk(k[0], k[1]); wk.y = cvtpk(k[2], k[3]); wv.x = cvtpk(v[0], v[1]); wv.y = cvtpk(v[2], v[3]);
        *(GAS u32x2*)(KG + dst) = wk; *(GAS u32x2*)(VG + dst) = wv;
    }
    for (int i = blockIdx.x * 512 + tid_; i < 131072; i += G * 512) {
        { const int d4 = (i & 7) * 4, hc = (i >> 3) & 7, p = (i >> 6) & 255, b = i >> 14;
          const size_t src = ((((size_t)b * 4 + l) * 256 + p) * 8 + hc) * 32 + d4;
          const size_t dst = (((8192L + (long)SLAT * b) * 8 + (long)hc * SLAT + 4096 + p) * 32) + d4;
          const f32x4 k = *(const GAS f32x4*)(P.cache_dk + src); u32x2 w; w.x = cvtpk(k[0], k[1]); w.y = cvtpk(k[2], k[3]); *(GAS u32x2*)(KD + dst) = w; }
        { const int d4 = (i & 15) * 4, hh = (i >> 4) & 3, p = (i >> 6) & 255, b = i >> 14;
          const size_t src = ((((size_t)b * 4 + l) * 256 + p) * 4 + hh) * 64 + d4;
          const size_t dst = (((8192L + (long)SLAT * b) * 4 + (long)hh * SLAT + 4096 + p) * 64) + d4;
          const f32x4 v = *(const GAS f32x4*)(P.cache_dv + src); u32x2 w; w.x = cvtpk(v[0], v[1]); w.y = cvtpk(v[2], v[3]); *(GAS u32x2*)(VD + dst) = w; }
    }
}

__device__ __forceinline__ void fixup_phase(const float* cw, bf16_t* F, const float* EP, const float* EA, const float* EU, int G) {
    const int tid_ = opaque_tid();
    for (int i = blockIdx.x * 512 + tid_; i < 128 * 2 * DFF; i += G * 512) {
        const int c = i % DFF, e = (i / DFF) & 1, pm = 32 + i / (2 * DFF); const int j = (pm - 32) & 15;
        if (e == 0 ? j == 0 : j == 15) continue;
        const size_t eo = ((size_t)pm * 2 + e) * DFF + c;
        float conv;
        if (e == 0) conv = EP[eo] + cw[c] * EA[((size_t)(pm - 1) * 2 + 1) * DFF + c];
        else conv = EP[eo] + cw[2 * DFF + c] * EA[((size_t)(pm + 1) * 2 + 0) * DFF + c];
        const float f = silu_f(conv) * EU[eo];
        const size_t row = (size_t)pm * 256 + (e ? 255 : 0);
        F[row * DFF + c] = (bf16_t)(cvtpk(f, 0.f) & 0xffffu);
    }
}


#define XB_TMO      128
#define XB_XCNT(j)  (256  + 64 * (j))
#define XB_XSUB(j)  (1280 + 64 * (j))
#define XB_XGEN(j)  (2304 + 64 * (j))
#define XB_TOP      3328
#define XB_TOPGEN   3392
#define XCD_BAR_WORDS 3456
#define XB_SPIN_CAP (1u << 22)
__device__ __forceinline__ unsigned xb_ld(unsigned* p)              { return __hip_atomic_load(p, __ATOMIC_RELAXED, __HIP_MEMORY_SCOPE_AGENT); }
__device__ __forceinline__ unsigned xb_add(unsigned* p, unsigned v) { return __hip_atomic_fetch_add(p, v, __ATOMIC_RELAXED, __HIP_MEMORY_SCOPE_AGENT); }
__device__ __forceinline__ unsigned xb_xcc_id() { return (unsigned)__builtin_amdgcn_s_getreg((3 << 11) | 20) & 0xFu; }
#define XB_SPIN(cond, bar) do { unsigned _sp = 0; while (cond) { __builtin_amdgcn_s_sleep(1); \
    if ((++_sp & 255u) == 0u) { if (xb_ld(&(bar)[XB_TMO])) break; if (_sp > XB_SPIN_CAP) { atomicAdd(&(bar)[XB_TMO], 1u); break; } } } } while (0)
struct XcdBarrier { unsigned* bar; unsigned x; volatile LAS unsigned* st; };
__device__ __forceinline__ XcdBarrier xcd_barrier_post(unsigned* bar, volatile LAS unsigned* st) {
    XcdBarrier b; b.bar = bar; b.x = xb_xcc_id(); b.st = st;
    if (threadIdx.x == 0) (void)xb_add(&bar[XB_XCNT(b.x)], 1u);
    return b;
}
__device__ __forceinline__ void xcd_barrier_complete(unsigned* bar, unsigned x, unsigned& nloc, unsigned& nx) {
    const unsigned G = gridDim.x * gridDim.y * gridDim.z;
    unsigned sum, cnt, mine, sp = 0u;
    for (;;) {
        sum = 0u; cnt = 0u; mine = 0u;
#pragma unroll
        for (unsigned j = 0; j < 16; ++j) { const unsigned c = xb_ld(&bar[XB_XCNT(j)]); sum += c; cnt += (c > 0u) ? 1u : 0u; mine = (j == x) ? c : mine; }
        if (sum == G) break;
        __builtin_amdgcn_s_sleep(1);
        if ((++sp & 255u) == 0u) { if (xb_ld(&bar[XB_TMO])) break; if (sp > XB_SPIN_CAP) { atomicAdd(&bar[XB_TMO], 1u); break; } }
    }
    nloc = mine > 0u ? mine : 1u; nx = cnt > 0u ? cnt : 1u;
}
__device__ __forceinline__ void xcd_barrier(const XcdBarrier& b) {
    asm volatile("s_waitcnt vmcnt(0)" ::: "memory");
    __syncthreads();
    if (threadIdx.x == 0) {
        unsigned* bar = b.bar;
        __builtin_amdgcn_s_waitcnt(0);
        unsigned nloc = b.st[0], nx = b.st[1];
        if (nloc == 0u) { xcd_barrier_complete(bar, b.x, nloc, nx); b.st[0] = nloc; b.st[1] = nx; }
        const unsigned old = xb_add(&bar[XB_XSUB(b.x)], 1u);
        const unsigned gen = old / nloc;
        if (old + 1u == (gen + 1u) * nloc) {
            __builtin_amdgcn_fence(__ATOMIC_RELEASE, "agent");
            asm volatile("s_waitcnt vmcnt(0)" ::: "memory");
            const unsigned og = xb_add(&bar[XB_TOP], 1u);
            const unsigned tg = og / nx;
            if (og + 1u == (tg + 1u) * nx) xb_add(&bar[XB_TOPGEN], 1u);
            else XB_SPIN(xb_ld(&bar[XB_TOPGEN]) == tg, bar);
            __builtin_amdgcn_fence(__ATOMIC_ACQUIRE, "agent");
            xb_add(&bar[XB_XGEN(b.x)], 1u);
            asm volatile("s_waitcnt vmcnt(0)" ::: "memory");
        } else {
            XB_SPIN(xb_ld(&bar[XB_XGEN(b.x)]) == gen, bar);
            __builtin_amdgcn_fence(__ATOMIC_ACQUIRE, "agent");
            asm volatile("s_waitcnt vmcnt(0)" ::: "memory");
        }
    }
    __syncthreads();
}

__global__ void __launch_bounds__(512, 2) fwd_kernel(Params P) {
    extern __shared__ __attribute__((aligned(16))) unsigned char lds_raw[];
    LAS unsigned char* lds = (LAS unsigned char*)lds_raw;
    cg::grid_group grid = cg::this_grid();
    const int G = gridDim.x;
    volatile LAS unsigned* bst = (volatile LAS unsigned*)(lds + MISC_OFF);
    if (threadIdx.x < 2) bst[threadIdx.x] = 0u;
    __syncthreads();
    XcdBarrier bar = xcd_barrier_post((unsigned*)(P.ws + WS_CTL), bst);
    int ph = 0;
#define PHASE_BEGIN if (ph >= P.ph_lo && ph < P.ph_hi) { unsigned char* ws = P.ws; float* outp = P.out; asm volatile("" : "+s"(ws), "+s"(outp));
#define PHASE_END   if (ph + 1 < P.ph_hi) { if (ph == 0) grid.sync(); else xcd_barrier(bar); } } ++ph;
    PHASE_BEGIN
#ifndef SKIP_PRO
        prologue(P, lds, G);
#endif
    PHASE_END
    for (int l = 0; l < DEPTH; ++l) {
        PHASE_BEGIN
            const float* xin_ctx = l == 0 ? P.x_prompt : outp; const float* xin_lat = l == 0 ? P.x_sample : outp + (size_t)M_CTX * DM;
            norm_phase(xin_ctx, xin_lat, P.norm1_g + l * DM, (const float*)(ws + WS_MODS) + (size_t)l * NCOND * 6144, 0, (bf16_t*)(ws + WS_XN), G);
            cache_phase(P, l, G);
        PHASE_END
        PHASE_BEGIN {
            const float* MISC = (const float*)(ws + WS_MISC);
            pg8::Gemm g{(const bf16_t*)(ws + WS_XN), (const bf16_t*)(ws + WS_WIN) + (size_t)l * INW * 1024, M_ALL, INW, 1024}; pg8::StaticOrder S; S.init(M_ALL, INW, G, blockIdx.x);
            EpiIn E{l, P.gqa_qn_g + l * 64, P.gqa_kn_g + l * 64, P.diff_qn_g + l * 32, P.diff_kn_g + l * 32, MISC + MI_R64C, MISC + MI_R64S, MISC + MI_R32C, MISC + MI_R32S,
                    (bf16_t*)(ws + WS_QG), (bf16_t*)(ws + WS_QD), (bf16_t*)(ws + WS_KG), (bf16_t*)(ws + WS_VG), (bf16_t*)(ws + WS_KD), (bf16_t*)(ws + WS_VD), (bf16_t*)(ws + WS_CB), (bf16_t*)(ws + WS_PB), outp};
#ifndef SKIP_IN
            pg8::gemm_phase(lds, lds + XCH_OFF, g, S, E);
#endif
        } PHASE_END
        PHASE_BEGIN {
            const float* MISC = (const float*)(ws + WS_MISC);
            AttnArgs A{(const bf16_t*)(ws + WS_QG), (const bf16_t*)(ws + WS_QD), (const bf16_t*)(ws + WS_KG), (const bf16_t*)(ws + WS_VG), (const bf16_t*)(ws + WS_KD), (const bf16_t*)(ws + WS_VD),
                       (const bf16_t*)(ws + WS_CB), (const bf16_t*)(ws + WS_PB), (bf16_t*)(ws + WS_XN), P.conv_w + l * 768, P.conv_b + l * 256, P.diff_subln_g + l * 64, MISC[MI_LAM + l], P.lam_init[l]};
#ifndef SKIP_ATT
            attn_phase(A, (LAS char*)lds, G);
#endif
        } PHASE_END
        PHASE_BEGIN {
            const float* xin_ctx = l == 0 ? P.x_prompt : outp; const float* xin_lat = l == 0 ? P.x_sample : outp + (size_t)M_CTX * DM;
            pg8::Gemm g{(const bf16_t*)(ws + WS_XN), (const bf16_t*)(ws + WS_WOUT) + (size_t)l * 1024 * 1024, M_ALL, 1024, 1024}; pg8::StaticOrder S; S.init(M_ALL, 1024, G, blockIdx.x);
            EpiRes E{xin_ctx, xin_lat, outp, (const float*)(ws + WS_MODS) + (size_t)l * NCOND * 6144 + 2 * 1024};
#ifndef SKIP_RES
            pg8::gemm_phase(lds, lds + XCH_OFF, g, S, E);
#endif
        } PHASE_END
        PHASE_BEGIN
            norm_phase(outp, outp + (size_t)M_CTX * DM, P.norm2_g + l * DM, (const float*)(ws + WS_MODS) + (size_t)l * NCOND * 6144, 3, (bf16_t*)(ws + WS_XN), G);
        PHASE_END
        PHASE_BEGIN {
            float* EPb = (float*)(ws + WS_EDGE);
            pg8::Gemm g{(const bf16_t*)(ws + WS_XN), (const bf16_t*)(ws + WS_WUP) + (size_t)l * UPW * 1024, M_ALL, UPW, 1024}; pg8::StaticOrder S; S.init(M_ALL, UPW, G, blockIdx.x);
            EpiUp E{P.ffn_conv_w + (size_t)l * 3 * DFF, P.ffn_conv_b + (size_t)l * DFF, (bf16_t*)(ws + WS_U), EPb, EPb + EDGE_ELEMS, EPb + 2 * EDGE_ELEMS};
#ifndef SKIP_UP
            pg8::gemm_phase(lds, lds + XCH_OFF, g, S, E);
#endif
        } PHASE_END
        PHASE_BEGIN {
            float* EPb = (float*)(ws + WS_EDGE);
            fixup_phase(P.ffn_conv_w + (size_t)l * 3 * DFF, (bf16_t*)(ws + WS_U), EPb, EPb + EDGE_ELEMS, EPb + 2 * EDGE_ELEMS, G);
        } PHASE_END
        PHASE_BEGIN {
            pg8::Gemm g{(const bf16_t*)(ws + WS_U), (const bf16_t*)(ws + WS_WDN) + (size_t)l * 1024 * DFF, M_ALL, 1024, DFF}; pg8::StaticOrder S; S.init(M_ALL, 1024, G, blockIdx.x);
            EpiRes E{outp, outp + (size_t)M_CTX * DM, outp, (const float*)(ws + WS_MODS) + (size_t)l * NCOND * 6144 + 5 * 1024};
#ifndef SKIP_RES
            pg8::gemm_phase(lds, lds + XCH_OFF, g, S, E);
#endif
        } PHASE_END
    }
}

constexpr int N_PHASES = 1 + DEPTH * 8;
#ifndef N_LAUNCH_SPLIT
#define N_LAUNCH_SPLIT 0
#endif

extern "C" void kernel_launch(void* const* d_in, const int* in_sizes, int n_in, void* d_out, int out_size, void* d_ws, size_t ws_size, hipStream_t stream) {
    static int grid = 0;
    if (grid == 0) {
        if (n_in != 26 || ws_size < WS_END) { fprintf(stderr, "kernel_launch: unexpected n_in %d or ws_size %zu (< %zu)\n", n_in, ws_size, (size_t)WS_END); grid = -1; return; }
        int dev = 0, cus = 0, per_cu = 0;
        hipGetDevice(&dev); hipDeviceGetAttribute(&cus, hipDeviceAttributeMultiprocessorCount, dev);
        hipFuncSetAttribute((const void*)fwd_kernel, hipFuncAttributeMaxDynamicSharedMemorySize, LDS_BYTES);
        hipOccupancyMaxActiveBlocksPerMultiprocessor(&per_cu, (const void*)fwd_kernel, 512, LDS_BYTES);
        if (per_cu < 1) { fprintf(stderr, "kernel_launch: occupancy query gives %d\n", per_cu); per_cu = 1; }
        (void)hipGetLastError();
        grid = cus * 1;
    }
    if (grid < 0) return;
    Params p{};
    const float** pp = (const float**)&p;
    for (int i = 0; i < 26; ++i) pp[i] = (const float*)d_in[i];
    p.out = (float*)d_out; p.ws = (unsigned char*)d_ws;
    for (int l = 0; l < 4; ++l) p.lam_init[l] = (float)(0.8 - 0.6 * exp(-0.3 * (double)l));
#if N_LAUNCH_SPLIT
    for (int ph = 0; ph < N_PHASES; ++ph) { p.ph_lo = ph; p.ph_hi = ph + 1; hipLaunchKernelGGL(fwd_kernel, dim3(grid), dim3(512), LDS_BYTES, stream, p); }
#else
    p.ph_lo = 0; p.ph_hi = N_PHASES;
    if (hipMemsetAsync((char*)d_ws + WS_CTL, 0, CTL_ZERO_BYTES, stream) != hipSuccess) { fprintf(stderr, "kernel_launch: memset failed\n"); return; }
    void* args[] = {&p};
    hipError_t e = hipLaunchCooperativeKernel((const void*)fwd_kernel, dim3(grid), dim3(512), args, LDS_BYTES, stream);
    if (e != hipSuccess) fprintf(stderr, "cooperative launch failed: %s (grid %d)\n", hipGetErrorString(e), grid);
#endif
}
```

```cpp
#include <hip/hip_runtime.h>
#include <hip/hip_cooperative_groups.h>
#include <cstdio>
#include <cstdint>
#include <cmath>
namespace cg = cooperative_groups;

#define LAS __attribute__((address_space(3)))
#define GAS __attribute__((address_space(1)))
typedef unsigned short bf16_t;
typedef short bf16x8 __attribute__((ext_vector_type(8)));
typedef short s16x4 __attribute__((ext_vector_type(4)));
typedef float f32x4 __attribute__((ext_vector_type(4)));
typedef float f32x16 __attribute__((ext_vector_type(16)));
typedef unsigned u32x4 __attribute__((ext_vector_type(4)));
typedef unsigned u32x2 __attribute__((ext_vector_type(2)));
typedef float f32x2 __attribute__((ext_vector_type(2)));
typedef __bf16 bf16x2_t __attribute__((ext_vector_type(2)));

__device__ __forceinline__ unsigned cvtpk(float lo, float hi) { f32x2 v = {lo, hi}; bf16x2_t b = __builtin_convertvector(v, bf16x2_t); return __builtin_bit_cast(unsigned, b); }
__device__ __forceinline__ int opaque_tid() { int t = threadIdx.x; asm volatile("" : "+v"(t)); return t; }
__device__ __forceinline__ float bf2f(unsigned short u) { return __uint_as_float(((unsigned)u) << 16); }

constexpr int DM = 1024, DEPTH = 4, NCOND = 9;
constexpr int M_CTX = 8192, M_ALL = 40960, NTM = 160;
constexpr int INW = 2304, DFF = 2816, UPW = 5632;
constexpr int SLAT = 4352;
constexpr float EPS = 1e-6f;
constexpr float LOG2E = 1.4426950408889634f;
constexpr float QSCALE_G = 0.125f * LOG2E;
constexpr float QSCALE_D = 0.17677669529663687f * LOG2E;
constexpr size_t OUT_GK = 41943040, OUT_GV = OUT_GK + 4194304, OUT_DK = OUT_GV + 4194304, OUT_DV = OUT_DK + 8388608;
constexpr size_t MiB = 1u << 20;
constexpr size_t WS_MODS = 1 * MiB;
constexpr size_t WS_MISC = 2 * MiB;
constexpr size_t WS_EDGE = 3 * MiB;
constexpr size_t EDGE_ELEMS = (size_t)NTM * 2 * DFF;
constexpr size_t WS_WIN = 16 * MiB;
constexpr size_t WS_WOUT = 34 * MiB;
constexpr size_t WS_WUP = 42 * MiB;
constexpr size_t WS_WDN = 86 * MiB;
constexpr size_t WS_XN = 108 * MiB;
constexpr size_t WS_U = 188 * MiB;
constexpr size_t WS_QG = WS_U, WS_QD = WS_QG + (size_t)M_ALL * 512 * 2, WS_KG = WS_QD + (size_t)M_ALL * 256 * 2;
constexpr size_t KROWS = 8192 + 8 * SLAT;
constexpr size_t WS_VG = WS_KG + KROWS * 128 * 2, WS_KD = WS_VG + KROWS * 128 * 2, WS_VD = WS_KD + KROWS * 256 * 2;
constexpr size_t WS_CB = WS_VD + KROWS * 256 * 2, WS_PB = WS_CB + (size_t)M_ALL * 256 * 2, WS_UEND = WS_PB + (size_t)M_ALL * 256 * 2;
constexpr size_t WS_END = WS_U + (size_t)M_ALL * DFF * 2;
static_assert(WS_UEND <= WS_END, "union");
constexpr int MI_LAM = 0, MI_R64C = 64, MI_R64S = MI_R64C + 1024, MI_R32C = MI_R64S + 1024, MI_R32S = MI_R32C + 512;

constexpr int RING_BYTES = 131072, XCH_OFF = RING_BYTES, MISC_OFF = RING_BYTES + 4096, LDS_BYTES = RING_BYTES + 4096 + 256;
constexpr size_t WS_CTL = 0, CTL_ZERO_BYTES = 65536;

struct TileInfo {
    int lat, seq, t0, ci, S; long R;
    __device__ __forceinline__ TileInfo(int pm) {
        if (pm < 32) { lat = 0; seq = pm; t0 = 0; ci = 0; S = 256; R = 256L * pm; }
        else { const int b = (pm - 32) >> 4; lat = 1; seq = b; t0 = ((pm - 32) & 15) * 256; ci = 1 + b; S = SLAT; R = 8192L + (long)SLAT * b; }
    }
};

namespace pg8 {
constexpr int BM = 256, BK = 64, HALF = 128, HTB = HALF * BK * 2, NXCD = 8, WGM = 8;
__host__ __device__ __forceinline__ int lds_byte(int r, int c) { const int st = (r >> 4) * 2 + (c >> 5), rr = r & 15, cc = c & 31, ob = rr * 64 + cc * 2; return st * 1024 + (ob ^ (((ob >> 9) & 1) << 5)); }
__host__ __device__ __forceinline__ void stage_rc(int b, int& R, int& C) { const int st = b / 1024, sb = b % 1024, swz = sb ^ (((sb >> 9) & 1) << 5); R = (st >> 1) * 16 + swz / 64; C = (st & 1) * 32 + (swz % 64) / 2; }
struct Unit { int pm, pn; };
struct Gemm { const bf16_t* A; const bf16_t* Bt; int M, N, K; };
struct StaticOrder {
    int nM, nN, nwg, G, c;
    __device__ void init(int M, int N, int G_, int c_) { nM = M / BM; nN = N / BM; nwg = nM * nN; G = G_; c = c_; }
    __device__ bool next(int i, Unit& u) const {
        const long L = (long)i * G + c; if (L >= nwg) return false;
        int wgid = (int)L; { const int q = nwg / NXCD, r = nwg % NXCD, xcd = wgid % NXCD, off = wgid / NXCD; wgid = (xcd < r ? xcd * (q + 1) : r * (q + 1) + (xcd - r) * q) + off; }
        const int nig = WGM * nN, gid = wgid / nig, fm = gid * WGM, gsz = (nM - fm) < WGM ? (nM - fm) : WGM;
        u.pm = fm + ((wgid % nig) % gsz); u.pn = (wgid % nig) / gsz; return true;
    }
};
template <class Epi>
__device__ __forceinline__ void gemm_phase(LAS unsigned char* lds, LAS unsigned char* xlds, const Gemm g, const StaticOrder& S, const Epi& E) {
    const int tid = opaque_tid(), wid = __builtin_amdgcn_readfirstlane(tid >> 6), lane = tid & 63, wr = wid >> 2, wc = wid & 3, fr = lane & 15, fq = lane >> 4;
    const int K = g.K, nt = K / BK;
    unsigned voffA[2];
#pragma unroll
    for (int i = 0; i < 2; ++i) { int R, C; stage_rc(tid * 16 + i * 8192, R, C); voffA[i] = (unsigned)(R * K + C) * 2u; }
    const size_t kstep = (size_t)(BK * 2);
    const size_t hstep = (size_t)HALF * K * 2;
    const size_t tstep = 2 * hstep;
    const unsigned ldsw = (unsigned)wid * 1024u;
    const int aoff = lds_byte(wr * 64 + fr, fq * 8), boff = lds_byte(wc * 32 + fr, fq * 8);
#define PG8_SA(b, h) (((b) * 2 + (h)) * HTB)
#define PG8_SB(b, h) ((4 + (b) * 2 + (h)) * HTB)
#define PG8_STAGE(bufoff, gbase) do { _Pragma("unroll") for (int _i = 0; _i < 2; ++_i) \
        __builtin_amdgcn_global_load_lds((const unsigned*)((const char*)(gbase) + voffA[_i]), (LAS unsigned*)(lds + (bufoff) + ldsw + _i * 8192), 16, 0, 0); } while (0)
#define PG8_LDA(dst, b, h) do { _Pragma("unroll") for (int m = 0; m < 4; ++m) _Pragma("unroll") for (int k = 0; k < 2; ++k) dst[m][k] = *(const LAS bf16x8*)(lds + PG8_SA(b, h) + aoff + m * 2048 + k * 1024); } while (0)
#define PG8_LDB(dst, b, h) do { _Pragma("unroll") for (int n = 0; n < 2; ++n) _Pragma("unroll") for (int k = 0; k < 2; ++k) dst[n][k] = *(const LAS bf16x8*)(lds + PG8_SB(b, h) + boff + n * 2048 + k * 1024); } while (0)
#define PG8_MMA(ai, bj, At, Bt) do { __builtin_amdgcn_s_setprio(1); _Pragma("unroll") for (int m = 0; m < 4; ++m) _Pragma("unroll") for (int n = 0; n < 2; ++n) _Pragma("unroll") for (int k = 0; k < 2; ++k) \
        acc[ai][bj][m][n] = __builtin_amdgcn_mfma_f32_16x16x32_bf16(Bt[n][k], At[m][k], acc[ai][bj][m][n], 0, 0, 0); __builtin_amdgcn_s_setprio(0); } while (0)
#define PG8_WAIT_V(n) asm volatile("s_waitcnt vmcnt(" #n ")" ::: "memory")
#define PG8_WAIT_L(n) asm volatile("s_waitcnt lgkmcnt(" #n ")" ::: "memory")
#define PG8_BAR __builtin_amdgcn_s_barrier()
#define PG8_SCHED __builtin_amdgcn_sched_barrier(0)
    Unit cur, nxt; int ui = 0;
    if (!S.next(0, cur)) return;
    f32x4 acc[2][2][4][2];
#pragma unroll
    for (int a = 0; a < 2; ++a)
#pragma unroll
        for (int b = 0; b < 2; ++b)
#pragma unroll
            for (int m = 0; m < 4; ++m)
#pragma unroll
                for (int n = 0; n < 2; ++n) acc[a][b][m][n] = (f32x4){0.f, 0.f, 0.f, 0.f};
    bf16x8 At[4][2], B0[2][2], B1[2][2];
    const char* cA = (const char*)g.A + (size_t)cur.pm * tstep; const char* cB = (const char*)g.Bt + (size_t)cur.pn * tstep;
    PG8_STAGE(PG8_SB(0, 0), cB); PG8_STAGE(PG8_SB(0, 1), cB + hstep); PG8_STAGE(PG8_SA(0, 0), cA); PG8_STAGE(PG8_SA(0, 1), cA + hstep);
    if (wr == 1) PG8_BAR;
    PG8_WAIT_V(2); PG8_BAR;
    PG8_STAGE(PG8_SB(1, 0), cB + kstep); PG8_STAGE(PG8_SA(1, 0), cA + kstep); PG8_STAGE(PG8_SB(1, 1), cB + hstep + kstep);
    PG8_WAIT_V(6); PG8_BAR;
    for (;;) {
        const bool has_next = S.next(ui + 1, nxt);
        const char* nA = has_next ? (const char*)g.A + (size_t)nxt.pm * tstep : cA; const char* nB = has_next ? (const char*)g.Bt + (size_t)nxt.pn * tstep : cB;
        for (int t = 0; t < nt; t += 2) {
            const bool last = (t == nt - 2);
            const char* a1 = cA + (size_t)(t + 1) * kstep;
            const char* a2 = last ? nA : cA + (size_t)(t + 2) * kstep; const char* b2 = last ? nB : cB + (size_t)(t + 2) * kstep;
            const char* a3 = a2 + kstep; const char* b3 = b2 + kstep;
            PG8_LDB(B0, 0, 0); PG8_LDB(B1, 0, 1); PG8_SCHED; PG8_LDA(At, 0, 0); PG8_STAGE(PG8_SA(1, 1), a1 + hstep);
            PG8_WAIT_V(8); PG8_WAIT_L(0); PG8_BAR; PG8_MMA(0, 0, At, B0); PG8_MMA(0, 1, At, B1); PG8_BAR; PG8_SCHED;
            PG8_LDA(At, 0, 1); PG8_STAGE(PG8_SB(0, 0), b2); PG8_STAGE(PG8_SB(0, 1), b2 + hstep); PG8_STAGE(PG8_SA(0, 0), a2);
            PG8_WAIT_V(8); PG8_WAIT_L(0); PG8_BAR; PG8_MMA(1, 0, At, B0); PG8_MMA(1, 1, At, B1); PG8_BAR; PG8_SCHED;
            PG8_LDB(B0, 1, 0); PG8_LDB(B1, 1, 1); PG8_SCHED; PG8_LDA(At, 1, 0); PG8_STAGE(PG8_SA(0, 1), a2 + hstep);
            PG8_WAIT_V(8); PG8_WAIT_L(0); PG8_BAR; PG8_MMA(0, 0, At, B0); PG8_MMA(0, 1, At, B1); PG8_BAR; PG8_SCHED;
            PG8_LDA(At, 1, 1); PG8_STAGE(PG8_SB(1, 0), b3); PG8_STAGE(PG8_SB(1, 1), b3 + hstep); PG8_STAGE(PG8_SA(1, 0), a3);
            PG8_WAIT_V(8); PG8_WAIT_L(0); PG8_BAR; PG8_MMA(1, 0, At, B0); PG8_MMA(1, 1, At, B1); PG8_BAR; PG8_SCHED;
        }
        if (wr == 0) PG8_BAR;
        { int fr_ = fr, fq_ = fq; asm volatile("" : "+v"(fr_), "+v"(fq_)); E(acc, cur, wr, wc, fr_, fq_, xlds); }
        if (!has_next) break;
#pragma unroll
        for (int a = 0; a < 2; ++a)
#pragma unroll
            for (int b = 0; b < 2; ++b)
#pragma unroll
                for (int m = 0; m < 4; ++m)
#pragma unroll
                    for (int n = 0; n < 2; ++n) acc[a][b][m][n] = (f32x4){0.f, 0.f, 0.f, 0.f};
        cur = nxt; cA = nA; cB = nB; ++ui;
        if (wr == 1) PG8_BAR;
    }
    PG8_WAIT_V(0);
    PG8_BAR;
#undef PG8_SA
#undef PG8_SB
#undef PG8_STAGE
#undef PG8_LDA
#undef PG8_LDB
#undef PG8_MMA
#undef PG8_WAIT_V
#undef PG8_WAIT_L
#undef PG8_BAR
#undef PG8_SCHED
}
}

typedef f32x4 Acc[2][2][4][2];

struct EpiRes {
    const float* xin_ctx; const float* xin_lat; float* xout; const float* gate;
    __device__ __forceinline__ void operator()(const Acc& acc, const pg8::Unit& u, int wr, int wc, int fr, int fq, LAS unsigned char*) const {
        const TileInfo ti(u.pm);
        const int col0 = u.pn * 256 + wc * 32 + 4 * fq;
        const float* gp = gate + ti.ci * 6144 + col0;
        f32x4 g4[2][2];
#pragma unroll
        for (int bj = 0; bj < 2; ++bj)
#pragma unroll
            for (int n = 0; n < 2; ++n) g4[bj][n] = *(const GAS f32x4*)(gp + bj * 128 + n * 16);
        const float* xin = ti.lat ? xin_lat + (size_t)(u.pm * 256 - M_CTX) * DM : xin_ctx + (size_t)(u.pm * 256) * DM;
        float* xo = xout + (size_t)(u.pm * 256) * DM;
#pragma unroll
        for (int ai = 0; ai < 2; ++ai) {
            f32x4 xv[4][2][2];
#pragma unroll
            for (int m = 0; m < 4; ++m) {
                const size_t off = (size_t)(ai * 128 + wr * 64 + m * 16 + fr) * DM + col0;
#pragma unroll
                for (int bj = 0; bj < 2; ++bj)
#pragma unroll
                    for (int n = 0; n < 2; ++n) xv[m][bj][n] = *(const GAS f32x4*)(xin + off + bj * 128 + n * 16);
            }
#pragma unroll
            for (int m = 0; m < 4; ++m) {
                const size_t off = (size_t)(ai * 128 + wr * 64 + m * 16 + fr) * DM + col0;
#pragma unroll
                for (int bj = 0; bj < 2; ++bj)
#pragma unroll
                    for (int n = 0; n < 2; ++n) *(GAS f32x4*)(xo + off + bj * 128 + n * 16) = xv[m][bj][n] + g4[bj][n] * acc[ai][bj][m][n];
            }
            __builtin_amdgcn_sched_group_barrier(0x020, 16, 0);
            asm volatile("" ::: "memory");
            __builtin_amdgcn_sched_barrier(0);
        }
    }
};

struct EpiIn {
    int layer;
    const float *qn_g, *kn_g, *dqn_g, *dkn_g;
    const float *r64c, *r64s, *r32c, *r32s;
    bf16_t *QG, *QD, *KG, *VG, *KD, *VD, *CB, *PB;
    float* out;
    __device__ __forceinline__ void operator()(const Acc& acc, const pg8::Unit& u, int wr, int wc, int fr, int fq, LAS unsigned char*) const {
        const TileInfo ti(u.pm);
        const int pn = u.pn;
        const int rbase = wr * 64 + fr;
        if (pn < 2 || (pn == 2 && wc < 2)) {
            const bool isq = pn < 2;
            const float* gsrc = (isq ? qn_g : kn_g) + 4 * fq;
            const int head = isq ? 4 * pn + wc : wc;
#pragma unroll
            for (int ai = 0; ai < 2; ++ai)
#pragma unroll
                for (int m = 0; m < 4; ++m) {
                    const int rt = ai * 128 + m * 16 + rbase; const int t = ti.t0 + rt;
                    float ss = 0.f;
#pragma unroll
                    for (int bj = 0; bj < 2; ++bj)
#pragma unroll
                        for (int n = 0; n < 2; ++n) { const f32x4 v = acc[ai][bj][m][n]; ss += (v[0] * v[0] + v[1] * v[1]) + (v[2] * v[2] + v[3] * v[3]); }
                    ss += __shfl_xor(ss, 16); ss += __shfl_xor(ss, 32);
                    const float rstd = rsqrtf(ss * (1.f / 64.f) + EPS);
                    bf16_t* dst = isq ? QG + ((size_t)u.pm * 256 + rt) * 512 + head * 64 + 4 * fq : KG + ((ti.R * 2 + (long)head * ti.S + t) * 64) + 4 * fq;
                    float* o = out + OUT_GK + ((size_t)(ti.seq * 4 + layer) * 256 + t) * 128 + head * 64 + 4 * fq;
#pragma unroll
                    for (int bj = 0; bj < 2; ++bj) {
                        f32x4 y0 = acc[ai][bj][m][0] * rstd * *(const GAS f32x4*)(gsrc + 32 * bj), y1 = acc[ai][bj][m][1] * rstd * *(const GAS f32x4*)(gsrc + 32 * bj + 16);
                        if (!isq && !ti.lat) { *(GAS f32x4*)(o + 32 * bj) = y0; *(GAS f32x4*)(o + 32 * bj + 16) = y1; }
                        if (ti.lat) {
                            const int pos = bj ? (t & 63) : (t >> 6);
                            const f32x4 c4 = *(const GAS f32x4*)(r64c + pos * 16 + 4 * fq), s4 = *(const GAS f32x4*)(r64s + pos * 16 + 4 * fq);
                            const f32x4 o0 = y0 * c4 - y1 * s4, o1 = y1 * c4 + y0 * s4; y0 = o0; y1 = o1;
                        }
                        if (isq) { y0 = y0 * QSCALE_G; y1 = y1 * QSCALE_G; }
                        u32x2 w0, w1; w0.x = cvtpk(y0[0], y0[1]); w0.y = cvtpk(y0[2], y0[3]); w1.x = cvtpk(y1[0], y1[1]); w1.y = cvtpk(y1[2], y1[3]);
                        *(GAS u32x2*)(dst + 32 * bj) = w0; *(GAS u32x2*)(dst + 32 * bj + 16) = w1;
                    }
                    asm volatile("" ::: "memory");
                }
        } else if (pn == 2) {
            const int head = wc - 2;
#pragma unroll
            for (int ai = 0; ai < 2; ++ai)
#pragma unroll
                for (int m = 0; m < 4; ++m) {
                    const int rt = ai * 128 + m * 16 + rbase; const int t = ti.t0 + rt;
                    if (!ti.lat) {
                        float* o = out + OUT_GV + ((size_t)(ti.seq * 4 + layer) * 256 + t) * 128 + head * 64 + 4 * fq;
#pragma unroll
                        for (int bj = 0; bj < 2; ++bj)
#pragma unroll
                            for (int n = 0; n < 2; ++n) *(GAS f32x4*)(o + 32 * bj + 16 * n) = acc[ai][bj][m][n];
                    }
                    bf16_t* vp = VG + ((ti.R * 2 + (long)head * ti.S + t) * 64) + 4 * fq;
#pragma unroll
                    for (int bj = 0; bj < 2; ++bj)
#pragma unroll
                        for (int n = 0; n < 2; ++n) { const f32x4 v = acc[ai][bj][m][n]; u32x2 w; w.x = cvtpk(v[0], v[1]); w.y = cvtpk(v[2], v[3]); *(GAS u32x2*)(vp + 32 * bj + 16 * n) = w; }
                }
        } else if (pn == 3) {
#pragma unroll
            for (int ai = 0; ai < 2; ++ai)
#pragma unroll
                for (int m = 0; m < 4; ++m) {
                    const size_t grow = (size_t)u.pm * 256 + ai * 128 + m * 16 + rbase;
                    bf16_t* p = CB + grow * 256 + 32 * wc + 8 * fq;
#pragma unroll
                    for (int bj = 0; bj < 2; ++bj) { const f32x4 a = acc[ai][bj][m][0], b = acc[ai][bj][m][1]; u32x4 w; w.x = cvtpk(a[0], a[1]); w.y = cvtpk(a[2], a[3]); w.z = cvtpk(b[0], b[1]); w.w = cvtpk(b[2], b[3]); *(GAS u32x4*)(p + 128 * bj) = w; }
                }
        } else if (pn < 6) {
#pragma unroll
            for (int ai = 0; ai < 2; ++ai)
#pragma unroll
                for (int m = 0; m < 4; ++m) {
                    const size_t grow = (size_t)u.pm * 256 + ai * 128 + m * 16 + rbase;
                    bf16_t* p = PB + grow * 256 + 128 * (pn - 4) + 32 * wc + 8 * fq;
                    const f32x4 a = acc[ai][0][m][0] * acc[ai][1][m][0], b = acc[ai][0][m][1] * acc[ai][1][m][1];
                    u32x4 w; w.x = cvtpk(a[0], a[1]); w.y = cvtpk(a[2], a[3]); w.z = cvtpk(b[0], b[1]); w.w = cvtpk(b[2], b[3]); *(GAS u32x4*)p = w;
                }
        } else if (pn < 8) {
            const bool isq = pn == 6;
            const float* gsrc = isq ? dqn_g : dkn_g;
            const int a_ax = fq >> 1, ib = 4 * (fq & 1);
            const float* gp = gsrc + 16 * a_ax + ib;
            const int head = wc;
#pragma unroll
            for (int ai = 0; ai < 2; ++ai)
#pragma unroll
                for (int m = 0; m < 4; ++m) {
                    const int rt = ai * 128 + m * 16 + rbase; const int t = ti.t0 + rt; const size_t grow = (size_t)u.pm * 256 + rt;
#pragma unroll
                    for (int bj = 0; bj < 2; ++bj) {
                        float ss = 0.f;
#pragma unroll
                        for (int n = 0; n < 2; ++n) { const f32x4 v = acc[ai][bj][m][n]; ss += (v[0] * v[0] + v[1] * v[1]) + (v[2] * v[2] + v[3] * v[3]); }
                        ss += __shfl_xor(ss, 16); ss += __shfl_xor(ss, 32);
                        const float rstd = rsqrtf(ss * (1.f / 32.f) + EPS);
                        f32x4 y0 = acc[ai][bj][m][0] * rstd * *(const GAS f32x4*)gp, y1 = acc[ai][bj][m][1] * rstd * *(const GAS f32x4*)(gp + 8);
                        if (!isq && !ti.lat) {
                            float* o = out + OUT_DK + ((size_t)(ti.seq * 4 + layer) * 256 + t) * 256 + head * 64 + bj * 32 + 16 * a_ax + ib;
                            *(GAS f32x4*)(o) = y0; *(GAS f32x4*)(o + 8) = y1;
                        }
                        if (ti.lat) {
                            const int pos = a_ax ? (t & 63) : (t >> 6);
                            const f32x4 c4 = *(const GAS f32x4*)(r32c + pos * 8 + ib), s4 = *(const GAS f32x4*)(r32s + pos * 8 + ib);
                            const f32x4 o0 = y0 * c4 - y1 * s4, o1 = y1 * c4 + y0 * s4; y0 = o0; y1 = o1;
                        }
                        bf16_t* dst;
                        if (isq) { y0 = y0 * QSCALE_D; y1 = y1 * QSCALE_D; dst = QD + grow * 256 + head * 64 + bj * 32 + 16 * a_ax + ib; }
                        else dst = KD + ((ti.R * 8 + (long)(head * 2 + bj) * ti.S + t) * 32) + 16 * a_ax + ib;
                        u32x2 w0, w1; w0.x = cvtpk(y0[0], y0[1]); w0.y = cvtpk(y0[2], y0[3]); w1.x = cvtpk(y1[0], y1[1]); w1.y = cvtpk(y1[2], y1[3]);
                        *(GAS u32x2*)dst = w0; *(GAS u32x2*)(dst + 8) = w1;
                    }
                    asm volatile("" ::: "memory");
                }
        } else {
            const int head = wc;
#pragma unroll
            for (int ai = 0; ai < 2; ++ai)
#pragma unroll
                for (int m = 0; m < 4; ++m) {
                    const int rt = ai * 128 + m * 16 + rbase; const int t = ti.t0 + rt;
                    if (!ti.lat) {
                        float* o = out + OUT_DV + ((size_t)(ti.seq * 4 + layer) * 256 + t) * 256 + head * 64 + 8 * fq;
#pragma unroll
                        for (int bj = 0; bj < 2; ++bj) { *(GAS f32x4*)(o + 32 * bj) = acc[ai][bj][m][0]; *(GAS f32x4*)(o + 32 * bj + 4) = acc[ai][bj][m][1]; }
                    }
                    bf16_t* vp = VD + ((ti.R * 4 + (long)head * ti.S + t) * 64) + 8 * fq;
#pragma unroll
                    for (int bj = 0; bj < 2; ++bj) { const f32x4 a = acc[ai][bj][m][0], b = acc[ai][bj][m][1]; u32x4 w; w.x = cvtpk(a[0], a[1]); w.y = cvtpk(a[2], a[3]); w.z = cvtpk(b[0], b[1]); w.w = cvtpk(b[2], b[3]); *(GAS u32x4*)(vp + 32 * bj) = w; }
                }
        }
    }
};

__device__ __forceinline__ float dpp_ror1(float x) { return __int_as_float(__builtin_amdgcn_update_dpp(0, __float_as_int(x), 0x121, 0xf, 0xf, false)); }
__device__ __forceinline__ float dpp_ror15(float x) { return __int_as_float(__builtin_amdgcn_update_dpp(0, __float_as_int(x), 0x12F, 0xf, 0xf, false)); }
__device__ __forceinline__ float silu_f(float x) { return x * __builtin_amdgcn_rcpf(1.f + __builtin_amdgcn_exp2f(-x * LOG2E)); }
struct EpiUp {
    const float* cw; const float* cbias; bf16_t* F; float* EP; float* EA; float* EU;
    __device__ __forceinline__ void operator()(const Acc& acc, const pg8::Unit& u, int wr, int wc, int fr, int fq, LAS unsigned char* xlds) const {
        const TileInfo ti(u.pm);
        const int c0 = u.pn * 128 + wc * 32 + 8 * fq;
        LAS float* X = (LAS float*)xlds;
#pragma unroll
        for (int ai = 0; ai < 2; ++ai) {
            if (fr == 0) { LAS float* p = X + ((((ai * 2 + wr) * 4 + wc) * 2 + 0) * 4 + fq) * 8; *(LAS f32x4*)p = acc[ai][0][0][0]; *(LAS f32x4*)(p + 4) = acc[ai][0][0][1]; }
            if (fr == 15) { LAS float* p = X + ((((ai * 2 + wr) * 4 + wc) * 2 + 1) * 4 + fq) * 8; *(LAS f32x4*)p = acc[ai][0][3][0]; *(LAS f32x4*)(p + 4) = acc[ai][0][3][1]; }
        }
        asm volatile("s_waitcnt lgkmcnt(0)" ::: "memory"); __builtin_amdgcn_s_barrier(); asm volatile("" ::: "memory");
        f32x4 w0[2], w1[2], w2[2], bb[2];
#pragma unroll
        for (int n = 0; n < 2; ++n) { w0[n] = *(const GAS f32x4*)(cw + c0 + 4 * n); w1[n] = *(const GAS f32x4*)(cw + DFF + c0 + 4 * n); w2[n] = *(const GAS f32x4*)(cw + 2 * DFF + c0 + 4 * n); bb[n] = *(const GAS f32x4*)(cbias + c0 + 4 * n); }
        const bool has_prev = ti.lat && ti.t0 > 0, has_next = ti.lat && ti.t0 < 4096 - 256;
#pragma unroll
        for (int ai = 0; ai < 2; ++ai) {
            f32x4 pb[2] = {(f32x4){0.f, 0.f, 0.f, 0.f}, (f32x4){0.f, 0.f, 0.f, 0.f}}, nb[2] = {(f32x4){0.f, 0.f, 0.f, 0.f}, (f32x4){0.f, 0.f, 0.f, 0.f}};
            { const int seg = ai * 2 + wr;
              if (seg > 0) { const int ps = seg - 1; LAS float* p = X + ((((ps >> 1) * 2 + (ps & 1)) * 4 + wc) * 2 + 1) * 32 + fq * 8; pb[0] = *(LAS f32x4*)p; pb[1] = *(LAS f32x4*)(p + 4); }
              if (seg < 3) { const int ns = seg + 1; LAS float* p = X + ((((ns >> 1) * 2 + (ns & 1)) * 4 + wc) * 2 + 0) * 32 + fq * 8; nb[0] = *(LAS f32x4*)p; nb[1] = *(LAS f32x4*)(p + 4); } }
#pragma unroll
            for (int m = 0; m < 4; ++m) {
                const int rt = ai * 128 + wr * 64 + m * 16 + fr; const size_t grow = (size_t)u.pm * 256 + rt;
                f32x4 fo[2], cv[2];
#pragma unroll
                for (int n = 0; n < 2; ++n) {
                    const f32x4 a = acc[ai][0][m][n];
                    const f32x4 up = (m > 0) ? acc[ai][0][m > 0 ? m - 1 : 0][n] : pb[n];
                    const f32x4 dn = (m < 3) ? acc[ai][0][m < 3 ? m + 1 : 3][n] : nb[n];
                    f32x4 pv, nx;
#pragma unroll
                    for (int e = 0; e < 4; ++e) {
                        pv[e] = dpp_ror1(fr == 15 ? up[e] : a[e]);
                        nx[e] = dpp_ror15(fr == 0 ? dn[e] : a[e]);
                    }
                    const f32x4 c = w0[n] * pv + w1[n] * a + w2[n] * nx + bb[n];
                    cv[n] = c;
                    const f32x4 uu = acc[ai][1][m][n];
#pragma unroll
                    for (int e = 0; e < 4; ++e) fo[n][e] = silu_f(c[e]) * uu[e];
                }
                u32x4 w; w.x = cvtpk(fo[0][0], fo[0][1]); w.y = cvtpk(fo[0][2], fo[0][3]); w.z = cvtpk(fo[1][0], fo[1][1]); w.w = cvtpk(fo[1][2], fo[1][3]);
                *(GAS u32x4*)(F + grow * DFF + c0) = w;
                if (ai == 0 && m == 0) { if (has_prev && rt == 0) { const size_t eo = ((size_t)u.pm * 2 + 0) * DFF + c0;
                        *(GAS f32x4*)(EP + eo) = cv[0]; *(GAS f32x4*)(EP + eo + 4) = cv[1]; *(GAS f32x4*)(EA + eo) = acc[0][0][0][0]; *(GAS f32x4*)(EA + eo + 4) = acc[0][0][0][1]; *(GAS f32x4*)(EU + eo) = acc[0][1][0][0]; *(GAS f32x4*)(EU + eo + 4) = acc[0][1][0][1]; } }
                if (ai == 1 && m == 3) { if (has_next && rt == 255) { const size_t eo = ((size_t)u.pm * 2 + 1) * DFF + c0;
                        *(GAS f32x4*)(EP + eo) = cv[0]; *(GAS f32x4*)(EP + eo + 4) = cv[1]; *(GAS f32x4*)(EA + eo) = acc[1][0][3][0]; *(GAS f32x4*)(EA + eo + 4) = acc[1][0][3][1]; *(GAS f32x4*)(EU + eo) = acc[1][1][3][0]; *(GAS f32x4*)(EU + eo + 4) = acc[1][1][3][1]; } }
            }
        }
        asm volatile("s_waitcnt lgkmcnt(0)" ::: "memory"); __builtin_amdgcn_s_barrier(); asm volatile("" ::: "memory");
    }
};

typedef short v4i16_t __attribute__((ext_vector_type(4)));
__device__ __forceinline__ s16x4 vtr(LAS const char* p) { return __builtin_bit_cast(s16x4, __builtin_amdgcn_ds_read_tr16_b64_v4i16((LAS v4i16_t*)p)); }
__device__ __forceinline__ float xhalf_max(float m) { auto rr = __builtin_amdgcn_permlane32_swap(__float_as_uint(m), __float_as_uint(m), false, false); return fmaxf(__uint_as_float(rr[0]), __uint_as_float(rr[1])); }
__device__ __forceinline__ float xhalf_sum(float m) { auto rr = __builtin_amdgcn_permlane32_swap(__float_as_uint(m), __float_as_uint(m), false, false); return __uint_as_float(rr[0]) + __uint_as_float(rr[1]); }

constexpr int ATT_VS = 192;
constexpr float ATT_THR = 8.f;
#define MX3(a, b, c) __builtin_fmaxf(__builtin_fmaxf((a), (b)), (c))
template <int DQK, bool YORD>
__device__ __forceinline__ void flash_pass(const bf16_t* __restrict__ Qw, int qpitch, const bf16_t* __restrict__ Kg, const bf16_t* __restrict__ Vg, int NT, int tst,
                                           LAS char* lds, f32x16 (&o)[2], float& lsum) {
#define ATT_TI(T) (((T) + tst) < NT ? ((T) + tst) : ((T) + tst - NT))
    constexpr int KS = DQK * 2 + 16, KBUF = 64 * KS, VBUF = 64 * ATT_VS, NDS = DQK / 16;
    constexpr int KROWB = DQK * 2;
    const int tid = opaque_tid(), lane = tid & 63, r32 = lane & 31, h = lane >> 5;
    LAS char* Kb = lds; LAS char* Vb = lds + 2 * KBUF;
    bf16x8 qf[NDS];
#pragma unroll
    for (int ds = 0; ds < NDS; ++ds) qf[ds] = *(const GAS bf16x8*)(Qw + (size_t)r32 * qpitch + 16 * ds + 8 * h);
    const bool kload = (tid * 16) < 64 * KROWB;
    const int krow = (tid * 16) / KROWB, kcb = (tid * 16) % KROWB;
    const int kdst = krow * KS + kcb, vdst = (tid >> 3) * ATT_VS + (tid & 7) * 16;
    const char* kg = (const char*)Kg + tid * 16; const char* vg = (const char*)Vg + tid * 16;
    u32x4 kreg = {0, 0, 0, 0}, vreg;
    {
        u32x4 k1 = {0, 0, 0, 0};
        if (kload) { kreg = *(const GAS u32x4*)(kg + (size_t)ATT_TI(0) * 64 * KROWB); k1 = *(const GAS u32x4*)(kg + (size_t)ATT_TI(1) * 64 * KROWB); }
        vreg = *(const GAS u32x4*)(vg + (size_t)ATT_TI(0) * 64 * 128);
        if (kload) { *(LAS u32x4*)(Kb + kdst) = kreg; *(LAS u32x4*)(Kb + KBUF + kdst) = k1; }
        *(LAS u32x4*)(Vb + vdst) = vreg;
        *(LAS u32x4*)(Vb + 2 * VBUF + vdst) = (u32x4){0, 0, 0, 0};
    }
    __syncthreads();
    const int kfo = r32 * KS + h * 16;
    const int vfo = (4 * h + ((lane & 15) >> 2)) * ATT_VS + (((lane >> 4) & 1) * 16 + (lane & 3) * 4) * 2;
    f32x16 p0 = (f32x16){}, p1 = (f32x16){};
#pragma unroll
    for (int ds = 0; ds < NDS; ++ds) {
        const bf16x8 k0 = *(LAS const bf16x8*)(Kb + kfo + ds * 32), k1 = *(LAS const bf16x8*)(Kb + kfo + 32 * KS + ds * 32);
        p0 = __builtin_amdgcn_mfma_f32_32x32x16_bf16(k0, qf[ds], p0, 0, 0, 0);
        p1 = __builtin_amdgcn_mfma_f32_32x32x16_bf16(k1, qf[ds], p1, 0, 0, 0);
    }
    __syncthreads();
    float mref, l = 0.f;
    {
        float a = MX3(p0[0], p0[1], p1[0]), b = MX3(p0[2], p0[3], p1[1]); a = MX3(a, p1[2], p1[3]);
#pragma unroll
        for (int r = 4; r < 16; r += 4) { a = MX3(a, p0[r], p0[r + 1]); b = MX3(b, p0[r + 2], p0[r + 3]); a = MX3(a, p1[r], p1[r + 1]); b = MX3(b, p1[r + 2], p1[r + 3]); }
        mref = xhalf_max(fmaxf(a, b));
#pragma unroll
        for (int r = 0; r < 16; ++r) { p0[r] -= mref; p1[r] -= mref; }
    }
    f32x16 negm;
#pragma unroll
    for (int r = 0; r < 16; ++r) negm[r] = -mref;
    asm volatile("" : "+v"(negm));
    o[0] = (f32x16){}; o[1] = (f32x16){};
    bf16x8 pk[4] = {};
    int vs_prev = 2 * VBUF, vs_cur = 0, vs_next = VBUF;
#define ATT_MPART(N0, N1, T) do { \
        LAS const char* kb_ = Kb + ((((T) + 1) & 1) * KBUF) + kfo; LAS const char* vb_ = Vb + vs_prev + vfo; \
        bf16x8 kf_[2 * NDS]; s16x4 vl_[8], vh_[8]; \
        _Pragma("unroll") for (int ds = 0; ds < NDS; ++ds) { kf_[2 * ds] = *(LAS const bf16x8*)(kb_ + ds * 32); kf_[2 * ds + 1] = *(LAS const bf16x8*)(kb_ + 32 * KS + ds * 32); } \
        _Pragma("unroll") for (int s_ = 0; s_ < 4; ++s_) { _Pragma("unroll") for (int db_ = 0; db_ < 2; ++db_) { \
            vl_[2 * s_ + db_] = vtr(vb_ + (16 * s_) * ATT_VS + db_ * 64); vh_[2 * s_ + db_] = vtr(vb_ + (16 * s_ + 8) * ATT_VS + db_ * 64); } } \
        N0 = __builtin_amdgcn_mfma_f32_32x32x16_bf16(kf_[0], qf[0], negm, 0, 0, 0); N1 = __builtin_amdgcn_mfma_f32_32x32x16_bf16(kf_[1], qf[0], negm, 0, 0, 0); \
        _Pragma("unroll") for (int ds = 1; ds < NDS; ++ds) { \
            N0 = __builtin_amdgcn_mfma_f32_32x32x16_bf16(kf_[2 * ds], qf[ds], N0, 0, 0, 0); N1 = __builtin_amdgcn_mfma_f32_32x32x16_bf16(kf_[2 * ds + 1], qf[ds], N1, 0, 0, 0); } \
        _Pragma("unroll") for (int s_ = 0; s_ < 4; ++s_) { _Pragma("unroll") for (int db_ = 0; db_ < 2; ++db_) { \
            const bf16x8 vf_ = __builtin_shufflevector(vl_[2 * s_ + db_], vh_[2 * s_ + db_], 0, 1, 2, 3, 4, 5, 6, 7); \
            o[db_] = __builtin_amdgcn_mfma_f32_32x32x16_bf16(vf_, pk[s_], o[db_], 0, 0, 0); } } \
        __builtin_amdgcn_sched_group_barrier(0x100, 2 * NDS + 8, 0); __builtin_amdgcn_sched_group_barrier(0x008, 2 * NDS, 0); \
        __builtin_amdgcn_sched_group_barrier(0x100, 8, 0); __builtin_amdgcn_sched_group_barrier(0x008, 8, 0); } while (0)
#define ATT_VPART(P0, P1, N0, N1) do { \
        float a = MX3(P0[0], P0[1], P1[0]), b = MX3(P0[2], P0[3], P1[1]); a = MX3(a, P1[2], P1[3]); \
        _Pragma("unroll") for (int r = 4; r < 16; r += 4) { a = MX3(a, P0[r], P0[r + 1]); b = MX3(b, P0[r + 2], P0[r + 3]); a = MX3(a, P1[r], P1[r + 1]); b = MX3(b, P1[r + 2], P1[r + 3]); } \
        const float mt = xhalf_max(fmaxf(a, b)); \
        resc = __any(mt > ATT_THR); \
        if (__builtin_expect(resc, 0)) { \
            const float dl = fmaxf(mt, 0.f); mref += dl; fsc = __builtin_amdgcn_exp2f(-dl); l *= fsc; \
            _Pragma("unroll") for (int r = 0; r < 16; ++r) { P0[r] -= dl; P1[r] -= dl; } \
            if (!YORD) { _Pragma("unroll") for (int r = 0; r < 16; ++r) { N0[r] -= dl; N1[r] -= dl; o[0][r] *= fsc; o[1][r] *= fsc; } } \
            _Pragma("unroll") for (int r = 0; r < 16; ++r) negm[r] = -mref; \
            asm volatile("" : "+v"(negm)); } \
        float ps0 = 0.f, ps1 = 0.f; \
        _Pragma("unroll") for (int r = 0; r < 16; ++r) { P0[r] = __builtin_amdgcn_exp2f(P0[r]); P1[r] = __builtin_amdgcn_exp2f(P1[r]); ps0 += P0[r]; ps1 += P1[r]; } \
        l += ps0 + ps1; \
        _Pragma("unroll") for (int s = 0; s < 2; ++s) { u32x4 a4, b4; \
            a4.x = cvtpk(P0[8 * s + 0], P0[8 * s + 1]); a4.y = cvtpk(P0[8 * s + 2], P0[8 * s + 3]); a4.z = cvtpk(P0[8 * s + 4], P0[8 * s + 5]); a4.w = cvtpk(P0[8 * s + 6], P0[8 * s + 7]); \
            b4.x = cvtpk(P1[8 * s + 0], P1[8 * s + 1]); b4.y = cvtpk(P1[8 * s + 2], P1[8 * s + 3]); b4.z = cvtpk(P1[8 * s + 4], P1[8 * s + 5]); b4.w = cvtpk(P1[8 * s + 6], P1[8 * s + 7]); \
            pkn[s] = __builtin_bit_cast(bf16x8, a4); pkn[2 + s] = __builtin_bit_cast(bf16x8, b4); } } while (0)
#define ATT_STEP(P0, P1, N0, N1, T) do { \
        const bool more = (T) + 1 < NT, more2 = (T) + 2 < NT; \
        if (more2 && kload) kreg = *(const GAS u32x4*)(kg + (size_t)ATT_TI((T) + 2) * 64 * KROWB); \
        if (more) vreg = *(const GAS u32x4*)(vg + (size_t)ATT_TI((T) + 1) * 64 * 128); \
        float fsc = 1.f; bool resc; bf16x8 pkn[4]; \
        if (!YORD) { ATT_MPART(N0, N1, T); __builtin_amdgcn_sched_barrier(0); ATT_VPART(P0, P1, N0, N1); } \
        else { ATT_VPART(P0, P1, N0, N1); __builtin_amdgcn_sched_barrier(0); ATT_MPART(N0, N1, T); \
            if (__builtin_expect(resc, 0)) { _Pragma("unroll") for (int r = 0; r < 16; ++r) { o[0][r] *= fsc; o[1][r] *= fsc; } } } \
        _Pragma("unroll") for (int s = 0; s < 4; ++s) pk[s] = pkn[s]; \
        if (more2 && kload) *(LAS u32x4*)(Kb + ((T) & 1) * KBUF + kdst) = kreg; \
        if (more) *(LAS u32x4*)(Vb + vs_next + vdst) = vreg; \
        __syncthreads(); \
        vs_prev = vs_cur; vs_cur = vs_next; vs_next = (vs_next == 2 * VBUF) ? 0 : vs_next + VBUF; } while (0)
    f32x16 n0, n1;
    for (int t = 0; t < NT; t += 2) {
        ATT_STEP(p0, p1, n0, n1, t);
        ATT_STEP(n0, n1, p0, p1, t + 1);
    }
    {
        LAS const char* vb_ = Vb + vs_prev + vfo;
#pragma unroll
        for (int s_ = 0; s_ < 4; ++s_) {
#pragma unroll
            for (int db_ = 0; db_ < 2; ++db_) {
                const s16x4 lo_ = vtr(vb_ + (16 * s_) * ATT_VS + db_ * 64), hi_ = vtr(vb_ + (16 * s_ + 8) * ATT_VS + db_ * 64);
                const bf16x8 vf_ = __builtin_shufflevector(lo_, hi_, 0, 1, 2, 3, 4, 5, 6, 7);
                o[db_] = __builtin_amdgcn_mfma_f32_32x32x16_bf16(vf_, pk[s_], o[db_], 0, 0, 0);
            }
        }
    }
    __syncthreads();
#undef ATT_STEP
#undef ATT_TI
#undef ATT_VPART
#undef ATT_MPART
    lsum = xhalf_sum(l);
}

__device__ __forceinline__ void store_ot(const f32x16 (&o)[2], bf16_t* dst  , int h) {
#pragma unroll
    for (int db = 0; db < 2; ++db)
#pragma unroll
        for (int g = 0; g < 4; ++g) { u32x2 w; w.x = cvtpk(o[db][4 * g], o[db][4 * g + 1]); w.y = cvtpk(o[db][4 * g + 2], o[db][4 * g + 3]); *(GAS u32x2*)(dst + 32 * db + 8 * g + 4 * h) = w; }
}

#include <hip/hip_bf16.h>
namespace attn64 {
using bf16=__hip_bfloat16;
using bf16x8=__attribute__((ext_vector_type(8)))short;
using s16x4=__attribute__((ext_vector_type(4)))short;
using f32x16=__attribute__((ext_vector_type(16)))float;
using u32x4=__attribute__((ext_vector_type(4)))unsigned;
constexpr int D=64;
constexpr int NW=8,QBLK=32,QB=QBLK*NW,KVBLK=64;

__device__ __forceinline__ int crow(int r,int hi){return (r&3)+8*(r>>2)+4*hi;}
#define SBAR() __builtin_amdgcn_sched_barrier(0)
__device__ __forceinline__ void cmask(f32x16&p0,f32x16&p1,int jb,int qrel,int hi){
  const float NEG=-INFINITY; int kb=64*jb+4*hi;
  #pragma unroll
  for(int r=0;r<16;++r){int kv=kb+(r&3)+8*(r>>2); if(kv>qrel)p0[r]=NEG; if(kv+32>qrel)p1[r]=NEG;}
}

constexpr int NSLOT=3, SLOTB=8192;
constexpr int LDS_K=0, LDS_V=NSLOT*SLOTB, LDS_WS=2*NSLOT*SLOTB, LDS_OST=LDS_WS+NW*64*4, LDS_BYTES=LDS_OST+NW*4096;
constexpr float C2=0.125f*1.4426950408889634f;
__device__ __forceinline__ void glds16(const void*gsrc,unsigned lds_dst){unsigned keep;
  asm volatile("s_mov_b32 %0, m0\n\ts_mov_b32 m0, %2\n\ts_nop 0\n\tglobal_load_lds_dwordx4 %1, off\n\ts_mov_b32 m0, %0":"=&s"(keep):"v"(gsrc),"s"(lds_dst):"memory");}
__device__ __forceinline__ float max3f(float a,float b,float c){float r;asm("v_max3_f32 %0, %1, %2, %3":"=v"(r):"v"(a),"v"(b),"v"(c));return r;}
__device__ __forceinline__ float max2f(float a,float b){float r;asm("v_max_f32_e32 %0, %1, %2":"=v"(r):"v"(a),"v"(b));return r;}
__device__ __forceinline__ float fadd_s(float a,float b){float r;asm("v_add_f32_e32 %0, %1, %2":"=v"(r):"v"(a),"v"(b));return r;}
__device__ __forceinline__ float fsub_s(float a,float b){float r;asm("v_sub_f32_e32 %0, %1, %2":"=v"(r):"v"(a),"v"(b));return r;}
typedef float f32x2_t __attribute__((ext_vector_type(2))); typedef __bf16 bf16x2_t __attribute__((ext_vector_type(2)));
__device__ __forceinline__ unsigned cvtpk_s(float lo,float hi){f32x2_t v={lo,hi};bf16x2_t b=__builtin_convertvector(v,bf16x2_t);return __builtin_bit_cast(unsigned,b);}
#define WAIT_BAR(N) asm volatile("s_waitcnt vmcnt(" #N ") lgkmcnt(0)\n\ts_barrier":::"memory")

__device__ __forceinline__ void qkt(f32x16&p0,f32x16&p1,const char*Kslot,const bf16x8*qr,const f32x16&negm,int r32,int hi){
  const char*kb=Kslot+hi*1024+r32*16;
  #pragma unroll
  for(int d0=0;d0<4;++d0){
    const bf16x8 b0=*reinterpret_cast<const bf16x8*>(kb+d0*2048);
    const bf16x8 b1=*reinterpret_cast<const bf16x8*>(kb+d0*2048+512);
    if(d0==0){p0=__builtin_amdgcn_mfma_f32_32x32x16_bf16(b0,qr[0],negm,0,0,0);p1=__builtin_amdgcn_mfma_f32_32x32x16_bf16(b1,qr[0],negm,0,0,0);}
    else{p0=__builtin_amdgcn_mfma_f32_32x32x16_bf16(b0,qr[d0],p0,0,0,0);p1=__builtin_amdgcn_mfma_f32_32x32x16_bf16(b1,qr[d0],p1,0,0,0);}}
}
typedef __attribute__((address_space(3))) const char* lds_cptr;
typedef short v4i16_t __attribute__((ext_vector_type(4)));
__device__ __forceinline__ void kload8(bf16x8*kf,lds_cptr kp){
  kf[0]=*(const __attribute__((address_space(3))) bf16x8*)(kp);      kf[1]=*(const __attribute__((address_space(3))) bf16x8*)(kp+512);
  kf[2]=*(const __attribute__((address_space(3))) bf16x8*)(kp+2048); kf[3]=*(const __attribute__((address_space(3))) bf16x8*)(kp+2560);
  kf[4]=*(const __attribute__((address_space(3))) bf16x8*)(kp+4096); kf[5]=*(const __attribute__((address_space(3))) bf16x8*)(kp+4608);
  kf[6]=*(const __attribute__((address_space(3))) bf16x8*)(kp+6144); kf[7]=*(const __attribute__((address_space(3))) bf16x8*)(kp+6656);
}
__device__ __forceinline__ void kload2(bf16x8*kf,lds_cptr kp,int j){ kf[2*j]=*(const __attribute__((address_space(3))) bf16x8*)(kp+j*2048); kf[2*j+1]=*(const __attribute__((address_space(3))) bf16x8*)(kp+j*2048+512); }
__device__ __forceinline__ s16x4 vtr(lds_cptr p){ return __builtin_bit_cast(s16x4,__builtin_amdgcn_ds_read_tr16_b64_v4i16((__attribute__((address_space(3))) v4i16_t*)p)); }
__device__ __forceinline__ float rowmax(const f32x16&p0,const f32x16&p1){
  float a=max3f(p0[0],p0[1],p1[0]),b=max3f(p0[2],p0[3],p1[1]);a=max3f(a,p1[2],p1[3]);
  #pragma unroll
  for(int r=4;r<16;r+=4){a=max3f(a,p0[r],p0[r+1]);b=max3f(b,p0[r+2],p0[r+3]);a=max3f(a,p1[r],p1[r+1]);b=max3f(b,p1[r+2],p1[r+3]);}
  const float m=max2f(a,b);
  auto rr=__builtin_amdgcn_permlane32_swap(__float_as_uint(m),__float_as_uint(m),false,false);
  return max2f(__uint_as_float(rr[0]),__uint_as_float(rr[1]));
}
__device__ __forceinline__ void pv(f32x16*o,int vb,bf16x8 pa0,bf16x8 pa1,bf16x8 pa2,bf16x8 pa3){
  #pragma unroll
  for(int d0=0;d0<2;++d0){s16x4 lo[4],hi[4];
    #pragma unroll
    for(int ks=0;ks<4;++ks){
      asm volatile("ds_read_b64_tr_b16 %0,%1 offset:%c2":"=&v"(lo[ks]):"v"(vb),"i"(d0*4096+ks*1024):"memory");
      asm volatile("ds_read_b64_tr_b16 %0,%1 offset:%c2":"=&v"(hi[ks]):"v"(vb),"i"(d0*4096+ks*1024+512):"memory");}
    asm volatile("s_waitcnt lgkmcnt(0)":::"memory");SBAR();
    #define PK(k) (bf16x8){lo[k][0],lo[k][1],lo[k][2],lo[k][3],hi[k][0],hi[k][1],hi[k][2],hi[k][3]}
    o[d0]=__builtin_amdgcn_mfma_f32_32x32x16_bf16(pa0,PK(0),o[d0],0,0,0);
    o[d0]=__builtin_amdgcn_mfma_f32_32x32x16_bf16(pa1,PK(1),o[d0],0,0,0);
    o[d0]=__builtin_amdgcn_mfma_f32_32x32x16_bf16(pa2,PK(2),o[d0],0,0,0);
    o[d0]=__builtin_amdgcn_mfma_f32_32x32x16_bf16(pa3,PK(3),o[d0],0,0,0);
    #undef PK
  }
}

#ifndef ATTN_STORE16
#define ATTN_STORE16(p,v) (*(GAS u32x4*)(p)=(v))
#endif
template<int THRL> __device__ __forceinline__ void attn_unit(const bf16*Qw0,int qp,const bf16*__restrict__ Kh,const bf16*__restrict__ Vh,int kvp,int NT,bf16*Ow0,int op,char*shm){
  const int tid=opaque_tid(),lane=tid&63,r32=lane&31,hi=lane>>5; const int wid=__builtin_amdgcn_readfirstlane(tid>>6);
  const bf16*Qw=Qw0+(long)(wid*QBLK)*qp;
  const unsigned lds0=(unsigned)(uintptr_t)shm;
  float*wsf=(float*)(shm+LDS_WS)+wid*64;
  const bf16*ksrc=Kh+(long)lane*kvp+wid*8;
  const bf16*vsrc=Vh+(long)(16*(wid&3)+(lane>>2))*kvp+(wid>>2)*32+(lane&3)*8;
  const unsigned kdst=lds0+LDS_K+wid*1024, vdst=lds0+LDS_V+wid*1024;
  #define DMA_K(t,slot) glds16(ksrc+(long)(t)*KVBLK*kvp,(unsigned)__builtin_amdgcn_readfirstlane(kdst+(slot)))
  #define DMA_V(t,slot) glds16(vsrc+(long)(t)*KVBLK*kvp,(unsigned)__builtin_amdgcn_readfirstlane(vdst+(slot)))
  const int vb0=(int)(lds0+LDS_V)+((lane>>4)&1)*32+(lane&3)*8+(4*hi+((lane&15)>>2))*64;
  const char*Kbase=shm+LDS_K; bf16x8 kf[8];
  const lds_cptr shm3=(lds_cptr)shm; const lds_cptr kp0=shm3+LDS_K+hi*1024+r32*16; const lds_cptr vp0=shm3+LDS_V+((lane>>4)&1)*32+(lane&3)*8+(4*hi+((lane&15)>>2))*64;
  DMA_K(0,0);DMA_V(0,0);DMA_K(1,SLOTB);
  bf16x8 qr[4];
  #pragma unroll
  for(int d0=0;d0<4;++d0)qr[d0]=*(const GAS bf16x8*)(&Qw[(long)r32*qp+d0*16+hi*8]);
  float mhat=0.f,l_reg=0.f;f32x16 o[2];o[0]=f32x16{};o[1]=f32x16{};f32x16 negm=f32x16{};asm volatile("":"+v"(negm));
  #define CMASK(P0,P1,t) do{}while(0)
  bool resc=false;
  #define START(P0,P1) do{ const float rm=rowmax(P0,P1); resc=false; \
    { const float dl=rm; mhat=fadd_s(mhat,dl); \
      _Pragma("unroll") for(int r=0;r<16;++r){P0[r]=fsub_s(P0[r],dl);P1[r]=fsub_s(P1[r],dl);} \
      _Pragma("unroll") for(int r=0;r<16;++r)negm[r]=-mhat; asm volatile("":"+v"(negm)); } \
    _Pragma("unroll") for(int r=0;r<16;++r)P0[r]=__builtin_amdgcn_exp2f(P0[r]); }while(0)
  #define RESC() do{ if(resc){ asm volatile("s_waitcnt lgkmcnt(0)":::"memory"); \
      _Pragma("unroll") for(int d_=0;d_<2;++d_) _Pragma("unroll") for(int r=0;r<16;++r)o[d_][r]*=wsf[crow(r,hi)]; } }while(0)
  f32x16 pA0,pA1,pB0,pB1;
  int sl_prev=0,sl_cur=0,sl_next=SLOTB;
  #define ROT() do{sl_prev=sl_cur;sl_cur=sl_next;sl_next=(sl_next==(NSLOT-1)*SLOTB)?0:sl_next+SLOTB;}while(0)
  DMA_K(2,2*SLOTB);
  WAIT_BAR(3);
  qkt(pA0,pA1,Kbase,qr,negm,r32,hi);asm volatile("s_nop 15\n\ts_nop 7":"+v"(pA0),"+v"(pA1));CMASK(pA0,pA1,0);
  START(pA0,pA1);
  _Pragma("unroll") for(int r=0;r<16;++r)pA1[r]=__builtin_amdgcn_exp2f(pA1[r]);
  WAIT_BAR(0);
  DMA_K(3,0);DMA_V(1,SLOTB);
  ROT();
  kload8(kf,kp0+sl_cur);
  WAIT_BAR(2);
  s16x4 vlo[8],vhi[8]; u32x4 pw0,pw1,pw2,pw3;
  #define PKW(P,B) cvtpk_s(P[B],P[B+1])
  #define PAF(k) __builtin_bit_cast(bf16x8,pw##k)
  #define VFR(i) (bf16x8){vlo[i][0],vlo[i][1],vlo[i][2],vlo[i][3],vhi[i][0],vhi[i][1],vhi[i][2],vhi[i][3]}
  #define PIN(x) asm volatile("":"+v"(x))
  #define MX3(a,b,c) __builtin_fmaxf(__builtin_fmaxf((a),(b)),(c))
  #define GAPA(MF,A0,A1,A2,A3,W0,W1,PW) do{ MF; sacc+=A0; sacc+=A1; sacc+=A2; sacc+=A3; PIN(sacc); W0; W1; PIN(PW); SBAR(); }while(0)
  #define EX(v) __builtin_amdgcn_exp2f(v)
  #define GAPB(MF,X,B) do{ MF; X[B]=EX(X[B]); X[B+1]=EX(X[B+1]); X[B+2]=EX(X[B+2]); X[B+3]=EX(X[B+3]); PIN(X); SBAR(); }while(0)
  #define VRD(i) do{ vlo[i]=vtr(vp_+(((i)>>2)*4096+((i)&3)*1024)); vhi[i]=vtr(vp_+(((i)>>2)*4096+((i)&3)*1024+512)); }while(0)
  #define KRD(G,j) do{ if(G){ kload2(kf,kp0+sl_next,j); SBAR(); } }while(0)
  #define STEP(C0,C1,P0,P1,t,GK,GV,GL) do{ SBAR(); \
    const lds_cptr vp_=vp0+sl_prev; \
    VRD(0); SBAR(); float sacc=(P0[0]+P0[1]); \
    GAPA(C0=__builtin_amdgcn_mfma_f32_32x32x16_bf16(kf[0],qr[0],negm,0,0,0), P0[2],P0[3],P0[4],P0[5],     pw0[0]=PKW(P0,0), pw0[1]=PKW(P0,2), pw0); \
    VRD(4); SBAR(); GAPA(C1=__builtin_amdgcn_mfma_f32_32x32x16_bf16(kf[1],qr[0],negm,0,0,0), P0[6],P0[7],P0[8],P0[9],     pw0[2]=PKW(P0,4), pw0[3]=PKW(P0,6), pw0); \
    VRD(1); SBAR(); GAPA(C0=__builtin_amdgcn_mfma_f32_32x32x16_bf16(kf[2],qr[1],C0,0,0,0),   P0[10],P0[11],P0[12],P0[13], pw1[0]=PKW(P0,8), pw1[1]=PKW(P0,10), pw1); \
    VRD(5); SBAR(); GAPA(C1=__builtin_amdgcn_mfma_f32_32x32x16_bf16(kf[3],qr[1],C1,0,0,0),   P0[14],P0[15],P1[0],P1[1],   pw1[2]=PKW(P0,12),pw1[3]=PKW(P0,14), pw1); \
    VRD(2); SBAR(); GAPA(C0=__builtin_amdgcn_mfma_f32_32x32x16_bf16(kf[4],qr[2],C0,0,0,0),   P1[2],P1[3],P1[4],P1[5],     pw2[0]=PKW(P1,0), pw2[1]=PKW(P1,2), pw2); \
    VRD(6); SBAR(); GAPA(C1=__builtin_amdgcn_mfma_f32_32x32x16_bf16(kf[5],qr[2],C1,0,0,0),   P1[6],P1[7],P1[8],P1[9],     pw2[2]=PKW(P1,4), pw2[3]=PKW(P1,6), pw2); \
    VRD(3); SBAR(); GAPA(C0=__builtin_amdgcn_mfma_f32_32x32x16_bf16(kf[6],qr[3],C0,0,0,0),   P1[10],P1[11],P1[12],P1[13], pw3[0]=PKW(P1,8), pw3[1]=PKW(P1,10), pw3); \
    VRD(7); SBAR(); GAPA(C1=__builtin_amdgcn_mfma_f32_32x32x16_bf16(kf[7],qr[3],C1,0,0,0),   P1[14],P1[15],0.f,0.f,       pw3[2]=PKW(P1,12),pw3[3]=PKW(P1,14), pw3); \
    l_reg+=sacc; \
    if(GK){DMA_K((t)+3,sl_cur);} if(GV){DMA_V((t)+1,sl_next);} \
    CMASK(C0,C1,t); \
    { float a=MX3(C0[0],C0[1],C1[0]),b=MX3(C0[2],C0[3],C1[1]); a=MX3(a,C1[2],C1[3]); \
      _Pragma("unroll") for(int r=4;r<16;r+=4){a=MX3(a,C0[r],C0[r+1]);b=MX3(b,C0[r+2],C0[r+3]);a=MX3(a,C1[r],C1[r+1]);b=MX3(b,C1[r+2],C1[r+3]);} \
      float rm=__builtin_fmaxf(a,b); { auto rr=__builtin_amdgcn_permlane32_swap(__float_as_uint(rm),__float_as_uint(rm),false,false); rm=__builtin_fmaxf(__uint_as_float(rr[0]),__uint_as_float(rr[1])); } \
      resc=false; \
      if(__builtin_expect(__any(rm>(float)THRL),0)){ const float dl=__builtin_fmaxf(rm,0.f); mhat+=dl; \
        _Pragma("unroll") for(int r=0;r<16;++r){C0[r]-=dl;C1[r]-=dl;} \
        _Pragma("unroll") for(int r=0;r<16;++r)negm[r]=-mhat; asm volatile("":"+v"(negm)); \
        const float f=__builtin_amdgcn_exp2f(-dl); l_reg*=f; if(hi==0)wsf[r32]=f; resc=true; } } \
    SBAR(); \
    GAPB(o[0]=__builtin_amdgcn_mfma_f32_32x32x16_bf16(PAF(0),VFR(0),o[0],0,0,0), C0,0); \
    GAPB(o[1]=__builtin_amdgcn_mfma_f32_32x32x16_bf16(PAF(0),VFR(4),o[1],0,0,0), C0,4); \
    KRD(GL,0); GAPB(o[0]=__builtin_amdgcn_mfma_f32_32x32x16_bf16(PAF(1),VFR(1),o[0],0,0,0), C0,8); \
    KRD(GL,1); GAPB(o[1]=__builtin_amdgcn_mfma_f32_32x32x16_bf16(PAF(1),VFR(5),o[1],0,0,0), C0,12); \
    KRD(GL,2); GAPB(o[0]=__builtin_amdgcn_mfma_f32_32x32x16_bf16(PAF(2),VFR(2),o[0],0,0,0), C1,0); \
    KRD(GL,3); GAPB(o[1]=__builtin_amdgcn_mfma_f32_32x32x16_bf16(PAF(2),VFR(6),o[1],0,0,0), C1,4); \
    GAPB(o[0]=__builtin_amdgcn_mfma_f32_32x32x16_bf16(PAF(3),VFR(3),o[0],0,0,0), C1,8); \
    GAPB(o[1]=__builtin_amdgcn_mfma_f32_32x32x16_bf16(PAF(3),VFR(7),o[1],0,0,0), C1,12); \
    }while(0)
  int t=1;
  #undef CMASK
  #define CMASK(P0,P1,t) do{}while(0)
  for(;t+5<NT;t+=2){
    STEP(pB0,pB1,pA0,pA1,t,true,true,true);     WAIT_BAR(2); RESC(); ROT();
    STEP(pA0,pA1,pB0,pB1,t+1,true,true,true);   WAIT_BAR(2); RESC(); ROT();
  }
  #undef CMASK
  #define CMASK(P0,P1,t) do{}while(0)
  #define ENDW(tt) do{ if((tt)+3<NT){WAIT_BAR(2);} else if((tt)+2<NT){WAIT_BAR(1);} else {WAIT_BAR(0);} }while(0)
  for(;t+1<NT;t+=2){
    STEP(pB0,pB1,pA0,pA1,t,(t+3<NT),(t+1<NT),(t+1<NT));       ENDW(t);   RESC(); ROT();
    STEP(pA0,pA1,pB0,pB1,t+1,(t+4<NT),(t+2<NT),(t+2<NT));     ENDW(t+1); RESC(); ROT();
  }
  STEP(pB0,pB1,pA0,pA1,NT-1,false,false,false); RESC();
  { float sacc=pB0[0]+pB0[1]; _Pragma("unroll") for(int r=2;r<16;++r)sacc+=pB0[r]; _Pragma("unroll") for(int r=0;r<16;++r)sacc+=pB1[r]; l_reg+=sacc;
    pw0=(u32x4){PKW(pB0,0),PKW(pB0,2),PKW(pB0,4),PKW(pB0,6)};pw1=(u32x4){PKW(pB0,8),PKW(pB0,10),PKW(pB0,12),PKW(pB0,14)};pw2=(u32x4){PKW(pB1,0),PKW(pB1,2),PKW(pB1,4),PKW(pB1,6)};pw3=(u32x4){PKW(pB1,8),PKW(pB1,10),PKW(pB1,12),PKW(pB1,14)};
    SBAR(); pv(o,vb0+sl_cur,PAF(0),PAF(1),PAF(2),PAF(3)); }
  #undef PKW
  #undef PAF
  #undef VFR
  #undef PIN
  #undef MX3
  #undef GAPA
  #undef GAPB
  #undef EX
  #undef VRD
  #undef KRD
  #undef STEP
  #undef ENDW
  {auto rr=__builtin_amdgcn_permlane32_swap(__float_as_uint(l_reg),__float_as_uint(l_reg),false,false);l_reg=__uint_as_float(rr[0])+__uint_as_float(rr[1]);}
  if(hi==0)wsf[32+r32]=l_reg;asm volatile("s_waitcnt lgkmcnt(0)":::"memory");
  float rli[16];
  #pragma unroll
  for(int r=0;r<16;++r)rli[r]=__builtin_amdgcn_rcpf(wsf[32+crow(r,hi)]);
  bf16*Ow=Ow0+(long)(wid*QBLK)*op;
  { bf16*stg=(bf16*)(shm+LDS_OST)+wid*2048;
    #pragma unroll
    for(int r=0;r<16;++r){const int orow=crow(r,hi);
      #pragma unroll
      for(int d0=0;d0<2;++d0)stg[orow*64+d0*32+r32]=__float2bfloat16(o[d0][r]*rli[r]);}
    asm volatile("s_waitcnt lgkmcnt(0)":::"memory");
    #pragma unroll
    for(int i=0;i<4;++i){const int row=i*8+(lane>>3),ch=lane&7; const u32x4 v=*(const u32x4*)(stg+row*64+ch*8); ATTN_STORE16(Ow+(long)row*op+ch*8,v);} }
  asm volatile("s_waitcnt lgkmcnt(0)\n\ts_barrier":::"memory");
  #undef DMA_K
  #undef DMA_V
  #undef CMASK
  #undef START
  #undef RESC
  #undef ROT
}
#undef SBAR
#undef WAIT_BAR
}

struct AttnArgs { const bf16_t *QG, *QD, *KG, *VG, *KD, *VD, *CB, *PB; bf16_t* MIX; const float* conv_w; const float* conv_b; const float* subln_g; float lam, lam_init; };

__device__ __forceinline__ void attn_gqa_unit(const AttnArgs& A, LAS char* lds, char* lds_generic, int lat, int seq, int qh, int qb) {
    const long R = lat ? 8192L + (long)SLAT * seq : 256L * seq; const int S = lat ? SLAT : 256;
    const size_t grow0 = (lat ? 8192 + (size_t)4096 * seq : (size_t)256 * seq) + 256 * qb;
    const int kvh = qh >> 2;
    int NT = S / 64; asm volatile("" : "+s"(NT));
    typedef attn64::bf16 abf;
    attn64::attn_unit<8>((const abf*)(A.QG + grow0 * 512 + 64 * qh), 512, (const abf*)(A.KG + (R * 2 + (long)kvh * S) * 64), (const abf*)(A.VG + (R * 2 + (long)kvh * S) * 64), 64, NT,
                         (abf*)(A.MIX + grow0 * 1024 + 64 * qh), 1024, lds_generic);
}
__device__ __forceinline__ void attn_diff_unit(const AttnArgs& A, LAS char* lds, int lat, int seq, int hd, int qb) {
    const int tid_ = opaque_tid(); const int wave = __builtin_amdgcn_readfirstlane(tid_ >> 6), lane = tid_ & 63, r32 = lane & 31, h = lane >> 5;
    const long R = lat ? 8192L + (long)SLAT * seq : 256L * seq; const int S = lat ? SLAT : 256;
    const size_t grow0 = (lat ? 8192 + (size_t)4096 * seq : (size_t)256 * seq) + 256 * qb + 32 * wave;
    f32x16 o0[2], o1[2]; float l0, l1;
    const bf16_t* V = A.VD + (R * 4 + (long)hd * S) * 64;
    int NT = S / 64; asm volatile("" : "+s"(NT)); const int tst = (int)((((blockIdx.x >> 3) & 31) * NT) >> 5);
    if (wave < 4) { flash_pass<32, false>(A.QD + grow0 * 256 + 64 * hd, 256, A.KD + (R * 8 + (long)(hd * 2) * S) * 32, V, NT, tst, lds, o0, l0);
        flash_pass<32, false>(A.QD + grow0 * 256 + 64 * hd + 32, 256, A.KD + (R * 8 + (long)(hd * 2 + 1) * S) * 32, V, NT, tst, lds, o1, l1); }
    else { flash_pass<32, true>(A.QD + grow0 * 256 + 64 * hd, 256, A.KD + (R * 8 + (long)(hd * 2) * S) * 32, V, NT, tst, lds, o0, l0);
        flash_pass<32, true>(A.QD + grow0 * 256 + 64 * hd + 32, 256, A.KD + (R * 8 + (long)(hd * 2 + 1) * S) * 32, V, NT, tst, lds, o1, l1); }
    const float i0 = 1.f / l0, i1 = A.lam / l1;
    float ss = 0.f;
#pragma unroll
    for (int db = 0; db < 2; ++db)
#pragma unroll
        for (int r = 0; r < 16; ++r) { const float v = o0[db][r] * i0 - o1[db][r] * i1; o0[db][r] = v; ss += v * v; }
    ss = xhalf_sum(ss);
    const float rstd = rsqrtf(ss * (1.f / 64.f) + EPS) * (1.f - A.lam_init);
#pragma unroll
    for (int db = 0; db < 2; ++db)
#pragma unroll
        for (int g = 0; g < 4; ++g) { const f32x4 g4 = *(const GAS f32x4*)(A.subln_g + 32 * db + 8 * g + 4 * h);
#pragma unroll
            for (int e = 0; e < 4; ++e) o0[db][4 * g + e] *= rstd * g4[e]; }
    store_ot(o0, A.MIX + (grow0 + r32) * 1024 + 768 + 64 * hd, h);
}

__device__ __forceinline__ void attn_phase(const AttnArgs& A, LAS char* lds, char* lds_generic, int G) {
    for (int u = blockIdx.x; u < 1920; u += G) {
        if (u < 512) { const int b = u & 7, r = u >> 3; attn_diff_unit(A, lds, 1, b, r >> 4, r & 15); }
        else if (u < 1536) { const int v = u - 512, b = v & 7, r = v >> 3; attn_gqa_unit(A, lds, lds_generic, 1, b, r & 7, r >> 3); }
        else if (u < 1664) { const int w = u - 1536; attn_diff_unit(A, lds, 0, w >> 2, w & 3, 0); }
        else { const int w = u - 1664; attn_gqa_unit(A, lds, lds_generic, 0, w >> 3, w & 7, 0); }
    }
    const int tid_c = opaque_tid();
    for (int idx = blockIdx.x * 512 + tid_c; idx < M_ALL * 32; idx += G * 512) {
        const int row = idx >> 5, c8 = (idx & 31) * 8;
        int t, S; if (row < M_CTX) { t = row & 255; S = 256; } else { t = (row - M_CTX) & 4095; S = 4096; }
        const u32x4 z = {0, 0, 0, 0};
        const u32x4 pc = *(const GAS u32x4*)(A.PB + (size_t)row * 256 + c8);
        const u32x4 pp = t > 0 ? *(const GAS u32x4*)(A.PB + (size_t)(row - 1) * 256 + c8) : z;
        const u32x4 pn = t < S - 1 ? *(const GAS u32x4*)(A.PB + (size_t)(row + 1) * 256 + c8) : z;
        const u32x4 cb = *(const GAS u32x4*)(A.CB + (size_t)row * 256 + c8);
        float res[8];
#pragma unroll
        for (int j = 0; j < 8; ++j) {
            const int sh = (j & 1) * 16;
            const float a = __uint_as_float(((pp[j >> 1] >> sh) & 0xffffu) << 16), b = __uint_as_float(((pc[j >> 1] >> sh) & 0xffffu) << 16), c = __uint_as_float(((pn[j >> 1] >> sh) & 0xffffu) << 16);
            const float g = __uint_as_float(((cb[j >> 1] >> sh) & 0xffffu) << 16);
            const int cc = c8 + j;
            res[j] = g * (A.conv_w[cc] * a + A.conv_w[256 + cc] * b + A.conv_w[512 + cc] * c + A.conv_b[cc]);
        }
        u32x4 w; w.x = cvtpk(res[0], res[1]); w.y = cvtpk(res[2], res[3]); w.z = cvtpk(res[4], res[5]); w.w = cvtpk(res[6], res[7]);
        *(GAS u32x4*)(A.MIX + (size_t)row * 1024 + 512 + c8) = w;
    }
}

__device__ __forceinline__ int sigma_map(int type, int i) {
    if (type == 1) return 8 * ((i >> 2) & 3) + 4 * (i >> 4) + (i & 3);
    if (type == 2) return 16 * ((i >> 3) & 1) + 8 * (i >> 4) + (i & 7);
    return i;
}
__device__ __forceinline__ void in_group(int g, int& Lbase, int& type) {
    const int pn = g >> 3, bj = (g >> 2) & 1, wc = g & 3;
    if (pn < 2) { Lbase = 64 * (4 * pn + wc) + 32 * bj; type = 0; }
    else if (pn == 2) { Lbase = (wc < 2 ? 512 + 64 * wc : 640 + 64 * (wc - 2)) + 32 * bj; type = 0; }
    else if (pn == 3) { Lbase = 768 + 128 * bj + 32 * wc; type = 1; }
    else if (pn < 6) { Lbase = 1024 + 256 * bj + 128 * (pn - 4) + 32 * wc; type = 1; }
    else if (pn < 8) { Lbase = (pn == 6 ? 1536 : 1792) + 64 * wc + 32 * bj; type = 2; }
    else { Lbase = 2048 + 64 * wc + 32 * bj; type = 1; }
}
__device__ __forceinline__ void transpose_item(const float* W, int K, int N, bf16_t* WT, int k0, int nphys0, int Lbase, int type, LAS float* scr, int lane) {
#pragma unroll 8
    for (int i = 0; i < 32; ++i) { const int kk = 2 * i + (lane >> 5); scr[kk * 33 + (lane & 31)] = ((const GAS float*)W)[(size_t)(k0 + kk) * N + Lbase + (lane & 31)]; }
    asm volatile("s_waitcnt lgkmcnt(0)" ::: "memory");
    const int c = lane & 7;
#pragma unroll
    for (int j = 0; j < 4; ++j) { const int n = (lane >> 3) + 8 * j; const LAS float* s = scr + (8 * c) * 33 + sigma_map(type, n);
        u32x4 o; o.x = cvtpk(s[0 * 33], s[1 * 33]); o.y = cvtpk(s[2 * 33], s[3 * 33]); o.z = cvtpk(s[4 * 33], s[5 * 33]); o.w = cvtpk(s[6 * 33], s[7 * 33]);
        *(GAS u32x4*)(WT + (size_t)(nphys0 + n) * K + k0 + 8 * c) = o; }
    asm volatile("s_waitcnt lgkmcnt(0)" ::: "memory");
}

struct Params {
    const float *x_prompt, *x_sample, *cache_gk, *cache_gv, *cache_dk, *cache_dv, *c, *c_ctx;
    const float *w_mod, *b_mod, *norm1_g, *w_in, *gqa_qn_g, *gqa_kn_g, *conv_w, *conv_b, *diff_qn_g, *diff_kn_g, *diff_lambda, *diff_subln_g, *w_out, *norm2_g, *ffn_up, *ffn_conv_w, *ffn_conv_b, *ffn_down;
    float* out; unsigned char* ws;
    float lam_init[4];
    int ph_lo, ph_hi;
};

__device__ __forceinline__ void prologue(const Params& P, LAS unsigned char* lds, int G) {
    const int tid = opaque_tid(), lane = tid & 63, wave = __builtin_amdgcn_readfirstlane(tid >> 6);
    float* MODS = (float*)(P.ws + WS_MODS); float* MISC = (float*)(P.ws + WS_MISC);
    if ((int)blockIdx.x < 384) {
        LAS float* sc = (LAS float*)lds;
        LAS float* part = (LAS float*)(lds + 49152);
        for (int i = tid; i < NCOND * 1024; i += 512) { const int ci = i >> 10, k = i & 1023; const float v = ci == 0 ? P.c_ctx[k] : P.c[(ci - 1) * 1024 + k]; sc[k * 12 + ci] = v / (1.f + __expf(-v)); }
        __syncthreads();
        for (int it = blockIdx.x; it < 384; it += G) {
            const int l = it / 96, col = (it % 96) * 64 + lane;
            const float* w = P.w_mod + (size_t)l * 1024 * 6144 + col;
            float acc[NCOND];
#pragma unroll
            for (int ci = 0; ci < NCOND; ++ci) acc[ci] = 0.f;
#pragma unroll 8
            for (int kk = 0; kk < 128; ++kk) { const int k = wave * 128 + kk; const float wv = ((const GAS float*)w)[(size_t)k * 6144];
                const f32x4 s0 = *(LAS f32x4*)(sc + k * 12), s1 = *(LAS f32x4*)(sc + k * 12 + 4); const float s8 = sc[k * 12 + 8];
                acc[0] += s0[0] * wv; acc[1] += s0[1] * wv; acc[2] += s0[2] * wv; acc[3] += s0[3] * wv; acc[4] += s1[0] * wv; acc[5] += s1[1] * wv; acc[6] += s1[2] * wv; acc[7] += s1[3] * wv; acc[8] += s8 * wv; }
#pragma unroll
            for (int ci = 0; ci < NCOND; ++ci) part[(wave * NCOND + ci) * 64 + lane] = acc[ci];
            __syncthreads();
            for (int i = tid; i < NCOND * 64; i += 512) { const int ci = i >> 6, cc = i & 63; float s = 0.f;
#pragma unroll
                for (int w8 = 0; w8 < 8; ++w8) s += part[(w8 * NCOND + ci) * 64 + cc];
                const int j = (it % 96) * 64 + cc; MODS[((size_t)l * NCOND + ci) * 6144 + j] = s + P.b_mod[l * 6144 + j]; }
            __syncthreads();
        }
    }
    if ((int)blockIdx.x == G - 1) {
        if (tid < 4) { const float* lf = P.diff_lambda + tid * 128; float s1 = 0.f, s2 = 0.f; for (int i = 0; i < 32; ++i) { s1 += lf[i] * lf[32 + i]; s2 += lf[64 + i] * lf[96 + i]; }
            MISC[MI_LAM + tid] = expf(s1) - expf(s2) + P.lam_init[tid]; }
        for (int i = tid; i < 1024; i += 512) { const int pos = i >> 4, idx = i & 15; const float fr = powf(10000.f, -(float)idx / 16.f); const float ang = (float)pos * fr; MISC[MI_R64C + i] = cosf(ang); MISC[MI_R64S + i] = sinf(ang); }
        for (int i = tid; i < 512; i += 512) { const int pos = i >> 3, idx = i & 7; const float fr = powf(10000.f, -(float)idx / 8.f); const float ang = (float)pos * fr; MISC[MI_R32C + i] = cosf(ang); MISC[MI_R32S + i] = sinf(ang); }
    }
    __syncthreads();
    LAS float* scr = (LAS float*)(lds + wave * 16384);
    const int gw = blockIdx.x * 8 + wave, NGW = G * 8;
    constexpr int I_IN = 16 * 72, I_OUT = 16 * 32, I_UP = 16 * 176, I_DN = 44 * 32, I_L = I_IN + I_OUT + I_UP + I_DN;
    for (int it = gw; it < DEPTH * I_L; it += NGW) {
        const int l = it / I_L; int r = it % I_L;
        if (r < I_IN) { const int kb = r / 72, g = r % 72; int Lb, ty; in_group(g, Lb, ty);
            transpose_item(P.w_in + (size_t)l * 1024 * INW, 1024, INW, (bf16_t*)(P.ws + WS_WIN) + (size_t)l * INW * 1024, kb * 64, g * 32, Lb, ty, scr, lane); continue; }
        r -= I_IN;
        if (r < I_OUT) { const int kb = r / 32, g = r % 32;
            transpose_item(P.w_out + (size_t)l * 1024 * 1024, 1024, 1024, (bf16_t*)(P.ws + WS_WOUT) + (size_t)l * 1024 * 1024, kb * 64, g * 32, g * 32, 0, scr, lane); continue; }
        r -= I_OUT;
        if (r < I_UP) { const int kb = r / 176, g = r % 176; const int pn = g >> 3, bj = (g >> 2) & 1, wc = g & 3;
            transpose_item(P.ffn_up + (size_t)l * 1024 * UPW, 1024, UPW, (bf16_t*)(P.ws + WS_WUP) + (size_t)l * UPW * 1024, kb * 64, g * 32, bj * DFF + 128 * pn + 32 * wc, 1, scr, lane); continue; }
        r -= I_UP;
        { const int kb = r / 32, g = r % 32;
            transpose_item(P.ffn_down + (size_t)l * DFF * 1024, DFF, 1024, (bf16_t*)(P.ws + WS_WDN) + (size_t)l * 1024 * DFF, kb * 64, g * 32, g * 32, 0, scr, lane); }
    }
}

__device__ __forceinline__ void norm_phase(const float* xin_ctx, const float* xin_lat, const float* ng, const float* mods_l  , int sh_idx, bf16_t* XN, int G) {
    const int tid_ = opaque_tid(); const int lane = tid_ & 63, wave = __builtin_amdgcn_readfirstlane(tid_ >> 6);
    const int nw = G * 8, gw = blockIdx.x * 8 + wave;
    const int per = (M_ALL + nw - 1) / nw;
    const int r0 = gw * per, r1 = min(r0 + per, M_ALL);
    int cur_ci = -1; f32x4 Aa[4], Bb[4];
    for (int row = r0; row < r1; ++row) {
        const int ci = row < M_CTX ? 0 : 1 + ((row - M_CTX) >> 12);
        if (ci != cur_ci) { cur_ci = ci; const float* sh = mods_l + ci * 6144 + sh_idx * 1024; const float* sc = sh + 1024;
#pragma unroll
            for (int j = 0; j < 4; ++j) { const int c = 4 * lane + 256 * j; const f32x4 g4 = *(const GAS f32x4*)(ng + c), s4 = *(const GAS f32x4*)(sc + c); Aa[j] = g4 * (1.f + s4); Bb[j] = *(const GAS f32x4*)(sh + c); } }
        const float* xr = row < M_CTX ? xin_ctx + (size_t)row * DM : xin_lat + (size_t)(row - M_CTX) * DM;
        f32x4 v[4]; float s = 0.f;
#pragma unroll
        for (int j = 0; j < 4; ++j) { v[j] = *(const GAS f32x4*)(xr + 4 * lane + 256 * j); s += (v[j][0] * v[j][0] + v[j][1] * v[j][1]) + (v[j][2] * v[j][2] + v[j][3] * v[j][3]); }
#pragma unroll
        for (int o = 1; o < 64; o <<= 1) s += __shfl_xor(s, o);
        const float rstd = rsqrtf(s * (1.f / DM) + EPS);
#pragma unroll
        for (int j = 0; j < 4; ++j) { const f32x4 y = v[j] * rstd * Aa[j] + Bb[j]; u32x2 w; w.x = cvtpk(y[0], y[1]); w.y = cvtpk(y[2], y[3]); *(GAS u32x2*)(XN + (size_t)row * DM + 4 * lane + 256 * j) = w; }
    }
}

__device__ __forceinline__ void cache_phase(const Params& P, int l, int G) {
    bf16_t* KG = (bf16_t*)(P.ws + WS_KG); bf16_t* VG = (bf16_t*)(P.ws + WS_VG); bf16_t* KD = (bf16_t*)(P.ws + WS_KD); bf16_t* VD = (bf16_t*)(P.ws + WS_VD);
    const int tid_ = opaque_tid();
    for (int i = blockIdx.x * 512 + tid_; i < 65536; i += G * 512) {
        const int d4 = (i & 15) * 4, kvh = (i >> 4) & 1, p = (i >> 5) & 255, b = i >> 13;
        const size_t src = ((((size_t)b * 4 + l) * 256 + p) * 2 + kvh) * 64 + d4;
        const size_t dst = (((8192L + (long)SLAT * b) * 2 + (long)kvh * SLAT + 4096 + p) * 64) + d4;
        const f32x4 k = *(const GAS f32x4*)(P.cache_gk + src), v = *(const GAS f32x4*)(P.cache_gv + src);
        u32x2 wk, wv; wk.x = cvtpk(k[0], k[1]); wk.y = cvtpk(k[2], k[3]); wv.x = cvtpk(v[0], v[1]); wv.y = cvtpk(v[2], v[3]);
        *(GAS u32x2*)(KG + dst) = wk; *(GAS u32x2*)(VG + dst) = wv;
    }
    for (int i = blockIdx.x * 512 + tid_; i < 131072; i += G * 512) {
        { const int d4 = (i & 7) * 4, hc = (i >> 3) & 7, p = (i >> 6) & 255, b = i >> 14;
          const size_t src = ((((size_t)b * 4 + l) * 256 + p) * 8 + hc) * 32 + d4;
          const size_t dst = (((8192L + (long)SLAT * b) * 8 + (long)hc * SLAT + 4096 + p) * 32) + d4;
          const f32x4 k = *(const GAS f32x4*)(P.cache_dk + src); u32x2 w; w.x = cvtpk(k[0], k[1]); w.y = cvtpk(k[2], k[3]); *(GAS u32x2*)(KD + dst) = w; }
        { const int d4 = (i & 15) * 4, hh = (i >> 4) & 3, p = (i >> 6) & 255, b = i >> 14;
          const size_t src = ((((size_t)b * 4 + l) * 256 + p) * 4 + hh) * 64 + d4;
          const size_t dst = (((8192L + (long)SLAT * b) * 4 + (long)hh * SLAT + 4096 + p) * 64) + d4;
          const f32x4 v = *(const GAS f32x4*)(P.cache_dv + src); u32x2 w; w.x = cvtpk(v[0], v[1]); w.y = cvtpk(v[2], v[3]); *(GAS u32x2*)(VD + dst) = w; }
    }
}

__device__ __forceinline__ void fixup_phase(const float* cw, bf16_t* F, const float* EP, const float* EA, const float* EU, int G) {
    const int tid_ = opaque_tid();
    for (int i = blockIdx.x * 512 + tid_; i < 128 * 2 * DFF; i += G * 512) {
        const int c = i % DFF, e = (i / DFF) & 1, pm = 32 + i / (2 * DFF); const int j = (pm - 32) & 15;
        if (e == 0 ? j == 0 : j == 15) continue;
        const size_t eo = ((size_t)pm * 2 + e) * DFF + c;
        float conv;
        if (e == 0) conv = EP[eo] + cw[c] * EA[((size_t)(pm - 1) * 2 + 1) * DFF + c];
        else conv = EP[eo] + cw[2 * DFF + c] * EA[((size_t)(pm + 1) * 2 + 0) * DFF + c];
        const float f = silu_f(conv) * EU[eo];
        const size_t row = (size_t)pm * 256 + (e ? 255 : 0);
        F[row * DFF + c] = (bf16_t)(cvtpk(f, 0.f) & 0xffffu);
    }
}


#define XB_TMO      128
#define XB_XCNT(j)  (256  + 64 * (j))
#define XB_XSUB(j)  (1280 + 64 * (j))
#define XB_XGEN(j)  (2304 + 64 * (j))
#define XB_TOP      3328
#define XB_TOPGEN   3392
#define XCD_BAR_WORDS 3456
#define XB_SPIN_CAP (1u << 22)
__device__ __forceinline__ unsigned xb_ld(unsigned* p)              { return __hip_atomic_load(p, __ATOMIC_RELAXED, __HIP_MEMORY_SCOPE_AGENT); }
__device__ __forceinline__ unsigned xb_add(unsigned* p, unsigned v) { return __hip_atomic_fetch_add(p, v, __ATOMIC_RELAXED, __HIP_MEMORY_SCOPE_AGENT); }
__device__ __forceinline__ unsigned xb_xcc_id() { return (unsigned)__builtin_amdgcn_s_getreg((3 << 11) | 20) & 0xFu; }
#define XB_SPIN(cond, bar) do { unsigned _sp = 0; while (cond) { __builtin_amdgcn_s_sleep(1); \
    if ((++_sp & 255u) == 0u) { if (xb_ld(&(bar)[XB_TMO])) break; if (_sp > XB_SPIN_CAP) { atomicAdd(&(bar)[XB_TMO], 1u); break; } } } } while (0)
struct XcdBarrier { unsigned* bar; unsigned x; volatile LAS unsigned* st; };
__device__ __forceinline__ XcdBarrier xcd_barrier_post(unsigned* bar, volatile LAS unsigned* st) {
    XcdBarrier b; b.bar = bar; b.x = xb_xcc_id(); b.st = st;
    if (threadIdx.x == 0) (void)xb_add(&bar[XB_XCNT(b.x)], 1u);
    return b;
}
__device__ __forceinline__ void xcd_barrier_complete(unsigned* bar, unsigned x, unsigned& nloc, unsigned& nx) {
    const unsigned G = gridDim.x * gridDim.y * gridDim.z;
    unsigned sum, cnt, mine, sp = 0u;
    for (;;) {
        sum = 0u; cnt = 0u; mine = 0u;
#pragma unroll
        for (unsigned j = 0; j < 16; ++j) { const unsigned c = xb_ld(&bar[XB_XCNT(j)]); sum += c; cnt += (c > 0u) ? 1u : 0u; mine = (j == x) ? c : mine; }
        if (sum == G) break;
        __builtin_amdgcn_s_sleep(1);
        if ((++sp & 255u) == 0u) { if (xb_ld(&bar[XB_TMO])) break; if (sp > XB_SPIN_CAP) { atomicAdd(&bar[XB_TMO], 1u); break; } }
    }
    nloc = mine > 0u ? mine : 1u; nx = cnt > 0u ? cnt : 1u;
}
__device__ __forceinline__ void xcd_barrier(const XcdBarrier& b) {
    asm volatile("s_waitcnt vmcnt(0)" ::: "memory");
    __syncthreads();
    if (threadIdx.x == 0) {
        unsigned* bar = b.bar;
        __builtin_amdgcn_s_waitcnt(0);
        unsigned nloc = b.st[0], nx = b.st[1];
        if (nloc == 0u) { xcd_barrier_complete(bar, b.x, nloc, nx); b.st[0] = nloc; b.st[1] = nx; }
        const unsigned old = xb_add(&bar[XB_XSUB(b.x)], 1u);
        const unsigned gen = old / nloc;
        if (old + 1u == (gen + 1u) * nloc) {
            __builtin_amdgcn_fence(__ATOMIC_RELEASE, "agent");
            asm volatile("s_waitcnt vmcnt(0)" ::: "memory");
            const unsigned og = xb_add(&bar[XB_TOP], 1u);
            const unsigned tg = og / nx;
            if (og + 1u == (tg + 1u) * nx) xb_add(&bar[XB_TOPGEN], 1u);
            else XB_SPIN(xb_ld(&bar[XB_TOPGEN]) == tg, bar);
            __builtin_amdgcn_fence(__ATOMIC_ACQUIRE, "agent");
            xb_add(&bar[XB_XGEN(b.x)], 1u);
            asm volatile("s_waitcnt vmcnt(0)" ::: "memory");
        } else {
            XB_SPIN(xb_ld(&bar[XB_XGEN(b.x)]) == gen, bar);
            __builtin_amdgcn_fence(__ATOMIC_ACQUIRE, "agent");
            asm volatile("s_waitcnt vmcnt(0)" ::: "memory");
        }
    }
    __syncthreads();
}

__global__ void __launch_bounds__(512, 2) fwd_kernel(Params P) {
    extern __shared__ __attribute__((aligned(16))) unsigned char lds_raw[];
    LAS unsigned char* lds = (LAS unsigned char*)lds_raw;
    cg::grid_group grid = cg::this_grid();
    const int G = gridDim.x;
    volatile LAS unsigned* bst = (volatile LAS unsigned*)(lds + MISC_OFF);
    if (threadIdx.x < 2) bst[threadIdx.x] = 0u;
    __syncthreads();
    XcdBarrier bar = xcd_barrier_post((unsigned*)(P.ws + WS_CTL), bst);
    int ph = 0;
#define PHASE_BEGIN if (ph >= P.ph_lo && ph < P.ph_hi) { unsigned char* ws = P.ws; float* outp = P.out; asm volatile("" : "+s"(ws), "+s"(outp));
#define PHASE_END   if (ph + 1 < P.ph_hi) { if (ph == 0) grid.sync(); else xcd_barrier(bar); } } ++ph;
    PHASE_BEGIN
#ifndef SKIP_PRO
        prologue(P, lds, G);
#endif
    PHASE_END
    for (int l = 0; l < DEPTH; ++l) {
        PHASE_BEGIN
            const float* xin_ctx = l == 0 ? P.x_prompt : outp; const float* xin_lat = l == 0 ? P.x_sample : outp + (size_t)M_CTX * DM;
            norm_phase(xin_ctx, xin_lat, P.norm1_g + l * DM, (const float*)(ws + WS_MODS) + (size_t)l * NCOND * 6144, 0, (bf16_t*)(ws + WS_XN), G);
            cache_phase(P, l, G);
        PHASE_END
        PHASE_BEGIN {
            const float* MISC = (const float*)(ws + WS_MISC);
            pg8::Gemm g{(const bf16_t*)(ws + WS_XN), (const bf16_t*)(ws + WS_WIN) + (size_t)l * INW * 1024, M_ALL, INW, 1024}; pg8::StaticOrder S; S.init(M_ALL, INW, G, blockIdx.x);
            EpiIn E{l, P.gqa_qn_g + l * 64, P.gqa_kn_g + l * 64, P.diff_qn_g + l * 32, P.diff_kn_g + l * 32, MISC + MI_R64C, MISC + MI_R64S, MISC + MI_R32C, MISC + MI_R32S,
                    (bf16_t*)(ws + WS_QG), (bf16_t*)(ws + WS_QD), (bf16_t*)(ws + WS_KG), (bf16_t*)(ws + WS_VG), (bf16_t*)(ws + WS_KD), (bf16_t*)(ws + WS_VD), (bf16_t*)(ws + WS_CB), (bf16_t*)(ws + WS_PB), outp};
#ifndef SKIP_IN
            pg8::gemm_phase(lds, lds + XCH_OFF, g, S, E);
#endif
        } PHASE_END
        PHASE_BEGIN {
            const float* MISC = (const float*)(ws + WS_MISC);
            AttnArgs A{(const bf16_t*)(ws + WS_QG), (const bf16_t*)(ws + WS_QD), (const bf16_t*)(ws + WS_KG), (const bf16_t*)(ws + WS_VG), (const bf16_t*)(ws + WS_KD), (const bf16_t*)(ws + WS_VD),
                       (const bf16_t*)(ws + WS_CB), (const bf16_t*)(ws + WS_PB), (bf16_t*)(ws + WS_XN), P.conv_w + l * 768, P.conv_b + l * 256, P.diff_subln_g + l * 64, MISC[MI_LAM + l], P.lam_init[l]};
#ifndef SKIP_ATT
            attn_phase(A, (LAS char*)lds, (char*)lds_raw, G);
#endif
        } PHASE_END
        PHASE_BEGIN {
            const float* xin_ctx = l == 0 ? P.x_prompt : outp; const float* xin_lat = l == 0 ? P.x_sample : outp + (size_t)M_CTX * DM;
            pg8::Gemm g{(const bf16_t*)(ws + WS_XN), (const bf16_t*)(ws + WS_WOUT) + (size_t)l * 1024 * 1024, M_ALL, 1024, 1024}; pg8::StaticOrder S; S.init(M_ALL, 1024, G, blockIdx.x);
            EpiRes E{xin_ctx, xin_lat, outp, (const float*)(ws + WS_MODS) + (size_t)l * NCOND * 6144 + 2 * 1024};
#ifndef SKIP_RES
            pg8::gemm_phase(lds, lds + XCH_OFF, g, S, E);
#endif
        } PHASE_END
        PHASE_BEGIN
            norm_phase(outp, outp + (size_t)M_CTX * DM, P.norm2_g + l * DM, (const float*)(ws + WS_MODS) + (size_t)l * NCOND * 6144, 3, (bf16_t*)(ws + WS_XN), G);
        PHASE_END
        PHASE_BEGIN {
            float* EPb = (float*)(ws + WS_EDGE);
            pg8::Gemm g{(const bf16_t*)(ws + WS_XN), (const bf16_t*)(ws + WS_WUP) + (size_t)l * UPW * 1024, M_ALL, UPW, 1024}; pg8::StaticOrder S; S.init(M_ALL, UPW, G, blockIdx.x);
            EpiUp E{P.ffn_conv_w + (size_t)l * 3 * DFF, P.ffn_conv_b + (size_t)l * DFF, (bf16_t*)(ws + WS_U), EPb, EPb + EDGE_ELEMS, EPb + 2 * EDGE_ELEMS};
#ifndef SKIP_UP
            pg8::gemm_phase(lds, lds + XCH_OFF, g, S, E);
#endif
        } PHASE_END
        PHASE_BEGIN {
            float* EPb = (float*)(ws + WS_EDGE);
            fixup_phase(P.ffn_conv_w + (size_t)l * 3 * DFF, (bf16_t*)(ws + WS_U), EPb, EPb + EDGE_ELEMS, EPb + 2 * EDGE_ELEMS, G);
        } PHASE_END
        PHASE_BEGIN {
            pg8::Gemm g{(const bf16_t*)(ws + WS_U), (const bf16_t*)(ws + WS_WDN) + (size_t)l * 1024 * DFF, M_ALL, 1024, DFF}; pg8::StaticOrder S; S.init(M_ALL, 1024, G, blockIdx.x);
            EpiRes E{outp, outp + (size_t)M_CTX * DM, outp, (const float*)(ws + WS_MODS) + (size_t)l * NCOND * 6144 + 5 * 1024};
#ifndef SKIP_RES
            pg8::gemm_phase(lds, lds + XCH_OFF, g, S, E);
#endif
        } PHASE_END
    }
}

constexpr int N_PHASES = 1 + DEPTH * 8;
#ifndef N_LAUNCH_SPLIT
#define N_LAUNCH_SPLIT 0
#endif

extern "C" void kernel_launch(void* const* d_in, const int* in_sizes, int n_in, void* d_out, int out_size, void* d_ws, size_t ws_size, hipStream_t stream) {
    static int grid = 0;
    if (grid == 0) {
        if (n_in != 26 || ws_size < WS_END) { fprintf(stderr, "kernel_launch: unexpected n_in %d or ws_size %zu (< %zu)\n", n_in, ws_size, (size_t)WS_END); grid = -1; return; }
        int dev = 0, cus = 0, per_cu = 0;
        hipGetDevice(&dev); hipDeviceGetAttribute(&cus, hipDeviceAttributeMultiprocessorCount, dev);
        hipFuncSetAttribute((const void*)fwd_kernel, hipFuncAttributeMaxDynamicSharedMemorySize, LDS_BYTES);
        hipOccupancyMaxActiveBlocksPerMultiprocessor(&per_cu, (const void*)fwd_kernel, 512, LDS_BYTES);
        if (per_cu < 1) { fprintf(stderr, "kernel_launch: occupancy query gives %d\n", per_cu); per_cu = 1; }
        (void)hipGetLastError();
        grid = cus * 1;
    }
    if (grid < 0) return;
    Params p{};
    const float** pp = (const float**)&p;
    for (int i = 0; i < 26; ++i) pp[i] = (const float*)d_in[i];
    p.out = (float*)d_out; p.ws = (unsigned char*)d_ws;
    for (int l = 0; l < 4; ++l) p.lam_init[l] = (float)(0.8 - 0.6 * exp(-0.3 * (double)l));
#if N_LAUNCH_SPLIT
    for (int ph = 0; ph < N_PHASES; ++ph) { p.ph_lo = ph; p.ph_hi = ph + 1; hipLaunchKernelGGL(fwd_kernel, dim3(grid), dim3(512), LDS_BYTES, stream, p); }
#else
    p.ph_lo = 0; p.ph_hi = N_PHASES;
    if (hipMemsetAsync((char*)d_ws + WS_CTL, 0, CTL_ZERO_BYTES, stream) != hipSuccess) { fprintf(stderr, "kernel_launch: memset failed\n"); return; }
    void* args[] = {&p};
    hipError_t e = hipLaunchCooperativeKernel((const void*)fwd_kernel, dim3(grid), dim3(512), args, LDS_BYTES, stream);
    if (e != hipSuccess) fprintf(stderr, "cooperative launch failed: %s (grid %d)\n", hipGetErrorString(e), grid);
#endif
}
```

```cpp
#include <hip/hip_runtime.h>
#include <hip/hip_cooperative_groups.h>
#include <cstdio>
#include <cstdint>
#include <cmath>
namespace cg = cooperative_groups;

#define LAS __attribute__((address_space(3)))
#define GAS __attribute__((address_space(1)))
typedef unsigned short bf16_t;
typedef short bf16x8 __attribute__((ext_vector_type(8)));
typedef short s16x4 __attribute__((ext_vector_type(4)));
typedef float f32x4 __attribute__((ext_vector_type(4)));
typedef float f32x16 __attribute__((ext_vector_type(16)));
typedef unsigned u32x4 __attribute__((ext_vector_type(4)));
typedef unsigned u32x2 __attribute__((ext_vector_type(2)));
typedef float f32x2 __attribute__((ext_vector_type(2)));
typedef __bf16 bf16x2_t __attribute__((ext_vector_type(2)));

__device__ __forceinline__ unsigned cvtpk(float lo, float hi) { f32x2 v = {lo, hi}; bf16x2_t b = __builtin_convertvector(v, bf16x2_t); return __builtin_bit_cast(unsigned, b); }
__device__ __forceinline__ int opaque_tid() { int t = threadIdx.x; asm volatile("" : "+v"(t)); return t; }
__device__ __forceinline__ float bf2f(unsigned short u) { return __uint_as_float(((unsigned)u) << 16); }

constexpr int DM = 1024, DEPTH = 4, NCOND = 9;
constexpr int M_CTX = 8192, M_ALL = 40960, NTM = 160;
constexpr int INW = 2304, DFF = 2816, UPW = 5632;
constexpr int SLAT = 4352;
constexpr float EPS = 1e-6f;
constexpr float LOG2E = 1.4426950408889634f;
constexpr float QSCALE_G = 0.125f * LOG2E;
constexpr float QSCALE_D = 0.17677669529663687f * LOG2E;
constexpr size_t OUT_GK = 41943040, OUT_GV = OUT_GK + 4194304, OUT_DK = OUT_GV + 4194304, OUT_DV = OUT_DK + 8388608;
constexpr size_t MiB = 1u << 20;
constexpr size_t WS_MODS = 1 * MiB;
constexpr size_t WS_MISC = 2 * MiB;
constexpr size_t WS_EDGE = 3 * MiB;
constexpr size_t EDGE_ELEMS = (size_t)NTM * 2 * DFF;
constexpr size_t WS_WIN = 16 * MiB;
constexpr size_t WS_WOUT = 34 * MiB;
constexpr size_t WS_WUP = 42 * MiB;
constexpr size_t WS_WDN = 86 * MiB;
constexpr size_t WS_XN = 108 * MiB;
constexpr size_t WS_U = 188 * MiB;
constexpr size_t WS_QG = WS_U, WS_QD = WS_QG + (size_t)M_ALL * 512 * 2, WS_KG = WS_QD + (size_t)M_ALL * 256 * 2;
constexpr size_t KROWS = 8192 + 8 * SLAT;
constexpr size_t WS_VG = WS_KG + KROWS * 128 * 2, WS_KD = WS_VG + KROWS * 128 * 2, WS_VD = WS_KD + KROWS * 256 * 2;
constexpr size_t WS_CB = WS_VD + KROWS * 256 * 2, WS_PB = WS_CB + (size_t)M_ALL * 256 * 2, WS_UEND = WS_PB + (size_t)M_ALL * 256 * 2;
constexpr size_t WS_DSCR = WS_U + (size_t)M_ALL * DFF * 2;
constexpr size_t WS_END = WS_DSCR + 32 * MiB;
static_assert(WS_UEND <= WS_DSCR, "union");
constexpr int MI_LAM = 0, MI_R64C = 64, MI_R64S = MI_R64C + 1024, MI_R32C = MI_R64S + 1024, MI_R32S = MI_R32C + 512;

constexpr int RING_BYTES = 131072, XCH_OFF = RING_BYTES, MISC_OFF = RING_BYTES + 4096, LDS_BYTES = RING_BYTES + 4096 + 256;
constexpr size_t WS_CTL = 0, CTL_ZERO_BYTES = 65536;

struct TileInfo {
    int lat, seq, t0, ci, S; long R;
    __device__ __forceinline__ TileInfo(int pm) {
        if (pm < 32) { lat = 0; seq = pm; t0 = 0; ci = 0; S = 256; R = 256L * pm; }
        else { const int b = (pm - 32) >> 4; lat = 1; seq = b; t0 = ((pm - 32) & 15) * 256; ci = 1 + b; S = SLAT; R = 8192L + (long)SLAT * b; }
    }
};

namespace pg8 {
constexpr int BM = 256, BK = 64, HALF = 128, HTB = HALF * BK * 2, NXCD = 8, WGM = 8;
__host__ __device__ __forceinline__ int lds_byte(int r, int c) { const int st = (r >> 4) * 2 + (c >> 5), rr = r & 15, cc = c & 31, ob = rr * 64 + cc * 2; return st * 1024 + (ob ^ (((ob >> 9) & 1) << 5)); }
__host__ __device__ __forceinline__ void stage_rc(int b, int& R, int& C) { const int st = b / 1024, sb = b % 1024, swz = sb ^ (((sb >> 9) & 1) << 5); R = (st >> 1) * 16 + swz / 64; C = (st & 1) * 32 + (swz % 64) / 2; }
struct Unit { int pm, pn; };
struct Gemm { const bf16_t* A; const bf16_t* Bt; int M, N, K; };
struct StaticOrder {
    int nM, nN, nwg, G, c;
    __device__ void init(int M, int N, int G_, int c_) { nM = M / BM; nN = N / BM; nwg = nM * nN; G = G_; c = c_; }
    __device__ bool next(int i, Unit& u) const {
        const long L = (long)i * G + c; if (L >= nwg) return false;
        int wgid = (int)L; { const int q = nwg / NXCD, r = nwg % NXCD, xcd = wgid % NXCD, off = wgid / NXCD; wgid = (xcd < r ? xcd * (q + 1) : r * (q + 1) + (xcd - r) * q) + off; }
        const int nig = WGM * nN, gid = wgid / nig, fm = gid * WGM, gsz = (nM - fm) < WGM ? (nM - fm) : WGM;
        u.pm = fm + ((wgid % nig) % gsz); u.pn = (wgid % nig) / gsz; return true;
    }
};
template <class Epi>
__device__ __forceinline__ void gemm_phase(LAS unsigned char* lds, LAS unsigned char* xlds, const Gemm g, const StaticOrder& S, const Epi& E) {
    const int tid = opaque_tid(), wid = __builtin_amdgcn_readfirstlane(tid >> 6), lane = tid & 63, wr = wid >> 2, wc = wid & 3, fr = lane & 15, fq = lane >> 4;
    const int K = g.K, nt = K / BK;
    unsigned voffA[2];
#pragma unroll
    for (int i = 0; i < 2; ++i) { int R, C; stage_rc(tid * 16 + i * 8192, R, C); voffA[i] = (unsigned)(R * K + C) * 2u; }
    const size_t kstep = (size_t)(BK * 2);
    const size_t hstep = (size_t)HALF * K * 2;
    const size_t tstep = 2 * hstep;
    const unsigned ldsw = (unsigned)wid * 1024u;
    const int aoff = lds_byte(wr * 64 + fr, fq * 8), boff = lds_byte(wc * 32 + fr, fq * 8);
#define PG8_SA(b, h) (((b) * 2 + (h)) * HTB)
#define PG8_SB(b, h) ((4 + (b) * 2 + (h)) * HTB)
#define PG8_STAGE(bufoff, gbase) do { _Pragma("unroll") for (int _i = 0; _i < 2; ++_i) \
        __builtin_amdgcn_global_load_lds((const unsigned*)((const char*)(gbase) + voffA[_i]), (LAS unsigned*)(lds + (bufoff) + ldsw + _i * 8192), 16, 0, 0); } while (0)
#define PG8_LDA(dst, b, h) do { _Pragma("unroll") for (int m = 0; m < 4; ++m) _Pragma("unroll") for (int k = 0; k < 2; ++k) dst[m][k] = *(const LAS bf16x8*)(lds + PG8_SA(b, h) + aoff + m * 2048 + k * 1024); } while (0)
#define PG8_LDB(dst, b, h) do { _Pragma("unroll") for (int n = 0; n < 2; ++n) _Pragma("unroll") for (int k = 0; k < 2; ++k) dst[n][k] = *(const LAS bf16x8*)(lds + PG8_SB(b, h) + boff + n * 2048 + k * 1024); } while (0)
#define PG8_MMA(ai, bj, At, Bt) do { __builtin_amdgcn_s_setprio(1); _Pragma("unroll") for (int m = 0; m < 4; ++m) _Pragma("unroll") for (int n = 0; n < 2; ++n) _Pragma("unroll") for (int k = 0; k < 2; ++k) \
        acc[ai][bj][m][n] = __builtin_amdgcn_mfma_f32_16x16x32_bf16(Bt[n][k], At[m][k], acc[ai][bj][m][n], 0, 0, 0); __builtin_amdgcn_s_setprio(0); } while (0)
#define PG8_WAIT_V(n) asm volatile("s_waitcnt vmcnt(" #n ")" ::: "memory")
#define PG8_WAIT_L(n) asm volatile("s_waitcnt lgkmcnt(" #n ")" ::: "memory")
#define PG8_BAR __builtin_amdgcn_s_barrier()
#define PG8_SCHED __builtin_amdgcn_sched_barrier(0)
    Unit cur, nxt; int ui = 0;
    if (!S.next(0, cur)) return;
    f32x4 acc[2][2][4][2];
#pragma unroll
    for (int a = 0; a < 2; ++a)
#pragma unroll
        for (int b = 0; b < 2; ++b)
#pragma unroll
            for (int m = 0; m < 4; ++m)
#pragma unroll
                for (int n = 0; n < 2; ++n) acc[a][b][m][n] = (f32x4){0.f, 0.f, 0.f, 0.f};
    bf16x8 At[4][2], B0[2][2], B1[2][2];
    const char* cA = (const char*)g.A + (size_t)cur.pm * tstep; const char* cB = (const char*)g.Bt + (size_t)cur.pn * tstep;
    PG8_STAGE(PG8_SB(0, 0), cB); PG8_STAGE(PG8_SB(0, 1), cB + hstep); PG8_STAGE(PG8_SA(0, 0), cA); PG8_STAGE(PG8_SA(0, 1), cA + hstep);
    if (wr == 1) PG8_BAR;
    PG8_WAIT_V(2); PG8_BAR;
    PG8_STAGE(PG8_SB(1, 0), cB + kstep); PG8_STAGE(PG8_SA(1, 0), cA + kstep); PG8_STAGE(PG8_SB(1, 1), cB + hstep + kstep);
    PG8_WAIT_V(6); PG8_BAR;
    for (;;) {
        const bool has_next = S.next(ui + 1, nxt);
        const char* nA = has_next ? (const char*)g.A + (size_t)nxt.pm * tstep : cA; const char* nB = has_next ? (const char*)g.Bt + (size_t)nxt.pn * tstep : cB;
        for (int t = 0; t < nt; t += 2) {
            const bool last = (t == nt - 2);
            const char* a1 = cA + (size_t)(t + 1) * kstep;
            const char* a2 = last ? nA : cA + (size_t)(t + 2) * kstep; const char* b2 = last ? nB : cB + (size_t)(t + 2) * kstep;
            const char* a3 = a2 + kstep; const char* b3 = b2 + kstep;
            PG8_LDB(B0, 0, 0); PG8_LDB(B1, 0, 1); PG8_SCHED; PG8_LDA(At, 0, 0); PG8_STAGE(PG8_SA(1, 1), a1 + hstep);
            PG8_WAIT_V(8); PG8_WAIT_L(0); PG8_BAR; PG8_MMA(0, 0, At, B0); PG8_MMA(0, 1, At, B1); PG8_BAR; PG8_SCHED;
            PG8_LDA(At, 0, 1); PG8_STAGE(PG8_SB(0, 0), b2); PG8_STAGE(PG8_SB(0, 1), b2 + hstep); PG8_STAGE(PG8_SA(0, 0), a2);
            PG8_WAIT_V(8); PG8_WAIT_L(0); PG8_BAR; PG8_MMA(1, 0, At, B0); PG8_MMA(1, 1, At, B1); PG8_BAR; PG8_SCHED;
            PG8_LDB(B0, 1, 0); PG8_LDB(B1, 1, 1); PG8_SCHED; PG8_LDA(At, 1, 0); PG8_STAGE(PG8_SA(0, 1), a2 + hstep);
            PG8_WAIT_V(8); PG8_WAIT_L(0); PG8_BAR; PG8_MMA(0, 0, At, B0); PG8_MMA(0, 1, At, B1); PG8_BAR; PG8_SCHED;
            PG8_LDA(At, 1, 1); PG8_STAGE(PG8_SB(1, 0), b3); PG8_STAGE(PG8_SB(1, 1), b3 + hstep); PG8_STAGE(PG8_SA(1, 0), a3);
            PG8_WAIT_V(8); PG8_WAIT_L(0); PG8_BAR; PG8_MMA(1, 0, At, B0); PG8_MMA(1, 1, At, B1); PG8_BAR; PG8_SCHED;
        }
        if (wr == 0) PG8_BAR;
        { int fr_ = fr, fq_ = fq; asm volatile("" : "+v"(fr_), "+v"(fq_)); E(acc, cur, wr, wc, fr_, fq_, xlds); }
        if (!has_next) break;
#pragma unroll
        for (int a = 0; a < 2; ++a)
#pragma unroll
            for (int b = 0; b < 2; ++b)
#pragma unroll
                for (int m = 0; m < 4; ++m)
#pragma unroll
                    for (int n = 0; n < 2; ++n) acc[a][b][m][n] = (f32x4){0.f, 0.f, 0.f, 0.f};
        cur = nxt; cA = nA; cB = nB; ++ui;
        if (wr == 1) PG8_BAR;
    }
    PG8_WAIT_V(0);
    PG8_BAR;
#undef PG8_SA
#undef PG8_SB
#undef PG8_STAGE
#undef PG8_LDA
#undef PG8_LDB
#undef PG8_MMA
#undef PG8_WAIT_V
#undef PG8_WAIT_L
#undef PG8_BAR
#undef PG8_SCHED
}
}

typedef f32x4 Acc[2][2][4][2];

struct EpiRes {
    const float* xin_ctx; const float* xin_lat; float* xout; const float* gate;
    __device__ __forceinline__ void operator()(const Acc& acc, const pg8::Unit& u, int wr, int wc, int fr, int fq, LAS unsigned char*) const {
        const TileInfo ti(u.pm);
        const int col0 = u.pn * 256 + wc * 32 + 4 * fq;
        const float* gp = gate + ti.ci * 6144 + col0;
        f32x4 g4[2][2];
#pragma unroll
        for (int bj = 0; bj < 2; ++bj)
#pragma unroll
            for (int n = 0; n < 2; ++n) g4[bj][n] = *(const GAS f32x4*)(gp + bj * 128 + n * 16);
        const float* xin = ti.lat ? xin_lat + (size_t)(u.pm * 256 - M_CTX) * DM : xin_ctx + (size_t)(u.pm * 256) * DM;
        float* xo = xout + (size_t)(u.pm * 256) * DM;
#pragma unroll
        for (int ai = 0; ai < 2; ++ai) {
            f32x4 xv[4][2][2];
#pragma unroll
            for (int m = 0; m < 4; ++m) {
                const size_t off = (size_t)(ai * 128 + wr * 64 + m * 16 + fr) * DM + col0;
#pragma unroll
                for (int bj = 0; bj < 2; ++bj)
#pragma unroll
                    for (int n = 0; n < 2; ++n) xv[m][bj][n] = *(const GAS f32x4*)(xin + off + bj * 128 + n * 16);
            }
#pragma unroll
            for (int m = 0; m < 4; ++m) {
                const size_t off = (size_t)(ai * 128 + wr * 64 + m * 16 + fr) * DM + col0;
#pragma unroll
                for (int bj = 0; bj < 2; ++bj)
#pragma unroll
                    for (int n = 0; n < 2; ++n) *(GAS f32x4*)(xo + off + bj * 128 + n * 16) = xv[m][bj][n] + g4[bj][n] * acc[ai][bj][m][n];
            }
            __builtin_amdgcn_sched_group_barrier(0x020, 16, 0);
            asm volatile("" ::: "memory");
            __builtin_amdgcn_sched_barrier(0);
        }
    }
};

struct EpiIn {
    int layer;
    const float *qn_g, *kn_g, *dqn_g, *dkn_g;
    const float *r64c, *r64s, *r32c, *r32s;
    bf16_t *QG, *QD, *KG, *VG, *KD, *VD, *CB, *PB;
    float* out;
    __device__ __forceinline__ void operator()(const Acc& acc, const pg8::Unit& u, int wr, int wc, int fr, int fq, LAS unsigned char*) const {
        const TileInfo ti(u.pm);
        const int pn = u.pn;
        const int rbase = wr * 64 + fr;
        if (pn < 2 || (pn == 2 && wc < 2)) {
            const bool isq = pn < 2;
            const float* gsrc = (isq ? qn_g : kn_g) + 4 * fq;
            const int head = isq ? 4 * pn + wc : wc;
#pragma unroll
            for (int ai = 0; ai < 2; ++ai)
#pragma unroll
                for (int m = 0; m < 4; ++m) {
                    const int rt = ai * 128 + m * 16 + rbase; const int t = ti.t0 + rt;
                    float ss = 0.f;
#pragma unroll
                    for (int bj = 0; bj < 2; ++bj)
#pragma unroll
                        for (int n = 0; n < 2; ++n) { const f32x4 v = acc[ai][bj][m][n]; ss += (v[0] * v[0] + v[1] * v[1]) + (v[2] * v[2] + v[3] * v[3]); }
                    ss += __shfl_xor(ss, 16); ss += __shfl_xor(ss, 32);
                    const float rstd = rsqrtf(ss * (1.f / 64.f) + EPS);
                    bf16_t* dst = isq ? QG + ((size_t)u.pm * 256 + rt) * 512 + head * 64 + 4 * fq : KG + ((ti.R * 2 + (long)head * ti.S + t) * 64) + 4 * fq;
                    float* o = out + OUT_GK + ((size_t)(ti.seq * 4 + layer) * 256 + t) * 128 + head * 64 + 4 * fq;
#pragma unroll
                    for (int bj = 0; bj < 2; ++bj) {
                        f32x4 y0 = acc[ai][bj][m][0] * rstd * *(const GAS f32x4*)(gsrc + 32 * bj), y1 = acc[ai][bj][m][1] * rstd * *(const GAS f32x4*)(gsrc + 32 * bj + 16);
                        if (!isq && !ti.lat) { *(GAS f32x4*)(o + 32 * bj) = y0; *(GAS f32x4*)(o + 32 * bj + 16) = y1; }
                        if (ti.lat) {
                            const int pos = bj ? (t & 63) : (t >> 6);
                            const f32x4 c4 = *(const GAS f32x4*)(r64c + pos * 16 + 4 * fq), s4 = *(const GAS f32x4*)(r64s + pos * 16 + 4 * fq);
                            const f32x4 o0 = y0 * c4 - y1 * s4, o1 = y1 * c4 + y0 * s4; y0 = o0; y1 = o1;
                        }
                        if (isq) { y0 = y0 * QSCALE_G; y1 = y1 * QSCALE_G; }
                        u32x2 w0, w1; w0.x = cvtpk(y0[0], y0[1]); w0.y = cvtpk(y0[2], y0[3]); w1.x = cvtpk(y1[0], y1[1]); w1.y = cvtpk(y1[2], y1[3]);
                        *(GAS u32x2*)(dst + 32 * bj) = w0; *(GAS u32x2*)(dst + 32 * bj + 16) = w1;
                    }
                    asm volatile("" ::: "memory");
                }
        } else if (pn == 2) {
            const int head = wc - 2;
#pragma unroll
            for (int ai = 0; ai < 2; ++ai)
#pragma unroll
                for (int m = 0; m < 4; ++m) {
                    const int rt = ai * 128 + m * 16 + rbase; const int t = ti.t0 + rt;
                    if (!ti.lat) {
                        float* o = out + OUT_GV + ((size_t)(ti.seq * 4 + layer) * 256 + t) * 128 + head * 64 + 4 * fq;
#pragma unroll
                        for (int bj = 0; bj < 2; ++bj)
#pragma unroll
                            for (int n = 0; n < 2; ++n) *(GAS f32x4*)(o + 32 * bj + 16 * n) = acc[ai][bj][m][n];
                    }
                    bf16_t* vp = VG + ((ti.R * 2 + (long)head * ti.S + t) * 64) + 4 * fq;
#pragma unroll
                    for (int bj = 0; bj < 2; ++bj)
#pragma unroll
                        for (int n = 0; n < 2; ++n) { const f32x4 v = acc[ai][bj][m][n]; u32x2 w; w.x = cvtpk(v[0], v[1]); w.y = cvtpk(v[2], v[3]); *(GAS u32x2*)(vp + 32 * bj + 16 * n) = w; }
                }
        } else if (pn == 3) {
#pragma unroll
            for (int ai = 0; ai < 2; ++ai)
#pragma unroll
                for (int m = 0; m < 4; ++m) {
                    const size_t grow = (size_t)u.pm * 256 + ai * 128 + m * 16 + rbase;
                    bf16_t* p = CB + grow * 256 + 32 * wc + 8 * fq;
#pragma unroll
                    for (int bj = 0; bj < 2; ++bj) { const f32x4 a = acc[ai][bj][m][0], b = acc[ai][bj][m][1]; u32x4 w; w.x = cvtpk(a[0], a[1]); w.y = cvtpk(a[2], a[3]); w.z = cvtpk(b[0], b[1]); w.w = cvtpk(b[2], b[3]); *(GAS u32x4*)(p + 128 * bj) = w; }
                }
        } else if (pn < 6) {
#pragma unroll
            for (int ai = 0; ai < 2; ++ai)
#pragma unroll
                for (int m = 0; m < 4; ++m) {
                    const size_t grow = (size_t)u.pm * 256 + ai * 128 + m * 16 + rbase;
                    bf16_t* p = PB + grow * 256 + 128 * (pn - 4) + 32 * wc + 8 * fq;
                    const f32x4 a = acc[ai][0][m][0] * acc[ai][1][m][0], b = acc[ai][0][m][1] * acc[ai][1][m][1];
                    u32x4 w; w.x = cvtpk(a[0], a[1]); w.y = cvtpk(a[2], a[3]); w.z = cvtpk(b[0], b[1]); w.w = cvtpk(b[2], b[3]); *(GAS u32x4*)p = w;
                }
        } else if (pn < 8) {
            const bool isq = pn == 6;
            const float* gsrc = isq ? dqn_g : dkn_g;
            const int a_ax = fq >> 1, ib = 4 * (fq & 1);
            const float* gp = gsrc + 16 * a_ax + ib;
            const int head = wc;
#pragma unroll
            for (int ai = 0; ai < 2; ++ai)
#pragma unroll
                for (int m = 0; m < 4; ++m) {
                    const int rt = ai * 128 + m * 16 + rbase; const int t = ti.t0 + rt; const size_t grow = (size_t)u.pm * 256 + rt;
#pragma unroll
                    for (int bj = 0; bj < 2; ++bj) {
                        float ss = 0.f;
#pragma unroll
                        for (int n = 0; n < 2; ++n) { const f32x4 v = acc[ai][bj][m][n]; ss += (v[0] * v[0] + v[1] * v[1]) + (v[2] * v[2] + v[3] * v[3]); }
                        ss += __shfl_xor(ss, 16); ss += __shfl_xor(ss, 32);
                        const float rstd = rsqrtf(ss * (1.f / 32.f) + EPS);
                        f32x4 y0 = acc[ai][bj][m][0] * rstd * *(const GAS f32x4*)gp, y1 = acc[ai][bj][m][1] * rstd * *(const GAS f32x4*)(gp + 8);
                        if (!isq && !ti.lat) {
                            float* o = out + OUT_DK + ((size_t)(ti.seq * 4 + layer) * 256 + t) * 256 + head * 64 + bj * 32 + 16 * a_ax + ib;
                            *(GAS f32x4*)(o) = y0; *(GAS f32x4*)(o + 8) = y1;
                        }
                        if (ti.lat) {
                            const int pos = a_ax ? (t & 63) : (t >> 6);
                            const f32x4 c4 = *(const GAS f32x4*)(r32c + pos * 8 + ib), s4 = *(const GAS f32x4*)(r32s + pos * 8 + ib);
                            const f32x4 o0 = y0 * c4 - y1 * s4, o1 = y1 * c4 + y0 * s4; y0 = o0; y1 = o1;
                        }
                        bf16_t* dst;
                        if (isq) { y0 = y0 * QSCALE_D; y1 = y1 * QSCALE_D; dst = QD + grow * 256 + head * 64 + bj * 32 + 16 * a_ax + ib; }
                        else dst = KD + ((ti.R * 8 + (long)(head * 2 + bj) * ti.S + t) * 32) + 16 * a_ax + ib;
                        u32x2 w0, w1; w0.x = cvtpk(y0[0], y0[1]); w0.y = cvtpk(y0[2], y0[3]); w1.x = cvtpk(y1[0], y1[1]); w1.y = cvtpk(y1[2], y1[3]);
                        *(GAS u32x2*)dst = w0; *(GAS u32x2*)(dst + 8) = w1;
                    }
                    asm volatile("" ::: "memory");
                }
        } else {
            const int head = wc;
#pragma unroll
            for (int ai = 0; ai < 2; ++ai)
#pragma unroll
                for (int m = 0; m < 4; ++m) {
                    const int rt = ai * 128 + m * 16 + rbase; const int t = ti.t0 + rt;
                    if (!ti.lat) {
                        float* o = out + OUT_DV + ((size_t)(ti.seq * 4 + layer) * 256 + t) * 256 + head * 64 + 8 * fq;
#pragma unroll
                        for (int bj = 0; bj < 2; ++bj) { *(GAS f32x4*)(o + 32 * bj) = acc[ai][bj][m][0]; *(GAS f32x4*)(o + 32 * bj + 4) = acc[ai][bj][m][1]; }
                    }
                    bf16_t* vp = VD + ((ti.R * 4 + (long)head * ti.S + t) * 64) + 8 * fq;
#pragma unroll
                    for (int bj = 0; bj < 2; ++bj) { const f32x4 a = acc[ai][bj][m][0], b = acc[ai][bj][m][1]; u32x4 w; w.x = cvtpk(a[0], a[1]); w.y = cvtpk(a[2], a[3]); w.z = cvtpk(b[0], b[1]); w.w = cvtpk(b[2], b[3]); *(GAS u32x4*)(vp + 32 * bj) = w; }
                }
        }
    }
};

__device__ __forceinline__ float dpp_ror1(float x) { return __int_as_float(__builtin_amdgcn_update_dpp(0, __float_as_int(x), 0x121, 0xf, 0xf, false)); }
__device__ __forceinline__ float dpp_ror15(float x) { return __int_as_float(__builtin_amdgcn_update_dpp(0, __float_as_int(x), 0x12F, 0xf, 0xf, false)); }
__device__ __forceinline__ float silu_f(float x) { return x * __builtin_amdgcn_rcpf(1.f + __builtin_amdgcn_exp2f(-x * LOG2E)); }
struct EpiUp {
    const float* cw; const float* cbias; bf16_t* F; float* EP; float* EA; float* EU;
    __device__ __forceinline__ void operator()(const Acc& acc, const pg8::Unit& u, int wr, int wc, int fr, int fq, LAS unsigned char* xlds) const {
        const TileInfo ti(u.pm);
        const int c0 = u.pn * 128 + wc * 32 + 8 * fq;
        LAS float* X = (LAS float*)xlds;
#pragma unroll
        for (int ai = 0; ai < 2; ++ai) {
            if (fr == 0) { LAS float* p = X + ((((ai * 2 + wr) * 4 + wc) * 2 + 0) * 4 + fq) * 8; *(LAS f32x4*)p = acc[ai][0][0][0]; *(LAS f32x4*)(p + 4) = acc[ai][0][0][1]; }
            if (fr == 15) { LAS float* p = X + ((((ai * 2 + wr) * 4 + wc) * 2 + 1) * 4 + fq) * 8; *(LAS f32x4*)p = acc[ai][0][3][0]; *(LAS f32x4*)(p + 4) = acc[ai][0][3][1]; }
        }
        asm volatile("s_waitcnt lgkmcnt(0)" ::: "memory"); __builtin_amdgcn_s_barrier(); asm volatile("" ::: "memory");
        f32x4 w0[2], w1[2], w2[2], bb[2];
#pragma unroll
        for (int n = 0; n < 2; ++n) { w0[n] = *(const GAS f32x4*)(cw + c0 + 4 * n); w1[n] = *(const GAS f32x4*)(cw + DFF + c0 + 4 * n); w2[n] = *(const GAS f32x4*)(cw + 2 * DFF + c0 + 4 * n); bb[n] = *(const GAS f32x4*)(cbias + c0 + 4 * n); }
        const bool has_prev = ti.lat && ti.t0 > 0, has_next = ti.lat && ti.t0 < 4096 - 256;
#pragma unroll
        for (int ai = 0; ai < 2; ++ai) {
            f32x4 pb[2] = {(f32x4){0.f, 0.f, 0.f, 0.f}, (f32x4){0.f, 0.f, 0.f, 0.f}}, nb[2] = {(f32x4){0.f, 0.f, 0.f, 0.f}, (f32x4){0.f, 0.f, 0.f, 0.f}};
            { const int seg = ai * 2 + wr;
              if (seg > 0) { const int ps = seg - 1; LAS float* p = X + ((((ps >> 1) * 2 + (ps & 1)) * 4 + wc) * 2 + 1) * 32 + fq * 8; pb[0] = *(LAS f32x4*)p; pb[1] = *(LAS f32x4*)(p + 4); }
              if (seg < 3) { const int ns = seg + 1; LAS float* p = X + ((((ns >> 1) * 2 + (ns & 1)) * 4 + wc) * 2 + 0) * 32 + fq * 8; nb[0] = *(LAS f32x4*)p; nb[1] = *(LAS f32x4*)(p + 4); } }
#pragma unroll
            for (int m = 0; m < 4; ++m) {
                const int rt = ai * 128 + wr * 64 + m * 16 + fr; const size_t grow = (size_t)u.pm * 256 + rt;
                f32x4 fo[2], cv[2];
#pragma unroll
                for (int n = 0; n < 2; ++n) {
                    const f32x4 a = acc[ai][0][m][n];
                    const f32x4 up = (m > 0) ? acc[ai][0][m > 0 ? m - 1 : 0][n] : pb[n];
                    const f32x4 dn = (m < 3) ? acc[ai][0][m < 3 ? m + 1 : 3][n] : nb[n];
                    f32x4 pv, nx;
#pragma unroll
                    for (int e = 0; e < 4; ++e) {
                        pv[e] = dpp_ror1(fr == 15 ? up[e] : a[e]);
                        nx[e] = dpp_ror15(fr == 0 ? dn[e] : a[e]);
                    }
                    const f32x4 c = w0[n] * pv + w1[n] * a + w2[n] * nx + bb[n];
                    cv[n] = c;
                    const f32x4 uu = acc[ai][1][m][n];
#pragma unroll
                    for (int e = 0; e < 4; ++e) fo[n][e] = silu_f(c[e]) * uu[e];
                }
                u32x4 w; w.x = cvtpk(fo[0][0], fo[0][1]); w.y = cvtpk(fo[0][2], fo[0][3]); w.z = cvtpk(fo[1][0], fo[1][1]); w.w = cvtpk(fo[1][2], fo[1][3]);
                *(GAS u32x4*)(F + grow * DFF + c0) = w;
                if (ai == 0 && m == 0) { if (has_prev && rt == 0) { const size_t eo = ((size_t)u.pm * 2 + 0) * DFF + c0;
                        *(GAS f32x4*)(EP + eo) = cv[0]; *(GAS f32x4*)(EP + eo + 4) = cv[1]; *(GAS f32x4*)(EA + eo) = acc[0][0][0][0]; *(GAS f32x4*)(EA + eo + 4) = acc[0][0][0][1]; *(GAS f32x4*)(EU + eo) = acc[0][1][0][0]; *(GAS f32x4*)(EU + eo + 4) = acc[0][1][0][1]; } }
                if (ai == 1 && m == 3) { if (has_next && rt == 255) { const size_t eo = ((size_t)u.pm * 2 + 1) * DFF + c0;
                        *(GAS f32x4*)(EP + eo) = cv[0]; *(GAS f32x4*)(EP + eo + 4) = cv[1]; *(GAS f32x4*)(EA + eo) = acc[1][0][3][0]; *(GAS f32x4*)(EA + eo + 4) = acc[1][0][3][1]; *(GAS f32x4*)(EU + eo) = acc[1][1][3][0]; *(GAS f32x4*)(EU + eo + 4) = acc[1][1][3][1]; } }
            }
        }
        asm volatile("s_waitcnt lgkmcnt(0)" ::: "memory"); __builtin_amdgcn_s_barrier(); asm volatile("" ::: "memory");
    }
};

typedef short v4i16_t __attribute__((ext_vector_type(4)));
__device__ __forceinline__ s16x4 vtr(LAS const char* p) { return __builtin_bit_cast(s16x4, __builtin_amdgcn_ds_read_tr16_b64_v4i16((LAS v4i16_t*)p)); }
__device__ __forceinline__ float xhalf_max(float m) { auto rr = __builtin_amdgcn_permlane32_swap(__float_as_uint(m), __float_as_uint(m), false, false); return fmaxf(__uint_as_float(rr[0]), __uint_as_float(rr[1])); }
__device__ __forceinline__ float xhalf_sum(float m) { auto rr = __builtin_amdgcn_permlane32_swap(__float_as_uint(m), __float_as_uint(m), false, false); return __uint_as_float(rr[0]) + __uint_as_float(rr[1]); }

constexpr int ATT_VS = 192;
constexpr float ATT_THR = 8.f;
#define MX3(a, b, c) __builtin_fmaxf(__builtin_fmaxf((a), (b)), (c))
template <int DQK, bool YORD>
__device__ __forceinline__ void flash_pass(const bf16_t* __restrict__ Qw, int qpitch, const bf16_t* __restrict__ Kg, const bf16_t* __restrict__ Vg, int NT, int tst,
                                           LAS char* lds, f32x16 (&o)[2], float& lsum) {
#define ATT_TI(T) (((T) + tst) < NT ? ((T) + tst) : ((T) + tst - NT))
    constexpr int KS = DQK * 2 + 16, KBUF = 64 * KS, VBUF = 64 * ATT_VS, NDS = DQK / 16;
    constexpr int KROWB = DQK * 2;
    const int tid = opaque_tid(), lane = tid & 63, r32 = lane & 31, h = lane >> 5;
    LAS char* Kb = lds; LAS char* Vb = lds + 2 * KBUF;
    bf16x8 qf[NDS];
#pragma unroll
    for (int ds = 0; ds < NDS; ++ds) qf[ds] = *(const GAS bf16x8*)(Qw + (size_t)r32 * qpitch + 16 * ds + 8 * h);
    const bool kload = (tid * 16) < 64 * KROWB;
    const int krow = (tid * 16) / KROWB, kcb = (tid * 16) % KROWB;
    const int kdst = krow * KS + kcb, vdst = (tid >> 3) * ATT_VS + (tid & 7) * 16;
    const char* kg = (const char*)Kg + tid * 16; const char* vg = (const char*)Vg + tid * 16;
    u32x4 kreg = {0, 0, 0, 0}, vreg;
    {
        u32x4 k1 = {0, 0, 0, 0};
        if (kload) { kreg = *(const GAS u32x4*)(kg + (size_t)ATT_TI(0) * 64 * KROWB); k1 = *(const GAS u32x4*)(kg + (size_t)ATT_TI(1) * 64 * KROWB); }
        vreg = *(const GAS u32x4*)(vg + (size_t)ATT_TI(0) * 64 * 128);
        if (kload) { *(LAS u32x4*)(Kb + kdst) = kreg; *(LAS u32x4*)(Kb + KBUF + kdst) = k1; }
        *(LAS u32x4*)(Vb + vdst) = vreg;
        *(LAS u32x4*)(Vb + 2 * VBUF + vdst) = (u32x4){0, 0, 0, 0};
    }
    __syncthreads();
    const int kfo = r32 * KS + h * 16;
    const int vfo = (4 * h + ((lane & 15) >> 2)) * ATT_VS + (((lane >> 4) & 1) * 16 + (lane & 3) * 4) * 2;
    f32x16 p0 = (f32x16){}, p1 = (f32x16){};
#pragma unroll
    for (int ds = 0; ds < NDS; ++ds) {
        const bf16x8 k0 = *(LAS const bf16x8*)(Kb + kfo + ds * 32), k1 = *(LAS const bf16x8*)(Kb + kfo + 32 * KS + ds * 32);
        p0 = __builtin_amdgcn_mfma_f32_32x32x16_bf16(k0, qf[ds], p0, 0, 0, 0);
        p1 = __builtin_amdgcn_mfma_f32_32x32x16_bf16(k1, qf[ds], p1, 0, 0, 0);
    }
    __syncthreads();
    float mref, l = 0.f;
    {
        float a = MX3(p0[0], p0[1], p1[0]), b = MX3(p0[2], p0[3], p1[1]); a = MX3(a, p1[2], p1[3]);
#pragma unroll
        for (int r = 4; r < 16; r += 4) { a = MX3(a, p0[r], p0[r + 1]); b = MX3(b, p0[r + 2], p0[r + 3]); a = MX3(a, p1[r], p1[r + 1]); b = MX3(b, p1[r + 2], p1[r + 3]); }
        mref = xhalf_max(fmaxf(a, b));
#pragma unroll
        for (int r = 0; r < 16; ++r) { p0[r] -= mref; p1[r] -= mref; }
    }
    f32x16 negm;
#pragma unroll
    for (int r = 0; r < 16; ++r) negm[r] = -mref;
    asm volatile("" : "+v"(negm));
    o[0] = (f32x16){}; o[1] = (f32x16){};
    bf16x8 pk[4] = {};
    int vs_prev = 2 * VBUF, vs_cur = 0, vs_next = VBUF;
#define ATT_MPART(N0, N1, T) do { \
        LAS const char* kb_ = Kb + ((((T) + 1) & 1) * KBUF) + kfo; LAS const char* vb_ = Vb + vs_prev + vfo; \
        bf16x8 kf_[2 * NDS]; s16x4 vl_[8], vh_[8]; \
        _Pragma("unroll") for (int ds = 0; ds < NDS; ++ds) { kf_[2 * ds] = *(LAS const bf16x8*)(kb_ + ds * 32); kf_[2 * ds + 1] = *(LAS const bf16x8*)(kb_ + 32 * KS + ds * 32); } \
        _Pragma("unroll") for (int s_ = 0; s_ < 4; ++s_) { _Pragma("unroll") for (int db_ = 0; db_ < 2; ++db_) { \
            vl_[2 * s_ + db_] = vtr(vb_ + (16 * s_) * ATT_VS + db_ * 64); vh_[2 * s_ + db_] = vtr(vb_ + (16 * s_ + 8) * ATT_VS + db_ * 64); } } \
        N0 = __builtin_amdgcn_mfma_f32_32x32x16_bf16(kf_[0], qf[0], negm, 0, 0, 0); N1 = __builtin_amdgcn_mfma_f32_32x32x16_bf16(kf_[1], qf[0], negm, 0, 0, 0); \
        _Pragma("unroll") for (int ds = 1; ds < NDS; ++ds) { \
            N0 = __builtin_amdgcn_mfma_f32_32x32x16_bf16(kf_[2 * ds], qf[ds], N0, 0, 0, 0); N1 = __builtin_amdgcn_mfma_f32_32x32x16_bf16(kf_[2 * ds + 1], qf[ds], N1, 0, 0, 0); } \
        _Pragma("unroll") for (int s_ = 0; s_ < 4; ++s_) { _Pragma("unroll") for (int db_ = 0; db_ < 2; ++db_) { \
            const bf16x8 vf_ = __builtin_shufflevector(vl_[2 * s_ + db_], vh_[2 * s_ + db_], 0, 1, 2, 3, 4, 5, 6, 7); \
            o[db_] = __builtin_amdgcn_mfma_f32_32x32x16_bf16(vf_, pk[s_], o[db_], 0, 0, 0); } } \
        __builtin_amdgcn_sched_group_barrier(0x100, 2 * NDS + 8, 0); __builtin_amdgcn_sched_group_barrier(0x008, 2 * NDS, 0); \
        __builtin_amdgcn_sched_group_barrier(0x100, 8, 0); __builtin_amdgcn_sched_group_barrier(0x008, 8, 0); } while (0)
#define ATT_VPART(P0, P1, N0, N1) do { \
        float a = MX3(P0[0], P0[1], P1[0]), b = MX3(P0[2], P0[3], P1[1]); a = MX3(a, P1[2], P1[3]); \
        _Pragma("unroll") for (int r = 4; r < 16; r += 4) { a = MX3(a, P0[r], P0[r + 1]); b = MX3(b, P0[r + 2], P0[r + 3]); a = MX3(a, P1[r], P1[r + 1]); b = MX3(b, P1[r + 2], P1[r + 3]); } \
        const float mt = xhalf_max(fmaxf(a, b)); \
        resc = __any(mt > ATT_THR); \
        if (__builtin_expect(resc, 0)) { \
            const float dl = fmaxf(mt, 0.f); mref += dl; fsc = __builtin_amdgcn_exp2f(-dl); l *= fsc; \
            _Pragma("unroll") for (int r = 0; r < 16; ++r) { P0[r] -= dl; P1[r] -= dl; } \
            if (!YORD) { _Pragma("unroll") for (int r = 0; r < 16; ++r) { N0[r] -= dl; N1[r] -= dl; o[0][r] *= fsc; o[1][r] *= fsc; } } \
            _Pragma("unroll") for (int r = 0; r < 16; ++r) negm[r] = -mref; \
            asm volatile("" : "+v"(negm)); } \
        float ps0 = 0.f, ps1 = 0.f; \
        _Pragma("unroll") for (int r = 0; r < 16; ++r) { P0[r] = __builtin_amdgcn_exp2f(P0[r]); P1[r] = __builtin_amdgcn_exp2f(P1[r]); ps0 += P0[r]; ps1 += P1[r]; } \
        l += ps0 + ps1; \
        _Pragma("unroll") for (int s = 0; s < 2; ++s) { u32x4 a4, b4; \
            a4.x = cvtpk(P0[8 * s + 0], P0[8 * s + 1]); a4.y = cvtpk(P0[8 * s + 2], P0[8 * s + 3]); a4.z = cvtpk(P0[8 * s + 4], P0[8 * s + 5]); a4.w = cvtpk(P0[8 * s + 6], P0[8 * s + 7]); \
            b4.x = cvtpk(P1[8 * s + 0], P1[8 * s + 1]); b4.y = cvtpk(P1[8 * s + 2], P1[8 * s + 3]); b4.z = cvtpk(P1[8 * s + 4], P1[8 * s + 5]); b4.w = cvtpk(P1[8 * s + 6], P1[8 * s + 7]); \
            pkn[s] = __builtin_bit_cast(bf16x8, a4); pkn[2 + s] = __builtin_bit_cast(bf16x8, b4); } } while (0)
#define ATT_STEP(P0, P1, N0, N1, T) do { \
        const bool more = (T) + 1 < NT, more2 = (T) + 2 < NT; \
        if (more2 && kload) kreg = *(const GAS u32x4*)(kg + (size_t)ATT_TI((T) + 2) * 64 * KROWB); \
        if (more) vreg = *(const GAS u32x4*)(vg + (size_t)ATT_TI((T) + 1) * 64 * 128); \
        float fsc = 1.f; bool resc; bf16x8 pkn[4]; \
        if (!YORD) { ATT_MPART(N0, N1, T); __builtin_amdgcn_sched_barrier(0); ATT_VPART(P0, P1, N0, N1); } \
        else { ATT_VPART(P0, P1, N0, N1); __builtin_amdgcn_sched_barrier(0); ATT_MPART(N0, N1, T); \
            if (__builtin_expect(resc, 0)) { _Pragma("unroll") for (int r = 0; r < 16; ++r) { o[0][r] *= fsc; o[1][r] *= fsc; } } } \
        _Pragma("unroll") for (int s = 0; s < 4; ++s) pk[s] = pkn[s]; \
        if (more2 && kload) *(LAS u32x4*)(Kb + ((T) & 1) * KBUF + kdst) = kreg; \
        if (more) *(LAS u32x4*)(Vb + vs_next + vdst) = vreg; \
        __syncthreads(); \
        vs_prev = vs_cur; vs_cur = vs_next; vs_next = (vs_next == 2 * VBUF) ? 0 : vs_next + VBUF; } while (0)
    f32x16 n0, n1;
    for (int t = 0; t < NT; t += 2) {
        ATT_STEP(p0, p1, n0, n1, t);
        ATT_STEP(n0, n1, p0, p1, t + 1);
    }
    {
        LAS const char* vb_ = Vb + vs_prev + vfo;
#pragma unroll
        for (int s_ = 0; s_ < 4; ++s_) {
#pragma unroll
            for (int db_ = 0; db_ < 2; ++db_) {
                const s16x4 lo_ = vtr(vb_ + (16 * s_) * ATT_VS + db_ * 64), hi_ = vtr(vb_ + (16 * s_ + 8) * ATT_VS + db_ * 64);
                const bf16x8 vf_ = __builtin_shufflevector(lo_, hi_, 0, 1, 2, 3, 4, 5, 6, 7);
                o[db_] = __builtin_amdgcn_mfma_f32_32x32x16_bf16(vf_, pk[s_], o[db_], 0, 0, 0);
            }
        }
    }
    __syncthreads();
#undef ATT_STEP
#undef ATT_TI
#undef ATT_VPART
#undef ATT_MPART
    lsum = xhalf_sum(l);
}

__device__ __forceinline__ void store_ot(const f32x16 (&o)[2], bf16_t* dst  , int h) {
#pragma unroll
    for (int db = 0; db < 2; ++db)
#pragma unroll
        for (int g = 0; g < 4; ++g) { u32x2 w; w.x = cvtpk(o[db][4 * g], o[db][4 * g + 1]); w.y = cvtpk(o[db][4 * g + 2], o[db][4 * g + 3]); *(GAS u32x2*)(dst + 32 * db + 8 * g + 4 * h) = w; }
}

#include <hip/hip_bf16.h>
namespace attn64 {
using bf16=__hip_bfloat16;
using bf16x8=__attribute__((ext_vector_type(8)))short;
using s16x4=__attribute__((ext_vector_type(4)))short;
using f32x16=__attribute__((ext_vector_type(16)))float;
using u32x4=__attribute__((ext_vector_type(4)))unsigned;
constexpr int D=64;
constexpr int NW=8,QBLK=32,QB=QBLK*NW,KVBLK=64;

__device__ __forceinline__ int crow(int r,int hi){return (r&3)+8*(r>>2)+4*hi;}
#define SBAR() __builtin_amdgcn_sched_barrier(0)
__device__ __forceinline__ void cmask(f32x16&p0,f32x16&p1,int jb,int qrel,int hi){
  const float NEG=-INFINITY; int kb=64*jb+4*hi;
  #pragma unroll
  for(int r=0;r<16;++r){int kv=kb+(r&3)+8*(r>>2); if(kv>qrel)p0[r]=NEG; if(kv+32>qrel)p1[r]=NEG;}
}

constexpr int NSLOT=3, SLOTB=8192;
constexpr int LDS_K=0, LDS_V=NSLOT*SLOTB, LDS_WS=2*NSLOT*SLOTB, LDS_OST=LDS_WS+NW*64*4, LDS_BYTES=LDS_OST+NW*4096;
constexpr float C2=0.125f*1.4426950408889634f;
__device__ __forceinline__ void glds16(const void*gsrc,unsigned lds_dst){unsigned keep;
  asm volatile("s_mov_b32 %0, m0\n\ts_mov_b32 m0, %2\n\ts_nop 0\n\tglobal_load_lds_dwordx4 %1, off\n\ts_mov_b32 m0, %0":"=&s"(keep):"v"(gsrc),"s"(lds_dst):"memory");}
__device__ __forceinline__ float max3f(float a,float b,float c){float r;asm("v_max3_f32 %0, %1, %2, %3":"=v"(r):"v"(a),"v"(b),"v"(c));return r;}
__device__ __forceinline__ float max2f(float a,float b){float r;asm("v_max_f32_e32 %0, %1, %2":"=v"(r):"v"(a),"v"(b));return r;}
__device__ __forceinline__ float fadd_s(float a,float b){float r;asm("v_add_f32_e32 %0, %1, %2":"=v"(r):"v"(a),"v"(b));return r;}
__device__ __forceinline__ float fsub_s(float a,float b){float r;asm("v_sub_f32_e32 %0, %1, %2":"=v"(r):"v"(a),"v"(b));return r;}
typedef float f32x2_t __attribute__((ext_vector_type(2))); typedef __bf16 bf16x2_t __attribute__((ext_vector_type(2)));
__device__ __forceinline__ unsigned cvtpk_s(float lo,float hi){f32x2_t v={lo,hi};bf16x2_t b=__builtin_convertvector(v,bf16x2_t);return __builtin_bit_cast(unsigned,b);}
#define WAIT_BAR(N) asm volatile("s_waitcnt vmcnt(" #N ") lgkmcnt(0)\n\ts_barrier":::"memory")

template<int NDS_> __device__ __forceinline__ void qkt(f32x16&p0,f32x16&p1,const char*Kslot,const bf16x8*qr,const f32x16&negm,int r32,int hi){
  const char*kb=Kslot+hi*1024+r32*16;
  #pragma unroll
  for(int d0=0;d0<NDS_;++d0){
    const bf16x8 b0=*reinterpret_cast<const bf16x8*>(kb+d0*2048);
    const bf16x8 b1=*reinterpret_cast<const bf16x8*>(kb+d0*2048+512);
    if(d0==0){p0=__builtin_amdgcn_mfma_f32_32x32x16_bf16(b0,qr[0],negm,0,0,0);p1=__builtin_amdgcn_mfma_f32_32x32x16_bf16(b1,qr[0],negm,0,0,0);}
    else{p0=__builtin_amdgcn_mfma_f32_32x32x16_bf16(b0,qr[d0],p0,0,0,0);p1=__builtin_amdgcn_mfma_f32_32x32x16_bf16(b1,qr[d0],p1,0,0,0);}}
}
typedef __attribute__((address_space(3))) const char* lds_cptr;
typedef short v4i16_t __attribute__((ext_vector_type(4)));
__device__ __forceinline__ void kload8(bf16x8*kf,lds_cptr kp){
  kf[0]=*(const __attribute__((address_space(3))) bf16x8*)(kp);      kf[1]=*(const __attribute__((address_space(3))) bf16x8*)(kp+512);
  kf[2]=*(const __attribute__((address_space(3))) bf16x8*)(kp+2048); kf[3]=*(const __attribute__((address_space(3))) bf16x8*)(kp+2560);
  kf[4]=*(const __attribute__((address_space(3))) bf16x8*)(kp+4096); kf[5]=*(const __attribute__((address_space(3))) bf16x8*)(kp+4608);
  kf[6]=*(const __attribute__((address_space(3))) bf16x8*)(kp+6144); kf[7]=*(const __attribute__((address_space(3))) bf16x8*)(kp+6656);
}
__device__ __forceinline__ void kload2(bf16x8*kf,lds_cptr kp,int j){ kf[2*j]=*(const __attribute__((address_space(3))) bf16x8*)(kp+j*2048); kf[2*j+1]=*(const __attribute__((address_space(3))) bf16x8*)(kp+j*2048+512); }
__device__ __forceinline__ s16x4 vtr(lds_cptr p){ return __builtin_bit_cast(s16x4,__builtin_amdgcn_ds_read_tr16_b64_v4i16((__attribute__((address_space(3))) v4i16_t*)p)); }
__device__ __forceinline__ float rowmax(const f32x16&p0,const f32x16&p1){
  float a=max3f(p0[0],p0[1],p1[0]),b=max3f(p0[2],p0[3],p1[1]);a=max3f(a,p1[2],p1[3]);
  #pragma unroll
  for(int r=4;r<16;r+=4){a=max3f(a,p0[r],p0[r+1]);b=max3f(b,p0[r+2],p0[r+3]);a=max3f(a,p1[r],p1[r+1]);b=max3f(b,p1[r+2],p1[r+3]);}
  const float m=max2f(a,b);
  auto rr=__builtin_amdgcn_permlane32_swap(__float_as_uint(m),__float_as_uint(m),false,false);
  return max2f(__uint_as_float(rr[0]),__uint_as_float(rr[1]));
}
__device__ __forceinline__ void pv(f32x16*o,int vb,bf16x8 pa0,bf16x8 pa1,bf16x8 pa2,bf16x8 pa3){
  #pragma unroll
  for(int d0=0;d0<2;++d0){s16x4 lo[4],hi[4];
    #pragma unroll
    for(int ks=0;ks<4;++ks){
      asm volatile("ds_read_b64_tr_b16 %0,%1 offset:%c2":"=&v"(lo[ks]):"v"(vb),"i"(d0*4096+ks*1024):"memory");
      asm volatile("ds_read_b64_tr_b16 %0,%1 offset:%c2":"=&v"(hi[ks]):"v"(vb),"i"(d0*4096+ks*1024+512):"memory");}
    asm volatile("s_waitcnt lgkmcnt(0)":::"memory");SBAR();
    #define PK(k) (bf16x8){lo[k][0],lo[k][1],lo[k][2],lo[k][3],hi[k][0],hi[k][1],hi[k][2],hi[k][3]}
    o[d0]=__builtin_amdgcn_mfma_f32_32x32x16_bf16(pa0,PK(0),o[d0],0,0,0);
    o[d0]=__builtin_amdgcn_mfma_f32_32x32x16_bf16(pa1,PK(1),o[d0],0,0,0);
    o[d0]=__builtin_amdgcn_mfma_f32_32x32x16_bf16(pa2,PK(2),o[d0],0,0,0);
    o[d0]=__builtin_amdgcn_mfma_f32_32x32x16_bf16(pa3,PK(3),o[d0],0,0,0);
    #undef PK
  }
}

#ifndef ATTN_STORE16
#define ATTN_STORE16(p,v) (*(GAS u32x4*)(p)=(v))
#endif
__device__ __forceinline__ void stage_store(const f32x16 (&o)[2],bf16*Ow,int op,char*shm,int wid,int lane,int r32,int hi){
  bf16*stg=(bf16*)(shm+LDS_OST)+wid*2048;
  #pragma unroll
  for(int r=0;r<16;++r){const int orow=crow(r,hi);
    #pragma unroll
    for(int d0=0;d0<2;++d0)stg[orow*64+d0*32+r32]=__float2bfloat16(o[d0][r]);}
  asm volatile("s_waitcnt lgkmcnt(0)":::"memory");
  #pragma unroll
  for(int i=0;i<4;++i){const int row=i*8+(lane>>3),ch=lane&7; const u32x4 v=*(const u32x4*)(stg+row*64+ch*8); ATTN_STORE16(Ow+(long)row*op+ch*8,v);}
}
template<int THRL,int MODE,int DQ> __device__ __forceinline__ void attn_unit(const bf16*Qw0,int qp,const bf16*__restrict__ Kh,int kp,const bf16*__restrict__ Vh,int vp,int NT,bf16*Ow0,int op,char*shm,f32x16 (&oret)[2]){
  constexpr int NDS=DQ/16;
  const int tid=opaque_tid(),lane=tid&63,r32=lane&31,hi=lane>>5; const int wid=__builtin_amdgcn_readfirstlane(tid>>6);
  const bf16*Qw=Qw0+(long)(wid*QBLK)*qp;
  const unsigned lds0=(unsigned)(uintptr_t)shm;
  float*wsf=(float*)(shm+LDS_WS)+wid*64;
  const int kch=(DQ==64)?wid:(wid&3);
  const bf16*ksrc=Kh+(long)lane*kp+kch*8;
  const bf16*vsrc=Vh+(long)(16*(wid&3)+(lane>>2))*vp+(wid>>2)*32+(lane&3)*8;
  const unsigned kdst=lds0+LDS_K+kch*1024, vdst=lds0+LDS_V+wid*1024;
  #define DMA_K(t,slot) glds16(ksrc+(long)(t)*KVBLK*kp,(unsigned)__builtin_amdgcn_readfirstlane(kdst+(slot)))
  #define DMA_V(t,slot) glds16(vsrc+(long)(t)*KVBLK*vp,(unsigned)__builtin_amdgcn_readfirstlane(vdst+(slot)))
  const int vb0=(int)(lds0+LDS_V)+((lane>>4)&1)*32+(lane&3)*8+(4*hi+((lane&15)>>2))*64;
  const char*Kbase=shm+LDS_K; bf16x8 kf[8];
  const lds_cptr shm3=(lds_cptr)shm; const lds_cptr kp0=shm3+LDS_K+hi*1024+r32*16; const lds_cptr vp0=shm3+LDS_V+((lane>>4)&1)*32+(lane&3)*8+(4*hi+((lane&15)>>2))*64;
  DMA_K(0,0);DMA_V(0,0);DMA_K(1,SLOTB);
  bf16x8 qr[4];
  #pragma unroll
  for(int d0=0;d0<NDS;++d0)qr[d0]=*(const GAS bf16x8*)(&Qw[(long)r32*qp+d0*16+hi*8]);
  float mhat=0.f,l_reg=0.f;f32x16 o[2];o[0]=f32x16{};o[1]=f32x16{};f32x16 negm=f32x16{};asm volatile("":"+v"(negm));
  #define CMASK(P0,P1,t) do{}while(0)
  bool resc=false;
  #define START(P0,P1) do{ const float rm=rowmax(P0,P1); resc=false; \
    { const float dl=rm; mhat=fadd_s(mhat,dl); \
      _Pragma("unroll") for(int r=0;r<16;++r){P0[r]=fsub_s(P0[r],dl);P1[r]=fsub_s(P1[r],dl);} \
      _Pragma("unroll") for(int r=0;r<16;++r)negm[r]=-mhat; asm volatile("":"+v"(negm)); } \
    _Pragma("unroll") for(int r=0;r<16;++r)P0[r]=__builtin_amdgcn_exp2f(P0[r]); }while(0)
  #define RESC() do{ if(resc){ asm volatile("s_waitcnt lgkmcnt(0)":::"memory"); \
      _Pragma("unroll") for(int d_=0;d_<2;++d_) _Pragma("unroll") for(int r=0;r<16;++r)o[d_][r]*=wsf[crow(r,hi)]; } }while(0)
  f32x16 pA0,pA1,pB0,pB1;
  int sl_prev=0,sl_cur=0,sl_next=SLOTB;
  #define ROT() do{sl_prev=sl_cur;sl_cur=sl_next;sl_next=(sl_next==(NSLOT-1)*SLOTB)?0:sl_next+SLOTB;}while(0)
  DMA_K(2,2*SLOTB);
  WAIT_BAR(3);
  qkt<NDS>(pA0,pA1,Kbase,qr,negm,r32,hi);asm volatile("s_nop 15\n\ts_nop 7":"+v"(pA0),"+v"(pA1));CMASK(pA0,pA1,0);
  START(pA0,pA1);
  _Pragma("unroll") for(int r=0;r<16;++r)pA1[r]=__builtin_amdgcn_exp2f(pA1[r]);
  WAIT_BAR(0);
  DMA_K(3,0);DMA_V(1,SLOTB);
  ROT();
  if constexpr(DQ==64) kload8(kf,kp0+sl_cur); else { kload2(kf,kp0+sl_cur,0); kload2(kf,kp0+sl_cur,1); }
  WAIT_BAR(2);
  s16x4 vlo[8],vhi[8]; u32x4 pw0,pw1,pw2,pw3;
  #define PKW(P,B) cvtpk_s(P[B],P[B+1])
  #define PAF(k) __builtin_bit_cast(bf16x8,pw##k)
  #define VFR(i) (bf16x8){vlo[i][0],vlo[i][1],vlo[i][2],vlo[i][3],vhi[i][0],vhi[i][1],vhi[i][2],vhi[i][3]}
  #define PIN(x) asm volatile("":"+v"(x))
  #define MX3(a,b,c) __builtin_fmaxf(__builtin_fmaxf((a),(b)),(c))
  #define GAPA(MF,A0,A1,A2,A3,W0,W1,PW) do{ MF; sacc+=A0; sacc+=A1; sacc+=A2; sacc+=A3; PIN(sacc); W0; W1; PIN(PW); SBAR(); }while(0)
  #define EX(v) __builtin_amdgcn_exp2f(v)
  #define GAPB(MF,X,B) do{ MF; X[B]=EX(X[B]); X[B+1]=EX(X[B+1]); X[B+2]=EX(X[B+2]); X[B+3]=EX(X[B+3]); PIN(X); SBAR(); }while(0)
  #define VRD(i) do{ vlo[i]=vtr(vp_+(((i)>>2)*4096+((i)&3)*1024)); vhi[i]=vtr(vp_+(((i)>>2)*4096+((i)&3)*1024+512)); }while(0)
  #define KRD(G,j) do{ if(G){ kload2(kf,kp0+sl_next,j); SBAR(); } }while(0)
  #define STEP(C0,C1,P0,P1,t,GK,GV,GL) do{ SBAR(); \
    const lds_cptr vp_=vp0+sl_prev; \
    VRD(0); SBAR(); float sacc=(P0[0]+P0[1]); \
    GAPA(C0=__builtin_amdgcn_mfma_f32_32x32x16_bf16(kf[0],qr[0],negm,0,0,0), P0[2],P0[3],P0[4],P0[5],     pw0[0]=PKW(P0,0), pw0[1]=PKW(P0,2), pw0); \
    VRD(4); SBAR(); GAPA(C1=__builtin_amdgcn_mfma_f32_32x32x16_bf16(kf[1],qr[0],negm,0,0,0), P0[6],P0[7],P0[8],P0[9],     pw0[2]=PKW(P0,4), pw0[3]=PKW(P0,6), pw0); \
    VRD(1); SBAR(); GAPA(C0=__builtin_amdgcn_mfma_f32_32x32x16_bf16(kf[2],qr[1],C0,0,0,0),   P0[10],P0[11],P0[12],P0[13], pw1[0]=PKW(P0,8), pw1[1]=PKW(P0,10), pw1); \
    VRD(5); SBAR(); GAPA(C1=__builtin_amdgcn_mfma_f32_32x32x16_bf16(kf[3],qr[1],C1,0,0,0),   P0[14],P0[15],P1[0],P1[1],   pw1[2]=PKW(P0,12),pw1[3]=PKW(P0,14), pw1); \
    VRD(2); SBAR(); GAPA(if constexpr(DQ==64) C0=__builtin_amdgcn_mfma_f32_32x32x16_bf16(kf[4],qr[2],C0,0,0,0),   P1[2],P1[3],P1[4],P1[5],     pw2[0]=PKW(P1,0), pw2[1]=PKW(P1,2), pw2); \
    VRD(6); SBAR(); GAPA(if constexpr(DQ==64) C1=__builtin_amdgcn_mfma_f32_32x32x16_bf16(kf[5],qr[2],C1,0,0,0),   P1[6],P1[7],P1[8],P1[9],     pw2[2]=PKW(P1,4), pw2[3]=PKW(P1,6), pw2); \
    VRD(3); SBAR(); GAPA(if constexpr(DQ==64) C0=__builtin_amdgcn_mfma_f32_32x32x16_bf16(kf[6],qr[3],C0,0,0,0),   P1[10],P1[11],P1[12],P1[13], pw3[0]=PKW(P1,8), pw3[1]=PKW(P1,10), pw3); \
    VRD(7); SBAR(); GAPA(if constexpr(DQ==64) C1=__builtin_amdgcn_mfma_f32_32x32x16_bf16(kf[7],qr[3],C1,0,0,0),   P1[14],P1[15],0.f,0.f,       pw3[2]=PKW(P1,12),pw3[3]=PKW(P1,14), pw3); \
    l_reg+=sacc; \
    if(GK){DMA_K((t)+3,sl_cur);} if(GV){DMA_V((t)+1,sl_next);} \
    CMASK(C0,C1,t); \
    { float a=MX3(C0[0],C0[1],C1[0]),b=MX3(C0[2],C0[3],C1[1]); a=MX3(a,C1[2],C1[3]); \
      _Pragma("unroll") for(int r=4;r<16;r+=4){a=MX3(a,C0[r],C0[r+1]);b=MX3(b,C0[r+2],C0[r+3]);a=MX3(a,C1[r],C1[r+1]);b=MX3(b,C1[r+2],C1[r+3]);} \
      float rm=__builtin_fmaxf(a,b); { auto rr=__builtin_amdgcn_permlane32_swap(__float_as_uint(rm),__float_as_uint(rm),false,false); rm=__builtin_fmaxf(__uint_as_float(rr[0]),__uint_as_float(rr[1])); } \
      resc=false; \
      if(__builtin_expect(__any(rm>(float)THRL),0)){ const float dl=__builtin_fmaxf(rm,0.f); mhat+=dl; \
        _Pragma("unroll") for(int r=0;r<16;++r){C0[r]-=dl;C1[r]-=dl;} \
        _Pragma("unroll") for(int r=0;r<16;++r)negm[r]=-mhat; asm volatile("":"+v"(negm)); \
        const float f=__builtin_amdgcn_exp2f(-dl); l_reg*=f; if(hi==0)wsf[r32]=f; resc=true; } } \
    SBAR(); \
    GAPB(o[0]=__builtin_amdgcn_mfma_f32_32x32x16_bf16(PAF(0),VFR(0),o[0],0,0,0), C0,0); \
    GAPB(o[1]=__builtin_amdgcn_mfma_f32_32x32x16_bf16(PAF(0),VFR(4),o[1],0,0,0), C0,4); \
    KRD(GL,0); GAPB(o[0]=__builtin_amdgcn_mfma_f32_32x32x16_bf16(PAF(1),VFR(1),o[0],0,0,0), C0,8); \
    KRD(GL,1); GAPB(o[1]=__builtin_amdgcn_mfma_f32_32x32x16_bf16(PAF(1),VFR(5),o[1],0,0,0), C0,12); \
    if constexpr(DQ==64) KRD(GL,2); GAPB(o[0]=__builtin_amdgcn_mfma_f32_32x32x16_bf16(PAF(2),VFR(2),o[0],0,0,0), C1,0); \
    if constexpr(DQ==64) KRD(GL,3); GAPB(o[1]=__builtin_amdgcn_mfma_f32_32x32x16_bf16(PAF(2),VFR(6),o[1],0,0,0), C1,4); \
    GAPB(o[0]=__builtin_amdgcn_mfma_f32_32x32x16_bf16(PAF(3),VFR(3),o[0],0,0,0), C1,8); \
    GAPB(o[1]=__builtin_amdgcn_mfma_f32_32x32x16_bf16(PAF(3),VFR(7),o[1],0,0,0), C1,12); \
    }while(0)
  int t=1;
  #undef CMASK
  #define CMASK(P0,P1,t) do{}while(0)
  for(;t+5<NT;t+=2){
    STEP(pB0,pB1,pA0,pA1,t,true,true,true);     WAIT_BAR(2); RESC(); ROT();
    STEP(pA0,pA1,pB0,pB1,t+1,true,true,true);   WAIT_BAR(2); RESC(); ROT();
  }
  #undef CMASK
  #define CMASK(P0,P1,t) do{}while(0)
  #define ENDW(tt) do{ if((tt)+3<NT){WAIT_BAR(2);} else if((tt)+2<NT){WAIT_BAR(1);} else {WAIT_BAR(0);} }while(0)
  for(;t+1<NT;t+=2){
    STEP(pB0,pB1,pA0,pA1,t,(t+3<NT),(t+1<NT),(t+1<NT));       ENDW(t);   RESC(); ROT();
    STEP(pA0,pA1,pB0,pB1,t+1,(t+4<NT),(t+2<NT),(t+2<NT));     ENDW(t+1); RESC(); ROT();
  }
  STEP(pB0,pB1,pA0,pA1,NT-1,false,false,false); RESC();
  { float sacc=pB0[0]+pB0[1]; _Pragma("unroll") for(int r=2;r<16;++r)sacc+=pB0[r]; _Pragma("unroll") for(int r=0;r<16;++r)sacc+=pB1[r]; l_reg+=sacc;
    pw0=(u32x4){PKW(pB0,0),PKW(pB0,2),PKW(pB0,4),PKW(pB0,6)};pw1=(u32x4){PKW(pB0,8),PKW(pB0,10),PKW(pB0,12),PKW(pB0,14)};pw2=(u32x4){PKW(pB1,0),PKW(pB1,2),PKW(pB1,4),PKW(pB1,6)};pw3=(u32x4){PKW(pB1,8),PKW(pB1,10),PKW(pB1,12),PKW(pB1,14)};
    SBAR(); pv(o,vb0+sl_cur,PAF(0),PAF(1),PAF(2),PAF(3)); }
  #undef PKW
  #undef PAF
  #undef VFR
  #undef PIN
  #undef MX3
  #undef GAPA
  #undef GAPB
  #undef EX
  #undef VRD
  #undef KRD
  #undef STEP
  #undef ENDW
  {auto rr=__builtin_amdgcn_permlane32_swap(__float_as_uint(l_reg),__float_as_uint(l_reg),false,false);l_reg=__uint_as_float(rr[0])+__uint_as_float(rr[1]);}
  if(hi==0)wsf[32+r32]=l_reg;asm volatile("s_waitcnt lgkmcnt(0)":::"memory");
  float rli[16];
  #pragma unroll
  for(int r=0;r<16;++r)rli[r]=__builtin_amdgcn_rcpf(wsf[32+crow(r,hi)]);
  #pragma unroll
  for(int r=0;r<16;++r){o[0][r]*=rli[r];o[1][r]*=rli[r];}
  if constexpr(MODE==0){ bf16*Ow=Ow0+(long)(wid*QBLK)*op; stage_store(o,Ow,op,shm,wid,lane,r32,hi); }
  else { oret[0]=o[0]; oret[1]=o[1]; }
  asm volatile("s_waitcnt lgkmcnt(0)\n\ts_barrier":::"memory");
  #undef DMA_K
  #undef DMA_V
  #undef CMASK
  #undef START
  #undef RESC
  #undef ROT
}
#undef SBAR
#undef WAIT_BAR
}

struct AttnArgs { const bf16_t *QG, *QD, *KG, *VG, *KD, *VD, *CB, *PB; bf16_t* MIX; const float* conv_w; const float* conv_b; const float* subln_g; float lam, lam_init; float* dscr; };

__device__ __forceinline__ void attn_gqa_unit(const AttnArgs& A, LAS char* lds, char* lds_generic, int lat, int seq, int qh, int qb) {
    const long R = lat ? 8192L + (long)SLAT * seq : 256L * seq; const int S = lat ? SLAT : 256;
    const size_t grow0 = (lat ? 8192 + (size_t)4096 * seq : (size_t)256 * seq) + 256 * qb;
    const int kvh = qh >> 2;
    int NT = S / 64; asm volatile("" : "+s"(NT));
    typedef attn64::bf16 abf;
    f32x16 dummy[2];
    attn64::attn_unit<8, 0, 64>((const abf*)(A.QG + grow0 * 512 + 64 * qh), 512, (const abf*)(A.KG + (R * 2 + (long)kvh * S) * 64), 64, (const abf*)(A.VG + (R * 2 + (long)kvh * S) * 64), 64, NT,
                                (abf*)(A.MIX + grow0 * 1024 + 64 * qh), 1024, lds_generic, dummy);
}
__device__ __forceinline__ void attn_diff_unit(const AttnArgs& A, LAS char* lds, char* lds_generic, int lat, int seq, int hd, int qb) {
    const int tid_ = opaque_tid(); const int wave = __builtin_amdgcn_readfirstlane(tid_ >> 6), lane = tid_ & 63, r32 = lane & 31, h = lane >> 5;
    const long R = lat ? 8192L + (long)SLAT * seq : 256L * seq; const int S = lat ? SLAT : 256;
    const size_t grow0 = (lat ? 8192 + (size_t)4096 * seq : (size_t)256 * seq) + 256 * qb;
    int NT = S / 64; asm volatile("" : "+s"(NT));
    typedef attn64::bf16 abf;
    const abf* V = (const abf*)(A.VD + (R * 4 + (long)hd * S) * 64);
    f32x16 oa[2], ob[2];
    attn64::attn_unit<8, 1, 32>((const abf*)(A.QD + grow0 * 256 + 64 * hd), 256, (const abf*)(A.KD + (R * 8 + (long)(hd * 2) * S) * 32), 32, V, 64, NT, (abf*)nullptr, 0, lds_generic, oa);
    GAS float* scr = (GAS float*)A.dscr + ((size_t)(blockIdx.x * 8 + wave) * 32) * 64 + lane;
#pragma unroll
    for (int d0 = 0; d0 < 2; ++d0)
#pragma unroll
        for (int r = 0; r < 16; ++r) scr[(d0 * 16 + r) * 64] = oa[d0][r];
    attn64::attn_unit<8, 1, 32>((const abf*)(A.QD + grow0 * 256 + 64 * hd + 32), 256, (const abf*)(A.KD + (R * 8 + (long)(hd * 2 + 1) * S) * 32), 32, V, 64, NT, (abf*)nullptr, 0, lds_generic, ob);
    float ss[16];
#pragma unroll
    for (int r = 0; r < 16; ++r) {
        const float v0 = scr[r * 64] - A.lam * ob[0][r], v1 = scr[(16 + r) * 64] - A.lam * ob[1][r];
        ob[0][r] = v0; ob[1][r] = v1; ss[r] = v0 * v0 + v1 * v1;
    }
#pragma unroll
    for (int o = 1; o < 32; o <<= 1)
#pragma unroll
        for (int r = 0; r < 16; ++r) ss[r] += __shfl_xor(ss[r], o);
    const float g0 = A.subln_g[r32], g1 = A.subln_g[32 + r32], sc = 1.f - A.lam_init;
#pragma unroll
    for (int r = 0; r < 16; ++r) { const float rstd = rsqrtf(ss[r] * (1.f / 64.f) + EPS) * sc; ob[0][r] *= rstd * g0; ob[1][r] *= rstd * g1; }
    attn64::stage_store(ob, (abf*)(A.MIX + (grow0 + 32 * wave) * 1024 + 768 + 64 * hd), 1024, lds_generic, wave, lane, r32, h);
}

__device__ __forceinline__ void attn_phase(const AttnArgs& A, LAS char* lds, char* lds_generic, int G) {
    for (int u = blockIdx.x; u < 1920; u += G) {
        if (u < 512) { const int b = u & 7, r = u >> 3; attn_diff_unit(A, lds, lds_generic, 1, b, r >> 4, r & 15); }
        else if (u < 1536) { const int v = u - 512, b = v & 7, r = v >> 3; attn_gqa_unit(A, lds, lds_generic, 1, b, r & 7, r >> 3); }
        else if (u < 1664) { const int w = u - 1536; attn_diff_unit(A, lds, lds_generic, 0, w >> 2, w & 3, 0); }
        else { const int w = u - 1664; attn_gqa_unit(A, lds, lds_generic, 0, w >> 3, w & 7, 0); }
    }
    const int tid_c = opaque_tid();
    for (int idx = blockIdx.x * 512 + tid_c; idx < M_ALL * 32; idx += G * 512) {
        const int row = idx >> 5, c8 = (idx & 31) * 8;
        int t, S; if (row < M_CTX) { t = row & 255; S = 256; } else { t = (row - M_CTX) & 4095; S = 4096; }
        const u32x4 z = {0, 0, 0, 0};
        const u32x4 pc = *(const GAS u32x4*)(A.PB + (size_t)row * 256 + c8);
        const u32x4 pp = t > 0 ? *(const GAS u32x4*)(A.PB + (size_t)(row - 1) * 256 + c8) : z;
        const u32x4 pn = t < S - 1 ? *(const GAS u32x4*)(A.PB + (size_t)(row + 1) * 256 + c8) : z;
        const u32x4 cb = *(const GAS u32x4*)(A.CB + (size_t)row * 256 + c8);
        float res[8];
#pragma unroll
        for (int j = 0; j < 8; ++j) {
            const int sh = (j & 1) * 16;
            const float a = __uint_as_float(((pp[j >> 1] >> sh) & 0xffffu) << 16), b = __uint_as_float(((pc[j >> 1] >> sh) & 0xffffu) << 16), c = __uint_as_float(((pn[j >> 1] >> sh) & 0xffffu) << 16);
            const float g = __uint_as_float(((cb[j >> 1] >> sh) & 0xffffu) << 16);
            const int cc = c8 + j;
            res[j] = g * (A.conv_w[cc] * a + A.conv_w[256 + cc] * b + A.conv_w[512 + cc] * c + A.conv_b[cc]);
        }
        u32x4 w; w.x = cvtpk(res[0], res[1]); w.y = cvtpk(res[2], res[3]); w.z = cvtpk(res[4], res[5]); w.w = cvtpk(res[6], res[7]);
        *(GAS u32x4*)(A.MIX + (size_t)row * 1024 + 512 + c8) = w;
    }
}

__device__ __forceinline__ int sigma_map(int type, int i) {
    if (type == 1) return 8 * ((i >> 2) & 3) + 4 * (i >> 4) + (i & 3);
    if (type == 2) return 16 * ((i >> 3) & 1) + 8 * (i >> 4) + (i & 7);
    return i;
}
__device__ __forceinline__ void in_group(int g, int& Lbase, int& type) {
    const int pn = g >> 3, bj = (g >> 2) & 1, wc = g & 3;
    if (pn < 2) { Lbase = 64 * (4 * pn + wc) + 32 * bj; type = 0; }
    else if (pn == 2) { Lbase = (wc < 2 ? 512 + 64 * wc : 640 + 64 * (wc - 2)) + 32 * bj; type = 0; }
    else if (pn == 3) { Lbase = 768 + 128 * bj + 32 * wc; type = 1; }
    else if (pn < 6) { Lbase = 1024 + 256 * bj + 128 * (pn - 4) + 32 * wc; type = 1; }
    else if (pn < 8) { Lbase = (pn == 6 ? 1536 : 1792) + 64 * wc + 32 * bj; type = 2; }
    else { Lbase = 2048 + 64 * wc + 32 * bj; type = 1; }
}
__device__ __forceinline__ void transpose_item(const float* W, int K, int N, bf16_t* WT, int k0, int nphys0, int Lbase, int type, LAS float* scr, int lane) {
#pragma unroll 8
    for (int i = 0; i < 32; ++i) { const int kk = 2 * i + (lane >> 5); scr[kk * 33 + (lane & 31)] = ((const GAS float*)W)[(size_t)(k0 + kk) * N + Lbase + (lane & 31)]; }
    asm volatile("s_waitcnt lgkmcnt(0)" ::: "memory");
    const int c = lane & 7;
#pragma unroll
    for (int j = 0; j < 4; ++j) { const int n = (lane >> 3) + 8 * j; const LAS float* s = scr + (8 * c) * 33 + sigma_map(type, n);
        u32x4 o; o.x = cvtpk(s[0 * 33], s[1 * 33]); o.y = cvtpk(s[2 * 33], s[3 * 33]); o.z = cvtpk(s[4 * 33], s[5 * 33]); o.w = cvtpk(s[6 * 33], s[7 * 33]);
        *(GAS u32x4*)(WT + (size_t)(nphys0 + n) * K + k0 + 8 * c) = o; }
    asm volatile("s_waitcnt lgkmcnt(0)" ::: "memory");
}

struct Params {
    const float *x_prompt, *x_sample, *cache_gk, *cache_gv, *cache_dk, *cache_dv, *c, *c_ctx;
    const float *w_mod, *b_mod, *norm1_g, *w_in, *gqa_qn_g, *gqa_kn_g, *conv_w, *conv_b, *diff_qn_g, *diff_kn_g, *diff_lambda, *diff_subln_g, *w_out, *norm2_g, *ffn_up, *ffn_conv_w, *ffn_conv_b, *ffn_down;
    float* out; unsigned char* ws;
    float lam_init[4];
    int ph_lo, ph_hi;
};

__device__ __forceinline__ void prologue(const Params& P, LAS unsigned char* lds, int G) {
    const int tid = opaque_tid(), lane = tid & 63, wave = __builtin_amdgcn_readfirstlane(tid >> 6);
    float* MODS = (float*)(P.ws + WS_MODS); float* MISC = (float*)(P.ws + WS_MISC);
    if ((int)blockIdx.x < 384) {
        LAS float* sc = (LAS float*)lds;
        LAS float* part = (LAS float*)(lds + 49152);
        for (int i = tid; i < NCOND * 1024; i += 512) { const int ci = i >> 10, k = i & 1023; const float v = ci == 0 ? P.c_ctx[k] : P.c[(ci - 1) * 1024 + k]; sc[k * 12 + ci] = v / (1.f + __expf(-v)); }
        __syncthreads();
        for (int it = blockIdx.x; it < 384; it += G) {
            const int l = it / 96, col = (it % 96) * 64 + lane;
            const float* w = P.w_mod + (size_t)l * 1024 * 6144 + col;
            float acc[NCOND];
#pragma unroll
            for (int ci = 0; ci < NCOND; ++ci) acc[ci] = 0.f;
#pragma unroll 8
            for (int kk = 0; kk < 128; ++kk) { const int k = wave * 128 + kk; const float wv = ((const GAS float*)w)[(size_t)k * 6144];
                const f32x4 s0 = *(LAS f32x4*)(sc + k * 12), s1 = *(LAS f32x4*)(sc + k * 12 + 4); const float s8 = sc[k * 12 + 8];
                acc[0] += s0[0] * wv; acc[1] += s0[1] * wv; acc[2] += s0[2] * wv; acc[3] += s0[3] * wv; acc[4] += s1[0] * wv; acc[5] += s1[1] * wv; acc[6] += s1[2] * wv; acc[7] += s1[3] * wv; acc[8] += s8 * wv; }
#pragma unroll
            for (int ci = 0; ci < NCOND; ++ci) part[(wave * NCOND + ci) * 64 + lane] = acc[ci];
            __syncthreads();
            for (int i = tid; i < NCOND * 64; i += 512) { const int ci = i >> 6, cc = i & 63; float s = 0.f;
#pragma unroll
                for (int w8 = 0; w8 < 8; ++w8) s += part[(w8 * NCOND + ci) * 64 + cc];
                const int j = (it % 96) * 64 + cc; MODS[((size_t)l * NCOND + ci) * 6144 + j] = s + P.b_mod[l * 6144 + j]; }
            __syncthreads();
        }
    }
    if ((int)blockIdx.x == G - 1) {
        if (tid < 4) { const float* lf = P.diff_lambda + tid * 128; float s1 = 0.f, s2 = 0.f; for (int i = 0; i < 32; ++i) { s1 += lf[i] * lf[32 + i]; s2 += lf[64 + i] * lf[96 + i]; }
            MISC[MI_LAM + tid] = expf(s1) - expf(s2) + P.lam_init[tid]; }
        for (int i = tid; i < 1024; i += 512) { const int pos = i >> 4, idx = i & 15; const float fr = powf(10000.f, -(float)idx / 16.f); const float ang = (float)pos * fr; MISC[MI_R64C + i] = cosf(ang); MISC[MI_R64S + i] = sinf(ang); }
        for (int i = tid; i < 512; i += 512) { const int pos = i >> 3, idx = i & 7; const float fr = powf(10000.f, -(float)idx / 8.f); const float ang = (float)pos * fr; MISC[MI_R32C + i] = cosf(ang); MISC[MI_R32S + i] = sinf(ang); }
    }
    __syncthreads();
    LAS float* scr = (LAS float*)(lds + wave * 16384);
    const int gw = blockIdx.x * 8 + wave, NGW = G * 8;
    constexpr int I_IN = 16 * 72, I_OUT = 16 * 32, I_UP = 16 * 176, I_DN = 44 * 32, I_L = I_IN + I_OUT + I_UP + I_DN;
    for (int it = gw; it < DEPTH * I_L; it += NGW) {
        const int l = it / I_L; int r = it % I_L;
        if (r < I_IN) { const int kb = r / 72, g = r % 72; int Lb, ty; in_group(g, Lb, ty);
            transpose_item(P.w_in + (size_t)l * 1024 * INW, 1024, INW, (bf16_t*)(P.ws + WS_WIN) + (size_t)l * INW * 1024, kb * 64, g * 32, Lb, ty, scr, lane); continue; }
        r -= I_IN;
        if (r < I_OUT) { const int kb = r / 32, g = r % 32;
            transpose_item(P.w_out + (size_t)l * 1024 * 1024, 1024, 1024, (bf16_t*)(P.ws + WS_WOUT) + (size_t)l * 1024 * 1024, kb * 64, g * 32, g * 32, 0, scr, lane); continue; }
        r -= I_OUT;
        if (r < I_UP) { const int kb = r / 176, g = r % 176; const int pn = g >> 3, bj = (g >> 2) & 1, wc = g & 3;
            transpose_item(P.ffn_up + (size_t)l * 1024 * UPW, 1024, UPW, (bf16_t*)(P.ws + WS_WUP) + (size_t)l * UPW * 1024, kb * 64, g * 32, bj * DFF + 128 * pn + 32 * wc, 1, scr, lane); continue; }
        r -= I_UP;
        { const int kb = r / 32, g = r % 32;
            transpose_item(P.ffn_down + (size_t)l * DFF * 1024, DFF, 1024, (bf16_t*)(P.ws + WS_WDN) + (size_t)l * 1024 * DFF, kb * 64, g * 32, g * 32, 0, scr, lane); }
    }
}

__device__ __forceinline__ void norm_phase(const float* xin_ctx, const float* xin_lat, const float* ng, const float* mods_l  , int sh_idx, bf16_t* XN, int G) {
    const int tid_ = opaque_tid(); const int lane = tid_ & 63, wave = __builtin_amdgcn_readfirstlane(tid_ >> 6);
    const int nw = G * 8, gw = blockIdx.x * 8 + wave;
    const int per = (M_ALL + nw - 1) / nw;
    const int r0 = gw * per, r1 = min(r0 + per, M_ALL);
    int cur_ci = -1; f32x4 Aa[4], Bb[4];
    for (int row = r0; row < r1; ++row) {
        const int ci = row < M_CTX ? 0 : 1 + ((row - M_CTX) >> 12);
        if (ci != cur_ci) { cur_ci = ci; const float* sh = mods_l + ci * 6144 + sh_idx * 1024; const float* sc = sh + 1024;
#pragma unroll
            for (int j = 0; j < 4; ++j) { const int c = 4 * lane + 256 * j; const f32x4 g4 = *(const GAS f32x4*)(ng + c), s4 = *(const GAS f32x4*)(sc + c); Aa[j] = g4 * (1.f + s4); Bb[j] = *(const GAS f32x4*)(sh + c); } }
        const float* xr = row < M_CTX ? xin_ctx + (size_t)row * DM : xin_lat + (size_t)(row - M_CTX) * DM;
        f32x4 v[4]; float s = 0.f;
#pragma unroll
        for (int j = 0; j < 4; ++j) { v[j] = *(const GAS f32x4*)(xr + 4 * lane + 256 * j); s += (v[j][0] * v[j][0] + v[j][1] * v[j][1]) + (v[j][2] * v[j][2] + v[j][3] * v[j][3]); }
#pragma unroll
        for (int o = 1; o < 64; o <<= 1) s += __shfl_xor(s, o);
        const float rstd = rsqrtf(s * (1.f / DM) + EPS);
#pragma unroll
        for (int j = 0; j < 4; ++j) { const f32x4 y = v[j] * rstd * Aa[j] + Bb[j]; u32x2 w; w.x = cvtpk(y[0], y[1]); w.y = cvtpk(y[2], y[3]); *(GAS u32x2*)(XN + (size_t)row * DM + 4 * lane + 256 * j) = w; }
    }
}

__device__ __forceinline__ void cache_phase(const Params& P, int l, int G) {
    bf16_t* KG = (bf16_t*)(P.ws + WS_KG); bf16_t* VG = (bf16_t*)(P.ws + WS_VG); bf16_t* KD = (bf16_t*)(P.ws + WS_KD); bf16_t* VD = (bf16_t*)(P.ws + WS_VD);
    const int tid_ = opaque_tid();
    for (int i = blockIdx.x * 512 + tid_; i < 65536; i += G * 512) {
        const int d4 = (i & 15) * 4, kvh = (i >> 4) & 1, p = (i >> 5) & 255, b = i >> 13;
        const size_t src = ((((size_t)b * 4 + l) * 256 + p) * 2 + kvh) * 64 + d4;
        const size_t dst = (((8192L + (long)SLAT * b) * 2 + (long)kvh * SLAT + 4096 + p) * 64) + d4;
        const f32x4 k = *(const GAS f32x4*)(P.cache_gk + src), v = *(const GAS f32x4*)(P.cache_gv + src);
        u32x2 wk, wv; wk.x = cvtpk(k[0], k[1]); wk.y = cvtpk(k[2], k[3]); wv.x = cvtpk(v[0], v[1]); wv.y = cvtpk(v[2], v[3]);
        *(GAS u32x2*)(KG + dst) = wk; *(GAS u32x2*)(VG + dst) = wv;
    }
    for (int i = blockIdx.x * 512 + tid_; i < 131072; i += G * 512) {
        { const int d4 = (i & 7) * 4, hc = (i >> 3) & 7, p = (i >> 6) & 255, b = i >> 14;
          const size_t src = ((((size_t)b * 4 + l) * 256 + p) * 8 + hc) * 32 + d4;
          const size_t dst = (((8192L + (long)SLAT * b) * 8 + (long)hc * SLAT + 4096 + p) * 32) + d4;
          const f32x4 k = *(const GAS f32x4*)(P.cache_dk + src); u32x2 w; w.x = cvtpk(k[0], k[1]); w.y = cvtpk(k[2], k[3]); *(GAS u32x2*)(KD + dst) = w; }
        { const int d4 = (i & 15) * 4, hh = (i >> 4) & 3, p = (i >> 6) & 255, b = i >> 14;
          const size_t src = ((((size_t)b * 4 + l) * 256 + p) * 4 + hh) * 64 + d4;
          const size_t dst = (((8192L + (long)SLAT * b) * 4 + (long)hh * SLAT + 4096 + p) * 64) + d4;
          const f32x4 v = *(const GAS f32x4*)(P.cache_dv + src); u32x2 w; w.x = cvtpk(v[0], v[1]); w.y = cvtpk(v[2], v[3]); *(GAS u32x2*)(VD + dst) = w; }
    }
}

__device__ __forceinline__ void fixup_phase(const float* cw, bf16_t* F, const float* EP, const float* EA, const float* EU, int G) {
    const int tid_ = opaque_tid();
    for (int i = blockIdx.x * 512 + tid_; i < 128 * 2 * DFF; i += G * 512) {
        const int c = i % DFF, e = (i / DFF) & 1, pm = 32 + i / (2 * DFF); const int j = (pm - 32) & 15;
        if (e == 0 ? j == 0 : j == 15) continue;
        const size_t eo = ((size_t)pm * 2 + e) * DFF + c;
        float conv;
        if (e == 0) conv = EP[eo] + cw[c] * EA[((size_t)(pm - 1) * 2 + 1) * DFF + c];
        else conv = EP[eo] + cw[2 * DFF + c] * EA[((size_t)(pm + 1) * 2 + 0) * DFF + c];
        const float f = silu_f(conv) * EU[eo];
        const size_t row = (size_t)pm * 256 + (e ? 255 : 0);
        F[row * DFF + c] = (bf16_t)(cvtpk(f, 0.f) & 0xffffu);
    }
}


#define XB_TMO      128
#define XB_XCNT(j)  (256  + 64 * (j))
#define XB_XSUB(j)  (1280 + 64 * (j))
#define XB_XGEN(j)  (2304 + 64 * (j))
#define XB_TOP      3328
#define XB_TOPGEN   3392
#define XCD_BAR_WORDS 3456
#define XB_SPIN_CAP (1u << 22)
__device__ __forceinline__ unsigned xb_ld(unsigned* p)              { return __hip_atomic_load(p, __ATOMIC_RELAXED, __HIP_MEMORY_SCOPE_AGENT); }
__device__ __forceinline__ unsigned xb_add(unsigned* p, unsigned v) { return __hip_atomic_fetch_add(p, v, __ATOMIC_RELAXED, __HIP_MEMORY_SCOPE_AGENT); }
__device__ __forceinline__ unsigned xb_xcc_id() { return (unsigned)__builtin_amdgcn_s_getreg((3 << 11) | 20) & 0xFu; }
#define XB_SPIN(cond, bar) do { unsigned _sp = 0; while (cond) { __builtin_amdgcn_s_sleep(1); \
    if ((++_sp & 255u) == 0u) { if (xb_ld(&(bar)[XB_TMO])) break; if (_sp > XB_SPIN_CAP) { atomicAdd(&(bar)[XB_TMO], 1u); break; } } } } while (0)
struct XcdBarrier { unsigned* bar; unsigned x; volatile LAS unsigned* st; };
__device__ __forceinline__ XcdBarrier xcd_barrier_post(unsigned* bar, volatile LAS unsigned* st) {
    XcdBarrier b; b.bar = bar; b.x = xb_xcc_id(); b.st = st;
    if (threadIdx.x == 0) (void)xb_add(&bar[XB_XCNT(b.x)], 1u);
    return b;
}
__device__ __forceinline__ void xcd_barrier_complete(unsigned* bar, unsigned x, unsigned& nloc, unsigned& nx) {
    const unsigned G = gridDim.x * gridDim.y * gridDim.z;
    unsigned sum, cnt, mine, sp = 0u;
    for (;;) {
        sum = 0u; cnt = 0u; mine = 0u;
#pragma unroll
        for (unsigned j = 0; j < 16; ++j) { const unsigned c = xb_ld(&bar[XB_XCNT(j)]); sum += c; cnt += (c > 0u) ? 1u : 0u; mine = (j == x) ? c : mine; }
        if (sum == G) break;
        __builtin_amdgcn_s_sleep(1);
        if ((++sp & 255u) == 0u) { if (xb_ld(&bar[XB_TMO])) break; if (sp > XB_SPIN_CAP) { atomicAdd(&bar[XB_TMO], 1u); break; } }
    }
    nloc = mine > 0u ? mine : 1u; nx = cnt > 0u ? cnt : 1u;
}
__device__ __forceinline__ void xcd_barrier(const XcdBarrier& b) {
    asm volatile("s_waitcnt vmcnt(0)" ::: "memory");
    __syncthreads();
    if (threadIdx.x == 0) {
        unsigned* bar = b.bar;
        __builtin_amdgcn_s_waitcnt(0);
        unsigned nloc = b.st[0], nx = b.st[1];
        if (nloc == 0u) { xcd_barrier_complete(bar, b.x, nloc, nx); b.st[0] = nloc; b.st[1] = nx; }
        const unsigned old = xb_add(&bar[XB_XSUB(b.x)], 1u);
        const unsigned gen = old / nloc;
        if (old + 1u == (gen + 1u) * nloc) {
            __builtin_amdgcn_fence(__ATOMIC_RELEASE, "agent");
            asm volatile("s_waitcnt vmcnt(0)" ::: "memory");
            const unsigned og = xb_add(&bar[XB_TOP], 1u);
            const unsigned tg = og / nx;
            if (og + 1u == (tg + 1u) * nx) xb_add(&bar[XB_TOPGEN], 1u);
            else XB_SPIN(xb_ld(&bar[XB_TOPGEN]) == tg, bar);
            __builtin_amdgcn_fence(__ATOMIC_ACQUIRE, "agent");
            xb_add(&bar[XB_XGEN(b.x)], 1u);
            asm volatile("s_waitcnt vmcnt(0)" ::: "memory");
        } else {
            XB_SPIN(xb_ld(&bar[XB_XGEN(b.x)]) == gen, bar);
            __builtin_amdgcn_fence(__ATOMIC_ACQUIRE, "agent");
            asm volatile("s_waitcnt vmcnt(0)" ::: "memory");
        }
    }
    __syncthreads();
}

__global__ void __launch_bounds__(512, 2) fwd_kernel(Params P) {
    extern __shared__ __attribute__((aligned(16))) unsigned char lds_raw[];
    LAS unsigned char* lds = (LAS unsigned char*)lds_raw;
    cg::grid_group grid = cg::this_grid();
    const int G = gridDim.x;
    volatile LAS unsigned* bst = (volatile LAS unsigned*)(lds + MISC_OFF);
    if (threadIdx.x < 2) bst[threadIdx.x] = 0u;
    __syncthreads();
    XcdBarrier bar = xcd_barrier_post((unsigned*)(P.ws + WS_CTL), bst);
    int ph = 0;
#define PHASE_BEGIN if (ph >= P.ph_lo && ph < P.ph_hi) { unsigned char* ws = P.ws; float* outp = P.out; asm volatile("" : "+s"(ws), "+s"(outp));
#define PHASE_END   if (ph + 1 < P.ph_hi) { if (ph == 0) grid.sync(); else xcd_barrier(bar); } } ++ph;
    PHASE_BEGIN
#ifndef SKIP_PRO
        prologue(P, lds, G);
#endif
    PHASE_END
    for (int l = 0; l < DEPTH; ++l) {
        PHASE_BEGIN
            const float* xin_ctx = l == 0 ? P.x_prompt : outp; const float* xin_lat = l == 0 ? P.x_sample : outp + (size_t)M_CTX * DM;
            norm_phase(xin_ctx, xin_lat, P.norm1_g + l * DM, (const float*)(ws + WS_MODS) + (size_t)l * NCOND * 6144, 0, (bf16_t*)(ws + WS_XN), G);
            cache_phase(P, l, G);
        PHASE_END
        PHASE_BEGIN {
            const float* MISC = (const float*)(ws + WS_MISC);
            pg8::Gemm g{(const bf16_t*)(ws + WS_XN), (const bf16_t*)(ws + WS_WIN) + (size_t)l * INW * 1024, M_ALL, INW, 1024}; pg8::StaticOrder S; S.init(M_ALL, INW, G, blockIdx.x);
            EpiIn E{l, P.gqa_qn_g + l * 64, P.gqa_kn_g + l * 64, P.diff_qn_g + l * 32, P.diff_kn_g + l * 32, MISC + MI_R64C, MISC + MI_R64S, MISC + MI_R32C, MISC + MI_R32S,
                    (bf16_t*)(ws + WS_QG), (bf16_t*)(ws + WS_QD), (bf16_t*)(ws + WS_KG), (bf16_t*)(ws + WS_VG), (bf16_t*)(ws + WS_KD), (bf16_t*)(ws + WS_VD), (bf16_t*)(ws + WS_CB), (bf16_t*)(ws + WS_PB), outp};
#ifndef SKIP_IN
            pg8::gemm_phase(lds, lds + XCH_OFF, g, S, E);
#endif
        } PHASE_END
        PHASE_BEGIN {
            const float* MISC = (const float*)(ws + WS_MISC);
            AttnArgs A{(const bf16_t*)(ws + WS_QG), (const bf16_t*)(ws + WS_QD), (const bf16_t*)(ws + WS_KG), (const bf16_t*)(ws + WS_VG), (const bf16_t*)(ws + WS_KD), (const bf16_t*)(ws + WS_VD),
                       (const bf16_t*)(ws + WS_CB), (const bf16_t*)(ws + WS_PB), (bf16_t*)(ws + WS_XN), P.conv_w + l * 768, P.conv_b + l * 256, P.diff_subln_g + l * 64, MISC[MI_LAM + l], P.lam_init[l], (float*)(ws + WS_DSCR)};
#ifndef SKIP_ATT
            attn_phase(A, (LAS char*)lds, (char*)lds_raw, G);
#endif
        } PHASE_END
        PHASE_BEGIN {
            const float* xin_ctx = l == 0 ? P.x_prompt : outp; const float* xin_lat = l == 0 ? P.x_sample : outp + (size_t)M_CTX * DM;
            pg8::Gemm g{(const bf16_t*)(ws + WS_XN), (const bf16_t*)(ws + WS_WOUT) + (size_t)l * 1024 * 1024, M_ALL, 1024, 1024}; pg8::StaticOrder S; S.init(M_ALL, 1024, G, blockIdx.x);
            EpiRes E{xin_ctx, xin_lat, outp, (const float*)(ws + WS_MODS) + (size_t)l * NCOND * 6144 + 2 * 1024};
#ifndef SKIP_RES
            pg8::gemm_phase(lds, lds + XCH_OFF, g, S, E);
#endif
        } PHASE_END
        PHASE_BEGIN
            norm_phase(outp, outp + (size_t)M_CTX * DM, P.norm2_g + l * DM, (const float*)(ws + WS_MODS) + (size_t)l * NCOND * 6144, 3, (bf16_t*)(ws + WS_XN), G);
        PHASE_END
        PHASE_BEGIN {
            float* EPb = (float*)(ws + WS_EDGE);
            pg8::Gemm g{(const bf16_t*)(ws + WS_XN), (const bf16_t*)(ws + WS_WUP) + (size_t)l * UPW * 1024, M_ALL, UPW, 1024}; pg8::StaticOrder S; S.init(M_ALL, UPW, G, blockIdx.x);
            EpiUp E{P.ffn_conv_w + (size_t)l * 3 * DFF, P.ffn_conv_b + (size_t)l * DFF, (bf16_t*)(ws + WS_U), EPb, EPb + EDGE_ELEMS, EPb + 2 * EDGE_ELEMS};
#ifndef SKIP_UP
            pg8::gemm_phase(lds, lds + XCH_OFF, g, S, E);
#endif
        } PHASE_END
        PHASE_BEGIN {
            float* EPb = (float*)(ws + WS_EDGE);
            fixup_phase(P.ffn_conv_w + (size_t)l * 3 * DFF, (bf16_t*)(ws + WS_U), EPb, EPb + EDGE_ELEMS, EPb + 2 * EDGE_ELEMS, G);
        } PHASE_END
        PHASE_BEGIN {
            pg8::Gemm g{(const bf16_t*)(ws + WS_U), (const bf16_t*)(ws + WS_WDN) + (size_t)l * 1024 * DFF, M_ALL, 1024, DFF}; pg8::StaticOrder S; S.init(M_ALL, 1024, G, blockIdx.x);
            EpiRes E{outp, outp + (size_t)M_CTX * DM, outp, (const float*)(ws + WS_MODS) + (size_t)l * NCOND * 6144 + 5 * 1024};
#ifndef SKIP_RES
            pg8::gemm_phase(lds, lds + XCH_OFF, g, S, E);
#endif
        } PHASE_END
    }
}

constexpr int N_PHASES = 1 + DEPTH * 8;
#ifndef N_LAUNCH_SPLIT
#define N_LAUNCH_SPLIT 0
#endif

extern "C" void kernel_launch(void* const* d_in, const int* in_sizes, int n_in, void* d_out, int out_size, void* d_ws, size_t ws_size, hipStream_t stream) {
    static int grid = 0;
    if (grid == 0) {
        if (n_in != 26 || ws_size < WS_END) { fprintf(stderr, "kernel_launch: unexpected n_in %d or ws_size %zu (< %zu)\n", n_in, ws_size, (size_t)WS_END); grid = -1; return; }
        int dev = 0, cus = 0, per_cu = 0;
        hipGetDevice(&dev); hipDeviceGetAttribute(&cus, hipDeviceAttributeMultiprocessorCount, dev);
        hipFuncSetAttribute((const void*)fwd_kernel, hipFuncAttributeMaxDynamicSharedMemorySize, LDS_BYTES);
        hipOccupancyMaxActiveBlocksPerMultiprocessor(&per_cu, (const void*)fwd_kernel, 512, LDS_BYTES);
        if (per_cu < 1) { fprintf(stderr, "kernel_launch: occupancy query gives %d\n", per_cu); per_cu = 1; }
        (void)hipGetLastError();
        grid = cus * 1;
    }
    if (grid < 0) return;
    Params p{};
    const float** pp = (const float**)&p;
    for (int i = 0; i < 26; ++i) pp[i] = (const float*)d_in[i];
    p.out = (float*)d_out; p.ws = (unsigned char*)d_ws;
    for (int l = 0; l < 4; ++l) p.lam_init[l] = (float)(0.8 - 0.6 * exp(-0.3 * (double)l));
#if N_LAUNCH_SPLIT
    for (int ph = 0; ph < N_PHASES; ++ph) { p.ph_lo = ph; p.ph_hi = ph + 1; hipLaunchKernelGGL(fwd_kernel, dim3(grid), dim3(512), LDS_BYTES, stream, p); }
#else
    p.ph_lo = 0; p.ph_hi = N_PHASES;
    if (hipMemsetAsync((char*)d_ws + WS_CTL, 0, CTL_ZERO_BYTES, stream) != hipSuccess) { fprintf(stderr, "kernel_launch: memset failed\n"); return; }
    void* args[] = {&p};
    hipError_t e = hipLaunchCooperativeKernel((const void*)fwd_kernel, dim3(grid), dim3(512), args, LDS_BYTES, stream);
    if (e != hipSuccess) fprintf(stderr, "cooperative launch failed: %s (grid %d)\n", hipGetErrorString(e), grid);
#endif
}
```

```cpp
#include <hip/hip_runtime.h>
#include <hip/hip_cooperative_groups.h>
#include <cstdio>
#include <cstdint>
#include <cmath>
namespace cg = cooperative_groups;

#define LAS __attribute__((address_space(3)))
#define GAS __attribute__((address_space(1)))
typedef unsigned short bf16_t;
typedef short bf16x8 __attribute__((ext_vector_type(8)));
typedef short s16x4 __attribute__((ext_vector_type(4)));
typedef float f32x4 __attribute__((ext_vector_type(4)));
typedef float f32x16 __attribute__((ext_vector_type(16)));
typedef unsigned u32x4 __attribute__((ext_vector_type(4)));
typedef unsigned u32x2 __attribute__((ext_vector_type(2)));
typedef float f32x2 __attribute__((ext_vector_type(2)));
typedef __bf16 bf16x2_t __attribute__((ext_vector_type(2)));

__device__ __forceinline__ unsigned cvtpk(float lo, float hi) { f32x2 v = {lo, hi}; bf16x2_t b = __builtin_convertvector(v, bf16x2_t); return __builtin_bit_cast(unsigned, b); }
__device__ __forceinline__ int opaque_tid() { int t = threadIdx.x; asm volatile("" : "+v"(t)); return t; }
__device__ __forceinline__ float bf2f(unsigned short u) { return __uint_as_float(((unsigned)u) << 16); }

constexpr int DM = 1024, DEPTH = 4, NCOND = 9;
constexpr int M_CTX = 8192, M_ALL = 40960, NTM = 160;
constexpr int INW = 2304, DFF = 2816, UPW = 5632;
constexpr int SLAT = 4352;
constexpr float EPS = 1e-6f;
constexpr float LOG2E = 1.4426950408889634f;
constexpr float QSCALE_G = 0.125f * LOG2E;
constexpr float QSCALE_D = 0.17677669529663687f * LOG2E;
constexpr size_t OUT_GK = 41943040, OUT_GV = OUT_GK + 4194304, OUT_DK = OUT_GV + 4194304, OUT_DV = OUT_DK + 8388608;
constexpr size_t MiB = 1u << 20;
constexpr size_t WS_MODS = 1 * MiB;
constexpr size_t WS_MISC = 2 * MiB;
constexpr size_t WS_EDGE = 3 * MiB;
constexpr size_t EDGE_ELEMS = (size_t)NTM * 2 * DFF;
constexpr size_t WS_WIN = 16 * MiB;
constexpr size_t WS_WOUT = 34 * MiB;
constexpr size_t WS_WUP = 42 * MiB;
constexpr size_t WS_WDN = 86 * MiB;
constexpr size_t WS_XN = 108 * MiB;
constexpr size_t WS_U = 188 * MiB;
constexpr size_t WS_QG = WS_U, WS_QD = WS_QG + (size_t)M_ALL * 512 * 2, WS_KG = WS_QD + (size_t)M_ALL * 256 * 2;
constexpr size_t KROWS = 8192 + 8 * SLAT;
constexpr size_t WS_VG = WS_KG + KROWS * 128 * 2, WS_KD = WS_VG + KROWS * 128 * 2, WS_VD = WS_KD + KROWS * 256 * 2;
constexpr size_t WS_CB = WS_VD + KROWS * 256 * 2, WS_PB = WS_CB + (size_t)M_ALL * 256 * 2, WS_UEND = WS_PB + (size_t)M_ALL * 256 * 2;
constexpr size_t WS_DSCR = WS_U + (size_t)M_ALL * DFF * 2;
constexpr size_t WS_END = WS_DSCR + 32 * MiB;
static_assert(WS_UEND <= WS_DSCR, "union");
constexpr int MI_LAM = 0, MI_R64C = 64, MI_R64S = MI_R64C + 1024, MI_R32C = MI_R64S + 1024, MI_R32S = MI_R32C + 512;

constexpr int RING_BYTES = 131072, XCH_OFF = RING_BYTES, MISC_OFF = RING_BYTES + 4096, LDS_BYTES = RING_BYTES + 4096 + 256;
constexpr size_t WS_CTL = 0, CTL_ZERO_BYTES = 65536;

struct TileInfo {
    int lat, seq, t0, ci, S; long R;
    __device__ __forceinline__ TileInfo(int pm) {
        if (pm < 32) { lat = 0; seq = pm; t0 = 0; ci = 0; S = 256; R = 256L * pm; }
        else { const int b = (pm - 32) >> 4; lat = 1; seq = b; t0 = ((pm - 32) & 15) * 256; ci = 1 + b; S = SLAT; R = 8192L + (long)SLAT * b; }
    }
};

namespace pg8 {
constexpr int BM = 256, BK = 64, HALF = 128, HTB = HALF * BK * 2, NXCD = 8, WGM = 8;
__host__ __device__ __forceinline__ int lds_byte(int r, int c) { const int st = (r >> 4) * 2 + (c >> 5), rr = r & 15, cc = c & 31, ob = rr * 64 + cc * 2; return st * 1024 + (ob ^ (((ob >> 9) & 1) << 5)); }
__host__ __device__ __forceinline__ void stage_rc(int b, int& R, int& C) { const int st = b / 1024, sb = b % 1024, swz = sb ^ (((sb >> 9) & 1) << 5); R = (st >> 1) * 16 + swz / 64; C = (st & 1) * 32 + (swz % 64) / 2; }
struct Unit { int pm, pn; };
struct Gemm { const bf16_t* A; const bf16_t* Bt; int M, N, K; };
struct StaticOrder {
    int nM, nN, nwg, G, c;
    __device__ void init(int M, int N, int G_, int c_) { nM = M / BM; nN = N / BM; nwg = nM * nN; G = G_; c = c_; }
    __device__ bool next(int i, Unit& u) const {
        const long L = (long)i * G + c; if (L >= nwg) return false;
        int wgid = (int)L; { const int q = nwg / NXCD, r = nwg % NXCD, xcd = wgid % NXCD, off = wgid / NXCD; wgid = (xcd < r ? xcd * (q + 1) : r * (q + 1) + (xcd - r) * q) + off; }
        const int nig = WGM * nN, gid = wgid / nig, fm = gid * WGM, gsz = (nM - fm) < WGM ? (nM - fm) : WGM;
        u.pm = fm + ((wgid % nig) % gsz); u.pn = (wgid % nig) / gsz; return true;
    }
};
template <class Epi>
__device__ __forceinline__ void gemm_phase(LAS unsigned char* lds, LAS unsigned char* xlds, const Gemm g, const StaticOrder& S, const Epi& E) {
    const int tid = opaque_tid(), wid = __builtin_amdgcn_readfirstlane(tid >> 6), lane = tid & 63, wr = wid >> 2, wc = wid & 3, fr = lane & 15, fq = lane >> 4;
    const int K = g.K, nt = K / BK;
    unsigned voffA[2];
#pragma unroll
    for (int i = 0; i < 2; ++i) { int R, C; stage_rc(tid * 16 + i * 8192, R, C); voffA[i] = (unsigned)(R * K + C) * 2u; }
    const size_t kstep = (size_t)(BK * 2);
    const size_t hstep = (size_t)HALF * K * 2;
    const size_t tstep = 2 * hstep;
    const unsigned ldsw = (unsigned)wid * 1024u;
    const int aoff = lds_byte(wr * 64 + fr, fq * 8), boff = lds_byte(wc * 32 + fr, fq * 8);
#define PG8_SA(b, h) (((b) * 2 + (h)) * HTB)
#define PG8_SB(b, h) ((4 + (b) * 2 + (h)) * HTB)
#define PG8_STAGE(bufoff, gbase) do { _Pragma("unroll") for (int _i = 0; _i < 2; ++_i) \
        __builtin_amdgcn_global_load_lds((const unsigned*)((const char*)(gbase) + voffA[_i]), (LAS unsigned*)(lds + (bufoff) + ldsw + _i * 8192), 16, 0, 0); } while (0)
#define PG8_LDA(dst, b, h) do { _Pragma("unroll") for (int m = 0; m < 4; ++m) _Pragma("unroll") for (int k = 0; k < 2; ++k) dst[m][k] = *(const LAS bf16x8*)(lds + PG8_SA(b, h) + aoff + m * 2048 + k * 1024); } while (0)
#define PG8_LDB(dst, b, h) do { _Pragma("unroll") for (int n = 0; n < 2; ++n) _Pragma("unroll") for (int k = 0; k < 2; ++k) dst[n][k] = *(const LAS bf16x8*)(lds + PG8_SB(b, h) + boff + n * 2048 + k * 1024); } while (0)
#define PG8_MMA(ai, bj, At, Bt) do { __builtin_amdgcn_s_setprio(1); _Pragma("unroll") for (int m = 0; m < 4; ++m) _Pragma("unroll") for (int n = 0; n < 2; ++n) _Pragma("unroll") for (int k = 0; k < 2; ++k) \
        acc[ai][bj][m][n] = __builtin_amdgcn_mfma_f32_16x16x32_bf16(Bt[n][k], At[m][k], acc[ai][bj][m][n], 0, 0, 0); __builtin_amdgcn_s_setprio(0); } while (0)
#define PG8_WAIT_V(n) asm volatile("s_waitcnt vmcnt(" #n ")" ::: "memory")
#define PG8_WAIT_L(n) asm volatile("s_waitcnt lgkmcnt(" #n ")" ::: "memory")
#define PG8_BAR __builtin_amdgcn_s_barrier()
#define PG8_SCHED __builtin_amdgcn_sched_barrier(0)
    Unit cur, nxt; int ui = 0;
    if (!S.next(0, cur)) return;
    f32x4 acc[2][2][4][2];
#pragma unroll
    for (int a = 0; a < 2; ++a)
#pragma unroll
        for (int b = 0; b < 2; ++b)
#pragma unroll
            for (int m = 0; m < 4; ++m)
#pragma unroll
                for (int n = 0; n < 2; ++n) acc[a][b][m][n] = (f32x4){0.f, 0.f, 0.f, 0.f};
    bf16x8 At[4][2], B0[2][2], B1[2][2];
    const char* cA = (const char*)g.A + (size_t)cur.pm * tstep; const char* cB = (const char*)g.Bt + (size_t)cur.pn * tstep;
    PG8_STAGE(PG8_SB(0, 0), cB); PG8_STAGE(PG8_SB(0, 1), cB + hstep); PG8_STAGE(PG8_SA(0, 0), cA); PG8_STAGE(PG8_SA(0, 1), cA + hstep);
    if (wr == 1) PG8_BAR;
    PG8_WAIT_V(2); PG8_BAR;
    PG8_STAGE(PG8_SB(1, 0), cB + kstep); PG8_STAGE(PG8_SA(1, 0), cA + kstep); PG8_STAGE(PG8_SB(1, 1), cB + hstep + kstep);
    PG8_WAIT_V(6); PG8_BAR;
    for (;;) {
        const bool has_next = S.next(ui + 1, nxt);
        const char* nA = has_next ? (const char*)g.A + (size_t)nxt.pm * tstep : cA; const char* nB = has_next ? (const char*)g.Bt + (size_t)nxt.pn * tstep : cB;
        for (int t = 0; t < nt; t += 2) {
            const bool last = (t == nt - 2);
            const char* a1 = cA + (size_t)(t + 1) * kstep;
            const char* a2 = last ? nA : cA + (size_t)(t + 2) * kstep; const char* b2 = last ? nB : cB + (size_t)(t + 2) * kstep;
            const char* a3 = a2 + kstep; const char* b3 = b2 + kstep;
            PG8_LDB(B0, 0, 0); PG8_LDB(B1, 0, 1); PG8_SCHED; PG8_LDA(At, 0, 0); PG8_STAGE(PG8_SA(1, 1), a1 + hstep);
            PG8_WAIT_V(8); PG8_WAIT_L(0); PG8_BAR; PG8_MMA(0, 0, At, B0); PG8_MMA(0, 1, At, B1); PG8_BAR; PG8_SCHED;
            PG8_LDA(At, 0, 1); PG8_STAGE(PG8_SB(0, 0), b2); PG8_STAGE(PG8_SB(0, 1), b2 + hstep); PG8_STAGE(PG8_SA(0, 0), a2);
            PG8_WAIT_V(8); PG8_WAIT_L(0); PG8_BAR; PG8_MMA(1, 0, At, B0); PG8_MMA(1, 1, At, B1); PG8_BAR; PG8_SCHED;
            PG8_LDB(B0, 1, 0); PG8_LDB(B1, 1, 1); PG8_SCHED; PG8_LDA(At, 1, 0); PG8_STAGE(PG8_SA(0, 1), a2 + hstep);
            PG8_WAIT_V(8); PG8_WAIT_L(0); PG8_BAR; PG8_MMA(0, 0, At, B0); PG8_MMA(0, 1, At, B1); PG8_BAR; PG8_SCHED;
            PG8_LDA(At, 1, 1); PG8_STAGE(PG8_SB(1, 0), b3); PG8_STAGE(PG8_SB(1, 1), b3 + hstep); PG8_STAGE(PG8_SA(1, 0), a3);
            PG8_WAIT_V(8); PG8_WAIT_L(0); PG8_BAR; PG8_MMA(1, 0, At, B0); PG8_MMA(1, 1, At, B1); PG8_BAR; PG8_SCHED;
        }
        if (wr == 0) PG8_BAR;
        { int fr_ = fr, fq_ = fq; asm volatile("" : "+v"(fr_), "+v"(fq_)); E(acc, cur, wr, wc, fr_, fq_, xlds); }
        if (!has_next) break;
#pragma unroll
        for (int a = 0; a < 2; ++a)
#pragma unroll
            for (int b = 0; b < 2; ++b)
#pragma unroll
                for (int m = 0; m < 4; ++m)
#pragma unroll
                    for (int n = 0; n < 2; ++n) acc[a][b][m][n] = (f32x4){0.f, 0.f, 0.f, 0.f};
        cur = nxt; cA = nA; cB = nB; ++ui;
        if (wr == 1) PG8_BAR;
    }
    PG8_WAIT_V(0);
    PG8_BAR;
#undef PG8_SA
#undef PG8_SB
#undef PG8_STAGE
#undef PG8_LDA
#undef PG8_LDB
#undef PG8_MMA
#undef PG8_WAIT_V
#undef PG8_WAIT_L
#undef PG8_BAR
#undef PG8_SCHED
}
}

typedef f32x4 Acc[2][2][4][2];

struct EpiRes {
    const float* xin_ctx; const float* xin_lat; float* xout; const float* gate;
    __device__ __forceinline__ void operator()(const Acc& acc, const pg8::Unit& u, int wr, int wc, int fr, int fq, LAS unsigned char*) const {
        const TileInfo ti(u.pm);
        const int col0 = u.pn * 256 + wc * 32 + 4 * fq;
        const float* gp = gate + ti.ci * 6144 + col0;
        f32x4 g4[2][2];
#pragma unroll
        for (int bj = 0; bj < 2; ++bj)
#pragma unroll
            for (int n = 0; n < 2; ++n) g4[bj][n] = *(const GAS f32x4*)(gp + bj * 128 + n * 16);
        const float* xin = ti.lat ? xin_lat + (size_t)(u.pm * 256 - M_CTX) * DM : xin_ctx + (size_t)(u.pm * 256) * DM;
        float* xo = xout + (size_t)(u.pm * 256) * DM;
#pragma unroll
        for (int ai = 0; ai < 2; ++ai) {
            f32x4 xv[4][2][2];
#pragma unroll
            for (int m = 0; m < 4; ++m) {
                const size_t off = (size_t)(ai * 128 + wr * 64 + m * 16 + fr) * DM + col0;
#pragma unroll
                for (int bj = 0; bj < 2; ++bj)
#pragma unroll
                    for (int n = 0; n < 2; ++n) xv[m][bj][n] = *(const GAS f32x4*)(xin + off + bj * 128 + n * 16);
            }
#pragma unroll
            for (int m = 0; m < 4; ++m) {
                const size_t off = (size_t)(ai * 128 + wr * 64 + m * 16 + fr) * DM + col0;
#pragma unroll
                for (int bj = 0; bj < 2; ++bj)
#pragma unroll
                    for (int n = 0; n < 2; ++n) *(GAS f32x4*)(xo + off + bj * 128 + n * 16) = xv[m][bj][n] + g4[bj][n] * acc[ai][bj][m][n];
            }
            __builtin_amdgcn_sched_group_barrier(0x020, 16, 0);
            asm volatile("" ::: "memory");
            __builtin_amdgcn_sched_barrier(0);
        }
    }
};

struct EpiIn {
    int layer;
    const float *qn_g, *kn_g, *dqn_g, *dkn_g;
    const float *r64c, *r64s, *r32c, *r32s;
    bf16_t *QG, *QD, *KG, *VG, *KD, *VD, *CB, *PB;
    float* out;
    __device__ __forceinline__ void operator()(const Acc& acc, const pg8::Unit& u, int wr, int wc, int fr, int fq, LAS unsigned char*) const {
        const TileInfo ti(u.pm);
        const int pn = u.pn;
        const int rbase = wr * 64 + fr;
        if (pn < 2 || (pn == 2 && wc < 2)) {
            const bool isq = pn < 2;
            const float* gsrc = (isq ? qn_g : kn_g) + 4 * fq;
            const int head = isq ? 4 * pn + wc : wc;
#pragma unroll
            for (int ai = 0; ai < 2; ++ai)
#pragma unroll
                for (int m = 0; m < 4; ++m) {
                    const int rt = ai * 128 + m * 16 + rbase; const int t = ti.t0 + rt;
                    float ss = 0.f;
#pragma unroll
                    for (int bj = 0; bj < 2; ++bj)
#pragma unroll
                        for (int n = 0; n < 2; ++n) { const f32x4 v = acc[ai][bj][m][n]; ss += (v[0] * v[0] + v[1] * v[1]) + (v[2] * v[2] + v[3] * v[3]); }
                    ss += __shfl_xor(ss, 16); ss += __shfl_xor(ss, 32);
                    const float rstd = rsqrtf(ss * (1.f / 64.f) + EPS);
                    bf16_t* dst = isq ? QG + ((size_t)u.pm * 256 + rt) * 512 + head * 64 + 4 * fq : KG + ((ti.R * 2 + (long)head * ti.S + t) * 64) + 4 * fq;
                    float* o = out + OUT_GK + ((size_t)(ti.seq * 4 + layer) * 256 + t) * 128 + head * 64 + 4 * fq;
#pragma unroll
                    for (int bj = 0; bj < 2; ++bj) {
                        f32x4 y0 = acc[ai][bj][m][0] * rstd * *(const GAS f32x4*)(gsrc + 32 * bj), y1 = acc[ai][bj][m][1] * rstd * *(const GAS f32x4*)(gsrc + 32 * bj + 16);
                        if (!isq && !ti.lat) { *(GAS f32x4*)(o + 32 * bj) = y0; *(GAS f32x4*)(o + 32 * bj + 16) = y1; }
                        if (ti.lat) {
                            const int pos = bj ? (t & 63) : (t >> 6);
                            const f32x4 c4 = *(const GAS f32x4*)(r64c + pos * 16 + 4 * fq), s4 = *(const GAS f32x4*)(r64s + pos * 16 + 4 * fq);
                            const f32x4 o0 = y0 * c4 - y1 * s4, o1 = y1 * c4 + y0 * s4; y0 = o0; y1 = o1;
                        }
                        if (isq) { y0 = y0 * QSCALE_G; y1 = y1 * QSCALE_G; }
                        u32x2 w0, w1; w0.x = cvtpk(y0[0], y0[1]); w0.y = cvtpk(y0[2], y0[3]); w1.x = cvtpk(y1[0], y1[1]); w1.y = cvtpk(y1[2], y1[3]);
                        *(GAS u32x2*)(dst + 32 * bj) = w0; *(GAS u32x2*)(dst + 32 * bj + 16) = w1;
                    }
                    asm volatile("" ::: "memory");
                }
        } else if (pn == 2) {
            const int head = wc - 2;
#pragma unroll
            for (int ai = 0; ai < 2; ++ai)
#pragma unroll
                for (int m = 0; m < 4; ++m) {
                    const int rt = ai * 128 + m * 16 + rbase; const int t = ti.t0 + rt;
                    if (!ti.lat) {
                        float* o = out + OUT_GV + ((size_t)(ti.seq * 4 + layer) * 256 + t) * 128 + head * 64 + 4 * fq;
#pragma unroll
                        for (int bj = 0; bj < 2; ++bj)
#pragma unroll
                            for (int n = 0; n < 2; ++n) *(GAS f32x4*)(o + 32 * bj + 16 * n) = acc[ai][bj][m][n];
                    }
                    bf16_t* vp = VG + ((ti.R * 2 + (long)head * ti.S + t) * 64) + 4 * fq;
#pragma unroll
                    for (int bj = 0; bj < 2; ++bj)
#pragma unroll
                        for (int n = 0; n < 2; ++n) { const f32x4 v = acc[ai][bj][m][n]; u32x2 w; w.x = cvtpk(v[0], v[1]); w.y = cvtpk(v[2], v[3]); *(GAS u32x2*)(vp + 32 * bj + 16 * n) = w; }
                }
        } else if (pn == 3) {
#pragma unroll
            for (int ai = 0; ai < 2; ++ai)
#pragma unroll
                for (int m = 0; m < 4; ++m) {
                    const size_t grow = (size_t)u.pm * 256 + ai * 128 + m * 16 + rbase;
                    bf16_t* p = CB + grow * 256 + 32 * wc + 8 * fq;
#pragma unroll
                    for (int bj = 0; bj < 2; ++bj) { const f32x4 a = acc[ai][bj][m][0], b = acc[ai][bj][m][1]; u32x4 w; w.x = cvtpk(a[0], a[1]); w.y = cvtpk(a[2], a[3]); w.z = cvtpk(b[0], b[1]); w.w = cvtpk(b[2], b[3]); *(GAS u32x4*)(p + 128 * bj) = w; }
                }
        } else if (pn < 6) {
#pragma unroll
            for (int ai = 0; ai < 2; ++ai)
#pragma unroll
                for (int m = 0; m < 4; ++m) {
                    const size_t grow = (size_t)u.pm * 256 + ai * 128 + m * 16 + rbase;
                    bf16_t* p = PB + grow * 256 + 128 * (pn - 4) + 32 * wc + 8 * fq;
                    const f32x4 a = acc[ai][0][m][0] * acc[ai][1][m][0], b = acc[ai][0][m][1] * acc[ai][1][m][1];
                    u32x4 w; w.x = cvtpk(a[0], a[1]); w.y = cvtpk(a[2], a[3]); w.z = cvtpk(b[0], b[1]); w.w = cvtpk(b[2], b[3]); *(GAS u32x4*)p = w;
                }
        } else if (pn < 8) {
            const bool isq = pn == 6;
            const float* gsrc = isq ? dqn_g : dkn_g;
            const int a_ax = fq >> 1, ib = 4 * (fq & 1);
            const float* gp = gsrc + 16 * a_ax + ib;
            const int head = wc;
#pragma unroll
            for (int ai = 0; ai < 2; ++ai)
#pragma unroll
                for (int m = 0; m < 4; ++m) {
                    const int rt = ai * 128 + m * 16 + rbase; const int t = ti.t0 + rt; const size_t grow = (size_t)u.pm * 256 + rt;
#pragma unroll
                    for (int bj = 0; bj < 2; ++bj) {
                        float ss = 0.f;
#pragma unroll
                        for (int n = 0; n < 2; ++n) { const f32x4 v = acc[ai][bj][m][n]; ss += (v[0] * v[0] + v[1] * v[1]) + (v[2] * v[2] + v[3] * v[3]); }
                        ss += __shfl_xor(ss, 16); ss += __shfl_xor(ss, 32);
                        const float rstd = rsqrtf(ss * (1.f / 32.f) + EPS);
                        f32x4 y0 = acc[ai][bj][m][0] * rstd * *(const GAS f32x4*)gp, y1 = acc[ai][bj][m][1] * rstd * *(const GAS f32x4*)(gp + 8);
                        if (!isq && !ti.lat) {
                            float* o = out + OUT_DK + ((size_t)(ti.seq * 4 + layer) * 256 + t) * 256 + head * 64 + bj * 32 + 16 * a_ax + ib;
                            *(GAS f32x4*)(o) = y0; *(GAS f32x4*)(o + 8) = y1;
                        }
                        if (ti.lat) {
                            const int pos = a_ax ? (t & 63) : (t >> 6);
                            const f32x4 c4 = *(const GAS f32x4*)(r32c + pos * 8 + ib), s4 = *(const GAS f32x4*)(r32s + pos * 8 + ib);
                            const f32x4 o0 = y0 * c4 - y1 * s4, o1 = y1 * c4 + y0 * s4; y0 = o0; y1 = o1;
                        }
                        bf16_t* dst;
                        if (isq) { y0 = y0 * QSCALE_D; y1 = y1 * QSCALE_D; dst = QD + grow * 256 + head * 64 + bj * 32 + 16 * a_ax + ib; }
                        else dst = KD + ((ti.R * 8 + (long)(head * 2 + bj) * ti.S + t) * 32) + 16 * a_ax + ib;
                        u32x2 w0, w1; w0.x = cvtpk(y0[0], y0[1]); w0.y = cvtpk(y0[2], y0[3]); w1.x = cvtpk(y1[0], y1[1]); w1.y = cvtpk(y1[2], y1[3]);
                        *(GAS u32x2*)dst = w0; *(GAS u32x2*)(dst + 8) = w1;
                    }
                    asm volatile("" ::: "memory");
                }
        } else {
            const int head = wc;
#pragma unroll
            for (int ai = 0; ai < 2; ++ai)
#pragma unroll
                for (int m = 0; m < 4; ++m) {
                    const int rt = ai * 128 + m * 16 + rbase; const int t = ti.t0 + rt;
                    if (!ti.lat) {
                        float* o = out + OUT_DV + ((size_t)(ti.seq * 4 + layer) * 256 + t) * 256 + head * 64 + 8 * fq;
#pragma unroll
                        for (int bj = 0; bj < 2; ++bj) { *(GAS f32x4*)(o + 32 * bj) = acc[ai][bj][m][0]; *(GAS f32x4*)(o + 32 * bj + 4) = acc[ai][bj][m][1]; }
                    }
                    bf16_t* vp = VD + ((ti.R * 4 + (long)head * ti.S + t) * 64) + 8 * fq;
#pragma unroll
                    for (int bj = 0; bj < 2; ++bj) { const f32x4 a = acc[ai][bj][m][0], b = acc[ai][bj][m][1]; u32x4 w; w.x = cvtpk(a[0], a[1]); w.y = cvtpk(a[2], a[3]); w.z = cvtpk(b[0], b[1]); w.w = cvtpk(b[2], b[3]); *(GAS u32x4*)(vp + 32 * bj) = w; }
                }
        }
    }
};

__device__ __forceinline__ float dpp_ror1(float x) { return __int_as_float(__builtin_amdgcn_update_dpp(0, __float_as_int(x), 0x121, 0xf, 0xf, false)); }
__device__ __forceinline__ float dpp_ror15(float x) { return __int_as_float(__builtin_amdgcn_update_dpp(0, __float_as_int(x), 0x12F, 0xf, 0xf, false)); }
__device__ __forceinline__ float silu_f(float x) { return x * __builtin_amdgcn_rcpf(1.f + __builtin_amdgcn_exp2f(-x * LOG2E)); }
struct EpiUp {
    const float* cw; const float* cbias; bf16_t* F; float* EP; float* EA; float* EU;
    __device__ __forceinline__ void operator()(const Acc& acc, const pg8::Unit& u, int wr, int wc, int fr, int fq, LAS unsigned char* xlds) const {
        const TileInfo ti(u.pm);
        const int c0 = u.pn * 128 + wc * 32 + 8 * fq;
        LAS float* X = (LAS float*)xlds;
#pragma unroll
        for (int ai = 0; ai < 2; ++ai) {
            if (fr == 0) { LAS float* p = X + ((((ai * 2 + wr) * 4 + wc) * 2 + 0) * 4 + fq) * 8; *(LAS f32x4*)p = acc[ai][0][0][0]; *(LAS f32x4*)(p + 4) = acc[ai][0][0][1]; }
            if (fr == 15) { LAS float* p = X + ((((ai * 2 + wr) * 4 + wc) * 2 + 1) * 4 + fq) * 8; *(LAS f32x4*)p = acc[ai][0][3][0]; *(LAS f32x4*)(p + 4) = acc[ai][0][3][1]; }
        }
        asm volatile("s_waitcnt lgkmcnt(0)" ::: "memory"); __builtin_amdgcn_s_barrier(); asm volatile("" ::: "memory");
        f32x4 w0[2], w1[2], w2[2], bb[2];
#pragma unroll
        for (int n = 0; n < 2; ++n) { w0[n] = *(const GAS f32x4*)(cw + c0 + 4 * n); w1[n] = *(const GAS f32x4*)(cw + DFF + c0 + 4 * n); w2[n] = *(const GAS f32x4*)(cw + 2 * DFF + c0 + 4 * n); bb[n] = *(const GAS f32x4*)(cbias + c0 + 4 * n); }
        const bool has_prev = ti.lat && ti.t0 > 0, has_next = ti.lat && ti.t0 < 4096 - 256;
#pragma unroll
        for (int ai = 0; ai < 2; ++ai) {
            f32x4 pb[2] = {(f32x4){0.f, 0.f, 0.f, 0.f}, (f32x4){0.f, 0.f, 0.f, 0.f}}, nb[2] = {(f32x4){0.f, 0.f, 0.f, 0.f}, (f32x4){0.f, 0.f, 0.f, 0.f}};
            { const int seg = ai * 2 + wr;
              if (seg > 0) { const int ps = seg - 1; LAS float* p = X + ((((ps >> 1) * 2 + (ps & 1)) * 4 + wc) * 2 + 1) * 32 + fq * 8; pb[0] = *(LAS f32x4*)p; pb[1] = *(LAS f32x4*)(p + 4); }
              if (seg < 3) { const int ns = seg + 1; LAS float* p = X + ((((ns >> 1) * 2 + (ns & 1)) * 4 + wc) * 2 + 0) * 32 + fq * 8; nb[0] = *(LAS f32x4*)p; nb[1] = *(LAS f32x4*)(p + 4); } }
#pragma unroll
            for (int m = 0; m < 4; ++m) {
                const int rt = ai * 128 + wr * 64 + m * 16 + fr; const size_t grow = (size_t)u.pm * 256 + rt;
                f32x4 fo[2], cv[2];
#pragma unroll
                for (int n = 0; n < 2; ++n) {
                    const f32x4 a = acc[ai][0][m][n];
                    const f32x4 up = (m > 0) ? acc[ai][0][m > 0 ? m - 1 : 0][n] : pb[n];
                    const f32x4 dn = (m < 3) ? acc[ai][0][m < 3 ? m + 1 : 3][n] : nb[n];
                    f32x4 pv, nx;
#pragma unroll
                    for (int e = 0; e < 4; ++e) {
                        pv[e] = dpp_ror1(fr == 15 ? up[e] : a[e]);
                        nx[e] = dpp_ror15(fr == 0 ? dn[e] : a[e]);
                    }
                    const f32x4 c = w0[n] * pv + w1[n] * a + w2[n] * nx + bb[n];
                    cv[n] = c;
                    const f32x4 uu = acc[ai][1][m][n];
#pragma unroll
                    for (int e = 0; e < 4; ++e) fo[n][e] = silu_f(c[e]) * uu[e];
                }
                u32x4 w; w.x = cvtpk(fo[0][0], fo[0][1]); w.y = cvtpk(fo[0][2], fo[0][3]); w.z = cvtpk(fo[1][0], fo[1][1]); w.w = cvtpk(fo[1][2], fo[1][3]);
                *(GAS u32x4*)(F + grow * DFF + c0) = w;
                if (ai == 0 && m == 0) { if (has_prev && rt == 0) { const size_t eo = ((size_t)u.pm * 2 + 0) * DFF + c0;
                        *(GAS f32x4*)(EP + eo) = cv[0]; *(GAS f32x4*)(EP + eo + 4) = cv[1]; *(GAS f32x4*)(EA + eo) = acc[0][0][0][0]; *(GAS f32x4*)(EA + eo + 4) = acc[0][0][0][1]; *(GAS f32x4*)(EU + eo) = acc[0][1][0][0]; *(GAS f32x4*)(EU + eo + 4) = acc[0][1][0][1]; } }
                if (ai == 1 && m == 3) { if (has_next && rt == 255) { const size_t eo = ((size_t)u.pm * 2 + 1) * DFF + c0;
                        *(GAS f32x4*)(EP + eo) = cv[0]; *(GAS f32x4*)(EP + eo + 4) = cv[1]; *(GAS f32x4*)(EA + eo) = acc[1][0][3][0]; *(GAS f32x4*)(EA + eo + 4) = acc[1][0][3][1]; *(GAS f32x4*)(EU + eo) = acc[1][1][3][0]; *(GAS f32x4*)(EU + eo + 4) = acc[1][1][3][1]; } }
            }
        }
        asm volatile("s_waitcnt lgkmcnt(0)" ::: "memory"); __builtin_amdgcn_s_barrier(); asm volatile("" ::: "memory");
    }
};

typedef short v4i16_t __attribute__((ext_vector_type(4)));
__device__ __forceinline__ s16x4 vtr(LAS const char* p) { return __builtin_bit_cast(s16x4, __builtin_amdgcn_ds_read_tr16_b64_v4i16((LAS v4i16_t*)p)); }
__device__ __forceinline__ float xhalf_max(float m) { auto rr = __builtin_amdgcn_permlane32_swap(__float_as_uint(m), __float_as_uint(m), false, false); return fmaxf(__uint_as_float(rr[0]), __uint_as_float(rr[1])); }
__device__ __forceinline__ float xhalf_sum(float m) { auto rr = __builtin_amdgcn_permlane32_swap(__float_as_uint(m), __float_as_uint(m), false, false); return __uint_as_float(rr[0]) + __uint_as_float(rr[1]); }

constexpr int ATT_VS = 192;
constexpr float ATT_THR = 8.f;
#define MX3(a, b, c) __builtin_fmaxf(__builtin_fmaxf((a), (b)), (c))
template <int DQK, bool YORD>
__device__ __forceinline__ void flash_pass(const bf16_t* __restrict__ Qw, int qpitch, const bf16_t* __restrict__ Kg, const bf16_t* __restrict__ Vg, int NT, int tst,
                                           LAS char* lds, f32x16 (&o)[2], float& lsum) {
#define ATT_TI(T) (((T) + tst) < NT ? ((T) + tst) : ((T) + tst - NT))
    constexpr int KS = DQK * 2 + 16, KBUF = 64 * KS, VBUF = 64 * ATT_VS, NDS = DQK / 16;
    constexpr int KROWB = DQK * 2;
    const int tid = opaque_tid(), lane = tid & 63, r32 = lane & 31, h = lane >> 5;
    LAS char* Kb = lds; LAS char* Vb = lds + 2 * KBUF;
    bf16x8 qf[NDS];
#pragma unroll
    for (int ds = 0; ds < NDS; ++ds) qf[ds] = *(const GAS bf16x8*)(Qw + (size_t)r32 * qpitch + 16 * ds + 8 * h);
    const bool kload = (tid * 16) < 64 * KROWB;
    const int krow = (tid * 16) / KROWB, kcb = (tid * 16) % KROWB;
    const int kdst = krow * KS + kcb, vdst = (tid >> 3) * ATT_VS + (tid & 7) * 16;
    const char* kg = (const char*)Kg + tid * 16; const char* vg = (const char*)Vg + tid * 16;
    u32x4 kreg = {0, 0, 0, 0}, vreg;
    {
        u32x4 k1 = {0, 0, 0, 0};
        if (kload) { kreg = *(const GAS u32x4*)(kg + (size_t)ATT_TI(0) * 64 * KROWB); k1 = *(const GAS u32x4*)(kg + (size_t)ATT_TI(1) * 64 * KROWB); }
        vreg = *(const GAS u32x4*)(vg + (size_t)ATT_TI(0) * 64 * 128);
        if (kload) { *(LAS u32x4*)(Kb + kdst) = kreg; *(LAS u32x4*)(Kb + KBUF + kdst) = k1; }
        *(LAS u32x4*)(Vb + vdst) = vreg;
        *(LAS u32x4*)(Vb + 2 * VBUF + vdst) = (u32x4){0, 0, 0, 0};
    }
    __syncthreads();
    const int kfo = r32 * KS + h * 16;
    const int vfo = (4 * h + ((lane & 15) >> 2)) * ATT_VS + (((lane >> 4) & 1) * 16 + (lane & 3) * 4) * 2;
    f32x16 p0 = (f32x16){}, p1 = (f32x16){};
#pragma unroll
    for (int ds = 0; ds < NDS; ++ds) {
        const bf16x8 k0 = *(LAS const bf16x8*)(Kb + kfo + ds * 32), k1 = *(LAS const bf16x8*)(Kb + kfo + 32 * KS + ds * 32);
        p0 = __builtin_amdgcn_mfma_f32_32x32x16_bf16(k0, qf[ds], p0, 0, 0, 0);
        p1 = __builtin_amdgcn_mfma_f32_32x32x16_bf16(k1, qf[ds], p1, 0, 0, 0);
    }
    __syncthreads();
    float mref, l = 0.f;
    {
        float a = MX3(p0[0], p0[1], p1[0]), b = MX3(p0[2], p0[3], p1[1]); a = MX3(a, p1[2], p1[3]);
#pragma unroll
        for (int r = 4; r < 16; r += 4) { a = MX3(a, p0[r], p0[r + 1]); b = MX3(b, p0[r + 2], p0[r + 3]); a = MX3(a, p1[r], p1[r + 1]); b = MX3(b, p1[r + 2], p1[r + 3]); }
        mref = xhalf_max(fmaxf(a, b));
#pragma unroll
        for (int r = 0; r < 16; ++r) { p0[r] -= mref; p1[r] -= mref; }
    }
    f32x16 negm;
#pragma unroll
    for (int r = 0; r < 16; ++r) negm[r] = -mref;
    asm volatile("" : "+v"(negm));
    o[0] = (f32x16){}; o[1] = (f32x16){};
    bf16x8 pk[4] = {};
    int vs_prev = 2 * VBUF, vs_cur = 0, vs_next = VBUF;
#define ATT_MPART(N0, N1, T) do { \
        LAS const char* kb_ = Kb + ((((T) + 1) & 1) * KBUF) + kfo; LAS const char* vb_ = Vb + vs_prev + vfo; \
        bf16x8 kf_[2 * NDS]; s16x4 vl_[8], vh_[8]; \
        _Pragma("unroll") for (int ds = 0; ds < NDS; ++ds) { kf_[2 * ds] = *(LAS const bf16x8*)(kb_ + ds * 32); kf_[2 * ds + 1] = *(LAS const bf16x8*)(kb_ + 32 * KS + ds * 32); } \
        _Pragma("unroll") for (int s_ = 0; s_ < 4; ++s_) { _Pragma("unroll") for (int db_ = 0; db_ < 2; ++db_) { \
            vl_[2 * s_ + db_] = vtr(vb_ + (16 * s_) * ATT_VS + db_ * 64); vh_[2 * s_ + db_] = vtr(vb_ + (16 * s_ + 8) * ATT_VS + db_ * 64); } } \
        N0 = __builtin_amdgcn_mfma_f32_32x32x16_bf16(kf_[0], qf[0], negm, 0, 0, 0); N1 = __builtin_amdgcn_mfma_f32_32x32x16_bf16(kf_[1], qf[0], negm, 0, 0, 0); \
        _Pragma("unroll") for (int ds = 1; ds < NDS; ++ds) { \
            N0 = __builtin_amdgcn_mfma_f32_32x32x16_bf16(kf_[2 * ds], qf[ds], N0, 0, 0, 0); N1 = __builtin_amdgcn_mfma_f32_32x32x16_bf16(kf_[2 * ds + 1], qf[ds], N1, 0, 0, 0); } \
        _Pragma("unroll") for (int s_ = 0; s_ < 4; ++s_) { _Pragma("unroll") for (int db_ = 0; db_ < 2; ++db_) { \
            const bf16x8 vf_ = __builtin_shufflevector(vl_[2 * s_ + db_], vh_[2 * s_ + db_], 0, 1, 2, 3, 4, 5, 6, 7); \
            o[db_] = __builtin_amdgcn_mfma_f32_32x32x16_bf16(vf_, pk[s_], o[db_], 0, 0, 0); } } \
        __builtin_amdgcn_sched_group_barrier(0x100, 2 * NDS + 8, 0); __builtin_amdgcn_sched_group_barrier(0x008, 2 * NDS, 0); \
        __builtin_amdgcn_sched_group_barrier(0x100, 8, 0); __builtin_amdgcn_sched_group_barrier(0x008, 8, 0); } while (0)
#define ATT_VPART(P0, P1, N0, N1) do { \
        float a = MX3(P0[0], P0[1], P1[0]), b = MX3(P0[2], P0[3], P1[1]); a = MX3(a, P1[2], P1[3]); \
        _Pragma("unroll") for (int r = 4; r < 16; r += 4) { a = MX3(a, P0[r], P0[r + 1]); b = MX3(b, P0[r + 2], P0[r + 3]); a = MX3(a, P1[r], P1[r + 1]); b = MX3(b, P1[r + 2], P1[r + 3]); } \
        const float mt = xhalf_max(fmaxf(a, b)); \
        resc = __any(mt > ATT_THR); \
        if (__builtin_expect(resc, 0)) { \
            const float dl = fmaxf(mt, 0.f); mref += dl; fsc = __builtin_amdgcn_exp2f(-dl); l *= fsc; \
            _Pragma("unroll") for (int r = 0; r < 16; ++r) { P0[r] -= dl; P1[r] -= dl; } \
            if (!YORD) { _Pragma("unroll") for (int r = 0; r < 16; ++r) { N0[r] -= dl; N1[r] -= dl; o[0][r] *= fsc; o[1][r] *= fsc; } } \
            _Pragma("unroll") for (int r = 0; r < 16; ++r) negm[r] = -mref; \
            asm volatile("" : "+v"(negm)); } \
        float ps0 = 0.f, ps1 = 0.f; \
        _Pragma("unroll") for (int r = 0; r < 16; ++r) { P0[r] = __builtin_amdgcn_exp2f(P0[r]); P1[r] = __builtin_amdgcn_exp2f(P1[r]); ps0 += P0[r]; ps1 += P1[r]; } \
        l += ps0 + ps1; \
        _Pragma("unroll") for (int s = 0; s < 2; ++s) { u32x4 a4, b4; \
            a4.x = cvtpk(P0[8 * s + 0], P0[8 * s + 1]); a4.y = cvtpk(P0[8 * s + 2], P0[8 * s + 3]); a4.z = cvtpk(P0[8 * s + 4], P0[8 * s + 5]); a4.w = cvtpk(P0[8 * s + 6], P0[8 * s + 7]); \
            b4.x = cvtpk(P1[8 * s + 0], P1[8 * s + 1]); b4.y = cvtpk(P1[8 * s + 2], P1[8 * s + 3]); b4.z = cvtpk(P1[8 * s + 4], P1[8 * s + 5]); b4.w = cvtpk(P1[8 * s + 6], P1[8 * s + 7]); \
            pkn[s] = __builtin_bit_cast(bf16x8, a4); pkn[2 + s] = __builtin_bit_cast(bf16x8, b4); } } while (0)
#define ATT_STEP(P0, P1, N0, N1, T) do { \
        const bool more = (T) + 1 < NT, more2 = (T) + 2 < NT; \
        if (more2 && kload) kreg = *(const GAS u32x4*)(kg + (size_t)ATT_TI((T) + 2) * 64 * KROWB); \
        if (more) vreg = *(const GAS u32x4*)(vg + (size_t)ATT_TI((T) + 1) * 64 * 128); \
        float fsc = 1.f; bool resc; bf16x8 pkn[4]; \
        if (!YORD) { ATT_MPART(N0, N1, T); __builtin_amdgcn_sched_barrier(0); ATT_VPART(P0, P1, N0, N1); } \
        else { ATT_VPART(P0, P1, N0, N1); __builtin_amdgcn_sched_barrier(0); ATT_MPART(N0, N1, T); \
            if (__builtin_expect(resc, 0)) { _Pragma("unroll") for (int r = 0; r < 16; ++r) { o[0][r] *= fsc; o[1][r] *= fsc; } } } \
        _Pragma("unroll") for (int s = 0; s < 4; ++s) pk[s] = pkn[s]; \
        if (more2 && kload) *(LAS u32x4*)(Kb + ((T) & 1) * KBUF + kdst) = kreg; \
        if (more) *(LAS u32x4*)(Vb + vs_next + vdst) = vreg; \
        __syncthreads(); \
        vs_prev = vs_cur; vs_cur = vs_next; vs_next = (vs_next == 2 * VBUF) ? 0 : vs_next + VBUF; } while (0)
    f32x16 n0, n1;
    for (int t = 0; t < NT; t += 2) {
        ATT_STEP(p0, p1, n0, n1, t);
        ATT_STEP(n0, n1, p0, p1, t + 1);
    }
    {
        LAS const char* vb_ = Vb + vs_prev + vfo;
#pragma unroll
        for (int s_ = 0; s_ < 4; ++s_) {
#pragma unroll
            for (int db_ = 0; db_ < 2; ++db_) {
                const s16x4 lo_ = vtr(vb_ + (16 * s_) * ATT_VS + db_ * 64), hi_ = vtr(vb_ + (16 * s_ + 8) * ATT_VS + db_ * 64);
                const bf16x8 vf_ = __builtin_shufflevector(lo_, hi_, 0, 1, 2, 3, 4, 5, 6, 7);
                o[db_] = __builtin_amdgcn_mfma_f32_32x32x16_bf16(vf_, pk[s_], o[db_], 0, 0, 0);
            }
        }
    }
    __syncthreads();
#undef ATT_STEP
#undef ATT_TI
#undef ATT_VPART
#undef ATT_MPART
    lsum = xhalf_sum(l);
}

__device__ __forceinline__ void store_ot(const f32x16 (&o)[2], bf16_t* dst  , int h) {
#pragma unroll
    for (int db = 0; db < 2; ++db)
#pragma unroll
        for (int g = 0; g < 4; ++g) { u32x2 w; w.x = cvtpk(o[db][4 * g], o[db][4 * g + 1]); w.y = cvtpk(o[db][4 * g + 2], o[db][4 * g + 3]); *(GAS u32x2*)(dst + 32 * db + 8 * g + 4 * h) = w; }
}

#include <hip/hip_bf16.h>
namespace attn64 {
using bf16=__hip_bfloat16;
using bf16x8=__attribute__((ext_vector_type(8)))short;
using s16x4=__attribute__((ext_vector_type(4)))short;
using f32x16=__attribute__((ext_vector_type(16)))float;
using u32x4=__attribute__((ext_vector_type(4)))unsigned;
constexpr int D=64;
constexpr int NW=8,QBLK=32,QB=QBLK*NW,KVBLK=64;

__device__ __forceinline__ int crow(int r,int hi){return (r&3)+8*(r>>2)+4*hi;}
#define SBAR() __builtin_amdgcn_sched_barrier(0)
__device__ __forceinline__ void cmask(f32x16&p0,f32x16&p1,int jb,int qrel,int hi){
  const float NEG=-INFINITY; int kb=64*jb+4*hi;
  #pragma unroll
  for(int r=0;r<16;++r){int kv=kb+(r&3)+8*(r>>2); if(kv>qrel)p0[r]=NEG; if(kv+32>qrel)p1[r]=NEG;}
}

constexpr int NSLOT=3, SLOTB=8192;
constexpr int LDS_K=0, LDS_V=NSLOT*SLOTB, LDS_WS=2*NSLOT*SLOTB, LDS_OST=LDS_WS+NW*64*4, LDS_BYTES=LDS_OST+NW*4096;
constexpr float C2=0.125f*1.4426950408889634f;
__device__ __forceinline__ void glds16(const void*gsrc,unsigned lds_dst){unsigned keep;
  asm volatile("s_mov_b32 %0, m0\n\ts_mov_b32 m0, %2\n\ts_nop 0\n\tglobal_load_lds_dwordx4 %1, off\n\ts_mov_b32 m0, %0":"=&s"(keep):"v"(gsrc),"s"(lds_dst):"memory");}
__device__ __forceinline__ float max3f(float a,float b,float c){float r;asm("v_max3_f32 %0, %1, %2, %3":"=v"(r):"v"(a),"v"(b),"v"(c));return r;}
__device__ __forceinline__ float max2f(float a,float b){float r;asm("v_max_f32_e32 %0, %1, %2":"=v"(r):"v"(a),"v"(b));return r;}
__device__ __forceinline__ float fadd_s(float a,float b){float r;asm("v_add_f32_e32 %0, %1, %2":"=v"(r):"v"(a),"v"(b));return r;}
__device__ __forceinline__ float fsub_s(float a,float b){float r;asm("v_sub_f32_e32 %0, %1, %2":"=v"(r):"v"(a),"v"(b));return r;}
typedef float f32x2_t __attribute__((ext_vector_type(2))); typedef __bf16 bf16x2_t __attribute__((ext_vector_type(2)));
__device__ __forceinline__ unsigned cvtpk_s(float lo,float hi){f32x2_t v={lo,hi};bf16x2_t b=__builtin_convertvector(v,bf16x2_t);return __builtin_bit_cast(unsigned,b);}
#define WAIT_BAR(N) asm volatile("s_waitcnt vmcnt(" #N ") lgkmcnt(0)\n\ts_barrier":::"memory")

template<int NDS_> __device__ __forceinline__ void qkt(f32x16&p0,f32x16&p1,const char*Kslot,const bf16x8*qr,const f32x16&negm,int r32,int hi){
  const char*kb=Kslot+hi*1024+r32*16;
  #pragma unroll
  for(int d0=0;d0<NDS_;++d0){
    const bf16x8 b0=*reinterpret_cast<const bf16x8*>(kb+d0*2048);
    const bf16x8 b1=*reinterpret_cast<const bf16x8*>(kb+d0*2048+512);
    if(d0==0){p0=__builtin_amdgcn_mfma_f32_32x32x16_bf16(b0,qr[0],negm,0,0,0);p1=__builtin_amdgcn_mfma_f32_32x32x16_bf16(b1,qr[0],negm,0,0,0);}
    else{p0=__builtin_amdgcn_mfma_f32_32x32x16_bf16(b0,qr[d0],p0,0,0,0);p1=__builtin_amdgcn_mfma_f32_32x32x16_bf16(b1,qr[d0],p1,0,0,0);}}
}
typedef __attribute__((address_space(3))) const char* lds_cptr;
typedef short v4i16_t __attribute__((ext_vector_type(4)));
__device__ __forceinline__ void kload8(bf16x8*kf,lds_cptr kp){
  kf[0]=*(const __attribute__((address_space(3))) bf16x8*)(kp);      kf[1]=*(const __attribute__((address_space(3))) bf16x8*)(kp+512);
  kf[2]=*(const __attribute__((address_space(3))) bf16x8*)(kp+2048); kf[3]=*(const __attribute__((address_space(3))) bf16x8*)(kp+2560);
  kf[4]=*(const __attribute__((address_space(3))) bf16x8*)(kp+4096); kf[5]=*(const __attribute__((address_space(3))) bf16x8*)(kp+4608);
  kf[6]=*(const __attribute__((address_space(3))) bf16x8*)(kp+6144); kf[7]=*(const __attribute__((address_space(3))) bf16x8*)(kp+6656);
}
__device__ __forceinline__ void kload2(bf16x8*kf,lds_cptr kp,int j){ kf[2*j]=*(const __attribute__((address_space(3))) bf16x8*)(kp+j*2048); kf[2*j+1]=*(const __attribute__((address_space(3))) bf16x8*)(kp+j*2048+512); }
__device__ __forceinline__ s16x4 vtr(lds_cptr p){ return __builtin_bit_cast(s16x4,__builtin_amdgcn_ds_read_tr16_b64_v4i16((__attribute__((address_space(3))) v4i16_t*)p)); }
__device__ __forceinline__ float rowmax(const f32x16&p0,const f32x16&p1){
  float a=max3f(p0[0],p0[1],p1[0]),b=max3f(p0[2],p0[3],p1[1]);a=max3f(a,p1[2],p1[3]);
  #pragma unroll
  for(int r=4;r<16;r+=4){a=max3f(a,p0[r],p0[r+1]);b=max3f(b,p0[r+2],p0[r+3]);a=max3f(a,p1[r],p1[r+1]);b=max3f(b,p1[r+2],p1[r+3]);}
  const float m=max2f(a,b);
  auto rr=__builtin_amdgcn_permlane32_swap(__float_as_uint(m),__float_as_uint(m),false,false);
  return max2f(__uint_as_float(rr[0]),__uint_as_float(rr[1]));
}
__device__ __forceinline__ void pv(f32x16*o,int vb,bf16x8 pa0,bf16x8 pa1,bf16x8 pa2,bf16x8 pa3){
  #pragma unroll
  for(int d0=0;d0<2;++d0){s16x4 lo[4],hi[4];
    #pragma unroll
    for(int ks=0;ks<4;++ks){
      asm volatile("ds_read_b64_tr_b16 %0,%1 offset:%c2":"=&v"(lo[ks]):"v"(vb),"i"(d0*4096+ks*1024):"memory");
      asm volatile("ds_read_b64_tr_b16 %0,%1 offset:%c2":"=&v"(hi[ks]):"v"(vb),"i"(d0*4096+ks*1024+512):"memory");}
    asm volatile("s_waitcnt lgkmcnt(0)":::"memory");SBAR();
    #define PK(k) (bf16x8){lo[k][0],lo[k][1],lo[k][2],lo[k][3],hi[k][0],hi[k][1],hi[k][2],hi[k][3]}
    o[d0]=__builtin_amdgcn_mfma_f32_32x32x16_bf16(pa0,PK(0),o[d0],0,0,0);
    o[d0]=__builtin_amdgcn_mfma_f32_32x32x16_bf16(pa1,PK(1),o[d0],0,0,0);
    o[d0]=__builtin_amdgcn_mfma_f32_32x32x16_bf16(pa2,PK(2),o[d0],0,0,0);
    o[d0]=__builtin_amdgcn_mfma_f32_32x32x16_bf16(pa3,PK(3),o[d0],0,0,0);
    #undef PK
  }
}

#ifndef ATTN_STORE16
#define ATTN_STORE16(p,v) (*(GAS u32x4*)(p)=(v))
#endif
__device__ __forceinline__ void stage_store(const f32x16 (&o)[2],bf16*Ow,int op,char*shm,int wid,int lane,int r32,int hi){
  bf16*stg=(bf16*)(shm+LDS_OST)+wid*2048;
  #pragma unroll
  for(int r=0;r<16;++r){const int orow=crow(r,hi);
    #pragma unroll
    for(int d0=0;d0<2;++d0)stg[orow*64+d0*32+r32]=__float2bfloat16(o[d0][r]);}
  asm volatile("s_waitcnt lgkmcnt(0)":::"memory");
  #pragma unroll
  for(int i=0;i<4;++i){const int row=i*8+(lane>>3),ch=lane&7; const u32x4 v=*(const u32x4*)(stg+row*64+ch*8); ATTN_STORE16(Ow+(long)row*op+ch*8,v);}
}
template<int THRL,int MODE,int DQ> __device__ __forceinline__ void attn_unit(const bf16*Qw0,int qp,const bf16*__restrict__ Kh,int kp,const bf16*__restrict__ Vh,int vp,int NT,bf16*Ow0,int op,char*shm,f32x16 (&oret)[2]){
  constexpr int NDS=DQ/16;
  const int tid=opaque_tid(),lane=tid&63,r32=lane&31,hi=lane>>5; const int wid=__builtin_amdgcn_readfirstlane(tid>>6);
  const bf16*Qw=Qw0+(long)(wid*QBLK)*qp;
  const unsigned lds0=(unsigned)(uintptr_t)shm;
  float*wsf=(float*)(shm+LDS_WS)+wid*64;
  const int kch=(DQ==64)?wid:(wid&3);
  const bf16*ksrc=Kh+(long)lane*kp+kch*8;
  const bf16*vsrc=Vh+(long)(16*(wid&3)+(lane>>2))*vp+(wid>>2)*32+(lane&3)*8;
  const unsigned kdst=lds0+LDS_K+kch*1024, vdst=lds0+LDS_V+wid*1024;
  #define DMA_K(t,slot) glds16(ksrc+(long)(t)*KVBLK*kp,(unsigned)__builtin_amdgcn_readfirstlane(kdst+(slot)))
  #define DMA_V(t,slot) glds16(vsrc+(long)(t)*KVBLK*vp,(unsigned)__builtin_amdgcn_readfirstlane(vdst+(slot)))
  const int vb0=(int)(lds0+LDS_V)+((lane>>4)&1)*32+(lane&3)*8+(4*hi+((lane&15)>>2))*64;
  const char*Kbase=shm+LDS_K; bf16x8 kf[8];
  const lds_cptr shm3=(lds_cptr)shm; const lds_cptr kp0=shm3+LDS_K+hi*1024+r32*16; const lds_cptr vp0=shm3+LDS_V+((lane>>4)&1)*32+(lane&3)*8+(4*hi+((lane&15)>>2))*64;
  DMA_K(0,0);DMA_V(0,0);DMA_K(1,SLOTB);
  bf16x8 qr[4];
  #pragma unroll
  for(int d0=0;d0<NDS;++d0)qr[d0]=*(const GAS bf16x8*)(&Qw[(long)r32*qp+d0*16+hi*8]);
  float mhat=0.f,l_reg=0.f;f32x16 o[2];o[0]=f32x16{};o[1]=f32x16{};f32x16 negm=f32x16{};asm volatile("":"+v"(negm));
  #define CMASK(P0,P1,t) do{}while(0)
  bool resc=false;
  #define START(P0,P1) do{ const float rm=rowmax(P0,P1); resc=false; \
    { const float dl=rm; mhat=fadd_s(mhat,dl); \
      _Pragma("unroll") for(int r=0;r<16;++r){P0[r]=fsub_s(P0[r],dl);P1[r]=fsub_s(P1[r],dl);} \
      _Pragma("unroll") for(int r=0;r<16;++r)negm[r]=-mhat; asm volatile("":"+v"(negm)); } \
    _Pragma("unroll") for(int r=0;r<16;++r)P0[r]=__builtin_amdgcn_exp2f(P0[r]); }while(0)
  #define RESC() do{ if(resc){ asm volatile("s_waitcnt lgkmcnt(0)":::"memory"); \
      _Pragma("unroll") for(int d_=0;d_<2;++d_) _Pragma("unroll") for(int r=0;r<16;++r)o[d_][r]*=wsf[crow(r,hi)]; } }while(0)
  f32x16 pA0,pA1,pB0,pB1;
  int sl_prev=0,sl_cur=0,sl_next=SLOTB;
  #define ROT() do{sl_prev=sl_cur;sl_cur=sl_next;sl_next=(sl_next==(NSLOT-1)*SLOTB)?0:sl_next+SLOTB;}while(0)
  DMA_K(2,2*SLOTB);
  WAIT_BAR(3);
  qkt<NDS>(pA0,pA1,Kbase,qr,negm,r32,hi);asm volatile("s_nop 15\n\ts_nop 7":"+v"(pA0),"+v"(pA1));CMASK(pA0,pA1,0);
  START(pA0,pA1);
  _Pragma("unroll") for(int r=0;r<16;++r)pA1[r]=__builtin_amdgcn_exp2f(pA1[r]);
  WAIT_BAR(0);
  DMA_K(3,0);DMA_V(1,SLOTB);
  ROT();
  if constexpr(DQ==64) kload8(kf,kp0+sl_cur); else { kload2(kf,kp0+sl_cur,0); kload2(kf,kp0+sl_cur,1); }
  WAIT_BAR(2);
  s16x4 vlo[8],vhi[8]; u32x4 pw0,pw1,pw2,pw3;
  #define PKW(P,B) cvtpk_s(P[B],P[B+1])
  #define PAF(k) __builtin_bit_cast(bf16x8,pw##k)
  #define VFR(i) (bf16x8){vlo[i][0],vlo[i][1],vlo[i][2],vlo[i][3],vhi[i][0],vhi[i][1],vhi[i][2],vhi[i][3]}
  #define PIN(x) asm volatile("":"+v"(x))
  #define MX3(a,b,c) __builtin_fmaxf(__builtin_fmaxf((a),(b)),(c))
  #define GAPA(MF,A0,A1,A2,A3,W0,W1,PW) do{ MF; sacc+=A0; sacc+=A1; sacc+=A2; sacc+=A3; PIN(sacc); W0; W1; PIN(PW); SBAR(); }while(0)
  #define EX(v) __builtin_amdgcn_exp2f(v)
  #define GAPB(MF,X,B) do{ MF; X[B]=EX(X[B]); X[B+1]=EX(X[B+1]); X[B+2]=EX(X[B+2]); X[B+3]=EX(X[B+3]); PIN(X); SBAR(); }while(0)
  #define VRD(i) do{ vlo[i]=vtr(vp_+(((i)>>2)*4096+((i)&3)*1024)); vhi[i]=vtr(vp_+(((i)>>2)*4096+((i)&3)*1024+512)); }while(0)
  #define KRD(G,j) do{ if(G){ kload2(kf,kp0+sl_next,j); SBAR(); } }while(0)
  #define STEP(C0,C1,P0,P1,t,GK,GV,GL) do{ SBAR(); \
    const lds_cptr vp_=vp0+sl_prev; \
    VRD(0); SBAR(); float sacc=(P0[0]+P0[1]); \
    GAPA(C0=__builtin_amdgcn_mfma_f32_32x32x16_bf16(kf[0],qr[0],negm,0,0,0), P0[2],P0[3],P0[4],P0[5],     pw0[0]=PKW(P0,0), pw0[1]=PKW(P0,2), pw0); \
    VRD(4); SBAR(); GAPA(C1=__builtin_amdgcn_mfma_f32_32x32x16_bf16(kf[1],qr[0],negm,0,0,0), P0[6],P0[7],P0[8],P0[9],     pw0[2]=PKW(P0,4), pw0[3]=PKW(P0,6), pw0); \
    VRD(1); SBAR(); GAPA(C0=__builtin_amdgcn_mfma_f32_32x32x16_bf16(kf[2],qr[1],C0,0,0,0),   P0[10],P0[11],P0[12],P0[13], pw1[0]=PKW(P0,8), pw1[1]=PKW(P0,10), pw1); \
    VRD(5); SBAR(); GAPA(C1=__builtin_amdgcn_mfma_f32_32x32x16_bf16(kf[3],qr[1],C1,0,0,0),   P0[14],P0[15],P1[0],P1[1],   pw1[2]=PKW(P0,12),pw1[3]=PKW(P0,14), pw1); \
    VRD(2); SBAR(); GAPA(if constexpr(DQ==64) C0=__builtin_amdgcn_mfma_f32_32x32x16_bf16(kf[4],qr[2],C0,0,0,0),   P1[2],P1[3],P1[4],P1[5],     pw2[0]=PKW(P1,0), pw2[1]=PKW(P1,2), pw2); \
    VRD(6); SBAR(); GAPA(if constexpr(DQ==64) C1=__builtin_amdgcn_mfma_f32_32x32x16_bf16(kf[5],qr[2],C1,0,0,0),   P1[6],P1[7],P1[8],P1[9],     pw2[2]=PKW(P1,4), pw2[3]=PKW(P1,6), pw2); \
    VRD(3); SBAR(); GAPA(if constexpr(DQ==64) C0=__builtin_amdgcn_mfma_f32_32x32x16_bf16(kf[6],qr[3],C0,0,0,0),   P1[10],P1[11],P1[12],P1[13], pw3[0]=PKW(P1,8), pw3[1]=PKW(P1,10), pw3); \
    VRD(7); SBAR(); GAPA(if constexpr(DQ==64) C1=__builtin_amdgcn_mfma_f32_32x32x16_bf16(kf[7],qr[3],C1,0,0,0),   P1[14],P1[15],0.f,0.f,       pw3[2]=PKW(P1,12),pw3[3]=PKW(P1,14), pw3); \
    l_reg+=sacc; \
    if(GK){DMA_K((t)+3,sl_cur);} if(GV){DMA_V((t)+1,sl_next);} \
    CMASK(C0,C1,t); \
    { float a=MX3(C0[0],C0[1],C1[0]),b=MX3(C0[2],C0[3],C1[1]); a=MX3(a,C1[2],C1[3]); \
      _Pragma("unroll") for(int r=4;r<16;r+=4){a=MX3(a,C0[r],C0[r+1]);b=MX3(b,C0[r+2],C0[r+3]);a=MX3(a,C1[r],C1[r+1]);b=MX3(b,C1[r+2],C1[r+3]);} \
      float rm=__builtin_fmaxf(a,b); { auto rr=__builtin_amdgcn_permlane32_swap(__float_as_uint(rm),__float_as_uint(rm),false,false); rm=__builtin_fmaxf(__uint_as_float(rr[0]),__uint_as_float(rr[1])); } \
      resc=false; \
      if(__builtin_expect(__any(rm>(float)THRL),0)){ const float dl=__builtin_fmaxf(rm,0.f); mhat+=dl; \
        _Pragma("unroll") for(int r=0;r<16;++r){C0[r]-=dl;C1[r]-=dl;} \
        _Pragma("unroll") for(int r=0;r<16;++r)negm[r]=-mhat; asm volatile("":"+v"(negm)); \
        const float f=__builtin_amdgcn_exp2f(-dl); l_reg*=f; if(hi==0)wsf[r32]=f; resc=true; } } \
    SBAR(); \
    GAPB(o[0]=__builtin_amdgcn_mfma_f32_32x32x16_bf16(PAF(0),VFR(0),o[0],0,0,0), C0,0); \
    GAPB(o[1]=__builtin_amdgcn_mfma_f32_32x32x16_bf16(PAF(0),VFR(4),o[1],0,0,0), C0,4); \
    KRD(GL,0); GAPB(o[0]=__builtin_amdgcn_mfma_f32_32x32x16_bf16(PAF(1),VFR(1),o[0],0,0,0), C0,8); \
    KRD(GL,1); GAPB(o[1]=__builtin_amdgcn_mfma_f32_32x32x16_bf16(PAF(1),VFR(5),o[1],0,0,0), C0,12); \
    if constexpr(DQ==64) KRD(GL,2); GAPB(o[0]=__builtin_amdgcn_mfma_f32_32x32x16_bf16(PAF(2),VFR(2),o[0],0,0,0), C1,0); \
    if constexpr(DQ==64) KRD(GL,3); GAPB(o[1]=__builtin_amdgcn_mfma_f32_32x32x16_bf16(PAF(2),VFR(6),o[1],0,0,0), C1,4); \
    GAPB(o[0]=__builtin_amdgcn_mfma_f32_32x32x16_bf16(PAF(3),VFR(3),o[0],0,0,0), C1,8); \
    GAPB(o[1]=__builtin_amdgcn_mfma_f32_32x32x16_bf16(PAF(3),VFR(7),o[1],0,0,0), C1,12); \
    }while(0)
  int t=1;
  #undef CMASK
  #define CMASK(P0,P1,t) do{}while(0)
  for(;t+5<NT;t+=2){
    STEP(pB0,pB1,pA0,pA1,t,true,true,true);     WAIT_BAR(2); RESC(); ROT();
    STEP(pA0,pA1,pB0,pB1,t+1,true,true,true);   WAIT_BAR(2); RESC(); ROT();
  }
  #undef CMASK
  #define CMASK(P0,P1,t) do{}while(0)
  #define ENDW(tt) do{ if((tt)+3<NT){WAIT_BAR(2);} else if((tt)+2<NT){WAIT_BAR(1);} else {WAIT_BAR(0);} }while(0)
  for(;t+1<NT;t+=2){
    STEP(pB0,pB1,pA0,pA1,t,(t+3<NT),(t+1<NT),(t+1<NT));       ENDW(t);   RESC(); ROT();
    STEP(pA0,pA1,pB0,pB1,t+1,(t+4<NT),(t+2<NT),(t+2<NT));     ENDW(t+1); RESC(); ROT();
  }
  STEP(pB0,pB1,pA0,pA1,NT-1,false,false,false); RESC();
  { float sacc=pB0[0]+pB0[1]; _Pragma("unroll") for(int r=2;r<16;++r)sacc+=pB0[r]; _Pragma("unroll") for(int r=0;r<16;++r)sacc+=pB1[r]; l_reg+=sacc;
    pw0=(u32x4){PKW(pB0,0),PKW(pB0,2),PKW(pB0,4),PKW(pB0,6)};pw1=(u32x4){PKW(pB0,8),PKW(pB0,10),PKW(pB0,12),PKW(pB0,14)};pw2=(u32x4){PKW(pB1,0),PKW(pB1,2),PKW(pB1,4),PKW(pB1,6)};pw3=(u32x4){PKW(pB1,8),PKW(pB1,10),PKW(pB1,12),PKW(pB1,14)};
    SBAR(); pv(o,vb0+sl_cur,PAF(0),PAF(1),PAF(2),PAF(3)); }
  #undef PKW
  #undef PAF
  #undef VFR
  #undef PIN
  #undef MX3
  #undef GAPA
  #undef GAPB
  #undef EX
  #undef VRD
  #undef KRD
  #undef STEP
  #undef ENDW
  {auto rr=__builtin_amdgcn_permlane32_swap(__float_as_uint(l_reg),__float_as_uint(l_reg),false,false);l_reg=__uint_as_float(rr[0])+__uint_as_float(rr[1]);}
  if(hi==0)wsf[32+r32]=l_reg;asm volatile("s_waitcnt lgkmcnt(0)":::"memory");
  float rli[16];
  #pragma unroll
  for(int r=0;r<16;++r)rli[r]=__builtin_amdgcn_rcpf(wsf[32+crow(r,hi)]);
  #pragma unroll
  for(int r=0;r<16;++r){o[0][r]*=rli[r];o[1][r]*=rli[r];}
  if constexpr(MODE==0){ bf16*Ow=Ow0+(long)(wid*QBLK)*op; stage_store(o,Ow,op,shm,wid,lane,r32,hi); }
  else { oret[0]=o[0]; oret[1]=o[1]; }
  asm volatile("s_waitcnt lgkmcnt(0)\n\ts_barrier":::"memory");
  #undef DMA_K
  #undef DMA_V
  #undef CMASK
  #undef START
  #undef RESC
  #undef ROT
}
#undef SBAR
#undef WAIT_BAR
}

struct AttnArgs { const bf16_t *QG, *QD, *KG, *VG, *KD, *VD, *CB, *PB; bf16_t* MIX; const float* conv_w; const float* conv_b; const float* subln_g; float lam, lam_init; float* dscr; };

__device__ __forceinline__ void attn_gqa_unit(const AttnArgs& A, LAS char* lds, char* lds_generic, int lat, int seq, int qh, int qb) {
    const long R = lat ? 8192L + (long)SLAT * seq : 256L * seq; const int S = lat ? SLAT : 256;
    const size_t grow0 = (lat ? 8192 + (size_t)4096 * seq : (size_t)256 * seq) + 256 * qb;
    const int kvh = qh >> 2;
    int NT = S / 64; asm volatile("" : "+s"(NT));
    typedef attn64::bf16 abf;
    f32x16 dummy[2];
    attn64::attn_unit<8, 0, 64>((const abf*)(A.QG + grow0 * 512 + 64 * qh), 512, (const abf*)(A.KG + (R * 2 + (long)kvh * S) * 64), 64, (const abf*)(A.VG + (R * 2 + (long)kvh * S) * 64), 64, NT,
                                (abf*)(A.MIX + grow0 * 1024 + 64 * qh), 1024, lds_generic, dummy);
}
__device__ __forceinline__ void attn_diff_unit(const AttnArgs& A, LAS char* lds, char* lds_generic, int lat, int seq, int hd, int qb) {
    const int tid_ = opaque_tid(); const int wave = __builtin_amdgcn_readfirstlane(tid_ >> 6), lane = tid_ & 63, r32 = lane & 31, h = lane >> 5;
    const long R = lat ? 8192L + (long)SLAT * seq : 256L * seq; const int S = lat ? SLAT : 256;
    const size_t grow0 = (lat ? 8192 + (size_t)4096 * seq : (size_t)256 * seq) + 256 * qb;
    int NT = S / 64; asm volatile("" : "+s"(NT));
    typedef attn64::bf16 abf;
    const abf* V = (const abf*)(A.VD + (R * 4 + (long)hd * S) * 64);
    f32x16 oa[2], ob[2];
    attn64::attn_unit<8, 1, 32>((const abf*)(A.QD + grow0 * 256 + 64 * hd), 256, (const abf*)(A.KD + (R * 8 + (long)(hd * 2) * S) * 32), 32, V, 64, NT, (abf*)nullptr, 0, lds_generic, oa);
    GAS float* scr = (GAS float*)A.dscr + ((size_t)(blockIdx.x * 8 + wave) * 32) * 64 + lane;
#pragma unroll
    for (int d0 = 0; d0 < 2; ++d0)
#pragma unroll
        for (int r = 0; r < 16; ++r) scr[(d0 * 16 + r) * 64] = oa[d0][r];
    attn64::attn_unit<8, 1, 32>((const abf*)(A.QD + grow0 * 256 + 64 * hd + 32), 256, (const abf*)(A.KD + (R * 8 + (long)(hd * 2 + 1) * S) * 32), 32, V, 64, NT, (abf*)nullptr, 0, lds_generic, ob);
    float ss[16];
#pragma unroll
    for (int r = 0; r < 16; ++r) {
        const float v0 = scr[r * 64] - A.lam * ob[0][r], v1 = scr[(16 + r) * 64] - A.lam * ob[1][r];
        ob[0][r] = v0; ob[1][r] = v1; ss[r] = v0 * v0 + v1 * v1;
    }
#pragma unroll
    for (int o = 1; o < 32; o <<= 1)
#pragma unroll
        for (int r = 0; r < 16; ++r) ss[r] += __shfl_xor(ss[r], o);
    const float g0 = A.subln_g[r32], g1 = A.subln_g[32 + r32], sc = 1.f - A.lam_init;
#pragma unroll
    for (int r = 0; r < 16; ++r) { const float rstd = rsqrtf(ss[r] * (1.f / 64.f) + EPS) * sc; ob[0][r] *= rstd * g0; ob[1][r] *= rstd * g1; }
    attn64::stage_store(ob, (abf*)(A.MIX + (grow0 + 32 * wave) * 1024 + 768 + 64 * hd), 1024, lds_generic, wave, lane, r32, h);
}

__device__ __forceinline__ void attn_phase(const AttnArgs& A, LAS char* lds, char* lds_generic, int G) {
    for (int u = blockIdx.x; u < 1920; u += G) {
        if (u < 512) { const int b = u & 7, r = u >> 3; attn_diff_unit(A, lds, lds_generic, 1, b, r >> 4, r & 15); }
        else if (u < 1536) { const int v = u - 512, b = v & 7, r = v >> 3; attn_gqa_unit(A, lds, lds_generic, 1, b, r & 7, r >> 3); }
        else if (u < 1664) { const int w = u - 1536; attn_diff_unit(A, lds, lds_generic, 0, w >> 2, w & 3, 0); }
        else { const int w = u - 1664; attn_gqa_unit(A, lds, lds_generic, 0, w >> 3, w & 7, 0); }
    }
    const int tid_c = opaque_tid();
    for (int idx = blockIdx.x * 512 + tid_c; idx < M_ALL * 32; idx += G * 512) {
        const int row = idx >> 5, c8 = (idx & 31) * 8;
        int t, S; if (row < M_CTX) { t = row & 255; S = 256; } else { t = (row - M_CTX) & 4095; S = 4096; }
        const u32x4 z = {0, 0, 0, 0};
        const u32x4 pc = *(const GAS u32x4*)(A.PB + (size_t)row * 256 + c8);
        const u32x4 pp = t > 0 ? *(const GAS u32x4*)(A.PB + (size_t)(row - 1) * 256 + c8) : z;
        const u32x4 pn = t < S - 1 ? *(const GAS u32x4*)(A.PB + (size_t)(row + 1) * 256 + c8) : z;
        const u32x4 cb = *(const GAS u32x4*)(A.CB + (size_t)row * 256 + c8);
        float res[8];
#pragma unroll
        for (int j = 0; j < 8; ++j) {
            const int sh = (j & 1) * 16;
            const float a = __uint_as_float(((pp[j >> 1] >> sh) & 0xffffu) << 16), b = __uint_as_float(((pc[j >> 1] >> sh) & 0xffffu) << 16), c = __uint_as_float(((pn[j >> 1] >> sh) & 0xffffu) << 16);
            const float g = __uint_as_float(((cb[j >> 1] >> sh) & 0xffffu) << 16);
            const int cc = c8 + j;
            res[j] = g * (A.conv_w[cc] * a + A.conv_w[256 + cc] * b + A.conv_w[512 + cc] * c + A.conv_b[cc]);
        }
        u32x4 w; w.x = cvtpk(res[0], res[1]); w.y = cvtpk(res[2], res[3]); w.z = cvtpk(res[4], res[5]); w.w = cvtpk(res[6], res[7]);
        *(GAS u32x4*)(A.MIX + (size_t)row * 1024 + 512 + c8) = w;
    }
}

__device__ __forceinline__ int sigma_map(int type, int i) {
    if (type == 1) return 8 * ((i >> 2) & 3) + 4 * (i >> 4) + (i & 3);
    if (type == 2) return 16 * ((i >> 3) & 1) + 8 * (i >> 4) + (i & 7);
    return i;
}
__device__ __forceinline__ void in_group(int g, int& Lbase, int& type) {
    const int pn = g >> 3, bj = (g >> 2) & 1, wc = g & 3;
    if (pn < 2) { Lbase = 64 * (4 * pn + wc) + 32 * bj; type = 0; }
    else if (pn == 2) { Lbase = (wc < 2 ? 512 + 64 * wc : 640 + 64 * (wc - 2)) + 32 * bj; type = 0; }
    else if (pn == 3) { Lbase = 768 + 128 * bj + 32 * wc; type = 1; }
    else if (pn < 6) { Lbase = 1024 + 256 * bj + 128 * (pn - 4) + 32 * wc; type = 1; }
    else if (pn < 8) { Lbase = (pn == 6 ? 1536 : 1792) + 64 * wc + 32 * bj; type = 2; }
    else { Lbase = 2048 + 64 * wc + 32 * bj; type = 1; }
}
__device__ __forceinline__ void transpose_item(const float* W, int K, int N, bf16_t* WT, int k0, int nphys0, int Lbase, int type, LAS float* scr, int lane) {
#pragma unroll 8
    for (int i = 0; i < 32; ++i) { const int kk = 2 * i + (lane >> 5); scr[kk * 33 + (lane & 31)] = ((const GAS float*)W)[(size_t)(k0 + kk) * N + Lbase + (lane & 31)]; }
    asm volatile("s_waitcnt lgkmcnt(0)" ::: "memory");
    const int c = lane & 7;
#pragma unroll
    for (int j = 0; j < 4; ++j) { const int n = (lane >> 3) + 8 * j; const LAS float* s = scr + (8 * c) * 33 + sigma_map(type, n);
        u32x4 o; o.x = cvtpk(s[0 * 33], s[1 * 33]); o.y = cvtpk(s[2 * 33], s[3 * 33]); o.z = cvtpk(s[4 * 33], s[5 * 33]); o.w = cvtpk(s[6 * 33], s[7 * 33]);
        *(GAS u32x4*)(WT + (size_t)(nphys0 + n) * K + k0 + 8 * c) = o; }
    asm volatile("s_waitcnt lgkmcnt(0)" ::: "memory");
}

struct Params {
    const float *x_prompt, *x_sample, *cache_gk, *cache_gv, *cache_dk, *cache_dv, *c, *c_ctx;
    const float *w_mod, *b_mod, *norm1_g, *w_in, *gqa_qn_g, *gqa_kn_g, *conv_w, *conv_b, *diff_qn_g, *diff_kn_g, *diff_lambda, *diff_subln_g, *w_out, *norm2_g, *ffn_up, *ffn_conv_w, *ffn_conv_b, *ffn_down;
    float* out; unsigned char* ws;
    float lam_init[4];
    int ph_lo, ph_hi;
};

__device__ __forceinline__ void prologue(const Params& P, LAS unsigned char* lds, int G) {
    const int tid = opaque_tid(), lane = tid & 63, wave = __builtin_amdgcn_readfirstlane(tid >> 6);
    float* MODS = (float*)(P.ws + WS_MODS); float* MISC = (float*)(P.ws + WS_MISC);
    if ((int)blockIdx.x < 384) {
        LAS float* sc = (LAS float*)lds;
        LAS float* part = (LAS float*)(lds + 49152);
        for (int i = tid; i < NCOND * 1024; i += 512) { const int ci = i >> 10, k = i & 1023; const float v = ci == 0 ? P.c_ctx[k] : P.c[(ci - 1) * 1024 + k]; sc[k * 12 + ci] = v / (1.f + __expf(-v)); }
        __syncthreads();
        for (int it = blockIdx.x; it < 384; it += G) {
            const int l = it / 96, col = (it % 96) * 64 + lane;
            const float* w = P.w_mod + (size_t)l * 1024 * 6144 + col;
            float acc[NCOND];
#pragma unroll
            for (int ci = 0; ci < NCOND; ++ci) acc[ci] = 0.f;
#pragma unroll 8
            for (int kk = 0; kk < 128; ++kk) { const int k = wave * 128 + kk; const float wv = ((const GAS float*)w)[(size_t)k * 6144];
                const f32x4 s0 = *(LAS f32x4*)(sc + k * 12), s1 = *(LAS f32x4*)(sc + k * 12 + 4); const float s8 = sc[k * 12 + 8];
                acc[0] += s0[0] * wv; acc[1] += s0[1] * wv; acc[2] += s0[2] * wv; acc[3] += s0[3] * wv; acc[4] += s1[0] * wv; acc[5] += s1[1] * wv; acc[6] += s1[2] * wv; acc[7] += s1[3] * wv; acc[8] += s8 * wv; }
#pragma unroll
            for (int ci = 0; ci < NCOND; ++ci) part[(wave * NCOND + ci) * 64 + lane] = acc[ci];
            __syncthreads();
            for (int i = tid; i < NCOND * 64; i += 512) { const int ci = i >> 6, cc = i & 63; float s = 0.f;
#pragma unroll
                for (int w8 = 0; w8 < 8; ++w8) s += part[(w8 * NCOND + ci) * 64 + cc];
                const int j = (it % 96) * 64 + cc; MODS[((size_t)l * NCOND + ci) * 6144 + j] = s + P.b_mod[l * 6144 + j]; }
            __syncthreads();
        }
    }
    if ((int)blockIdx.x == G - 1) {
        if (tid < 4) { const float* lf = P.diff_lambda + tid * 128; float s1 = 0.f, s2 = 0.f; for (int i = 0; i < 32; ++i) { s1 += lf[i] * lf[32 + i]; s2 += lf[64 + i] * lf[96 + i]; }
            MISC[MI_LAM + tid] = expf(s1) - expf(s2) + P.lam_init[tid]; }
        for (int i = tid; i < 1024; i += 512) { const int pos = i >> 4, idx = i & 15; const float fr = powf(10000.f, -(float)idx / 16.f); const float ang = (float)pos * fr; MISC[MI_R64C + i] = cosf(ang); MISC[MI_R64S + i] = sinf(ang); }
        for (int i = tid; i < 512; i += 512) { const int pos = i >> 3, idx = i & 7; const float fr = powf(10000.f, -(float)idx / 8.f); const float ang = (float)pos * fr; MISC[MI_R32C + i] = cosf(ang); MISC[MI_R32S + i] = sinf(ang); }
    }
    __syncthreads();
    LAS float* scr = (LAS float*)(lds + wave * 16384);
    const int gw = blockIdx.x * 8 + wave, NGW = G * 8;
    constexpr int I_IN = 16 * 72, I_OUT = 16 * 32, I_UP = 16 * 176, I_DN = 44 * 32, I_L = I_IN + I_OUT + I_UP + I_DN;
    for (int it = gw; it < DEPTH * I_L; it += NGW) {
        const int l = it / I_L; int r = it % I_L;
        if (r < I_IN) { const int kb = r / 72, g = r % 72; int Lb, ty; in_group(g, Lb, ty);
            transpose_item(P.w_in + (size_t)l * 1024 * INW, 1024, INW, (bf16_t*)(P.ws + WS_WIN) + (size_t)l * INW * 1024, kb * 64, g * 32, Lb, ty, scr, lane); continue; }
        r -= I_IN;
        if (r < I_OUT) { const int kb = r / 32, g = r % 32;
            transpose_item(P.w_out + (size_t)l * 1024 * 1024, 1024, 1024, (bf16_t*)(P.ws + WS_WOUT) + (size_t)l * 1024 * 1024, kb * 64, g * 32, g * 32, 0, scr, lane); continue; }
        r -= I_OUT;
        if (r < I_UP) { const int kb = r / 176, g = r % 176; const int pn = g >> 3, bj = (g >> 2) & 1, wc = g & 3;
            transpose_item(P.ffn_up + (size_t)l * 1024 * UPW, 1024, UPW, (bf16_t*)(P.ws + WS_WUP) + (size_t)l * UPW * 1024, kb * 64, g * 32, bj * DFF + 128 * pn + 32 * wc, 1, scr, lane); continue; }
        r -= I_UP;
        { const int kb = r / 32, g = r % 32;
            transpose_item(P.ffn_down + (size_t)l * DFF * 1024, DFF, 1024, (bf16_t*)(P.ws + WS_WDN) + (size_t)l * 1024 * DFF, kb * 64, g * 32, g * 32, 0, scr, lane); }
    }
}

__device__ __forceinline__ void norm_phase(const float* xin_ctx, const float* xin_lat, const float* ng, const float* mods_l  , int sh_idx, bf16_t* XN, int G) {
    const int tid_ = opaque_tid(); const int lane = tid_ & 63, wave = __builtin_amdgcn_readfirstlane(tid_ >> 6);
    const int nw = G * 8, gw = blockIdx.x * 8 + wave;
    const int per = (M_ALL + nw - 1) / nw;
    const int r0 = gw * per, r1 = min(r0 + per, M_ALL);
    int cur_ci = -1; f32x4 Aa[4], Bb[4];
    f32x4 v[4], vn[4];
    if (r0 < r1) { const float* xr = r0 < M_CTX ? xin_ctx + (size_t)r0 * DM : xin_lat + (size_t)(r0 - M_CTX) * DM;
#pragma unroll
        for (int j = 0; j < 4; ++j) vn[j] = *(const GAS f32x4*)(xr + 4 * lane + 256 * j); }
    for (int row = r0; row < r1; ++row) {
#pragma unroll
        for (int j = 0; j < 4; ++j) v[j] = vn[j];
        if (row + 1 < r1) { const int rn = row + 1; const float* xr = rn < M_CTX ? xin_ctx + (size_t)rn * DM : xin_lat + (size_t)(rn - M_CTX) * DM;
#pragma unroll
            for (int j = 0; j < 4; ++j) vn[j] = *(const GAS f32x4*)(xr + 4 * lane + 256 * j); }
        const int ci = row < M_CTX ? 0 : 1 + ((row - M_CTX) >> 12);
        if (ci != cur_ci) { cur_ci = ci; const float* sh = mods_l + ci * 6144 + sh_idx * 1024; const float* sc = sh + 1024;
#pragma unroll
            for (int j = 0; j < 4; ++j) { const int c = 4 * lane + 256 * j; const f32x4 g4 = *(const GAS f32x4*)(ng + c), s4 = *(const GAS f32x4*)(sc + c); Aa[j] = g4 * (1.f + s4); Bb[j] = *(const GAS f32x4*)(sh + c); } }
        float s = 0.f;
#pragma unroll
        for (int j = 0; j < 4; ++j) s += (v[j][0] * v[j][0] + v[j][1] * v[j][1]) + (v[j][2] * v[j][2] + v[j][3] * v[j][3]);
#pragma unroll
        for (int o = 1; o < 64; o <<= 1) s += __shfl_xor(s, o);
        const float rstd = rsqrtf(s * (1.f / DM) + EPS);
#pragma unroll
        for (int j = 0; j < 4; ++j) { const f32x4 y = v[j] * rstd * Aa[j] + Bb[j]; u32x2 w; w.x = cvtpk(y[0], y[1]); w.y = cvtpk(y[2], y[3]); *(GAS u32x2*)(XN + (size_t)row * DM + 4 * lane + 256 * j) = w; }
    }
}

__device__ __forceinline__ void cache_phase(const Params& P, int l, int G) {
    bf16_t* KG = (bf16_t*)(P.ws + WS_KG); bf16_t* VG = (bf16_t*)(P.ws + WS_VG); bf16_t* KD = (bf16_t*)(P.ws + WS_KD); bf16_t* VD = (bf16_t*)(P.ws + WS_VD);
    const int tid_ = opaque_tid();
    for (int i = blockIdx.x * 512 + tid_; i < 65536; i += G * 512) {
        const int d4 = (i & 15) * 4, kvh = (i >> 4) & 1, p = (i >> 5) & 255, b = i >> 13;
        const size_t src = ((((size_t)b * 4 + l) * 256 + p) * 2 + kvh) * 64 + d4;
        const size_t dst = (((8192L + (long)SLAT * b) * 2 + (long)kvh * SLAT + 4096 + p) * 64) + d4;
        const f32x4 k = *(const GAS f32x4*)(P.cache_gk + src), v = *(const GAS f32x4*)(P.cache_gv + src);
        u32x2 wk, wv; wk.x = cvtpk(k[0], k[1]); wk.y = cvtpk(k[2], k[3]); wv.x = cvtpk(v[0], v[1]); wv.y = cvtpk(v[2], v[3]);
        *(GAS u32x2*)(KG + dst) = wk; *(GAS u32x2*)(VG + dst) = wv;
    }
    for (int i = blockIdx.x * 512 + tid_; i < 131072; i += G * 512) {
        { const int d4 = (i & 7) * 4, hc = (i >> 3) & 7, p = (i >> 6) & 255, b = i >> 14;
          const size_t src = ((((size_t)b * 4 + l) * 256 + p) * 8 + hc) * 32 + d4;
          const size_t dst = (((8192L + (long)SLAT * b) * 8 + (long)hc * SLAT + 4096 + p) * 32) + d4;
          const f32x4 k = *(const GAS f32x4*)(P.cache_dk + src); u32x2 w; w.x = cvtpk(k[0], k[1]); w.y = cvtpk(k[2], k[3]); *(GAS u32x2*)(KD + dst) = w; }
        { const int d4 = (i & 15) * 4, hh = (i >> 4) & 3, p = (i >> 6) & 255, b = i >> 14;
          const size_t src = ((((size_t)b * 4 + l) * 256 + p) * 4 + hh) * 64 + d4;
          const size_t dst = (((8192L + (long)SLAT * b) * 4 + (long)hh * SLAT + 4096 + p) * 64) + d4;
          const f32x4 v = *(const GAS f32x4*)(P.cache_dv + src); u32x2 w; w.x = cvtpk(v[0], v[1]); w.y = cvtpk(v[2], v[3]); *(GAS u32x2*)(VD + dst) = w; }
    }
}

__device__ __forceinline__ void fixup_phase(const float* cw, bf16_t* F, const float* EP, const float* EA, const float* EU, int G) {
    const int tid_ = opaque_tid();
    for (int i = blockIdx.x * 512 + tid_; i < 128 * 2 * DFF; i += G * 512) {
        const int c = i % DFF, e = (i / DFF) & 1, pm = 32 + i / (2 * DFF); const int j = (pm - 32) & 15;
        if (e == 0 ? j == 0 : j == 15) continue;
        const size_t eo = ((size_t)pm * 2 + e) * DFF + c;
        float conv;
        if (e == 0) conv = EP[eo] + cw[c] * EA[((size_t)(pm - 1) * 2 + 1) * DFF + c];
        else conv = EP[eo] + cw[2 * DFF + c] * EA[((size_t)(pm + 1) * 2 + 0) * DFF + c];
        const float f = silu_f(conv) * EU[eo];
        const size_t row = (size_t)pm * 256 + (e ? 255 : 0);
        F[row * DFF + c] = (bf16_t)(cvtpk(f, 0.f) & 0xffffu);
    }
}


#define XB_TMO      128
#define XB_XCNT(j)  (256  + 64 * (j))
#define XB_XSUB(j)  (1280 + 64 * (j))
#define XB_XGEN(j)  (2304 + 64 * (j))
#define XB_TOP      3328
#define XB_TOPGEN   3392
#define XCD_BAR_WORDS 3456
#define XB_SPIN_CAP (1u << 22)
__device__ __forceinline__ unsigned xb_ld(unsigned* p)              { return __hip_atomic_load(p, __ATOMIC_RELAXED, __HIP_MEMORY_SCOPE_AGENT); }
__device__ __forceinline__ unsigned xb_add(unsigned* p, unsigned v) { return __hip_atomic_fetch_add(p, v, __ATOMIC_RELAXED, __HIP_MEMORY_SCOPE_AGENT); }
__device__ __forceinline__ unsigned xb_xcc_id() { return (unsigned)__builtin_amdgcn_s_getreg((3 << 11) | 20) & 0xFu; }
#define XB_SPIN(cond, bar) do { unsigned _sp = 0; while (cond) { __builtin_amdgcn_s_sleep(1); \
    if ((++_sp & 255u) == 0u) { if (xb_ld(&(bar)[XB_TMO])) break; if (_sp > XB_SPIN_CAP) { atomicAdd(&(bar)[XB_TMO], 1u); break; } } } } while (0)
struct XcdBarrier { unsigned* bar; unsigned x; volatile LAS unsigned* st; };
__device__ __forceinline__ XcdBarrier xcd_barrier_post(unsigned* bar, volatile LAS unsigned* st) {
    XcdBarrier b; b.bar = bar; b.x = xb_xcc_id(); b.st = st;
    if (threadIdx.x == 0) (void)xb_add(&bar[XB_XCNT(b.x)], 1u);
    return b;
}
__device__ __forceinline__ void xcd_barrier_complete(unsigned* bar, unsigned x, unsigned& nloc, unsigned& nx) {
    const unsigned G = gridDim.x * gridDim.y * gridDim.z;
    unsigned sum, cnt, mine, sp = 0u;
    for (;;) {
        sum = 0u; cnt = 0u; mine = 0u;
#pragma unroll
        for (unsigned j = 0; j < 16; ++j) { const unsigned c = xb_ld(&bar[XB_XCNT(j)]); sum += c; cnt += (c > 0u) ? 1u : 0u; mine = (j == x) ? c : mine; }
        if (sum == G) break;
        __builtin_amdgcn_s_sleep(1);
        if ((++sp & 255u) == 0u) { if (xb_ld(&bar[XB_TMO])) break; if (sp > XB_SPIN_CAP) { atomicAdd(&bar[XB_TMO], 1u); break; } }
    }
    nloc = mine > 0u ? mine : 1u; nx = cnt > 0u ? cnt : 1u;
}
__device__ __forceinline__ void xcd_barrier(const XcdBarrier& b) {
    asm volatile("s_waitcnt vmcnt(0)" ::: "memory");
    __syncthreads();
    if (threadIdx.x == 0) {
        unsigned* bar = b.bar;
        __builtin_amdgcn_s_waitcnt(0);
        unsigned nloc = b.st[0], nx = b.st[1];
        if (nloc == 0u) { xcd_barrier_complete(bar, b.x, nloc, nx); b.st[0] = nloc; b.st[1] = nx; }
        const unsigned old = xb_add(&bar[XB_XSUB(b.x)], 1u);
        const unsigned gen = old / nloc;
        if (old + 1u == (gen + 1u) * nloc) {
            __builtin_amdgcn_fence(__ATOMIC_RELEASE, "agent");
            asm volatile("s_waitcnt vmcnt(0)" ::: "memory");
            const unsigned og = xb_add(&bar[XB_TOP], 1u);
            const unsigned tg = og / nx;
            if (og + 1u == (tg + 1u) * nx) xb_add(&bar[XB_TOPGEN], 1u);
            else XB_SPIN(xb_ld(&bar[XB_TOPGEN]) == tg, bar);
            __builtin_amdgcn_fence(__ATOMIC_ACQUIRE, "agent");
            xb_add(&bar[XB_XGEN(b.x)], 1u);
            asm volatile("s_waitcnt vmcnt(0)" ::: "memory");
        } else {
            XB_SPIN(xb_ld(&bar[XB_XGEN(b.x)]) == gen, bar);
            __builtin_amdgcn_fence(__ATOMIC_ACQUIRE, "agent");
            asm volatile("s_waitcnt vmcnt(0)" ::: "memory");
        }
    }
    __syncthreads();
}

__global__ void __launch_bounds__(512, 2) fwd_kernel(Params P) {
    extern __shared__ __attribute__((aligned(16))) unsigned char lds_raw[];
    LAS unsigned char* lds = (LAS unsigned char*)lds_raw;
    cg::grid_group grid = cg::this_grid();
    const int G = gridDim.x;
    volatile LAS unsigned* bst = (volatile LAS unsigned*)(lds + MISC_OFF);
    if (threadIdx.x < 2) bst[threadIdx.x] = 0u;
    __syncthreads();
    XcdBarrier bar = xcd_barrier_post((unsigned*)(P.ws + WS_CTL), bst);
    int ph = 0;
#define PHASE_BEGIN if (ph >= P.ph_lo && ph < P.ph_hi) { unsigned char* ws = P.ws; float* outp = P.out; asm volatile("" : "+s"(ws), "+s"(outp));
#define PHASE_END   if (ph + 1 < P.ph_hi) { if (ph == 0) grid.sync(); else xcd_barrier(bar); } } ++ph;
    PHASE_BEGIN
#ifndef SKIP_PRO
        prologue(P, lds, G);
#endif
    PHASE_END
    for (int l = 0; l < DEPTH; ++l) {
        PHASE_BEGIN
            const float* xin_ctx = l == 0 ? P.x_prompt : outp; const float* xin_lat = l == 0 ? P.x_sample : outp + (size_t)M_CTX * DM;
            norm_phase(xin_ctx, xin_lat, P.norm1_g + l * DM, (const float*)(ws + WS_MODS) + (size_t)l * NCOND * 6144, 0, (bf16_t*)(ws + WS_XN), G);
            cache_phase(P, l, G);
        PHASE_END
        PHASE_BEGIN {
            const float* MISC = (const float*)(ws + WS_MISC);
            pg8::Gemm g{(const bf16_t*)(ws + WS_XN), (const bf16_t*)(ws + WS_WIN) + (size_t)l * INW * 1024, M_ALL, INW, 1024}; pg8::StaticOrder S; S.init(M_ALL, INW, G, blockIdx.x);
            EpiIn E{l, P.gqa_qn_g + l * 64, P.gqa_kn_g + l * 64, P.diff_qn_g + l * 32, P.diff_kn_g + l * 32, MISC + MI_R64C, MISC + MI_R64S, MISC + MI_R32C, MISC + MI_R32S,
                    (bf16_t*)(ws + WS_QG), (bf16_t*)(ws + WS_QD), (bf16_t*)(ws + WS_KG), (bf16_t*)(ws + WS_VG), (bf16_t*)(ws + WS_KD), (bf16_t*)(ws + WS_VD), (bf16_t*)(ws + WS_CB), (bf16_t*)(ws + WS_PB), outp};
#ifndef SKIP_IN
            pg8::gemm_phase(lds, lds + XCH_OFF, g, S, E);
#endif
        } PHASE_END
        PHASE_BEGIN {
            const float* MISC = (const float*)(ws + WS_MISC);
            AttnArgs A{(const bf16_t*)(ws + WS_QG), (const bf16_t*)(ws + WS_QD), (const bf16_t*)(ws + WS_KG), (const bf16_t*)(ws + WS_VG), (const bf16_t*)(ws + WS_KD), (const bf16_t*)(ws + WS_VD),
                       (const bf16_t*)(ws + WS_CB), (const bf16_t*)(ws + WS_PB), (bf16_t*)(ws + WS_XN), P.conv_w + l * 768, P.conv_b + l * 256, P.diff_subln_g + l * 64, MISC[MI_LAM + l], P.lam_init[l], (float*)(ws + WS_DSCR)};
#ifndef SKIP_ATT
            attn_phase(A, (LAS char*)lds, (char*)lds_raw, G);
#endif
        } PHASE_END
        PHASE_BEGIN {
            const float* xin_ctx = l == 0 ? P.x_prompt : outp; const float* xin_lat = l == 0 ? P.x_sample : outp + (size_t)M_CTX * DM;
            pg8::Gemm g{(const bf16_t*)(ws + WS_XN), (const bf16_t*)(ws + WS_WOUT) + (size_t)l * 1024 * 1024, M_ALL, 1024, 1024}; pg8::StaticOrder S; S.init(M_ALL, 1024, G, blockIdx.x);
            EpiRes E{xin_ctx, xin_lat, outp, (const float*)(ws + WS_MODS) + (size_t)l * NCOND * 6144 + 2 * 1024};
#ifndef SKIP_RES
            pg8::gemm_phase(lds, lds + XCH_OFF, g, S, E);
#endif
        } PHASE_END
        PHASE_BEGIN
            norm_phase(outp, outp + (size_t)M_CTX * DM, P.norm2_g + l * DM, (const float*)(ws + WS_MODS) + (size_t)l * NCOND * 6144, 3, (bf16_t*)(ws + WS_XN), G);
        PHASE_END
        PHASE_BEGIN {
            float* EPb = (float*)(ws + WS_EDGE);
            pg8::Gemm g{(const bf16_t*)(ws + WS_XN), (const bf16_t*)(ws + WS_WUP) + (size_t)l * UPW * 1024, M_ALL, UPW, 1024}; pg8::StaticOrder S; S.init(M_ALL, UPW, G, blockIdx.x);
            EpiUp E{P.ffn_conv_w + (size_t)l * 3 * DFF, P.ffn_conv_b + (size_t)l * DFF, (bf16_t*)(ws + WS_U), EPb, EPb + EDGE_ELEMS, EPb + 2 * EDGE_ELEMS};
#ifndef SKIP_UP
            pg8::gemm_phase(lds, lds + XCH_OFF, g, S, E);
#endif
        } PHASE_END
        PHASE_BEGIN {
            float* EPb = (float*)(ws + WS_EDGE);
            fixup_phase(P.ffn_conv_w + (size_t)l * 3 * DFF, (bf16_t*)(ws + WS_U), EPb, EPb + EDGE_ELEMS, EPb + 2 * EDGE_ELEMS, G);
        } PHASE_END
        PHASE_BEGIN {
            pg8::Gemm g{(const bf16_t*)(ws + WS_U), (const bf16_t*)(ws + WS_WDN) + (size_t)l * 1024 * DFF, M_ALL, 1024, DFF}; pg8::StaticOrder S; S.init(M_ALL, 1024, G, blockIdx.x);
            EpiRes E{outp, outp + (size_t)M_CTX * DM, outp, (const float*)(ws + WS_MODS) + (size_t)l * NCOND * 6144 + 5 * 1024};
#ifndef SKIP_RES
            pg8::gemm_phase(lds, lds + XCH_OFF, g, S, E);
#endif
        } PHASE_END
    }
}

constexpr int N_PHASES = 1 + DEPTH * 8;
#ifndef N_LAUNCH_SPLIT
#define N_LAUNCH_SPLIT 0
#endif

extern "C" void kernel_launch(void* const* d_in, const int* in_sizes, int n_in, void* d_out, int out_size, void* d_ws, size_t ws_size, hipStream_t stream) {
    static int grid = 0;
    if (grid == 0) {
        if (n_in != 26 || ws_size < WS_END) { fprintf(stderr, "kernel_launch: unexpected n_in %d or ws_size %zu (< %zu)\n", n_in, ws_size, (size_t)WS_END); grid = -1; return; }
        int dev = 0, cus = 0, per_cu = 0;
        hipGetDevice(&dev); hipDeviceGetAttribute(&cus, hipDeviceAttributeMultiprocessorCount, dev);
        hipFuncSetAttribute((const void*)fwd_kernel, hipFuncAttributeMaxDynamicSharedMemorySize, LDS_BYTES);
        hipOccupancyMaxActiveBlocksPerMultiprocessor(&per_cu, (const void*)fwd_kernel, 512, LDS_BYTES);
        if (per_cu < 1) { fprintf(stderr, "kernel_launch: occupancy query gives %d\n", per_cu); per_cu = 1; }
        (void)hipGetLastError();
        grid = cus * 1;
    }
    if (grid < 0) return;
    Params p{};
    const float** pp = (const float**)&p;
    for (int i = 0; i < 26; ++i) pp[i] = (const float*)d_in[i];
    p.out = (float*)d_out; p.ws = (unsigned char*)d_ws;
    for (int l = 0; l < 4; ++l) p.lam_init[l] = (float)(0.8 - 0.6 * exp(-0.3 * (double)l));
#if N_LAUNCH_SPLIT
    for (int ph = 0; ph < N_PHASES; ++ph) { p.ph_lo = ph; p.ph_hi = ph + 1; hipLaunchKernelGGL(fwd_kernel, dim3(grid), dim3(512), LDS_BYTES, stream, p); }
#else
    p.ph_lo = 0; p.ph_hi = N_PHASES;
    if (hipMemsetAsync((char*)d_ws + WS_CTL, 0, CTL_ZERO_BYTES, stream) != hipSuccess) { fprintf(stderr, "kernel_launch: memset failed\n"); return; }
    void* args[] = {&p};
    hipError_t e = hipLaunchCooperativeKernel((const void*)fwd_kernel, dim3(grid), dim3(512), args, LDS_BYTES, stream);
    if (e != hipSuccess) fprintf(stderr, "cooperative launch failed: %s (grid %d)\n", hipGetErrorString(e), grid);
#endif
}
```

```cpp
#include <hip/hip_runtime.h>
#include <hip/hip_cooperative_groups.h>
#include <cstdio>
#include <cstdint>
#include <cmath>
namespace cg = cooperative_groups;

#define LAS __attribute__((address_space(3)))
#define GAS __attribute__((address_space(1)))
typedef unsigned short bf16_t;
typedef short bf16x8 __attribute__((ext_vector_type(8)));
typedef short s16x4 __attribute__((ext_vector_type(4)));
typedef float f32x4 __attribute__((ext_vector_type(4)));
typedef float f32x16 __attribute__((ext_vector_type(16)));
typedef unsigned u32x4 __attribute__((ext_vector_type(4)));
typedef unsigned u32x2 __attribute__((ext_vector_type(2)));
typedef float f32x2 __attribute__((ext_vector_type(2)));
typedef __bf16 bf16x2_t __attribute__((ext_vector_type(2)));

__device__ __forceinline__ unsigned cvtpk(float lo, float hi) { f32x2 v = {lo, hi}; bf16x2_t b = __builtin_convertvector(v, bf16x2_t); return __builtin_bit_cast(unsigned, b); }
__device__ __forceinline__ int opaque_tid() { int t = threadIdx.x; asm volatile("" : "+v"(t)); return t; }
__device__ __forceinline__ float bf2f(unsigned short u) { return __uint_as_float(((unsigned)u) << 16); }

constexpr int DM = 1024, DEPTH = 4, NCOND = 9;
constexpr int M_CTX = 8192, M_ALL = 40960, NTM = 160;
constexpr int INW = 2304, DFF = 2816, UPW = 5632;
constexpr int SLAT = 4352;
constexpr float EPS = 1e-6f;
constexpr float LOG2E = 1.4426950408889634f;
constexpr float QSCALE_G = 0.125f * LOG2E;
constexpr float QSCALE_D = 0.17677669529663687f * LOG2E;
constexpr size_t OUT_GK = 41943040, OUT_GV = OUT_GK + 4194304, OUT_DK = OUT_GV + 4194304, OUT_DV = OUT_DK + 8388608;
constexpr size_t MiB = 1u << 20;
constexpr size_t WS_MODS = 1 * MiB;
constexpr size_t WS_MISC = 2 * MiB;
constexpr size_t WS_EDGE = 3 * MiB;
constexpr size_t EDGE_ELEMS = (size_t)NTM * 2 * DFF;
constexpr size_t WS_WIN = 16 * MiB;
constexpr size_t WS_WOUT = 34 * MiB;
constexpr size_t WS_WUP = 42 * MiB;
constexpr size_t WS_WDN = 86 * MiB;
constexpr size_t WS_XN = 108 * MiB;
constexpr size_t WS_U = 188 * MiB;
constexpr size_t WS_QG = WS_U, WS_QD = WS_QG + (size_t)M_ALL * 512 * 2, WS_KG = WS_QD + (size_t)M_ALL * 256 * 2;
constexpr size_t KROWS = 8192 + 8 * SLAT;
constexpr size_t WS_VG = WS_KG + KROWS * 128 * 2, WS_KD = WS_VG + KROWS * 128 * 2, WS_VD = WS_KD + KROWS * 256 * 2;
constexpr size_t WS_CB = WS_VD + KROWS * 256 * 2, WS_PB = WS_CB + (size_t)M_ALL * 256 * 2, WS_UEND = WS_PB + (size_t)M_ALL * 256 * 2;
constexpr size_t WS_DSCR = WS_U + (size_t)M_ALL * DFF * 2;
constexpr size_t WS_END = WS_DSCR + 32 * MiB;
static_assert(WS_UEND <= WS_DSCR, "union");
constexpr int MI_LAM = 0, MI_R64C = 64, MI_R64S = MI_R64C + 1024, MI_R32C = MI_R64S + 1024, MI_R32S = MI_R32C + 512;

constexpr int RING_BYTES = 131072, XCH_OFF = RING_BYTES, MISC_OFF = RING_BYTES + 4096, LDS_BYTES = RING_BYTES + 4096 + 256;
constexpr size_t WS_CTL = 0, CTL_ZERO_BYTES = 65536;

struct TileInfo {
    int lat, seq, t0, ci, S; long R;
    __device__ __forceinline__ TileInfo(int pm) {
        if (pm < 32) { lat = 0; seq = pm; t0 = 0; ci = 0; S = 256; R = 256L * pm; }
        else { const int b = (pm - 32) >> 4; lat = 1; seq = b; t0 = ((pm - 32) & 15) * 256; ci = 1 + b; S = SLAT; R = 8192L + (long)SLAT * b; }
    }
};

namespace pg8 {
constexpr int BM = 256, BK = 64, HALF = 128, HTB = HALF * BK * 2, NXCD = 8, WGM = 8;
__host__ __device__ __forceinline__ int lds_byte(int r, int c) { const int st = (r >> 4) * 2 + (c >> 5), rr = r & 15, cc = c & 31, ob = rr * 64 + cc * 2; return st * 1024 + (ob ^ (((ob >> 9) & 1) << 5)); }
__host__ __device__ __forceinline__ void stage_rc(int b, int& R, int& C) { const int st = b / 1024, sb = b % 1024, swz = sb ^ (((sb >> 9) & 1) << 5); R = (st >> 1) * 16 + swz / 64; C = (st & 1) * 32 + (swz % 64) / 2; }
struct Unit { int pm, pn; };
struct Gemm { const bf16_t* A; const bf16_t* Bt; int M, N, K; };
struct StaticOrder {
    int nM, nN, nwg, G, c;
    __device__ void init(int M, int N, int G_, int c_) { nM = M / BM; nN = N / BM; nwg = nM * nN; G = G_; c = c_; }
    __device__ bool next(int i, Unit& u) const {
        const long L = (long)i * G + c; if (L >= nwg) return false;
        int wgid = (int)L; { const int q = nwg / NXCD, r = nwg % NXCD, xcd = wgid % NXCD, off = wgid / NXCD; wgid = (xcd < r ? xcd * (q + 1) : r * (q + 1) + (xcd - r) * q) + off; }
        const int nig = WGM * nN, gid = wgid / nig, fm = gid * WGM, gsz = (nM - fm) < WGM ? (nM - fm) : WGM;
        u.pm = fm + ((wgid % nig) % gsz); u.pn = (wgid % nig) / gsz; return true;
    }
};
template <class Epi>
__device__ __forceinline__ void gemm_phase(LAS unsigned char* lds, LAS unsigned char* xlds, const Gemm g, const StaticOrder& S, const Epi& E) {
    const int tid = opaque_tid(), wid = __builtin_amdgcn_readfirstlane(tid >> 6), lane = tid & 63, wr = wid >> 2, wc = wid & 3, fr = lane & 15, fq = lane >> 4;
    const int K = g.K, nt = K / BK;
    unsigned voffA[2];
#pragma unroll
    for (int i = 0; i < 2; ++i) { int R, C; stage_rc(tid * 16 + i * 8192, R, C); voffA[i] = (unsigned)(R * K + C) * 2u; }
    const size_t kstep = (size_t)(BK * 2);
    const size_t hstep = (size_t)HALF * K * 2;
    const size_t tstep = 2 * hstep;
    const unsigned ldsw = (unsigned)wid * 1024u;
    const int aoff = lds_byte(wr * 64 + fr, fq * 8), boff = lds_byte(wc * 32 + fr, fq * 8);
#define PG8_SA(b, h) (((b) * 2 + (h)) * HTB)
#define PG8_SB(b, h) ((4 + (b) * 2 + (h)) * HTB)
#define PG8_STAGE(bufoff, gbase) do { _Pragma("unroll") for (int _i = 0; _i < 2; ++_i) \
        __builtin_amdgcn_global_load_lds((const unsigned*)((const char*)(gbase) + voffA[_i]), (LAS unsigned*)(lds + (bufoff) + ldsw + _i * 8192), 16, 0, 0); } while (0)
#define PG8_LDA(dst, b, h) do { _Pragma("unroll") for (int m = 0; m < 4; ++m) _Pragma("unroll") for (int k = 0; k < 2; ++k) dst[m][k] = *(const LAS bf16x8*)(lds + PG8_SA(b, h) + aoff + m * 2048 + k * 1024); } while (0)
#define PG8_LDB(dst, b, h) do { _Pragma("unroll") for (int n = 0; n < 2; ++n) _Pragma("unroll") for (int k = 0; k < 2; ++k) dst[n][k] = *(const LAS bf16x8*)(lds + PG8_SB(b, h) + boff + n * 2048 + k * 1024); } while (0)
#define PG8_MMA(ai, bj, At, Bt) do { __builtin_amdgcn_s_setprio(1); _Pragma("unroll") for (int m = 0; m < 4; ++m) _Pragma("unroll") for (int n = 0; n < 2; ++n) _Pragma("unroll") for (int k = 0; k < 2; ++k) \
        acc[ai][bj][m][n] = __builtin_amdgcn_mfma_f32_16x16x32_bf16(Bt[n][k], At[m][k], acc[ai][bj][m][n], 0, 0, 0); __builtin_amdgcn_s_setprio(0); } while (0)
#define PG8_WAIT_V(n) asm volatile("s_waitcnt vmcnt(" #n ")" ::: "memory")
#define PG8_WAIT_L(n) asm volatile("s_waitcnt lgkmcnt(" #n ")" ::: "memory")
#define PG8_BAR __builtin_amdgcn_s_barrier()
#define PG8_SCHED __builtin_amdgcn_sched_barrier(0)
    Unit cur, nxt; int ui = 0;
    if (!S.next(0, cur)) return;
    f32x4 acc[2][2][4][2];
#pragma unroll
    for (int a = 0; a < 2; ++a)
#pragma unroll
        for (int b = 0; b < 2; ++b)
#pragma unroll
            for (int m = 0; m < 4; ++m)
#pragma unroll
                for (int n = 0; n < 2; ++n) acc[a][b][m][n] = (f32x4){0.f, 0.f, 0.f, 0.f};
    bf16x8 At[4][2], B0[2][2], B1[2][2];
    const char* cA = (const char*)g.A + (size_t)cur.pm * tstep; const char* cB = (const char*)g.Bt + (size_t)cur.pn * tstep;
    PG8_STAGE(PG8_SB(0, 0), cB); PG8_STAGE(PG8_SB(0, 1), cB + hstep); PG8_STAGE(PG8_SA(0, 0), cA); PG8_STAGE(PG8_SA(0, 1), cA + hstep);
    if (wr == 1) PG8_BAR;
    PG8_WAIT_V(2); PG8_BAR;
    PG8_STAGE(PG8_SB(1, 0), cB + kstep); PG8_STAGE(PG8_SA(1, 0), cA + kstep); PG8_STAGE(PG8_SB(1, 1), cB + hstep + kstep);
    PG8_WAIT_V(6); PG8_BAR;
    for (;;) {
        const bool has_next = S.next(ui + 1, nxt);
        const char* nA = has_next ? (const char*)g.A + (size_t)nxt.pm * tstep : cA; const char* nB = has_next ? (const char*)g.Bt + (size_t)nxt.pn * tstep : cB;
        for (int t = 0; t < nt; t += 2) {
            const bool last = (t == nt - 2);
            const char* a1 = cA + (size_t)(t + 1) * kstep;
            const char* a2 = last ? nA : cA + (size_t)(t + 2) * kstep; const char* b2 = last ? nB : cB + (size_t)(t + 2) * kstep;
            const char* a3 = a2 + kstep; const char* b3 = b2 + kstep;
            PG8_LDB(B0, 0, 0); PG8_LDB(B1, 0, 1); PG8_SCHED; PG8_LDA(At, 0, 0); PG8_STAGE(PG8_SA(1, 1), a1 + hstep);
            PG8_WAIT_V(8); PG8_WAIT_L(0); PG8_BAR; PG8_MMA(0, 0, At, B0); PG8_MMA(0, 1, At, B1); PG8_BAR; PG8_SCHED;
            PG8_LDA(At, 0, 1); PG8_STAGE(PG8_SB(0, 0), b2); PG8_STAGE(PG8_SB(0, 1), b2 + hstep); PG8_STAGE(PG8_SA(0, 0), a2);
            PG8_WAIT_V(8); PG8_WAIT_L(0); PG8_BAR; PG8_MMA(1, 0, At, B0); PG8_MMA(1, 1, At, B1); PG8_BAR; PG8_SCHED;
            PG8_LDB(B0, 1, 0); PG8_LDB(B1, 1, 1); PG8_SCHED; PG8_LDA(At, 1, 0); PG8_STAGE(PG8_SA(0, 1), a2 + hstep);
            PG8_WAIT_V(8); PG8_WAIT_L(0); PG8_BAR; PG8_MMA(0, 0, At, B0); PG8_MMA(0, 1, At, B1); PG8_BAR; PG8_SCHED;
            PG8_LDA(At, 1, 1); PG8_STAGE(PG8_SB(1, 0), b3); PG8_STAGE(PG8_SB(1, 1), b3 + hstep); PG8_STAGE(PG8_SA(1, 0), a3);
            PG8_WAIT_V(8); PG8_WAIT_L(0); PG8_BAR; PG8_MMA(1, 0, At, B0); PG8_MMA(1, 1, At, B1); PG8_BAR; PG8_SCHED;
        }
        if (wr == 0) PG8_BAR;
        { int fr_ = fr, fq_ = fq; asm volatile("" : "+v"(fr_), "+v"(fq_)); E(acc, cur, wr, wc, fr_, fq_, xlds); }
        if (!has_next) break;
#pragma unroll
        for (int a = 0; a < 2; ++a)
#pragma unroll
            for (int b = 0; b < 2; ++b)
#pragma unroll
                for (int m = 0; m < 4; ++m)
#pragma unroll
                    for (int n = 0; n < 2; ++n) acc[a][b][m][n] = (f32x4){0.f, 0.f, 0.f, 0.f};
        cur = nxt; cA = nA; cB = nB; ++ui;
        if (wr == 1) PG8_BAR;
    }
    PG8_WAIT_V(0);
    PG8_BAR;
#undef PG8_SA
#undef PG8_SB
#undef PG8_STAGE
#undef PG8_LDA
#undef PG8_LDB
#undef PG8_MMA
#undef PG8_WAIT_V
#undef PG8_WAIT_L
#undef PG8_BAR
#undef PG8_SCHED
}
}

typedef f32x4 Acc[2][2][4][2];

struct EpiRes {
    const float* xin_ctx; const float* xin_lat; float* xout; const float* gate;
    __device__ __forceinline__ void operator()(const Acc& acc, const pg8::Unit& u, int wr, int wc, int fr, int fq, LAS unsigned char*) const {
        const TileInfo ti(u.pm);
        const int col0 = u.pn * 256 + wc * 32 + 4 * fq;
        const float* gp = gate + ti.ci * 6144 + col0;
        f32x4 g4[2][2];
#pragma unroll
        for (int bj = 0; bj < 2; ++bj)
#pragma unroll
            for (int n = 0; n < 2; ++n) g4[bj][n] = *(const GAS f32x4*)(gp + bj * 128 + n * 16);
        const float* xin = ti.lat ? xin_lat + (size_t)(u.pm * 256 - M_CTX) * DM : xin_ctx + (size_t)(u.pm * 256) * DM;
        float* xo = xout + (size_t)(u.pm * 256) * DM;
#pragma unroll
        for (int ai = 0; ai < 2; ++ai) {
            f32x4 xv[4][2][2];
#pragma unroll
            for (int m = 0; m < 4; ++m) {
                const size_t off = (size_t)(ai * 128 + wr * 64 + m * 16 + fr) * DM + col0;
#pragma unroll
                for (int bj = 0; bj < 2; ++bj)
#pragma unroll
                    for (int n = 0; n < 2; ++n) xv[m][bj][n] = *(const GAS f32x4*)(xin + off + bj * 128 + n * 16);
            }
#pragma unroll
            for (int m = 0; m < 4; ++m) {
                const size_t off = (size_t)(ai * 128 + wr * 64 + m * 16 + fr) * DM + col0;
#pragma unroll
                for (int bj = 0; bj < 2; ++bj)
#pragma unroll
                    for (int n = 0; n < 2; ++n) *(GAS f32x4*)(xo + off + bj * 128 + n * 16) = xv[m][bj][n] + g4[bj][n] * acc[ai][bj][m][n];
            }
            __builtin_amdgcn_sched_group_barrier(0x020, 16, 0);
            asm volatile("" ::: "memory");
            __builtin_amdgcn_sched_barrier(0);
        }
    }
};

struct EpiIn {
    int layer;
    const float *qn_g, *kn_g, *dqn_g, *dkn_g;
    const float *r64c, *r64s, *r32c, *r32s;
    bf16_t *QG, *QD, *KG, *VG, *KD, *VD, *CB, *PB;
    float* out;
    __device__ __forceinline__ void operator()(const Acc& acc, const pg8::Unit& u, int wr, int wc, int fr, int fq, LAS unsigned char*) const {
        const TileInfo ti(u.pm);
        const int pn = u.pn;
        const int rbase = wr * 64 + fr;
        if (pn < 2 || (pn == 2 && wc < 2)) {
            const bool isq = pn < 2;
            const float* gsrc = (isq ? qn_g : kn_g) + 4 * fq;
            const int head = isq ? 4 * pn + wc : wc;
            f32x4 g4[2][2], rc[2], rs[2];
#pragma unroll
            for (int bj = 0; bj < 2; ++bj)
#pragma unroll
                for (int n = 0; n < 2; ++n) g4[bj][n] = *(const GAS f32x4*)(gsrc + 32 * bj + 16 * n);
#pragma unroll
            for (int ai = 0; ai < 2; ++ai) { const int pos = (ti.t0 >> 6) + 2 * ai + wr; rc[ai] = *(const GAS f32x4*)(r64c + pos * 16 + 4 * fq); rs[ai] = *(const GAS f32x4*)(r64s + pos * 16 + 4 * fq); }
            float ss[8];
#pragma unroll
            for (int ai = 0; ai < 2; ++ai)
#pragma unroll
                for (int m = 0; m < 4; ++m) { float t_ = 0.f;
#pragma unroll
                    for (int bj = 0; bj < 2; ++bj)
#pragma unroll
                        for (int n = 0; n < 2; ++n) { const f32x4 v = acc[ai][bj][m][n]; t_ += (v[0] * v[0] + v[1] * v[1]) + (v[2] * v[2] + v[3] * v[3]); }
                    ss[ai * 4 + m] = t_; }
#pragma unroll
            for (int i = 0; i < 8; ++i) ss[i] += __shfl_xor(ss[i], 16);
#pragma unroll
            for (int i = 0; i < 8; ++i) ss[i] += __shfl_xor(ss[i], 32);
#pragma unroll
            for (int mh = 0; mh < 2; ++mh) {
                f32x4 cc[2], cs[2];
#pragma unroll
                for (int mm = 0; mm < 2; ++mm) { const int pos = 16 * (2 * mh + mm) + fr; cc[mm] = *(const GAS f32x4*)(r64c + pos * 16 + 4 * fq); cs[mm] = *(const GAS f32x4*)(r64s + pos * 16 + 4 * fq); }
                if (mh == 0) __builtin_amdgcn_sched_group_barrier(0x020, 12, 0); else __builtin_amdgcn_sched_group_barrier(0x020, 4, 0);
#pragma unroll
                for (int mm = 0; mm < 2; ++mm)
#pragma unroll
                    for (int ai = 0; ai < 2; ++ai) {
                        const int m = 2 * mh + mm;
                        const int rt = ai * 128 + m * 16 + rbase; const int t = ti.t0 + rt;
                        const float rstd = rsqrtf(ss[ai * 4 + m] * (1.f / 64.f) + EPS);
                        bf16_t* dst = isq ? QG + ((size_t)u.pm * 256 + rt) * 512 + head * 64 + 8 * fq : KG + ((ti.R * 2 + (long)head * ti.S + t) * 64) + 8 * fq;
                        float* o = out + OUT_GK + ((size_t)(ti.seq * 4 + layer) * 256 + t) * 128 + head * 64 + 4 * fq;
#pragma unroll
                        for (int bj = 0; bj < 2; ++bj) {
                            f32x4 y0 = acc[ai][bj][m][0] * rstd * g4[bj][0], y1 = acc[ai][bj][m][1] * rstd * g4[bj][1];
                            if (!isq && !ti.lat) { *(GAS f32x4*)(o + 32 * bj) = y0; *(GAS f32x4*)(o + 32 * bj + 16) = y1; }
                            if (ti.lat) {
                                const f32x4 c4 = bj ? cc[mm] : rc[ai], s4 = bj ? cs[mm] : rs[ai];
                                const f32x4 o0 = y0 * c4 - y1 * s4, o1 = y1 * c4 + y0 * s4; y0 = o0; y1 = o1;
                            }
                            if (isq) { y0 = y0 * QSCALE_G; y1 = y1 * QSCALE_G; }
                            u32x4 w; w.x = cvtpk(y0[0], y0[1]); w.y = cvtpk(y0[2], y0[3]); w.z = cvtpk(y1[0], y1[1]); w.w = cvtpk(y1[2], y1[3]);
                            *(GAS u32x4*)(dst + 32 * bj) = w;
                        }
                    }
                asm volatile("" ::: "memory"); __builtin_amdgcn_sched_barrier(0);
            }
        } else if (pn == 2) {
            const int head = wc - 2;
#pragma unroll
            for (int ai = 0; ai < 2; ++ai)
#pragma unroll
                for (int m = 0; m < 4; ++m) {
                    const int rt = ai * 128 + m * 16 + rbase; const int t = ti.t0 + rt;
                    if (!ti.lat) {
                        float* o = out + OUT_GV + ((size_t)(ti.seq * 4 + layer) * 256 + t) * 128 + head * 64 + 8 * fq;
#pragma unroll
                        for (int bj = 0; bj < 2; ++bj) { *(GAS f32x4*)(o + 32 * bj) = acc[ai][bj][m][0]; *(GAS f32x4*)(o + 32 * bj + 4) = acc[ai][bj][m][1]; }
                    }
                    bf16_t* vp = VG + ((ti.R * 2 + (long)head * ti.S + t) * 64) + 8 * fq;
#pragma unroll
                    for (int bj = 0; bj < 2; ++bj) { const f32x4 a = acc[ai][bj][m][0], b = acc[ai][bj][m][1]; u32x4 w; w.x = cvtpk(a[0], a[1]); w.y = cvtpk(a[2], a[3]); w.z = cvtpk(b[0], b[1]); w.w = cvtpk(b[2], b[3]); *(GAS u32x4*)(vp + 32 * bj) = w; }
                }
        } else if (pn == 3) {
#pragma unroll
            for (int ai = 0; ai < 2; ++ai)
#pragma unroll
                for (int m = 0; m < 4; ++m) {
                    const size_t grow = (size_t)u.pm * 256 + ai * 128 + m * 16 + rbase;
                    bf16_t* p = CB + grow * 256 + 32 * wc + 8 * fq;
#pragma unroll
                    for (int bj = 0; bj < 2; ++bj) { const f32x4 a = acc[ai][bj][m][0], b = acc[ai][bj][m][1]; u32x4 w; w.x = cvtpk(a[0], a[1]); w.y = cvtpk(a[2], a[3]); w.z = cvtpk(b[0], b[1]); w.w = cvtpk(b[2], b[3]); *(GAS u32x4*)(p + 128 * bj) = w; }
                }
        } else if (pn < 6) {
#pragma unroll
            for (int ai = 0; ai < 2; ++ai)
#pragma unroll
                for (int m = 0; m < 4; ++m) {
                    const size_t grow = (size_t)u.pm * 256 + ai * 128 + m * 16 + rbase;
                    bf16_t* p = PB + grow * 256 + 128 * (pn - 4) + 32 * wc + 8 * fq;
                    const f32x4 a = acc[ai][0][m][0] * acc[ai][1][m][0], b = acc[ai][0][m][1] * acc[ai][1][m][1];
                    u32x4 w; w.x = cvtpk(a[0], a[1]); w.y = cvtpk(a[2], a[3]); w.z = cvtpk(b[0], b[1]); w.w = cvtpk(b[2], b[3]); *(GAS u32x4*)p = w;
                }
        } else if (pn < 8) {
            const bool isq = pn == 6;
            const float* gsrc = isq ? dqn_g : dkn_g;
            const int a_ax = fq >> 1, ib = 4 * (fq & 1);
            const float* gp = gsrc + 16 * a_ax + ib;
            const int head = wc;
            const f32x4 g0 = *(const GAS f32x4*)gp, g1 = *(const GAS f32x4*)(gp + 8);
            f32x4 tc[4], ts[4];
#pragma unroll
            for (int j = 0; j < 4; ++j) { const int pos = a_ax ? (16 * j + fr) : ((ti.t0 >> 6) + 2 * (j & 1) + wr); tc[j] = *(const GAS f32x4*)(r32c + pos * 8 + ib); ts[j] = *(const GAS f32x4*)(r32s + pos * 8 + ib); }
            __builtin_amdgcn_sched_group_barrier(0x020, 10, 0);
#pragma unroll
            for (int ai = 0; ai < 2; ++ai) {
                float ss[4][2];
#pragma unroll
                for (int m = 0; m < 4; ++m)
#pragma unroll
                    for (int bj = 0; bj < 2; ++bj) { float t_ = 0.f;
#pragma unroll
                        for (int n = 0; n < 2; ++n) { const f32x4 v = acc[ai][bj][m][n]; t_ += (v[0] * v[0] + v[1] * v[1]) + (v[2] * v[2] + v[3] * v[3]); }
                        ss[m][bj] = t_; }
#pragma unroll
                for (int i = 0; i < 4; ++i) { ss[i][0] += __shfl_xor(ss[i][0], 16); ss[i][1] += __shfl_xor(ss[i][1], 16); }
#pragma unroll
                for (int i = 0; i < 4; ++i) { ss[i][0] += __shfl_xor(ss[i][0], 32); ss[i][1] += __shfl_xor(ss[i][1], 32); }
#pragma unroll
                for (int m = 0; m < 4; ++m) {
                    const int rt = ai * 128 + m * 16 + rbase; const int t = ti.t0 + rt; const size_t grow = (size_t)u.pm * 256 + rt;
                    const f32x4 c4 = a_ax ? tc[m] : tc[ai], s4 = a_ax ? ts[m] : ts[ai];
#pragma unroll
                    for (int bj = 0; bj < 2; ++bj) {
                        const float rstd = rsqrtf(ss[m][bj] * (1.f / 32.f) + EPS);
                        f32x4 y0 = acc[ai][bj][m][0] * rstd * g0, y1 = acc[ai][bj][m][1] * rstd * g1;
                        if (!isq && !ti.lat) {
                            float* o = out + OUT_DK + ((size_t)(ti.seq * 4 + layer) * 256 + t) * 256 + head * 64 + bj * 32 + 16 * a_ax + ib;
                            *(GAS f32x4*)(o) = y0; *(GAS f32x4*)(o + 8) = y1;
                        }
                        if (ti.lat) { const f32x4 o0 = y0 * c4 - y1 * s4, o1 = y1 * c4 + y0 * s4; y0 = o0; y1 = o1; }
                        bf16_t* dst;
                        if (isq) { y0 = y0 * QSCALE_D; y1 = y1 * QSCALE_D; dst = QD + grow * 256 + head * 64 + bj * 32 + 16 * a_ax + 2 * ib; }
                        else dst = KD + ((ti.R * 8 + (long)(head * 2 + bj) * ti.S + t) * 32) + 16 * a_ax + 2 * ib;
                        u32x4 w; w.x = cvtpk(y0[0], y0[1]); w.y = cvtpk(y0[2], y0[3]); w.z = cvtpk(y1[0], y1[1]); w.w = cvtpk(y1[2], y1[3]);
                        *(GAS u32x4*)dst = w;
                    }
                }
                asm volatile("" ::: "memory"); __builtin_amdgcn_sched_barrier(0);
            }
        } else {
            const int head = wc;
#pragma unroll
            for (int ai = 0; ai < 2; ++ai)
#pragma unroll
                for (int m = 0; m < 4; ++m) {
                    const int rt = ai * 128 + m * 16 + rbase; const int t = ti.t0 + rt;
                    if (!ti.lat) {
                        float* o = out + OUT_DV + ((size_t)(ti.seq * 4 + layer) * 256 + t) * 256 + head * 64 + 8 * fq;
#pragma unroll
                        for (int bj = 0; bj < 2; ++bj) { *(GAS f32x4*)(o + 32 * bj) = acc[ai][bj][m][0]; *(GAS f32x4*)(o + 32 * bj + 4) = acc[ai][bj][m][1]; }
                    }
                    bf16_t* vp = VD + ((ti.R * 4 + (long)head * ti.S + t) * 64) + 8 * fq;
#pragma unroll
                    for (int bj = 0; bj < 2; ++bj) { const f32x4 a = acc[ai][bj][m][0], b = acc[ai][bj][m][1]; u32x4 w; w.x = cvtpk(a[0], a[1]); w.y = cvtpk(a[2], a[3]); w.z = cvtpk(b[0], b[1]); w.w = cvtpk(b[2], b[3]); *(GAS u32x4*)(vp + 32 * bj) = w; }
                }
        }
    }
};

__device__ __forceinline__ float dpp_ror1(float x) { return __int_as_float(__builtin_amdgcn_update_dpp(0, __float_as_int(x), 0x121, 0xf, 0xf, false)); }
__device__ __forceinline__ float dpp_ror15(float x) { return __int_as_float(__builtin_amdgcn_update_dpp(0, __float_as_int(x), 0x12F, 0xf, 0xf, false)); }
__device__ __forceinline__ float silu_f(float x) { return x * __builtin_amdgcn_rcpf(1.f + __builtin_amdgcn_exp2f(-x * LOG2E)); }
struct EpiUp {
    const float* cw; const float* cbias; bf16_t* F; float* EP; float* EA; float* EU;
    __device__ __forceinline__ void operator()(const Acc& acc, const pg8::Unit& u, int wr, int wc, int fr, int fq, LAS unsigned char* xlds) const {
        const TileInfo ti(u.pm);
        const int c0 = u.pn * 128 + wc * 32 + 8 * fq;
        LAS float* X = (LAS float*)xlds;
#pragma unroll
        for (int ai = 0; ai < 2; ++ai) {
            if (fr == 0) { LAS float* p = X + ((((ai * 2 + wr) * 4 + wc) * 2 + 0) * 4 + fq) * 8; *(LAS f32x4*)p = acc[ai][0][0][0]; *(LAS f32x4*)(p + 4) = acc[ai][0][0][1]; }
            if (fr == 15) { LAS float* p = X + ((((ai * 2 + wr) * 4 + wc) * 2 + 1) * 4 + fq) * 8; *(LAS f32x4*)p = acc[ai][0][3][0]; *(LAS f32x4*)(p + 4) = acc[ai][0][3][1]; }
        }
        asm volatile("s_waitcnt lgkmcnt(0)" ::: "memory"); __builtin_amdgcn_s_barrier(); asm volatile("" ::: "memory");
        f32x4 w0[2], w1[2], w2[2], bb[2];
#pragma unroll
        for (int n = 0; n < 2; ++n) { w0[n] = *(const GAS f32x4*)(cw + c0 + 4 * n); w1[n] = *(const GAS f32x4*)(cw + DFF + c0 + 4 * n); w2[n] = *(const GAS f32x4*)(cw + 2 * DFF + c0 + 4 * n); bb[n] = *(const GAS f32x4*)(cbias + c0 + 4 * n); }
        const bool has_prev = ti.lat && ti.t0 > 0, has_next = ti.lat && ti.t0 < 4096 - 256;
#pragma unroll
        for (int ai = 0; ai < 2; ++ai) {
            f32x4 pb[2] = {(f32x4){0.f, 0.f, 0.f, 0.f}, (f32x4){0.f, 0.f, 0.f, 0.f}}, nb[2] = {(f32x4){0.f, 0.f, 0.f, 0.f}, (f32x4){0.f, 0.f, 0.f, 0.f}};
            { const int seg = ai * 2 + wr;
              if (seg > 0) { const int ps = seg - 1; LAS float* p = X + ((((ps >> 1) * 2 + (ps & 1)) * 4 + wc) * 2 + 1) * 32 + fq * 8; pb[0] = *(LAS f32x4*)p; pb[1] = *(LAS f32x4*)(p + 4); }
              if (seg < 3) { const int ns = seg + 1; LAS float* p = X + ((((ns >> 1) * 2 + (ns & 1)) * 4 + wc) * 2 + 0) * 32 + fq * 8; nb[0] = *(LAS f32x4*)p; nb[1] = *(LAS f32x4*)(p + 4); } }
#pragma unroll
            for (int m = 0; m < 4; ++m) {
                const int rt = ai * 128 + wr * 64 + m * 16 + fr; const size_t grow = (size_t)u.pm * 256 + rt;
                f32x4 fo[2], cv[2];
#pragma unroll
                for (int n = 0; n < 2; ++n) {
                    const f32x4 a = acc[ai][0][m][n];
                    const f32x4 up = (m > 0) ? acc[ai][0][m > 0 ? m - 1 : 0][n] : pb[n];
                    const f32x4 dn = (m < 3) ? acc[ai][0][m < 3 ? m + 1 : 3][n] : nb[n];
                    f32x4 pv, nx;
#pragma unroll
                    for (int e = 0; e < 4; ++e) {
                        pv[e] = dpp_ror1(fr == 15 ? up[e] : a[e]);
                        nx[e] = dpp_ror15(fr == 0 ? dn[e] : a[e]);
                    }
                    const f32x4 c = w0[n] * pv + w1[n] * a + w2[n] * nx + bb[n];
                    cv[n] = c;
                    const f32x4 uu = acc[ai][1][m][n];
#pragma unroll
                    for (int e = 0; e < 4; ++e) fo[n][e] = silu_f(c[e]) * uu[e];
                }
                u32x4 w; w.x = cvtpk(fo[0][0], fo[0][1]); w.y = cvtpk(fo[0][2], fo[0][3]); w.z = cvtpk(fo[1][0], fo[1][1]); w.w = cvtpk(fo[1][2], fo[1][3]);
                *(GAS u32x4*)(F + grow * DFF + c0) = w;
                if (ai == 0 && m == 0) { if (has_prev && rt == 0) { const size_t eo = ((size_t)u.pm * 2 + 0) * DFF + c0;
                        *(GAS f32x4*)(EP + eo) = cv[0]; *(GAS f32x4*)(EP + eo + 4) = cv[1]; *(GAS f32x4*)(EA + eo) = acc[0][0][0][0]; *(GAS f32x4*)(EA + eo + 4) = acc[0][0][0][1]; *(GAS f32x4*)(EU + eo) = acc[0][1][0][0]; *(GAS f32x4*)(EU + eo + 4) = acc[0][1][0][1]; } }
                if (ai == 1 && m == 3) { if (has_next && rt == 255) { const size_t eo = ((size_t)u.pm * 2 + 1) * DFF + c0;
                        *(GAS f32x4*)(EP + eo) = cv[0]; *(GAS f32x4*)(EP + eo + 4) = cv[1]; *(GAS f32x4*)(EA + eo) = acc[1][0][3][0]; *(GAS f32x4*)(EA + eo + 4) = acc[1][0][3][1]; *(GAS f32x4*)(EU + eo) = acc[1][1][3][0]; *(GAS f32x4*)(EU + eo + 4) = acc[1][1][3][1]; } }
            }
        }
        asm volatile("s_waitcnt lgkmcnt(0)" ::: "memory"); __builtin_amdgcn_s_barrier(); asm volatile("" ::: "memory");
    }
};

typedef short v4i16_t __attribute__((ext_vector_type(4)));
__device__ __forceinline__ s16x4 vtr(LAS const char* p) { return __builtin_bit_cast(s16x4, __builtin_amdgcn_ds_read_tr16_b64_v4i16((LAS v4i16_t*)p)); }
__device__ __forceinline__ float xhalf_max(float m) { auto rr = __builtin_amdgcn_permlane32_swap(__float_as_uint(m), __float_as_uint(m), false, false); return fmaxf(__uint_as_float(rr[0]), __uint_as_float(rr[1])); }
__device__ __forceinline__ float xhalf_sum(float m) { auto rr = __builtin_amdgcn_permlane32_swap(__float_as_uint(m), __float_as_uint(m), false, false); return __uint_as_float(rr[0]) + __uint_as_float(rr[1]); }

constexpr int ATT_VS = 192;
constexpr float ATT_THR = 8.f;
#define MX3(a, b, c) __builtin_fmaxf(__builtin_fmaxf((a), (b)), (c))
template <int DQK, bool YORD>
__device__ __forceinline__ void flash_pass(const bf16_t* __restrict__ Qw, int qpitch, const bf16_t* __restrict__ Kg, const bf16_t* __restrict__ Vg, int NT, int tst,
                                           LAS char* lds, f32x16 (&o)[2], float& lsum) {
#define ATT_TI(T) (((T) + tst) < NT ? ((T) + tst) : ((T) + tst - NT))
    constexpr int KS = DQK * 2 + 16, KBUF = 64 * KS, VBUF = 64 * ATT_VS, NDS = DQK / 16;
    constexpr int KROWB = DQK * 2;
    const int tid = opaque_tid(), lane = tid & 63, r32 = lane & 31, h = lane >> 5;
    LAS char* Kb = lds; LAS char* Vb = lds + 2 * KBUF;
    bf16x8 qf[NDS];
#pragma unroll
    for (int ds = 0; ds < NDS; ++ds) qf[ds] = *(const GAS bf16x8*)(Qw + (size_t)r32 * qpitch + 16 * ds + 8 * h);
    const bool kload = (tid * 16) < 64 * KROWB;
    const int krow = (tid * 16) / KROWB, kcb = (tid * 16) % KROWB;
    const int kdst = krow * KS + kcb, vdst = (tid >> 3) * ATT_VS + (tid & 7) * 16;
    const char* kg = (const char*)Kg + tid * 16; const char* vg = (const char*)Vg + tid * 16;
    u32x4 kreg = {0, 0, 0, 0}, vreg;
    {
        u32x4 k1 = {0, 0, 0, 0};
        if (kload) { kreg = *(const GAS u32x4*)(kg + (size_t)ATT_TI(0) * 64 * KROWB); k1 = *(const GAS u32x4*)(kg + (size_t)ATT_TI(1) * 64 * KROWB); }
        vreg = *(const GAS u32x4*)(vg + (size_t)ATT_TI(0) * 64 * 128);
        if (kload) { *(LAS u32x4*)(Kb + kdst) = kreg; *(LAS u32x4*)(Kb + KBUF + kdst) = k1; }
        *(LAS u32x4*)(Vb + vdst) = vreg;
        *(LAS u32x4*)(Vb + 2 * VBUF + vdst) = (u32x4){0, 0, 0, 0};
    }
    __syncthreads();
    const int kfo = r32 * KS + h * 16;
    const int vfo = (4 * h + ((lane & 15) >> 2)) * ATT_VS + (((lane >> 4) & 1) * 16 + (lane & 3) * 4) * 2;
    f32x16 p0 = (f32x16){}, p1 = (f32x16){};
#pragma unroll
    for (int ds = 0; ds < NDS; ++ds) {
        const bf16x8 k0 = *(LAS const bf16x8*)(Kb + kfo + ds * 32), k1 = *(LAS const bf16x8*)(Kb + kfo + 32 * KS + ds * 32);
        p0 = __builtin_amdgcn_mfma_f32_32x32x16_bf16(k0, qf[ds], p0, 0, 0, 0);
        p1 = __builtin_amdgcn_mfma_f32_32x32x16_bf16(k1, qf[ds], p1, 0, 0, 0);
    }
    __syncthreads();
    float mref, l = 0.f;
    {
        float a = MX3(p0[0], p0[1], p1[0]), b = MX3(p0[2], p0[3], p1[1]); a = MX3(a, p1[2], p1[3]);
#pragma unroll
        for (int r = 4; r < 16; r += 4) { a = MX3(a, p0[r], p0[r + 1]); b = MX3(b, p0[r + 2], p0[r + 3]); a = MX3(a, p1[r], p1[r + 1]); b = MX3(b, p1[r + 2], p1[r + 3]); }
        mref = xhalf_max(fmaxf(a, b));
#pragma unroll
        for (int r = 0; r < 16; ++r) { p0[r] -= mref; p1[r] -= mref; }
    }
    f32x16 negm;
#pragma unroll
    for (int r = 0; r < 16; ++r) negm[r] = -mref;
    asm volatile("" : "+v"(negm));
    o[0] = (f32x16){}; o[1] = (f32x16){};
    bf16x8 pk[4] = {};
    int vs_prev = 2 * VBUF, vs_cur = 0, vs_next = VBUF;
#define ATT_MPART(N0, N1, T) do { \
        LAS const char* kb_ = Kb + ((((T) + 1) & 1) * KBUF) + kfo; LAS const char* vb_ = Vb + vs_prev + vfo; \
        bf16x8 kf_[2 * NDS]; s16x4 vl_[8], vh_[8]; \
        _Pragma("unroll") for (int ds = 0; ds < NDS; ++ds) { kf_[2 * ds] = *(LAS const bf16x8*)(kb_ + ds * 32); kf_[2 * ds + 1] = *(LAS const bf16x8*)(kb_ + 32 * KS + ds * 32); } \
        _Pragma("unroll") for (int s_ = 0; s_ < 4; ++s_) { _Pragma("unroll") for (int db_ = 0; db_ < 2; ++db_) { \
            vl_[2 * s_ + db_] = vtr(vb_ + (16 * s_) * ATT_VS + db_ * 64); vh_[2 * s_ + db_] = vtr(vb_ + (16 * s_ + 8) * ATT_VS + db_ * 64); } } \
        N0 = __builtin_amdgcn_mfma_f32_32x32x16_bf16(kf_[0], qf[0], negm, 0, 0, 0); N1 = __builtin_amdgcn_mfma_f32_32x32x16_bf16(kf_[1], qf[0], negm, 0, 0, 0); \
        _Pragma("unroll") for (int ds = 1; ds < NDS; ++ds) { \
            N0 = __builtin_amdgcn_mfma_f32_32x32x16_bf16(kf_[2 * ds], qf[ds], N0, 0, 0, 0); N1 = __builtin_amdgcn_mfma_f32_32x32x16_bf16(kf_[2 * ds + 1], qf[ds], N1, 0, 0, 0); } \
        _Pragma("unroll") for (int s_ = 0; s_ < 4; ++s_) { _Pragma("unroll") for (int db_ = 0; db_ < 2; ++db_) { \
            const bf16x8 vf_ = __builtin_shufflevector(vl_[2 * s_ + db_], vh_[2 * s_ + db_], 0, 1, 2, 3, 4, 5, 6, 7); \
            o[db_] = __builtin_amdgcn_mfma_f32_32x32x16_bf16(vf_, pk[s_], o[db_], 0, 0, 0); } } \
        __builtin_amdgcn_sched_group_barrier(0x100, 2 * NDS + 8, 0); __builtin_amdgcn_sched_group_barrier(0x008, 2 * NDS, 0); \
        __builtin_amdgcn_sched_group_barrier(0x100, 8, 0); __builtin_amdgcn_sched_group_barrier(0x008, 8, 0); } while (0)
#define ATT_VPART(P0, P1, N0, N1) do { \
        float a = MX3(P0[0], P0[1], P1[0]), b = MX3(P0[2], P0[3], P1[1]); a = MX3(a, P1[2], P1[3]); \
        _Pragma("unroll") for (int r = 4; r < 16; r += 4) { a = MX3(a, P0[r], P0[r + 1]); b = MX3(b, P0[r + 2], P0[r + 3]); a = MX3(a, P1[r], P1[r + 1]); b = MX3(b, P1[r + 2], P1[r + 3]); } \
        const float mt = xhalf_max(fmaxf(a, b)); \
        resc = __any(mt > ATT_THR); \
        if (__builtin_expect(resc, 0)) { \
            const float dl = fmaxf(mt, 0.f); mref += dl; fsc = __builtin_amdgcn_exp2f(-dl); l *= fsc; \
            _Pragma("unroll") for (int r = 0; r < 16; ++r) { P0[r] -= dl; P1[r] -= dl; } \
            if (!YORD) { _Pragma("unroll") for (int r = 0; r < 16; ++r) { N0[r] -= dl; N1[r] -= dl; o[0][r] *= fsc; o[1][r] *= fsc; } } \
            _Pragma("unroll") for (int r = 0; r < 16; ++r) negm[r] = -mref; \
            asm volatile("" : "+v"(negm)); } \
        float ps0 = 0.f, ps1 = 0.f; \
        _Pragma("unroll") for (int r = 0; r < 16; ++r) { P0[r] = __builtin_amdgcn_exp2f(P0[r]); P1[r] = __builtin_amdgcn_exp2f(P1[r]); ps0 += P0[r]; ps1 += P1[r]; } \
        l += ps0 + ps1; \
        _Pragma("unroll") for (int s = 0; s < 2; ++s) { u32x4 a4, b4; \
            a4.x = cvtpk(P0[8 * s + 0], P0[8 * s + 1]); a4.y = cvtpk(P0[8 * s + 2], P0[8 * s + 3]); a4.z = cvtpk(P0[8 * s + 4], P0[8 * s + 5]); a4.w = cvtpk(P0[8 * s + 6], P0[8 * s + 7]); \
            b4.x = cvtpk(P1[8 * s + 0], P1[8 * s + 1]); b4.y = cvtpk(P1[8 * s + 2], P1[8 * s + 3]); b4.z = cvtpk(P1[8 * s + 4], P1[8 * s + 5]); b4.w = cvtpk(P1[8 * s + 6], P1[8 * s + 7]); \
            pkn[s] = __builtin_bit_cast(bf16x8, a4); pkn[2 + s] = __builtin_bit_cast(bf16x8, b4); } } while (0)
#define ATT_STEP(P0, P1, N0, N1, T) do { \
        const bool more = (T) + 1 < NT, more2 = (T) + 2 < NT; \
        if (more2 && kload) kreg = *(const GAS u32x4*)(kg + (size_t)ATT_TI((T) + 2) * 64 * KROWB); \
        if (more) vreg = *(const GAS u32x4*)(vg + (size_t)ATT_TI((T) + 1) * 64 * 128); \
        float fsc = 1.f; bool resc; bf16x8 pkn[4]; \
        if (!YORD) { ATT_MPART(N0, N1, T); __builtin_amdgcn_sched_barrier(0); ATT_VPART(P0, P1, N0, N1); } \
        else { ATT_VPART(P0, P1, N0, N1); __builtin_amdgcn_sched_barrier(0); ATT_MPART(N0, N1, T); \
            if (__builtin_expect(resc, 0)) { _Pragma("unroll") for (int r = 0; r < 16; ++r) { o[0][r] *= fsc; o[1][r] *= fsc; } } } \
        _Pragma("unroll") for (int s = 0; s < 4; ++s) pk[s] = pkn[s]; \
        if (more2 && kload) *(LAS u32x4*)(Kb + ((T) & 1) * KBUF + kdst) = kreg; \
        if (more) *(LAS u32x4*)(Vb + vs_next + vdst) = vreg; \
        __syncthreads(); \
        vs_prev = vs_cur; vs_cur = vs_next; vs_next = (vs_next == 2 * VBUF) ? 0 : vs_next + VBUF; } while (0)
    f32x16 n0, n1;
    for (int t = 0; t < NT; t += 2) {
        ATT_STEP(p0, p1, n0, n1, t);
        ATT_STEP(n0, n1, p0, p1, t + 1);
    }
    {
        LAS const char* vb_ = Vb + vs_prev + vfo;
#pragma unroll
        for (int s_ = 0; s_ < 4; ++s_) {
#pragma unroll
            for (int db_ = 0; db_ < 2; ++db_) {
                const s16x4 lo_ = vtr(vb_ + (16 * s_) * ATT_VS + db_ * 64), hi_ = vtr(vb_ + (16 * s_ + 8) * ATT_VS + db_ * 64);
                const bf16x8 vf_ = __builtin_shufflevector(lo_, hi_, 0, 1, 2, 3, 4, 5, 6, 7);
                o[db_] = __builtin_amdgcn_mfma_f32_32x32x16_bf16(vf_, pk[s_], o[db_], 0, 0, 0);
            }
        }
    }
    __syncthreads();
#undef ATT_STEP
#undef ATT_TI
#undef ATT_VPART
#undef ATT_MPART
    lsum = xhalf_sum(l);
}

__device__ __forceinline__ void store_ot(const f32x16 (&o)[2], bf16_t* dst  , int h) {
#pragma unroll
    for (int db = 0; db < 2; ++db)
#pragma unroll
        for (int g = 0; g < 4; ++g) { u32x2 w; w.x = cvtpk(o[db][4 * g], o[db][4 * g + 1]); w.y = cvtpk(o[db][4 * g + 2], o[db][4 * g + 3]); *(GAS u32x2*)(dst + 32 * db + 8 * g + 4 * h) = w; }
}

#include <hip/hip_bf16.h>
namespace attn64 {
using bf16=__hip_bfloat16;
using bf16x8=__attribute__((ext_vector_type(8)))short;
using s16x4=__attribute__((ext_vector_type(4)))short;
using f32x16=__attribute__((ext_vector_type(16)))float;
using u32x4=__attribute__((ext_vector_type(4)))unsigned;
constexpr int D=64;
constexpr int NW=8,QBLK=32,QB=QBLK*NW,KVBLK=64;

__device__ __forceinline__ int crow(int r,int hi){return (r&3)+8*(r>>2)+4*hi;}
#define SBAR() __builtin_amdgcn_sched_barrier(0)
__device__ __forceinline__ void cmask(f32x16&p0,f32x16&p1,int jb,int qrel,int hi){
  const float NEG=-INFINITY; int kb=64*jb+4*hi;
  #pragma unroll
  for(int r=0;r<16;++r){int kv=kb+(r&3)+8*(r>>2); if(kv>qrel)p0[r]=NEG; if(kv+32>qrel)p1[r]=NEG;}
}

constexpr int NSLOT=3, SLOTB=8192;
constexpr int LDS_K=0, LDS_V=NSLOT*SLOTB, LDS_WS=2*NSLOT*SLOTB, LDS_OST=LDS_WS+NW*64*4, LDS_BYTES=LDS_OST+NW*4096;
constexpr float C2=0.125f*1.4426950408889634f;
__device__ __forceinline__ void glds16(const void*gsrc,unsigned lds_dst){unsigned keep;
  asm volatile("s_mov_b32 %0, m0\n\ts_mov_b32 m0, %2\n\ts_nop 0\n\tglobal_load_lds_dwordx4 %1, off\n\ts_mov_b32 m0, %0":"=&s"(keep):"v"(gsrc),"s"(lds_dst):"memory");}
__device__ __forceinline__ float max3f(float a,float b,float c){float r;asm("v_max3_f32 %0, %1, %2, %3":"=v"(r):"v"(a),"v"(b),"v"(c));return r;}
__device__ __forceinline__ float max2f(float a,float b){float r;asm("v_max_f32_e32 %0, %1, %2":"=v"(r):"v"(a),"v"(b));return r;}
__device__ __forceinline__ float fadd_s(float a,float b){float r;asm("v_add_f32_e32 %0, %1, %2":"=v"(r):"v"(a),"v"(b));return r;}
__device__ __forceinline__ float fsub_s(float a,float b){float r;asm("v_sub_f32_e32 %0, %1, %2":"=v"(r):"v"(a),"v"(b));return r;}
typedef float f32x2_t __attribute__((ext_vector_type(2))); typedef __bf16 bf16x2_t __attribute__((ext_vector_type(2)));
__device__ __forceinline__ unsigned cvtpk_s(float lo,float hi){f32x2_t v={lo,hi};bf16x2_t b=__builtin_convertvector(v,bf16x2_t);return __builtin_bit_cast(unsigned,b);}
#define WAIT_BAR(N) asm volatile("s_waitcnt vmcnt(" #N ") lgkmcnt(0)\n\ts_barrier":::"memory")

template<int NDS_> __device__ __forceinline__ void qkt(f32x16&p0,f32x16&p1,const char*Kslot,const bf16x8*qr,const f32x16&negm,int r32,int hi){
  const char*kb=Kslot+hi*1024+r32*16;
  #pragma unroll
  for(int d0=0;d0<NDS_;++d0){
    const bf16x8 b0=*reinterpret_cast<const bf16x8*>(kb+d0*2048);
    const bf16x8 b1=*reinterpret_cast<const bf16x8*>(kb+d0*2048+512);
    if(d0==0){p0=__builtin_amdgcn_mfma_f32_32x32x16_bf16(b0,qr[0],negm,0,0,0);p1=__builtin_amdgcn_mfma_f32_32x32x16_bf16(b1,qr[0],negm,0,0,0);}
    else{p0=__builtin_amdgcn_mfma_f32_32x32x16_bf16(b0,qr[d0],p0,0,0,0);p1=__builtin_amdgcn_mfma_f32_32x32x16_bf16(b1,qr[d0],p1,0,0,0);}}
}
typedef __attribute__((address_space(3))) const char* lds_cptr;
typedef short v4i16_t __attribute__((ext_vector_type(4)));
__device__ __forceinline__ void kload8(bf16x8*kf,lds_cptr kp){
  kf[0]=*(const __attribute__((address_space(3))) bf16x8*)(kp);      kf[1]=*(const __attribute__((address_space(3))) bf16x8*)(kp+512);
  kf[2]=*(const __attribute__((address_space(3))) bf16x8*)(kp+2048); kf[3]=*(const __attribute__((address_space(3))) bf16x8*)(kp+2560);
  kf[4]=*(const __attribute__((address_space(3))) bf16x8*)(kp+4096); kf[5]=*(const __attribute__((address_space(3))) bf16x8*)(kp+4608);
  kf[6]=*(const __attribute__((address_space(3))) bf16x8*)(kp+6144); kf[7]=*(const __attribute__((address_space(3))) bf16x8*)(kp+6656);
}
__device__ __forceinline__ void kload2(bf16x8*kf,lds_cptr kp,int j){ kf[2*j]=*(const __attribute__((address_space(3))) bf16x8*)(kp+j*2048); kf[2*j+1]=*(const __attribute__((address_space(3))) bf16x8*)(kp+j*2048+512); }
__device__ __forceinline__ s16x4 vtr(lds_cptr p){ return __builtin_bit_cast(s16x4,__builtin_amdgcn_ds_read_tr16_b64_v4i16((__attribute__((address_space(3))) v4i16_t*)p)); }
__device__ __forceinline__ float rowmax(const f32x16&p0,const f32x16&p1){
  float a=max3f(p0[0],p0[1],p1[0]),b=max3f(p0[2],p0[3],p1[1]);a=max3f(a,p1[2],p1[3]);
  #pragma unroll
  for(int r=4;r<16;r+=4){a=max3f(a,p0[r],p0[r+1]);b=max3f(b,p0[r+2],p0[r+3]);a=max3f(a,p1[r],p1[r+1]);b=max3f(b,p1[r+2],p1[r+3]);}
  const float m=max2f(a,b);
  auto rr=__builtin_amdgcn_permlane32_swap(__float_as_uint(m),__float_as_uint(m),false,false);
  return max2f(__uint_as_float(rr[0]),__uint_as_float(rr[1]));
}
__device__ __forceinline__ void pv(f32x16*o,int vb,bf16x8 pa0,bf16x8 pa1,bf16x8 pa2,bf16x8 pa3){
  #pragma unroll
  for(int d0=0;d0<2;++d0){s16x4 lo[4],hi[4];
    #pragma unroll
    for(int ks=0;ks<4;++ks){
      asm volatile("ds_read_b64_tr_b16 %0,%1 offset:%c2":"=&v"(lo[ks]):"v"(vb),"i"(d0*4096+ks*1024):"memory");
      asm volatile("ds_read_b64_tr_b16 %0,%1 offset:%c2":"=&v"(hi[ks]):"v"(vb),"i"(d0*4096+ks*1024+512):"memory");}
    asm volatile("s_waitcnt lgkmcnt(0)":::"memory");SBAR();
    #define PK(k) (bf16x8){lo[k][0],lo[k][1],lo[k][2],lo[k][3],hi[k][0],hi[k][1],hi[k][2],hi[k][3]}
    o[d0]=__builtin_amdgcn_mfma_f32_32x32x16_bf16(pa0,PK(0),o[d0],0,0,0);
    o[d0]=__builtin_amdgcn_mfma_f32_32x32x16_bf16(pa1,PK(1),o[d0],0,0,0);
    o[d0]=__builtin_amdgcn_mfma_f32_32x32x16_bf16(pa2,PK(2),o[d0],0,0,0);
    o[d0]=__builtin_amdgcn_mfma_f32_32x32x16_bf16(pa3,PK(3),o[d0],0,0,0);
    #undef PK
  }
}

#ifndef ATTN_STORE16
#define ATTN_STORE16(p,v) (*(GAS u32x4*)(p)=(v))
#endif
__device__ __forceinline__ void stage_store(const f32x16 (&o)[2],bf16*Ow,int op,char*shm,int wid,int lane,int r32,int hi){
  bf16*stg=(bf16*)(shm+LDS_OST)+wid*2048;
  #pragma unroll
  for(int r=0;r<16;++r){const int orow=crow(r,hi);
    #pragma unroll
    for(int d0=0;d0<2;++d0)stg[orow*64+d0*32+r32]=__float2bfloat16(o[d0][r]);}
  asm volatile("s_waitcnt lgkmcnt(0)":::"memory");
  #pragma unroll
  for(int i=0;i<4;++i){const int row=i*8+(lane>>3),ch=lane&7; const u32x4 v=*(const u32x4*)(stg+row*64+ch*8); ATTN_STORE16(Ow+(long)row*op+ch*8,v);}
}
template<int THRL,int MODE,int DQ> __device__ __forceinline__ void attn_unit(const bf16*Qw0,int qp,const bf16*__restrict__ Kh,int kp,const bf16*__restrict__ Vh,int vp,int NT,bf16*Ow0,int op,char*shm,f32x16 (&oret)[2]){
  constexpr int NDS=DQ/16;
  const int tid=opaque_tid(),lane=tid&63,r32=lane&31,hi=lane>>5; const int wid=__builtin_amdgcn_readfirstlane(tid>>6);
  const bf16*Qw=Qw0+(long)(wid*QBLK)*qp;
  const unsigned lds0=(unsigned)(uintptr_t)shm;
  float*wsf=(float*)(shm+LDS_WS)+wid*64;
  const int kch=(DQ==64)?wid:(wid&3);
  const bf16*ksrc=Kh+(long)lane*kp+kch*8;
  const bf16*vsrc=Vh+(long)(16*(wid&3)+(lane>>2))*vp+(wid>>2)*32+(lane&3)*8;
  const unsigned kdst=lds0+LDS_K+kch*1024, vdst=lds0+LDS_V+wid*1024;
  #define DMA_K(t,slot) glds16(ksrc+(long)(t)*KVBLK*kp,(unsigned)__builtin_amdgcn_readfirstlane(kdst+(slot)))
  #define DMA_V(t,slot) glds16(vsrc+(long)(t)*KVBLK*vp,(unsigned)__builtin_amdgcn_readfirstlane(vdst+(slot)))
  const int vb0=(int)(lds0+LDS_V)+((lane>>4)&1)*32+(lane&3)*8+(4*hi+((lane&15)>>2))*64;
  const char*Kbase=shm+LDS_K; bf16x8 kf[8];
  const lds_cptr shm3=(lds_cptr)shm; const lds_cptr kp0=shm3+LDS_K+hi*1024+r32*16; const lds_cptr vp0=shm3+LDS_V+((lane>>4)&1)*32+(lane&3)*8+(4*hi+((lane&15)>>2))*64;
  DMA_K(0,0);DMA_V(0,0);DMA_K(1,SLOTB);
  bf16x8 qr[4];
  #pragma unroll
  for(int d0=0;d0<NDS;++d0)qr[d0]=*(const GAS bf16x8*)(&Qw[(long)r32*qp+d0*16+hi*8]);
  float mhat=0.f,l_reg=0.f;f32x16 o[2];o[0]=f32x16{};o[1]=f32x16{};f32x16 negm=f32x16{};asm volatile("":"+v"(negm));
  #define CMASK(P0,P1,t) do{}while(0)
  bool resc=false;
  #define START(P0,P1) do{ const float rm=rowmax(P0,P1); resc=false; \
    { const float dl=rm; mhat=fadd_s(mhat,dl); \
      _Pragma("unroll") for(int r=0;r<16;++r){P0[r]=fsub_s(P0[r],dl);P1[r]=fsub_s(P1[r],dl);} \
      _Pragma("unroll") for(int r=0;r<16;++r)negm[r]=-mhat; asm volatile("":"+v"(negm)); } \
    _Pragma("unroll") for(int r=0;r<16;++r)P0[r]=__builtin_amdgcn_exp2f(P0[r]); }while(0)
  #define RESC() do{ if(resc){ asm volatile("s_waitcnt lgkmcnt(0)":::"memory"); \
      _Pragma("unroll") for(int d_=0;d_<2;++d_) _Pragma("unroll") for(int r=0;r<16;++r)o[d_][r]*=wsf[crow(r,hi)]; } }while(0)
  f32x16 pA0,pA1,pB0,pB1;
  int sl_prev=0,sl_cur=0,sl_next=SLOTB;
  #define ROT() do{sl_prev=sl_cur;sl_cur=sl_next;sl_next=(sl_next==(NSLOT-1)*SLOTB)?0:sl_next+SLOTB;}while(0)
  DMA_K(2,2*SLOTB);
  WAIT_BAR(3);
  qkt<NDS>(pA0,pA1,Kbase,qr,negm,r32,hi);asm volatile("s_nop 15\n\ts_nop 7":"+v"(pA0),"+v"(pA1));CMASK(pA0,pA1,0);
  START(pA0,pA1);
  _Pragma("unroll") for(int r=0;r<16;++r)pA1[r]=__builtin_amdgcn_exp2f(pA1[r]);
  WAIT_BAR(0);
  DMA_K(3,0);DMA_V(1,SLOTB);
  ROT();
  if constexpr(DQ==64) kload8(kf,kp0+sl_cur); else { kload2(kf,kp0+sl_cur,0); kload2(kf,kp0+sl_cur,1); }
  WAIT_BAR(2);
  s16x4 vlo[8],vhi[8]; u32x4 pw0,pw1,pw2,pw3;
  #define PKW(P,B) cvtpk_s(P[B],P[B+1])
  #define PAF(k) __builtin_bit_cast(bf16x8,pw##k)
  #define VFR(i) (bf16x8){vlo[i][0],vlo[i][1],vlo[i][2],vlo[i][3],vhi[i][0],vhi[i][1],vhi[i][2],vhi[i][3]}
  #define PIN(x) asm volatile("":"+v"(x))
  #define MX3(a,b,c) __builtin_fmaxf(__builtin_fmaxf((a),(b)),(c))
  #define GAPA(MF,A0,A1,A2,A3,W0,W1,PW) do{ MF; sacc+=A0; sacc+=A1; sacc+=A2; sacc+=A3; PIN(sacc); W0; W1; PIN(PW); SBAR(); }while(0)
  #define EX(v) __builtin_amdgcn_exp2f(v)
  #define GAPB(MF,X,B) do{ MF; X[B]=EX(X[B]); X[B+1]=EX(X[B+1]); X[B+2]=EX(X[B+2]); X[B+3]=EX(X[B+3]); PIN(X); SBAR(); }while(0)
  #define VRD(i) do{ vlo[i]=vtr(vp_+(((i)>>2)*4096+((i)&3)*1024)); vhi[i]=vtr(vp_+(((i)>>2)*4096+((i)&3)*1024+512)); }while(0)
  #define KRD(G,j) do{ if(G){ kload2(kf,kp0+sl_next,j); SBAR(); } }while(0)
  #define STEP(C0,C1,P0,P1,t,GK,GV,GL) do{ SBAR(); \
    const lds_cptr vp_=vp0+sl_prev; \
    VRD(0); SBAR(); float sacc=(P0[0]+P0[1]); \
    GAPA(C0=__builtin_amdgcn_mfma_f32_32x32x16_bf16(kf[0],qr[0],negm,0,0,0), P0[2],P0[3],P0[4],P0[5],     pw0[0]=PKW(P0,0), pw0[1]=PKW(P0,2), pw0); \
    VRD(4); SBAR(); GAPA(C1=__builtin_amdgcn_mfma_f32_32x32x16_bf16(kf[1],qr[0],negm,0,0,0), P0[6],P0[7],P0[8],P0[9],     pw0[2]=PKW(P0,4), pw0[3]=PKW(P0,6), pw0); \
    VRD(1); SBAR(); GAPA(C0=__builtin_amdgcn_mfma_f32_32x32x16_bf16(kf[2],qr[1],C0,0,0,0),   P0[10],P0[11],P0[12],P0[13], pw1[0]=PKW(P0,8), pw1[1]=PKW(P0,10), pw1); \
    VRD(5); SBAR(); GAPA(C1=__builtin_amdgcn_mfma_f32_32x32x16_bf16(kf[3],qr[1],C1,0,0,0),   P0[14],P0[15],P1[0],P1[1],   pw1[2]=PKW(P0,12),pw1[3]=PKW(P0,14), pw1); \
    VRD(2); SBAR(); GAPA(if constexpr(DQ==64) C0=__builtin_amdgcn_mfma_f32_32x32x16_bf16(kf[4],qr[2],C0,0,0,0),   P1[2],P1[3],P1[4],P1[5],     pw2[0]=PKW(P1,0), pw2[1]=PKW(P1,2), pw2); \
    VRD(6); SBAR(); GAPA(if constexpr(DQ==64) C1=__builtin_amdgcn_mfma_f32_32x32x16_bf16(kf[5],qr[2],C1,0,0,0),   P1[6],P1[7],P1[8],P1[9],     pw2[2]=PKW(P1,4), pw2[3]=PKW(P1,6), pw2); \
    VRD(3); SBAR(); GAPA(if constexpr(DQ==64) C0=__builtin_amdgcn_mfma_f32_32x32x16_bf16(kf[6],qr[3],C0,0,0,0),   P1[10],P1[11],P1[12],P1[13], pw3[0]=PKW(P1,8), pw3[1]=PKW(P1,10), pw3); \
    VRD(7); SBAR(); GAPA(if constexpr(DQ==64) C1=__builtin_amdgcn_mfma_f32_32x32x16_bf16(kf[7],qr[3],C1,0,0,0),   P1[14],P1[15],0.f,0.f,       pw3[2]=PKW(P1,12),pw3[3]=PKW(P1,14), pw3); \
    l_reg+=sacc; \
    if(GK){DMA_K((t)+3,sl_cur);} if(GV){DMA_V((t)+1,sl_next);} \
    CMASK(C0,C1,t); \
    { float a=MX3(C0[0],C0[1],C1[0]),b=MX3(C0[2],C0[3],C1[1]); a=MX3(a,C1[2],C1[3]); \
      _Pragma("unroll") for(int r=4;r<16;r+=4){a=MX3(a,C0[r],C0[r+1]);b=MX3(b,C0[r+2],C0[r+3]);a=MX3(a,C1[r],C1[r+1]);b=MX3(b,C1[r+2],C1[r+3]);} \
      float rm=__builtin_fmaxf(a,b); { auto rr=__builtin_amdgcn_permlane32_swap(__float_as_uint(rm),__float_as_uint(rm),false,false); rm=__builtin_fmaxf(__uint_as_float(rr[0]),__uint_as_float(rr[1])); } \
      resc=false; \
      if(__builtin_expect(__any(rm>(float)THRL),0)){ const float dl=__builtin_fmaxf(rm,0.f); mhat+=dl; \
        _Pragma("unroll") for(int r=0;r<16;++r){C0[r]-=dl;C1[r]-=dl;} \
        _Pragma("unroll") for(int r=0;r<16;++r)negm[r]=-mhat; asm volatile("":"+v"(negm)); \
        const float f=__builtin_amdgcn_exp2f(-dl); l_reg*=f; if(hi==0)wsf[r32]=f; resc=true; } } \
    SBAR(); \
    GAPB(o[0]=__builtin_amdgcn_mfma_f32_32x32x16_bf16(PAF(0),VFR(0),o[0],0,0,0), C0,0); \
    GAPB(o[1]=__builtin_amdgcn_mfma_f32_32x32x16_bf16(PAF(0),VFR(4),o[1],0,0,0), C0,4); \
    KRD(GL,0); GAPB(o[0]=__builtin_amdgcn_mfma_f32_32x32x16_bf16(PAF(1),VFR(1),o[0],0,0,0), C0,8); \
    KRD(GL,1); GAPB(o[1]=__builtin_amdgcn_mfma_f32_32x32x16_bf16(PAF(1),VFR(5),o[1],0,0,0), C0,12); \
    if constexpr(DQ==64) KRD(GL,2); GAPB(o[0]=__builtin_amdgcn_mfma_f32_32x32x16_bf16(PAF(2),VFR(2),o[0],0,0,0), C1,0); \
    if constexpr(DQ==64) KRD(GL,3); GAPB(o[1]=__builtin_amdgcn_mfma_f32_32x32x16_bf16(PAF(2),VFR(6),o[1],0,0,0), C1,4); \
    GAPB(o[0]=__builtin_amdgcn_mfma_f32_32x32x16_bf16(PAF(3),VFR(3),o[0],0,0,0), C1,8); \
    GAPB(o[1]=__builtin_amdgcn_mfma_f32_32x32x16_bf16(PAF(3),VFR(7),o[1],0,0,0), C1,12); \
    }while(0)
  int t=1;
  #undef CMASK
  #define CMASK(P0,P1,t) do{}while(0)
  for(;t+5<NT;t+=2){
    STEP(pB0,pB1,pA0,pA1,t,true,true,true);     WAIT_BAR(2); RESC(); ROT();
    STEP(pA0,pA1,pB0,pB1,t+1,true,true,true);   WAIT_BAR(2); RESC(); ROT();
  }
  #undef CMASK
  #define CMASK(P0,P1,t) do{}while(0)
  #define ENDW(tt) do{ if((tt)+3<NT){WAIT_BAR(2);} else if((tt)+2<NT){WAIT_BAR(1);} else {WAIT_BAR(0);} }while(0)
  for(;t+1<NT;t+=2){
    STEP(pB0,pB1,pA0,pA1,t,(t+3<NT),(t+1<NT),(t+1<NT));       ENDW(t);   RESC(); ROT();
    STEP(pA0,pA1,pB0,pB1,t+1,(t+4<NT),(t+2<NT),(t+2<NT));     ENDW(t+1); RESC(); ROT();
  }
  STEP(pB0,pB1,pA0,pA1,NT-1,false,false,false); RESC();
  { float sacc=pB0[0]+pB0[1]; _Pragma("unroll") for(int r=2;r<16;++r)sacc+=pB0[r]; _Pragma("unroll") for(int r=0;r<16;++r)sacc+=pB1[r]; l_reg+=sacc;
    pw0=(u32x4){PKW(pB0,0),PKW(pB0,2),PKW(pB0,4),PKW(pB0,6)};pw1=(u32x4){PKW(pB0,8),PKW(pB0,10),PKW(pB0,12),PKW(pB0,14)};pw2=(u32x4){PKW(pB1,0),PKW(pB1,2),PKW(pB1,4),PKW(pB1,6)};pw3=(u32x4){PKW(pB1,8),PKW(pB1,10),PKW(pB1,12),PKW(pB1,14)};
    SBAR(); pv(o,vb0+sl_cur,PAF(0),PAF(1),PAF(2),PAF(3)); }
  #undef PKW
  #undef PAF
  #undef VFR
  #undef PIN
  #undef MX3
  #undef GAPA
  #undef GAPB
  #undef EX
  #undef VRD
  #undef KRD
  #undef STEP
  #undef ENDW
  {auto rr=__builtin_amdgcn_permlane32_swap(__float_as_uint(l_reg),__float_as_uint(l_reg),false,false);l_reg=__uint_as_float(rr[0])+__uint_as_float(rr[1]);}
  if(hi==0)wsf[32+r32]=l_reg;asm volatile("s_waitcnt lgkmcnt(0)":::"memory");
  float rli[16];
  #pragma unroll
  for(int r=0;r<16;++r)rli[r]=__builtin_amdgcn_rcpf(wsf[32+crow(r,hi)]);
  #pragma unroll
  for(int r=0;r<16;++r){o[0][r]*=rli[r];o[1][r]*=rli[r];}
  if constexpr(MODE==0){ bf16*Ow=Ow0+(long)(wid*QBLK)*op; stage_store(o,Ow,op,shm,wid,lane,r32,hi); }
  else { oret[0]=o[0]; oret[1]=o[1]; }
  asm volatile("s_waitcnt lgkmcnt(0)\n\ts_barrier":::"memory");
  #undef DMA_K
  #undef DMA_V
  #undef CMASK
  #undef START
  #undef RESC
  #undef ROT
}
#undef SBAR
#undef WAIT_BAR
}

struct AttnArgs { const bf16_t *QG, *QD, *KG, *VG, *KD, *VD, *CB, *PB; bf16_t* MIX; const float* conv_w; const float* conv_b; const float* subln_g; float lam, lam_init; float* dscr; };

__device__ __forceinline__ void attn_gqa_unit(const AttnArgs& A, LAS char* lds, char* lds_generic, int lat, int seq, int qh, int qb) {
    const long R = lat ? 8192L + (long)SLAT * seq : 256L * seq; const int S = lat ? SLAT : 256;
    const size_t grow0 = (lat ? 8192 + (size_t)4096 * seq : (size_t)256 * seq) + 256 * qb;
    const int kvh = qh >> 2;
    int NT = S / 64; asm volatile("" : "+s"(NT));
    typedef attn64::bf16 abf;
    f32x16 dummy[2];
    attn64::attn_unit<8, 0, 64>((const abf*)(A.QG + grow0 * 512 + 64 * qh), 512, (const abf*)(A.KG + (R * 2 + (long)kvh * S) * 64), 64, (const abf*)(A.VG + (R * 2 + (long)kvh * S) * 64), 64, NT,
                                (abf*)(A.MIX + grow0 * 1024 + 64 * qh), 1024, lds_generic, dummy);
}
__device__ __forceinline__ void attn_diff_unit(const AttnArgs& A, LAS char* lds, char* lds_generic, int lat, int seq, int hd, int qb) {
    const int tid_ = opaque_tid(); const int wave = __builtin_amdgcn_readfirstlane(tid_ >> 6), lane = tid_ & 63, r32 = lane & 31, h = lane >> 5;
    const long R = lat ? 8192L + (long)SLAT * seq : 256L * seq; const int S = lat ? SLAT : 256;
    const size_t grow0 = (lat ? 8192 + (size_t)4096 * seq : (size_t)256 * seq) + 256 * qb;
    int NT = S / 64; asm volatile("" : "+s"(NT));
    typedef attn64::bf16 abf;
    const abf* V = (const abf*)(A.VD + (R * 4 + (long)hd * S) * 64);
    f32x16 oa[2], ob[2];
    attn64::attn_unit<8, 1, 32>((const abf*)(A.QD + grow0 * 256 + 64 * hd), 256, (const abf*)(A.KD + (R * 8 + (long)(hd * 2) * S) * 32), 32, V, 64, NT, (abf*)nullptr, 0, lds_generic, oa);
    GAS float* scr = (GAS float*)A.dscr + ((size_t)(blockIdx.x * 8 + wave) * 32) * 64 + lane;
#pragma unroll
    for (int d0 = 0; d0 < 2; ++d0)
#pragma unroll
        for (int r = 0; r < 16; ++r) scr[(d0 * 16 + r) * 64] = oa[d0][r];
    attn64::attn_unit<8, 1, 32>((const abf*)(A.QD + grow0 * 256 + 64 * hd + 32), 256, (const abf*)(A.KD + (R * 8 + (long)(hd * 2 + 1) * S) * 32), 32, V, 64, NT, (abf*)nullptr, 0, lds_generic, ob);
    float ss[16];
#pragma unroll
    for (int r = 0; r < 16; ++r) {
        const float v0 = scr[r * 64] - A.lam * ob[0][r], v1 = scr[(16 + r) * 64] - A.lam * ob[1][r];
        ob[0][r] = v0; ob[1][r] = v1; ss[r] = v0 * v0 + v1 * v1;
    }
#pragma unroll
    for (int o = 1; o < 32; o <<= 1)
#pragma unroll
        for (int r = 0; r < 16; ++r) ss[r] += __shfl_xor(ss[r], o);
    const float g0 = A.subln_g[r32], g1 = A.subln_g[32 + r32], sc = 1.f - A.lam_init;
#pragma unroll
    for (int r = 0; r < 16; ++r) { const float rstd = rsqrtf(ss[r] * (1.f / 64.f) + EPS) * sc; ob[0][r] *= rstd * g0; ob[1][r] *= rstd * g1; }
    attn64::stage_store(ob, (abf*)(A.MIX + (grow0 + 32 * wave) * 1024 + 768 + 64 * hd), 1024, lds_generic, wave, lane, r32, h);
}

__device__ __forceinline__ void attn_phase(const AttnArgs& A, LAS char* lds, char* lds_generic, int G) {
    for (int u = blockIdx.x; u < 1920; u += G) {
        if (u < 512) { const int b = u & 7, r = u >> 3; attn_diff_unit(A, lds, lds_generic, 1, b, r >> 4, r & 15); }
        else if (u < 1536) { const int v = u - 512, b = v & 7, r = v >> 3; attn_gqa_unit(A, lds, lds_generic, 1, b, r & 7, r >> 3); }
        else if (u < 1664) { const int w = u - 1536; attn_diff_unit(A, lds, lds_generic, 0, w >> 2, w & 3, 0); }
        else { const int w = u - 1664; attn_gqa_unit(A, lds, lds_generic, 0, w >> 3, w & 7, 0); }
    }
    const int tid_c = opaque_tid();
    for (int idx = blockIdx.x * 512 + tid_c; idx < M_ALL * 32; idx += G * 512) {
        const int row = idx >> 5, c8 = (idx & 31) * 8;
        int t, S; if (row < M_CTX) { t = row & 255; S = 256; } else { t = (row - M_CTX) & 4095; S = 4096; }
        const u32x4 z = {0, 0, 0, 0};
        const u32x4 pc = *(const GAS u32x4*)(A.PB + (size_t)row * 256 + c8);
        const u32x4 pp = t > 0 ? *(const GAS u32x4*)(A.PB + (size_t)(row - 1) * 256 + c8) : z;
        const u32x4 pn = t < S - 1 ? *(const GAS u32x4*)(A.PB + (size_t)(row + 1) * 256 + c8) : z;
        const u32x4 cb = *(const GAS u32x4*)(A.CB + (size_t)row * 256 + c8);
        float res[8];
#pragma unroll
        for (int j = 0; j < 8; ++j) {
            const int sh = (j & 1) * 16;
            const float a = __uint_as_float(((pp[j >> 1] >> sh) & 0xffffu) << 16), b = __uint_as_float(((pc[j >> 1] >> sh) & 0xffffu) << 16), c = __uint_as_float(((pn[j >> 1] >> sh) & 0xffffu) << 16);
            const float g = __uint_as_float(((cb[j >> 1] >> sh) & 0xffffu) << 16);
            const int cc = c8 + j;
            res[j] = g * (A.conv_w[cc] * a + A.conv_w[256 + cc] * b + A.conv_w[512 + cc] * c + A.conv_b[cc]);
        }
        u32x4 w; w.x = cvtpk(res[0], res[1]); w.y = cvtpk(res[2], res[3]); w.z = cvtpk(res[4], res[5]); w.w = cvtpk(res[6], res[7]);
        *(GAS u32x4*)(A.MIX + (size_t)row * 1024 + 512 + c8) = w;
    }
}

__device__ __forceinline__ int sigma_map(int type, int i) {
    if (type == 1) return 8 * ((i >> 2) & 3) + 4 * (i >> 4) + (i & 3);
    if (type == 2) return 16 * ((i >> 3) & 1) + 8 * (i >> 4) + (i & 7);
    return i;
}
__device__ __forceinline__ void in_group(int g, int& Lbase, int& type) {
    const int pn = g >> 3, bj = (g >> 2) & 1, wc = g & 3;
    if (pn < 2) { Lbase = 64 * (4 * pn + wc) + 32 * bj; type = 0; }
    else if (pn == 2) { Lbase = (wc < 2 ? 512 + 64 * wc : 640 + 64 * (wc - 2)) + 32 * bj; type = wc < 2 ? 0 : 1; }
    else if (pn == 3) { Lbase = 768 + 128 * bj + 32 * wc; type = 1; }
    else if (pn < 6) { Lbase = 1024 + 256 * bj + 128 * (pn - 4) + 32 * wc; type = 1; }
    else if (pn < 8) { Lbase = (pn == 6 ? 1536 : 1792) + 64 * wc + 32 * bj; type = 2; }
    else { Lbase = 2048 + 64 * wc + 32 * bj; type = 1; }
}
__device__ __forceinline__ void transpose_item(const float* W, int K, int N, bf16_t* WT, int k0, int nphys0, int Lbase, int type, LAS float* scr, int lane) {
#pragma unroll 8
    for (int i = 0; i < 32; ++i) { const int kk = 2 * i + (lane >> 5); scr[kk * 33 + (lane & 31)] = ((const GAS float*)W)[(size_t)(k0 + kk) * N + Lbase + (lane & 31)]; }
    asm volatile("s_waitcnt lgkmcnt(0)" ::: "memory");
    const int c = lane & 7;
#pragma unroll
    for (int j = 0; j < 4; ++j) { const int n = (lane >> 3) + 8 * j; const LAS float* s = scr + (8 * c) * 33 + sigma_map(type, n);
        u32x4 o; o.x = cvtpk(s[0 * 33], s[1 * 33]); o.y = cvtpk(s[2 * 33], s[3 * 33]); o.z = cvtpk(s[4 * 33], s[5 * 33]); o.w = cvtpk(s[6 * 33], s[7 * 33]);
        *(GAS u32x4*)(WT + (size_t)(nphys0 + n) * K + k0 + 8 * c) = o; }
    asm volatile("s_waitcnt lgkmcnt(0)" ::: "memory");
}

struct Params {
    const float *x_prompt, *x_sample, *cache_gk, *cache_gv, *cache_dk, *cache_dv, *c, *c_ctx;
    const float *w_mod, *b_mod, *norm1_g, *w_in, *gqa_qn_g, *gqa_kn_g, *conv_w, *conv_b, *diff_qn_g, *diff_kn_g, *diff_lambda, *diff_subln_g, *w_out, *norm2_g, *ffn_up, *ffn_conv_w, *ffn_conv_b, *ffn_down;
    float* out; unsigned char* ws;
    float lam_init[4];
    int ph_lo, ph_hi;
};

__device__ __forceinline__ void prologue(const Params& P, LAS unsigned char* lds, int G) {
    const int tid = opaque_tid(), lane = tid & 63, wave = __builtin_amdgcn_readfirstlane(tid >> 6);
    float* MODS = (float*)(P.ws + WS_MODS); float* MISC = (float*)(P.ws + WS_MISC);
    if ((int)blockIdx.x < 384) {
        LAS float* sc = (LAS float*)lds;
        LAS float* part = (LAS float*)(lds + 49152);
        for (int i = tid; i < NCOND * 1024; i += 512) { const int ci = i >> 10, k = i & 1023; const float v = ci == 0 ? P.c_ctx[k] : P.c[(ci - 1) * 1024 + k]; sc[k * 12 + ci] = v / (1.f + __expf(-v)); }
        __syncthreads();
        for (int it = blockIdx.x; it < 384; it += G) {
            const int l = it / 96, col = (it % 96) * 64 + lane;
            const float* w = P.w_mod + (size_t)l * 1024 * 6144 + col;
            float acc[NCOND];
#pragma unroll
            for (int ci = 0; ci < NCOND; ++ci) acc[ci] = 0.f;
#pragma unroll 8
            for (int kk = 0; kk < 128; ++kk) { const int k = wave * 128 + kk; const float wv = ((const GAS float*)w)[(size_t)k * 6144];
                const f32x4 s0 = *(LAS f32x4*)(sc + k * 12), s1 = *(LAS f32x4*)(sc + k * 12 + 4); const float s8 = sc[k * 12 + 8];
                acc[0] += s0[0] * wv; acc[1] += s0[1] * wv; acc[2] += s0[2] * wv; acc[3] += s0[3] * wv; acc[4] += s1[0] * wv; acc[5] += s1[1] * wv; acc[6] += s1[2] * wv; acc[7] += s1[3] * wv; acc[8] += s8 * wv; }
#pragma unroll
            for (int ci = 0; ci < NCOND; ++ci) part[(wave * NCOND + ci) * 64 + lane] = acc[ci];
            __syncthreads();
            for (int i = tid; i < NCOND * 64; i += 512) { const int ci = i >> 6, cc = i & 63; float s = 0.f;
#pragma unroll
                for (int w8 = 0; w8 < 8; ++w8) s += part[(w8 * NCOND + ci) * 64 + cc];
                const int j = (it % 96) * 64 + cc; MODS[((size_t)l * NCOND + ci) * 6144 + j] = s + P.b_mod[l * 6144 + j]; }
            __syncthreads();
        }
    }
    if ((int)blockIdx.x == G - 1) {
        if (tid < 4) { const float* lf = P.diff_lambda + tid * 128; float s1 = 0.f, s2 = 0.f; for (int i = 0; i < 32; ++i) { s1 += lf[i] * lf[32 + i]; s2 += lf[64 + i] * lf[96 + i]; }
            MISC[MI_LAM + tid] = expf(s1) - expf(s2) + P.lam_init[tid]; }
        for (int i = tid; i < 1024; i += 512) { const int pos = i >> 4, idx = i & 15; const float fr = powf(10000.f, -(float)idx / 16.f); const float ang = (float)pos * fr; MISC[MI_R64C + i] = cosf(ang); MISC[MI_R64S + i] = sinf(ang); }
        for (int i = tid; i < 512; i += 512) { const int pos = i >> 3, idx = i & 7; const float fr = powf(10000.f, -(float)idx / 8.f); const float ang = (float)pos * fr; MISC[MI_R32C + i] = cosf(ang); MISC[MI_R32S + i] = sinf(ang); }
    }
    __syncthreads();
    LAS float* scr = (LAS float*)(lds + wave * 16384);
    const int gw = blockIdx.x * 8 + wave, NGW = G * 8;
    constexpr int I_IN = 16 * 72, I_OUT = 16 * 32, I_UP = 16 * 176, I_DN = 44 * 32, I_L = I_IN + I_OUT + I_UP + I_DN;
    for (int it = gw; it < DEPTH * I_L; it += NGW) {
        const int l = it / I_L; int r = it % I_L;
        if (r < I_IN) { const int kb = r / 72, g = r % 72; int Lb, ty; in_group(g, Lb, ty);
            transpose_item(P.w_in + (size_t)l * 1024 * INW, 1024, INW, (bf16_t*)(P.ws + WS_WIN) + (size_t)l * INW * 1024, kb * 64, g * 32, Lb, ty, scr, lane); continue; }
        r -= I_IN;
        if (r < I_OUT) { const int kb = r / 32, g = r % 32;
            transpose_item(P.w_out + (size_t)l * 1024 * 1024, 1024, 1024, (bf16_t*)(P.ws + WS_WOUT) + (size_t)l * 1024 * 1024, kb * 64, g * 32, g * 32, 0, scr, lane); continue; }
        r -= I_OUT;
        if (r < I_UP) { const int kb = r / 176, g = r % 176; const int pn = g >> 3, bj = (g >> 2) & 1, wc = g & 3;
            transpose_item(P.ffn_up + (size_t)l * 1024 * UPW, 1024, UPW, (bf16_t*)(P.ws + WS_WUP) + (size_t)l * UPW * 1024, kb * 64, g * 32, bj * DFF + 128 * pn + 32 * wc, 1, scr, lane); continue; }
        r -= I_UP;
        { const int kb = r / 32, g = r % 32;
            transpose_item(P.ffn_down + (size_t)l * DFF * 1024, DFF, 1024, (bf16_t*)(P.ws + WS_WDN) + (size_t)l * 1024 * DFF, kb * 64, g * 32, g * 32, 0, scr, lane); }
    }
}

__device__ __forceinline__ void norm_phase(const float* xin_ctx, const float* xin_lat, const float* ng, const float* mods_l  , int sh_idx, bf16_t* XN, int G) {
    const int tid_ = opaque_tid(); const int lane = tid_ & 63, wave = __builtin_amdgcn_readfirstlane(tid_ >> 6);
    const int nw = G * 8, gw = blockIdx.x * 8 + wave;
    const int per = (M_ALL + nw - 1) / nw;
    const int r0 = gw * per, r1 = min(r0 + per, M_ALL);
    int cur_ci = -1; f32x4 Aa[4], Bb[4];
    f32x4 v[4], vn[4];
    if (r0 < r1) { const float* xr = r0 < M_CTX ? xin_ctx + (size_t)r0 * DM : xin_lat + (size_t)(r0 - M_CTX) * DM;
#pragma unroll
        for (int j = 0; j < 4; ++j) vn[j] = *(const GAS f32x4*)(xr + 4 * lane + 256 * j); }
    for (int row = r0; row < r1; ++row) {
#pragma unroll
        for (int j = 0; j < 4; ++j) v[j] = vn[j];
        if (row + 1 < r1) { const int rn = row + 1; const float* xr = rn < M_CTX ? xin_ctx + (size_t)rn * DM : xin_lat + (size_t)(rn - M_CTX) * DM;
#pragma unroll
            for (int j = 0; j < 4; ++j) vn[j] = *(const GAS f32x4*)(xr + 4 * lane + 256 * j); }
        const int ci = row < M_CTX ? 0 : 1 + ((row - M_CTX) >> 12);
        if (ci != cur_ci) { cur_ci = ci; const float* sh = mods_l + ci * 6144 + sh_idx * 1024; const float* sc = sh + 1024;
#pragma unroll
            for (int j = 0; j < 4; ++j) { const int c = 4 * lane + 256 * j; const f32x4 g4 = *(const GAS f32x4*)(ng + c), s4 = *(const GAS f32x4*)(sc + c); Aa[j] = g4 * (1.f + s4); Bb[j] = *(const GAS f32x4*)(sh + c); } }
        float s = 0.f;
#pragma unroll
        for (int j = 0; j < 4; ++j) s += (v[j][0] * v[j][0] + v[j][1] * v[j][1]) + (v[j][2] * v[j][2] + v[j][3] * v[j][3]);
#pragma unroll
        for (int o = 1; o < 64; o <<= 1) s += __shfl_xor(s, o);
        const float rstd = rsqrtf(s * (1.f / DM) + EPS);
#pragma unroll
        for (int j = 0; j < 4; ++j) { const f32x4 y = v[j] * rstd * Aa[j] + Bb[j]; u32x2 w; w.x = cvtpk(y[0], y[1]); w.y = cvtpk(y[2], y[3]); *(GAS u32x2*)(XN + (size_t)row * DM + 4 * lane + 256 * j) = w; }
    }
}

__device__ __forceinline__ void cache_phase(const Params& P, int l, int G) {
    bf16_t* KG = (bf16_t*)(P.ws + WS_KG); bf16_t* VG = (bf16_t*)(P.ws + WS_VG); bf16_t* KD = (bf16_t*)(P.ws + WS_KD); bf16_t* VD = (bf16_t*)(P.ws + WS_VD);
    const int tid_ = opaque_tid();
    for (int i = blockIdx.x * 512 + tid_; i < 65536; i += G * 512) {
        const int d4 = (i & 15) * 4, kvh = (i >> 4) & 1, p = (i >> 5) & 255, b = i >> 13;
        const size_t src = ((((size_t)b * 4 + l) * 256 + p) * 2 + kvh) * 64 + d4;
        const size_t dst = (((8192L + (long)SLAT * b) * 2 + (long)kvh * SLAT + 4096 + p) * 64);
        const int pk4 = (d4 & 32) | ((d4 & 12) << 1) | ((d4 & 16) >> 2);
        const f32x4 k = *(const GAS f32x4*)(P.cache_gk + src), v = *(const GAS f32x4*)(P.cache_gv + src);
        u32x2 wk, wv; wk.x = cvtpk(k[0], k[1]); wk.y = cvtpk(k[2], k[3]); wv.x = cvtpk(v[0], v[1]); wv.y = cvtpk(v[2], v[3]);
        *(GAS u32x2*)(KG + dst + pk4) = wk; *(GAS u32x2*)(VG + dst + d4) = wv;
    }
    for (int i = blockIdx.x * 512 + tid_; i < 131072; i += G * 512) {
        { const int d4 = (i & 7) * 4, hc = (i >> 3) & 7, p = (i >> 6) & 255, b = i >> 14;
          const size_t src = ((((size_t)b * 4 + l) * 256 + p) * 8 + hc) * 32 + d4;
          const size_t dst = (((8192L + (long)SLAT * b) * 8 + (long)hc * SLAT + 4096 + p) * 32) + ((d4 & 16) | ((d4 & 4) << 1) | ((d4 & 8) >> 1));
          const f32x4 k = *(const GAS f32x4*)(P.cache_dk + src); u32x2 w; w.x = cvtpk(k[0], k[1]); w.y = cvtpk(k[2], k[3]); *(GAS u32x2*)(KD + dst) = w; }
        { const int d4 = (i & 15) * 4, hh = (i >> 4) & 3, p = (i >> 6) & 255, b = i >> 14;
          const size_t src = ((((size_t)b * 4 + l) * 256 + p) * 4 + hh) * 64 + d4;
          const size_t dst = (((8192L + (long)SLAT * b) * 4 + (long)hh * SLAT + 4096 + p) * 64) + d4;
          const f32x4 v = *(const GAS f32x4*)(P.cache_dv + src); u32x2 w; w.x = cvtpk(v[0], v[1]); w.y = cvtpk(v[2], v[3]); *(GAS u32x2*)(VD + dst) = w; }
    }
}

__device__ __forceinline__ void fixup_phase(const float* cw, bf16_t* F, const float* EP, const float* EA, const float* EU, int G) {
    const int tid_ = opaque_tid();
    for (int i = blockIdx.x * 512 + tid_; i < 128 * 2 * DFF; i += G * 512) {
        const int c = i % DFF, e = (i / DFF) & 1, pm = 32 + i / (2 * DFF); const int j = (pm - 32) & 15;
        if (e == 0 ? j == 0 : j == 15) continue;
        const size_t eo = ((size_t)pm * 2 + e) * DFF + c;
        float conv;
        if (e == 0) conv = EP[eo] + cw[c] * EA[((size_t)(pm - 1) * 2 + 1) * DFF + c];
        else conv = EP[eo] + cw[2 * DFF + c] * EA[((size_t)(pm + 1) * 2 + 0) * DFF + c];
        const float f = silu_f(conv) * EU[eo];
        const size_t row = (size_t)pm * 256 + (e ? 255 : 0);
        F[row * DFF + c] = (bf16_t)(cvtpk(f, 0.f) & 0xffffu);
    }
}


#define XB_TMO      128
#define XB_XCNT(j)  (256  + 64 * (j))
#define XB_XSUB(j)  (1280 + 64 * (j))
#define XB_XGEN(j)  (2304 + 64 * (j))
#define XB_TOP      3328
#define XB_TOPGEN   3392
#define XCD_BAR_WORDS 3456
#define XB_SPIN_CAP (1u << 22)
__device__ __forceinline__ unsigned xb_ld(unsigned* p)              { return __hip_atomic_load(p, __ATOMIC_RELAXED, __HIP_MEMORY_SCOPE_AGENT); }
__device__ __forceinline__ unsigned xb_add(unsigned* p, unsigned v) { return __hip_atomic_fetch_add(p, v, __ATOMIC_RELAXED, __HIP_MEMORY_SCOPE_AGENT); }
__device__ __forceinline__ unsigned xb_xcc_id() { return (unsigned)__builtin_amdgcn_s_getreg((3 << 11) | 20) & 0xFu; }
#define XB_SPIN(cond, bar) do { unsigned _sp = 0; while (cond) { __builtin_amdgcn_s_sleep(1); \
    if ((++_sp & 255u) == 0u) { if (xb_ld(&(bar)[XB_TMO])) break; if (_sp > XB_SPIN_CAP) { atomicAdd(&(bar)[XB_TMO], 1u); break; } } } } while (0)
struct XcdBarrier { unsigned* bar; unsigned x; volatile LAS unsigned* st; };
__device__ __forceinline__ XcdBarrier xcd_barrier_post(unsigned* bar, volatile LAS unsigned* st) {
    XcdBarrier b; b.bar = bar; b.x = xb_xcc_id(); b.st = st;
    if (threadIdx.x == 0) (void)xb_add(&bar[XB_XCNT(b.x)], 1u);
    return b;
}
__device__ __forceinline__ void xcd_barrier_complete(unsigned* bar, unsigned x, unsigned& nloc, unsigned& nx) {
    const unsigned G = gridDim.x * gridDim.y * gridDim.z;
    unsigned sum, cnt, mine, sp = 0u;
    for (;;) {
        sum = 0u; cnt = 0u; mine = 0u;
#pragma unroll
        for (unsigned j = 0; j < 16; ++j) { const unsigned c = xb_ld(&bar[XB_XCNT(j)]); sum += c; cnt += (c > 0u) ? 1u : 0u; mine = (j == x) ? c : mine; }
        if (sum == G) break;
        __builtin_amdgcn_s_sleep(1);
        if ((++sp & 255u) == 0u) { if (xb_ld(&bar[XB_TMO])) break; if (sp > XB_SPIN_CAP) { atomicAdd(&bar[XB_TMO], 1u); break; } }
    }
    nloc = mine > 0u ? mine : 1u; nx = cnt > 0u ? cnt : 1u;
}
__device__ __forceinline__ void xcd_barrier(const XcdBarrier& b) {
    asm volatile("s_waitcnt vmcnt(0)" ::: "memory");
    __syncthreads();
    if (threadIdx.x == 0) {
        unsigned* bar = b.bar;
        __builtin_amdgcn_s_waitcnt(0);
        unsigned nloc = b.st[0], nx = b.st[1];
        if (nloc == 0u) { xcd_barrier_complete(bar, b.x, nloc, nx); b.st[0] = nloc; b.st[1] = nx; }
        const unsigned old = xb_add(&bar[XB_XSUB(b.x)], 1u);
        const unsigned gen = old / nloc;
        if (old + 1u == (gen + 1u) * nloc) {
            __builtin_amdgcn_fence(__ATOMIC_RELEASE, "agent");
            asm volatile("s_waitcnt vmcnt(0)" ::: "memory");
            const unsigned og = xb_add(&bar[XB_TOP], 1u);
            const unsigned tg = og / nx;
            if (og + 1u == (tg + 1u) * nx) xb_add(&bar[XB_TOPGEN], 1u);
            else XB_SPIN(xb_ld(&bar[XB_TOPGEN]) == tg, bar);
            __builtin_amdgcn_fence(__ATOMIC_ACQUIRE, "agent");
            xb_add(&bar[XB_XGEN(b.x)], 1u);
            asm volatile("s_waitcnt vmcnt(0)" ::: "memory");
        } else {
            XB_SPIN(xb_ld(&bar[XB_XGEN(b.x)]) == gen, bar);
            __builtin_amdgcn_fence(__ATOMIC_ACQUIRE, "agent");
            asm volatile("s_waitcnt vmcnt(0)" ::: "memory");
        }
    }
    __syncthreads();
}

__global__ void __launch_bounds__(512, 2) fwd_kernel(Params P) {
    extern __shared__ __attribute__((aligned(16))) unsigned char lds_raw[];
    LAS unsigned char* lds = (LAS unsigned char*)lds_raw;
    cg::grid_group grid = cg::this_grid();
    const int G = gridDim.x;
    volatile LAS unsigned* bst = (volatile LAS unsigned*)(lds + MISC_OFF);
    if (threadIdx.x < 2) bst[threadIdx.x] = 0u;
    __syncthreads();
    XcdBarrier bar = xcd_barrier_post((unsigned*)(P.ws + WS_CTL), bst);
    int ph = 0;
#define PHASE_BEGIN if (ph >= P.ph_lo && ph < P.ph_hi) { unsigned char* ws = P.ws; float* outp = P.out; asm volatile("" : "+s"(ws), "+s"(outp));
#define PHASE_END   if (ph + 1 < P.ph_hi) { if (ph == 0) grid.sync(); else xcd_barrier(bar); } } ++ph;
    PHASE_BEGIN
#ifndef SKIP_PRO
        prologue(P, lds, G);
#endif
    PHASE_END
    for (int l = 0; l < DEPTH; ++l) {
        PHASE_BEGIN
            const float* xin_ctx = l == 0 ? P.x_prompt : outp; const float* xin_lat = l == 0 ? P.x_sample : outp + (size_t)M_CTX * DM;
            norm_phase(xin_ctx, xin_lat, P.norm1_g + l * DM, (const float*)(ws + WS_MODS) + (size_t)l * NCOND * 6144, 0, (bf16_t*)(ws + WS_XN), G);
            cache_phase(P, l, G);
        PHASE_END
        PHASE_BEGIN {
            const float* MISC = (const float*)(ws + WS_MISC);
            pg8::Gemm g{(const bf16_t*)(ws + WS_XN), (const bf16_t*)(ws + WS_WIN) + (size_t)l * INW * 1024, M_ALL, INW, 1024}; pg8::StaticOrder S; S.init(M_ALL, INW, G, blockIdx.x);
            EpiIn E{l, P.gqa_qn_g + l * 64, P.gqa_kn_g + l * 64, P.diff_qn_g + l * 32, P.diff_kn_g + l * 32, MISC + MI_R64C, MISC + MI_R64S, MISC + MI_R32C, MISC + MI_R32S,
                    (bf16_t*)(ws + WS_QG), (bf16_t*)(ws + WS_QD), (bf16_t*)(ws + WS_KG), (bf16_t*)(ws + WS_VG), (bf16_t*)(ws + WS_KD), (bf16_t*)(ws + WS_VD), (bf16_t*)(ws + WS_CB), (bf16_t*)(ws + WS_PB), outp};
#ifndef SKIP_IN
            pg8::gemm_phase(lds, lds + XCH_OFF, g, S, E);
#endif
        } PHASE_END
        PHASE_BEGIN {
            const float* MISC = (const float*)(ws + WS_MISC);
            AttnArgs A{(const bf16_t*)(ws + WS_QG), (const bf16_t*)(ws + WS_QD), (const bf16_t*)(ws + WS_KG), (const bf16_t*)(ws + WS_VG), (const bf16_t*)(ws + WS_KD), (const bf16_t*)(ws + WS_VD),
                       (const bf16_t*)(ws + WS_CB), (const bf16_t*)(ws + WS_PB), (bf16_t*)(ws + WS_XN), P.conv_w + l * 768, P.conv_b + l * 256, P.diff_subln_g + l * 64, MISC[MI_LAM + l], P.lam_init[l], (float*)(ws + WS_DSCR)};
#ifndef SKIP_ATT
            attn_phase(A, (LAS char*)lds, (char*)lds_raw, G);
#endif
        } PHASE_END
        PHASE_BEGIN {
            const float* xin_ctx = l == 0 ? P.x_prompt : outp; const float* xin_lat = l == 0 ? P.x_sample : outp + (size_t)M_CTX * DM;
            pg8::Gemm g{(const bf16_t*)(ws + WS_XN), (const bf16_t*)(ws + WS_WOUT) + (size_t)l * 1024 * 1024, M_ALL, 1024, 1024}; pg8::StaticOrder S; S.init(M_ALL, 1024, G, blockIdx.x);
            EpiRes E{xin_ctx, xin_lat, outp, (const float*)(ws + WS_MODS) + (size_t)l * NCOND * 6144 + 2 * 1024};
#ifndef SKIP_RES
            pg8::gemm_phase(lds, lds + XCH_OFF, g, S, E);
#endif
        } PHASE_END
        PHASE_BEGIN
            norm_phase(outp, outp + (size_t)M_CTX * DM, P.norm2_g + l * DM, (const float*)(ws + WS_MODS) + (size_t)l * NCOND * 6144, 3, (bf16_t*)(ws + WS_XN), G);
        PHASE_END
        PHASE_BEGIN {
            float* EPb = (float*)(ws + WS_EDGE);
            pg8::Gemm g{(const bf16_t*)(ws + WS_XN), (const bf16_t*)(ws + WS_WUP) + (size_t)l * UPW * 1024, M_ALL, UPW, 1024}; pg8::StaticOrder S; S.init(M_ALL, UPW, G, blockIdx.x);
            EpiUp E{P.ffn_conv_w + (size_t)l * 3 * DFF, P.ffn_conv_b + (size_t)l * DFF, (bf16_t*)(ws + WS_U), EPb, EPb + EDGE_ELEMS, EPb + 2 * EDGE_ELEMS};
#ifndef SKIP_UP
            pg8::gemm_phase(lds, lds + XCH_OFF, g, S, E);
#endif
        } PHASE_END
        PHASE_BEGIN {
            float* EPb = (float*)(ws + WS_EDGE);
            fixup_phase(P.ffn_conv_w + (size_t)l * 3 * DFF, (bf16_t*)(ws + WS_U), EPb, EPb + EDGE_ELEMS, EPb + 2 * EDGE_ELEMS, G);
        } PHASE_END
        PHASE_BEGIN {
            pg8::Gemm g{(const bf16_t*)(ws + WS_U), (const bf16_t*)(ws + WS_WDN) + (size_t)l * 1024 * DFF, M_ALL, 1024, DFF}; pg8::StaticOrder S; S.init(M_ALL, 1024, G, blockIdx.x);
            EpiRes E{outp, outp + (size_t)M_CTX * DM, outp, (const float*)(ws + WS_MODS) + (size_t)l * NCOND * 6144 + 5 * 1024};
#ifndef SKIP_RES
            pg8::gemm_phase(lds, lds + XCH_OFF, g, S, E);
#endif
        } PHASE_END
    }
}

constexpr int N_PHASES = 1 + DEPTH * 8;
#ifndef N_LAUNCH_SPLIT
#define N_LAUNCH_SPLIT 0
#endif

extern "C" void kernel_launch(void* const* d_in, const int* in_sizes, int n_in, void* d_out, int out_size, void* d_ws, size_t ws_size, hipStream_t stream) {
    static int grid = 0;
    if (grid == 0) {
        if (n_in != 26 || ws_size < WS_END) { fprintf(stderr, "kernel_launch: unexpected n_in %d or ws_size %zu (< %zu)\n", n_in, ws_size, (size_t)WS_END); grid = -1; return; }
        int dev = 0, cus = 0, per_cu = 0;
        hipGetDevice(&dev); hipDeviceGetAttribute(&cus, hipDeviceAttributeMultiprocessorCount, dev);
        hipFuncSetAttribute((const void*)fwd_kernel, hipFuncAttributeMaxDynamicSharedMemorySize, LDS_BYTES);
        hipOccupancyMaxActiveBlocksPerMultiprocessor(&per_cu, (const void*)fwd_kernel, 512, LDS_BYTES);
        if (per_cu < 1) { fprintf(stderr, "kernel_launch: occupancy query gives %d\n", per_cu); per_cu = 1; }
        (void)hipGetLastError();
        grid = cus * 1;
    }
    if (grid < 0) return;
    Params p{};
    const float** pp = (const float**)&p;
    for (int i = 0; i < 26; ++i) pp[i] = (const float*)d_in[i];
    p.out = (float*)d_out; p.ws = (unsigned char*)d_ws;
    for (int l = 0; l < 4; ++l) p.lam_init[l] = (float)(0.8 - 0.6 * exp(-0.3 * (double)l));
#if N_LAUNCH_SPLIT
    for (int ph = 0; ph < N_PHASES; ++ph) { p.ph_lo = ph; p.ph_hi = ph + 1; hipLaunchKernelGGL(fwd_kernel, dim3(grid), dim3(512), LDS_BYTES, stream, p); }
#else
    p.ph_lo = 0; p.ph_hi = N_PHASES;
    if (hipMemsetAsync((char*)d_ws + WS_CTL, 0, CTL_ZERO_BYTES, stream) != hipSuccess) { fprintf(stderr, "kernel_launch: memset failed\n"); return; }
    void* args[] = {&p};
    hipError_t e = hipLaunchCooperativeKernel((const void*)fwd_kernel, dim3(grid), dim3(512), args, LDS_BYTES, stream);
    if (e != hipSuccess) fprintf(stderr, "cooperative launch failed: %s (grid %d)\n", hipGetErrorString(e), grid);
#endif
}
```

```cpp
#include <hip/hip_runtime.h>
#include <hip/hip_cooperative_groups.h>
#include <cstdio>
#include <cstdint>
#include <cmath>
namespace cg = cooperative_groups;

#define LAS __attribute__((address_space(3)))
#define GAS __attribute__((address_space(1)))
typedef unsigned short bf16_t;
typedef short bf16x8 __attribute__((ext_vector_type(8)));
typedef short s16x4 __attribute__((ext_vector_type(4)));
typedef float f32x4 __attribute__((ext_vector_type(4)));
typedef float f32x16 __attribute__((ext_vector_type(16)));
typedef unsigned u32x4 __attribute__((ext_vector_type(4)));
typedef unsigned u32x2 __attribute__((ext_vector_type(2)));
typedef float f32x2 __attribute__((ext_vector_type(2)));
typedef __bf16 bf16x2_t __attribute__((ext_vector_type(2)));

__device__ __forceinline__ unsigned cvtpk(float lo, float hi) { f32x2 v = {lo, hi}; bf16x2_t b = __builtin_convertvector(v, bf16x2_t); return __builtin_bit_cast(unsigned, b); }
__device__ __forceinline__ int opaque_tid() { int t = threadIdx.x; asm volatile("" : "+v"(t)); return t; }
__device__ __forceinline__ float bf2f(unsigned short u) { return __uint_as_float(((unsigned)u) << 16); }

constexpr int DM = 1024, DEPTH = 4, NCOND = 9;
constexpr int M_CTX = 8192, M_ALL = 40960, NTM = 160;
constexpr int INW = 2304, DFF = 2816, UPW = 5632;
constexpr int SLAT = 4352;
constexpr float EPS = 1e-6f;
constexpr float LOG2E = 1.4426950408889634f;
constexpr float QSCALE_G = 0.125f * LOG2E;
constexpr float QSCALE_D = 0.17677669529663687f * LOG2E;
constexpr size_t OUT_GK = 41943040, OUT_GV = OUT_GK + 4194304, OUT_DK = OUT_GV + 4194304, OUT_DV = OUT_DK + 8388608;
constexpr size_t MiB = 1u << 20;
constexpr size_t WS_MODS = 1 * MiB;
constexpr size_t WS_MISC = 2 * MiB;
constexpr size_t WS_EDGE = 3 * MiB;
constexpr size_t EDGE_ELEMS = (size_t)NTM * 2 * DFF;
constexpr size_t WS_WIN = 16 * MiB;
constexpr size_t WS_WOUT = 34 * MiB;
constexpr size_t WS_WUP = 42 * MiB;
constexpr size_t WS_WDN = 86 * MiB;
constexpr size_t WS_XN = 108 * MiB;
constexpr size_t WS_U = 188 * MiB;
constexpr size_t WS_QG = WS_U, WS_QD = WS_QG + (size_t)M_ALL * 512 * 2, WS_KG = WS_QD + (size_t)M_ALL * 256 * 2;
constexpr size_t KROWS = 8192 + 8 * SLAT;
constexpr size_t WS_VG = WS_KG + KROWS * 128 * 2, WS_KD = WS_VG + KROWS * 128 * 2, WS_VD = WS_KD + KROWS * 256 * 2;
constexpr size_t WS_CB = WS_VD + KROWS * 256 * 2, WS_PB = WS_CB + (size_t)M_ALL * 256 * 2, WS_UEND = WS_PB + (size_t)M_ALL * 256 * 2;
constexpr size_t WS_DSCR = WS_U + (size_t)M_ALL * DFF * 2;
constexpr size_t WS_END = WS_DSCR + 32 * MiB;
static_assert(WS_UEND <= WS_DSCR, "union");
constexpr int MI_LAM = 0, MI_R64C = 64, MI_R64S = MI_R64C + 1024, MI_R32C = MI_R64S + 1024, MI_R32S = MI_R32C + 512;

constexpr int RING_BYTES = 131072, XCH_OFF = RING_BYTES, MISC_OFF = RING_BYTES + 4096, LDS_BYTES = RING_BYTES + 4096 + 256;
constexpr size_t WS_CTL = 0, CTL_ZERO_BYTES = 65536;

struct TileInfo {
    int lat, seq, t0, ci, S; long R;
    __device__ __forceinline__ TileInfo(int pm) {
        if (pm < 32) { lat = 0; seq = pm; t0 = 0; ci = 0; S = 256; R = 256L * pm; }
        else { const int b = (pm - 32) >> 4; lat = 1; seq = b; t0 = ((pm - 32) & 15) * 256; ci = 1 + b; S = SLAT; R = 8192L + (long)SLAT * b; }
    }
};

namespace pg8 {
constexpr int BM = 256, BK = 64, HALF = 128, HTB = HALF * BK * 2, NXCD = 8, WGM = 8;
__host__ __device__ __forceinline__ int lds_byte(int r, int c) { const int st = (r >> 4) * 2 + (c >> 5), rr = r & 15, cc = c & 31, ob = rr * 64 + cc * 2; return st * 1024 + (ob ^ (((ob >> 9) & 1) << 5)); }
__host__ __device__ __forceinline__ void stage_rc(int b, int& R, int& C) { const int st = b / 1024, sb = b % 1024, swz = sb ^ (((sb >> 9) & 1) << 5); R = (st >> 1) * 16 + swz / 64; C = (st & 1) * 32 + (swz % 64) / 2; }
struct Unit { int pm, pn; };
struct Gemm { const bf16_t* A; const bf16_t* Bt; int M, N, K; };
struct StaticOrder {
    int nM, nN, nwg, G, c;
    __device__ void init(int M, int N, int G_, int c_) { nM = M / BM; nN = N / BM; nwg = nM * nN; G = G_; c = c_; }
    __device__ bool next(int i, Unit& u) const {
        const long L = (long)i * G + c; if (L >= nwg) return false;
        int wgid = (int)L; { const int q = nwg / NXCD, r = nwg % NXCD, xcd = wgid % NXCD, off = wgid / NXCD; wgid = (xcd < r ? xcd * (q + 1) : r * (q + 1) + (xcd - r) * q) + off; }
        const int nig = WGM * nN, gid = wgid / nig, fm = gid * WGM, gsz = (nM - fm) < WGM ? (nM - fm) : WGM;
        u.pm = fm + ((wgid % nig) % gsz); u.pn = (wgid % nig) / gsz; return true;
    }
};
template <class Epi>
__device__ __forceinline__ void gemm_phase(LAS unsigned char* lds, LAS unsigned char* xlds, const Gemm g, const StaticOrder& S, const Epi& E) {
    const int tid = opaque_tid(), wid = __builtin_amdgcn_readfirstlane(tid >> 6), lane = tid & 63, wr = wid >> 2, wc = wid & 3, fr = lane & 15, fq = lane >> 4;
    const int K = g.K, nt = K / BK;
    unsigned voffA[2];
#pragma unroll
    for (int i = 0; i < 2; ++i) { int R, C; stage_rc(tid * 16 + i * 8192, R, C); voffA[i] = (unsigned)(R * K + C) * 2u; }
    const size_t kstep = (size_t)(BK * 2);
    const size_t hstep = (size_t)HALF * K * 2;
    const size_t tstep = 2 * hstep;
    const unsigned ldsw = (unsigned)wid * 1024u;
    const int aoff = lds_byte(wr * 64 + fr, fq * 8), boff = lds_byte(wc * 32 + fr, fq * 8);
#define PG8_SA(b, h) (((b) * 2 + (h)) * HTB)
#define PG8_SB(b, h) ((4 + (b) * 2 + (h)) * HTB)
#define PG8_STAGE(bufoff, gbase) do { _Pragma("unroll") for (int _i = 0; _i < 2; ++_i) \
        __builtin_amdgcn_global_load_lds((const unsigned*)((const char*)(gbase) + voffA[_i]), (LAS unsigned*)(lds + (bufoff) + ldsw + _i * 8192), 16, 0, 0); } while (0)
#define PG8_LDA(dst, b, h) do { _Pragma("unroll") for (int m = 0; m < 4; ++m) _Pragma("unroll") for (int k = 0; k < 2; ++k) dst[m][k] = *(const LAS bf16x8*)(lds + PG8_SA(b, h) + aoff + m * 2048 + k * 1024); } while (0)
#define PG8_LDB(dst, b, h) do { _Pragma("unroll") for (int n = 0; n < 2; ++n) _Pragma("unroll") for (int k = 0; k < 2; ++k) dst[n][k] = *(const LAS bf16x8*)(lds + PG8_SB(b, h) + boff + n * 2048 + k * 1024); } while (0)
#define PG8_MMA(ai, bj, At, Bt) do { __builtin_amdgcn_s_setprio(1); _Pragma("unroll") for (int m = 0; m < 4; ++m) _Pragma("unroll") for (int n = 0; n < 2; ++n) _Pragma("unroll") for (int k = 0; k < 2; ++k) \
        acc[ai][bj][m][n] = __builtin_amdgcn_mfma_f32_16x16x32_bf16(Bt[n][k], At[m][k], acc[ai][bj][m][n], 0, 0, 0); __builtin_amdgcn_s_setprio(0); } while (0)
#define PG8_WAIT_V(n) asm volatile("s_waitcnt vmcnt(" #n ")" ::: "memory")
#define PG8_WAIT_L(n) asm volatile("s_waitcnt lgkmcnt(" #n ")" ::: "memory")
#define PG8_BAR __builtin_amdgcn_s_barrier()
#define PG8_SCHED __builtin_amdgcn_sched_barrier(0)
    Unit cur, nxt; int ui = 0;
    if (!S.next(0, cur)) return;
    f32x4 acc[2][2][4][2];
#pragma unroll
    for (int a = 0; a < 2; ++a)
#pragma unroll
        for (int b = 0; b < 2; ++b)
#pragma unroll
            for (int m = 0; m < 4; ++m)
#pragma unroll
                for (int n = 0; n < 2; ++n) acc[a][b][m][n] = (f32x4){0.f, 0.f, 0.f, 0.f};
    bf16x8 At[4][2], B0[2][2], B1[2][2];
    const char* cA = (const char*)g.A + (size_t)cur.pm * tstep; const char* cB = (const char*)g.Bt + (size_t)cur.pn * tstep;
    PG8_STAGE(PG8_SB(0, 0), cB); PG8_STAGE(PG8_SB(0, 1), cB + hstep); PG8_STAGE(PG8_SA(0, 0), cA); PG8_STAGE(PG8_SA(0, 1), cA + hstep);
    if (wr == 1) PG8_BAR;
    PG8_WAIT_V(2); PG8_BAR;
    PG8_STAGE(PG8_SB(1, 0), cB + kstep); PG8_STAGE(PG8_SA(1, 0), cA + kstep); PG8_STAGE(PG8_SB(1, 1), cB + hstep + kstep);
    PG8_WAIT_V(6); PG8_BAR;
    for (;;) {
        const bool has_next = S.next(ui + 1, nxt);
        const char* nA = has_next ? (const char*)g.A + (size_t)nxt.pm * tstep : cA; const char* nB = has_next ? (const char*)g.Bt + (size_t)nxt.pn * tstep : cB;
        for (int t = 0; t < nt; t += 2) {
            const bool last = (t == nt - 2);
            const char* a1 = cA + (size_t)(t + 1) * kstep;
            const char* a2 = last ? nA : cA + (size_t)(t + 2) * kstep; const char* b2 = last ? nB : cB + (size_t)(t + 2) * kstep;
            const char* a3 = a2 + kstep; const char* b3 = b2 + kstep;
            PG8_LDB(B0, 0, 0); PG8_LDB(B1, 0, 1); PG8_SCHED; PG8_LDA(At, 0, 0); PG8_STAGE(PG8_SA(1, 1), a1 + hstep);
            PG8_WAIT_V(8); PG8_WAIT_L(0); PG8_BAR; PG8_MMA(0, 0, At, B0); PG8_MMA(0, 1, At, B1); PG8_BAR; PG8_SCHED;
            PG8_LDA(At, 0, 1); PG8_STAGE(PG8_SB(0, 0), b2); PG8_STAGE(PG8_SB(0, 1), b2 + hstep); PG8_STAGE(PG8_SA(0, 0), a2);
            PG8_WAIT_V(8); PG8_WAIT_L(0); PG8_BAR; PG8_MMA(1, 0, At, B0); PG8_MMA(1, 1, At, B1); PG8_BAR; PG8_SCHED;
            PG8_LDB(B0, 1, 0); PG8_LDB(B1, 1, 1); PG8_SCHED; PG8_LDA(At, 1, 0); PG8_STAGE(PG8_SA(0, 1), a2 + hstep);
            PG8_WAIT_V(8); PG8_WAIT_L(0); PG8_BAR; PG8_MMA(0, 0, At, B0); PG8_MMA(0, 1, At, B1); PG8_BAR; PG8_SCHED;
            PG8_LDA(At, 1, 1); PG8_STAGE(PG8_SB(1, 0), b3); PG8_STAGE(PG8_SB(1, 1), b3 + hstep); PG8_STAGE(PG8_SA(1, 0), a3);
            PG8_WAIT_V(8); PG8_WAIT_L(0); PG8_BAR; PG8_MMA(1, 0, At, B0); PG8_MMA(1, 1, At, B1); PG8_BAR; PG8_SCHED;
        }
        if (wr == 0) PG8_BAR;
        { int fr_ = fr, fq_ = fq; asm volatile("" : "+v"(fr_), "+v"(fq_)); E(acc, cur, wr, wc, fr_, fq_, xlds); }
        if (!has_next) break;
#pragma unroll
        for (int a = 0; a < 2; ++a)
#pragma unroll
            for (int b = 0; b < 2; ++b)
#pragma unroll
                for (int m = 0; m < 4; ++m)
#pragma unroll
                    for (int n = 0; n < 2; ++n) acc[a][b][m][n] = (f32x4){0.f, 0.f, 0.f, 0.f};
        cur = nxt; cA = nA; cB = nB; ++ui;
        if (wr == 1) PG8_BAR;
    }
    PG8_WAIT_V(0);
    PG8_BAR;
#undef PG8_SA
#undef PG8_SB
#undef PG8_STAGE
#undef PG8_LDA
#undef PG8_LDB
#undef PG8_MMA
#undef PG8_WAIT_V
#undef PG8_WAIT_L
#undef PG8_BAR
#undef PG8_SCHED
}
}

typedef f32x4 Acc[2][2][4][2];

struct EpiRes {
    const float* xin_ctx; const float* xin_lat; float* xout; const float* gate;
    __device__ __forceinline__ void operator()(const Acc& acc, const pg8::Unit& u, int wr, int wc, int fr, int fq, LAS unsigned char*) const {
        const TileInfo ti(u.pm);
        const int col0 = u.pn * 256 + wc * 32 + 4 * fq;
        const float* gp = gate + ti.ci * 6144 + col0;
        f32x4 g4[2][2];
#pragma unroll
        for (int bj = 0; bj < 2; ++bj)
#pragma unroll
            for (int n = 0; n < 2; ++n) g4[bj][n] = *(const GAS f32x4*)(gp + bj * 128 + n * 16);
        const float* xin = ti.lat ? xin_lat + (size_t)(u.pm * 256 - M_CTX) * DM : xin_ctx + (size_t)(u.pm * 256) * DM;
        float* xo = xout + (size_t)(u.pm * 256) * DM;
#pragma unroll
        for (int ai = 0; ai < 2; ++ai) {
            f32x4 xv[4][2][2];
#pragma unroll
            for (int m = 0; m < 4; ++m) {
                const size_t off = (size_t)(ai * 128 + wr * 64 + m * 16 + fr) * DM + col0;
#pragma unroll
                for (int bj = 0; bj < 2; ++bj)
#pragma unroll
                    for (int n = 0; n < 2; ++n) xv[m][bj][n] = *(const GAS f32x4*)(xin + off + bj * 128 + n * 16);
            }
#pragma unroll
            for (int m = 0; m < 4; ++m) {
                const size_t off = (size_t)(ai * 128 + wr * 64 + m * 16 + fr) * DM + col0;
#pragma unroll
                for (int bj = 0; bj < 2; ++bj)
#pragma unroll
                    for (int n = 0; n < 2; ++n) *(GAS f32x4*)(xo + off + bj * 128 + n * 16) = xv[m][bj][n] + g4[bj][n] * acc[ai][bj][m][n];
            }
            __builtin_amdgcn_sched_group_barrier(0x020, 16, 0);
            asm volatile("" ::: "memory");
            __builtin_amdgcn_sched_barrier(0);
        }
    }
};

struct EpiIn {
    int layer;
    const float *qn_g, *kn_g, *dqn_g, *dkn_g;
    const float *r64c, *r64s, *r32c, *r32s;
    bf16_t *QG, *QD, *KG, *VG, *KD, *VD, *CB, *PB;
    float* out;
    __device__ __forceinline__ void operator()(const Acc& acc, const pg8::Unit& u, int wr, int wc, int fr, int fq, LAS unsigned char*) const {
        const TileInfo ti(u.pm);
        const int pn = u.pn;
        const int rbase = wr * 64 + fr;
        if (pn < 2 || (pn == 2 && wc < 2)) {
            const bool isq = pn < 2;
            const float* gsrc = (isq ? qn_g : kn_g) + 4 * fq;
            const int head = isq ? 4 * pn + wc : wc;
            f32x4 g4[2][2], rc[2], rs[2];
#pragma unroll
            for (int bj = 0; bj < 2; ++bj)
#pragma unroll
                for (int n = 0; n < 2; ++n) g4[bj][n] = *(const GAS f32x4*)(gsrc + 32 * bj + 16 * n);
#pragma unroll
            for (int ai = 0; ai < 2; ++ai) { const int pos = (ti.t0 >> 6) + 2 * ai + wr; rc[ai] = *(const GAS f32x4*)(r64c + pos * 16 + 4 * fq); rs[ai] = *(const GAS f32x4*)(r64s + pos * 16 + 4 * fq); }
            float ss[8];
#pragma unroll
            for (int ai = 0; ai < 2; ++ai)
#pragma unroll
                for (int m = 0; m < 4; ++m) { float t_ = 0.f;
#pragma unroll
                    for (int bj = 0; bj < 2; ++bj)
#pragma unroll
                        for (int n = 0; n < 2; ++n) { const f32x4 v = acc[ai][bj][m][n]; t_ += (v[0] * v[0] + v[1] * v[1]) + (v[2] * v[2] + v[3] * v[3]); }
                    ss[ai * 4 + m] = t_; }
#pragma unroll
            for (int i = 0; i < 8; ++i) ss[i] += __shfl_xor(ss[i], 16);
#pragma unroll
            for (int i = 0; i < 8; ++i) ss[i] += __shfl_xor(ss[i], 32);
#pragma unroll
            for (int mh = 0; mh < 2; ++mh) {
                f32x4 cc[2], cs[2];
#pragma unroll
                for (int mm = 0; mm < 2; ++mm) { const int pos = 16 * (2 * mh + mm) + fr; cc[mm] = *(const GAS f32x4*)(r64c + pos * 16 + 4 * fq); cs[mm] = *(const GAS f32x4*)(r64s + pos * 16 + 4 * fq); }
                if (mh == 0) __builtin_amdgcn_sched_group_barrier(0x020, 12, 0); else __builtin_amdgcn_sched_group_barrier(0x020, 4, 0);
#pragma unroll
                for (int mm = 0; mm < 2; ++mm)
#pragma unroll
                    for (int ai = 0; ai < 2; ++ai) {
                        const int m = 2 * mh + mm;
                        const int rt = ai * 128 + m * 16 + rbase; const int t = ti.t0 + rt;
                        const float rstd = rsqrtf(ss[ai * 4 + m] * (1.f / 64.f) + EPS);
                        bf16_t* dst = isq ? QG + ((size_t)u.pm * 256 + rt) * 512 + head * 64 + 8 * fq : KG + ((ti.R * 2 + (long)head * ti.S + t) * 64) + 8 * fq;
                        float* o = out + OUT_GK + ((size_t)(ti.seq * 4 + layer) * 256 + t) * 128 + head * 64 + 4 * fq;
#pragma unroll
                        for (int bj = 0; bj < 2; ++bj) {
                            f32x4 y0 = acc[ai][bj][m][0] * rstd * g4[bj][0], y1 = acc[ai][bj][m][1] * rstd * g4[bj][1];
                            if (!isq && !ti.lat) { *(GAS f32x4*)(o + 32 * bj) = y0; *(GAS f32x4*)(o + 32 * bj + 16) = y1; }
                            if (ti.lat) {
                                const f32x4 c4 = bj ? cc[mm] : rc[ai], s4 = bj ? cs[mm] : rs[ai];
                                const f32x4 o0 = y0 * c4 - y1 * s4, o1 = y1 * c4 + y0 * s4; y0 = o0; y1 = o1;
                            }
                            if (isq) { y0 = y0 * QSCALE_G; y1 = y1 * QSCALE_G; }
                            u32x4 w; w.x = cvtpk(y0[0], y0[1]); w.y = cvtpk(y0[2], y0[3]); w.z = cvtpk(y1[0], y1[1]); w.w = cvtpk(y1[2], y1[3]);
                            *(GAS u32x4*)(dst + 32 * bj) = w;
                        }
                    }
                asm volatile("" ::: "memory"); __builtin_amdgcn_sched_barrier(0);
            }
        } else if (pn == 2) {
            const int head = wc - 2;
#pragma unroll
            for (int ai = 0; ai < 2; ++ai)
#pragma unroll
                for (int m = 0; m < 4; ++m) {
                    const int rt = ai * 128 + m * 16 + rbase; const int t = ti.t0 + rt;
                    if (!ti.lat) {
                        float* o = out + OUT_GV + ((size_t)(ti.seq * 4 + layer) * 256 + t) * 128 + head * 64 + 8 * fq;
#pragma unroll
                        for (int bj = 0; bj < 2; ++bj) { *(GAS f32x4*)(o + 32 * bj) = acc[ai][bj][m][0]; *(GAS f32x4*)(o + 32 * bj + 4) = acc[ai][bj][m][1]; }
                    }
                    bf16_t* vp = VG + ((ti.R * 2 + (long)head * ti.S + t) * 64) + 8 * fq;
#pragma unroll
                    for (int bj = 0; bj < 2; ++bj) { const f32x4 a = acc[ai][bj][m][0], b = acc[ai][bj][m][1]; u32x4 w; w.x = cvtpk(a[0], a[1]); w.y = cvtpk(a[2], a[3]); w.z = cvtpk(b[0], b[1]); w.w = cvtpk(b[2], b[3]); *(GAS u32x4*)(vp + 32 * bj) = w; }
                }
        } else if (pn == 3) {
#pragma unroll
            for (int ai = 0; ai < 2; ++ai)
#pragma unroll
                for (int m = 0; m < 4; ++m) {
                    const size_t grow = (size_t)u.pm * 256 + ai * 128 + m * 16 + rbase;
                    bf16_t* p = CB + grow * 256 + 32 * wc + 8 * fq;
#pragma unroll
                    for (int bj = 0; bj < 2; ++bj) { const f32x4 a = acc[ai][bj][m][0], b = acc[ai][bj][m][1]; u32x4 w; w.x = cvtpk(a[0], a[1]); w.y = cvtpk(a[2], a[3]); w.z = cvtpk(b[0], b[1]); w.w = cvtpk(b[2], b[3]); *(GAS u32x4*)(p + 128 * bj) = w; }
                }
        } else if (pn < 6) {
#pragma unroll
            for (int ai = 0; ai < 2; ++ai)
#pragma unroll
                for (int m = 0; m < 4; ++m) {
                    const size_t grow = (size_t)u.pm * 256 + ai * 128 + m * 16 + rbase;
                    bf16_t* p = PB + grow * 256 + 128 * (pn - 4) + 32 * wc + 8 * fq;
                    const f32x4 a = acc[ai][0][m][0] * acc[ai][1][m][0], b = acc[ai][0][m][1] * acc[ai][1][m][1];
                    u32x4 w; w.x = cvtpk(a[0], a[1]); w.y = cvtpk(a[2], a[3]); w.z = cvtpk(b[0], b[1]); w.w = cvtpk(b[2], b[3]); *(GAS u32x4*)p = w;
                }
        } else if (pn < 8) {
            const bool isq = pn == 6;
            const float* gsrc = isq ? dqn_g : dkn_g;
            const int a_ax = fq >> 1, ib = 4 * (fq & 1);
            const float* gp = gsrc + 16 * a_ax + ib;
            const int head = wc;
            const f32x4 g0 = *(const GAS f32x4*)gp, g1 = *(const GAS f32x4*)(gp + 8);
            f32x4 tc[4], ts[4];
#pragma unroll
            for (int j = 0; j < 4; ++j) { const int pos = a_ax ? (16 * j + fr) : ((ti.t0 >> 6) + 2 * (j & 1) + wr); tc[j] = *(const GAS f32x4*)(r32c + pos * 8 + ib); ts[j] = *(const GAS f32x4*)(r32s + pos * 8 + ib); }
            __builtin_amdgcn_sched_group_barrier(0x020, 10, 0);
#pragma unroll
            for (int ai = 0; ai < 2; ++ai) {
                float ss[4][2];
#pragma unroll
                for (int m = 0; m < 4; ++m)
#pragma unroll
                    for (int bj = 0; bj < 2; ++bj) { float t_ = 0.f;
#pragma unroll
                        for (int n = 0; n < 2; ++n) { const f32x4 v = acc[ai][bj][m][n]; t_ += (v[0] * v[0] + v[1] * v[1]) + (v[2] * v[2] + v[3] * v[3]); }
                        ss[m][bj] = t_; }
#pragma unroll
                for (int i = 0; i < 4; ++i) { ss[i][0] += __shfl_xor(ss[i][0], 16); ss[i][1] += __shfl_xor(ss[i][1], 16); }
#pragma unroll
                for (int i = 0; i < 4; ++i) { ss[i][0] += __shfl_xor(ss[i][0], 32); ss[i][1] += __shfl_xor(ss[i][1], 32); }
#pragma unroll
                for (int m = 0; m < 4; ++m) {
                    const int rt = ai * 128 + m * 16 + rbase; const int t = ti.t0 + rt; const size_t grow = (size_t)u.pm * 256 + rt;
                    const f32x4 c4 = a_ax ? tc[m] : tc[ai], s4 = a_ax ? ts[m] : ts[ai];
#pragma unroll
                    for (int bj = 0; bj < 2; ++bj) {
                        const float rstd = rsqrtf(ss[m][bj] * (1.f / 32.f) + EPS);
                        f32x4 y0 = acc[ai][bj][m][0] * rstd * g0, y1 = acc[ai][bj][m][1] * rstd * g1;
                        if (!isq && !ti.lat) {
                            float* o = out + OUT_DK + ((size_t)(ti.seq * 4 + layer) * 256 + t) * 256 + head * 64 + bj * 32 + 16 * a_ax + ib;
                            *(GAS f32x4*)(o) = y0; *(GAS f32x4*)(o + 8) = y1;
                        }
                        if (ti.lat) { const f32x4 o0 = y0 * c4 - y1 * s4, o1 = y1 * c4 + y0 * s4; y0 = o0; y1 = o1; }
                        bf16_t* dst;
                        if (isq) { y0 = y0 * QSCALE_D; y1 = y1 * QSCALE_D; dst = QD + grow * 256 + head * 64 + bj * 32 + 16 * a_ax + 2 * ib; }
                        else dst = KD + ((ti.R * 8 + (long)(head * 2 + bj) * ti.S + t) * 32) + 16 * a_ax + 2 * ib;
                        u32x4 w; w.x = cvtpk(y0[0], y0[1]); w.y = cvtpk(y0[2], y0[3]); w.z = cvtpk(y1[0], y1[1]); w.w = cvtpk(y1[2], y1[3]);
                        *(GAS u32x4*)dst = w;
                    }
                }
                asm volatile("" ::: "memory"); __builtin_amdgcn_sched_barrier(0);
            }
        } else {
            const int head = wc;
#pragma unroll
            for (int ai = 0; ai < 2; ++ai)
#pragma unroll
                for (int m = 0; m < 4; ++m) {
                    const int rt = ai * 128 + m * 16 + rbase; const int t = ti.t0 + rt;
                    if (!ti.lat) {
                        float* o = out + OUT_DV + ((size_t)(ti.seq * 4 + layer) * 256 + t) * 256 + head * 64 + 8 * fq;
#pragma unroll
                        for (int bj = 0; bj < 2; ++bj) { *(GAS f32x4*)(o + 32 * bj) = acc[ai][bj][m][0]; *(GAS f32x4*)(o + 32 * bj + 4) = acc[ai][bj][m][1]; }
                    }
                    bf16_t* vp = VD + ((ti.R * 4 + (long)head * ti.S + t) * 64) + 8 * fq;
#pragma unroll
                    for (int bj = 0; bj < 2; ++bj) { const f32x4 a = acc[ai][bj][m][0], b = acc[ai][bj][m][1]; u32x4 w; w.x = cvtpk(a[0], a[1]); w.y = cvtpk(a[2], a[3]); w.z = cvtpk(b[0], b[1]); w.w = cvtpk(b[2], b[3]); *(GAS u32x4*)(vp + 32 * bj) = w; }
                }
        }
    }
};

__device__ __forceinline__ float dpp_ror1(float x) { return __int_as_float(__builtin_amdgcn_update_dpp(0, __float_as_int(x), 0x121, 0xf, 0xf, false)); }
__device__ __forceinline__ float dpp_ror15(float x) { return __int_as_float(__builtin_amdgcn_update_dpp(0, __float_as_int(x), 0x12F, 0xf, 0xf, false)); }
__device__ __forceinline__ float silu_f(float x) { return x * __builtin_amdgcn_rcpf(1.f + __builtin_amdgcn_exp2f(-x * LOG2E)); }
struct EpiUp {
    const float* cw; const float* cbias; bf16_t* F; float* EP; float* EA; float* EU;
    __device__ __forceinline__ void operator()(const Acc& acc, const pg8::Unit& u, int wr, int wc, int fr, int fq, LAS unsigned char* xlds) const {
        const TileInfo ti(u.pm);
        const int c0 = u.pn * 128 + wc * 32 + 8 * fq;
        LAS float* X = (LAS float*)xlds;
#pragma unroll
        for (int ai = 0; ai < 2; ++ai) {
            if (fr == 0) { LAS float* p = X + ((((ai * 2 + wr) * 4 + wc) * 2 + 0) * 4 + fq) * 8; *(LAS f32x4*)p = acc[ai][0][0][0]; *(LAS f32x4*)(p + 4) = acc[ai][0][0][1]; }
            if (fr == 15) { LAS float* p = X + ((((ai * 2 + wr) * 4 + wc) * 2 + 1) * 4 + fq) * 8; *(LAS f32x4*)p = acc[ai][0][3][0]; *(LAS f32x4*)(p + 4) = acc[ai][0][3][1]; }
        }
        asm volatile("s_waitcnt lgkmcnt(0)" ::: "memory"); __builtin_amdgcn_s_barrier(); asm volatile("" ::: "memory");
        f32x4 w0[2], w1[2], w2[2], bb[2];
#pragma unroll
        for (int n = 0; n < 2; ++n) { w0[n] = *(const GAS f32x4*)(cw + c0 + 4 * n); w1[n] = *(const GAS f32x4*)(cw + DFF + c0 + 4 * n); w2[n] = *(const GAS f32x4*)(cw + 2 * DFF + c0 + 4 * n); bb[n] = *(const GAS f32x4*)(cbias + c0 + 4 * n); }
        const bool has_prev = ti.lat && ti.t0 > 0, has_next = ti.lat && ti.t0 < 4096 - 256;
#pragma unroll
        for (int ai = 0; ai < 2; ++ai) {
            f32x4 pb[2] = {(f32x4){0.f, 0.f, 0.f, 0.f}, (f32x4){0.f, 0.f, 0.f, 0.f}}, nb[2] = {(f32x4){0.f, 0.f, 0.f, 0.f}, (f32x4){0.f, 0.f, 0.f, 0.f}};
            { const int seg = ai * 2 + wr;
              if (seg > 0) { const int ps = seg - 1; LAS float* p = X + ((((ps >> 1) * 2 + (ps & 1)) * 4 + wc) * 2 + 1) * 32 + fq * 8; pb[0] = *(LAS f32x4*)p; pb[1] = *(LAS f32x4*)(p + 4); }
              if (seg < 3) { const int ns = seg + 1; LAS float* p = X + ((((ns >> 1) * 2 + (ns & 1)) * 4 + wc) * 2 + 0) * 32 + fq * 8; nb[0] = *(LAS f32x4*)p; nb[1] = *(LAS f32x4*)(p + 4); } }
#pragma unroll
            for (int m = 0; m < 4; ++m) {
                const int rt = ai * 128 + wr * 64 + m * 16 + fr; const size_t grow = (size_t)u.pm * 256 + rt;
                f32x4 fo[2], cv[2];
#pragma unroll
                for (int n = 0; n < 2; ++n) {
                    const f32x4 a = acc[ai][0][m][n];
                    const f32x4 up = (m > 0) ? acc[ai][0][m > 0 ? m - 1 : 0][n] : pb[n];
                    const f32x4 dn = (m < 3) ? acc[ai][0][m < 3 ? m + 1 : 3][n] : nb[n];
                    f32x4 pv, nx;
#pragma unroll
                    for (int e = 0; e < 4; ++e) {
                        pv[e] = dpp_ror1(fr == 15 ? up[e] : a[e]);
                        nx[e] = dpp_ror15(fr == 0 ? dn[e] : a[e]);
                    }
                    const f32x4 c = w0[n] * pv + w1[n] * a + w2[n] * nx + bb[n];
                    cv[n] = c;
                    const f32x4 uu = acc[ai][1][m][n];
#pragma unroll
                    for (int e = 0; e < 4; ++e) fo[n][e] = silu_f(c[e]) * uu[e];
                }
                u32x4 w; w.x = cvtpk(fo[0][0], fo[0][1]); w.y = cvtpk(fo[0][2], fo[0][3]); w.z = cvtpk(fo[1][0], fo[1][1]); w.w = cvtpk(fo[1][2], fo[1][3]);
                *(GAS u32x4*)(F + grow * DFF + c0) = w;
                if (ai == 0 && m == 0) { if (has_prev && rt == 0) { const size_t eo = ((size_t)u.pm * 2 + 0) * DFF + c0;
                        *(GAS f32x4*)(EP + eo) = cv[0]; *(GAS f32x4*)(EP + eo + 4) = cv[1]; *(GAS f32x4*)(EA + eo) = acc[0][0][0][0]; *(GAS f32x4*)(EA + eo + 4) = acc[0][0][0][1]; *(GAS f32x4*)(EU + eo) = acc[0][1][0][0]; *(GAS f32x4*)(EU + eo + 4) = acc[0][1][0][1]; } }
                if (ai == 1 && m == 3) { if (has_next && rt == 255) { const size_t eo = ((size_t)u.pm * 2 + 1) * DFF + c0;
                        *(GAS f32x4*)(EP + eo) = cv[0]; *(GAS f32x4*)(EP + eo + 4) = cv[1]; *(GAS f32x4*)(EA + eo) = acc[1][0][3][0]; *(GAS f32x4*)(EA + eo + 4) = acc[1][0][3][1]; *(GAS f32x4*)(EU + eo) = acc[1][1][3][0]; *(GAS f32x4*)(EU + eo + 4) = acc[1][1][3][1]; } }
            }
        }
        asm volatile("s_waitcnt lgkmcnt(0)" ::: "memory"); __builtin_amdgcn_s_barrier(); asm volatile("" ::: "memory");
    }
};

typedef short v4i16_t __attribute__((ext_vector_type(4)));
__device__ __forceinline__ s16x4 vtr(LAS const char* p) { return __builtin_bit_cast(s16x4, __builtin_amdgcn_ds_read_tr16_b64_v4i16((LAS v4i16_t*)p)); }
__device__ __forceinline__ float xhalf_max(float m) { auto rr = __builtin_amdgcn_permlane32_swap(__float_as_uint(m), __float_as_uint(m), false, false); return fmaxf(__uint_as_float(rr[0]), __uint_as_float(rr[1])); }
__device__ __forceinline__ float xhalf_sum(float m) { auto rr = __builtin_amdgcn_permlane32_swap(__float_as_uint(m), __float_as_uint(m), false, false); return __uint_as_float(rr[0]) + __uint_as_float(rr[1]); }

constexpr int ATT_VS = 192;
constexpr float ATT_THR = 8.f;
#define MX3(a, b, c) __builtin_fmaxf(__builtin_fmaxf((a), (b)), (c))
template <int DQK, bool YORD>
__device__ __forceinline__ void flash_pass(const bf16_t* __restrict__ Qw, int qpitch, const bf16_t* __restrict__ Kg, const bf16_t* __restrict__ Vg, int NT, int tst,
                                           LAS char* lds, f32x16 (&o)[2], float& lsum) {
#define ATT_TI(T) (((T) + tst) < NT ? ((T) + tst) : ((T) + tst - NT))
    constexpr int KS = DQK * 2 + 16, KBUF = 64 * KS, VBUF = 64 * ATT_VS, NDS = DQK / 16;
    constexpr int KROWB = DQK * 2;
    const int tid = opaque_tid(), lane = tid & 63, r32 = lane & 31, h = lane >> 5;
    LAS char* Kb = lds; LAS char* Vb = lds + 2 * KBUF;
    bf16x8 qf[NDS];
#pragma unroll
    for (int ds = 0; ds < NDS; ++ds) qf[ds] = *(const GAS bf16x8*)(Qw + (size_t)r32 * qpitch + 16 * ds + 8 * h);
    const bool kload = (tid * 16) < 64 * KROWB;
    const int krow = (tid * 16) / KROWB, kcb = (tid * 16) % KROWB;
    const int kdst = krow * KS + kcb, vdst = (tid >> 3) * ATT_VS + (tid & 7) * 16;
    const char* kg = (const char*)Kg + tid * 16; const char* vg = (const char*)Vg + tid * 16;
    u32x4 kreg = {0, 0, 0, 0}, vreg;
    {
        u32x4 k1 = {0, 0, 0, 0};
        if (kload) { kreg = *(const GAS u32x4*)(kg + (size_t)ATT_TI(0) * 64 * KROWB); k1 = *(const GAS u32x4*)(kg + (size_t)ATT_TI(1) * 64 * KROWB); }
        vreg = *(const GAS u32x4*)(vg + (size_t)ATT_TI(0) * 64 * 128);
        if (kload) { *(LAS u32x4*)(Kb + kdst) = kreg; *(LAS u32x4*)(Kb + KBUF + kdst) = k1; }
        *(LAS u32x4*)(Vb + vdst) = vreg;
        *(LAS u32x4*)(Vb + 2 * VBUF + vdst) = (u32x4){0, 0, 0, 0};
    }
    __syncthreads();
    const int kfo = r32 * KS + h * 16;
    const int vfo = (4 * h + ((lane & 15) >> 2)) * ATT_VS + (((lane >> 4) & 1) * 16 + (lane & 3) * 4) * 2;
    f32x16 p0 = (f32x16){}, p1 = (f32x16){};
#pragma unroll
    for (int ds = 0; ds < NDS; ++ds) {
        const bf16x8 k0 = *(LAS const bf16x8*)(Kb + kfo + ds * 32), k1 = *(LAS const bf16x8*)(Kb + kfo + 32 * KS + ds * 32);
        p0 = __builtin_amdgcn_mfma_f32_32x32x16_bf16(k0, qf[ds], p0, 0, 0, 0);
        p1 = __builtin_amdgcn_mfma_f32_32x32x16_bf16(k1, qf[ds], p1, 0, 0, 0);
    }
    __syncthreads();
    float mref, l = 0.f;
    {
        float a = MX3(p0[0], p0[1], p1[0]), b = MX3(p0[2], p0[3], p1[1]); a = MX3(a, p1[2], p1[3]);
#pragma unroll
        for (int r = 4; r < 16; r += 4) { a = MX3(a, p0[r], p0[r + 1]); b = MX3(b, p0[r + 2], p0[r + 3]); a = MX3(a, p1[r], p1[r + 1]); b = MX3(b, p1[r + 2], p1[r + 3]); }
        mref = xhalf_max(fmaxf(a, b));
#pragma unroll
        for (int r = 0; r < 16; ++r) { p0[r] -= mref; p1[r] -= mref; }
    }
    f32x16 negm;
#pragma unroll
    for (int r = 0; r < 16; ++r) negm[r] = -mref;
    asm volatile("" : "+v"(negm));
    o[0] = (f32x16){}; o[1] = (f32x16){};
    bf16x8 pk[4] = {};
    int vs_prev = 2 * VBUF, vs_cur = 0, vs_next = VBUF;
#define ATT_MPART(N0, N1, T) do { \
        LAS const char* kb_ = Kb + ((((T) + 1) & 1) * KBUF) + kfo; LAS const char* vb_ = Vb + vs_prev + vfo; \
        bf16x8 kf_[2 * NDS]; s16x4 vl_[8], vh_[8]; \
        _Pragma("unroll") for (int ds = 0; ds < NDS; ++ds) { kf_[2 * ds] = *(LAS const bf16x8*)(kb_ + ds * 32); kf_[2 * ds + 1] = *(LAS const bf16x8*)(kb_ + 32 * KS + ds * 32); } \
        _Pragma("unroll") for (int s_ = 0; s_ < 4; ++s_) { _Pragma("unroll") for (int db_ = 0; db_ < 2; ++db_) { \
            vl_[2 * s_ + db_] = vtr(vb_ + (16 * s_) * ATT_VS + db_ * 64); vh_[2 * s_ + db_] = vtr(vb_ + (16 * s_ + 8) * ATT_VS + db_ * 64); } } \
        N0 = __builtin_amdgcn_mfma_f32_32x32x16_bf16(kf_[0], qf[0], negm, 0, 0, 0); N1 = __builtin_amdgcn_mfma_f32_32x32x16_bf16(kf_[1], qf[0], negm, 0, 0, 0); \
        _Pragma("unroll") for (int ds = 1; ds < NDS; ++ds) { \
            N0 = __builtin_amdgcn_mfma_f32_32x32x16_bf16(kf_[2 * ds], qf[ds], N0, 0, 0, 0); N1 = __builtin_amdgcn_mfma_f32_32x32x16_bf16(kf_[2 * ds + 1], qf[ds], N1, 0, 0, 0); } \
        _Pragma("unroll") for (int s_ = 0; s_ < 4; ++s_) { _Pragma("unroll") for (int db_ = 0; db_ < 2; ++db_) { \
            const bf16x8 vf_ = __builtin_shufflevector(vl_[2 * s_ + db_], vh_[2 * s_ + db_], 0, 1, 2, 3, 4, 5, 6, 7); \
            o[db_] = __builtin_amdgcn_mfma_f32_32x32x16_bf16(vf_, pk[s_], o[db_], 0, 0, 0); } } \
        __builtin_amdgcn_sched_group_barrier(0x100, 2 * NDS + 8, 0); __builtin_amdgcn_sched_group_barrier(0x008, 2 * NDS, 0); \
        __builtin_amdgcn_sched_group_barrier(0x100, 8, 0); __builtin_amdgcn_sched_group_barrier(0x008, 8, 0); } while (0)
#define ATT_VPART(P0, P1, N0, N1) do { \
        float a = MX3(P0[0], P0[1], P1[0]), b = MX3(P0[2], P0[3], P1[1]); a = MX3(a, P1[2], P1[3]); \
        _Pragma("unroll") for (int r = 4; r < 16; r += 4) { a = MX3(a, P0[r], P0[r + 1]); b = MX3(b, P0[r + 2], P0[r + 3]); a = MX3(a, P1[r], P1[r + 1]); b = MX3(b, P1[r + 2], P1[r + 3]); } \
        const float mt = xhalf_max(fmaxf(a, b)); \
        resc = __any(mt > ATT_THR); \
        if (__builtin_expect(resc, 0)) { \
            const float dl = fmaxf(mt, 0.f); mref += dl; fsc = __builtin_amdgcn_exp2f(-dl); l *= fsc; \
            _Pragma("unroll") for (int r = 0; r < 16; ++r) { P0[r] -= dl; P1[r] -= dl; } \
            if (!YORD) { _Pragma("unroll") for (int r = 0; r < 16; ++r) { N0[r] -= dl; N1[r] -= dl; o[0][r] *= fsc; o[1][r] *= fsc; } } \
            _Pragma("unroll") for (int r = 0; r < 16; ++r) negm[r] = -mref; \
            asm volatile("" : "+v"(negm)); } \
        float ps0 = 0.f, ps1 = 0.f; \
        _Pragma("unroll") for (int r = 0; r < 16; ++r) { P0[r] = __builtin_amdgcn_exp2f(P0[r]); P1[r] = __builtin_amdgcn_exp2f(P1[r]); ps0 += P0[r]; ps1 += P1[r]; } \
        l += ps0 + ps1; \
        _Pragma("unroll") for (int s = 0; s < 2; ++s) { u32x4 a4, b4; \
            a4.x = cvtpk(P0[8 * s + 0], P0[8 * s + 1]); a4.y = cvtpk(P0[8 * s + 2], P0[8 * s + 3]); a4.z = cvtpk(P0[8 * s + 4], P0[8 * s + 5]); a4.w = cvtpk(P0[8 * s + 6], P0[8 * s + 7]); \
            b4.x = cvtpk(P1[8 * s + 0], P1[8 * s + 1]); b4.y = cvtpk(P1[8 * s + 2], P1[8 * s + 3]); b4.z = cvtpk(P1[8 * s + 4], P1[8 * s + 5]); b4.w = cvtpk(P1[8 * s + 6], P1[8 * s + 7]); \
            pkn[s] = __builtin_bit_cast(bf16x8, a4); pkn[2 + s] = __builtin_bit_cast(bf16x8, b4); } } while (0)
#define ATT_STEP(P0, P1, N0, N1, T) do { \
        const bool more = (T) + 1 < NT, more2 = (T) + 2 < NT; \
        if (more2 && kload) kreg = *(const GAS u32x4*)(kg + (size_t)ATT_TI((T) + 2) * 64 * KROWB); \
        if (more) vreg = *(const GAS u32x4*)(vg + (size_t)ATT_TI((T) + 1) * 64 * 128); \
        float fsc = 1.f; bool resc; bf16x8 pkn[4]; \
        if (!YORD) { ATT_MPART(N0, N1, T); __builtin_amdgcn_sched_barrier(0); ATT_VPART(P0, P1, N0, N1); } \
        else { ATT_VPART(P0, P1, N0, N1); __builtin_amdgcn_sched_barrier(0); ATT_MPART(N0, N1, T); \
            if (__builtin_expect(resc, 0)) { _Pragma("unroll") for (int r = 0; r < 16; ++r) { o[0][r] *= fsc; o[1][r] *= fsc; } } } \
        _Pragma("unroll") for (int s = 0; s < 4; ++s) pk[s] = pkn[s]; \
        if (more2 && kload) *(LAS u32x4*)(Kb + ((T) & 1) * KBUF + kdst) = kreg; \
        if (more) *(LAS u32x4*)(Vb + vs_next + vdst) = vreg; \
        __syncthreads(); \
        vs_prev = vs_cur; vs_cur = vs_next; vs_next = (vs_next == 2 * VBUF) ? 0 : vs_next + VBUF; } while (0)
    f32x16 n0, n1;
    for (int t = 0; t < NT; t += 2) {
        ATT_STEP(p0, p1, n0, n1, t);
        ATT_STEP(n0, n1, p0, p1, t + 1);
    }
    {
        LAS const char* vb_ = Vb + vs_prev + vfo;
#pragma unroll
        for (int s_ = 0; s_ < 4; ++s_) {
#pragma unroll
            for (int db_ = 0; db_ < 2; ++db_) {
                const s16x4 lo_ = vtr(vb_ + (16 * s_) * ATT_VS + db_ * 64), hi_ = vtr(vb_ + (16 * s_ + 8) * ATT_VS + db_ * 64);
                const bf16x8 vf_ = __builtin_shufflevector(lo_, hi_, 0, 1, 2, 3, 4, 5, 6, 7);
                o[db_] = __builtin_amdgcn_mfma_f32_32x32x16_bf16(vf_, pk[s_], o[db_], 0, 0, 0);
            }
        }
    }
    __syncthreads();
#undef ATT_STEP
#undef ATT_TI
#undef ATT_VPART
#undef ATT_MPART
    lsum = xhalf_sum(l);
}

__device__ __forceinline__ void store_ot(const f32x16 (&o)[2], bf16_t* dst  , int h) {
#pragma unroll
    for (int db = 0; db < 2; ++db)
#pragma unroll
        for (int g = 0; g < 4; ++g) { u32x2 w; w.x = cvtpk(o[db][4 * g], o[db][4 * g + 1]); w.y = cvtpk(o[db][4 * g + 2], o[db][4 * g + 3]); *(GAS u32x2*)(dst + 32 * db + 8 * g + 4 * h) = w; }
}

#include <hip/hip_bf16.h>
namespace attn64 {
using bf16=__hip_bfloat16;
using bf16x8=__attribute__((ext_vector_type(8)))short;
using s16x4=__attribute__((ext_vector_type(4)))short;
using f32x16=__attribute__((ext_vector_type(16)))float;
using u32x4=__attribute__((ext_vector_type(4)))unsigned;
constexpr int D=64;
constexpr int NW=8,QBLK=32,QB=QBLK*NW,KVBLK=64;

__device__ __forceinline__ int crow(int r,int hi){return (r&3)+8*(r>>2)+4*hi;}
#define SBAR() __builtin_amdgcn_sched_barrier(0)
__device__ __forceinline__ void cmask(f32x16&p0,f32x16&p1,int jb,int qrel,int hi){
  const float NEG=-INFINITY; int kb=64*jb+4*hi;
  #pragma unroll
  for(int r=0;r<16;++r){int kv=kb+(r&3)+8*(r>>2); if(kv>qrel)p0[r]=NEG; if(kv+32>qrel)p1[r]=NEG;}
}

constexpr int NSLOT=3, SLOTB=8192;
constexpr int LDS_K=0, LDS_V=NSLOT*SLOTB, LDS_WS=2*NSLOT*SLOTB, LDS_OST=LDS_WS+NW*64*4, LDS_BYTES=LDS_OST+NW*4096;
constexpr float C2=0.125f*1.4426950408889634f;
__device__ __forceinline__ void glds16(const void*gsrc,unsigned lds_dst){unsigned keep;
  asm volatile("s_mov_b32 %0, m0\n\ts_mov_b32 m0, %2\n\ts_nop 0\n\tglobal_load_lds_dwordx4 %1, off\n\ts_mov_b32 m0, %0":"=&s"(keep):"v"(gsrc),"s"(lds_dst):"memory");}
__device__ __forceinline__ float max3f(float a,float b,float c){float r;asm("v_max3_f32 %0, %1, %2, %3":"=v"(r):"v"(a),"v"(b),"v"(c));return r;}
__device__ __forceinline__ float max2f(float a,float b){float r;asm("v_max_f32_e32 %0, %1, %2":"=v"(r):"v"(a),"v"(b));return r;}
__device__ __forceinline__ float fadd_s(float a,float b){float r;asm("v_add_f32_e32 %0, %1, %2":"=v"(r):"v"(a),"v"(b));return r;}
__device__ __forceinline__ float fsub_s(float a,float b){float r;asm("v_sub_f32_e32 %0, %1, %2":"=v"(r):"v"(a),"v"(b));return r;}
typedef float f32x2_t __attribute__((ext_vector_type(2))); typedef __bf16 bf16x2_t __attribute__((ext_vector_type(2)));
__device__ __forceinline__ unsigned cvtpk_s(float lo,float hi){f32x2_t v={lo,hi};bf16x2_t b=__builtin_convertvector(v,bf16x2_t);return __builtin_bit_cast(unsigned,b);}
#define WAIT_BAR(N) asm volatile("s_waitcnt vmcnt(" #N ") lgkmcnt(0)\n\ts_barrier":::"memory")

template<int NDS_> __device__ __forceinline__ void qkt(f32x16&p0,f32x16&p1,const char*Kslot,const bf16x8*qr,const f32x16&negm,int r32,int hi){
  const char*kb=Kslot+hi*1024+r32*16;
  #pragma unroll
  for(int d0=0;d0<NDS_;++d0){
    const bf16x8 b0=*reinterpret_cast<const bf16x8*>(kb+d0*2048);
    const bf16x8 b1=*reinterpret_cast<const bf16x8*>(kb+d0*2048+512);
    if(d0==0){p0=__builtin_amdgcn_mfma_f32_32x32x16_bf16(b0,qr[0],negm,0,0,0);p1=__builtin_amdgcn_mfma_f32_32x32x16_bf16(b1,qr[0],negm,0,0,0);}
    else{p0=__builtin_amdgcn_mfma_f32_32x32x16_bf16(b0,qr[d0],p0,0,0,0);p1=__builtin_amdgcn_mfma_f32_32x32x16_bf16(b1,qr[d0],p1,0,0,0);}}
}
typedef __attribute__((address_space(3))) const char* lds_cptr;
typedef short v4i16_t __attribute__((ext_vector_type(4)));
__device__ __forceinline__ void kload8(bf16x8*kf,lds_cptr kp){
  kf[0]=*(const __attribute__((address_space(3))) bf16x8*)(kp);      kf[1]=*(const __attribute__((address_space(3))) bf16x8*)(kp+512);
  kf[2]=*(const __attribute__((address_space(3))) bf16x8*)(kp+2048); kf[3]=*(const __attribute__((address_space(3))) bf16x8*)(kp+2560);
  kf[4]=*(const __attribute__((address_space(3))) bf16x8*)(kp+4096); kf[5]=*(const __attribute__((address_space(3))) bf16x8*)(kp+4608);
  kf[6]=*(const __attribute__((address_space(3))) bf16x8*)(kp+6144); kf[7]=*(const __attribute__((address_space(3))) bf16x8*)(kp+6656);
}
__device__ __forceinline__ void kload2(bf16x8*kf,lds_cptr kp,int j){ kf[2*j]=*(const __attribute__((address_space(3))) bf16x8*)(kp+j*2048); kf[2*j+1]=*(const __attribute__((address_space(3))) bf16x8*)(kp+j*2048+512); }
__device__ __forceinline__ s16x4 vtr(lds_cptr p){ return __builtin_bit_cast(s16x4,__builtin_amdgcn_ds_read_tr16_b64_v4i16((__attribute__((address_space(3))) v4i16_t*)p)); }
__device__ __forceinline__ float rowmax(const f32x16&p0,const f32x16&p1){
  float a=max3f(p0[0],p0[1],p1[0]),b=max3f(p0[2],p0[3],p1[1]);a=max3f(a,p1[2],p1[3]);
  #pragma unroll
  for(int r=4;r<16;r+=4){a=max3f(a,p0[r],p0[r+1]);b=max3f(b,p0[r+2],p0[r+3]);a=max3f(a,p1[r],p1[r+1]);b=max3f(b,p1[r+2],p1[r+3]);}
  const float m=max2f(a,b);
  auto rr=__builtin_amdgcn_permlane32_swap(__float_as_uint(m),__float_as_uint(m),false,false);
  return max2f(__uint_as_float(rr[0]),__uint_as_float(rr[1]));
}
__device__ __forceinline__ void pv(f32x16*o,int vb,bf16x8 pa0,bf16x8 pa1,bf16x8 pa2,bf16x8 pa3){
  #pragma unroll
  for(int d0=0;d0<2;++d0){s16x4 lo[4],hi[4];
    #pragma unroll
    for(int ks=0;ks<4;++ks){
      asm volatile("ds_read_b64_tr_b16 %0,%1 offset:%c2":"=&v"(lo[ks]):"v"(vb),"i"(d0*4096+ks*1024):"memory");
      asm volatile("ds_read_b64_tr_b16 %0,%1 offset:%c2":"=&v"(hi[ks]):"v"(vb),"i"(d0*4096+ks*1024+512):"memory");}
    asm volatile("s_waitcnt lgkmcnt(0)":::"memory");SBAR();
    #define PK(k) (bf16x8){lo[k][0],lo[k][1],lo[k][2],lo[k][3],hi[k][0],hi[k][1],hi[k][2],hi[k][3]}
    o[d0]=__builtin_amdgcn_mfma_f32_32x32x16_bf16(pa0,PK(0),o[d0],0,0,0);
    o[d0]=__builtin_amdgcn_mfma_f32_32x32x16_bf16(pa1,PK(1),o[d0],0,0,0);
    o[d0]=__builtin_amdgcn_mfma_f32_32x32x16_bf16(pa2,PK(2),o[d0],0,0,0);
    o[d0]=__builtin_amdgcn_mfma_f32_32x32x16_bf16(pa3,PK(3),o[d0],0,0,0);
    #undef PK
  }
}

#ifndef ATTN_STORE16
#define ATTN_STORE16(p,v) (*(GAS u32x4*)(p)=(v))
#endif
__device__ __forceinline__ void stage_store(const f32x16 (&o)[2],bf16*Ow,int op,char*shm,int wid,int lane,int r32,int hi){
  bf16*stg=(bf16*)(shm+LDS_OST)+wid*2048;
  #pragma unroll
  for(int r=0;r<16;++r){const int orow=crow(r,hi);
    #pragma unroll
    for(int d0=0;d0<2;++d0)stg[orow*64+d0*32+r32]=__float2bfloat16(o[d0][r]);}
  asm volatile("s_waitcnt lgkmcnt(0)":::"memory");
  #pragma unroll
  for(int i=0;i<4;++i){const int row=i*8+(lane>>3),ch=lane&7; const u32x4 v=*(const u32x4*)(stg+row*64+ch*8); ATTN_STORE16(Ow+(long)row*op+ch*8,v);}
}
template<int THRL,int MODE,int DQ> __device__ __forceinline__ void attn_unit(const bf16*Qw0,int qp,const bf16*__restrict__ Kh,int kp,const bf16*__restrict__ Vh,int vp,int NT,bf16*Ow0,int op,char*shm,f32x16 (&oret)[2]){
  constexpr int NDS=DQ/16;
  const int tid=opaque_tid(),lane=tid&63,r32=lane&31,hi=lane>>5; const int wid=__builtin_amdgcn_readfirstlane(tid>>6);
  const bf16*Qw=Qw0+(long)(wid*QBLK)*qp;
  const unsigned lds0=(unsigned)(uintptr_t)shm;
  float*wsf=(float*)(shm+LDS_WS)+wid*64;
  const int kch=(DQ==64)?wid:(wid&3);
  const bf16*ksrc=Kh+(long)lane*kp+kch*8;
  const bf16*vsrc=Vh+(long)(16*(wid&3)+(lane>>2))*vp+(wid>>2)*32+(lane&3)*8;
  const unsigned kdst=lds0+LDS_K+kch*1024, vdst=lds0+LDS_V+wid*1024;
  #define DMA_K(t,slot) glds16(ksrc+(long)(t)*KVBLK*kp,(unsigned)__builtin_amdgcn_readfirstlane(kdst+(slot)))
  #define DMA_V(t,slot) glds16(vsrc+(long)(t)*KVBLK*vp,(unsigned)__builtin_amdgcn_readfirstlane(vdst+(slot)))
  const int vb0=(int)(lds0+LDS_V)+((lane>>4)&1)*32+(lane&3)*8+(4*hi+((lane&15)>>2))*64;
  const char*Kbase=shm+LDS_K; bf16x8 kf[8];
  const lds_cptr shm3=(lds_cptr)shm; const lds_cptr kp0=shm3+LDS_K+hi*1024+r32*16; const lds_cptr vp0=shm3+LDS_V+((lane>>4)&1)*32+(lane&3)*8+(4*hi+((lane&15)>>2))*64;
  DMA_K(0,0);DMA_V(0,0);DMA_K(1,SLOTB);
  bf16x8 qr[4];
  #pragma unroll
  for(int d0=0;d0<NDS;++d0)qr[d0]=*(const GAS bf16x8*)(&Qw[(long)r32*qp+d0*16+hi*8]);
  float mhat=0.f,l_reg=0.f;f32x16 o[2];o[0]=f32x16{};o[1]=f32x16{};f32x16 negm=f32x16{};asm volatile("":"+v"(negm));
  #define CMASK(P0,P1,t) do{}while(0)
  bool resc=false;
  #define START(P0,P1) do{ const float rm=rowmax(P0,P1); resc=false; \
    { const float dl=rm; mhat=fadd_s(mhat,dl); \
      _Pragma("unroll") for(int r=0;r<16;++r){P0[r]=fsub_s(P0[r],dl);P1[r]=fsub_s(P1[r],dl);} \
      _Pragma("unroll") for(int r=0;r<16;++r)negm[r]=-mhat; asm volatile("":"+v"(negm)); } \
    _Pragma("unroll") for(int r=0;r<16;++r)P0[r]=__builtin_amdgcn_exp2f(P0[r]); }while(0)
  #define RESC() do{ if(resc){ asm volatile("s_waitcnt lgkmcnt(0)":::"memory"); \
      _Pragma("unroll") for(int d_=0;d_<2;++d_) _Pragma("unroll") for(int r=0;r<16;++r)o[d_][r]*=wsf[crow(r,hi)]; } }while(0)
  f32x16 pA0,pA1,pB0,pB1;
  int sl_prev=0,sl_cur=0,sl_next=SLOTB;
  #define ROT() do{sl_prev=sl_cur;sl_cur=sl_next;sl_next=(sl_next==(NSLOT-1)*SLOTB)?0:sl_next+SLOTB;}while(0)
  DMA_K(2,2*SLOTB);
  WAIT_BAR(3);
  qkt<NDS>(pA0,pA1,Kbase,qr,negm,r32,hi);asm volatile("s_nop 15\n\ts_nop 7":"+v"(pA0),"+v"(pA1));CMASK(pA0,pA1,0);
  START(pA0,pA1);
  _Pragma("unroll") for(int r=0;r<16;++r)pA1[r]=__builtin_amdgcn_exp2f(pA1[r]);
  WAIT_BAR(0);
  DMA_K(3,0);DMA_V(1,SLOTB);
  ROT();
  if constexpr(DQ==64) kload8(kf,kp0+sl_cur); else { kload2(kf,kp0+sl_cur,0); kload2(kf,kp0+sl_cur,1); }
  WAIT_BAR(2);
  s16x4 vlo[8],vhi[8]; u32x4 pw0,pw1,pw2,pw3;
  #define PKW(P,B) cvtpk_s(P[B],P[B+1])
  #define PAF(k) __builtin_bit_cast(bf16x8,pw##k)
  #define VFR(i) (bf16x8){vlo[i][0],vlo[i][1],vlo[i][2],vlo[i][3],vhi[i][0],vhi[i][1],vhi[i][2],vhi[i][3]}
  #define PIN(x) asm volatile("":"+v"(x))
  #define MX3(a,b,c) __builtin_fmaxf(__builtin_fmaxf((a),(b)),(c))
  #define GAPA(MF,A0,A1,A2,A3,W0,W1,PW) do{ MF; sacc+=A0; sacc+=A1; sacc+=A2; sacc+=A3; PIN(sacc); W0; W1; PIN(PW); SBAR(); }while(0)
  #define EX(v) __builtin_amdgcn_exp2f(v)
  #define GAPB(MF,X,B) do{ MF; X[B]=EX(X[B]); X[B+1]=EX(X[B+1]); X[B+2]=EX(X[B+2]); X[B+3]=EX(X[B+3]); PIN(X); SBAR(); }while(0)
  #define VRD(i) do{ vlo[i]=vtr(vp_+(((i)>>2)*4096+((i)&3)*1024)); vhi[i]=vtr(vp_+(((i)>>2)*4096+((i)&3)*1024+512)); }while(0)
  #define KRD(G,j) do{ if(G){ kload2(kf,kp0+sl_next,j); SBAR(); } }while(0)
  #define STEP(C0,C1,P0,P1,t,GK,GV,GL) do{ SBAR(); \
    const lds_cptr vp_=vp0+sl_prev; \
    VRD(0); SBAR(); float sacc=(P0[0]+P0[1]); \
    GAPA(C0=__builtin_amdgcn_mfma_f32_32x32x16_bf16(kf[0],qr[0],negm,0,0,0), P0[2],P0[3],P0[4],P0[5],     pw0[0]=PKW(P0,0), pw0[1]=PKW(P0,2), pw0); \
    VRD(4); SBAR(); GAPA(C1=__builtin_amdgcn_mfma_f32_32x32x16_bf16(kf[1],qr[0],negm,0,0,0), P0[6],P0[7],P0[8],P0[9],     pw0[2]=PKW(P0,4), pw0[3]=PKW(P0,6), pw0); \
    VRD(1); SBAR(); GAPA(C0=__builtin_amdgcn_mfma_f32_32x32x16_bf16(kf[2],qr[1],C0,0,0,0),   P0[10],P0[11],P0[12],P0[13], pw1[0]=PKW(P0,8), pw1[1]=PKW(P0,10), pw1); \
    VRD(5); SBAR(); GAPA(C1=__builtin_amdgcn_mfma_f32_32x32x16_bf16(kf[3],qr[1],C1,0,0,0),   P0[14],P0[15],P1[0],P1[1],   pw1[2]=PKW(P0,12),pw1[3]=PKW(P0,14), pw1); \
    VRD(2); SBAR(); GAPA(if constexpr(DQ==64) C0=__builtin_amdgcn_mfma_f32_32x32x16_bf16(kf[4],qr[2],C0,0,0,0),   P1[2],P1[3],P1[4],P1[5],     pw2[0]=PKW(P1,0), pw2[1]=PKW(P1,2), pw2); \
    VRD(6); SBAR(); GAPA(if constexpr(DQ==64) C1=__builtin_amdgcn_mfma_f32_32x32x16_bf16(kf[5],qr[2],C1,0,0,0),   P1[6],P1[7],P1[8],P1[9],     pw2[2]=PKW(P1,4), pw2[3]=PKW(P1,6), pw2); \
    VRD(3); SBAR(); GAPA(if constexpr(DQ==64) C0=__builtin_amdgcn_mfma_f32_32x32x16_bf16(kf[6],qr[3],C0,0,0,0),   P1[10],P1[11],P1[12],P1[13], pw3[0]=PKW(P1,8), pw3[1]=PKW(P1,10), pw3); \
    VRD(7); SBAR(); GAPA(if constexpr(DQ==64) C1=__builtin_amdgcn_mfma_f32_32x32x16_bf16(kf[7],qr[3],C1,0,0,0),   P1[14],P1[15],0.f,0.f,       pw3[2]=PKW(P1,12),pw3[3]=PKW(P1,14), pw3); \
    l_reg+=sacc; \
    if(GK){DMA_K((t)+3,sl_cur);} if(GV){DMA_V((t)+1,sl_next);} \
    CMASK(C0,C1,t); \
    { float a=MX3(C0[0],C0[1],C1[0]),b=MX3(C0[2],C0[3],C1[1]); a=MX3(a,C1[2],C1[3]); \
      _Pragma("unroll") for(int r=4;r<16;r+=4){a=MX3(a,C0[r],C0[r+1]);b=MX3(b,C0[r+2],C0[r+3]);a=MX3(a,C1[r],C1[r+1]);b=MX3(b,C1[r+2],C1[r+3]);} \
      float rm=__builtin_fmaxf(a,b); { auto rr=__builtin_amdgcn_permlane32_swap(__float_as_uint(rm),__float_as_uint(rm),false,false); rm=__builtin_fmaxf(__uint_as_float(rr[0]),__uint_as_float(rr[1])); } \
      resc=false; \
      if(__builtin_expect(__any(rm>(float)THRL),0)){ const float dl=__builtin_fmaxf(rm,0.f); mhat+=dl; \
        _Pragma("unroll") for(int r=0;r<16;++r){C0[r]-=dl;C1[r]-=dl;} \
        _Pragma("unroll") for(int r=0;r<16;++r)negm[r]=-mhat; asm volatile("":"+v"(negm)); \
        const float f=__builtin_amdgcn_exp2f(-dl); l_reg*=f; if(hi==0)wsf[r32]=f; resc=true; } } \
    SBAR(); \
    GAPB(o[0]=__builtin_amdgcn_mfma_f32_32x32x16_bf16(PAF(0),VFR(0),o[0],0,0,0), C0,0); \
    GAPB(o[1]=__builtin_amdgcn_mfma_f32_32x32x16_bf16(PAF(0),VFR(4),o[1],0,0,0), C0,4); \
    KRD(GL,0); GAPB(o[0]=__builtin_amdgcn_mfma_f32_32x32x16_bf16(PAF(1),VFR(1),o[0],0,0,0), C0,8); \
    KRD(GL,1); GAPB(o[1]=__builtin_amdgcn_mfma_f32_32x32x16_bf16(PAF(1),VFR(5),o[1],0,0,0), C0,12); \
    if constexpr(DQ==64) KRD(GL,2); GAPB(o[0]=__builtin_amdgcn_mfma_f32_32x32x16_bf16(PAF(2),VFR(2),o[0],0,0,0), C1,0); \
    if constexpr(DQ==64) KRD(GL,3); GAPB(o[1]=__builtin_amdgcn_mfma_f32_32x32x16_bf16(PAF(2),VFR(6),o[1],0,0,0), C1,4); \
    GAPB(o[0]=__builtin_amdgcn_mfma_f32_32x32x16_bf16(PAF(3),VFR(3),o[0],0,0,0), C1,8); \
    GAPB(o[1]=__builtin_amdgcn_mfma_f32_32x32x16_bf16(PAF(3),VFR(7),o[1],0,0,0), C1,12); \
    }while(0)
  int t=1;
  #undef CMASK
  #define CMASK(P0,P1,t) do{}while(0)
  for(;t+5<NT;t+=2){
    STEP(pB0,pB1,pA0,pA1,t,true,true,true);     WAIT_BAR(2); RESC(); ROT();
    STEP(pA0,pA1,pB0,pB1,t+1,true,true,true);   WAIT_BAR(2); RESC(); ROT();
  }
  #undef CMASK
  #define CMASK(P0,P1,t) do{}while(0)
  #define ENDW(tt) do{ if((tt)+3<NT){WAIT_BAR(2);} else if((tt)+2<NT){WAIT_BAR(1);} else {WAIT_BAR(0);} }while(0)
  for(;t+1<NT;t+=2){
    STEP(pB0,pB1,pA0,pA1,t,(t+3<NT),(t+1<NT),(t+1<NT));       ENDW(t);   RESC(); ROT();
    STEP(pA0,pA1,pB0,pB1,t+1,(t+4<NT),(t+2<NT),(t+2<NT));     ENDW(t+1); RESC(); ROT();
  }
  STEP(pB0,pB1,pA0,pA1,NT-1,false,false,false); RESC();
  { float sacc=pB0[0]+pB0[1]; _Pragma("unroll") for(int r=2;r<16;++r)sacc+=pB0[r]; _Pragma("unroll") for(int r=0;r<16;++r)sacc+=pB1[r]; l_reg+=sacc;
    pw0=(u32x4){PKW(pB0,0),PKW(pB0,2),PKW(pB0,4),PKW(pB0,6)};pw1=(u32x4){PKW(pB0,8),PKW(pB0,10),PKW(pB0,12),PKW(pB0,14)};pw2=(u32x4){PKW(pB1,0),PKW(pB1,2),PKW(pB1,4),PKW(pB1,6)};pw3=(u32x4){PKW(pB1,8),PKW(pB1,10),PKW(pB1,12),PKW(pB1,14)};
    SBAR(); pv(o,vb0+sl_cur,PAF(0),PAF(1),PAF(2),PAF(3)); }
  #undef PKW
  #undef PAF
  #undef VFR
  #undef PIN
  #undef MX3
  #undef GAPA
  #undef GAPB
  #undef EX
  #undef VRD
  #undef KRD
  #undef STEP
  #undef ENDW
  {auto rr=__builtin_amdgcn_permlane32_swap(__float_as_uint(l_reg),__float_as_uint(l_reg),false,false);l_reg=__uint_as_float(rr[0])+__uint_as_float(rr[1]);}
  if(hi==0)wsf[32+r32]=l_reg;asm volatile("s_waitcnt lgkmcnt(0)":::"memory");
  float rli[16];
  #pragma unroll
  for(int r=0;r<16;++r)rli[r]=__builtin_amdgcn_rcpf(wsf[32+crow(r,hi)]);
  #pragma unroll
  for(int r=0;r<16;++r){o[0][r]*=rli[r];o[1][r]*=rli[r];}
  if constexpr(MODE==0){ bf16*Ow=Ow0+(long)(wid*QBLK)*op; stage_store(o,Ow,op,shm,wid,lane,r32,hi); }
  else { oret[0]=o[0]; oret[1]=o[1]; }
  asm volatile("s_waitcnt lgkmcnt(0)\n\ts_barrier":::"memory");
  #undef DMA_K
  #undef DMA_V
  #undef CMASK
  #undef START
  #undef RESC
  #undef ROT
}
#undef SBAR
#undef WAIT_BAR
}

struct AttnArgs { const bf16_t *QG, *QD, *KG, *VG, *KD, *VD, *CB, *PB; bf16_t* MIX; const float* conv_w; const float* conv_b; const float* subln_g; float lam, lam_init; float* dscr; };

__device__ __forceinline__ void attn_gqa_unit(const AttnArgs& A, LAS char* lds, char* lds_generic, int lat, int seq, int qh, int qb) {
    const long R = lat ? 8192L + (long)SLAT * seq : 256L * seq; const int S = lat ? SLAT : 256;
    const size_t grow0 = (lat ? 8192 + (size_t)4096 * seq : (size_t)256 * seq) + 256 * qb;
    const int kvh = qh >> 2;
    int NT = S / 64; asm volatile("" : "+s"(NT));
    typedef attn64::bf16 abf;
    f32x16 dummy[2];
    attn64::attn_unit<8, 0, 64>((const abf*)(A.QG + grow0 * 512 + 64 * qh), 512, (const abf*)(A.KG + (R * 2 + (long)kvh * S) * 64), 64, (const abf*)(A.VG + (R * 2 + (long)kvh * S) * 64), 64, NT,
                                (abf*)(A.MIX + grow0 * 1024 + 64 * qh), 1024, lds_generic, dummy);
}
__device__ __forceinline__ void attn_diff_unit(const AttnArgs& A, LAS char* lds, char* lds_generic, int lat, int seq, int hd, int qb) {
    const int tid_ = opaque_tid(); const int wave = __builtin_amdgcn_readfirstlane(tid_ >> 6), lane = tid_ & 63, r32 = lane & 31, h = lane >> 5;
    const long R = lat ? 8192L + (long)SLAT * seq : 256L * seq; const int S = lat ? SLAT : 256;
    const size_t grow0 = (lat ? 8192 + (size_t)4096 * seq : (size_t)256 * seq) + 256 * qb;
    int NT = S / 64; asm volatile("" : "+s"(NT));
    typedef attn64::bf16 abf;
    const abf* V = (const abf*)(A.VD + (R * 4 + (long)hd * S) * 64);
    f32x16 oa[2], ob[2];
    attn64::attn_unit<8, 1, 32>((const abf*)(A.QD + grow0 * 256 + 64 * hd), 256, (const abf*)(A.KD + (R * 8 + (long)(hd * 2) * S) * 32), 32, V, 64, NT, (abf*)nullptr, 0, lds_generic, oa);
    GAS float* scr = (GAS float*)A.dscr + ((size_t)(blockIdx.x * 8 + wave) * 32) * 64 + lane;
#pragma unroll
    for (int d0 = 0; d0 < 2; ++d0)
#pragma unroll
        for (int r = 0; r < 16; ++r) scr[(d0 * 16 + r) * 64] = oa[d0][r];
    attn64::attn_unit<8, 1, 32>((const abf*)(A.QD + grow0 * 256 + 64 * hd + 32), 256, (const abf*)(A.KD + (R * 8 + (long)(hd * 2 + 1) * S) * 32), 32, V, 64, NT, (abf*)nullptr, 0, lds_generic, ob);
    float ss[16];
#pragma unroll
    for (int r = 0; r < 16; ++r) {
        const float v0 = scr[r * 64] - A.lam * ob[0][r], v1 = scr[(16 + r) * 64] - A.lam * ob[1][r];
        ob[0][r] = v0; ob[1][r] = v1; ss[r] = v0 * v0 + v1 * v1;
    }
#pragma unroll
    for (int o = 1; o < 32; o <<= 1)
#pragma unroll
        for (int r = 0; r < 16; ++r) ss[r] += __shfl_xor(ss[r], o);
    const float g0 = A.subln_g[r32], g1 = A.subln_g[32 + r32], sc = 1.f - A.lam_init;
#pragma unroll
    for (int r = 0; r < 16; ++r) { const float rstd = rsqrtf(ss[r] * (1.f / 64.f) + EPS) * sc; ob[0][r] *= rstd * g0; ob[1][r] *= rstd * g1; }
    attn64::stage_store(ob, (abf*)(A.MIX + (grow0 + 32 * wave) * 1024 + 768 + 64 * hd), 1024, lds_generic, wave, lane, r32, h);
}

__device__ __forceinline__ void attn_phase(const AttnArgs& A, LAS char* lds, char* lds_generic, int G) {
    for (int u = blockIdx.x; u < 2048; u += G) {
        if (u < 512) { const int b = u & 7, r = u >> 3; attn_diff_unit(A, lds, lds_generic, 1, b, r >> 4, r & 15); }
        else if (u < 1536) { const int v = u - 512, b = v & 7, r = v >> 3; attn_gqa_unit(A, lds, lds_generic, 1, b, r & 7, r >> 3); }
        else { const int v = u - 1536;
            if (v < 128) attn_diff_unit(A, lds, lds_generic, 0, v >> 2, v & 3, 0);
            else if (v < 256) { const int w = 2 * (v - 128); attn_gqa_unit(A, lds, lds_generic, 0, w >> 3, w & 7, 0); }
            else if (v >= 384) { const int w = 2 * (v - 384) + 1; attn_gqa_unit(A, lds, lds_generic, 0, w >> 3, w & 7, 0); } }
    }
    const int tid_c = opaque_tid();
    for (int idx = blockIdx.x * 512 + tid_c; idx < M_ALL * 32; idx += G * 512) {
        const int row = idx >> 5, c8 = (idx & 31) * 8;
        int t, S; if (row < M_CTX) { t = row & 255; S = 256; } else { t = (row - M_CTX) & 4095; S = 4096; }
        const u32x4 z = {0, 0, 0, 0};
        const u32x4 pc = *(const GAS u32x4*)(A.PB + (size_t)row * 256 + c8);
        const u32x4 pp = t > 0 ? *(const GAS u32x4*)(A.PB + (size_t)(row - 1) * 256 + c8) : z;
        const u32x4 pn = t < S - 1 ? *(const GAS u32x4*)(A.PB + (size_t)(row + 1) * 256 + c8) : z;
        const u32x4 cb = *(const GAS u32x4*)(A.CB + (size_t)row * 256 + c8);
        float res[8];
#pragma unroll
        for (int j = 0; j < 8; ++j) {
            const int sh = (j & 1) * 16;
            const float a = __uint_as_float(((pp[j >> 1] >> sh) & 0xffffu) << 16), b = __uint_as_float(((pc[j >> 1] >> sh) & 0xffffu) << 16), c = __uint_as_float(((pn[j >> 1] >> sh) & 0xffffu) << 16);
            const float g = __uint_as_float(((cb[j >> 1] >> sh) & 0xffffu) << 16);
            const int cc = c8 + j;
            res[j] = g * (A.conv_w[cc] * a + A.conv_w[256 + cc] * b + A.conv_w[512 + cc] * c + A.conv_b[cc]);
        }
        u32x4 w; w.x = cvtpk(res[0], res[1]); w.y = cvtpk(res[2], res[3]); w.z = cvtpk(res[4], res[5]); w.w = cvtpk(res[6], res[7]);
        *(GAS u32x4*)(A.MIX + (size_t)row * 1024 + 512 + c8) = w;
    }
}

__device__ __forceinline__ int sigma_map(int type, int i) {
    if (type == 1) return 8 * ((i >> 2) & 3) + 4 * (i >> 4) + (i & 3);
    if (type == 2) return 16 * ((i >> 3) & 1) + 8 * (i >> 4) + (i & 7);
    return i;
}
__device__ __forceinline__ void in_group(int g, int& Lbase, int& type) {
    const int pn = g >> 3, bj = (g >> 2) & 1, wc = g & 3;
    if (pn < 2) { Lbase = 64 * (4 * pn + wc) + 32 * bj; type = 0; }
    else if (pn == 2) { Lbase = (wc < 2 ? 512 + 64 * wc : 640 + 64 * (wc - 2)) + 32 * bj; type = wc < 2 ? 0 : 1; }
    else if (pn == 3) { Lbase = 768 + 128 * bj + 32 * wc; type = 1; }
    else if (pn < 6) { Lbase = 1024 + 256 * bj + 128 * (pn - 4) + 32 * wc; type = 1; }
    else if (pn < 8) { Lbase = (pn == 6 ? 1536 : 1792) + 64 * wc + 32 * bj; type = 2; }
    else { Lbase = 2048 + 64 * wc + 32 * bj; type = 1; }
}
__device__ __forceinline__ void transpose_item(const float* W, int K, int N, bf16_t* WT, int k0, int nphys0, int Lbase, int type, LAS float* scr, int lane) {
#pragma unroll 8
    for (int i = 0; i < 32; ++i) { const int kk = 2 * i + (lane >> 5); scr[kk * 33 + (lane & 31)] = ((const GAS float*)W)[(size_t)(k0 + kk) * N + Lbase + (lane & 31)]; }
    asm volatile("s_waitcnt lgkmcnt(0)" ::: "memory");
    const int c = lane & 7;
#pragma unroll
    for (int j = 0; j < 4; ++j) { const int n = (lane >> 3) + 8 * j; const LAS float* s = scr + (8 * c) * 33 + sigma_map(type, n);
        u32x4 o; o.x = cvtpk(s[0 * 33], s[1 * 33]); o.y = cvtpk(s[2 * 33], s[3 * 33]); o.z = cvtpk(s[4 * 33], s[5 * 33]); o.w = cvtpk(s[6 * 33], s[7 * 33]);
        *(GAS u32x4*)(WT + (size_t)(nphys0 + n) * K + k0 + 8 * c) = o; }
    asm volatile("s_waitcnt lgkmcnt(0)" ::: "memory");
}

struct Params {
    const float *x_prompt, *x_sample, *cache_gk, *cache_gv, *cache_dk, *cache_dv, *c, *c_ctx;
    const float *w_mod, *b_mod, *norm1_g, *w_in, *gqa_qn_g, *gqa_kn_g, *conv_w, *conv_b, *diff_qn_g, *diff_kn_g, *diff_lambda, *diff_subln_g, *w_out, *norm2_g, *ffn_up, *ffn_conv_w, *ffn_conv_b, *ffn_down;
    float* out; unsigned char* ws;
    float lam_init[4];
    int ph_lo, ph_hi;
};

__device__ __forceinline__ void prologue(const Params& P, LAS unsigned char* lds, int G) {
    const int tid = opaque_tid(), lane = tid & 63, wave = __builtin_amdgcn_readfirstlane(tid >> 6);
    float* MODS = (float*)(P.ws + WS_MODS); float* MISC = (float*)(P.ws + WS_MISC);
    if ((int)blockIdx.x < 384) {
        LAS float* sc = (LAS float*)lds;
        LAS float* part = (LAS float*)(lds + 49152);
        for (int i = tid; i < NCOND * 1024; i += 512) { const int ci = i >> 10, k = i & 1023; const float v = ci == 0 ? P.c_ctx[k] : P.c[(ci - 1) * 1024 + k]; sc[k * 12 + ci] = v / (1.f + __expf(-v)); }
        __syncthreads();
        for (int it = blockIdx.x; it < 384; it += G) {
            const int l = it / 96, col = (it % 96) * 64 + lane;
            const float* w = P.w_mod + (size_t)l * 1024 * 6144 + col;
            float acc[NCOND];
#pragma unroll
            for (int ci = 0; ci < NCOND; ++ci) acc[ci] = 0.f;
#pragma unroll 8
            for (int kk = 0; kk < 128; ++kk) { const int k = wave * 128 + kk; const float wv = ((const GAS float*)w)[(size_t)k * 6144];
                const f32x4 s0 = *(LAS f32x4*)(sc + k * 12), s1 = *(LAS f32x4*)(sc + k * 12 + 4); const float s8 = sc[k * 12 + 8];
                acc[0] += s0[0] * wv; acc[1] += s0[1] * wv; acc[2] += s0[2] * wv; acc[3] += s0[3] * wv; acc[4] += s1[0] * wv; acc[5] += s1[1] * wv; acc[6] += s1[2] * wv; acc[7] += s1[3] * wv; acc[8] += s8 * wv; }
#pragma unroll
            for (int ci = 0; ci < NCOND; ++ci) part[(wave * NCOND + ci) * 64 + lane] = acc[ci];
            __syncthreads();
            for (int i = tid; i < NCOND * 64; i += 512) { const int ci = i >> 6, cc = i & 63; float s = 0.f;
#pragma unroll
                for (int w8 = 0; w8 < 8; ++w8) s += part[(w8 * NCOND + ci) * 64 + cc];
                const int j = (it % 96) * 64 + cc; MODS[((size_t)l * NCOND + ci) * 6144 + j] = s + P.b_mod[l * 6144 + j]; }
            __syncthreads();
        }
    }
    if ((int)blockIdx.x == G - 1) {
        if (tid < 4) { const float* lf = P.diff_lambda + tid * 128; float s1 = 0.f, s2 = 0.f; for (int i = 0; i < 32; ++i) { s1 += lf[i] * lf[32 + i]; s2 += lf[64 + i] * lf[96 + i]; }
            MISC[MI_LAM + tid] = expf(s1) - expf(s2) + P.lam_init[tid]; }
        for (int i = tid; i < 1024; i += 512) { const int pos = i >> 4, idx = i & 15; const float fr = powf(10000.f, -(float)idx / 16.f); const float ang = (float)pos * fr; MISC[MI_R64C + i] = cosf(ang); MISC[MI_R64S + i] = sinf(ang); }
        for (int i = tid; i < 512; i += 512) { const int pos = i >> 3, idx = i & 7; const float fr = powf(10000.f, -(float)idx / 8.f); const float ang = (float)pos * fr; MISC[MI_R32C + i] = cosf(ang); MISC[MI_R32S + i] = sinf(ang); }
    }
    __syncthreads();
    LAS float* scr = (LAS float*)(lds + wave * 16384);
    const int gw = blockIdx.x * 8 + wave, NGW = G * 8;
    constexpr int I_IN = 16 * 72, I_OUT = 16 * 32, I_UP = 16 * 176, I_DN = 44 * 32, I_L = I_IN + I_OUT + I_UP + I_DN;
    for (int it = gw; it < DEPTH * I_L; it += NGW) {
        const int l = it / I_L; int r = it % I_L;
        if (r < I_IN) { const int kb = r / 72, g = r % 72; int Lb, ty; in_group(g, Lb, ty);
            transpose_item(P.w_in + (size_t)l * 1024 * INW, 1024, INW, (bf16_t*)(P.ws + WS_WIN) + (size_t)l * INW * 1024, kb * 64, g * 32, Lb, ty, scr, lane); continue; }
        r -= I_IN;
        if (r < I_OUT) { const int kb = r / 32, g = r % 32;
            transpose_item(P.w_out + (size_t)l * 1024 * 1024, 1024, 1024, (bf16_t*)(P.ws + WS_WOUT) + (size_t)l * 1024 * 1024, kb * 64, g * 32, g * 32, 0, scr, lane); continue; }
        r -= I_OUT;
        if (r < I_UP) { const int kb = r / 176, g = r % 176; const int pn = g >> 3, bj = (g >> 2) & 1, wc = g & 3;
            transpose_item(P.ffn_up + (size_t)l * 1024 * UPW, 1024, UPW, (bf16_t*)(P.ws + WS_WUP) + (size_t)l * UPW * 1024, kb * 64, g * 32, bj * DFF + 128 * pn + 32 * wc, 1, scr, lane); continue; }
        r -= I_UP;
        { const int kb = r / 32, g = r % 32;
            transpose_item(P.ffn_down + (size_t)l * DFF * 1024, DFF, 1024, (bf16_t*)(P.ws + WS_WDN) + (size_t)l * 1024 * DFF, kb * 64, g * 32, g * 32, 0, scr, lane); }
    }
}

__device__ __forceinline__ void norm_phase(const float* xin_ctx, const float* xin_lat, const float* ng, const float* mods_l  , int sh_idx, bf16_t* XN, int G) {
    const int tid_ = opaque_tid(); const int lane = tid_ & 63, wave = __builtin_amdgcn_readfirstlane(tid_ >> 6);
    const int nw = G * 8, gw = blockIdx.x * 8 + wave;
    const int per = (M_ALL + nw - 1) / nw;
    const int r0 = gw * per, r1 = min(r0 + per, M_ALL);
    int cur_ci = -1; f32x4 Aa[4], Bb[4];
    f32x4 v[4], vn[4];
    if (r0 < r1) { const float* xr = r0 < M_CTX ? xin_ctx + (size_t)r0 * DM : xin_lat + (size_t)(r0 - M_CTX) * DM;
#pragma unroll
        for (int j = 0; j < 4; ++j) vn[j] = *(const GAS f32x4*)(xr + 4 * lane + 256 * j); }
    for (int row = r0; row < r1; ++row) {
#pragma unroll
        for (int j = 0; j < 4; ++j) v[j] = vn[j];
        if (row + 1 < r1) { const int rn = row + 1; const float* xr = rn < M_CTX ? xin_ctx + (size_t)rn * DM : xin_lat + (size_t)(rn - M_CTX) * DM;
#pragma unroll
            for (int j = 0; j < 4; ++j) vn[j] = *(const GAS f32x4*)(xr + 4 * lane + 256 * j); }
        const int ci = row < M_CTX ? 0 : 1 + ((row - M_CTX) >> 12);
        if (ci != cur_ci) { cur_ci = ci; const float* sh = mods_l + ci * 6144 + sh_idx * 1024; const float* sc = sh + 1024;
#pragma unroll
            for (int j = 0; j < 4; ++j) { const int c = 4 * lane + 256 * j; const f32x4 g4 = *(const GAS f32x4*)(ng + c), s4 = *(const GAS f32x4*)(sc + c); Aa[j] = g4 * (1.f + s4); Bb[j] = *(const GAS f32x4*)(sh + c); } }
        float s = 0.f;
#pragma unroll
        for (int j = 0; j < 4; ++j) s += (v[j][0] * v[j][0] + v[j][1] * v[j][1]) + (v[j][2] * v[j][2] + v[j][3] * v[j][3]);
#pragma unroll
        for (int o = 1; o < 64; o <<= 1) s += __shfl_xor(s, o);
        const float rstd = rsqrtf(s * (1.f / DM) + EPS);
#pragma unroll
        for (int j = 0; j < 4; ++j) { const f32x4 y = v[j] * rstd * Aa[j] + Bb[j]; u32x2 w; w.x = cvtpk(y[0], y[1]); w.y = cvtpk(y[2], y[3]); *(GAS u32x2*)(XN + (size_t)row * DM + 4 * lane + 256 * j) = w; }
    }
}

__device__ __forceinline__ void cache_phase(const Params& P, int l, int G) {
    bf16_t* KG = (bf16_t*)(P.ws + WS_KG); bf16_t* VG = (bf16_t*)(P.ws + WS_VG); bf16_t* KD = (bf16_t*)(P.ws + WS_KD); bf16_t* VD = (bf16_t*)(P.ws + WS_VD);
    const int tid_ = opaque_tid();
    for (int i = blockIdx.x * 512 + tid_; i < 65536; i += G * 512) {
        const int d4 = (i & 15) * 4, kvh = (i >> 4) & 1, p = (i >> 5) & 255, b = i >> 13;
        const size_t src = ((((size_t)b * 4 + l) * 256 + p) * 2 + kvh) * 64 + d4;
        const size_t dst = (((8192L + (long)SLAT * b) * 2 + (long)kvh * SLAT + 4096 + p) * 64);
        const int pk4 = (d4 & 32) | ((d4 & 12) << 1) | ((d4 & 16) >> 2);
        const f32x4 k = *(const GAS f32x4*)(P.cache_gk + src), v = *(const GAS f32x4*)(P.cache_gv + src);
        u32x2 wk, wv; wk.x = cvtpk(k[0], k[1]); wk.y = cvtpk(k[2], k[3]); wv.x = cvtpk(v[0], v[1]); wv.y = cvtpk(v[2], v[3]);
        *(GAS u32x2*)(KG + dst + pk4) = wk; *(GAS u32x2*)(VG + dst + d4) = wv;
    }
    for (int i = blockIdx.x * 512 + tid_; i < 131072; i += G * 512) {
        { const int d4 = (i & 7) * 4, hc = (i >> 3) & 7, p = (i >> 6) & 255, b = i >> 14;
          const size_t src = ((((size_t)b * 4 + l) * 256 + p) * 8 + hc) * 32 + d4;
          const size_t dst = (((8192L + (long)SLAT * b) * 8 + (long)hc * SLAT + 4096 + p) * 32) + ((d4 & 16) | ((d4 & 4) << 1) | ((d4 & 8) >> 1));
          const f32x4 k = *(const GAS f32x4*)(P.cache_dk + src); u32x2 w; w.x = cvtpk(k[0], k[1]); w.y = cvtpk(k[2], k[3]); *(GAS u32x2*)(KD + dst) = w; }
        { const int d4 = (i & 15) * 4, hh = (i >> 4) & 3, p = (i >> 6) & 255, b = i >> 14;
          const size_t src = ((((size_t)b * 4 + l) * 256 + p) * 4 + hh) * 64 + d4;
          const size_t dst = (((8192L + (long)SLAT * b) * 4 + (long)hh * SLAT + 4096 + p) * 64) + d4;
          const f32x4 v = *(const GAS f32x4*)(P.cache_dv + src); u32x2 w; w.x = cvtpk(v[0], v[1]); w.y = cvtpk(v[2], v[3]); *(GAS u32x2*)(VD + dst) = w; }
    }
}

__device__ __forceinline__ void fixup_phase(const float* cw, bf16_t* F, const float* EP, const float* EA, const float* EU, int G) {
    const int tid_ = opaque_tid();
    for (int i = blockIdx.x * 512 + tid_; i < 128 * 2 * DFF; i += G * 512) {
        const int c = i % DFF, e = (i / DFF) & 1, pm = 32 + i / (2 * DFF); const int j = (pm - 32) & 15;
        if (e == 0 ? j == 0 : j == 15) continue;
        const size_t eo = ((size_t)pm * 2 + e) * DFF + c;
        float conv;
        if (e == 0) conv = EP[eo] + cw[c] * EA[((size_t)(pm - 1) * 2 + 1) * DFF + c];
        else conv = EP[eo] + cw[2 * DFF + c] * EA[((size_t)(pm + 1) * 2 + 0) * DFF + c];
        const float f = silu_f(conv) * EU[eo];
        const size_t row = (size_t)pm * 256 + (e ? 255 : 0);
        F[row * DFF + c] = (bf16_t)(cvtpk(f, 0.f) & 0xffffu);
    }
}


#define XB_TMO      128
#define XB_XCNT(j)  (256  + 64 * (j))
#define XB_XSUB(j)  (1280 + 64 * (j))
#define XB_XGEN(j)  (2304 + 64 * (j))
#define XB_TOP      3328
#define XB_TOPGEN   3392
#define XCD_BAR_WORDS 3456
#define XB_SPIN_CAP (1u << 22)
__device__ __forceinline__ unsigned xb_ld(unsigned* p)              { return __hip_atomic_load(p, __ATOMIC_RELAXED, __HIP_MEMORY_SCOPE_AGENT); }
__device__ __forceinline__ unsigned xb_add(unsigned* p, unsigned v) { return __hip_atomic_fetch_add(p, v, __ATOMIC_RELAXED, __HIP_MEMORY_SCOPE_AGENT); }
__device__ __forceinline__ unsigned xb_xcc_id() { return (unsigned)__builtin_amdgcn_s_getreg((3 << 11) | 20) & 0xFu; }
#define XB_SPIN(cond, bar) do { unsigned _sp = 0; while (cond) { __builtin_amdgcn_s_sleep(1); \
    if ((++_sp & 255u) == 0u) { if (xb_ld(&(bar)[XB_TMO])) break; if (_sp > XB_SPIN_CAP) { atomicAdd(&(bar)[XB_TMO], 1u); break; } } } } while (0)
struct XcdBarrier { unsigned* bar; unsigned x; volatile LAS unsigned* st; };
__device__ __forceinline__ XcdBarrier xcd_barrier_post(unsigned* bar, volatile LAS unsigned* st) {
    XcdBarrier b; b.bar = bar; b.x = xb_xcc_id(); b.st = st;
    if (threadIdx.x == 0) (void)xb_add(&bar[XB_XCNT(b.x)], 1u);
    return b;
}
__device__ __forceinline__ void xcd_barrier_complete(unsigned* bar, unsigned x, unsigned& nloc, unsigned& nx) {
    const unsigned G = gridDim.x * gridDim.y * gridDim.z;
    unsigned sum, cnt, mine, sp = 0u;
    for (;;) {
        sum = 0u; cnt = 0u; mine = 0u;
#pragma unroll
        for (unsigned j = 0; j < 16; ++j) { const unsigned c = xb_ld(&bar[XB_XCNT(j)]); sum += c; cnt += (c > 0u) ? 1u : 0u; mine = (j == x) ? c : mine; }
        if (sum == G) break;
        __builtin_amdgcn_s_sleep(1);
        if ((++sp & 255u) == 0u) { if (xb_ld(&bar[XB_TMO])) break; if (sp > XB_SPIN_CAP) { atomicAdd(&bar[XB_TMO], 1u); break; } }
    }
    nloc = mine > 0u ? mine : 1u; nx = cnt > 0u ? cnt : 1u;
}
__device__ __forceinline__ void xcd_barrier(const XcdBarrier& b) {
    asm volatile("s_waitcnt vmcnt(0)" ::: "memory");
    __syncthreads();
    if (threadIdx.x == 0) {
        unsigned* bar = b.bar;
        __builtin_amdgcn_s_waitcnt(0);
        unsigned nloc = b.st[0], nx = b.st[1];
        if (nloc == 0u) { xcd_barrier_complete(bar, b.x, nloc, nx); b.st[0] = nloc; b.st[1] = nx; }
        const unsigned old = xb_add(&bar[XB_XSUB(b.x)], 1u);
        const unsigned gen = old / nloc;
        if (old + 1u == (gen + 1u) * nloc) {
            __builtin_amdgcn_fence(__ATOMIC_RELEASE, "agent");
            asm volatile("s_waitcnt vmcnt(0)" ::: "memory");
            const unsigned og = xb_add(&bar[XB_TOP], 1u);
            const unsigned tg = og / nx;
            if (og + 1u == (tg + 1u) * nx) xb_add(&bar[XB_TOPGEN], 1u);
            else XB_SPIN(xb_ld(&bar[XB_TOPGEN]) == tg, bar);
            __builtin_amdgcn_fence(__ATOMIC_ACQUIRE, "agent");
            xb_add(&bar[XB_XGEN(b.x)], 1u);
            asm volatile("s_waitcnt vmcnt(0)" ::: "memory");
        } else {
            XB_SPIN(xb_ld(&bar[XB_XGEN(b.x)]) == gen, bar);
            __builtin_amdgcn_fence(__ATOMIC_ACQUIRE, "agent");
            asm volatile("s_waitcnt vmcnt(0)" ::: "memory");
        }
    }
    __syncthreads();
}

__global__ void __launch_bounds__(512, 2) fwd_kernel(Params P) {
    extern __shared__ __attribute__((aligned(16))) unsigned char lds_raw[];
    LAS unsigned char* lds = (LAS unsigned char*)lds_raw;
    cg::grid_group grid = cg::this_grid();
    const int G = gridDim.x;
    volatile LAS unsigned* bst = (volatile LAS unsigned*)(lds + MISC_OFF);
    if (threadIdx.x < 2) bst[threadIdx.x] = 0u;
    __syncthreads();
    XcdBarrier bar = xcd_barrier_post((unsigned*)(P.ws + WS_CTL), bst);
    int ph = 0;
#define PHASE_BEGIN if (ph >= P.ph_lo && ph < P.ph_hi) { unsigned char* ws = P.ws; float* outp = P.out; asm volatile("" : "+s"(ws), "+s"(outp));
#define PHASE_END   if (ph + 1 < P.ph_hi) { if (ph == 0) grid.sync(); else xcd_barrier(bar); } } ++ph;
    PHASE_BEGIN
#ifndef SKIP_PRO
        prologue(P, lds, G);
#endif
    PHASE_END
    for (int l = 0; l < DEPTH; ++l) {
        PHASE_BEGIN
            const float* xin_ctx = l == 0 ? P.x_prompt : outp; const float* xin_lat = l == 0 ? P.x_sample : outp + (size_t)M_CTX * DM;
            norm_phase(xin_ctx, xin_lat, P.norm1_g + l * DM, (const float*)(ws + WS_MODS) + (size_t)l * NCOND * 6144, 0, (bf16_t*)(ws + WS_XN), G);
            cache_phase(P, l, G);
        PHASE_END
        PHASE_BEGIN {
            const float* MISC = (const float*)(ws + WS_MISC);
            pg8::Gemm g{(const bf16_t*)(ws + WS_XN), (const bf16_t*)(ws + WS_WIN) + (size_t)l * INW * 1024, M_ALL, INW, 1024}; pg8::StaticOrder S; S.init(M_ALL, INW, G, blockIdx.x);
            EpiIn E{l, P.gqa_qn_g + l * 64, P.gqa_kn_g + l * 64, P.diff_qn_g + l * 32, P.diff_kn_g + l * 32, MISC + MI_R64C, MISC + MI_R64S, MISC + MI_R32C, MISC + MI_R32S,
                    (bf16_t*)(ws + WS_QG), (bf16_t*)(ws + WS_QD), (bf16_t*)(ws + WS_KG), (bf16_t*)(ws + WS_VG), (bf16_t*)(ws + WS_KD), (bf16_t*)(ws + WS_VD), (bf16_t*)(ws + WS_CB), (bf16_t*)(ws + WS_PB), outp};
#ifndef SKIP_IN
            pg8::gemm_phase(lds, lds + XCH_OFF, g, S, E);
#endif
        } PHASE_END
        PHASE_BEGIN {
            const float* MISC = (const float*)(ws + WS_MISC);
            AttnArgs A{(const bf16_t*)(ws + WS_QG), (const bf16_t*)(ws + WS_QD), (const bf16_t*)(ws + WS_KG), (const bf16_t*)(ws + WS_VG), (const bf16_t*)(ws + WS_KD), (const bf16_t*)(ws + WS_VD),
                       (const bf16_t*)(ws + WS_CB), (const bf16_t*)(ws + WS_PB), (bf16_t*)(ws + WS_XN), P.conv_w + l * 768, P.conv_b + l * 256, P.diff_subln_g + l * 64, MISC[MI_LAM + l], P.lam_init[l], (float*)(ws + WS_DSCR)};
#ifndef SKIP_ATT
            attn_phase(A, (LAS char*)lds, (char*)lds_raw, G);
#endif
        } PHASE_END
        PHASE_BEGIN {
            const float* xin_ctx = l == 0 ? P.x_prompt : outp; const float* xin_lat = l == 0 ? P.x_sample : outp + (size_t)M_CTX * DM;
            pg8::Gemm g{(const bf16_t*)(ws + WS_XN), (const bf16_t*)(ws + WS_WOUT) + (size_t)l * 1024 * 1024, M_ALL, 1024, 1024}; pg8::StaticOrder S; S.init(M_ALL, 1024, G, blockIdx.x);
            EpiRes E{xin_ctx, xin_lat, outp, (const float*)(ws + WS_MODS) + (size_t)l * NCOND * 6144 + 2 * 1024};
#ifndef SKIP_RES
            pg8::gemm_phase(lds, lds + XCH_OFF, g, S, E);
#endif
        } PHASE_END
        PHASE_BEGIN
            norm_phase(outp, outp + (size_t)M_CTX * DM, P.norm2_g + l * DM, (const float*)(ws + WS_MODS) + (size_t)l * NCOND * 6144, 3, (bf16_t*)(ws + WS_XN), G);
        PHASE_END
        PHASE_BEGIN {
            float* EPb = (float*)(ws + WS_EDGE);
            pg8::Gemm g{(const bf16_t*)(ws + WS_XN), (const bf16_t*)(ws + WS_WUP) + (size_t)l * UPW * 1024, M_ALL, UPW, 1024}; pg8::StaticOrder S; S.init(M_ALL, UPW, G, blockIdx.x);
            EpiUp E{P.ffn_conv_w + (size_t)l * 3 * DFF, P.ffn_conv_b + (size_t)l * DFF, (bf16_t*)(ws + WS_U), EPb, EPb + EDGE_ELEMS, EPb + 2 * EDGE_ELEMS};
#ifndef SKIP_UP
            pg8::gemm_phase(lds, lds + XCH_OFF, g, S, E);
#endif
        } PHASE_END
        PHASE_BEGIN {
            float* EPb = (float*)(ws + WS_EDGE);
            fixup_phase(P.ffn_conv_w + (size_t)l * 3 * DFF, (bf16_t*)(ws + WS_U), EPb, EPb + EDGE_ELEMS, EPb + 2 * EDGE_ELEMS, G);
        } PHASE_END
        PHASE_BEGIN {
            pg8::Gemm g{(const bf16_t*)(ws + WS_U), (const bf16_t*)(ws + WS_WDN) + (size_t)l * 1024 * DFF, M_ALL, 1024, DFF}; pg8::StaticOrder S; S.init(M_ALL, 1024, G, blockIdx.x);
            EpiRes E{outp, outp + (size_t)M_CTX * DM, outp, (const float*)(ws + WS_MODS) + (size_t)l * NCOND * 6144 + 5 * 1024};
#ifndef SKIP_RES
            pg8::gemm_phase(lds, lds + XCH_OFF, g, S, E);
#endif
        } PHASE_END
    }
}

constexpr int N_PHASES = 1 + DEPTH * 8;
#ifndef N_LAUNCH_SPLIT
#define N_LAUNCH_SPLIT 0
#endif

extern "C" void kernel_launch(void* const* d_in, const int* in_sizes, int n_in, void* d_out, int out_size, void* d_ws, size_t ws_size, hipStream_t stream) {
    static int grid = 0;
    if (grid == 0) {
        if (n_in != 26 || ws_size < WS_END) { fprintf(stderr, "kernel_launch: unexpected n_in %d or ws_size %zu (< %zu)\n", n_in, ws_size, (size_t)WS_END); grid = -1; return; }
        int dev = 0, cus = 0, per_cu = 0;
        hipGetDevice(&dev); hipDeviceGetAttribute(&cus, hipDeviceAttributeMultiprocessorCount, dev);
        hipFuncSetAttribute((const void*)fwd_kernel, hipFuncAttributeMaxDynamicSharedMemorySize, LDS_BYTES);
        hipOccupancyMaxActiveBlocksPerMultiprocessor(&per_cu, (const void*)fwd_kernel, 512, LDS_BYTES);
        if (per_cu < 1) { fprintf(stderr, "kernel_launch: occupancy query gives %d\n", per_cu); per_cu = 1; }
        (void)hipGetLastError();
        grid = cus * 1;
    }
    if (grid < 0) return;
    Params p{};
    const float** pp = (const float**)&p;
    for (int i = 0; i < 26; ++i) pp[i] = (const float*)d_in[i];
    p.out = (float*)d_out; p.ws = (unsigned char*)d_ws;
    for (int l = 0; l < 4; ++l) p.lam_init[l] = (float)(0.8 - 0.6 * exp(-0.3 * (double)l));
#if N_LAUNCH_SPLIT
    for (int ph = 0; ph < N_PHASES; ++ph) { p.ph_lo = ph; p.ph_hi = ph + 1; hipLaunchKernelGGL(fwd_kernel, dim3(grid), dim3(512), LDS_BYTES, stream, p); }
#else
    p.ph_lo = 0; p.ph_hi = N_PHASES;
    if (hipMemsetAsync((char*)d_ws + WS_CTL, 0, CTL_ZERO_BYTES, stream) != hipSuccess) { fprintf(stderr, "kernel_launch: memset failed\n"); return; }
    void* args[] = {&p};
    hipError_t e = hipLaunchCooperativeKernel((const void*)fwd_kernel, dim3(grid), dim3(512), args, LDS_BYTES, stream);
    if (e != hipSuccess) fprintf(stderr, "cooperative launch failed: %s (grid %d)\n", hipGetErrorString(e), grid);
#endif
}
```

```cpp
#include <hip/hip_runtime.h>
#include <hip/hip_cooperative_groups.h>
#include <cstdio>
#include <cstdint>
#include <cmath>
namespace cg = cooperative_groups;

#define LAS __attribute__((address_space(3)))
#define GAS __attribute__((address_space(1)))
typedef unsigned short bf16_t;
typedef short bf16x8 __attribute__((ext_vector_type(8)));
typedef short s16x4 __attribute__((ext_vector_type(4)));
typedef float f32x4 __attribute__((ext_vector_type(4)));
typedef float f32x16 __attribute__((ext_vector_type(16)));
typedef unsigned u32x4 __attribute__((ext_vector_type(4)));
typedef unsigned u32x2 __attribute__((ext_vector_type(2)));
typedef float f32x2 __attribute__((ext_vector_type(2)));
typedef __bf16 bf16x2_t __attribute__((ext_vector_type(2)));

__device__ __forceinline__ unsigned cvtpk(float lo, float hi) { f32x2 v = {lo, hi}; bf16x2_t b = __builtin_convertvector(v, bf16x2_t); return __builtin_bit_cast(unsigned, b); }
__device__ __forceinline__ int opaque_tid() { int t = threadIdx.x; asm volatile("" : "+v"(t)); return t; }
__device__ __forceinline__ float bf2f(unsigned short u) { return __uint_as_float(((unsigned)u) << 16); }

constexpr int DM = 1024, DEPTH = 4, NCOND = 9;
constexpr int M_CTX = 8192, M_ALL = 40960, NTM = 160;
constexpr int INW = 2304, DFF = 2816, UPW = 5632;
constexpr int SLAT = 4352;
constexpr float EPS = 1e-6f;
constexpr float LOG2E = 1.4426950408889634f;
constexpr float QSCALE_G = 0.125f * LOG2E;
constexpr float QSCALE_D = 0.17677669529663687f * LOG2E;
constexpr size_t OUT_GK = 41943040, OUT_GV = OUT_GK + 4194304, OUT_DK = OUT_GV + 4194304, OUT_DV = OUT_DK + 8388608;
constexpr size_t MiB = 1u << 20;
constexpr size_t WS_MODS = 1 * MiB;
constexpr size_t WS_MISC = 2 * MiB;
constexpr size_t WS_EDGE = 3 * MiB;
constexpr size_t EDGE_ELEMS = (size_t)NTM * 2 * DFF;
constexpr size_t WS_WIN = 16 * MiB;
constexpr size_t WS_WOUT = 34 * MiB;
constexpr size_t WS_WUP = 42 * MiB;
constexpr size_t WS_WDN = 86 * MiB;
constexpr size_t WS_XN = 108 * MiB;
constexpr size_t WS_U = 188 * MiB;
constexpr size_t WS_QG = WS_U, WS_QD = WS_QG + (size_t)M_ALL * 512 * 2, WS_KG = WS_QD + (size_t)M_ALL * 256 * 2;
constexpr size_t KROWS = 8192 + 8 * SLAT;
constexpr size_t WS_VG = WS_KG + KROWS * 128 * 2, WS_KD = WS_VG + KROWS * 128 * 2, WS_VD = WS_KD + KROWS * 256 * 2;
constexpr size_t WS_CB = WS_VD + KROWS * 256 * 2, WS_PB = WS_CB + (size_t)M_ALL * 256 * 2, WS_UEND = WS_PB + (size_t)M_ALL * 256 * 2;
constexpr size_t WS_DSCR = WS_U + (size_t)M_ALL * DFF * 2;
constexpr size_t WS_END = WS_DSCR + 32 * MiB;
static_assert(WS_UEND <= WS_DSCR, "union");
constexpr int MI_LAM = 0, MI_R64C = 64, MI_R64S = MI_R64C + 1024, MI_R32C = MI_R64S + 1024, MI_R32S = MI_R32C + 512;

constexpr int RING_BYTES = 131072, XCH_OFF = RING_BYTES, MISC_OFF = RING_BYTES + 4096, LDS_BYTES = RING_BYTES + 4096 + 256;
constexpr size_t WS_CTL = 0, CTL_ZERO_BYTES = 65536;

struct TileInfo {
    int lat, seq, t0, ci, S; long R;
    __device__ __forceinline__ TileInfo(int pm) {
        if (pm < 32) { lat = 0; seq = pm; t0 = 0; ci = 0; S = 256; R = 256L * pm; }
        else { const int b = (pm - 32) >> 4; lat = 1; seq = b; t0 = ((pm - 32) & 15) * 256; ci = 1 + b; S = SLAT; R = 8192L + (long)SLAT * b; }
    }
};

namespace pg8 {
constexpr int BM = 256, BK = 64, HALF = 128, HTB = HALF * BK * 2, NXCD = 8, WGM = 8;
__host__ __device__ __forceinline__ int lds_byte(int r, int c) { const int st = (r >> 4) * 2 + (c >> 5), rr = r & 15, cc = c & 31, ob = rr * 64 + cc * 2; return st * 1024 + (ob ^ (((ob >> 9) & 1) << 5)); }
__host__ __device__ __forceinline__ void stage_rc(int b, int& R, int& C) { const int st = b / 1024, sb = b % 1024, swz = sb ^ (((sb >> 9) & 1) << 5); R = (st >> 1) * 16 + swz / 64; C = (st & 1) * 32 + (swz % 64) / 2; }
struct Unit { int pm, pn; };
struct Gemm { const bf16_t* A; const bf16_t* Bt; int M, N, K; };
struct StaticOrder {
    int nM, nN, nwg, G, c;
    __device__ void init(int M, int N, int G_, int c_) { nM = M / BM; nN = N / BM; nwg = nM * nN; G = G_; c = c_; }
    __device__ bool next(int i, Unit& u) const {
        const long L = (long)i * G + c; if (L >= nwg) return false;
        int wgid = (int)L; { const int q = nwg / NXCD, r = nwg % NXCD, xcd = wgid % NXCD, off = wgid / NXCD; wgid = (xcd < r ? xcd * (q + 1) : r * (q + 1) + (xcd - r) * q) + off; }
        const int nig = WGM * nN, gid = wgid / nig, fm = gid * WGM, gsz = (nM - fm) < WGM ? (nM - fm) : WGM;
        u.pm = fm + ((wgid % nig) % gsz); u.pn = (wgid % nig) / gsz; return true;
    }
};
template <class Epi>
__device__ __forceinline__ void gemm_phase(LAS unsigned char* lds, LAS unsigned char* xlds, const Gemm g, const StaticOrder& S, const Epi& E) {
    const int tid = opaque_tid(), wid = __builtin_amdgcn_readfirstlane(tid >> 6), lane = tid & 63, wr = wid >> 2, wc = wid & 3, fr = lane & 15, fq = lane >> 4;
    const int K = g.K, nt = K / BK;
    unsigned voffA[2];
#pragma unroll
    for (int i = 0; i < 2; ++i) { int R, C; stage_rc(tid * 16 + i * 8192, R, C); voffA[i] = (unsigned)(R * K + C) * 2u; }
    const size_t kstep = (size_t)(BK * 2);
    const size_t hstep = (size_t)HALF * K * 2;
    const size_t tstep = 2 * hstep;
    const unsigned ldsw = (unsigned)wid * 1024u;
    const int aoff = lds_byte(wr * 64 + fr, fq * 8), boff = lds_byte(wc * 32 + fr, fq * 8);
#define PG8_SA(b, h) (((b) * 2 + (h)) * HTB)
#define PG8_SB(b, h) ((4 + (b) * 2 + (h)) * HTB)
#define PG8_STAGE(bufoff, gbase) do { _Pragma("unroll") for (int _i = 0; _i < 2; ++_i) \
        __builtin_amdgcn_global_load_lds((const unsigned*)((const char*)(gbase) + voffA[_i]), (LAS unsigned*)(lds + (bufoff) + ldsw + _i * 8192), 16, 0, 0); } while (0)
#define PG8_LDA(dst, b, h) do { _Pragma("unroll") for (int m = 0; m < 4; ++m) _Pragma("unroll") for (int k = 0; k < 2; ++k) dst[m][k] = *(const LAS bf16x8*)(lds + PG8_SA(b, h) + aoff + m * 2048 + k * 1024); } while (0)
#define PG8_LDB(dst, b, h) do { _Pragma("unroll") for (int n = 0; n < 2; ++n) _Pragma("unroll") for (int k = 0; k < 2; ++k) dst[n][k] = *(const LAS bf16x8*)(lds + PG8_SB(b, h) + boff + n * 2048 + k * 1024); } while (0)
#define PG8_MMA(ai, bj, At, Bt) do { __builtin_amdgcn_s_setprio(1); _Pragma("unroll") for (int m = 0; m < 4; ++m) _Pragma("unroll") for (int n = 0; n < 2; ++n) _Pragma("unroll") for (int k = 0; k < 2; ++k) \
        acc[ai][bj][m][n] = __builtin_amdgcn_mfma_f32_16x16x32_bf16(Bt[n][k], At[m][k], acc[ai][bj][m][n], 0, 0, 0); __builtin_amdgcn_s_setprio(0); } while (0)
#define PG8_WAIT_V(n) asm volatile("s_waitcnt vmcnt(" #n ")" ::: "memory")
#define PG8_WAIT_L(n) asm volatile("s_waitcnt lgkmcnt(" #n ")" ::: "memory")
#define PG8_BAR __builtin_amdgcn_s_barrier()
#define PG8_SCHED __builtin_amdgcn_sched_barrier(0)
    Unit cur, nxt; int ui = 0;
    if (!S.next(0, cur)) return;
    f32x4 acc[2][2][4][2];
#pragma unroll
    for (int a = 0; a < 2; ++a)
#pragma unroll
        for (int b = 0; b < 2; ++b)
#pragma unroll
            for (int m = 0; m < 4; ++m)
#pragma unroll
                for (int n = 0; n < 2; ++n) acc[a][b][m][n] = (f32x4){0.f, 0.f, 0.f, 0.f};
    bf16x8 At[4][2], B0[2][2], B1[2][2];
    const char* cA = (const char*)g.A + (size_t)cur.pm * tstep; const char* cB = (const char*)g.Bt + (size_t)cur.pn * tstep;
    PG8_STAGE(PG8_SB(0, 0), cB); PG8_STAGE(PG8_SB(0, 1), cB + hstep); PG8_STAGE(PG8_SA(0, 0), cA); PG8_STAGE(PG8_SA(0, 1), cA + hstep);
    if (wr == 1) PG8_BAR;
    PG8_WAIT_V(2); PG8_BAR;
    PG8_STAGE(PG8_SB(1, 0), cB + kstep); PG8_STAGE(PG8_SA(1, 0), cA + kstep); PG8_STAGE(PG8_SB(1, 1), cB + hstep + kstep);
    PG8_WAIT_V(6); PG8_BAR;
    for (;;) {
        const bool has_next = S.next(ui + 1, nxt);
        const char* nA = has_next ? (const char*)g.A + (size_t)nxt.pm * tstep : cA; const char* nB = has_next ? (const char*)g.Bt + (size_t)nxt.pn * tstep : cB;
        for (int t = 0; t < nt; t += 2) {
            const bool last = (t == nt - 2);
            const char* a1 = cA + (size_t)(t + 1) * kstep;
            const char* a2 = last ? nA : cA + (size_t)(t + 2) * kstep; const char* b2 = last ? nB : cB + (size_t)(t + 2) * kstep;
            const char* a3 = a2 + kstep; const char* b3 = b2 + kstep;
            PG8_LDB(B0, 0, 0); PG8_LDB(B1, 0, 1); PG8_SCHED; PG8_LDA(At, 0, 0); PG8_STAGE(PG8_SA(1, 1), a1 + hstep);
            PG8_WAIT_V(8); PG8_WAIT_L(0); PG8_BAR; PG8_MMA(0, 0, At, B0); PG8_MMA(0, 1, At, B1); PG8_BAR; PG8_SCHED;
            PG8_LDA(At, 0, 1); PG8_STAGE(PG8_SB(0, 0), b2); PG8_STAGE(PG8_SB(0, 1), b2 + hstep); PG8_STAGE(PG8_SA(0, 0), a2);
            PG8_WAIT_V(8); PG8_WAIT_L(0); PG8_BAR; PG8_MMA(1, 0, At, B0); PG8_MMA(1, 1, At, B1); PG8_BAR; PG8_SCHED;
            PG8_LDB(B0, 1, 0); PG8_LDB(B1, 1, 1); PG8_SCHED; PG8_LDA(At, 1, 0); PG8_STAGE(PG8_SA(0, 1), a2 + hstep);
            PG8_WAIT_V(8); PG8_WAIT_L(0); PG8_BAR; PG8_MMA(0, 0, At, B0); PG8_MMA(0, 1, At, B1); PG8_BAR; PG8_SCHED;
            PG8_LDA(At, 1, 1); PG8_STAGE(PG8_SB(1, 0), b3); PG8_STAGE(PG8_SB(1, 1), b3 + hstep); PG8_STAGE(PG8_SA(1, 0), a3);
            PG8_WAIT_V(8); PG8_WAIT_L(0); PG8_BAR; PG8_MMA(1, 0, At, B0); PG8_MMA(1, 1, At, B1); PG8_BAR; PG8_SCHED;
        }
        if (wr == 0) PG8_BAR;
        { int fr_ = fr, fq_ = fq; asm volatile("" : "+v"(fr_), "+v"(fq_)); E(acc, cur, wr, wc, fr_, fq_, xlds); }
        if (!has_next) break;
#pragma unroll
        for (int a = 0; a < 2; ++a)
#pragma unroll
            for (int b = 0; b < 2; ++b)
#pragma unroll
                for (int m = 0; m < 4; ++m)
#pragma unroll
                    for (int n = 0; n < 2; ++n) acc[a][b][m][n] = (f32x4){0.f, 0.f, 0.f, 0.f};
        cur = nxt; cA = nA; cB = nB; ++ui;
        if (wr == 1) PG8_BAR;
    }
    PG8_WAIT_V(0);
    PG8_BAR;
#undef PG8_SA
#undef PG8_SB
#undef PG8_STAGE
#undef PG8_LDA
#undef PG8_LDB
#undef PG8_MMA
#undef PG8_WAIT_V
#undef PG8_WAIT_L
#undef PG8_BAR
#undef PG8_SCHED
}
}

typedef f32x4 Acc[2][2][4][2];

struct EpiRes {
    const float* xin_ctx; const float* xin_lat; float* xout; const float* gate;
    __device__ __forceinline__ void operator()(const Acc& acc, const pg8::Unit& u, int wr, int wc, int fr, int fq, LAS unsigned char*) const {
        const TileInfo ti(u.pm);
        const int col0 = u.pn * 256 + wc * 32 + 4 * fq;
        const float* gp = gate + ti.ci * 6144 + col0;
        f32x4 g4[2][2];
#pragma unroll
        for (int bj = 0; bj < 2; ++bj)
#pragma unroll
            for (int n = 0; n < 2; ++n) g4[bj][n] = *(const GAS f32x4*)(gp + bj * 128 + n * 16);
        const float* xin = ti.lat ? xin_lat + (size_t)(u.pm * 256 - M_CTX) * DM : xin_ctx + (size_t)(u.pm * 256) * DM;
        float* xo = xout + (size_t)(u.pm * 256) * DM;
#pragma unroll
        for (int ai = 0; ai < 2; ++ai) {
            f32x4 xv[4][2][2];
#pragma unroll
            for (int m = 0; m < 4; ++m) {
                const size_t off = (size_t)(ai * 128 + wr * 64 + m * 16 + fr) * DM + col0;
#pragma unroll
                for (int bj = 0; bj < 2; ++bj)
#pragma unroll
                    for (int n = 0; n < 2; ++n) xv[m][bj][n] = *(const GAS f32x4*)(xin + off + bj * 128 + n * 16);
            }
#pragma unroll
            for (int m = 0; m < 4; ++m) {
                const size_t off = (size_t)(ai * 128 + wr * 64 + m * 16 + fr) * DM + col0;
#pragma unroll
                for (int bj = 0; bj < 2; ++bj)
#pragma unroll
                    for (int n = 0; n < 2; ++n) *(GAS f32x4*)(xo + off + bj * 128 + n * 16) = xv[m][bj][n] + g4[bj][n] * acc[ai][bj][m][n];
            }
            __builtin_amdgcn_sched_group_barrier(0x020, 16, 0);
            asm volatile("" ::: "memory");
            __builtin_amdgcn_sched_barrier(0);
        }
    }
};

struct EpiIn {
    int layer;
    const float *qn_g, *kn_g, *dqn_g, *dkn_g;
    const float *r64c, *r64s, *r32c, *r32s;
    bf16_t *QG, *QD, *KG, *VG, *KD, *VD, *CB, *PB;
    float* out;
    __device__ __forceinline__ void operator()(const Acc& acc, const pg8::Unit& u, int wr, int wc, int fr, int fq, LAS unsigned char*) const {
        const TileInfo ti(u.pm);
        const int pn = u.pn;
        const int rbase = wr * 64 + fr;
        if (pn < 2 || (pn == 2 && wc < 2)) {
            const bool isq = pn < 2;
            const float* gsrc = (isq ? qn_g : kn_g) + 4 * fq;
            const int head = isq ? 4 * pn + wc : wc;
            f32x4 g4[2][2], rc[2], rs[2];
#pragma unroll
            for (int bj = 0; bj < 2; ++bj)
#pragma unroll
                for (int n = 0; n < 2; ++n) g4[bj][n] = *(const GAS f32x4*)(gsrc + 32 * bj + 16 * n);
#pragma unroll
            for (int ai = 0; ai < 2; ++ai) { const int pos = (ti.t0 >> 6) + 2 * ai + wr; rc[ai] = *(const GAS f32x4*)(r64c + pos * 16 + 4 * fq); rs[ai] = *(const GAS f32x4*)(r64s + pos * 16 + 4 * fq); }
            float ss[8];
#pragma unroll
            for (int ai = 0; ai < 2; ++ai)
#pragma unroll
                for (int m = 0; m < 4; ++m) { float t_ = 0.f;
#pragma unroll
                    for (int bj = 0; bj < 2; ++bj)
#pragma unroll
                        for (int n = 0; n < 2; ++n) { const f32x4 v = acc[ai][bj][m][n]; t_ += (v[0] * v[0] + v[1] * v[1]) + (v[2] * v[2] + v[3] * v[3]); }
                    ss[ai * 4 + m] = t_; }
#pragma unroll
            for (int i = 0; i < 8; ++i) ss[i] += __shfl_xor(ss[i], 16);
#pragma unroll
            for (int i = 0; i < 8; ++i) ss[i] += __shfl_xor(ss[i], 32);
#pragma unroll
            for (int mh = 0; mh < 2; ++mh) {
                f32x4 cc[2], cs[2];
#pragma unroll
                for (int mm = 0; mm < 2; ++mm) { const int pos = 16 * (2 * mh + mm) + fr; cc[mm] = *(const GAS f32x4*)(r64c + pos * 16 + 4 * fq); cs[mm] = *(const GAS f32x4*)(r64s + pos * 16 + 4 * fq); }
                if (mh == 0) __builtin_amdgcn_sched_group_barrier(0x020, 12, 0); else __builtin_amdgcn_sched_group_barrier(0x020, 4, 0);
#pragma unroll
                for (int mm = 0; mm < 2; ++mm)
#pragma unroll
                    for (int ai = 0; ai < 2; ++ai) {
                        const int m = 2 * mh + mm;
                        const int rt = ai * 128 + m * 16 + rbase; const int t = ti.t0 + rt;
                        const float rstd = rsqrtf(ss[ai * 4 + m] * (1.f / 64.f) + EPS);
                        bf16_t* dst = isq ? QG + ((size_t)u.pm * 256 + rt) * 512 + head * 64 + 8 * fq : KG + ((ti.R * 2 + (long)head * ti.S + t) * 64) + 8 * fq;
                        float* o = out + OUT_GK + ((size_t)(ti.seq * 4 + layer) * 256 + t) * 128 + head * 64 + 4 * fq;
#pragma unroll
                        for (int bj = 0; bj < 2; ++bj) {
                            f32x4 y0 = acc[ai][bj][m][0] * rstd * g4[bj][0], y1 = acc[ai][bj][m][1] * rstd * g4[bj][1];
                            if (!isq && !ti.lat) { *(GAS f32x4*)(o + 32 * bj) = y0; *(GAS f32x4*)(o + 32 * bj + 16) = y1; }
                            if (ti.lat) {
                                const f32x4 c4 = bj ? cc[mm] : rc[ai], s4 = bj ? cs[mm] : rs[ai];
                                const f32x4 o0 = y0 * c4 - y1 * s4, o1 = y1 * c4 + y0 * s4; y0 = o0; y1 = o1;
                            }
                            if (isq) { y0 = y0 * QSCALE_G; y1 = y1 * QSCALE_G; }
                            u32x4 w; w.x = cvtpk(y0[0], y0[1]); w.y = cvtpk(y0[2], y0[3]); w.z = cvtpk(y1[0], y1[1]); w.w = cvtpk(y1[2], y1[3]);
                            *(GAS u32x4*)(dst + 32 * bj) = w;
                        }
                    }
                asm volatile("" ::: "memory"); __builtin_amdgcn_sched_barrier(0);
            }
        } else if (pn == 2) {
            const int head = wc - 2;
#pragma unroll
            for (int ai = 0; ai < 2; ++ai)
#pragma unroll
                for (int m = 0; m < 4; ++m) {
                    const int rt = ai * 128 + m * 16 + rbase; const int t = ti.t0 + rt;
                    if (!ti.lat) {
                        float* o = out + OUT_GV + ((size_t)(ti.seq * 4 + layer) * 256 + t) * 128 + head * 64 + 8 * fq;
#pragma unroll
                        for (int bj = 0; bj < 2; ++bj) { *(GAS f32x4*)(o + 32 * bj) = acc[ai][bj][m][0]; *(GAS f32x4*)(o + 32 * bj + 4) = acc[ai][bj][m][1]; }
                    }
                    bf16_t* vp = VG + ((ti.R * 2 + (long)head * ti.S + t) * 64) + 8 * fq;
#pragma unroll
                    for (int bj = 0; bj < 2; ++bj) { const f32x4 a = acc[ai][bj][m][0], b = acc[ai][bj][m][1]; u32x4 w; w.x = cvtpk(a[0], a[1]); w.y = cvtpk(a[2], a[3]); w.z = cvtpk(b[0], b[1]); w.w = cvtpk(b[2], b[3]); *(GAS u32x4*)(vp + 32 * bj) = w; }
                }
        } else if (pn == 3) {
#pragma unroll
            for (int ai = 0; ai < 2; ++ai)
#pragma unroll
                for (int m = 0; m < 4; ++m) {
                    const size_t grow = (size_t)u.pm * 256 + ai * 128 + m * 16 + rbase;
                    bf16_t* p = CB + grow * 256 + 32 * wc + 8 * fq;
#pragma unroll
                    for (int bj = 0; bj < 2; ++bj) { const f32x4 a = acc[ai][bj][m][0], b = acc[ai][bj][m][1]; u32x4 w; w.x = cvtpk(a[0], a[1]); w.y = cvtpk(a[2], a[3]); w.z = cvtpk(b[0], b[1]); w.w = cvtpk(b[2], b[3]); *(GAS u32x4*)(p + 128 * bj) = w; }
                }
        } else if (pn < 6) {
#pragma unroll
            for (int ai = 0; ai < 2; ++ai)
#pragma unroll
                for (int m = 0; m < 4; ++m) {
                    const size_t grow = (size_t)u.pm * 256 + ai * 128 + m * 16 + rbase;
                    bf16_t* p = PB + grow * 256 + 128 * (pn - 4) + 32 * wc + 8 * fq;
                    const f32x4 a = acc[ai][0][m][0] * acc[ai][1][m][0], b = acc[ai][0][m][1] * acc[ai][1][m][1];
                    u32x4 w; w.x = cvtpk(a[0], a[1]); w.y = cvtpk(a[2], a[3]); w.z = cvtpk(b[0], b[1]); w.w = cvtpk(b[2], b[3]); *(GAS u32x4*)p = w;
                }
        } else if (pn < 8) {
            const bool isq = pn == 6;
            const float* gsrc = isq ? dqn_g : dkn_g;
            const int a_ax = fq >> 1, ib = 4 * (fq & 1);
            const float* gp = gsrc + 16 * a_ax + ib;
            const int head = wc;
            const f32x4 g0 = *(const GAS f32x4*)gp, g1 = *(const GAS f32x4*)(gp + 8);
            f32x4 tc[4], ts[4];
#pragma unroll
            for (int j = 0; j < 4; ++j) { const int pos = a_ax ? (16 * j + fr) : ((ti.t0 >> 6) + 2 * (j & 1) + wr); tc[j] = *(const GAS f32x4*)(r32c + pos * 8 + ib); ts[j] = *(const GAS f32x4*)(r32s + pos * 8 + ib); }
            __builtin_amdgcn_sched_group_barrier(0x020, 10, 0);
#pragma unroll
            for (int ai = 0; ai < 2; ++ai) {
                float ss[4][2];
#pragma unroll
                for (int m = 0; m < 4; ++m)
#pragma unroll
                    for (int bj = 0; bj < 2; ++bj) { float t_ = 0.f;
#pragma unroll
                        for (int n = 0; n < 2; ++n) { const f32x4 v = acc[ai][bj][m][n]; t_ += (v[0] * v[0] + v[1] * v[1]) + (v[2] * v[2] + v[3] * v[3]); }
                        ss[m][bj] = t_; }
#pragma unroll
                for (int i = 0; i < 4; ++i) { ss[i][0] += __shfl_xor(ss[i][0], 16); ss[i][1] += __shfl_xor(ss[i][1], 16); }
#pragma unroll
                for (int i = 0; i < 4; ++i) { ss[i][0] += __shfl_xor(ss[i][0], 32); ss[i][1] += __shfl_xor(ss[i][1], 32); }
#pragma unroll
                for (int m = 0; m < 4; ++m) {
                    const int rt = ai * 128 + m * 16 + rbase; const int t = ti.t0 + rt; const size_t grow = (size_t)u.pm * 256 + rt;
                    const f32x4 c4 = a_ax ? tc[m] : tc[ai], s4 = a_ax ? ts[m] : ts[ai];
#pragma unroll
                    for (int bj = 0; bj < 2; ++bj) {
                        const float rstd = rsqrtf(ss[m][bj] * (1.f / 32.f) + EPS);
                        f32x4 y0 = acc[ai][bj][m][0] * rstd * g0, y1 = acc[ai][bj][m][1] * rstd * g1;
                        if (!isq && !ti.lat) {
                            float* o = out + OUT_DK + ((size_t)(ti.seq * 4 + layer) * 256 + t) * 256 + head * 64 + bj * 32 + 16 * a_ax + ib;
                            *(GAS f32x4*)(o) = y0; *(GAS f32x4*)(o + 8) = y1;
                        }
                        if (ti.lat) { const f32x4 o0 = y0 * c4 - y1 * s4, o1 = y1 * c4 + y0 * s4; y0 = o0; y1 = o1; }
                        bf16_t* dst;
                        if (isq) { y0 = y0 * QSCALE_D; y1 = y1 * QSCALE_D; dst = QD + grow * 256 + head * 64 + bj * 32 + 16 * a_ax + 2 * ib; }
                        else dst = KD + ((ti.R * 8 + (long)(head * 2 + bj) * ti.S + t) * 32) + 16 * a_ax + 2 * ib;
                        u32x4 w; w.x = cvtpk(y0[0], y0[1]); w.y = cvtpk(y0[2], y0[3]); w.z = cvtpk(y1[0], y1[1]); w.w = cvtpk(y1[2], y1[3]);
                        *(GAS u32x4*)dst = w;
                    }
                }
                asm volatile("" ::: "memory"); __builtin_amdgcn_sched_barrier(0);
            }
        } else {
            const int head = wc;
#pragma unroll
            for (int ai = 0; ai < 2; ++ai)
#pragma unroll
                for (int m = 0; m < 4; ++m) {
                    const int rt = ai * 128 + m * 16 + rbase; const int t = ti.t0 + rt;
                    if (!ti.lat) {
                        float* o = out + OUT_DV + ((size_t)(ti.seq * 4 + layer) * 256 + t) * 256 + head * 64 + 8 * fq;
#pragma unroll
                        for (int bj = 0; bj < 2; ++bj) { *(GAS f32x4*)(o + 32 * bj) = acc[ai][bj][m][0]; *(GAS f32x4*)(o + 32 * bj + 4) = acc[ai][bj][m][1]; }
                    }
                    bf16_t* vp = VD + ((ti.R * 4 + (long)head * ti.S + t) * 64) + 8 * fq;
#pragma unroll
                    for (int bj = 0; bj < 2; ++bj) { const f32x4 a = acc[ai][bj][m][0], b = acc[ai][bj][m][1]; u32x4 w; w.x = cvtpk(a[0], a[1]); w.y = cvtpk(a[2], a[3]); w.z = cvtpk(b[0], b[1]); w.w = cvtpk(b[2], b[3]); *(GAS u32x4*)(vp + 32 * bj) = w; }
                }
        }
    }
};

__device__ __forceinline__ float dpp_ror1(float x) { return __int_as_float(__builtin_amdgcn_update_dpp(0, __float_as_int(x), 0x121, 0xf, 0xf, false)); }
__device__ __forceinline__ float dpp_ror15(float x) { return __int_as_float(__builtin_amdgcn_update_dpp(0, __float_as_int(x), 0x12F, 0xf, 0xf, false)); }
__device__ __forceinline__ float silu_f(float x) { return x * __builtin_amdgcn_rcpf(1.f + __builtin_amdgcn_exp2f(-x * LOG2E)); }
struct EpiUp {
    const float* cw; const float* cbias; bf16_t* F; float* EP; float* EA; float* EU;
    __device__ __forceinline__ void operator()(const Acc& acc, const pg8::Unit& u, int wr, int wc, int fr, int fq, LAS unsigned char* xlds) const {
        const TileInfo ti(u.pm);
        const int c0 = u.pn * 128 + wc * 32 + 8 * fq;
        LAS float* X = (LAS float*)xlds;
#pragma unroll
        for (int ai = 0; ai < 2; ++ai) {
            if (fr == 0) { LAS float* p = X + ((((ai * 2 + wr) * 4 + wc) * 2 + 0) * 4 + fq) * 8; *(LAS f32x4*)p = acc[ai][0][0][0]; *(LAS f32x4*)(p + 4) = acc[ai][0][0][1]; }
            if (fr == 15) { LAS float* p = X + ((((ai * 2 + wr) * 4 + wc) * 2 + 1) * 4 + fq) * 8; *(LAS f32x4*)p = acc[ai][0][3][0]; *(LAS f32x4*)(p + 4) = acc[ai][0][3][1]; }
        }
        asm volatile("s_waitcnt lgkmcnt(0)" ::: "memory"); __builtin_amdgcn_s_barrier(); asm volatile("" ::: "memory");
        f32x4 w0[2], w1[2], w2[2], bb[2];
#pragma unroll
        for (int n = 0; n < 2; ++n) { w0[n] = *(const GAS f32x4*)(cw + c0 + 4 * n); w1[n] = *(const GAS f32x4*)(cw + DFF + c0 + 4 * n); w2[n] = *(const GAS f32x4*)(cw + 2 * DFF + c0 + 4 * n); bb[n] = *(const GAS f32x4*)(cbias + c0 + 4 * n); }
        const bool has_prev = ti.lat && ti.t0 > 0, has_next = ti.lat && ti.t0 < 4096 - 256;
#pragma unroll
        for (int ai = 0; ai < 2; ++ai) {
            f32x4 pb[2] = {(f32x4){0.f, 0.f, 0.f, 0.f}, (f32x4){0.f, 0.f, 0.f, 0.f}}, nb[2] = {(f32x4){0.f, 0.f, 0.f, 0.f}, (f32x4){0.f, 0.f, 0.f, 0.f}};
            { const int seg = ai * 2 + wr;
              if (seg > 0) { const int ps = seg - 1; LAS float* p = X + ((((ps >> 1) * 2 + (ps & 1)) * 4 + wc) * 2 + 1) * 32 + fq * 8; pb[0] = *(LAS f32x4*)p; pb[1] = *(LAS f32x4*)(p + 4); }
              if (seg < 3) { const int ns = seg + 1; LAS float* p = X + ((((ns >> 1) * 2 + (ns & 1)) * 4 + wc) * 2 + 0) * 32 + fq * 8; nb[0] = *(LAS f32x4*)p; nb[1] = *(LAS f32x4*)(p + 4); } }
#pragma unroll
            for (int m = 0; m < 4; ++m) {
                const int rt = ai * 128 + wr * 64 + m * 16 + fr; const size_t grow = (size_t)u.pm * 256 + rt;
                f32x4 fo[2], cv[2];
#pragma unroll
                for (int n = 0; n < 2; ++n) {
                    const f32x4 a = acc[ai][0][m][n];
                    const f32x4 up = (m > 0) ? acc[ai][0][m > 0 ? m - 1 : 0][n] : pb[n];
                    const f32x4 dn = (m < 3) ? acc[ai][0][m < 3 ? m + 1 : 3][n] : nb[n];
                    f32x4 pv, nx;
#pragma unroll
                    for (int e = 0; e < 4; ++e) {
                        pv[e] = dpp_ror1(fr == 15 ? up[e] : a[e]);
                        nx[e] = dpp_ror15(fr == 0 ? dn[e] : a[e]);
                    }
                    const f32x4 c = w0[n] * pv + w1[n] * a + w2[n] * nx + bb[n];
                    cv[n] = c;
                    const f32x4 uu = acc[ai][1][m][n];
#pragma unroll
                    for (int e = 0; e < 4; ++e) fo[n][e] = silu_f(c[e]) * uu[e];
                }
                u32x4 w; w.x = cvtpk(fo[0][0], fo[0][1]); w.y = cvtpk(fo[0][2], fo[0][3]); w.z = cvtpk(fo[1][0], fo[1][1]); w.w = cvtpk(fo[1][2], fo[1][3]);
                *(GAS u32x4*)(F + grow * DFF + c0) = w;
                if (ai == 0 && m == 0) { if (has_prev && rt == 0) { const size_t eo = ((size_t)u.pm * 2 + 0) * DFF + c0;
                        *(GAS f32x4*)(EP + eo) = cv[0]; *(GAS f32x4*)(EP + eo + 4) = cv[1]; *(GAS f32x4*)(EA + eo) = acc[0][0][0][0]; *(GAS f32x4*)(EA + eo + 4) = acc[0][0][0][1]; *(GAS f32x4*)(EU + eo) = acc[0][1][0][0]; *(GAS f32x4*)(EU + eo + 4) = acc[0][1][0][1]; } }
                if (ai == 1 && m == 3) { if (has_next && rt == 255) { const size_t eo = ((size_t)u.pm * 2 + 1) * DFF + c0;
                        *(GAS f32x4*)(EP + eo) = cv[0]; *(GAS f32x4*)(EP + eo + 4) = cv[1]; *(GAS f32x4*)(EA + eo) = acc[1][0][3][0]; *(GAS f32x4*)(EA + eo + 4) = acc[1][0][3][1]; *(GAS f32x4*)(EU + eo) = acc[1][1][3][0]; *(GAS f32x4*)(EU + eo + 4) = acc[1][1][3][1]; } }
            }
        }
        asm volatile("s_waitcnt lgkmcnt(0)" ::: "memory"); __builtin_amdgcn_s_barrier(); asm volatile("" ::: "memory");
    }
};

typedef short v4i16_t __attribute__((ext_vector_type(4)));
__device__ __forceinline__ s16x4 vtr(LAS const char* p) { return __builtin_bit_cast(s16x4, __builtin_amdgcn_ds_read_tr16_b64_v4i16((LAS v4i16_t*)p)); }
__device__ __forceinline__ float xhalf_max(float m) { auto rr = __builtin_amdgcn_permlane32_swap(__float_as_uint(m), __float_as_uint(m), false, false); return fmaxf(__uint_as_float(rr[0]), __uint_as_float(rr[1])); }
__device__ __forceinline__ float xhalf_sum(float m) { auto rr = __builtin_amdgcn_permlane32_swap(__float_as_uint(m), __float_as_uint(m), false, false); return __uint_as_float(rr[0]) + __uint_as_float(rr[1]); }

constexpr int ATT_VS = 192;
constexpr float ATT_THR = 8.f;
#define MX3(a, b, c) __builtin_fmaxf(__builtin_fmaxf((a), (b)), (c))
template <int DQK, bool YORD>
__device__ __forceinline__ void flash_pass(const bf16_t* __restrict__ Qw, int qpitch, const bf16_t* __restrict__ Kg, const bf16_t* __restrict__ Vg, int NT, int tst,
                                           LAS char* lds, f32x16 (&o)[2], float& lsum) {
#define ATT_TI(T) (((T) + tst) < NT ? ((T) + tst) : ((T) + tst - NT))
    constexpr int KS = DQK * 2 + 16, KBUF = 64 * KS, VBUF = 64 * ATT_VS, NDS = DQK / 16;
    constexpr int KROWB = DQK * 2;
    const int tid = opaque_tid(), lane = tid & 63, r32 = lane & 31, h = lane >> 5;
    LAS char* Kb = lds; LAS char* Vb = lds + 2 * KBUF;
    bf16x8 qf[NDS];
#pragma unroll
    for (int ds = 0; ds < NDS; ++ds) qf[ds] = *(const GAS bf16x8*)(Qw + (size_t)r32 * qpitch + 16 * ds + 8 * h);
    const bool kload = (tid * 16) < 64 * KROWB;
    const int krow = (tid * 16) / KROWB, kcb = (tid * 16) % KROWB;
    const int kdst = krow * KS + kcb, vdst = (tid >> 3) * ATT_VS + (tid & 7) * 16;
    const char* kg = (const char*)Kg + tid * 16; const char* vg = (const char*)Vg + tid * 16;
    u32x4 kreg = {0, 0, 0, 0}, vreg;
    {
        u32x4 k1 = {0, 0, 0, 0};
        if (kload) { kreg = *(const GAS u32x4*)(kg + (size_t)ATT_TI(0) * 64 * KROWB); k1 = *(const GAS u32x4*)(kg + (size_t)ATT_TI(1) * 64 * KROWB); }
        vreg = *(const GAS u32x4*)(vg + (size_t)ATT_TI(0) * 64 * 128);
        if (kload) { *(LAS u32x4*)(Kb + kdst) = kreg; *(LAS u32x4*)(Kb + KBUF + kdst) = k1; }
        *(LAS u32x4*)(Vb + vdst) = vreg;
        *(LAS u32x4*)(Vb + 2 * VBUF + vdst) = (u32x4){0, 0, 0, 0};
    }
    __syncthreads();
    const int kfo = r32 * KS + h * 16;
    const int vfo = (4 * h + ((lane & 15) >> 2)) * ATT_VS + (((lane >> 4) & 1) * 16 + (lane & 3) * 4) * 2;
    f32x16 p0 = (f32x16){}, p1 = (f32x16){};
#pragma unroll
    for (int ds = 0; ds < NDS; ++ds) {
        const bf16x8 k0 = *(LAS const bf16x8*)(Kb + kfo + ds * 32), k1 = *(LAS const bf16x8*)(Kb + kfo + 32 * KS + ds * 32);
        p0 = __builtin_amdgcn_mfma_f32_32x32x16_bf16(k0, qf[ds], p0, 0, 0, 0);
        p1 = __builtin_amdgcn_mfma_f32_32x32x16_bf16(k1, qf[ds], p1, 0, 0, 0);
    }
    __syncthreads();
    float mref, l = 0.f;
    {
        float a = MX3(p0[0], p0[1], p1[0]), b = MX3(p0[2], p0[3], p1[1]); a = MX3(a, p1[2], p1[3]);
#pragma unroll
        for (int r = 4; r < 16; r += 4) { a = MX3(a, p0[r], p0[r + 1]); b = MX3(b, p0[r + 2], p0[r + 3]); a = MX3(a, p1[r], p1[r + 1]); b = MX3(b, p1[r + 2], p1[r + 3]); }
        mref = xhalf_max(fmaxf(a, b));
#pragma unroll
        for (int r = 0; r < 16; ++r) { p0[r] -= mref; p1[r] -= mref; }
    }
    f32x16 negm;
#pragma unroll
    for (int r = 0; r < 16; ++r) negm[r] = -mref;
    asm volatile("" : "+v"(negm));
    o[0] = (f32x16){}; o[1] = (f32x16){};
    bf16x8 pk[4] = {};
    int vs_prev = 2 * VBUF, vs_cur = 0, vs_next = VBUF;
#define ATT_MPART(N0, N1, T) do { \
        LAS const char* kb_ = Kb + ((((T) + 1) & 1) * KBUF) + kfo; LAS const char* vb_ = Vb + vs_prev + vfo; \
        bf16x8 kf_[2 * NDS]; s16x4 vl_[8], vh_[8]; \
        _Pragma("unroll") for (int ds = 0; ds < NDS; ++ds) { kf_[2 * ds] = *(LAS const bf16x8*)(kb_ + ds * 32); kf_[2 * ds + 1] = *(LAS const bf16x8*)(kb_ + 32 * KS + ds * 32); } \
        _Pragma("unroll") for (int s_ = 0; s_ < 4; ++s_) { _Pragma("unroll") for (int db_ = 0; db_ < 2; ++db_) { \
            vl_[2 * s_ + db_] = vtr(vb_ + (16 * s_) * ATT_VS + db_ * 64); vh_[2 * s_ + db_] = vtr(vb_ + (16 * s_ + 8) * ATT_VS + db_ * 64); } } \
        N0 = __builtin_amdgcn_mfma_f32_32x32x16_bf16(kf_[0], qf[0], negm, 0, 0, 0); N1 = __builtin_amdgcn_mfma_f32_32x32x16_bf16(kf_[1], qf[0], negm, 0, 0, 0); \
        _Pragma("unroll") for (int ds = 1; ds < NDS; ++ds) { \
            N0 = __builtin_amdgcn_mfma_f32_32x32x16_bf16(kf_[2 * ds], qf[ds], N0, 0, 0, 0); N1 = __builtin_amdgcn_mfma_f32_32x32x16_bf16(kf_[2 * ds + 1], qf[ds], N1, 0, 0, 0); } \
        _Pragma("unroll") for (int s_ = 0; s_ < 4; ++s_) { _Pragma("unroll") for (int db_ = 0; db_ < 2; ++db_) { \
            const bf16x8 vf_ = __builtin_shufflevector(vl_[2 * s_ + db_], vh_[2 * s_ + db_], 0, 1, 2, 3, 4, 5, 6, 7); \
            o[db_] = __builtin_amdgcn_mfma_f32_32x32x16_bf16(vf_, pk[s_], o[db_], 0, 0, 0); } } \
        __builtin_amdgcn_sched_group_barrier(0x100, 2 * NDS + 8, 0); __builtin_amdgcn_sched_group_barrier(0x008, 2 * NDS, 0); \
        __builtin_amdgcn_sched_group_barrier(0x100, 8, 0); __builtin_amdgcn_sched_group_barrier(0x008, 8, 0); } while (0)
#define ATT_VPART(P0, P1, N0, N1) do { \
        float a = MX3(P0[0], P0[1], P1[0]), b = MX3(P0[2], P0[3], P1[1]); a = MX3(a, P1[2], P1[3]); \
        _Pragma("unroll") for (int r = 4; r < 16; r += 4) { a = MX3(a, P0[r], P0[r + 1]); b = MX3(b, P0[r + 2], P0[r + 3]); a = MX3(a, P1[r], P1[r + 1]); b = MX3(b, P1[r + 2], P1[r + 3]); } \
        const float mt = xhalf_max(fmaxf(a, b)); \
        resc = __any(mt > ATT_THR); \
        if (__builtin_expect(resc, 0)) { \
            const float dl = fmaxf(mt, 0.f); mref += dl; fsc = __builtin_amdgcn_exp2f(-dl); l *= fsc; \
            _Pragma("unroll") for (int r = 0; r < 16; ++r) { P0[r] -= dl; P1[r] -= dl; } \
            if (!YORD) { _Pragma("unroll") for (int r = 0; r < 16; ++r) { N0[r] -= dl; N1[r] -= dl; o[0][r] *= fsc; o[1][r] *= fsc; } } \
            _Pragma("unroll") for (int r = 0; r < 16; ++r) negm[r] = -mref; \
            asm volatile("" : "+v"(negm)); } \
        float ps0 = 0.f, ps1 = 0.f; \
        _Pragma("unroll") for (int r = 0; r < 16; ++r) { P0[r] = __builtin_amdgcn_exp2f(P0[r]); P1[r] = __builtin_amdgcn_exp2f(P1[r]); ps0 += P0[r]; ps1 += P1[r]; } \
        l += ps0 + ps1; \
        _Pragma("unroll") for (int s = 0; s < 2; ++s) { u32x4 a4, b4; \
            a4.x = cvtpk(P0[8 * s + 0], P0[8 * s + 1]); a4.y = cvtpk(P0[8 * s + 2], P0[8 * s + 3]); a4.z = cvtpk(P0[8 * s + 4], P0[8 * s + 5]); a4.w = cvtpk(P0[8 * s + 6], P0[8 * s + 7]); \
            b4.x = cvtpk(P1[8 * s + 0], P1[8 * s + 1]); b4.y = cvtpk(P1[8 * s + 2], P1[8 * s + 3]); b4.z = cvtpk(P1[8 * s + 4], P1[8 * s + 5]); b4.w = cvtpk(P1[8 * s + 6], P1[8 * s + 7]); \
            pkn[s] = __builtin_bit_cast(bf16x8, a4); pkn[2 + s] = __builtin_bit_cast(bf16x8, b4); } } while (0)
#define ATT_STEP(P0, P1, N0, N1, T) do { \
        const bool more = (T) + 1 < NT, more2 = (T) + 2 < NT; \
        if (more2 && kload) kreg = *(const GAS u32x4*)(kg + (size_t)ATT_TI((T) + 2) * 64 * KROWB); \
        if (more) vreg = *(const GAS u32x4*)(vg + (size_t)ATT_TI((T) + 1) * 64 * 128); \
        float fsc = 1.f; bool resc; bf16x8 pkn[4]; \
        if (!YORD) { ATT_MPART(N0, N1, T); __builtin_amdgcn_sched_barrier(0); ATT_VPART(P0, P1, N0, N1); } \
        else { ATT_VPART(P0, P1, N0, N1); __builtin_amdgcn_sched_barrier(0); ATT_MPART(N0, N1, T); \
            if (__builtin_expect(resc, 0)) { _Pragma("unroll") for (int r = 0; r < 16; ++r) { o[0][r] *= fsc; o[1][r] *= fsc; } } } \
        _Pragma("unroll") for (int s = 0; s < 4; ++s) pk[s] = pkn[s]; \
        if (more2 && kload) *(LAS u32x4*)(Kb + ((T) & 1) * KBUF + kdst) = kreg; \
        if (more) *(LAS u32x4*)(Vb + vs_next + vdst) = vreg; \
        __syncthreads(); \
        vs_prev = vs_cur; vs_cur = vs_next; vs_next = (vs_next == 2 * VBUF) ? 0 : vs_next + VBUF; } while (0)
    f32x16 n0, n1;
    for (int t = 0; t < NT; t += 2) {
        ATT_STEP(p0, p1, n0, n1, t);
        ATT_STEP(n0, n1, p0, p1, t + 1);
    }
    {
        LAS const char* vb_ = Vb + vs_prev + vfo;
#pragma unroll
        for (int s_ = 0; s_ < 4; ++s_) {
#pragma unroll
            for (int db_ = 0; db_ < 2; ++db_) {
                const s16x4 lo_ = vtr(vb_ + (16 * s_) * ATT_VS + db_ * 64), hi_ = vtr(vb_ + (16 * s_ + 8) * ATT_VS + db_ * 64);
                const bf16x8 vf_ = __builtin_shufflevector(lo_, hi_, 0, 1, 2, 3, 4, 5, 6, 7);
                o[db_] = __builtin_amdgcn_mfma_f32_32x32x16_bf16(vf_, pk[s_], o[db_], 0, 0, 0);
            }
        }
    }
    __syncthreads();
#undef ATT_STEP
#undef ATT_TI
#undef ATT_VPART
#undef ATT_MPART
    lsum = xhalf_sum(l);
}

__device__ __forceinline__ void store_ot(const f32x16 (&o)[2], bf16_t* dst  , int h) {
#pragma unroll
    for (int db = 0; db < 2; ++db)
#pragma unroll
        for (int g = 0; g < 4; ++g) { u32x2 w; w.x = cvtpk(o[db][4 * g], o[db][4 * g + 1]); w.y = cvtpk(o[db][4 * g + 2], o[db][4 * g + 3]); *(GAS u32x2*)(dst + 32 * db + 8 * g + 4 * h) = w; }
}

#include <hip/hip_bf16.h>
namespace attn64 {
using bf16=__hip_bfloat16;
using bf16x8=__attribute__((ext_vector_type(8)))short;
using s16x4=__attribute__((ext_vector_type(4)))short;
using f32x16=__attribute__((ext_vector_type(16)))float;
using u32x4=__attribute__((ext_vector_type(4)))unsigned;
constexpr int D=64;
constexpr int NW=8,QBLK=32,QB=QBLK*NW,KVBLK=64;

__device__ __forceinline__ int crow(int r,int hi){return (r&3)+8*(r>>2)+4*hi;}
#define SBAR() __builtin_amdgcn_sched_barrier(0)
__device__ __forceinline__ void cmask(f32x16&p0,f32x16&p1,int jb,int qrel,int hi){
  const float NEG=-INFINITY; int kb=64*jb+4*hi;
  #pragma unroll
  for(int r=0;r<16;++r){int kv=kb+(r&3)+8*(r>>2); if(kv>qrel)p0[r]=NEG; if(kv+32>qrel)p1[r]=NEG;}
}

constexpr int NSLOT=3, SLOTB=8192;
constexpr int LDS_K=0, LDS_V=NSLOT*SLOTB, LDS_WS=2*NSLOT*SLOTB, LDS_OST=LDS_WS+NW*64*4, LDS_BYTES=LDS_OST+NW*4096;
constexpr float C2=0.125f*1.4426950408889634f;
__device__ __forceinline__ void glds16(const void*gsrc,unsigned lds_dst){unsigned keep;
  asm volatile("s_mov_b32 %0, m0\n\ts_mov_b32 m0, %2\n\ts_nop 0\n\tglobal_load_lds_dwordx4 %1, off\n\ts_mov_b32 m0, %0":"=&s"(keep):"v"(gsrc),"s"(lds_dst):"memory");}
__device__ __forceinline__ float max3f(float a,float b,float c){float r;asm("v_max3_f32 %0, %1, %2, %3":"=v"(r):"v"(a),"v"(b),"v"(c));return r;}
__device__ __forceinline__ float max2f(float a,float b){float r;asm("v_max_f32_e32 %0, %1, %2":"=v"(r):"v"(a),"v"(b));return r;}
__device__ __forceinline__ float fadd_s(float a,float b){float r;asm("v_add_f32_e32 %0, %1, %2":"=v"(r):"v"(a),"v"(b));return r;}
__device__ __forceinline__ float fsub_s(float a,float b){float r;asm("v_sub_f32_e32 %0, %1, %2":"=v"(r):"v"(a),"v"(b));return r;}
typedef float f32x2_t __attribute__((ext_vector_type(2))); typedef __bf16 bf16x2_t __attribute__((ext_vector_type(2)));
__device__ __forceinline__ unsigned cvtpk_s(float lo,float hi){f32x2_t v={lo,hi};bf16x2_t b=__builtin_convertvector(v,bf16x2_t);return __builtin_bit_cast(unsigned,b);}
#define WAIT_BAR(N) asm volatile("s_waitcnt vmcnt(" #N ") lgkmcnt(0)\n\ts_barrier":::"memory")

template<int NDS_> __device__ __forceinline__ void qkt(f32x16&p0,f32x16&p1,const char*Kslot,const bf16x8*qr,const f32x16&negm,int r32,int hi){
  const char*kb=Kslot+hi*1024+r32*16;
  #pragma unroll
  for(int d0=0;d0<NDS_;++d0){
    const bf16x8 b0=*reinterpret_cast<const bf16x8*>(kb+d0*2048);
    const bf16x8 b1=*reinterpret_cast<const bf16x8*>(kb+d0*2048+512);
    if(d0==0){p0=__builtin_amdgcn_mfma_f32_32x32x16_bf16(b0,qr[0],negm,0,0,0);p1=__builtin_amdgcn_mfma_f32_32x32x16_bf16(b1,qr[0],negm,0,0,0);}
    else{p0=__builtin_amdgcn_mfma_f32_32x32x16_bf16(b0,qr[d0],p0,0,0,0);p1=__builtin_amdgcn_mfma_f32_32x32x16_bf16(b1,qr[d0],p1,0,0,0);}}
}
typedef __attribute__((address_space(3))) const char* lds_cptr;
typedef short v4i16_t __attribute__((ext_vector_type(4)));
__device__ __forceinline__ void kload8(bf16x8*kf,lds_cptr kp){
  kf[0]=*(const __attribute__((address_space(3))) bf16x8*)(kp);      kf[1]=*(const __attribute__((address_space(3))) bf16x8*)(kp+512);
  kf[2]=*(const __attribute__((address_space(3))) bf16x8*)(kp+2048); kf[3]=*(const __attribute__((address_space(3))) bf16x8*)(kp+2560);
  kf[4]=*(const __attribute__((address_space(3))) bf16x8*)(kp+4096); kf[5]=*(const __attribute__((address_space(3))) bf16x8*)(kp+4608);
  kf[6]=*(const __attribute__((address_space(3))) bf16x8*)(kp+6144); kf[7]=*(const __attribute__((address_space(3))) bf16x8*)(kp+6656);
}
__device__ __forceinline__ void kload2(bf16x8*kf,lds_cptr kp,int j){ kf[2*j]=*(const __attribute__((address_space(3))) bf16x8*)(kp+j*2048); kf[2*j+1]=*(const __attribute__((address_space(3))) bf16x8*)(kp+j*2048+512); }
__device__ __forceinline__ s16x4 vtr(lds_cptr p){ return __builtin_bit_cast(s16x4,__builtin_amdgcn_ds_read_tr16_b64_v4i16((__attribute__((address_space(3))) v4i16_t*)p)); }
__device__ __forceinline__ float rowmax(const f32x16&p0,const f32x16&p1){
  float a=max3f(p0[0],p0[1],p1[0]),b=max3f(p0[2],p0[3],p1[1]);a=max3f(a,p1[2],p1[3]);
  #pragma unroll
  for(int r=4;r<16;r+=4){a=max3f(a,p0[r],p0[r+1]);b=max3f(b,p0[r+2],p0[r+3]);a=max3f(a,p1[r],p1[r+1]);b=max3f(b,p1[r+2],p1[r+3]);}
  const float m=max2f(a,b);
  auto rr=__builtin_amdgcn_permlane32_swap(__float_as_uint(m),__float_as_uint(m),false,false);
  return max2f(__uint_as_float(rr[0]),__uint_as_float(rr[1]));
}
__device__ __forceinline__ void pv(f32x16*o,int vb,bf16x8 pa0,bf16x8 pa1,bf16x8 pa2,bf16x8 pa3){
  #pragma unroll
  for(int d0=0;d0<2;++d0){s16x4 lo[4],hi[4];
    #pragma unroll
    for(int ks=0;ks<4;++ks){
      asm volatile("ds_read_b64_tr_b16 %0,%1 offset:%c2":"=&v"(lo[ks]):"v"(vb),"i"(d0*4096+ks*1024):"memory");
      asm volatile("ds_read_b64_tr_b16 %0,%1 offset:%c2":"=&v"(hi[ks]):"v"(vb),"i"(d0*4096+ks*1024+512):"memory");}
    asm volatile("s_waitcnt lgkmcnt(0)":::"memory");SBAR();
    #define PK(k) (bf16x8){lo[k][0],lo[k][1],lo[k][2],lo[k][3],hi[k][0],hi[k][1],hi[k][2],hi[k][3]}
    o[d0]=__builtin_amdgcn_mfma_f32_32x32x16_bf16(pa0,PK(0),o[d0],0,0,0);
    o[d0]=__builtin_amdgcn_mfma_f32_32x32x16_bf16(pa1,PK(1),o[d0],0,0,0);
    o[d0]=__builtin_amdgcn_mfma_f32_32x32x16_bf16(pa2,PK(2),o[d0],0,0,0);
    o[d0]=__builtin_amdgcn_mfma_f32_32x32x16_bf16(pa3,PK(3),o[d0],0,0,0);
    #undef PK
  }
}

#ifndef ATTN_STORE16
#define ATTN_STORE16(p,v) (*(GAS u32x4*)(p)=(v))
#endif
__device__ __forceinline__ void stage_store(const f32x16 (&o)[2],bf16*Ow,int op,char*shm,int wid,int lane,int r32,int hi){
  bf16*stg=(bf16*)(shm+LDS_OST)+wid*2048;
  #pragma unroll
  for(int r=0;r<16;++r){const int orow=crow(r,hi);
    #pragma unroll
    for(int d0=0;d0<2;++d0)stg[orow*64+d0*32+r32]=__float2bfloat16(o[d0][r]);}
  asm volatile("s_waitcnt lgkmcnt(0)":::"memory");
  #pragma unroll
  for(int i=0;i<4;++i){const int row=i*8+(lane>>3),ch=lane&7; const u32x4 v=*(const u32x4*)(stg+row*64+ch*8); ATTN_STORE16(Ow+(long)row*op+ch*8,v);}
}
template<int THRL,int MODE,int DQ> __device__ __forceinline__ void attn_unit(const bf16*Qw0,int qp,const bf16*__restrict__ Kh,int kp,const bf16*__restrict__ Vh,int vp,int NT,bf16*Ow0,int op,char*shm,f32x16 (&oret)[2]){
  constexpr int NDS=DQ/16;
  const int tid=opaque_tid(),lane=tid&63,r32=lane&31,hi=lane>>5; const int wid=__builtin_amdgcn_readfirstlane(tid>>6);
  const bf16*Qw=Qw0+(long)(wid*QBLK)*qp;
  const unsigned lds0=(unsigned)(uintptr_t)shm;
  float*wsf=(float*)(shm+LDS_WS)+wid*64;
  const int kch=(DQ==64)?wid:(wid&3);
  const bf16*ksrc=Kh+(long)lane*kp+kch*8;
  const bf16*vsrc=Vh+(long)(16*(wid&3)+(lane>>2))*vp+(wid>>2)*32+(lane&3)*8;
  const unsigned kdst=lds0+LDS_K+kch*1024, vdst=lds0+LDS_V+wid*1024;
  #define DMA_K(t,slot) glds16(ksrc+(long)(t)*KVBLK*kp,(unsigned)__builtin_amdgcn_readfirstlane(kdst+(slot)))
  #define DMA_V(t,slot) glds16(vsrc+(long)(t)*KVBLK*vp,(unsigned)__builtin_amdgcn_readfirstlane(vdst+(slot)))
  const int vb0=(int)(lds0+LDS_V)+((lane>>4)&1)*32+(lane&3)*8+(4*hi+((lane&15)>>2))*64;
  const char*Kbase=shm+LDS_K; bf16x8 kf[8];
  const lds_cptr shm3=(lds_cptr)shm; const lds_cptr kp0=shm3+LDS_K+hi*1024+r32*16; const lds_cptr vp0=shm3+LDS_V+((lane>>4)&1)*32+(lane&3)*8+(4*hi+((lane&15)>>2))*64;
  DMA_K(0,0);DMA_V(0,0);DMA_K(1,SLOTB);
  bf16x8 qr[4];
  #pragma unroll
  for(int d0=0;d0<NDS;++d0)qr[d0]=*(const GAS bf16x8*)(&Qw[(long)r32*qp+d0*16+hi*8]);
  float mhat=0.f,l_reg=0.f;f32x16 o[2];o[0]=f32x16{};o[1]=f32x16{};f32x16 negm=f32x16{};asm volatile("":"+v"(negm));
  #define CMASK(P0,P1,t) do{}while(0)
  bool resc=false;
  #define START(P0,P1) do{ const float rm=rowmax(P0,P1); resc=false; \
    { const float dl=rm; mhat=fadd_s(mhat,dl); \
      _Pragma("unroll") for(int r=0;r<16;++r){P0[r]=fsub_s(P0[r],dl);P1[r]=fsub_s(P1[r],dl);} \
      _Pragma("unroll") for(int r=0;r<16;++r)negm[r]=-mhat; asm volatile("":"+v"(negm)); } \
    _Pragma("unroll") for(int r=0;r<16;++r)P0[r]=__builtin_amdgcn_exp2f(P0[r]); }while(0)
  #define RESC() do{ if(resc){ asm volatile("s_waitcnt lgkmcnt(0)":::"memory"); \
      _Pragma("unroll") for(int d_=0;d_<2;++d_) _Pragma("unroll") for(int r=0;r<16;++r)o[d_][r]*=wsf[crow(r,hi)]; } }while(0)
  f32x16 pA0,pA1,pB0,pB1;
  int sl_prev=0,sl_cur=0,sl_next=SLOTB;
  #define ROT() do{sl_prev=sl_cur;sl_cur=sl_next;sl_next=(sl_next==(NSLOT-1)*SLOTB)?0:sl_next+SLOTB;}while(0)
  DMA_K(2,2*SLOTB);
  WAIT_BAR(3);
  qkt<NDS>(pA0,pA1,Kbase,qr,negm,r32,hi);asm volatile("s_nop 15\n\ts_nop 7":"+v"(pA0),"+v"(pA1));CMASK(pA0,pA1,0);
  START(pA0,pA1);
  _Pragma("unroll") for(int r=0;r<16;++r)pA1[r]=__builtin_amdgcn_exp2f(pA1[r]);
  WAIT_BAR(0);
  DMA_K(3,0);DMA_V(1,SLOTB);
  ROT();
  if constexpr(DQ==64) kload8(kf,kp0+sl_cur); else { kload2(kf,kp0+sl_cur,0); kload2(kf,kp0+sl_cur,1); }
  WAIT_BAR(2);
  s16x4 vlo[8],vhi[8]; u32x4 pw0,pw1,pw2,pw3;
  #define PKW(P,B) cvtpk_s(P[B],P[B+1])
  #define PAF(k) __builtin_bit_cast(bf16x8,pw##k)
  #define VFR(i) (bf16x8){vlo[i][0],vlo[i][1],vlo[i][2],vlo[i][3],vhi[i][0],vhi[i][1],vhi[i][2],vhi[i][3]}
  #define PIN(x) asm volatile("":"+v"(x))
  #define MX3(a,b,c) __builtin_fmaxf(__builtin_fmaxf((a),(b)),(c))
  #define GAPA(MF,A0,A1,A2,A3,W0,W1,PW) do{ MF; sacc+=A0; sacc+=A1; sacc+=A2; sacc+=A3; PIN(sacc); W0; W1; PIN(PW); SBAR(); }while(0)
  #define EX(v) __builtin_amdgcn_exp2f(v)
  #define GAPB(MF,X,B) do{ MF; X[B]=EX(X[B]); X[B+1]=EX(X[B+1]); X[B+2]=EX(X[B+2]); X[B+3]=EX(X[B+3]); PIN(X); SBAR(); }while(0)
  #define VRD(i) do{ vlo[i]=vtr(vp_+(((i)>>2)*4096+((i)&3)*1024)); vhi[i]=vtr(vp_+(((i)>>2)*4096+((i)&3)*1024+512)); }while(0)
  #define KRD(G,j) do{ if(G){ kload2(kf,kp0+sl_next,j); SBAR(); } }while(0)
  #define STEP(C0,C1,P0,P1,t,GK,GV,GL) do{ SBAR(); \
    const lds_cptr vp_=vp0+sl_prev; \
    VRD(0); SBAR(); float sacc=(P0[0]+P0[1]); \
    GAPA(C0=__builtin_amdgcn_mfma_f32_32x32x16_bf16(kf[0],qr[0],negm,0,0,0), P0[2],P0[3],P0[4],P0[5],     pw0[0]=PKW(P0,0), pw0[1]=PKW(P0,2), pw0); \
    VRD(4); SBAR(); GAPA(C1=__builtin_amdgcn_mfma_f32_32x32x16_bf16(kf[1],qr[0],negm,0,0,0), P0[6],P0[7],P0[8],P0[9],     pw0[2]=PKW(P0,4), pw0[3]=PKW(P0,6), pw0); \
    VRD(1); SBAR(); GAPA(C0=__builtin_amdgcn_mfma_f32_32x32x16_bf16(kf[2],qr[1],C0,0,0,0),   P0[10],P0[11],P0[12],P0[13], pw1[0]=PKW(P0,8), pw1[1]=PKW(P0,10), pw1); \
    VRD(5); SBAR(); GAPA(C1=__builtin_amdgcn_mfma_f32_32x32x16_bf16(kf[3],qr[1],C1,0,0,0),   P0[14],P0[15],P1[0],P1[1],   pw1[2]=PKW(P0,12),pw1[3]=PKW(P0,14), pw1); \
    VRD(2); SBAR(); GAPA(if constexpr(DQ==64) C0=__builtin_amdgcn_mfma_f32_32x32x16_bf16(kf[4],qr[2],C0,0,0,0),   P1[2],P1[3],P1[4],P1[5],     pw2[0]=PKW(P1,0), pw2[1]=PKW(P1,2), pw2); \
    VRD(6); SBAR(); GAPA(if constexpr(DQ==64) C1=__builtin_amdgcn_mfma_f32_32x32x16_bf16(kf[5],qr[2],C1,0,0,0),   P1[6],P1[7],P1[8],P1[9],     pw2[2]=PKW(P1,4), pw2[3]=PKW(P1,6), pw2); \
    VRD(3); SBAR(); GAPA(if constexpr(DQ==64) C0=__builtin_amdgcn_mfma_f32_32x32x16_bf16(kf[6],qr[3],C0,0,0,0),   P1[10],P1[11],P1[12],P1[13], pw3[0]=PKW(P1,8), pw3[1]=PKW(P1,10), pw3); \
    VRD(7); SBAR(); GAPA(if constexpr(DQ==64) C1=__builtin_amdgcn_mfma_f32_32x32x16_bf16(kf[7],qr[3],C1,0,0,0),   P1[14],P1[15],0.f,0.f,       pw3[2]=PKW(P1,12),pw3[3]=PKW(P1,14), pw3); \
    l_reg+=sacc; \
    if(GK){DMA_K((t)+3,sl_cur);} if(GV){DMA_V((t)+1,sl_next);} \
    CMASK(C0,C1,t); \
    { float a=MX3(C0[0],C0[1],C1[0]),b=MX3(C0[2],C0[3],C1[1]); a=MX3(a,C1[2],C1[3]); \
      _Pragma("unroll") for(int r=4;r<16;r+=4){a=MX3(a,C0[r],C0[r+1]);b=MX3(b,C0[r+2],C0[r+3]);a=MX3(a,C1[r],C1[r+1]);b=MX3(b,C1[r+2],C1[r+3]);} \
      float rm=__builtin_fmaxf(a,b); { auto rr=__builtin_amdgcn_permlane32_swap(__float_as_uint(rm),__float_as_uint(rm),false,false); rm=__builtin_fmaxf(__uint_as_float(rr[0]),__uint_as_float(rr[1])); } \
      resc=false; \
      if(__builtin_expect(__any(rm>(float)THRL),0)){ const float dl=__builtin_fmaxf(rm,0.f); mhat+=dl; \
        _Pragma("unroll") for(int r=0;r<16;++r){C0[r]-=dl;C1[r]-=dl;} \
        _Pragma("unroll") for(int r=0;r<16;++r)negm[r]=-mhat; asm volatile("":"+v"(negm)); \
        const float f=__builtin_amdgcn_exp2f(-dl); l_reg*=f; if(hi==0)wsf[r32]=f; resc=true; } } \
    SBAR(); \
    GAPB(o[0]=__builtin_amdgcn_mfma_f32_32x32x16_bf16(PAF(0),VFR(0),o[0],0,0,0), C0,0); \
    GAPB(o[1]=__builtin_amdgcn_mfma_f32_32x32x16_bf16(PAF(0),VFR(4),o[1],0,0,0), C0,4); \
    KRD(GL,0); GAPB(o[0]=__builtin_amdgcn_mfma_f32_32x32x16_bf16(PAF(1),VFR(1),o[0],0,0,0), C0,8); \
    KRD(GL,1); GAPB(o[1]=__builtin_amdgcn_mfma_f32_32x32x16_bf16(PAF(1),VFR(5),o[1],0,0,0), C0,12); \
    if constexpr(DQ==64) KRD(GL,2); GAPB(o[0]=__builtin_amdgcn_mfma_f32_32x32x16_bf16(PAF(2),VFR(2),o[0],0,0,0), C1,0); \
    if constexpr(DQ==64) KRD(GL,3); GAPB(o[1]=__builtin_amdgcn_mfma_f32_32x32x16_bf16(PAF(2),VFR(6),o[1],0,0,0), C1,4); \
    GAPB(o[0]=__builtin_amdgcn_mfma_f32_32x32x16_bf16(PAF(3),VFR(3),o[0],0,0,0), C1,8); \
    GAPB(o[1]=__builtin_amdgcn_mfma_f32_32x32x16_bf16(PAF(3),VFR(7),o[1],0,0,0), C1,12); \
    }while(0)
  int t=1;
  #undef CMASK
  #define CMASK(P0,P1,t) do{}while(0)
  for(;t+5<NT;t+=2){
    STEP(pB0,pB1,pA0,pA1,t,true,true,true);     WAIT_BAR(2); RESC(); ROT();
    STEP(pA0,pA1,pB0,pB1,t+1,true,true,true);   WAIT_BAR(2); RESC(); ROT();
  }
  #undef CMASK
  #define CMASK(P0,P1,t) do{}while(0)
  #define ENDW(tt) do{ if((tt)+3<NT){WAIT_BAR(2);} else if((tt)+2<NT){WAIT_BAR(1);} else {WAIT_BAR(0);} }while(0)
  for(;t+1<NT;t+=2){
    STEP(pB0,pB1,pA0,pA1,t,(t+3<NT),(t+1<NT),(t+1<NT));       ENDW(t);   RESC(); ROT();
    STEP(pA0,pA1,pB0,pB1,t+1,(t+4<NT),(t+2<NT),(t+2<NT));     ENDW(t+1); RESC(); ROT();
  }
  STEP(pB0,pB1,pA0,pA1,NT-1,false,false,false); RESC();
  { float sacc=pB0[0]+pB0[1]; _Pragma("unroll") for(int r=2;r<16;++r)sacc+=pB0[r]; _Pragma("unroll") for(int r=0;r<16;++r)sacc+=pB1[r]; l_reg+=sacc;
    pw0=(u32x4){PKW(pB0,0),PKW(pB0,2),PKW(pB0,4),PKW(pB0,6)};pw1=(u32x4){PKW(pB0,8),PKW(pB0,10),PKW(pB0,12),PKW(pB0,14)};pw2=(u32x4){PKW(pB1,0),PKW(pB1,2),PKW(pB1,4),PKW(pB1,6)};pw3=(u32x4){PKW(pB1,8),PKW(pB1,10),PKW(pB1,12),PKW(pB1,14)};
    SBAR(); pv(o,vb0+sl_cur,PAF(0),PAF(1),PAF(2),PAF(3)); }
  #undef PKW
  #undef PAF
  #undef VFR
  #undef PIN
  #undef MX3
  #undef GAPA
  #undef GAPB
  #undef EX
  #undef VRD
  #undef KRD
  #undef STEP
  #undef ENDW
  {auto rr=__builtin_amdgcn_permlane32_swap(__float_as_uint(l_reg),__float_as_uint(l_reg),false,false);l_reg=__uint_as_float(rr[0])+__uint_as_float(rr[1]);}
  if(hi==0)wsf[32+r32]=l_reg;asm volatile("s_waitcnt lgkmcnt(0)":::"memory");
  float rli[16];
  #pragma unroll
  for(int r=0;r<16;++r)rli[r]=__builtin_amdgcn_rcpf(wsf[32+crow(r,hi)]);
  #pragma unroll
  for(int r=0;r<16;++r){o[0][r]*=rli[r];o[1][r]*=rli[r];}
  if constexpr(MODE==0){ bf16*Ow=Ow0+(long)(wid*QBLK)*op; stage_store(o,Ow,op,shm,wid,lane,r32,hi); }
  else { oret[0]=o[0]; oret[1]=o[1]; }
  asm volatile("s_waitcnt lgkmcnt(0)\n\ts_barrier":::"memory");
  #undef DMA_K
  #undef DMA_V
  #undef CMASK
  #undef START
  #undef RESC
  #undef ROT
}
#undef SBAR
#undef WAIT_BAR
}

struct AttnArgs { const bf16_t *QG, *QD, *KG, *VG, *KD, *VD, *CB, *PB; bf16_t* MIX; const float* conv_w; const float* conv_b; const float* subln_g; float lam, lam_init; float* dscr; };

__device__ __forceinline__ void attn_gqa_unit(const AttnArgs& A, LAS char* lds, char* lds_generic, int lat, int seq, int qh, int qb) {
    const long R = lat ? 8192L + (long)SLAT * seq : 256L * seq; const int S = lat ? SLAT : 256;
    const size_t grow0 = (lat ? 8192 + (size_t)4096 * seq : (size_t)256 * seq) + 256 * qb;
    const int kvh = qh >> 2;
    int NT = S / 64; asm volatile("" : "+s"(NT));
    typedef attn64::bf16 abf;
    f32x16 dummy[2];
    attn64::attn_unit<8, 0, 64>((const abf*)(A.QG + grow0 * 512 + 64 * qh), 512, (const abf*)(A.KG + (R * 2 + (long)kvh * S) * 64), 64, (const abf*)(A.VG + (R * 2 + (long)kvh * S) * 64), 64, NT,
                                (abf*)(A.MIX + grow0 * 1024 + 64 * qh), 1024, lds_generic, dummy);
}
__device__ __forceinline__ void attn_diff_unit(const AttnArgs& A, LAS char* lds, char* lds_generic, int lat, int seq, int hd, int qb) {
    const int tid_ = opaque_tid(); const int wave = __builtin_amdgcn_readfirstlane(tid_ >> 6), lane = tid_ & 63, r32 = lane & 31, h = lane >> 5;
    const long R = lat ? 8192L + (long)SLAT * seq : 256L * seq; const int S = lat ? SLAT : 256;
    const size_t grow0 = (lat ? 8192 + (size_t)4096 * seq : (size_t)256 * seq) + 256 * qb;
    int NT = S / 64; asm volatile("" : "+s"(NT));
    typedef attn64::bf16 abf;
    const abf* V = (const abf*)(A.VD + (R * 4 + (long)hd * S) * 64);
    f32x16 oa[2], ob[2];
    attn64::attn_unit<8, 1, 32>((const abf*)(A.QD + grow0 * 256 + 64 * hd), 256, (const abf*)(A.KD + (R * 8 + (long)(hd * 2) * S) * 32), 32, V, 64, NT, (abf*)nullptr, 0, lds_generic, oa);
    GAS float* scr = (GAS float*)A.dscr + ((size_t)(blockIdx.x * 8 + wave) * 32) * 64 + lane;
#pragma unroll
    for (int d0 = 0; d0 < 2; ++d0)
#pragma unroll
        for (int r = 0; r < 16; ++r) scr[(d0 * 16 + r) * 64] = oa[d0][r];
    attn64::attn_unit<8, 1, 32>((const abf*)(A.QD + grow0 * 256 + 64 * hd + 32), 256, (const abf*)(A.KD + (R * 8 + (long)(hd * 2 + 1) * S) * 32), 32, V, 64, NT, (abf*)nullptr, 0, lds_generic, ob);
    float ss[16];
#pragma unroll
    for (int r = 0; r < 16; ++r) {
        const float v0 = scr[r * 64] - A.lam * ob[0][r], v1 = scr[(16 + r) * 64] - A.lam * ob[1][r];
        ob[0][r] = v0; ob[1][r] = v1; ss[r] = v0 * v0 + v1 * v1;
    }
#pragma unroll
    for (int o = 1; o < 32; o <<= 1)
#pragma unroll
        for (int r = 0; r < 16; ++r) ss[r] += __shfl_xor(ss[r], o);
    const float g0 = A.subln_g[r32], g1 = A.subln_g[32 + r32], sc = 1.f - A.lam_init;
#pragma unroll
    for (int r = 0; r < 16; ++r) { const float rstd = rsqrtf(ss[r] * (1.f / 64.f) + EPS) * sc; ob[0][r] *= rstd * g0; ob[1][r] *= rstd * g1; }
    attn64::stage_store(ob, (abf*)(A.MIX + (grow0 + 32 * wave) * 1024 + 768 + 64 * hd), 1024, lds_generic, wave, lane, r32, h);
}

__device__ __forceinline__ void attn_phase(const AttnArgs& A, LAS char* lds, char* lds_generic, int G) {
    for (int u = blockIdx.x; u < 2048; u += G) {
        if (u < 512) { const int b = u & 7, r = u >> 3; attn_diff_unit(A, lds, lds_generic, 1, b, r >> 4, r & 15); }
        else if (u < 1536) { const int v = u - 512, b = v & 7, r = v >> 3; attn_gqa_unit(A, lds, lds_generic, 1, b, r & 7, r >> 3); }
        else { const int v = u - 1536;
            if (v < 128) attn_diff_unit(A, lds, lds_generic, 0, v >> 2, v & 3, 0);
            else if (v < 256) { const int w = 2 * (v - 128); attn_gqa_unit(A, lds, lds_generic, 0, w >> 3, w & 7, 0); }
            else if (v >= 384) { const int w = 2 * (v - 384) + 1; attn_gqa_unit(A, lds, lds_generic, 0, w >> 3, w & 7, 0); } }
    }
    const int tid_c = opaque_tid();
    for (int idx = blockIdx.x * 512 + tid_c; idx < M_ALL * 32; idx += G * 512) {
        const int row = idx >> 5, c8 = (idx & 31) * 8;
        int t, S; if (row < M_CTX) { t = row & 255; S = 256; } else { t = (row - M_CTX) & 4095; S = 4096; }
        const u32x4 z = {0, 0, 0, 0};
        const u32x4 pc = *(const GAS u32x4*)(A.PB + (size_t)row * 256 + c8);
        const u32x4 pp = t > 0 ? *(const GAS u32x4*)(A.PB + (size_t)(row - 1) * 256 + c8) : z;
        const u32x4 pn = t < S - 1 ? *(const GAS u32x4*)(A.PB + (size_t)(row + 1) * 256 + c8) : z;
        const u32x4 cb = *(const GAS u32x4*)(A.CB + (size_t)row * 256 + c8);
        float res[8];
#pragma unroll
        for (int j = 0; j < 8; ++j) {
            const int sh = (j & 1) * 16;
            const float a = __uint_as_float(((pp[j >> 1] >> sh) & 0xffffu) << 16), b = __uint_as_float(((pc[j >> 1] >> sh) & 0xffffu) << 16), c = __uint_as_float(((pn[j >> 1] >> sh) & 0xffffu) << 16);
            const float g = __uint_as_float(((cb[j >> 1] >> sh) & 0xffffu) << 16);
            const int cc = c8 + j;
            res[j] = g * (A.conv_w[cc] * a + A.conv_w[256 + cc] * b + A.conv_w[512 + cc] * c + A.conv_b[cc]);
        }
        u32x4 w; w.x = cvtpk(res[0], res[1]); w.y = cvtpk(res[2], res[3]); w.z = cvtpk(res[4], res[5]); w.w = cvtpk(res[6], res[7]);
        *(GAS u32x4*)(A.MIX + (size_t)row * 1024 + 512 + c8) = w;
    }
}

__device__ __forceinline__ int sigma_map(int type, int i) {
    if (type == 1) return 8 * ((i >> 2) & 3) + 4 * (i >> 4) + (i & 3);
    if (type == 2) return 16 * ((i >> 3) & 1) + 8 * (i >> 4) + (i & 7);
    return i;
}
__device__ __forceinline__ void in_group(int g, int& Lbase, int& type) {
    const int pn = g >> 3, bj = (g >> 2) & 1, wc = g & 3;
    if (pn < 2) { Lbase = 64 * (4 * pn + wc) + 32 * bj; type = 0; }
    else if (pn == 2) { Lbase = (wc < 2 ? 512 + 64 * wc : 640 + 64 * (wc - 2)) + 32 * bj; type = wc < 2 ? 0 : 1; }
    else if (pn == 3) { Lbase = 768 + 128 * bj + 32 * wc; type = 1; }
    else if (pn < 6) { Lbase = 1024 + 256 * bj + 128 * (pn - 4) + 32 * wc; type = 1; }
    else if (pn < 8) { Lbase = (pn == 6 ? 1536 : 1792) + 64 * wc + 32 * bj; type = 2; }
    else { Lbase = 2048 + 64 * wc + 32 * bj; type = 1; }
}
__device__ __forceinline__ void transpose_item(const float* W, int K, int N, bf16_t* WT, int k0, int nphys0, int Lbase, int type, LAS float* scr, int lane) {
#pragma unroll 8
    for (int i = 0; i < 32; ++i) { const int kk = 2 * i + (lane >> 5); scr[kk * 33 + (lane & 31)] = ((const GAS float*)W)[(size_t)(k0 + kk) * N + Lbase + (lane & 31)]; }
    asm volatile("s_waitcnt lgkmcnt(0)" ::: "memory");
    const int c = lane & 7;
#pragma unroll
    for (int j = 0; j < 4; ++j) { const int n = (lane >> 3) + 8 * j; const LAS float* s = scr + (8 * c) * 33 + sigma_map(type, n);
        u32x4 o; o.x = cvtpk(s[0 * 33], s[1 * 33]); o.y = cvtpk(s[2 * 33], s[3 * 33]); o.z = cvtpk(s[4 * 33], s[5 * 33]); o.w = cvtpk(s[6 * 33], s[7 * 33]);
        *(GAS u32x4*)(WT + (size_t)(nphys0 + n) * K + k0 + 8 * c) = o; }
    asm volatile("s_waitcnt lgkmcnt(0)" ::: "memory");
}

struct Params {
    const float *x_prompt, *x_sample, *cache_gk, *cache_gv, *cache_dk, *cache_dv, *c, *c_ctx;
    const float *w_mod, *b_mod, *norm1_g, *w_in, *gqa_qn_g, *gqa_kn_g, *conv_w, *conv_b, *diff_qn_g, *diff_kn_g, *diff_lambda, *diff_subln_g, *w_out, *norm2_g, *ffn_up, *ffn_conv_w, *ffn_conv_b, *ffn_down;
    float* out; unsigned char* ws;
    float lam_init[4];
    int ph_lo, ph_hi;
};

__device__ __forceinline__ void prologue(const Params& P, LAS unsigned char* lds, int G) {
    const int tid = opaque_tid(), lane = tid & 63, wave = __builtin_amdgcn_readfirstlane(tid >> 6);
    float* MODS = (float*)(P.ws + WS_MODS); float* MISC = (float*)(P.ws + WS_MISC);
    if ((int)blockIdx.x < 384) {
        LAS float* sc = (LAS float*)lds;
        LAS float* part = (LAS float*)(lds + 49152);
        for (int i = tid; i < NCOND * 1024; i += 512) { const int ci = i >> 10, k = i & 1023; const float v = ci == 0 ? P.c_ctx[k] : P.c[(ci - 1) * 1024 + k]; sc[k * 12 + ci] = v / (1.f + __expf(-v)); }
        __syncthreads();
        for (int it = blockIdx.x; it < 384; it += G) {
            const int l = it / 96, col = (it % 96) * 64 + lane;
            const float* w = P.w_mod + (size_t)l * 1024 * 6144 + col;
            float acc[NCOND];
#pragma unroll
            for (int ci = 0; ci < NCOND; ++ci) acc[ci] = 0.f;
#pragma unroll 8
            for (int kk = 0; kk < 128; ++kk) { const int k = wave * 128 + kk; const float wv = ((const GAS float*)w)[(size_t)k * 6144];
                const f32x4 s0 = *(LAS f32x4*)(sc + k * 12), s1 = *(LAS f32x4*)(sc + k * 12 + 4); const float s8 = sc[k * 12 + 8];
                acc[0] += s0[0] * wv; acc[1] += s0[1] * wv; acc[2] += s0[2] * wv; acc[3] += s0[3] * wv; acc[4] += s1[0] * wv; acc[5] += s1[1] * wv; acc[6] += s1[2] * wv; acc[7] += s1[3] * wv; acc[8] += s8 * wv; }
#pragma unroll
            for (int ci = 0; ci < NCOND; ++ci) part[(wave * NCOND + ci) * 64 + lane] = acc[ci];
            __syncthreads();
            for (int i = tid; i < NCOND * 64; i += 512) { const int ci = i >> 6, cc = i & 63; float s = 0.f;
#pragma unroll
                for (int w8 = 0; w8 < 8; ++w8) s += part[(w8 * NCOND + ci) * 64 + cc];
                const int j = (it % 96) * 64 + cc; MODS[((size_t)l * NCOND + ci) * 6144 + j] = s + P.b_mod[l * 6144 + j]; }
            __syncthreads();
        }
    }
    if ((int)blockIdx.x == G - 1) {
        if (tid < 4) { const float* lf = P.diff_lambda + tid * 128; float s1 = 0.f, s2 = 0.f; for (int i = 0; i < 32; ++i) { s1 += lf[i] * lf[32 + i]; s2 += lf[64 + i] * lf[96 + i]; }
            MISC[MI_LAM + tid] = expf(s1) - expf(s2) + P.lam_init[tid]; }
        for (int i = tid; i < 1024; i += 512) { const int pos = i >> 4, idx = i & 15; const float fr = powf(10000.f, -(float)idx / 16.f); const float ang = (float)pos * fr; MISC[MI_R64C + i] = cosf(ang); MISC[MI_R64S + i] = sinf(ang); }
        for (int i = tid; i < 512; i += 512) { const int pos = i >> 3, idx = i & 7; const float fr = powf(10000.f, -(float)idx / 8.f); const float ang = (float)pos * fr; MISC[MI_R32C + i] = cosf(ang); MISC[MI_R32S + i] = sinf(ang); }
    }
    __syncthreads();
    LAS float* scr = (LAS float*)(lds + wave * 16384);
    const int gw = blockIdx.x * 8 + wave, NGW = G * 8;
    constexpr int I_IN = 16 * 72, I_OUT = 16 * 32, I_UP = 16 * 176, I_DN = 44 * 32, I_L = I_IN + I_OUT + I_UP + I_DN;
    for (int it = gw; it < DEPTH * I_L; it += NGW) {
        const int l = it / I_L; int r = it % I_L;
        if (r < I_IN) { const int kb = r / 72, g = r % 72; int Lb, ty; in_group(g, Lb, ty);
            transpose_item(P.w_in + (size_t)l * 1024 * INW, 1024, INW, (bf16_t*)(P.ws + WS_WIN) + (size_t)l * INW * 1024, kb * 64, g * 32, Lb, ty, scr, lane); continue; }
        r -= I_IN;
        if (r < I_OUT) { const int kb = r / 32, g = r % 32;
            transpose_item(P.w_out + (size_t)l * 1024 * 1024, 1024, 1024, (bf16_t*)(P.ws + WS_WOUT) + (size_t)l * 1024 * 1024, kb * 64, g * 32, g * 32, 0, scr, lane); continue; }
        r -= I_OUT;
        if (r < I_UP) { const int kb = r / 176, g = r % 176; const int pn = g >> 3, bj = (g >> 2) & 1, wc = g & 3;
            transpose_item(P.ffn_up + (size_t)l * 1024 * UPW, 1024, UPW, (bf16_t*)(P.ws + WS_WUP) + (size_t)l * UPW * 1024, kb * 64, g * 32, bj * DFF + 128 * pn + 32 * wc, 1, scr, lane); continue; }
        r -= I_UP;
        { const int kb = r / 32, g = r % 32;
            transpose_item(P.ffn_down + (size_t)l * DFF * 1024, DFF, 1024, (bf16_t*)(P.ws + WS_WDN) + (size_t)l * 1024 * DFF, kb * 64, g * 32, g * 32, 0, scr, lane); }
    }
}

__device__ __forceinline__ void norm_phase(const float* xin_ctx, const float* xin_lat, const float* ng, const float* mods_l  , int sh_idx, bf16_t* XN, int G) {
    const int tid_ = opaque_tid(); const int lane = tid_ & 63, wave = __builtin_amdgcn_readfirstlane(tid_ >> 6);
    const int nw = G * 8, gw = blockIdx.x * 8 + wave;
    const int per = (M_ALL + nw - 1) / nw;
    const int r0 = gw * per, r1 = min(r0 + per, M_ALL);
    int cur_ci = -1; f32x4 Aa[4], Bb[4];
    f32x4 v[4], vn[4];
    if (r0 < r1) { const float* xr = r0 < M_CTX ? xin_ctx + (size_t)r0 * DM : xin_lat + (size_t)(r0 - M_CTX) * DM;
#pragma unroll
        for (int j = 0; j < 4; ++j) vn[j] = *(const GAS f32x4*)(xr + 4 * lane + 256 * j); }
    for (int row = r0; row < r1; ++row) {
#pragma unroll
        for (int j = 0; j < 4; ++j) v[j] = vn[j];
        if (row + 1 < r1) { const int rn = row + 1; const float* xr = rn < M_CTX ? xin_ctx + (size_t)rn * DM : xin_lat + (size_t)(rn - M_CTX) * DM;
#pragma unroll
            for (int j = 0; j < 4; ++j) vn[j] = *(const GAS f32x4*)(xr + 4 * lane + 256 * j); }
        const int ci = row < M_CTX ? 0 : 1 + ((row - M_CTX) >> 12);
        if (ci != cur_ci) { cur_ci = ci; const float* sh = mods_l + ci * 6144 + sh_idx * 1024; const float* sc = sh + 1024;
#pragma unroll
            for (int j = 0; j < 4; ++j) { const int c = 4 * lane + 256 * j; const f32x4 g4 = *(const GAS f32x4*)(ng + c), s4 = *(const GAS f32x4*)(sc + c); Aa[j] = g4 * (1.f + s4); Bb[j] = *(const GAS f32x4*)(sh + c); } }
        float s = 0.f;
#pragma unroll
        for (int j = 0; j < 4; ++j) s += (v[j][0] * v[j][0] + v[j][1] * v[j][1]) + (v[j][2] * v[j][2] + v[j][3] * v[j][3]);
#pragma unroll
        for (int o = 1; o < 64; o <<= 1) s += __shfl_xor(s, o);
        const float rstd = rsqrtf(s * (1.f / DM) + EPS);
#pragma unroll
        for (int j = 0; j < 4; ++j) { const f32x4 y = v[j] * rstd * Aa[j] + Bb[j]; u32x2 w; w.x = cvtpk(y[0], y[1]); w.y = cvtpk(y[2], y[3]); *(GAS u32x2*)(XN + (size_t)row * DM + 4 * lane + 256 * j) = w; }
    }
}

__device__ __forceinline__ void cache_phase(const Params& P, int l, int G) {
    bf16_t* KG = (bf16_t*)(P.ws + WS_KG); bf16_t* VG = (bf16_t*)(P.ws + WS_VG); bf16_t* KD = (bf16_t*)(P.ws + WS_KD); bf16_t* VD = (bf16_t*)(P.ws + WS_VD);
    const int tid_ = opaque_tid();
    for (int i = blockIdx.x * 512 + tid_; i < 65536; i += G * 512) {
        const int d4 = (i & 15) * 4, kvh = (i >> 4) & 1, p = (i >> 5) & 255, b = i >> 13;
        const size_t src = ((((size_t)b * 4 + l) * 256 + p) * 2 + kvh) * 64 + d4;
        const size_t dst = (((8192L + (long)SLAT * b) * 2 + (long)kvh * SLAT + 4096 + p) * 64);
        const int pk4 = (d4 & 32) | ((d4 & 12) << 1) | ((d4 & 16) >> 2);
        const f32x4 k = *(const GAS f32x4*)(P.cache_gk + src), v = *(const GAS f32x4*)(P.cache_gv + src);
        u32x2 wk, wv; wk.x = cvtpk(k[0], k[1]); wk.y = cvtpk(k[2], k[3]); wv.x = cvtpk(v[0], v[1]); wv.y = cvtpk(v[2], v[3]);
        *(GAS u32x2*)(KG + dst + pk4) = wk; *(GAS u32x2*)(VG + dst + d4) = wv;
    }
    for (int i = blockIdx.x * 512 + tid_; i < 131072; i += G * 512) {
        { const int d4 = (i & 7) * 4, hc = (i >> 3) & 7, p = (i >> 6) & 255, b = i >> 14;
          const size_t src = ((((size_t)b * 4 + l) * 256 + p) * 8 + hc) * 32 + d4;
          const size_t dst = (((8192L + (long)SLAT * b) * 8 + (long)hc * SLAT + 4096 + p) * 32) + ((d4 & 16) | ((d4 & 4) << 1) | ((d4 & 8) >> 1));
          const f32x4 k = *(const GAS f32x4*)(P.cache_dk + src); u32x2 w; w.x = cvtpk(k[0], k[1]); w.y = cvtpk(k[2], k[3]); *(GAS u32x2*)(KD + dst) = w; }
        { const int d4 = (i & 15) * 4, hh = (i >> 4) & 3, p = (i >> 6) & 255, b = i >> 14;
          const size_t src = ((((size_t)b * 4 + l) * 256 + p) * 4 + hh) * 64 + d4;
          const size_t dst = (((8192L + (long)SLAT * b) * 4 + (long)hh * SLAT + 4096 + p) * 64) + d4;
          const f32x4 v = *(const GAS f32x4*)(P.cache_dv + src); u32x2 w; w.x = cvtpk(v[0], v[1]); w.y = cvtpk(v[2], v[3]); *(GAS u32x2*)(VD + dst) = w; }
    }
}

__device__ __forceinline__ void fixup_own_panels(const pg8::StaticOrder& S, const float* cw, bf16_t* F, const float* EP, const float* EA, const float* EU) {
    const int tid_ = opaque_tid();
    pg8::Unit u;
    for (int i = 0; S.next(i, u); ++i) {
        const int pm = u.pm; if (pm < 32) continue;
        const int j = (pm - 32) & 15;
        for (int e = 0; e < 2; ++e) {
            if (e == 0 ? j == 0 : j == 15) continue;
            const size_t eb = ((size_t)pm * 2 + e) * DFF, nb = e == 0 ? ((size_t)(pm - 1) * 2 + 1) * DFF : ((size_t)(pm + 1) * 2 + 0) * DFF;
            const float* w = cw + (e == 0 ? 0 : 2 * DFF);
            const size_t row = (size_t)pm * 256 + (e ? 255 : 0);
            for (int c = tid_ * 2; c < DFF; c += 1024) {
                const f32x2 p = *(const GAS f32x2*)(EP + eb + c), a = *(const GAS f32x2*)(EA + nb + c), uu = *(const GAS f32x2*)(EU + eb + c), ww = *(const GAS f32x2*)(w + c);
                const float f0 = silu_f(p[0] + ww[0] * a[0]) * uu[0], f1 = silu_f(p[1] + ww[1] * a[1]) * uu[1];
                *(GAS unsigned*)(F + row * DFF + c) = cvtpk(f0, f1);
            }
        }
    }
    asm volatile("s_waitcnt vmcnt(0)" ::: "memory");
    __syncthreads();
}
__device__ __forceinline__ void fixup_phase(const float* cw, bf16_t* F, const float* EP, const float* EA, const float* EU, int G) {
    const int tid_ = opaque_tid();
    for (int i = blockIdx.x * 512 + tid_; i < 128 * 2 * DFF; i += G * 512) {
        const int c = i % DFF, e = (i / DFF) & 1, pm = 32 + i / (2 * DFF); const int j = (pm - 32) & 15;
        if (e == 0 ? j == 0 : j == 15) continue;
        const size_t eo = ((size_t)pm * 2 + e) * DFF + c;
        float conv;
        if (e == 0) conv = EP[eo] + cw[c] * EA[((size_t)(pm - 1) * 2 + 1) * DFF + c];
        else conv = EP[eo] + cw[2 * DFF + c] * EA[((size_t)(pm + 1) * 2 + 0) * DFF + c];
        const float f = silu_f(conv) * EU[eo];
        const size_t row = (size_t)pm * 256 + (e ? 255 : 0);
        F[row * DFF + c] = (bf16_t)(cvtpk(f, 0.f) & 0xffffu);
    }
}


#define XB_TMO      128
#define XB_XCNT(j)  (256  + 64 * (j))
#define XB_XSUB(j)  (1280 + 64 * (j))
#define XB_XGEN(j)  (2304 + 64 * (j))
#define XB_TOP      3328
#define XB_TOPGEN   3392
#define XCD_BAR_WORDS 3456
#define XB_SPIN_CAP (1u << 22)
__device__ __forceinline__ unsigned xb_ld(unsigned* p)              { return __hip_atomic_load(p, __ATOMIC_RELAXED, __HIP_MEMORY_SCOPE_AGENT); }
__device__ __forceinline__ unsigned xb_add(unsigned* p, unsigned v) { return __hip_atomic_fetch_add(p, v, __ATOMIC_RELAXED, __HIP_MEMORY_SCOPE_AGENT); }
__device__ __forceinline__ unsigned xb_xcc_id() { return (unsigned)__builtin_amdgcn_s_getreg((3 << 11) | 20) & 0xFu; }
#define XB_SPIN(cond, bar) do { unsigned _sp = 0; while (cond) { __builtin_amdgcn_s_sleep(1); \
    if ((++_sp & 255u) == 0u) { if (xb_ld(&(bar)[XB_TMO])) break; if (_sp > XB_SPIN_CAP) { atomicAdd(&(bar)[XB_TMO], 1u); break; } } } } while (0)
struct XcdBarrier { unsigned* bar; unsigned x; volatile LAS unsigned* st; };
__device__ __forceinline__ XcdBarrier xcd_barrier_post(unsigned* bar, volatile LAS unsigned* st) {
    XcdBarrier b; b.bar = bar; b.x = xb_xcc_id(); b.st = st;
    if (threadIdx.x == 0) (void)xb_add(&bar[XB_XCNT(b.x)], 1u);
    return b;
}
__device__ __forceinline__ void xcd_barrier_complete(unsigned* bar, unsigned x, unsigned& nloc, unsigned& nx) {
    const unsigned G = gridDim.x * gridDim.y * gridDim.z;
    unsigned sum, cnt, mine, sp = 0u;
    for (;;) {
        sum = 0u; cnt = 0u; mine = 0u;
#pragma unroll
        for (unsigned j = 0; j < 16; ++j) { const unsigned c = xb_ld(&bar[XB_XCNT(j)]); sum += c; cnt += (c > 0u) ? 1u : 0u; mine = (j == x) ? c : mine; }
        if (sum == G) break;
        __builtin_amdgcn_s_sleep(1);
        if ((++sp & 255u) == 0u) { if (xb_ld(&bar[XB_TMO])) break; if (sp > XB_SPIN_CAP) { atomicAdd(&bar[XB_TMO], 1u); break; } }
    }
    nloc = mine > 0u ? mine : 1u; nx = cnt > 0u ? cnt : 1u;
}
__device__ __forceinline__ void xcd_barrier(const XcdBarrier& b) {
    asm volatile("s_waitcnt vmcnt(0)" ::: "memory");
    __syncthreads();
    if (threadIdx.x == 0) {
        unsigned* bar = b.bar;
        __builtin_amdgcn_s_waitcnt(0);
        unsigned nloc = b.st[0], nx = b.st[1];
        if (nloc == 0u) { xcd_barrier_complete(bar, b.x, nloc, nx); b.st[0] = nloc; b.st[1] = nx; }
        const unsigned old = xb_add(&bar[XB_XSUB(b.x)], 1u);
        const unsigned gen = old / nloc;
        if (old + 1u == (gen + 1u) * nloc) {
            __builtin_amdgcn_fence(__ATOMIC_RELEASE, "agent");
            asm volatile("s_waitcnt vmcnt(0)" ::: "memory");
            const unsigned og = xb_add(&bar[XB_TOP], 1u);
            const unsigned tg = og / nx;
            if (og + 1u == (tg + 1u) * nx) xb_add(&bar[XB_TOPGEN], 1u);
            else XB_SPIN(xb_ld(&bar[XB_TOPGEN]) == tg, bar);
            __builtin_amdgcn_fence(__ATOMIC_ACQUIRE, "agent");
            xb_add(&bar[XB_XGEN(b.x)], 1u);
            asm volatile("s_waitcnt vmcnt(0)" ::: "memory");
        } else {
            XB_SPIN(xb_ld(&bar[XB_XGEN(b.x)]) == gen, bar);
            __builtin_amdgcn_fence(__ATOMIC_ACQUIRE, "agent");
            asm volatile("s_waitcnt vmcnt(0)" ::: "memory");
        }
    }
    __syncthreads();
}

__global__ void __launch_bounds__(512, 2) fwd_kernel(Params P) {
    extern __shared__ __attribute__((aligned(16))) unsigned char lds_raw[];
    LAS unsigned char* lds = (LAS unsigned char*)lds_raw;
    cg::grid_group grid = cg::this_grid();
    const int G = gridDim.x;
    volatile LAS unsigned* bst = (volatile LAS unsigned*)(lds + MISC_OFF);
    if (threadIdx.x < 2) bst[threadIdx.x] = 0u;
    __syncthreads();
    XcdBarrier bar = xcd_barrier_post((unsigned*)(P.ws + WS_CTL), bst);
    int ph = 0;
#define PHASE_BEGIN if (ph >= P.ph_lo && ph < P.ph_hi) { unsigned char* ws = P.ws; float* outp = P.out; asm volatile("" : "+s"(ws), "+s"(outp));
#define PHASE_END   if (ph + 1 < P.ph_hi) { if (ph == 0) grid.sync(); else xcd_barrier(bar); } } ++ph;
    PHASE_BEGIN
#ifndef SKIP_PRO
        prologue(P, lds, G);
#endif
    PHASE_END
    for (int l = 0; l < DEPTH; ++l) {
        PHASE_BEGIN
            const float* xin_ctx = l == 0 ? P.x_prompt : outp; const float* xin_lat = l == 0 ? P.x_sample : outp + (size_t)M_CTX * DM;
            norm_phase(xin_ctx, xin_lat, P.norm1_g + l * DM, (const float*)(ws + WS_MODS) + (size_t)l * NCOND * 6144, 0, (bf16_t*)(ws + WS_XN), G);
            cache_phase(P, l, G);
        PHASE_END
        PHASE_BEGIN {
            const float* MISC = (const float*)(ws + WS_MISC);
            pg8::Gemm g{(const bf16_t*)(ws + WS_XN), (const bf16_t*)(ws + WS_WIN) + (size_t)l * INW * 1024, M_ALL, INW, 1024}; pg8::StaticOrder S; S.init(M_ALL, INW, G, blockIdx.x);
            EpiIn E{l, P.gqa_qn_g + l * 64, P.gqa_kn_g + l * 64, P.diff_qn_g + l * 32, P.diff_kn_g + l * 32, MISC + MI_R64C, MISC + MI_R64S, MISC + MI_R32C, MISC + MI_R32S,
                    (bf16_t*)(ws + WS_QG), (bf16_t*)(ws + WS_QD), (bf16_t*)(ws + WS_KG), (bf16_t*)(ws + WS_VG), (bf16_t*)(ws + WS_KD), (bf16_t*)(ws + WS_VD), (bf16_t*)(ws + WS_CB), (bf16_t*)(ws + WS_PB), outp};
#ifndef SKIP_IN
            pg8::gemm_phase(lds, lds + XCH_OFF, g, S, E);
#endif
        } PHASE_END
        PHASE_BEGIN {
            const float* MISC = (const float*)(ws + WS_MISC);
            AttnArgs A{(const bf16_t*)(ws + WS_QG), (const bf16_t*)(ws + WS_QD), (const bf16_t*)(ws + WS_KG), (const bf16_t*)(ws + WS_VG), (const bf16_t*)(ws + WS_KD), (const bf16_t*)(ws + WS_VD),
                       (const bf16_t*)(ws + WS_CB), (const bf16_t*)(ws + WS_PB), (bf16_t*)(ws + WS_XN), P.conv_w + l * 768, P.conv_b + l * 256, P.diff_subln_g + l * 64, MISC[MI_LAM + l], P.lam_init[l], (float*)(ws + WS_DSCR)};
#ifndef SKIP_ATT
            attn_phase(A, (LAS char*)lds, (char*)lds_raw, G);
#endif
        } PHASE_END
        PHASE_BEGIN {
            const float* xin_ctx = l == 0 ? P.x_prompt : outp; const float* xin_lat = l == 0 ? P.x_sample : outp + (size_t)M_CTX * DM;
            pg8::Gemm g{(const bf16_t*)(ws + WS_XN), (const bf16_t*)(ws + WS_WOUT) + (size_t)l * 1024 * 1024, M_ALL, 1024, 1024}; pg8::StaticOrder S; S.init(M_ALL, 1024, G, blockIdx.x);
            EpiRes E{xin_ctx, xin_lat, outp, (const float*)(ws + WS_MODS) + (size_t)l * NCOND * 6144 + 2 * 1024};
#ifndef SKIP_RES
            pg8::gemm_phase(lds, lds + XCH_OFF, g, S, E);
#endif
        } PHASE_END
        PHASE_BEGIN
            norm_phase(outp, outp + (size_t)M_CTX * DM, P.norm2_g + l * DM, (const float*)(ws + WS_MODS) + (size_t)l * NCOND * 6144, 3, (bf16_t*)(ws + WS_XN), G);
        PHASE_END
        PHASE_BEGIN {
            float* EPb = (float*)(ws + WS_EDGE);
            pg8::Gemm g{(const bf16_t*)(ws + WS_XN), (const bf16_t*)(ws + WS_WUP) + (size_t)l * UPW * 1024, M_ALL, UPW, 1024}; pg8::StaticOrder S; S.init(M_ALL, UPW, G, blockIdx.x);
            EpiUp E{P.ffn_conv_w + (size_t)l * 3 * DFF, P.ffn_conv_b + (size_t)l * DFF, (bf16_t*)(ws + WS_U), EPb, EPb + EDGE_ELEMS, EPb + 2 * EDGE_ELEMS};
#ifndef SKIP_UP
            pg8::gemm_phase(lds, lds + XCH_OFF, g, S, E);
#endif
        } PHASE_END
        PHASE_BEGIN {
            pg8::Gemm g{(const bf16_t*)(ws + WS_U), (const bf16_t*)(ws + WS_WDN) + (size_t)l * 1024 * DFF, M_ALL, 1024, DFF}; pg8::StaticOrder S; S.init(M_ALL, 1024, G, blockIdx.x);
            { float* EPb = (float*)(ws + WS_EDGE); fixup_own_panels(S, P.ffn_conv_w + (size_t)l * 3 * DFF, (bf16_t*)(ws + WS_U), EPb, EPb + EDGE_ELEMS, EPb + 2 * EDGE_ELEMS); }
            EpiRes E{outp, outp + (size_t)M_CTX * DM, outp, (const float*)(ws + WS_MODS) + (size_t)l * NCOND * 6144 + 5 * 1024};
#ifndef SKIP_RES
            pg8::gemm_phase(lds, lds + XCH_OFF, g, S, E);
#endif
        } PHASE_END
    }
}

constexpr int N_PHASES = 1 + DEPTH * 7;
#ifndef N_LAUNCH_SPLIT
#define N_LAUNCH_SPLIT 0
#endif

extern "C" void kernel_launch(void* const* d_in, const int* in_sizes, int n_in, void* d_out, int out_size, void* d_ws, size_t ws_size, hipStream_t stream) {
    static int grid = 0;
    if (grid == 0) {
        if (n_in != 26 || ws_size < WS_END) { fprintf(stderr, "kernel_launch: unexpected n_in %d or ws_size %zu (< %zu)\n", n_in, ws_size, (size_t)WS_END); grid = -1; return; }
        int dev = 0, cus = 0, per_cu = 0;
        hipGetDevice(&dev); hipDeviceGetAttribute(&cus, hipDeviceAttributeMultiprocessorCount, dev);
        hipFuncSetAttribute((const void*)fwd_kernel, hipFuncAttributeMaxDynamicSharedMemorySize, LDS_BYTES);
        hipOccupancyMaxActiveBlocksPerMultiprocessor(&per_cu, (const void*)fwd_kernel, 512, LDS_BYTES);
        if (per_cu < 1) { fprintf(stderr, "kernel_launch: occupancy query gives %d\n", per_cu); per_cu = 1; }
        (void)hipGetLastError();
        grid = cus * 1;
    }
    if (grid < 0) return;
    Params p{};
    const float** pp = (const float**)&p;
    for (int i = 0; i < 26; ++i) pp[i] = (const float*)d_in[i];
    p.out = (float*)d_out; p.ws = (unsigned char*)d_ws;
    for (int l = 0; l < 4; ++l) p.lam_init[l] = (float)(0.8 - 0.6 * exp(-0.3 * (double)l));
#if N_LAUNCH_SPLIT
    for (int ph = 0; ph < N_PHASES; ++ph) { p.ph_lo = ph; p.ph_hi = ph + 1; hipLaunchKernelGGL(fwd_kernel, dim3(grid), dim3(512), LDS_BYTES, stream, p); }
#else
    p.ph_lo = 0; p.ph_hi = N_PHASES;
    if (hipMemsetAsync((char*)d_ws + WS_CTL, 0, CTL_ZERO_BYTES, stream) != hipSuccess) { fprintf(stderr, "kernel_launch: memset failed\n"); return; }
    void* args[] = {&p};
    hipError_t e = hipLaunchCooperativeKernel((const void*)fwd_kernel, dim3(grid), dim3(512), args, LDS_BYTES, stream);
    if (e != hipSuccess) fprintf(stderr, "cooperative launch failed: %s (grid %d)\n", hipGetErrorString(e), grid);
#endif
}
```

```cpp
#include <hip/hip_runtime.h>
#include <hip/hip_cooperative_groups.h>
#include <cstdio>
#include <cstdint>
#include <cmath>
namespace cg = cooperative_groups;

#define LAS __attribute__((address_space(3)))
#define GAS __attribute__((address_space(1)))
typedef unsigned short bf16_t;
typedef short bf16x8 __attribute__((ext_vector_type(8)));
typedef short s16x4 __attribute__((ext_vector_type(4)));
typedef float f32x4 __attribute__((ext_vector_type(4)));
typedef float f32x16 __attribute__((ext_vector_type(16)));
typedef unsigned u32x4 __attribute__((ext_vector_type(4)));
typedef unsigned u32x2 __attribute__((ext_vector_type(2)));
typedef float f32x2 __attribute__((ext_vector_type(2)));
typedef __bf16 bf16x2_t __attribute__((ext_vector_type(2)));

__device__ __forceinline__ unsigned cvtpk(float lo, float hi) { f32x2 v = {lo, hi}; bf16x2_t b = __builtin_convertvector(v, bf16x2_t); return __builtin_bit_cast(unsigned, b); }
__device__ __forceinline__ int opaque_tid() { int t = threadIdx.x; asm volatile("" : "+v"(t)); return t; }
__device__ __forceinline__ float bf2f(unsigned short u) { return __uint_as_float(((unsigned)u) << 16); }

constexpr int DM = 1024, DEPTH = 4, NCOND = 9;
constexpr int M_CTX = 8192, M_ALL = 40960, NTM = 160;
constexpr int INW = 2304, DFF = 2816, UPW = 5632;
constexpr int SLAT = 4352;
constexpr float EPS = 1e-6f;
constexpr float LOG2E = 1.4426950408889634f;
constexpr float QSCALE_G = 0.125f * LOG2E;
constexpr float QSCALE_D = 0.17677669529663687f * LOG2E;
constexpr size_t OUT_GK = 41943040, OUT_GV = OUT_GK + 4194304, OUT_DK = OUT_GV + 4194304, OUT_DV = OUT_DK + 8388608;
constexpr size_t MiB = 1u << 20;
constexpr size_t WS_MODS = 1 * MiB;
constexpr size_t WS_MISC = 2 * MiB;
constexpr size_t WS_EDGE = 3 * MiB;
constexpr size_t EDGE_ELEMS = (size_t)NTM * 2 * DFF;
constexpr size_t WS_WIN = 16 * MiB;
constexpr size_t WS_WOUT = 34 * MiB;
constexpr size_t WS_WUP = 42 * MiB;
constexpr size_t WS_WDN = 86 * MiB;
constexpr size_t WS_XN = 108 * MiB;
constexpr size_t WS_U = 188 * MiB;
constexpr size_t WS_QG = WS_U, WS_QD = WS_QG + (size_t)M_ALL * 512 * 2, WS_KG = WS_QD + (size_t)M_ALL * 256 * 2;
constexpr size_t KROWS = 8192 + 8 * SLAT;
constexpr size_t WS_VG = WS_KG + KROWS * 128 * 2, WS_KD = WS_VG + KROWS * 128 * 2, WS_VD = WS_KD + KROWS * 256 * 2;
constexpr size_t WS_CB = WS_VD + KROWS * 256 * 2, WS_PB = WS_CB + (size_t)M_ALL * 256 * 2, WS_UEND = WS_PB + (size_t)M_ALL * 256 * 2;
constexpr size_t WS_DSCR = WS_U + (size_t)M_ALL * DFF * 2;
constexpr size_t WS_XB = WS_DSCR + 16 * MiB;
constexpr size_t WS_END = WS_XB + (size_t)M_ALL * DM * 2;
static_assert(WS_UEND <= WS_DSCR, "union");
constexpr int MI_LAM = 0, MI_R64C = 64, MI_R64S = MI_R64C + 1024, MI_R32C = MI_R64S + 1024, MI_R32S = MI_R32C + 512;

constexpr int RING_BYTES = 131072, XCH_OFF = RING_BYTES, MISC_OFF = RING_BYTES + 4096, LDS_BYTES = RING_BYTES + 4096 + 256;
constexpr size_t WS_CTL = 0, CTL_ZERO_BYTES = 65536;

struct TileInfo {
    int lat, seq, t0, ci, S; long R;
    __device__ __forceinline__ TileInfo(int pm) {
        if (pm < 32) { lat = 0; seq = pm; t0 = 0; ci = 0; S = 256; R = 256L * pm; }
        else { const int b = (pm - 32) >> 4; lat = 1; seq = b; t0 = ((pm - 32) & 15) * 256; ci = 1 + b; S = SLAT; R = 8192L + (long)SLAT * b; }
    }
};

namespace pg8 {
constexpr int BM = 256, BK = 64, HALF = 128, HTB = HALF * BK * 2, NXCD = 8, WGM = 8;
__host__ __device__ __forceinline__ int lds_byte(int r, int c) { const int st = (r >> 4) * 2 + (c >> 5), rr = r & 15, cc = c & 31, ob = rr * 64 + cc * 2; return st * 1024 + (ob ^ (((ob >> 9) & 1) << 5)); }
__host__ __device__ __forceinline__ void stage_rc(int b, int& R, int& C) { const int st = b / 1024, sb = b % 1024, swz = sb ^ (((sb >> 9) & 1) << 5); R = (st >> 1) * 16 + swz / 64; C = (st & 1) * 32 + (swz % 64) / 2; }
struct Unit { int pm, pn; };
struct Gemm { const bf16_t* A; const bf16_t* Bt; int M, N, K; };
struct StaticOrder {
    int nM, nN, nwg, G, c;
    __device__ void init(int M, int N, int G_, int c_) { nM = M / BM; nN = N / BM; nwg = nM * nN; G = G_; c = c_; }
    __device__ bool next(int i, Unit& u) const {
        const long L = (long)i * G + c; if (L >= nwg) return false;
        int wgid = (int)L; { const int q = nwg / NXCD, r = nwg % NXCD, xcd = wgid % NXCD, off = wgid / NXCD; wgid = (xcd < r ? xcd * (q + 1) : r * (q + 1) + (xcd - r) * q) + off; }
        const int nig = WGM * nN, gid = wgid / nig, fm = gid * WGM, gsz = (nM - fm) < WGM ? (nM - fm) : WGM;
        u.pm = fm + ((wgid % nig) % gsz); u.pn = (wgid % nig) / gsz; return true;
    }
};
template <class Epi>
__device__ __forceinline__ void gemm_phase(LAS unsigned char* lds, LAS unsigned char* xlds, const Gemm g, const StaticOrder& S, const Epi& E) {
    const int tid = opaque_tid(), wid = __builtin_amdgcn_readfirstlane(tid >> 6), lane = tid & 63, wr = wid >> 2, wc = wid & 3, fr = lane & 15, fq = lane >> 4;
    const int K = g.K, nt = K / BK;
    unsigned voffA[2];
#pragma unroll
    for (int i = 0; i < 2; ++i) { int R, C; stage_rc(tid * 16 + i * 8192, R, C); voffA[i] = (unsigned)(R * K + C) * 2u; }
    const size_t kstep = (size_t)(BK * 2);
    const size_t hstep = (size_t)HALF * K * 2;
    const size_t tstep = 2 * hstep;
    const unsigned ldsw = (unsigned)wid * 1024u;
    const int aoff = lds_byte(wr * 64 + fr, fq * 8), boff = lds_byte(wc * 32 + fr, fq * 8);
#define PG8_SA(b, h) (((b) * 2 + (h)) * HTB)
#define PG8_SB(b, h) ((4 + (b) * 2 + (h)) * HTB)
#define PG8_STAGE(bufoff, gbase) do { _Pragma("unroll") for (int _i = 0; _i < 2; ++_i) \
        __builtin_amdgcn_global_load_lds((const unsigned*)((const char*)(gbase) + voffA[_i]), (LAS unsigned*)(lds + (bufoff) + ldsw + _i * 8192), 16, 0, 0); } while (0)
#define PG8_LDA(dst, b, h) do { _Pragma("unroll") for (int m = 0; m < 4; ++m) _Pragma("unroll") for (int k = 0; k < 2; ++k) dst[m][k] = *(const LAS bf16x8*)(lds + PG8_SA(b, h) + aoff + m * 2048 + k * 1024); } while (0)
#define PG8_LDB(dst, b, h) do { _Pragma("unroll") for (int n = 0; n < 2; ++n) _Pragma("unroll") for (int k = 0; k < 2; ++k) dst[n][k] = *(const LAS bf16x8*)(lds + PG8_SB(b, h) + boff + n * 2048 + k * 1024); } while (0)
#define PG8_MMA(ai, bj, At, Bt) do { __builtin_amdgcn_s_setprio(1); _Pragma("unroll") for (int m = 0; m < 4; ++m) _Pragma("unroll") for (int n = 0; n < 2; ++n) _Pragma("unroll") for (int k = 0; k < 2; ++k) \
        acc[ai][bj][m][n] = __builtin_amdgcn_mfma_f32_16x16x32_bf16(Bt[n][k], At[m][k], acc[ai][bj][m][n], 0, 0, 0); __builtin_amdgcn_s_setprio(0); } while (0)
#define PG8_WAIT_V(n) asm volatile("s_waitcnt vmcnt(" #n ")" ::: "memory")
#define PG8_WAIT_L(n) asm volatile("s_waitcnt lgkmcnt(" #n ")" ::: "memory")
#define PG8_BAR __builtin_amdgcn_s_barrier()
#define PG8_SCHED __builtin_amdgcn_sched_barrier(0)
    Unit cur, nxt; int ui = 0;
    if (!S.next(0, cur)) return;
    f32x4 acc[2][2][4][2];
#pragma unroll
    for (int a = 0; a < 2; ++a)
#pragma unroll
        for (int b = 0; b < 2; ++b)
#pragma unroll
            for (int m = 0; m < 4; ++m)
#pragma unroll
                for (int n = 0; n < 2; ++n) acc[a][b][m][n] = (f32x4){0.f, 0.f, 0.f, 0.f};
    bf16x8 At[4][2], B0[2][2], B1[2][2];
    const char* cA = (const char*)g.A + (size_t)cur.pm * tstep; const char* cB = (const char*)g.Bt + (size_t)cur.pn * tstep;
    PG8_STAGE(PG8_SB(0, 0), cB); PG8_STAGE(PG8_SB(0, 1), cB + hstep); PG8_STAGE(PG8_SA(0, 0), cA); PG8_STAGE(PG8_SA(0, 1), cA + hstep);
    if (wr == 1) PG8_BAR;
    PG8_WAIT_V(2); PG8_BAR;
    PG8_STAGE(PG8_SB(1, 0), cB + kstep); PG8_STAGE(PG8_SA(1, 0), cA + kstep); PG8_STAGE(PG8_SB(1, 1), cB + hstep + kstep);
    PG8_WAIT_V(6); PG8_BAR;
    for (;;) {
        const bool has_next = S.next(ui + 1, nxt);
        const char* nA = has_next ? (const char*)g.A + (size_t)nxt.pm * tstep : cA; const char* nB = has_next ? (const char*)g.Bt + (size_t)nxt.pn * tstep : cB;
        for (int t = 0; t < nt; t += 2) {
            const bool last = (t == nt - 2);
            const char* a1 = cA + (size_t)(t + 1) * kstep;
            const char* a2 = last ? nA : cA + (size_t)(t + 2) * kstep; const char* b2 = last ? nB : cB + (size_t)(t + 2) * kstep;
            const char* a3 = a2 + kstep; const char* b3 = b2 + kstep;
            PG8_LDB(B0, 0, 0); PG8_LDB(B1, 0, 1); PG8_SCHED; PG8_LDA(At, 0, 0); PG8_STAGE(PG8_SA(1, 1), a1 + hstep);
            PG8_WAIT_V(8); PG8_WAIT_L(0); PG8_BAR; PG8_MMA(0, 0, At, B0); PG8_MMA(0, 1, At, B1); PG8_BAR; PG8_SCHED;
            PG8_LDA(At, 0, 1); PG8_STAGE(PG8_SB(0, 0), b2); PG8_STAGE(PG8_SB(0, 1), b2 + hstep); PG8_STAGE(PG8_SA(0, 0), a2);
            PG8_WAIT_V(8); PG8_WAIT_L(0); PG8_BAR; PG8_MMA(1, 0, At, B0); PG8_MMA(1, 1, At, B1); PG8_BAR; PG8_SCHED;
            PG8_LDB(B0, 1, 0); PG8_LDB(B1, 1, 1); PG8_SCHED; PG8_LDA(At, 1, 0); PG8_STAGE(PG8_SA(0, 1), a2 + hstep);
            PG8_WAIT_V(8); PG8_WAIT_L(0); PG8_BAR; PG8_MMA(0, 0, At, B0); PG8_MMA(0, 1, At, B1); PG8_BAR; PG8_SCHED;
            PG8_LDA(At, 1, 1); PG8_STAGE(PG8_SB(1, 0), b3); PG8_STAGE(PG8_SB(1, 1), b3 + hstep); PG8_STAGE(PG8_SA(1, 0), a3);
            PG8_WAIT_V(8); PG8_WAIT_L(0); PG8_BAR; PG8_MMA(1, 0, At, B0); PG8_MMA(1, 1, At, B1); PG8_BAR; PG8_SCHED;
        }
        if (wr == 0) PG8_BAR;
        { int fr_ = fr, fq_ = fq; asm volatile("" : "+v"(fr_), "+v"(fq_)); E(acc, cur, wr, wc, fr_, fq_, xlds); }
        if (!has_next) break;
#pragma unroll
        for (int a = 0; a < 2; ++a)
#pragma unroll
            for (int b = 0; b < 2; ++b)
#pragma unroll
                for (int m = 0; m < 4; ++m)
#pragma unroll
                    for (int n = 0; n < 2; ++n) acc[a][b][m][n] = (f32x4){0.f, 0.f, 0.f, 0.f};
        cur = nxt; cA = nA; cB = nB; ++ui;
        if (wr == 1) PG8_BAR;
    }
    PG8_WAIT_V(0);
    PG8_BAR;
#undef PG8_SA
#undef PG8_SB
#undef PG8_STAGE
#undef PG8_LDA
#undef PG8_LDB
#undef PG8_MMA
#undef PG8_WAIT_V
#undef PG8_WAIT_L
#undef PG8_BAR
#undef PG8_SCHED
}
}

typedef f32x4 Acc[2][2][4][2];

struct EpiRes {
    const float* xin_ctx; const float* xin_lat; float* xout; const float* gate;
    const bf16_t* xin_b; bf16_t* xout_b;
    __device__ __forceinline__ void operator()(const Acc& acc, const pg8::Unit& u, int wr, int wc, int fr, int fq, LAS unsigned char*) const {
        const TileInfo ti(u.pm);
        const int col0 = u.pn * 256 + wc * 32 + 4 * fq;
        const float* gp = gate + ti.ci * 6144 + col0;
        f32x4 g4[2][2];
#pragma unroll
        for (int bj = 0; bj < 2; ++bj)
#pragma unroll
            for (int n = 0; n < 2; ++n) g4[bj][n] = *(const GAS f32x4*)(gp + bj * 128 + n * 16);
        const float* xin = ti.lat ? xin_lat + (size_t)(u.pm * 256 - M_CTX) * DM : xin_ctx + (size_t)(u.pm * 256) * DM;
        float* xo = xout + (size_t)(u.pm * 256) * DM;
        const bf16_t* xib = xin_b + (size_t)(u.pm * 256) * DM; bf16_t* xob = xout_b + (size_t)(u.pm * 256) * DM;
#pragma unroll
        for (int ai = 0; ai < 2; ++ai) {
            f32x4 xv[4][2][2];
            if (xin_b) {
#pragma unroll
                for (int m = 0; m < 4; ++m) {
                    const size_t off = (size_t)(ai * 128 + wr * 64 + m * 16 + fr) * DM + col0;
#pragma unroll
                    for (int bj = 0; bj < 2; ++bj)
#pragma unroll
                        for (int n = 0; n < 2; ++n) { const u32x2 r = *(const GAS u32x2*)(xib + off + bj * 128 + n * 16);
                            xv[m][bj][n] = (f32x4){__uint_as_float(r.x << 16), __uint_as_float(r.x & 0xffff0000u), __uint_as_float(r.y << 16), __uint_as_float(r.y & 0xffff0000u)}; }
                }
            } else {
#pragma unroll
                for (int m = 0; m < 4; ++m) {
                    const size_t off = (size_t)(ai * 128 + wr * 64 + m * 16 + fr) * DM + col0;
#pragma unroll
                    for (int bj = 0; bj < 2; ++bj)
#pragma unroll
                        for (int n = 0; n < 2; ++n) xv[m][bj][n] = *(const GAS f32x4*)(xin + off + bj * 128 + n * 16);
                }
            }
#pragma unroll
            for (int m = 0; m < 4; ++m) {
                const size_t off = (size_t)(ai * 128 + wr * 64 + m * 16 + fr) * DM + col0;
#pragma unroll
                for (int bj = 0; bj < 2; ++bj)
#pragma unroll
                    for (int n = 0; n < 2; ++n) { const f32x4 o = xv[m][bj][n] + g4[bj][n] * acc[ai][bj][m][n];
                        if (xout_b) { u32x2 w; w.x = cvtpk(o[0], o[1]); w.y = cvtpk(o[2], o[3]); *(GAS u32x2*)(xob + off + bj * 128 + n * 16) = w; }
                        else *(GAS f32x4*)(xo + off + bj * 128 + n * 16) = o; }
            }
            __builtin_amdgcn_sched_group_barrier(0x020, 16, 0);
            asm volatile("" ::: "memory");
            __builtin_amdgcn_sched_barrier(0);
        }
    }
};

struct EpiIn {
    int layer;
    const float *qn_g, *kn_g, *dqn_g, *dkn_g;
    const float *r64c, *r64s, *r32c, *r32s;
    bf16_t *QG, *QD, *KG, *VG, *KD, *VD, *CB, *PB;
    float* out;
    __device__ __forceinline__ void operator()(const Acc& acc, const pg8::Unit& u, int wr, int wc, int fr, int fq, LAS unsigned char*) const {
        const TileInfo ti(u.pm);
        const int pn = u.pn;
        const int rbase = wr * 64 + fr;
        if (pn < 2 || (pn == 2 && wc < 2)) {
            const bool isq = pn < 2;
            const float* gsrc = (isq ? qn_g : kn_g) + 4 * fq;
            const int head = isq ? 4 * pn + wc : wc;
            f32x4 g4[2][2], rc[2], rs[2];
#pragma unroll
            for (int bj = 0; bj < 2; ++bj)
#pragma unroll
                for (int n = 0; n < 2; ++n) g4[bj][n] = *(const GAS f32x4*)(gsrc + 32 * bj + 16 * n);
#pragma unroll
            for (int ai = 0; ai < 2; ++ai) { const int pos = (ti.t0 >> 6) + 2 * ai + wr; rc[ai] = *(const GAS f32x4*)(r64c + pos * 16 + 4 * fq); rs[ai] = *(const GAS f32x4*)(r64s + pos * 16 + 4 * fq); }
            float ss[8];
#pragma unroll
            for (int ai = 0; ai < 2; ++ai)
#pragma unroll
                for (int m = 0; m < 4; ++m) { float t_ = 0.f;
#pragma unroll
                    for (int bj = 0; bj < 2; ++bj)
#pragma unroll
                        for (int n = 0; n < 2; ++n) { const f32x4 v = acc[ai][bj][m][n]; t_ += (v[0] * v[0] + v[1] * v[1]) + (v[2] * v[2] + v[3] * v[3]); }
                    ss[ai * 4 + m] = t_; }
#pragma unroll
            for (int i = 0; i < 8; ++i) ss[i] += __shfl_xor(ss[i], 16);
#pragma unroll
            for (int i = 0; i < 8; ++i) ss[i] += __shfl_xor(ss[i], 32);
#pragma unroll
            for (int mh = 0; mh < 2; ++mh) {
                f32x4 cc[2], cs[2];
#pragma unroll
                for (int mm = 0; mm < 2; ++mm) { const int pos = 16 * (2 * mh + mm) + fr; cc[mm] = *(const GAS f32x4*)(r64c + pos * 16 + 4 * fq); cs[mm] = *(const GAS f32x4*)(r64s + pos * 16 + 4 * fq); }
                if (mh == 0) __builtin_amdgcn_sched_group_barrier(0x020, 12, 0); else __builtin_amdgcn_sched_group_barrier(0x020, 4, 0);
#pragma unroll
                for (int mm = 0; mm < 2; ++mm)
#pragma unroll
                    for (int ai = 0; ai < 2; ++ai) {
                        const int m = 2 * mh + mm;
                        const int rt = ai * 128 + m * 16 + rbase; const int t = ti.t0 + rt;
                        const float rstd = rsqrtf(ss[ai * 4 + m] * (1.f / 64.f) + EPS);
                        bf16_t* dst = isq ? QG + ((size_t)u.pm * 256 + rt) * 512 + head * 64 + 8 * fq : KG + ((ti.R * 2 + (long)head * ti.S + t) * 64) + 8 * fq;
                        float* o = out + OUT_GK + ((size_t)(ti.seq * 4 + layer) * 256 + t) * 128 + head * 64 + 4 * fq;
#pragma unroll
                        for (int bj = 0; bj < 2; ++bj) {
                            f32x4 y0 = acc[ai][bj][m][0] * rstd * g4[bj][0], y1 = acc[ai][bj][m][1] * rstd * g4[bj][1];
                            if (!isq && !ti.lat) { *(GAS f32x4*)(o + 32 * bj) = y0; *(GAS f32x4*)(o + 32 * bj + 16) = y1; }
                            if (ti.lat) {
                                const f32x4 c4 = bj ? cc[mm] : rc[ai], s4 = bj ? cs[mm] : rs[ai];
                                const f32x4 o0 = y0 * c4 - y1 * s4, o1 = y1 * c4 + y0 * s4; y0 = o0; y1 = o1;
                            }
                            if (isq) { y0 = y0 * QSCALE_G; y1 = y1 * QSCALE_G; }
                            u32x4 w; w.x = cvtpk(y0[0], y0[1]); w.y = cvtpk(y0[2], y0[3]); w.z = cvtpk(y1[0], y1[1]); w.w = cvtpk(y1[2], y1[3]);
                            *(GAS u32x4*)(dst + 32 * bj) = w;
                        }
                    }
                asm volatile("" ::: "memory"); __builtin_amdgcn_sched_barrier(0);
            }
        } else if (pn == 2) {
            const int head = wc - 2;
#pragma unroll
            for (int ai = 0; ai < 2; ++ai)
#pragma unroll
                for (int m = 0; m < 4; ++m) {
                    const int rt = ai * 128 + m * 16 + rbase; const int t = ti.t0 + rt;
                    if (!ti.lat) {
                        float* o = out + OUT_GV + ((size_t)(ti.seq * 4 + layer) * 256 + t) * 128 + head * 64 + 8 * fq;
#pragma unroll
                        for (int bj = 0; bj < 2; ++bj) { *(GAS f32x4*)(o + 32 * bj) = acc[ai][bj][m][0]; *(GAS f32x4*)(o + 32 * bj + 4) = acc[ai][bj][m][1]; }
                    }
                    bf16_t* vp = VG + ((ti.R * 2 + (long)head * ti.S + t) * 64) + 8 * fq;
#pragma unroll
                    for (int bj = 0; bj < 2; ++bj) { const f32x4 a = acc[ai][bj][m][0], b = acc[ai][bj][m][1]; u32x4 w; w.x = cvtpk(a[0], a[1]); w.y = cvtpk(a[2], a[3]); w.z = cvtpk(b[0], b[1]); w.w = cvtpk(b[2], b[3]); *(GAS u32x4*)(vp + 32 * bj) = w; }
                }
        } else if (pn == 3) {
#pragma unroll
            for (int ai = 0; ai < 2; ++ai)
#pragma unroll
                for (int m = 0; m < 4; ++m) {
                    const size_t grow = (size_t)u.pm * 256 + ai * 128 + m * 16 + rbase;
                    bf16_t* p = CB + grow * 256 + 32 * wc + 8 * fq;
#pragma unroll
                    for (int bj = 0; bj < 2; ++bj) { const f32x4 a = acc[ai][bj][m][0], b = acc[ai][bj][m][1]; u32x4 w; w.x = cvtpk(a[0], a[1]); w.y = cvtpk(a[2], a[3]); w.z = cvtpk(b[0], b[1]); w.w = cvtpk(b[2], b[3]); *(GAS u32x4*)(p + 128 * bj) = w; }
                }
        } else if (pn < 6) {
#pragma unroll
            for (int ai = 0; ai < 2; ++ai)
#pragma unroll
                for (int m = 0; m < 4; ++m) {
                    const size_t grow = (size_t)u.pm * 256 + ai * 128 + m * 16 + rbase;
                    bf16_t* p = PB + grow * 256 + 128 * (pn - 4) + 32 * wc + 8 * fq;
                    const f32x4 a = acc[ai][0][m][0] * acc[ai][1][m][0], b = acc[ai][0][m][1] * acc[ai][1][m][1];
                    u32x4 w; w.x = cvtpk(a[0], a[1]); w.y = cvtpk(a[2], a[3]); w.z = cvtpk(b[0], b[1]); w.w = cvtpk(b[2], b[3]); *(GAS u32x4*)p = w;
                }
        } else if (pn < 8) {
            const bool isq = pn == 6;
            const float* gsrc = isq ? dqn_g : dkn_g;
            const int a_ax = fq >> 1, ib = 4 * (fq & 1);
            const float* gp = gsrc + 16 * a_ax + ib;
            const int head = wc;
            const f32x4 g0 = *(const GAS f32x4*)gp, g1 = *(const GAS f32x4*)(gp + 8);
            f32x4 tc[4], ts[4];
#pragma unroll
            for (int j = 0; j < 4; ++j) { const int pos = a_ax ? (16 * j + fr) : ((ti.t0 >> 6) + 2 * (j & 1) + wr); tc[j] = *(const GAS f32x4*)(r32c + pos * 8 + ib); ts[j] = *(const GAS f32x4*)(r32s + pos * 8 + ib); }
            __builtin_amdgcn_sched_group_barrier(0x020, 10, 0);
#pragma unroll
            for (int ai = 0; ai < 2; ++ai) {
                float ss[4][2];
#pragma unroll
                for (int m = 0; m < 4; ++m)
#pragma unroll
                    for (int bj = 0; bj < 2; ++bj) { float t_ = 0.f;
#pragma unroll
                        for (int n = 0; n < 2; ++n) { const f32x4 v = acc[ai][bj][m][n]; t_ += (v[0] * v[0] + v[1] * v[1]) + (v[2] * v[2] + v[3] * v[3]); }
                        ss[m][bj] = t_; }
#pragma unroll
                for (int i = 0; i < 4; ++i) { ss[i][0] += __shfl_xor(ss[i][0], 16); ss[i][1] += __shfl_xor(ss[i][1], 16); }
#pragma unroll
                for (int i = 0; i < 4; ++i) { ss[i][0] += __shfl_xor(ss[i][0], 32); ss[i][1] += __shfl_xor(ss[i][1], 32); }
#pragma unroll
                for (int m = 0; m < 4; ++m) {
                    const int rt = ai * 128 + m * 16 + rbase; const int t = ti.t0 + rt; const size_t grow = (size_t)u.pm * 256 + rt;
                    const f32x4 c4 = a_ax ? tc[m] : tc[ai], s4 = a_ax ? ts[m] : ts[ai];
#pragma unroll
                    for (int bj = 0; bj < 2; ++bj) {
                        const float rstd = rsqrtf(ss[m][bj] * (1.f / 32.f) + EPS);
                        f32x4 y0 = acc[ai][bj][m][0] * rstd * g0, y1 = acc[ai][bj][m][1] * rstd * g1;
                        if (!isq && !ti.lat) {
                            float* o = out + OUT_DK + ((size_t)(ti.seq * 4 + layer) * 256 + t) * 256 + head * 64 + bj * 32 + 16 * a_ax + ib;
                            *(GAS f32x4*)(o) = y0; *(GAS f32x4*)(o + 8) = y1;
                        }
                        if (ti.lat) { const f32x4 o0 = y0 * c4 - y1 * s4, o1 = y1 * c4 + y0 * s4; y0 = o0; y1 = o1; }
                        bf16_t* dst;
                        if (isq) { y0 = y0 * QSCALE_D; y1 = y1 * QSCALE_D; dst = QD + grow * 256 + head * 64 + bj * 32 + 16 * a_ax + 2 * ib; }
                        else dst = KD + ((ti.R * 8 + (long)(head * 2 + bj) * ti.S + t) * 32) + 16 * a_ax + 2 * ib;
                        u32x4 w; w.x = cvtpk(y0[0], y0[1]); w.y = cvtpk(y0[2], y0[3]); w.z = cvtpk(y1[0], y1[1]); w.w = cvtpk(y1[2], y1[3]);
                        *(GAS u32x4*)dst = w;
                    }
                }
                asm volatile("" ::: "memory"); __builtin_amdgcn_sched_barrier(0);
            }
        } else {
            const int head = wc;
#pragma unroll
            for (int ai = 0; ai < 2; ++ai)
#pragma unroll
                for (int m = 0; m < 4; ++m) {
                    const int rt = ai * 128 + m * 16 + rbase; const int t = ti.t0 + rt;
                    if (!ti.lat) {
                        float* o = out + OUT_DV + ((size_t)(ti.seq * 4 + layer) * 256 + t) * 256 + head * 64 + 8 * fq;
#pragma unroll
                        for (int bj = 0; bj < 2; ++bj) { *(GAS f32x4*)(o + 32 * bj) = acc[ai][bj][m][0]; *(GAS f32x4*)(o + 32 * bj + 4) = acc[ai][bj][m][1]; }
                    }
                    bf16_t* vp = VD + ((ti.R * 4 + (long)head * ti.S + t) * 64) + 8 * fq;
#pragma unroll
                    for (int bj = 0; bj < 2; ++bj) { const f32x4 a = acc[ai][bj][m][0], b = acc[ai][bj][m][1]; u32x4 w; w.x = cvtpk(a[0], a[1]); w.y = cvtpk(a[2], a[3]); w.z = cvtpk(b[0], b[1]); w.w = cvtpk(b[2], b[3]); *(GAS u32x4*)(vp + 32 * bj) = w; }
                }
        }
    }
};

__device__ __forceinline__ float dpp_ror1(float x) { return __int_as_float(__builtin_amdgcn_update_dpp(0, __float_as_int(x), 0x121, 0xf, 0xf, false)); }
__device__ __forceinline__ float dpp_ror15(float x) { return __int_as_float(__builtin_amdgcn_update_dpp(0, __float_as_int(x), 0x12F, 0xf, 0xf, false)); }
__device__ __forceinline__ float silu_f(float x) { return x * __builtin_amdgcn_rcpf(1.f + __builtin_amdgcn_exp2f(-x * LOG2E)); }
struct EpiUp {
    const float* cw; const float* cbias; bf16_t* F; float* EP; float* EA; float* EU;
    __device__ __forceinline__ void operator()(const Acc& acc, const pg8::Unit& u, int wr, int wc, int fr, int fq, LAS unsigned char* xlds) const {
        const TileInfo ti(u.pm);
        const int c0 = u.pn * 128 + wc * 32 + 8 * fq;
        LAS float* X = (LAS float*)xlds;
#pragma unroll
        for (int ai = 0; ai < 2; ++ai) {
            if (fr == 0) { LAS float* p = X + ((((ai * 2 + wr) * 4 + wc) * 2 + 0) * 4 + fq) * 8; *(LAS f32x4*)p = acc[ai][0][0][0]; *(LAS f32x4*)(p + 4) = acc[ai][0][0][1]; }
            if (fr == 15) { LAS float* p = X + ((((ai * 2 + wr) * 4 + wc) * 2 + 1) * 4 + fq) * 8; *(LAS f32x4*)p = acc[ai][0][3][0]; *(LAS f32x4*)(p + 4) = acc[ai][0][3][1]; }
        }
        asm volatile("s_waitcnt lgkmcnt(0)" ::: "memory"); __builtin_amdgcn_s_barrier(); asm volatile("" ::: "memory");
        f32x4 w0[2], w1[2], w2[2], bb[2];
#pragma unroll
        for (int n = 0; n < 2; ++n) { w0[n] = *(const GAS f32x4*)(cw + c0 + 4 * n); w1[n] = *(const GAS f32x4*)(cw + DFF + c0 + 4 * n); w2[n] = *(const GAS f32x4*)(cw + 2 * DFF + c0 + 4 * n); bb[n] = *(const GAS f32x4*)(cbias + c0 + 4 * n); }
        const bool has_prev = ti.lat && ti.t0 > 0, has_next = ti.lat && ti.t0 < 4096 - 256;
#pragma unroll
        for (int ai = 0; ai < 2; ++ai) {
            f32x4 pb[2] = {(f32x4){0.f, 0.f, 0.f, 0.f}, (f32x4){0.f, 0.f, 0.f, 0.f}}, nb[2] = {(f32x4){0.f, 0.f, 0.f, 0.f}, (f32x4){0.f, 0.f, 0.f, 0.f}};
            { const int seg = ai * 2 + wr;
              if (seg > 0) { const int ps = seg - 1; LAS float* p = X + ((((ps >> 1) * 2 + (ps & 1)) * 4 + wc) * 2 + 1) * 32 + fq * 8; pb[0] = *(LAS f32x4*)p; pb[1] = *(LAS f32x4*)(p + 4); }
              if (seg < 3) { const int ns = seg + 1; LAS float* p = X + ((((ns >> 1) * 2 + (ns & 1)) * 4 + wc) * 2 + 0) * 32 + fq * 8; nb[0] = *(LAS f32x4*)p; nb[1] = *(LAS f32x4*)(p + 4); } }
#pragma unroll
            for (int m = 0; m < 4; ++m) {
                const int rt = ai * 128 + wr * 64 + m * 16 + fr; const size_t grow = (size_t)u.pm * 256 + rt;
                f32x4 fo[2], cv[2];
#pragma unroll
                for (int n = 0; n < 2; ++n) {
                    const f32x4 a = acc[ai][0][m][n];
                    const f32x4 up = (m > 0) ? acc[ai][0][m > 0 ? m - 1 : 0][n] : pb[n];
                    const f32x4 dn = (m < 3) ? acc[ai][0][m < 3 ? m + 1 : 3][n] : nb[n];
                    f32x4 pv, nx;
#pragma unroll
                    for (int e = 0; e < 4; ++e) {
                        pv[e] = dpp_ror1(fr == 15 ? up[e] : a[e]);
                        nx[e] = dpp_ror15(fr == 0 ? dn[e] : a[e]);
                    }
                    const f32x4 c = w0[n] * pv + w1[n] * a + w2[n] * nx + bb[n];
                    cv[n] = c;
                    const f32x4 uu = acc[ai][1][m][n];
#pragma unroll
                    for (int e = 0; e < 4; ++e) fo[n][e] = silu_f(c[e]) * uu[e];
                }
                u32x4 w; w.x = cvtpk(fo[0][0], fo[0][1]); w.y = cvtpk(fo[0][2], fo[0][3]); w.z = cvtpk(fo[1][0], fo[1][1]); w.w = cvtpk(fo[1][2], fo[1][3]);
                *(GAS u32x4*)(F + grow * DFF + c0) = w;
                if (ai == 0 && m == 0) { if (has_prev && rt == 0) { const size_t eo = ((size_t)u.pm * 2 + 0) * DFF + c0;
                        *(GAS f32x4*)(EP + eo) = cv[0]; *(GAS f32x4*)(EP + eo + 4) = cv[1]; *(GAS f32x4*)(EA + eo) = acc[0][0][0][0]; *(GAS f32x4*)(EA + eo + 4) = acc[0][0][0][1]; *(GAS f32x4*)(EU + eo) = acc[0][1][0][0]; *(GAS f32x4*)(EU + eo + 4) = acc[0][1][0][1]; } }
                if (ai == 1 && m == 3) { if (has_next && rt == 255) { const size_t eo = ((size_t)u.pm * 2 + 1) * DFF + c0;
                        *(GAS f32x4*)(EP + eo) = cv[0]; *(GAS f32x4*)(EP + eo + 4) = cv[1]; *(GAS f32x4*)(EA + eo) = acc[1][0][3][0]; *(GAS f32x4*)(EA + eo + 4) = acc[1][0][3][1]; *(GAS f32x4*)(EU + eo) = acc[1][1][3][0]; *(GAS f32x4*)(EU + eo + 4) = acc[1][1][3][1]; } }
            }
        }
        asm volatile("s_waitcnt lgkmcnt(0)" ::: "memory"); __builtin_amdgcn_s_barrier(); asm volatile("" ::: "memory");
    }
};

typedef short v4i16_t __attribute__((ext_vector_type(4)));
__device__ __forceinline__ s16x4 vtr(LAS const char* p) { return __builtin_bit_cast(s16x4, __builtin_amdgcn_ds_read_tr16_b64_v4i16((LAS v4i16_t*)p)); }
__device__ __forceinline__ float xhalf_max(float m) { auto rr = __builtin_amdgcn_permlane32_swap(__float_as_uint(m), __float_as_uint(m), false, false); return fmaxf(__uint_as_float(rr[0]), __uint_as_float(rr[1])); }
__device__ __forceinline__ float xhalf_sum(float m) { auto rr = __builtin_amdgcn_permlane32_swap(__float_as_uint(m), __float_as_uint(m), false, false); return __uint_as_float(rr[0]) + __uint_as_float(rr[1]); }

constexpr int ATT_VS = 192;
constexpr float ATT_THR = 8.f;
#define MX3(a, b, c) __builtin_fmaxf(__builtin_fmaxf((a), (b)), (c))
template <int DQK, bool YORD>
__device__ __forceinline__ void flash_pass(const bf16_t* __restrict__ Qw, int qpitch, const bf16_t* __restrict__ Kg, const bf16_t* __restrict__ Vg, int NT, int tst,
                                           LAS char* lds, f32x16 (&o)[2], float& lsum) {
#define ATT_TI(T) (((T) + tst) < NT ? ((T) + tst) : ((T) + tst - NT))
    constexpr int KS = DQK * 2 + 16, KBUF = 64 * KS, VBUF = 64 * ATT_VS, NDS = DQK / 16;
    constexpr int KROWB = DQK * 2;
    const int tid = opaque_tid(), lane = tid & 63, r32 = lane & 31, h = lane >> 5;
    LAS char* Kb = lds; LAS char* Vb = lds + 2 * KBUF;
    bf16x8 qf[NDS];
#pragma unroll
    for (int ds = 0; ds < NDS; ++ds) qf[ds] = *(const GAS bf16x8*)(Qw + (size_t)r32 * qpitch + 16 * ds + 8 * h);
    const bool kload = (tid * 16) < 64 * KROWB;
    const int krow = (tid * 16) / KROWB, kcb = (tid * 16) % KROWB;
    const int kdst = krow * KS + kcb, vdst = (tid >> 3) * ATT_VS + (tid & 7) * 16;
    const char* kg = (const char*)Kg + tid * 16; const char* vg = (const char*)Vg + tid * 16;
    u32x4 kreg = {0, 0, 0, 0}, vreg;
    {
        u32x4 k1 = {0, 0, 0, 0};
        if (kload) { kreg = *(const GAS u32x4*)(kg + (size_t)ATT_TI(0) * 64 * KROWB); k1 = *(const GAS u32x4*)(kg + (size_t)ATT_TI(1) * 64 * KROWB); }
        vreg = *(const GAS u32x4*)(vg + (size_t)ATT_TI(0) * 64 * 128);
        if (kload) { *(LAS u32x4*)(Kb + kdst) = kreg; *(LAS u32x4*)(Kb + KBUF + kdst) = k1; }
        *(LAS u32x4*)(Vb + vdst) = vreg;
        *(LAS u32x4*)(Vb + 2 * VBUF + vdst) = (u32x4){0, 0, 0, 0};
    }
    __syncthreads();
    const int kfo = r32 * KS + h * 16;
    const int vfo = (4 * h + ((lane & 15) >> 2)) * ATT_VS + (((lane >> 4) & 1) * 16 + (lane & 3) * 4) * 2;
    f32x16 p0 = (f32x16){}, p1 = (f32x16){};
#pragma unroll
    for (int ds = 0; ds < NDS; ++ds) {
        const bf16x8 k0 = *(LAS const bf16x8*)(Kb + kfo + ds * 32), k1 = *(LAS const bf16x8*)(Kb + kfo + 32 * KS + ds * 32);
        p0 = __builtin_amdgcn_mfma_f32_32x32x16_bf16(k0, qf[ds], p0, 0, 0, 0);
        p1 = __builtin_amdgcn_mfma_f32_32x32x16_bf16(k1, qf[ds], p1, 0, 0, 0);
    }
    __syncthreads();
    float mref, l = 0.f;
    {
        float a = MX3(p0[0], p0[1], p1[0]), b = MX3(p0[2], p0[3], p1[1]); a = MX3(a, p1[2], p1[3]);
#pragma unroll
        for (int r = 4; r < 16; r += 4) { a = MX3(a, p0[r], p0[r + 1]); b = MX3(b, p0[r + 2], p0[r + 3]); a = MX3(a, p1[r], p1[r + 1]); b = MX3(b, p1[r + 2], p1[r + 3]); }
        mref = xhalf_max(fmaxf(a, b));
#pragma unroll
        for (int r = 0; r < 16; ++r) { p0[r] -= mref; p1[r] -= mref; }
    }
    f32x16 negm;
#pragma unroll
    for (int r = 0; r < 16; ++r) negm[r] = -mref;
    asm volatile("" : "+v"(negm));
    o[0] = (f32x16){}; o[1] = (f32x16){};
    bf16x8 pk[4] = {};
    int vs_prev = 2 * VBUF, vs_cur = 0, vs_next = VBUF;
#define ATT_MPART(N0, N1, T) do { \
        LAS const char* kb_ = Kb + ((((T) + 1) & 1) * KBUF) + kfo; LAS const char* vb_ = Vb + vs_prev + vfo; \
        bf16x8 kf_[2 * NDS]; s16x4 vl_[8], vh_[8]; \
        _Pragma("unroll") for (int ds = 0; ds < NDS; ++ds) { kf_[2 * ds] = *(LAS const bf16x8*)(kb_ + ds * 32); kf_[2 * ds + 1] = *(LAS const bf16x8*)(kb_ + 32 * KS + ds * 32); } \
        _Pragma("unroll") for (int s_ = 0; s_ < 4; ++s_) { _Pragma("unroll") for (int db_ = 0; db_ < 2; ++db_) { \
            vl_[2 * s_ + db_] = vtr(vb_ + (16 * s_) * ATT_VS + db_ * 64); vh_[2 * s_ + db_] = vtr(vb_ + (16 * s_ + 8) * ATT_VS + db_ * 64); } } \
        N0 = __builtin_amdgcn_mfma_f32_32x32x16_bf16(kf_[0], qf[0], negm, 0, 0, 0); N1 = __builtin_amdgcn_mfma_f32_32x32x16_bf16(kf_[1], qf[0], negm, 0, 0, 0); \
        _Pragma("unroll") for (int ds = 1; ds < NDS; ++ds) { \
            N0 = __builtin_amdgcn_mfma_f32_32x32x16_bf16(kf_[2 * ds], qf[ds], N0, 0, 0, 0); N1 = __builtin_amdgcn_mfma_f32_32x32x16_bf16(kf_[2 * ds + 1], qf[ds], N1, 0, 0, 0); } \
        _Pragma("unroll") for (int s_ = 0; s_ < 4; ++s_) { _Pragma("unroll") for (int db_ = 0; db_ < 2; ++db_) { \
            const bf16x8 vf_ = __builtin_shufflevector(vl_[2 * s_ + db_], vh_[2 * s_ + db_], 0, 1, 2, 3, 4, 5, 6, 7); \
            o[db_] = __builtin_amdgcn_mfma_f32_32x32x16_bf16(vf_, pk[s_], o[db_], 0, 0, 0); } } \
        __builtin_amdgcn_sched_group_barrier(0x100, 2 * NDS + 8, 0); __builtin_amdgcn_sched_group_barrier(0x008, 2 * NDS, 0); \
        __builtin_amdgcn_sched_group_barrier(0x100, 8, 0); __builtin_amdgcn_sched_group_barrier(0x008, 8, 0); } while (0)
#define ATT_VPART(P0, P1, N0, N1) do { \
        float a = MX3(P0[0], P0[1], P1[0]), b = MX3(P0[2], P0[3], P1[1]); a = MX3(a, P1[2], P1[3]); \
        _Pragma("unroll") for (int r = 4; r < 16; r += 4) { a = MX3(a, P0[r], P0[r + 1]); b = MX3(b, P0[r + 2], P0[r + 3]); a = MX3(a, P1[r], P1[r + 1]); b = MX3(b, P1[r + 2], P1[r + 3]); } \
        const float mt = xhalf_max(fmaxf(a, b)); \
        resc = __any(mt > ATT_THR); \
        if (__builtin_expect(resc, 0)) { \
            const float dl = fmaxf(mt, 0.f); mref += dl; fsc = __builtin_amdgcn_exp2f(-dl); l *= fsc; \
            _Pragma("unroll") for (int r = 0; r < 16; ++r) { P0[r] -= dl; P1[r] -= dl; } \
            if (!YORD) { _Pragma("unroll") for (int r = 0; r < 16; ++r) { N0[r] -= dl; N1[r] -= dl; o[0][r] *= fsc; o[1][r] *= fsc; } } \
            _Pragma("unroll") for (int r = 0; r < 16; ++r) negm[r] = -mref; \
            asm volatile("" : "+v"(negm)); } \
        float ps0 = 0.f, ps1 = 0.f; \
        _Pragma("unroll") for (int r = 0; r < 16; ++r) { P0[r] = __builtin_amdgcn_exp2f(P0[r]); P1[r] = __builtin_amdgcn_exp2f(P1[r]); ps0 += P0[r]; ps1 += P1[r]; } \
        l += ps0 + ps1; \
        _Pragma("unroll") for (int s = 0; s < 2; ++s) { u32x4 a4, b4; \
            a4.x = cvtpk(P0[8 * s + 0], P0[8 * s + 1]); a4.y = cvtpk(P0[8 * s + 2], P0[8 * s + 3]); a4.z = cvtpk(P0[8 * s + 4], P0[8 * s + 5]); a4.w = cvtpk(P0[8 * s + 6], P0[8 * s + 7]); \
            b4.x = cvtpk(P1[8 * s + 0], P1[8 * s + 1]); b4.y = cvtpk(P1[8 * s + 2], P1[8 * s + 3]); b4.z = cvtpk(P1[8 * s + 4], P1[8 * s + 5]); b4.w = cvtpk(P1[8 * s + 6], P1[8 * s + 7]); \
            pkn[s] = __builtin_bit_cast(bf16x8, a4); pkn[2 + s] = __builtin_bit_cast(bf16x8, b4); } } while (0)
#define ATT_STEP(P0, P1, N0, N1, T) do { \
        const bool more = (T) + 1 < NT, more2 = (T) + 2 < NT; \
        if (more2 && kload) kreg = *(const GAS u32x4*)(kg + (size_t)ATT_TI((T) + 2) * 64 * KROWB); \
        if (more) vreg = *(const GAS u32x4*)(vg + (size_t)ATT_TI((T) + 1) * 64 * 128); \
        float fsc = 1.f; bool resc; bf16x8 pkn[4]; \
        if (!YORD) { ATT_MPART(N0, N1, T); __builtin_amdgcn_sched_barrier(0); ATT_VPART(P0, P1, N0, N1); } \
        else { ATT_VPART(P0, P1, N0, N1); __builtin_amdgcn_sched_barrier(0); ATT_MPART(N0, N1, T); \
            if (__builtin_expect(resc, 0)) { _Pragma("unroll") for (int r = 0; r < 16; ++r) { o[0][r] *= fsc; o[1][r] *= fsc; } } } \
        _Pragma("unroll") for (int s = 0; s < 4; ++s) pk[s] = pkn[s]; \
        if (more2 && kload) *(LAS u32x4*)(Kb + ((T) & 1) * KBUF + kdst) = kreg; \
        if (more) *(LAS u32x4*)(Vb + vs_next + vdst) = vreg; \
        __syncthreads(); \
        vs_prev = vs_cur; vs_cur = vs_next; vs_next = (vs_next == 2 * VBUF) ? 0 : vs_next + VBUF; } while (0)
    f32x16 n0, n1;
    for (int t = 0; t < NT; t += 2) {
        ATT_STEP(p0, p1, n0, n1, t);
        ATT_STEP(n0, n1, p0, p1, t + 1);
    }
    {
        LAS const char* vb_ = Vb + vs_prev + vfo;
#pragma unroll
        for (int s_ = 0; s_ < 4; ++s_) {
#pragma unroll
            for (int db_ = 0; db_ < 2; ++db_) {
                const s16x4 lo_ = vtr(vb_ + (16 * s_) * ATT_VS + db_ * 64), hi_ = vtr(vb_ + (16 * s_ + 8) * ATT_VS + db_ * 64);
                const bf16x8 vf_ = __builtin_shufflevector(lo_, hi_, 0, 1, 2, 3, 4, 5, 6, 7);
                o[db_] = __builtin_amdgcn_mfma_f32_32x32x16_bf16(vf_, pk[s_], o[db_], 0, 0, 0);
            }
        }
    }
    __syncthreads();
#undef ATT_STEP
#undef ATT_TI
#undef ATT_VPART
#undef ATT_MPART
    lsum = xhalf_sum(l);
}

__device__ __forceinline__ void store_ot(const f32x16 (&o)[2], bf16_t* dst  , int h) {
#pragma unroll
    for (int db = 0; db < 2; ++db)
#pragma unroll
        for (int g = 0; g < 4; ++g) { u32x2 w; w.x = cvtpk(o[db][4 * g], o[db][4 * g + 1]); w.y = cvtpk(o[db][4 * g + 2], o[db][4 * g + 3]); *(GAS u32x2*)(dst + 32 * db + 8 * g + 4 * h) = w; }
}

#include <hip/hip_bf16.h>
namespace attn64 {
using bf16=__hip_bfloat16;
using bf16x8=__attribute__((ext_vector_type(8)))short;
using s16x4=__attribute__((ext_vector_type(4)))short;
using f32x16=__attribute__((ext_vector_type(16)))float;
using u32x4=__attribute__((ext_vector_type(4)))unsigned;
constexpr int D=64;
constexpr int NW=8,QBLK=32,QB=QBLK*NW,KVBLK=64;

__device__ __forceinline__ int crow(int r,int hi){return (r&3)+8*(r>>2)+4*hi;}
#define SBAR() __builtin_amdgcn_sched_barrier(0)
__device__ __forceinline__ void cmask(f32x16&p0,f32x16&p1,int jb,int qrel,int hi){
  const float NEG=-INFINITY; int kb=64*jb+4*hi;
  #pragma unroll
  for(int r=0;r<16;++r){int kv=kb+(r&3)+8*(r>>2); if(kv>qrel)p0[r]=NEG; if(kv+32>qrel)p1[r]=NEG;}
}

constexpr int NSLOT=3, SLOTB=8192;
constexpr int LDS_K=0, LDS_V=NSLOT*SLOTB, LDS_WS=2*NSLOT*SLOTB, LDS_OST=LDS_WS+NW*64*4, LDS_BYTES=LDS_OST+NW*4096;
constexpr float C2=0.125f*1.4426950408889634f;
__device__ __forceinline__ void glds16(const void*gsrc,unsigned lds_dst){unsigned keep;
  asm volatile("s_mov_b32 %0, m0\n\ts_mov_b32 m0, %2\n\ts_nop 0\n\tglobal_load_lds_dwordx4 %1, off\n\ts_mov_b32 m0, %0":"=&s"(keep):"v"(gsrc),"s"(lds_dst):"memory");}
__device__ __forceinline__ float max3f(float a,float b,float c){float r;asm("v_max3_f32 %0, %1, %2, %3":"=v"(r):"v"(a),"v"(b),"v"(c));return r;}
__device__ __forceinline__ float max2f(float a,float b){float r;asm("v_max_f32_e32 %0, %1, %2":"=v"(r):"v"(a),"v"(b));return r;}
__device__ __forceinline__ float fadd_s(float a,float b){float r;asm("v_add_f32_e32 %0, %1, %2":"=v"(r):"v"(a),"v"(b));return r;}
__device__ __forceinline__ float fsub_s(float a,float b){float r;asm("v_sub_f32_e32 %0, %1, %2":"=v"(r):"v"(a),"v"(b));return r;}
typedef float f32x2_t __attribute__((ext_vector_type(2))); typedef __bf16 bf16x2_t __attribute__((ext_vector_type(2)));
__device__ __forceinline__ unsigned cvtpk_s(float lo,float hi){f32x2_t v={lo,hi};bf16x2_t b=__builtin_convertvector(v,bf16x2_t);return __builtin_bit_cast(unsigned,b);}
#define WAIT_BAR(N) asm volatile("s_waitcnt vmcnt(" #N ") lgkmcnt(0)\n\ts_barrier":::"memory")

template<int NDS_> __device__ __forceinline__ void qkt(f32x16&p0,f32x16&p1,const char*Kslot,const bf16x8*qr,const f32x16&negm,int r32,int hi){
  const char*kb=Kslot+hi*1024+r32*16;
  #pragma unroll
  for(int d0=0;d0<NDS_;++d0){
    const bf16x8 b0=*reinterpret_cast<const bf16x8*>(kb+d0*2048);
    const bf16x8 b1=*reinterpret_cast<const bf16x8*>(kb+d0*2048+512);
    if(d0==0){p0=__builtin_amdgcn_mfma_f32_32x32x16_bf16(b0,qr[0],negm,0,0,0);p1=__builtin_amdgcn_mfma_f32_32x32x16_bf16(b1,qr[0],negm,0,0,0);}
    else{p0=__builtin_amdgcn_mfma_f32_32x32x16_bf16(b0,qr[d0],p0,0,0,0);p1=__builtin_amdgcn_mfma_f32_32x32x16_bf16(b1,qr[d0],p1,0,0,0);}}
}
typedef __attribute__((address_space(3))) const char* lds_cptr;
typedef short v4i16_t __attribute__((ext_vector_type(4)));
__device__ __forceinline__ void kload8(bf16x8*kf,lds_cptr kp){
  kf[0]=*(const __attribute__((address_space(3))) bf16x8*)(kp);      kf[1]=*(const __attribute__((address_space(3))) bf16x8*)(kp+512);
  kf[2]=*(const __attribute__((address_space(3))) bf16x8*)(kp+2048); kf[3]=*(const __attribute__((address_space(3))) bf16x8*)(kp+2560);
  kf[4]=*(const __attribute__((address_space(3))) bf16x8*)(kp+4096); kf[5]=*(const __attribute__((address_space(3))) bf16x8*)(kp+4608);
  kf[6]=*(const __attribute__((address_space(3))) bf16x8*)(kp+6144); kf[7]=*(const __attribute__((address_space(3))) bf16x8*)(kp+6656);
}
__device__ __forceinline__ void kload2(bf16x8*kf,lds_cptr kp,int j){ kf[2*j]=*(const __attribute__((address_space(3))) bf16x8*)(kp+j*2048); kf[2*j+1]=*(const __attribute__((address_space(3))) bf16x8*)(kp+j*2048+512); }
__device__ __forceinline__ s16x4 vtr(lds_cptr p){ return __builtin_bit_cast(s16x4,__builtin_amdgcn_ds_read_tr16_b64_v4i16((__attribute__((address_space(3))) v4i16_t*)p)); }
__device__ __forceinline__ float rowmax(const f32x16&p0,const f32x16&p1){
  float a=max3f(p0[0],p0[1],p1[0]),b=max3f(p0[2],p0[3],p1[1]);a=max3f(a,p1[2],p1[3]);
  #pragma unroll
  for(int r=4;r<16;r+=4){a=max3f(a,p0[r],p0[r+1]);b=max3f(b,p0[r+2],p0[r+3]);a=max3f(a,p1[r],p1[r+1]);b=max3f(b,p1[r+2],p1[r+3]);}
  const float m=max2f(a,b);
  auto rr=__builtin_amdgcn_permlane32_swap(__float_as_uint(m),__float_as_uint(m),false,false);
  return max2f(__uint_as_float(rr[0]),__uint_as_float(rr[1]));
}
__device__ __forceinline__ void pv(f32x16*o,int vb,bf16x8 pa0,bf16x8 pa1,bf16x8 pa2,bf16x8 pa3){
  #pragma unroll
  for(int d0=0;d0<2;++d0){s16x4 lo[4],hi[4];
    #pragma unroll
    for(int ks=0;ks<4;++ks){
      asm volatile("ds_read_b64_tr_b16 %0,%1 offset:%c2":"=&v"(lo[ks]):"v"(vb),"i"(d0*4096+ks*1024):"memory");
      asm volatile("ds_read_b64_tr_b16 %0,%1 offset:%c2":"=&v"(hi[ks]):"v"(vb),"i"(d0*4096+ks*1024+512):"memory");}
    asm volatile("s_waitcnt lgkmcnt(0)":::"memory");SBAR();
    #define PK(k) (bf16x8){lo[k][0],lo[k][1],lo[k][2],lo[k][3],hi[k][0],hi[k][1],hi[k][2],hi[k][3]}
    o[d0]=__builtin_amdgcn_mfma_f32_32x32x16_bf16(pa0,PK(0),o[d0],0,0,0);
    o[d0]=__builtin_amdgcn_mfma_f32_32x32x16_bf16(pa1,PK(1),o[d0],0,0,0);
    o[d0]=__builtin_amdgcn_mfma_f32_32x32x16_bf16(pa2,PK(2),o[d0],0,0,0);
    o[d0]=__builtin_amdgcn_mfma_f32_32x32x16_bf16(pa3,PK(3),o[d0],0,0,0);
    #undef PK
  }
}

#ifndef ATTN_STORE16
#define ATTN_STORE16(p,v) (*(GAS u32x4*)(p)=(v))
#endif
__device__ __forceinline__ void stage_store(const f32x16 (&o)[2],bf16*Ow,int op,char*shm,int wid,int lane,int r32,int hi){
  bf16*stg=(bf16*)(shm+LDS_OST)+wid*2048;
  #pragma unroll
  for(int r=0;r<16;++r){const int orow=crow(r,hi);
    #pragma unroll
    for(int d0=0;d0<2;++d0)stg[orow*64+d0*32+r32]=__float2bfloat16(o[d0][r]);}
  asm volatile("s_waitcnt lgkmcnt(0)":::"memory");
  #pragma unroll
  for(int i=0;i<4;++i){const int row=i*8+(lane>>3),ch=lane&7; const u32x4 v=*(const u32x4*)(stg+row*64+ch*8); ATTN_STORE16(Ow+(long)row*op+ch*8,v);}
}
template<int THRL,int MODE,int DQ> __device__ __forceinline__ void attn_unit(const bf16*Qw0,int qp,const bf16*__restrict__ Kh,int kp,const bf16*__restrict__ Vh,int vp,int NT,bf16*Ow0,int op,char*shm,f32x16 (&oret)[2]){
  constexpr int NDS=DQ/16;
  const int tid=opaque_tid(),lane=tid&63,r32=lane&31,hi=lane>>5; const int wid=__builtin_amdgcn_readfirstlane(tid>>6);
  const bf16*Qw=Qw0+(long)(wid*QBLK)*qp;
  const unsigned lds0=(unsigned)(uintptr_t)shm;
  float*wsf=(float*)(shm+LDS_WS)+wid*64;
  const int kch=(DQ==64)?wid:(wid&3);
  const bf16*ksrc=Kh+(long)lane*kp+kch*8;
  const bf16*vsrc=Vh+(long)(16*(wid&3)+(lane>>2))*vp+(wid>>2)*32+(lane&3)*8;
  const unsigned kdst=lds0+LDS_K+kch*1024, vdst=lds0+LDS_V+wid*1024;
  #define DMA_K(t,slot) glds16(ksrc+(long)(t)*KVBLK*kp,(unsigned)__builtin_amdgcn_readfirstlane(kdst+(slot)))
  #define DMA_V(t,slot) glds16(vsrc+(long)(t)*KVBLK*vp,(unsigned)__builtin_amdgcn_readfirstlane(vdst+(slot)))
  const int vb0=(int)(lds0+LDS_V)+((lane>>4)&1)*32+(lane&3)*8+(4*hi+((lane&15)>>2))*64;
  const char*Kbase=shm+LDS_K; bf16x8 kf[8];
  const lds_cptr shm3=(lds_cptr)shm; const lds_cptr kp0=shm3+LDS_K+hi*1024+r32*16; const lds_cptr vp0=shm3+LDS_V+((lane>>4)&1)*32+(lane&3)*8+(4*hi+((lane&15)>>2))*64;
  DMA_K(0,0);DMA_V(0,0);DMA_K(1,SLOTB);
  bf16x8 qr[4];
  #pragma unroll
  for(int d0=0;d0<NDS;++d0)qr[d0]=*(const GAS bf16x8*)(&Qw[(long)r32*qp+d0*16+hi*8]);
  float mhat=0.f,l_reg=0.f;f32x16 o[2];o[0]=f32x16{};o[1]=f32x16{};f32x16 negm=f32x16{};asm volatile("":"+v"(negm));
  #define CMASK(P0,P1,t) do{}while(0)
  bool resc=false;
  #define START(P0,P1) do{ const float rm=rowmax(P0,P1); resc=false; \
    { const float dl=rm; mhat=fadd_s(mhat,dl); \
      _Pragma("unroll") for(int r=0;r<16;++r){P0[r]=fsub_s(P0[r],dl);P1[r]=fsub_s(P1[r],dl);} \
      _Pragma("unroll") for(int r=0;r<16;++r)negm[r]=-mhat; asm volatile("":"+v"(negm)); } \
    _Pragma("unroll") for(int r=0;r<16;++r)P0[r]=__builtin_amdgcn_exp2f(P0[r]); }while(0)
  #define RESC() do{ if(resc){ asm volatile("s_waitcnt lgkmcnt(0)":::"memory"); \
      _Pragma("unroll") for(int d_=0;d_<2;++d_) _Pragma("unroll") for(int r=0;r<16;++r)o[d_][r]*=wsf[crow(r,hi)]; } }while(0)
  f32x16 pA0,pA1,pB0,pB1;
  int sl_prev=0,sl_cur=0,sl_next=SLOTB;
  #define ROT() do{sl_prev=sl_cur;sl_cur=sl_next;sl_next=(sl_next==(NSLOT-1)*SLOTB)?0:sl_next+SLOTB;}while(0)
  DMA_K(2,2*SLOTB);
  WAIT_BAR(3);
  qkt<NDS>(pA0,pA1,Kbase,qr,negm,r32,hi);asm volatile("s_nop 15\n\ts_nop 7":"+v"(pA0),"+v"(pA1));CMASK(pA0,pA1,0);
  START(pA0,pA1);
  _Pragma("unroll") for(int r=0;r<16;++r)pA1[r]=__builtin_amdgcn_exp2f(pA1[r]);
  WAIT_BAR(0);
  DMA_K(3,0);DMA_V(1,SLOTB);
  ROT();
  if constexpr(DQ==64) kload8(kf,kp0+sl_cur); else { kload2(kf,kp0+sl_cur,0); kload2(kf,kp0+sl_cur,1); }
  WAIT_BAR(2);
  s16x4 vlo[8],vhi[8]; u32x4 pw0,pw1,pw2,pw3;
  #define PKW(P,B) cvtpk_s(P[B],P[B+1])
  #define PAF(k) __builtin_bit_cast(bf16x8,pw##k)
  #define VFR(i) (bf16x8){vlo[i][0],vlo[i][1],vlo[i][2],vlo[i][3],vhi[i][0],vhi[i][1],vhi[i][2],vhi[i][3]}
  #define PIN(x) asm volatile("":"+v"(x))
  #define MX3(a,b,c) __builtin_fmaxf(__builtin_fmaxf((a),(b)),(c))
  #define GAPA(MF,A0,A1,A2,A3,W0,W1,PW) do{ MF; sacc+=A0; sacc+=A1; sacc+=A2; sacc+=A3; PIN(sacc); W0; W1; PIN(PW); SBAR(); }while(0)
  #define EX(v) __builtin_amdgcn_exp2f(v)
  #define GAPB(MF,X,B) do{ MF; X[B]=EX(X[B]); X[B+1]=EX(X[B+1]); X[B+2]=EX(X[B+2]); X[B+3]=EX(X[B+3]); PIN(X); SBAR(); }while(0)
  #define VRD(i) do{ vlo[i]=vtr(vp_+(((i)>>2)*4096+((i)&3)*1024)); vhi[i]=vtr(vp_+(((i)>>2)*4096+((i)&3)*1024+512)); }while(0)
  #define KRD(G,j) do{ if(G){ kload2(kf,kp0+sl_next,j); SBAR(); } }while(0)
  #define STEP(C0,C1,P0,P1,t,GK,GV,GL) do{ SBAR(); \
    const lds_cptr vp_=vp0+sl_prev; \
    VRD(0); SBAR(); float sacc=(P0[0]+P0[1]); \
    GAPA(C0=__builtin_amdgcn_mfma_f32_32x32x16_bf16(kf[0],qr[0],negm,0,0,0), P0[2],P0[3],P0[4],P0[5],     pw0[0]=PKW(P0,0), pw0[1]=PKW(P0,2), pw0); \
    VRD(4); SBAR(); GAPA(C1=__builtin_amdgcn_mfma_f32_32x32x16_bf16(kf[1],qr[0],negm,0,0,0), P0[6],P0[7],P0[8],P0[9],     pw0[2]=PKW(P0,4), pw0[3]=PKW(P0,6), pw0); \
    VRD(1); SBAR(); GAPA(C0=__builtin_amdgcn_mfma_f32_32x32x16_bf16(kf[2],qr[1],C0,0,0,0),   P0[10],P0[11],P0[12],P0[13], pw1[0]=PKW(P0,8), pw1[1]=PKW(P0,10), pw1); \
    VRD(5); SBAR(); GAPA(C1=__builtin_amdgcn_mfma_f32_32x32x16_bf16(kf[3],qr[1],C1,0,0,0),   P0[14],P0[15],P1[0],P1[1],   pw1[2]=PKW(P0,12),pw1[3]=PKW(P0,14), pw1); \
    VRD(2); SBAR(); GAPA(if constexpr(DQ==64) C0=__builtin_amdgcn_mfma_f32_32x32x16_bf16(kf[4],qr[2],C0,0,0,0),   P1[2],P1[3],P1[4],P1[5],     pw2[0]=PKW(P1,0), pw2[1]=PKW(P1,2), pw2); \
    VRD(6); SBAR(); GAPA(if constexpr(DQ==64) C1=__builtin_amdgcn_mfma_f32_32x32x16_bf16(kf[5],qr[2],C1,0,0,0),   P1[6],P1[7],P1[8],P1[9],     pw2[2]=PKW(P1,4), pw2[3]=PKW(P1,6), pw2); \
    VRD(3); SBAR(); GAPA(if constexpr(DQ==64) C0=__builtin_amdgcn_mfma_f32_32x32x16_bf16(kf[6],qr[3],C0,0,0,0),   P1[10],P1[11],P1[12],P1[13], pw3[0]=PKW(P1,8), pw3[1]=PKW(P1,10), pw3); \
    VRD(7); SBAR(); GAPA(if constexpr(DQ==64) C1=__builtin_amdgcn_mfma_f32_32x32x16_bf16(kf[7],qr[3],C1,0,0,0),   P1[14],P1[15],0.f,0.f,       pw3[2]=PKW(P1,12),pw3[3]=PKW(P1,14), pw3); \
    l_reg+=sacc; \
    if(GK){DMA_K((t)+3,sl_cur);} if(GV){DMA_V((t)+1,sl_next);} \
    CMASK(C0,C1,t); \
    { float a=MX3(C0[0],C0[1],C1[0]),b=MX3(C0[2],C0[3],C1[1]); a=MX3(a,C1[2],C1[3]); \
      _Pragma("unroll") for(int r=4;r<16;r+=4){a=MX3(a,C0[r],C0[r+1]);b=MX3(b,C0[r+2],C0[r+3]);a=MX3(a,C1[r],C1[r+1]);b=MX3(b,C1[r+2],C1[r+3]);} \
      float rm=__builtin_fmaxf(a,b); { auto rr=__builtin_amdgcn_permlane32_swap(__float_as_uint(rm),__float_as_uint(rm),false,false); rm=__builtin_fmaxf(__uint_as_float(rr[0]),__uint_as_float(rr[1])); } \
      resc=false; \
      if(__builtin_expect(__any(rm>(float)THRL),0)){ const float dl=__builtin_fmaxf(rm,0.f); mhat+=dl; \
        _Pragma("unroll") for(int r=0;r<16;++r){C0[r]-=dl;C1[r]-=dl;} \
        _Pragma("unroll") for(int r=0;r<16;++r)negm[r]=-mhat; asm volatile("":"+v"(negm)); \
        const float f=__builtin_amdgcn_exp2f(-dl); l_reg*=f; if(hi==0)wsf[r32]=f; resc=true; } } \
    SBAR(); \
    GAPB(o[0]=__builtin_amdgcn_mfma_f32_32x32x16_bf16(PAF(0),VFR(0),o[0],0,0,0), C0,0); \
    GAPB(o[1]=__builtin_amdgcn_mfma_f32_32x32x16_bf16(PAF(0),VFR(4),o[1],0,0,0), C0,4); \
    KRD(GL,0); GAPB(o[0]=__builtin_amdgcn_mfma_f32_32x32x16_bf16(PAF(1),VFR(1),o[0],0,0,0), C0,8); \
    KRD(GL,1); GAPB(o[1]=__builtin_amdgcn_mfma_f32_32x32x16_bf16(PAF(1),VFR(5),o[1],0,0,0), C0,12); \
    if constexpr(DQ==64) KRD(GL,2); GAPB(o[0]=__builtin_amdgcn_mfma_f32_32x32x16_bf16(PAF(2),VFR(2),o[0],0,0,0), C1,0); \
    if constexpr(DQ==64) KRD(GL,3); GAPB(o[1]=__builtin_amdgcn_mfma_f32_32x32x16_bf16(PAF(2),VFR(6),o[1],0,0,0), C1,4); \
    GAPB(o[0]=__builtin_amdgcn_mfma_f32_32x32x16_bf16(PAF(3),VFR(3),o[0],0,0,0), C1,8); \
    GAPB(o[1]=__builtin_amdgcn_mfma_f32_32x32x16_bf16(PAF(3),VFR(7),o[1],0,0,0), C1,12); \
    }while(0)
  int t=1;
  #undef CMASK
  #define CMASK(P0,P1,t) do{}while(0)
  for(;t+5<NT;t+=2){
    STEP(pB0,pB1,pA0,pA1,t,true,true,true);     WAIT_BAR(2); RESC(); ROT();
    STEP(pA0,pA1,pB0,pB1,t+1,true,true,true);   WAIT_BAR(2); RESC(); ROT();
  }
  #undef CMASK
  #define CMASK(P0,P1,t) do{}while(0)
  #define ENDW(tt) do{ if((tt)+3<NT){WAIT_BAR(2);} else if((tt)+2<NT){WAIT_BAR(1);} else {WAIT_BAR(0);} }while(0)
  for(;t+1<NT;t+=2){
    STEP(pB0,pB1,pA0,pA1,t,(t+3<NT),(t+1<NT),(t+1<NT));       ENDW(t);   RESC(); ROT();
    STEP(pA0,pA1,pB0,pB1,t+1,(t+4<NT),(t+2<NT),(t+2<NT));     ENDW(t+1); RESC(); ROT();
  }
  STEP(pB0,pB1,pA0,pA1,NT-1,false,false,false); RESC();
  { float sacc=pB0[0]+pB0[1]; _Pragma("unroll") for(int r=2;r<16;++r)sacc+=pB0[r]; _Pragma("unroll") for(int r=0;r<16;++r)sacc+=pB1[r]; l_reg+=sacc;
    pw0=(u32x4){PKW(pB0,0),PKW(pB0,2),PKW(pB0,4),PKW(pB0,6)};pw1=(u32x4){PKW(pB0,8),PKW(pB0,10),PKW(pB0,12),PKW(pB0,14)};pw2=(u32x4){PKW(pB1,0),PKW(pB1,2),PKW(pB1,4),PKW(pB1,6)};pw3=(u32x4){PKW(pB1,8),PKW(pB1,10),PKW(pB1,12),PKW(pB1,14)};
    SBAR(); pv(o,vb0+sl_cur,PAF(0),PAF(1),PAF(2),PAF(3)); }
  #undef PKW
  #undef PAF
  #undef VFR
  #undef PIN
  #undef MX3
  #undef GAPA
  #undef GAPB
  #undef EX
  #undef VRD
  #undef KRD
  #undef STEP
  #undef ENDW
  {auto rr=__builtin_amdgcn_permlane32_swap(__float_as_uint(l_reg),__float_as_uint(l_reg),false,false);l_reg=__uint_as_float(rr[0])+__uint_as_float(rr[1]);}
  if(hi==0)wsf[32+r32]=l_reg;asm volatile("s_waitcnt lgkmcnt(0)":::"memory");
  float rli[16];
  #pragma unroll
  for(int r=0;r<16;++r)rli[r]=__builtin_amdgcn_rcpf(wsf[32+crow(r,hi)]);
  #pragma unroll
  for(int r=0;r<16;++r){o[0][r]*=rli[r];o[1][r]*=rli[r];}
  if constexpr(MODE==0){ bf16*Ow=Ow0+(long)(wid*QBLK)*op; stage_store(o,Ow,op,shm,wid,lane,r32,hi); }
  else { oret[0]=o[0]; oret[1]=o[1]; }
  asm volatile("s_waitcnt lgkmcnt(0)\n\ts_barrier":::"memory");
  #undef DMA_K
  #undef DMA_V
  #undef CMASK
  #undef START
  #undef RESC
  #undef ROT
}
#undef SBAR
#undef WAIT_BAR
}

struct AttnArgs { const bf16_t *QG, *QD, *KG, *VG, *KD, *VD, *CB, *PB; bf16_t* MIX; const float* conv_w; const float* conv_b; const float* subln_g; float lam, lam_init; float* dscr; };

__device__ __forceinline__ void attn_gqa_unit(const AttnArgs& A, LAS char* lds, char* lds_generic, int lat, int seq, int qh, int qb) {
    const long R = lat ? 8192L + (long)SLAT * seq : 256L * seq; const int S = lat ? SLAT : 256;
    const size_t grow0 = (lat ? 8192 + (size_t)4096 * seq : (size_t)256 * seq) + 256 * qb;
    const int kvh = qh >> 2;
    int NT = S / 64; asm volatile("" : "+s"(NT));
    typedef attn64::bf16 abf;
    f32x16 dummy[2];
    attn64::attn_unit<8, 0, 64>((const abf*)(A.QG + grow0 * 512 + 64 * qh), 512, (const abf*)(A.KG + (R * 2 + (long)kvh * S) * 64), 64, (const abf*)(A.VG + (R * 2 + (long)kvh * S) * 64), 64, NT,
                                (abf*)(A.MIX + grow0 * 1024 + 64 * qh), 1024, lds_generic, dummy);
}
__device__ __forceinline__ void attn_diff_unit(const AttnArgs& A, LAS char* lds, char* lds_generic, int lat, int seq, int hd, int qb) {
    const int tid_ = opaque_tid(); const int wave = __builtin_amdgcn_readfirstlane(tid_ >> 6), lane = tid_ & 63, r32 = lane & 31, h = lane >> 5;
    const long R = lat ? 8192L + (long)SLAT * seq : 256L * seq; const int S = lat ? SLAT : 256;
    const size_t grow0 = (lat ? 8192 + (size_t)4096 * seq : (size_t)256 * seq) + 256 * qb;
    int NT = S / 64; asm volatile("" : "+s"(NT));
    typedef attn64::bf16 abf;
    const abf* V = (const abf*)(A.VD + (R * 4 + (long)hd * S) * 64);
    f32x16 oa[2], ob[2];
    attn64::attn_unit<8, 1, 32>((const abf*)(A.QD + grow0 * 256 + 64 * hd), 256, (const abf*)(A.KD + (R * 8 + (long)(hd * 2) * S) * 32), 32, V, 64, NT, (abf*)nullptr, 0, lds_generic, oa);
    GAS float* scr = (GAS float*)A.dscr + ((size_t)(blockIdx.x * 8 + wave) * 32) * 64 + lane;
#pragma unroll
    for (int d0 = 0; d0 < 2; ++d0)
#pragma unroll
        for (int r = 0; r < 16; ++r) scr[(d0 * 16 + r) * 64] = oa[d0][r];
    attn64::attn_unit<8, 1, 32>((const abf*)(A.QD + grow0 * 256 + 64 * hd + 32), 256, (const abf*)(A.KD + (R * 8 + (long)(hd * 2 + 1) * S) * 32), 32, V, 64, NT, (abf*)nullptr, 0, lds_generic, ob);
    float ss[16];
#pragma unroll
    for (int r = 0; r < 16; ++r) {
        const float v0 = scr[r * 64] - A.lam * ob[0][r], v1 = scr[(16 + r) * 64] - A.lam * ob[1][r];
        ob[0][r] = v0; ob[1][r] = v1; ss[r] = v0 * v0 + v1 * v1;
    }
#pragma unroll
    for (int o = 1; o < 32; o <<= 1)
#pragma unroll
        for (int r = 0; r < 16; ++r) ss[r] += __shfl_xor(ss[r], o);
    const float g0 = A.subln_g[r32], g1 = A.subln_g[32 + r32], sc = 1.f - A.lam_init;
#pragma unroll
    for (int r = 0; r < 16; ++r) { const float rstd = rsqrtf(ss[r] * (1.f / 64.f) + EPS) * sc; ob[0][r] *= rstd * g0; ob[1][r] *= rstd * g1; }
    attn64::stage_store(ob, (abf*)(A.MIX + (grow0 + 32 * wave) * 1024 + 768 + 64 * hd), 1024, lds_generic, wave, lane, r32, h);
}

__device__ __forceinline__ void attn_phase(const AttnArgs& A, LAS char* lds, char* lds_generic, int G) {
    for (int u = blockIdx.x; u < 2048; u += G) {
        if (u < 512) { const int b = u & 7, r = u >> 3; attn_diff_unit(A, lds, lds_generic, 1, b, r >> 4, r & 15); }
        else if (u < 1536) { const int v = u - 512, b = v & 7, r = v >> 3; attn_gqa_unit(A, lds, lds_generic, 1, b, r & 7, r >> 3); }
        else { const int v = u - 1536;
            if (v < 128) attn_diff_unit(A, lds, lds_generic, 0, v >> 2, v & 3, 0);
            else if (v < 256) { const int w = 2 * (v - 128); attn_gqa_unit(A, lds, lds_generic, 0, w >> 3, w & 7, 0); }
            else if (v >= 384) { const int w = 2 * (v - 384) + 1; attn_gqa_unit(A, lds, lds_generic, 0, w >> 3, w & 7, 0); } }
    }
    const int tid_c = opaque_tid();
    for (int idx = blockIdx.x * 512 + tid_c; idx < M_ALL * 32; idx += G * 512) {
        const int row = idx >> 5, c8 = (idx & 31) * 8;
        int t, S; if (row < M_CTX) { t = row & 255; S = 256; } else { t = (row - M_CTX) & 4095; S = 4096; }
        const u32x4 z = {0, 0, 0, 0};
        const u32x4 pc = *(const GAS u32x4*)(A.PB + (size_t)row * 256 + c8);
        const u32x4 pp = t > 0 ? *(const GAS u32x4*)(A.PB + (size_t)(row - 1) * 256 + c8) : z;
        const u32x4 pn = t < S - 1 ? *(const GAS u32x4*)(A.PB + (size_t)(row + 1) * 256 + c8) : z;
        const u32x4 cb = *(const GAS u32x4*)(A.CB + (size_t)row * 256 + c8);
        float res[8];
#pragma unroll
        for (int j = 0; j < 8; ++j) {
            const int sh = (j & 1) * 16;
            const float a = __uint_as_float(((pp[j >> 1] >> sh) & 0xffffu) << 16), b = __uint_as_float(((pc[j >> 1] >> sh) & 0xffffu) << 16), c = __uint_as_float(((pn[j >> 1] >> sh) & 0xffffu) << 16);
            const float g = __uint_as_float(((cb[j >> 1] >> sh) & 0xffffu) << 16);
            const int cc = c8 + j;
            res[j] = g * (A.conv_w[cc] * a + A.conv_w[256 + cc] * b + A.conv_w[512 + cc] * c + A.conv_b[cc]);
        }
        u32x4 w; w.x = cvtpk(res[0], res[1]); w.y = cvtpk(res[2], res[3]); w.z = cvtpk(res[4], res[5]); w.w = cvtpk(res[6], res[7]);
        *(GAS u32x4*)(A.MIX + (size_t)row * 1024 + 512 + c8) = w;
    }
}

__device__ __forceinline__ int sigma_map(int type, int i) {
    if (type == 1) return 8 * ((i >> 2) & 3) + 4 * (i >> 4) + (i & 3);
    if (type == 2) return 16 * ((i >> 3) & 1) + 8 * (i >> 4) + (i & 7);
    return i;
}
__device__ __forceinline__ void in_group(int g, int& Lbase, int& type) {
    const int pn = g >> 3, bj = (g >> 2) & 1, wc = g & 3;
    if (pn < 2) { Lbase = 64 * (4 * pn + wc) + 32 * bj; type = 0; }
    else if (pn == 2) { Lbase = (wc < 2 ? 512 + 64 * wc : 640 + 64 * (wc - 2)) + 32 * bj; type = wc < 2 ? 0 : 1; }
    else if (pn == 3) { Lbase = 768 + 128 * bj + 32 * wc; type = 1; }
    else if (pn < 6) { Lbase = 1024 + 256 * bj + 128 * (pn - 4) + 32 * wc; type = 1; }
    else if (pn < 8) { Lbase = (pn == 6 ? 1536 : 1792) + 64 * wc + 32 * bj; type = 2; }
    else { Lbase = 2048 + 64 * wc + 32 * bj; type = 1; }
}
__device__ __forceinline__ void transpose_item(const float* W, int K, int N, bf16_t* WT, int k0, int nphys0, int Lbase, int type, LAS float* scr, int lane) {
#pragma unroll 8
    for (int i = 0; i < 32; ++i) { const int kk = 2 * i + (lane >> 5); scr[kk * 33 + (lane & 31)] = ((const GAS float*)W)[(size_t)(k0 + kk) * N + Lbase + (lane & 31)]; }
    asm volatile("s_waitcnt lgkmcnt(0)" ::: "memory");
    const int c = lane & 7;
#pragma unroll
    for (int j = 0; j < 4; ++j) { const int n = (lane >> 3) + 8 * j; const LAS float* s = scr + (8 * c) * 33 + sigma_map(type, n);
        u32x4 o; o.x = cvtpk(s[0 * 33], s[1 * 33]); o.y = cvtpk(s[2 * 33], s[3 * 33]); o.z = cvtpk(s[4 * 33], s[5 * 33]); o.w = cvtpk(s[6 * 33], s[7 * 33]);
        *(GAS u32x4*)(WT + (size_t)(nphys0 + n) * K + k0 + 8 * c) = o; }
    asm volatile("s_waitcnt lgkmcnt(0)" ::: "memory");
}

struct Params {
    const float *x_prompt, *x_sample, *cache_gk, *cache_gv, *cache_dk, *cache_dv, *c, *c_ctx;
    const float *w_mod, *b_mod, *norm1_g, *w_in, *gqa_qn_g, *gqa_kn_g, *conv_w, *conv_b, *diff_qn_g, *diff_kn_g, *diff_lambda, *diff_subln_g, *w_out, *norm2_g, *ffn_up, *ffn_conv_w, *ffn_conv_b, *ffn_down;
    float* out; unsigned char* ws;
    float lam_init[4];
    int ph_lo, ph_hi;
};

__device__ __forceinline__ void prologue(const Params& P, LAS unsigned char* lds, int G) {
    const int tid = opaque_tid(), lane = tid & 63, wave = __builtin_amdgcn_readfirstlane(tid >> 6);
    float* MODS = (float*)(P.ws + WS_MODS); float* MISC = (float*)(P.ws + WS_MISC);
    if ((int)blockIdx.x < 384) {
        LAS float* sc = (LAS float*)lds;
        LAS float* part = (LAS float*)(lds + 49152);
        for (int i = tid; i < NCOND * 1024; i += 512) { const int ci = i >> 10, k = i & 1023; const float v = ci == 0 ? P.c_ctx[k] : P.c[(ci - 1) * 1024 + k]; sc[k * 12 + ci] = v / (1.f + __expf(-v)); }
        __syncthreads();
        for (int it = blockIdx.x; it < 384; it += G) {
            const int l = it / 96, col = (it % 96) * 64 + lane;
            const float* w = P.w_mod + (size_t)l * 1024 * 6144 + col;
            float acc[NCOND];
#pragma unroll
            for (int ci = 0; ci < NCOND; ++ci) acc[ci] = 0.f;
#pragma unroll 8
            for (int kk = 0; kk < 128; ++kk) { const int k = wave * 128 + kk; const float wv = ((const GAS float*)w)[(size_t)k * 6144];
                const f32x4 s0 = *(LAS f32x4*)(sc + k * 12), s1 = *(LAS f32x4*)(sc + k * 12 + 4); const float s8 = sc[k * 12 + 8];
                acc[0] += s0[0] * wv; acc[1] += s0[1] * wv; acc[2] += s0[2] * wv; acc[3] += s0[3] * wv; acc[4] += s1[0] * wv; acc[5] += s1[1] * wv; acc[6] += s1[2] * wv; acc[7] += s1[3] * wv; acc[8] += s8 * wv; }
#pragma unroll
            for (int ci = 0; ci < NCOND; ++ci) part[(wave * NCOND + ci) * 64 + lane] = acc[ci];
            __syncthreads();
            for (int i = tid; i < NCOND * 64; i += 512) { const int ci = i >> 6, cc = i & 63; float s = 0.f;
#pragma unroll
                for (int w8 = 0; w8 < 8; ++w8) s += part[(w8 * NCOND + ci) * 64 + cc];
                const int j = (it % 96) * 64 + cc; MODS[((size_t)l * NCOND + ci) * 6144 + j] = s + P.b_mod[l * 6144 + j]; }
            __syncthreads();
        }
    }
    if ((int)blockIdx.x == G - 1) {
        if (tid < 4) { const float* lf = P.diff_lambda + tid * 128; float s1 = 0.f, s2 = 0.f; for (int i = 0; i < 32; ++i) { s1 += lf[i] * lf[32 + i]; s2 += lf[64 + i] * lf[96 + i]; }
            MISC[MI_LAM + tid] = expf(s1) - expf(s2) + P.lam_init[tid]; }
        for (int i = tid; i < 1024; i += 512) { const int pos = i >> 4, idx = i & 15; const float fr = powf(10000.f, -(float)idx / 16.f); const float ang = (float)pos * fr; MISC[MI_R64C + i] = cosf(ang); MISC[MI_R64S + i] = sinf(ang); }
        for (int i = tid; i < 512; i += 512) { const int pos = i >> 3, idx = i & 7; const float fr = powf(10000.f, -(float)idx / 8.f); const float ang = (float)pos * fr; MISC[MI_R32C + i] = cosf(ang); MISC[MI_R32S + i] = sinf(ang); }
    }
    __syncthreads();
    LAS float* scr = (LAS float*)(lds + wave * 16384);
    const int gw = blockIdx.x * 8 + wave, NGW = G * 8;
    constexpr int I_IN = 16 * 72, I_OUT = 16 * 32, I_UP = 16 * 176, I_DN = 44 * 32, I_L = I_IN + I_OUT + I_UP + I_DN;
    for (int it = gw; it < DEPTH * I_L; it += NGW) {
        const int l = it / I_L; int r = it % I_L;
        if (r < I_IN) { const int kb = r / 72, g = r % 72; int Lb, ty; in_group(g, Lb, ty);
            transpose_item(P.w_in + (size_t)l * 1024 * INW, 1024, INW, (bf16_t*)(P.ws + WS_WIN) + (size_t)l * INW * 1024, kb * 64, g * 32, Lb, ty, scr, lane); continue; }
        r -= I_IN;
        if (r < I_OUT) { const int kb = r / 32, g = r % 32;
            transpose_item(P.w_out + (size_t)l * 1024 * 1024, 1024, 1024, (bf16_t*)(P.ws + WS_WOUT) + (size_t)l * 1024 * 1024, kb * 64, g * 32, g * 32, 0, scr, lane); continue; }
        r -= I_OUT;
        if (r < I_UP) { const int kb = r / 176, g = r % 176; const int pn = g >> 3, bj = (g >> 2) & 1, wc = g & 3;
            transpose_item(P.ffn_up + (size_t)l * 1024 * UPW, 1024, UPW, (bf16_t*)(P.ws + WS_WUP) + (size_t)l * UPW * 1024, kb * 64, g * 32, bj * DFF + 128 * pn + 32 * wc, 1, scr, lane); continue; }
        r -= I_UP;
        { const int kb = r / 32, g = r % 32;
            transpose_item(P.ffn_down + (size_t)l * DFF * 1024, DFF, 1024, (bf16_t*)(P.ws + WS_WDN) + (size_t)l * 1024 * DFF, kb * 64, g * 32, g * 32, 0, scr, lane); }
    }
}

__device__ __forceinline__ void norm_phase(const float* xin_ctx, const float* xin_lat, const bf16_t* xin_b  , const float* ng, const float* mods_l  , int sh_idx, bf16_t* XN, int G) {
    const int tid_ = opaque_tid(); const int lane = tid_ & 63, wave = __builtin_amdgcn_readfirstlane(tid_ >> 6);
    const int nw = G * 8, gw = blockIdx.x * 8 + wave;
    const int per = (M_ALL + nw - 1) / nw;
    const int r0 = gw * per, r1 = min(r0 + per, M_ALL);
    int cur_ci = -1; f32x4 Aa[4], Bb[4];
    f32x4 v[4], vn[4];
#define NORM_LOAD_ROW(R_) do { const int rr_ = (R_); \
        if (xin_b) { _Pragma("unroll") for (int j = 0; j < 4; ++j) { const u32x2 q_ = *(const GAS u32x2*)(xin_b + (size_t)rr_ * DM + 4 * lane + 256 * j); \
                vn[j] = (f32x4){__uint_as_float(q_.x << 16), __uint_as_float(q_.x & 0xffff0000u), __uint_as_float(q_.y << 16), __uint_as_float(q_.y & 0xffff0000u)}; } } \
        else { const float* xr_ = rr_ < M_CTX ? xin_ctx + (size_t)rr_ * DM : xin_lat + (size_t)(rr_ - M_CTX) * DM; \
            _Pragma("unroll") for (int j = 0; j < 4; ++j) vn[j] = *(const GAS f32x4*)(xr_ + 4 * lane + 256 * j); } } while (0)
    if (r0 < r1) NORM_LOAD_ROW(r0);
    for (int row = r0; row < r1; ++row) {
#pragma unroll
        for (int j = 0; j < 4; ++j) v[j] = vn[j];
        if (row + 1 < r1) NORM_LOAD_ROW(row + 1);
        const int ci = row < M_CTX ? 0 : 1 + ((row - M_CTX) >> 12);
        if (ci != cur_ci) { cur_ci = ci; const float* sh = mods_l + ci * 6144 + sh_idx * 1024; const float* sc = sh + 1024;
#pragma unroll
            for (int j = 0; j < 4; ++j) { const int c = 4 * lane + 256 * j; const f32x4 g4 = *(const GAS f32x4*)(ng + c), s4 = *(const GAS f32x4*)(sc + c); Aa[j] = g4 * (1.f + s4); Bb[j] = *(const GAS f32x4*)(sh + c); } }
        float s = 0.f;
#pragma unroll
        for (int j = 0; j < 4; ++j) s += (v[j][0] * v[j][0] + v[j][1] * v[j][1]) + (v[j][2] * v[j][2] + v[j][3] * v[j][3]);
#pragma unroll
        for (int o = 1; o < 64; o <<= 1) s += __shfl_xor(s, o);
        const float rstd = rsqrtf(s * (1.f / DM) + EPS);
#pragma unroll
        for (int j = 0; j < 4; ++j) { const f32x4 y = v[j] * rstd * Aa[j] + Bb[j]; u32x2 w; w.x = cvtpk(y[0], y[1]); w.y = cvtpk(y[2], y[3]); *(GAS u32x2*)(XN + (size_t)row * DM + 4 * lane + 256 * j) = w; }
    }
#undef NORM_LOAD_ROW
}

__device__ __forceinline__ void cache_phase(const Params& P, int l, int G) {
    bf16_t* KG = (bf16_t*)(P.ws + WS_KG); bf16_t* VG = (bf16_t*)(P.ws + WS_VG); bf16_t* KD = (bf16_t*)(P.ws + WS_KD); bf16_t* VD = (bf16_t*)(P.ws + WS_VD);
    const int tid_ = opaque_tid();
    for (int i = blockIdx.x * 512 + tid_; i < 65536; i += G * 512) {
        const int d4 = (i & 15) * 4, kvh = (i >> 4) & 1, p = (i >> 5) & 255, b = i >> 13;
        const size_t src = ((((size_t)b * 4 + l) * 256 + p) * 2 + kvh) * 64 + d4;
        const size_t dst = (((8192L + (long)SLAT * b) * 2 + (long)kvh * SLAT + 4096 + p) * 64);
        const int pk4 = (d4 & 32) | ((d4 & 12) << 1) | ((d4 & 16) >> 2);
        const f32x4 k = *(const GAS f32x4*)(P.cache_gk + src), v = *(const GAS f32x4*)(P.cache_gv + src);
        u32x2 wk, wv; wk.x = cvtpk(k[0], k[1]); wk.y = cvtpk(k[2], k[3]); wv.x = cvtpk(v[0], v[1]); wv.y = cvtpk(v[2], v[3]);
        *(GAS u32x2*)(KG + dst + pk4) = wk; *(GAS u32x2*)(VG + dst + d4) = wv;
    }
    for (int i = blockIdx.x * 512 + tid_; i < 131072; i += G * 512) {
        { const int d4 = (i & 7) * 4, hc = (i >> 3) & 7, p = (i >> 6) & 255, b = i >> 14;
          const size_t src = ((((size_t)b * 4 + l) * 256 + p) * 8 + hc) * 32 + d4;
          const size_t dst = (((8192L + (long)SLAT * b) * 8 + (long)hc * SLAT + 4096 + p) * 32) + ((d4 & 16) | ((d4 & 4) << 1) | ((d4 & 8) >> 1));
          const f32x4 k = *(const GAS f32x4*)(P.cache_dk + src); u32x2 w; w.x = cvtpk(k[0], k[1]); w.y = cvtpk(k[2], k[3]); *(GAS u32x2*)(KD + dst) = w; }
        { const int d4 = (i & 15) * 4, hh = (i >> 4) & 3, p = (i >> 6) & 255, b = i >> 14;
          const size_t src = ((((size_t)b * 4 + l) * 256 + p) * 4 + hh) * 64 + d4;
          const size_t dst = (((8192L + (long)SLAT * b) * 4 + (long)hh * SLAT + 4096 + p) * 64) + d4;
          const f32x4 v = *(const GAS f32x4*)(P.cache_dv + src); u32x2 w; w.x = cvtpk(v[0], v[1]); w.y = cvtpk(v[2], v[3]); *(GAS u32x2*)(VD + dst) = w; }
    }
}

__device__ __forceinline__ void fixup_own_panels(const pg8::StaticOrder& S, const float* cw, bf16_t* F, const float* EP, const float* EA, const float* EU) {
    const int tid_ = opaque_tid();
    pg8::Unit u;
    for (int i = 0; S.next(i, u); ++i) {
        const int pm = u.pm; if (pm < 32) continue;
        const int j = (pm - 32) & 15;
        for (int e = 0; e < 2; ++e) {
            if (e == 0 ? j == 0 : j == 15) continue;
            const size_t eb = ((size_t)pm * 2 + e) * DFF, nb = e == 0 ? ((size_t)(pm - 1) * 2 + 1) * DFF : ((size_t)(pm + 1) * 2 + 0) * DFF;
            const float* w = cw + (e == 0 ? 0 : 2 * DFF);
            const size_t row = (size_t)pm * 256 + (e ? 255 : 0);
            for (int c = tid_ * 2; c < DFF; c += 1024) {
                const f32x2 p = *(const GAS f32x2*)(EP + eb + c), a = *(const GAS f32x2*)(EA + nb + c), uu = *(const GAS f32x2*)(EU + eb + c), ww = *(const GAS f32x2*)(w + c);
                const float f0 = silu_f(p[0] + ww[0] * a[0]) * uu[0], f1 = silu_f(p[1] + ww[1] * a[1]) * uu[1];
                *(GAS unsigned*)(F + row * DFF + c) = cvtpk(f0, f1);
            }
        }
    }
    asm volatile("s_waitcnt vmcnt(0)" ::: "memory");
    __syncthreads();
}
__device__ __forceinline__ void fixup_phase(const float* cw, bf16_t* F, const float* EP, const float* EA, const float* EU, int G) {
    const int tid_ = opaque_tid();
    for (int i = blockIdx.x * 512 + tid_; i < 128 * 2 * DFF; i += G * 512) {
        const int c = i % DFF, e = (i / DFF) & 1, pm = 32 + i / (2 * DFF); const int j = (pm - 32) & 15;
        if (e == 0 ? j == 0 : j == 15) continue;
        const size_t eo = ((size_t)pm * 2 + e) * DFF + c;
        float conv;
        if (e == 0) conv = EP[eo] + cw[c] * EA[((size_t)(pm - 1) * 2 + 1) * DFF + c];
        else conv = EP[eo] + cw[2 * DFF + c] * EA[((size_t)(pm + 1) * 2 + 0) * DFF + c];
        const float f = silu_f(conv) * EU[eo];
        const size_t row = (size_t)pm * 256 + (e ? 255 : 0);
        F[row * DFF + c] = (bf16_t)(cvtpk(f, 0.f) & 0xffffu);
    }
}


#define XB_TMO      128
#define XB_XCNT(j)  (256  + 64 * (j))
#define XB_XSUB(j)  (1280 + 64 * (j))
#define XB_XGEN(j)  (2304 + 64 * (j))
#define XB_TOP      3328
#define XB_TOPGEN   3392
#define XCD_BAR_WORDS 3456
#define XB_SPIN_CAP (1u << 22)
__device__ __forceinline__ unsigned xb_ld(unsigned* p)              { return __hip_atomic_load(p, __ATOMIC_RELAXED, __HIP_MEMORY_SCOPE_AGENT); }
__device__ __forceinline__ unsigned xb_add(unsigned* p, unsigned v) { return __hip_atomic_fetch_add(p, v, __ATOMIC_RELAXED, __HIP_MEMORY_SCOPE_AGENT); }
__device__ __forceinline__ unsigned xb_xcc_id() { return (unsigned)__builtin_amdgcn_s_getreg((3 << 11) | 20) & 0xFu; }
#define XB_SPIN(cond, bar) do { unsigned _sp = 0; while (cond) { __builtin_amdgcn_s_sleep(1); \
    if ((++_sp & 255u) == 0u) { if (xb_ld(&(bar)[XB_TMO])) break; if (_sp > XB_SPIN_CAP) { atomicAdd(&(bar)[XB_TMO], 1u); break; } } } } while (0)
struct XcdBarrier { unsigned* bar; unsigned x; volatile LAS unsigned* st; };
__device__ __forceinline__ XcdBarrier xcd_barrier_post(unsigned* bar, volatile LAS unsigned* st) {
    XcdBarrier b; b.bar = bar; b.x = xb_xcc_id(); b.st = st;
    if (threadIdx.x == 0) (void)xb_add(&bar[XB_XCNT(b.x)], 1u);
    return b;
}
__device__ __forceinline__ void xcd_barrier_complete(unsigned* bar, unsigned x, unsigned& nloc, unsigned& nx) {
    const unsigned G = gridDim.x * gridDim.y * gridDim.z;
    unsigned sum, cnt, mine, sp = 0u;
    for (;;) {
        sum = 0u; cnt = 0u; mine = 0u;
#pragma unroll
        for (unsigned j = 0; j < 16; ++j) { const unsigned c = xb_ld(&bar[XB_XCNT(j)]); sum += c; cnt += (c > 0u) ? 1u : 0u; mine = (j == x) ? c : mine; }
        if (sum == G) break;
        __builtin_amdgcn_s_sleep(1);
        if ((++sp & 255u) == 0u) { if (xb_ld(&bar[XB_TMO])) break; if (sp > XB_SPIN_CAP) { atomicAdd(&bar[XB_TMO], 1u); break; } }
    }
    nloc = mine > 0u ? mine : 1u; nx = cnt > 0u ? cnt : 1u;
}
__device__ __forceinline__ void xcd_barrier(const XcdBarrier& b) {
    asm volatile("s_waitcnt vmcnt(0)" ::: "memory");
    __syncthreads();
    if (threadIdx.x == 0) {
        unsigned* bar = b.bar;
        __builtin_amdgcn_s_waitcnt(0);
        unsigned nloc = b.st[0], nx = b.st[1];
        if (nloc == 0u) { xcd_barrier_complete(bar, b.x, nloc, nx); b.st[0] = nloc; b.st[1] = nx; }
        const unsigned old = xb_add(&bar[XB_XSUB(b.x)], 1u);
        const unsigned gen = old / nloc;
        if (old + 1u == (gen + 1u) * nloc) {
            __builtin_amdgcn_fence(__ATOMIC_RELEASE, "agent");
            asm volatile("s_waitcnt vmcnt(0)" ::: "memory");
            const unsigned og = xb_add(&bar[XB_TOP], 1u);
            const unsigned tg = og / nx;
            if (og + 1u == (tg + 1u) * nx) xb_add(&bar[XB_TOPGEN], 1u);
            else XB_SPIN(xb_ld(&bar[XB_TOPGEN]) == tg, bar);
            __builtin_amdgcn_fence(__ATOMIC_ACQUIRE, "agent");
            xb_add(&bar[XB_XGEN(b.x)], 1u);
            asm volatile("s_waitcnt vmcnt(0)" ::: "memory");
        } else {
            XB_SPIN(xb_ld(&bar[XB_XGEN(b.x)]) == gen, bar);
            __builtin_amdgcn_fence(__ATOMIC_ACQUIRE, "agent");
            asm volatile("s_waitcnt vmcnt(0)" ::: "memory");
        }
    }
    __syncthreads();
}

__global__ void __launch_bounds__(512, 2) fwd_kernel(Params P) {
    extern __shared__ __attribute__((aligned(16))) unsigned char lds_raw[];
    LAS unsigned char* lds = (LAS unsigned char*)lds_raw;
    cg::grid_group grid = cg::this_grid();
    const int G = gridDim.x;
    volatile LAS unsigned* bst = (volatile LAS unsigned*)(lds + MISC_OFF);
    if (threadIdx.x < 2) bst[threadIdx.x] = 0u;
    __syncthreads();
    XcdBarrier bar = xcd_barrier_post((unsigned*)(P.ws + WS_CTL), bst);
    int ph = 0;
#define PHASE_BEGIN if (ph >= P.ph_lo && ph < P.ph_hi) { unsigned char* ws = P.ws; float* outp = P.out; asm volatile("" : "+s"(ws), "+s"(outp));
#define PHASE_END   if (ph + 1 < P.ph_hi) { if (ph == 0) grid.sync(); else xcd_barrier(bar); } } ++ph;
    PHASE_BEGIN
#ifndef SKIP_PRO
        prologue(P, lds, G);
#endif
    PHASE_END
    for (int l = 0; l < DEPTH; ++l) {
        PHASE_BEGIN
            const float* xin_ctx = l == 0 ? P.x_prompt : outp; const float* xin_lat = l == 0 ? P.x_sample : outp + (size_t)M_CTX * DM;
            norm_phase(P.x_prompt, P.x_sample, l == 0 ? (const bf16_t*)nullptr : (const bf16_t*)(ws + WS_XB), P.norm1_g + l * DM, (const float*)(ws + WS_MODS) + (size_t)l * NCOND * 6144, 0, (bf16_t*)(ws + WS_XN), G);
            cache_phase(P, l, G);
        PHASE_END
        PHASE_BEGIN {
            const float* MISC = (const float*)(ws + WS_MISC);
            pg8::Gemm g{(const bf16_t*)(ws + WS_XN), (const bf16_t*)(ws + WS_WIN) + (size_t)l * INW * 1024, M_ALL, INW, 1024}; pg8::StaticOrder S; S.init(M_ALL, INW, G, blockIdx.x);
            EpiIn E{l, P.gqa_qn_g + l * 64, P.gqa_kn_g + l * 64, P.diff_qn_g + l * 32, P.diff_kn_g + l * 32, MISC + MI_R64C, MISC + MI_R64S, MISC + MI_R32C, MISC + MI_R32S,
                    (bf16_t*)(ws + WS_QG), (bf16_t*)(ws + WS_QD), (bf16_t*)(ws + WS_KG), (bf16_t*)(ws + WS_VG), (bf16_t*)(ws + WS_KD), (bf16_t*)(ws + WS_VD), (bf16_t*)(ws + WS_CB), (bf16_t*)(ws + WS_PB), outp};
#ifndef SKIP_IN
            pg8::gemm_phase(lds, lds + XCH_OFF, g, S, E);
#endif
        } PHASE_END
        PHASE_BEGIN {
            const float* MISC = (const float*)(ws + WS_MISC);
            AttnArgs A{(const bf16_t*)(ws + WS_QG), (const bf16_t*)(ws + WS_QD), (const bf16_t*)(ws + WS_KG), (const bf16_t*)(ws + WS_VG), (const bf16_t*)(ws + WS_KD), (const bf16_t*)(ws + WS_VD),
                       (const bf16_t*)(ws + WS_CB), (const bf16_t*)(ws + WS_PB), (bf16_t*)(ws + WS_XN), P.conv_w + l * 768, P.conv_b + l * 256, P.diff_subln_g + l * 64, MISC[MI_LAM + l], P.lam_init[l], (float*)(ws + WS_DSCR)};
#ifndef SKIP_ATT
            attn_phase(A, (LAS char*)lds, (char*)lds_raw, G);
#endif
        } PHASE_END
        PHASE_BEGIN {
            const float* xin_ctx = l == 0 ? P.x_prompt : outp; const float* xin_lat = l == 0 ? P.x_sample : outp + (size_t)M_CTX * DM;
            pg8::Gemm g{(const bf16_t*)(ws + WS_XN), (const bf16_t*)(ws + WS_WOUT) + (size_t)l * 1024 * 1024, M_ALL, 1024, 1024}; pg8::StaticOrder S; S.init(M_ALL, 1024, G, blockIdx.x);
            EpiRes E{P.x_prompt, P.x_sample, outp, (const float*)(ws + WS_MODS) + (size_t)l * NCOND * 6144 + 2 * 1024, l == 0 ? (const bf16_t*)nullptr : (const bf16_t*)(ws + WS_XB), (bf16_t*)(ws + WS_XB)};
#ifndef SKIP_RES
            pg8::gemm_phase(lds, lds + XCH_OFF, g, S, E);
#endif
        } PHASE_END
        PHASE_BEGIN
            norm_phase(nullptr, nullptr, (const bf16_t*)(ws + WS_XB), P.norm2_g + l * DM, (const float*)(ws + WS_MODS) + (size_t)l * NCOND * 6144, 3, (bf16_t*)(ws + WS_XN), G);
        PHASE_END
        PHASE_BEGIN {
            float* EPb = (float*)(ws + WS_EDGE);
            pg8::Gemm g{(const bf16_t*)(ws + WS_XN), (const bf16_t*)(ws + WS_WUP) + (size_t)l * UPW * 1024, M_ALL, UPW, 1024}; pg8::StaticOrder S; S.init(M_ALL, UPW, G, blockIdx.x);
            EpiUp E{P.ffn_conv_w + (size_t)l * 3 * DFF, P.ffn_conv_b + (size_t)l * DFF, (bf16_t*)(ws + WS_U), EPb, EPb + EDGE_ELEMS, EPb + 2 * EDGE_ELEMS};
#ifndef SKIP_UP
            pg8::gemm_phase(lds, lds + XCH_OFF, g, S, E);
#endif
        } PHASE_END
        PHASE_BEGIN {
            pg8::Gemm g{(const bf16_t*)(ws + WS_U), (const bf16_t*)(ws + WS_WDN) + (size_t)l * 1024 * DFF, M_ALL, 1024, DFF}; pg8::StaticOrder S; S.init(M_ALL, 1024, G, blockIdx.x);
            { float* EPb = (float*)(ws + WS_EDGE); fixup_own_panels(S, P.ffn_conv_w + (size_t)l * 3 * DFF, (bf16_t*)(ws + WS_U), EPb, EPb + EDGE_ELEMS, EPb + 2 * EDGE_ELEMS); }
            EpiRes E{nullptr, nullptr, outp, (const float*)(ws + WS_MODS) + (size_t)l * NCOND * 6144 + 5 * 1024, (const bf16_t*)(ws + WS_XB), l + 1 < DEPTH ? (bf16_t*)(ws + WS_XB) : (bf16_t*)nullptr};
#ifndef SKIP_RES
            pg8::gemm_phase(lds, lds + XCH_OFF, g, S, E);
#endif
        } PHASE_END
    }
}

constexpr int N_PHASES = 1 + DEPTH * 7;
#ifndef N_LAUNCH_SPLIT
#define N_LAUNCH_SPLIT 0
#endif

extern "C" void kernel_launch(void* const* d_in, const int* in_sizes, int n_in, void* d_out, int out_size, void* d_ws, size_t ws_size, hipStream_t stream) {
    static int grid = 0;
    if (grid == 0) {
        if (n_in != 26 || ws_size < WS_END) { fprintf(stderr, "kernel_launch: unexpected n_in %d or ws_size %zu (< %zu)\n", n_in, ws_size, (size_t)WS_END); grid = -1; return; }
        int dev = 0, cus = 0, per_cu = 0;
        hipGetDevice(&dev); hipDeviceGetAttribute(&cus, hipDeviceAttributeMultiprocessorCount, dev);
        hipFuncSetAttribute((const void*)fwd_kernel, hipFuncAttributeMaxDynamicSharedMemorySize, LDS_BYTES);
        hipOccupancyMaxActiveBlocksPerMultiprocessor(&per_cu, (const void*)fwd_kernel, 512, LDS_BYTES);
        if (per_cu < 1) { fprintf(stderr, "kernel_launch: occupancy query gives %d\n", per_cu); per_cu = 1; }
        (void)hipGetLastError();
        grid = cus * 1;
    }
    if (grid < 0) return;
    Params p{};
    const float** pp = (const float**)&p;
    for (int i = 0; i < 26; ++i) pp[i] = (const float*)d_in[i];
    p.out = (float*)d_out; p.ws = (unsigned char*)d_ws;
    for (int l = 0; l < 4; ++l) p.lam_init[l] = (float)(0.8 - 0.6 * exp(-0.3 * (double)l));
#if N_LAUNCH_SPLIT
    for (int ph = 0; ph < N_PHASES; ++ph) { p.ph_lo = ph; p.ph_hi = ph + 1; hipLaunchKernelGGL(fwd_kernel, dim3(grid), dim3(512), LDS_BYTES, stream, p); }
#else
    p.ph_lo = 0; p.ph_hi = N_PHASES;
    if (hipMemsetAsync((char*)d_ws + WS_CTL, 0, CTL_ZERO_BYTES, stream) != hipSuccess) { fprintf(stderr, "kernel_launch: memset failed\n"); return; }
    void* args[] = {&p};
    hipError_t e = hipLaunchCooperativeKernel((const void*)fwd_kernel, dim3(grid), dim3(512), args, LDS_BYTES, stream);
    if (e != hipSuccess) fprintf(stderr, "cooperative launch failed: %s (grid %d)\n", hipGetErrorString(e), grid);
#endif
}
```

```cpp
#include <hip/hip_runtime.h>
#include <hip/hip_cooperative_groups.h>
#include <cstdio>
#include <cstdint>
#include <cmath>
namespace cg = cooperative_groups;

#define LAS __attribute__((address_space(3)))
#define GAS __attribute__((address_space(1)))
typedef unsigned short bf16_t;
typedef short bf16x8 __attribute__((ext_vector_type(8)));
typedef short s16x4 __attribute__((ext_vector_type(4)));
typedef float f32x4 __attribute__((ext_vector_type(4)));
typedef float f32x16 __attribute__((ext_vector_type(16)));
typedef unsigned u32x4 __attribute__((ext_vector_type(4)));
typedef unsigned u32x2 __attribute__((ext_vector_type(2)));
typedef float f32x2 __attribute__((ext_vector_type(2)));
typedef __bf16 bf16x2_t __attribute__((ext_vector_type(2)));

__device__ __forceinline__ unsigned cvtpk(float lo, float hi) { f32x2 v = {lo, hi}; bf16x2_t b = __builtin_convertvector(v, bf16x2_t); return __builtin_bit_cast(unsigned, b); }
__device__ __forceinline__ int opaque_tid() { int t = threadIdx.x; asm volatile("" : "+v"(t)); return t; }
__device__ __forceinline__ float bf2f(unsigned short u) { return __uint_as_float(((unsigned)u) << 16); }

constexpr int DM = 1024, DEPTH = 4, NCOND = 9;
constexpr int M_CTX = 8192, M_ALL = 40960, NTM = 160;
constexpr int INW = 2304, DFF = 2816, UPW = 5632;
constexpr int SLAT = 4352;
constexpr float EPS = 1e-6f;
constexpr float LOG2E = 1.4426950408889634f;
constexpr float QSCALE_G = 0.125f * LOG2E;
constexpr float QSCALE_D = 0.17677669529663687f * LOG2E;
constexpr size_t OUT_GK = 41943040, OUT_GV = OUT_GK + 4194304, OUT_DK = OUT_GV + 4194304, OUT_DV = OUT_DK + 8388608;
constexpr size_t MiB = 1u << 20;
constexpr size_t WS_MODS = 1 * MiB;
constexpr size_t WS_MISC = 2 * MiB;
constexpr size_t WS_EDGE = 3 * MiB;
constexpr size_t EDGE_ELEMS = (size_t)NTM * 2 * DFF;
constexpr size_t WS_WIN = 16 * MiB;
constexpr size_t WS_WOUT = 34 * MiB;
constexpr size_t WS_WUP = 42 * MiB;
constexpr size_t WS_WDN = 86 * MiB;
constexpr size_t WS_XN = 108 * MiB;
constexpr size_t WS_U = 188 * MiB;
constexpr size_t WS_QG = WS_U, WS_QD = WS_QG + (size_t)M_ALL * 512 * 2, WS_KG = WS_QD + (size_t)M_ALL * 256 * 2;
constexpr size_t KROWS = 8192 + 8 * SLAT;
constexpr size_t WS_VG = WS_KG + KROWS * 128 * 2, WS_KD = WS_VG + KROWS * 128 * 2, WS_VD = WS_KD + KROWS * 256 * 2;
constexpr size_t WS_CB = WS_VD + KROWS * 256 * 2, WS_PB = WS_CB + (size_t)M_ALL * 256 * 2, WS_UEND = WS_PB + (size_t)M_ALL * 256 * 2;
constexpr size_t WS_DSCR = WS_U + (size_t)M_ALL * DFF * 2;
constexpr size_t WS_XB = WS_DSCR + 16 * MiB;
constexpr size_t WS_END = WS_XB + (size_t)M_ALL * DM * 2;
static_assert(WS_UEND <= WS_DSCR, "union");
constexpr int MI_LAM = 0, MI_R64C = 64, MI_R64S = MI_R64C + 1024, MI_R32C = MI_R64S + 1024, MI_R32S = MI_R32C + 512;

constexpr int RING_BYTES = 131072, XCH_OFF = RING_BYTES, MISC_OFF = RING_BYTES + 4096, LDS_BYTES = RING_BYTES + 4096 + 256;
constexpr size_t WS_CTL = 0, CTL_ZERO_BYTES = 65536;

struct TileInfo {
    int lat, seq, t0, ci, S; long R;
    __device__ __forceinline__ TileInfo(int pm) {
        if (pm < 32) { lat = 0; seq = pm; t0 = 0; ci = 0; S = 256; R = 256L * pm; }
        else { const int b = (pm - 32) >> 4; lat = 1; seq = b; t0 = ((pm - 32) & 15) * 256; ci = 1 + b; S = SLAT; R = 8192L + (long)SLAT * b; }
    }
};

namespace pg8 {
constexpr int BM = 256, BK = 64, HALF = 128, HTB = HALF * BK * 2, NXCD = 8, WGM = 8;
__host__ __device__ __forceinline__ int lds_byte(int r, int c) { const int st = (r >> 4) * 2 + (c >> 5), rr = r & 15, cc = c & 31, ob = rr * 64 + cc * 2; return st * 1024 + (ob ^ (((ob >> 9) & 1) << 5)); }
__host__ __device__ __forceinline__ void stage_rc(int b, int& R, int& C) { const int st = b / 1024, sb = b % 1024, swz = sb ^ (((sb >> 9) & 1) << 5); R = (st >> 1) * 16 + swz / 64; C = (st & 1) * 32 + (swz % 64) / 2; }
struct Unit { int pm, pn; };
struct Gemm { const bf16_t* A; const bf16_t* Bt; int M, N, K; };
struct StaticOrder {
    int nM, nN, nwg, G, c;
    __device__ void init(int M, int N, int G_, int c_) { nM = M / BM; nN = N / BM; nwg = nM * nN; G = G_; c = c_; }
    __device__ bool next(int i, Unit& u) const {
        const long L = (long)i * G + c; if (L >= nwg) return false;
        int wgid = (int)L; { const int q = nwg / NXCD, r = nwg % NXCD, xcd = wgid % NXCD, off = wgid / NXCD; wgid = (xcd < r ? xcd * (q + 1) : r * (q + 1) + (xcd - r) * q) + off; }
        const int nig = WGM * nN, gid = wgid / nig, fm = gid * WGM, gsz = (nM - fm) < WGM ? (nM - fm) : WGM;
        u.pm = fm + ((wgid % nig) % gsz); u.pn = (wgid % nig) / gsz; return true;
    }
};
template <class Epi>
__device__ __forceinline__ void gemm_phase(LAS unsigned char* lds, LAS unsigned char* xlds, const Gemm g, const StaticOrder& S, const Epi& E) {
    const int tid = opaque_tid(), wid = __builtin_amdgcn_readfirstlane(tid >> 6), lane = tid & 63, wr = wid >> 2, wc = wid & 3, fr = lane & 15, fq = lane >> 4;
    const int K = g.K, nt = K / BK;
    unsigned voffA[2];
#pragma unroll
    for (int i = 0; i < 2; ++i) { int R, C; stage_rc(tid * 16 + i * 8192, R, C); voffA[i] = (unsigned)(R * K + C) * 2u; }
    const size_t kstep = (size_t)(BK * 2);
    const size_t hstep = (size_t)HALF * K * 2;
    const size_t tstep = 2 * hstep;
    const unsigned ldsw = (unsigned)wid * 1024u;
    const int aoff = lds_byte(wr * 64 + fr, fq * 8), boff = lds_byte(wc * 32 + fr, fq * 8);
#define PG8_SA(b, h) (((b) * 2 + (h)) * HTB)
#define PG8_SB(b, h) ((4 + (b) * 2 + (h)) * HTB)
#define PG8_STAGE(bufoff, gbase) do { _Pragma("unroll") for (int _i = 0; _i < 2; ++_i) \
        __builtin_amdgcn_global_load_lds((const unsigned*)((const char*)(gbase) + voffA[_i]), (LAS unsigned*)(lds + (bufoff) + ldsw + _i * 8192), 16, 0, 0); } while (0)
#define PG8_LDA(dst, b, h) do { _Pragma("unroll") for (int m = 0; m < 4; ++m) _Pragma("unroll") for (int k = 0; k < 2; ++k) dst[m][k] = *(const LAS bf16x8*)(lds + PG8_SA(b, h) + aoff + m * 2048 + k * 1024); } while (0)
#define PG8_LDB(dst, b, h) do { _Pragma("unroll") for (int n = 0; n < 2; ++n) _Pragma("unroll") for (int k = 0; k < 2; ++k) dst[n][k] = *(const LAS bf16x8*)(lds + PG8_SB(b, h) + boff + n * 2048 + k * 1024); } while (0)
#define PG8_MMA(ai, bj, At, Bt) do { __builtin_amdgcn_s_setprio(1); _Pragma("unroll") for (int m = 0; m < 4; ++m) _Pragma("unroll") for (int n = 0; n < 2; ++n) _Pragma("unroll") for (int k = 0; k < 2; ++k) \
        acc[ai][bj][m][n] = __builtin_amdgcn_mfma_f32_16x16x32_bf16(Bt[n][k], At[m][k], acc[ai][bj][m][n], 0, 0, 0); __builtin_amdgcn_s_setprio(0); } while (0)
#define PG8_WAIT_V(n) asm volatile("s_waitcnt vmcnt(" #n ")" ::: "memory")
#define PG8_WAIT_L(n) asm volatile("s_waitcnt lgkmcnt(" #n ")" ::: "memory")
#define PG8_BAR __builtin_amdgcn_s_barrier()
#define PG8_SCHED __builtin_amdgcn_sched_barrier(0)
    Unit cur, nxt; int ui = 0;
    if (!S.next(0, cur)) return;
    f32x4 acc[2][2][4][2];
#pragma unroll
    for (int a = 0; a < 2; ++a)
#pragma unroll
        for (int b = 0; b < 2; ++b)
#pragma unroll
            for (int m = 0; m < 4; ++m)
#pragma unroll
                for (int n = 0; n < 2; ++n) acc[a][b][m][n] = (f32x4){0.f, 0.f, 0.f, 0.f};
    bf16x8 At[4][2], B0[2][2], B1[2][2];
    const char* cA = (const char*)g.A + (size_t)cur.pm * tstep; const char* cB = (const char*)g.Bt + (size_t)cur.pn * tstep;
    PG8_STAGE(PG8_SB(0, 0), cB); PG8_STAGE(PG8_SB(0, 1), cB + hstep); PG8_STAGE(PG8_SA(0, 0), cA); PG8_STAGE(PG8_SA(0, 1), cA + hstep);
    if (wr == 1) PG8_BAR;
    PG8_WAIT_V(2); PG8_BAR;
    PG8_STAGE(PG8_SB(1, 0), cB + kstep); PG8_STAGE(PG8_SA(1, 0), cA + kstep); PG8_STAGE(PG8_SB(1, 1), cB + hstep + kstep);
    PG8_WAIT_V(6); PG8_BAR;
    for (;;) {
        const bool has_next = S.next(ui + 1, nxt);
        const char* nA = has_next ? (const char*)g.A + (size_t)nxt.pm * tstep : cA; const char* nB = has_next ? (const char*)g.Bt + (size_t)nxt.pn * tstep : cB;
        for (int t = 0; t < nt; t += 2) {
            const bool last = (t == nt - 2);
            const char* a1 = cA + (size_t)(t + 1) * kstep;
            const char* a2 = last ? nA : cA + (size_t)(t + 2) * kstep; const char* b2 = last ? nB : cB + (size_t)(t + 2) * kstep;
            const char* a3 = a2 + kstep; const char* b3 = b2 + kstep;
            PG8_LDB(B0, 0, 0); PG8_LDB(B1, 0, 1); PG8_SCHED; PG8_LDA(At, 0, 0); PG8_STAGE(PG8_SA(1, 1), a1 + hstep);
            PG8_WAIT_V(8); PG8_WAIT_L(0); PG8_BAR; PG8_MMA(0, 0, At, B0); PG8_MMA(0, 1, At, B1); PG8_BAR; PG8_SCHED;
            PG8_LDA(At, 0, 1); PG8_STAGE(PG8_SB(0, 0), b2); PG8_STAGE(PG8_SB(0, 1), b2 + hstep); PG8_STAGE(PG8_SA(0, 0), a2);
            PG8_WAIT_V(8); PG8_WAIT_L(0); PG8_BAR; PG8_MMA(1, 0, At, B0); PG8_MMA(1, 1, At, B1); PG8_BAR; PG8_SCHED;
            PG8_LDB(B0, 1, 0); PG8_LDB(B1, 1, 1); PG8_SCHED; PG8_LDA(At, 1, 0); PG8_STAGE(PG8_SA(0, 1), a2 + hstep);
            PG8_WAIT_V(8); PG8_WAIT_L(0); PG8_BAR; PG8_MMA(0, 0, At, B0); PG8_MMA(0, 1, At, B1); PG8_BAR; PG8_SCHED;
            PG8_LDA(At, 1, 1); PG8_STAGE(PG8_SB(1, 0), b3); PG8_STAGE(PG8_SB(1, 1), b3 + hstep); PG8_STAGE(PG8_SA(1, 0), a3);
            PG8_WAIT_V(8); PG8_WAIT_L(0); PG8_BAR; PG8_MMA(1, 0, At, B0); PG8_MMA(1, 1, At, B1); PG8_BAR; PG8_SCHED;
        }
        if (wr == 0) PG8_BAR;
        { int fr_ = fr, fq_ = fq; asm volatile("" : "+v"(fr_), "+v"(fq_)); E(acc, cur, wr, wc, fr_, fq_, xlds); }
        if (!has_next) break;
#pragma unroll
        for (int a = 0; a < 2; ++a)
#pragma unroll
            for (int b = 0; b < 2; ++b)
#pragma unroll
                for (int m = 0; m < 4; ++m)
#pragma unroll
                    for (int n = 0; n < 2; ++n) acc[a][b][m][n] = (f32x4){0.f, 0.f, 0.f, 0.f};
        cur = nxt; cA = nA; cB = nB; ++ui;
        if (wr == 1) PG8_BAR;
    }
    PG8_WAIT_V(0);
    PG8_BAR;
#undef PG8_SA
#undef PG8_SB
#undef PG8_STAGE
#undef PG8_LDA
#undef PG8_LDB
#undef PG8_MMA
#undef PG8_WAIT_V
#undef PG8_WAIT_L
#undef PG8_BAR
#undef PG8_SCHED
}
}

typedef f32x4 Acc[2][2][4][2];

struct EpiRes {
    const float* xin_ctx; const float* xin_lat; float* xout; const float* gate;
    const bf16_t* xin_b; bf16_t* xout_b;
    __device__ __forceinline__ void operator()(const Acc& acc, const pg8::Unit& u, int wr, int wc, int fr, int fq, LAS unsigned char*) const {
        const TileInfo ti(u.pm);
        const int col0 = u.pn * 256 + wc * 32 + 4 * fq;
        const float* gp = gate + ti.ci * 6144 + col0;
        f32x4 g4[2][2];
#pragma unroll
        for (int bj = 0; bj < 2; ++bj)
#pragma unroll
            for (int n = 0; n < 2; ++n) g4[bj][n] = *(const GAS f32x4*)(gp + bj * 128 + n * 16);
        const float* xin = ti.lat ? xin_lat + (size_t)(u.pm * 256 - M_CTX) * DM : xin_ctx + (size_t)(u.pm * 256) * DM;
        float* xo = xout + (size_t)(u.pm * 256) * DM;
        const bf16_t* xib = xin_b + (size_t)(u.pm * 256) * DM; bf16_t* xob = xout_b + (size_t)(u.pm * 256) * DM;
#pragma unroll
        for (int ai = 0; ai < 2; ++ai) {
            f32x4 xv[4][2][2];
            if (xin_b) {
#pragma unroll
                for (int m = 0; m < 4; ++m) {
                    const size_t off = (size_t)(ai * 128 + wr * 64 + m * 16 + fr) * DM + col0;
#pragma unroll
                    for (int bj = 0; bj < 2; ++bj)
#pragma unroll
                        for (int n = 0; n < 2; ++n) { const u32x2 r = *(const GAS u32x2*)(xib + off + bj * 128 + n * 16);
                            xv[m][bj][n] = (f32x4){__uint_as_float(r.x << 16), __uint_as_float(r.x & 0xffff0000u), __uint_as_float(r.y << 16), __uint_as_float(r.y & 0xffff0000u)}; }
                }
            } else {
#pragma unroll
                for (int m = 0; m < 4; ++m) {
                    const size_t off = (size_t)(ai * 128 + wr * 64 + m * 16 + fr) * DM + col0;
#pragma unroll
                    for (int bj = 0; bj < 2; ++bj)
#pragma unroll
                        for (int n = 0; n < 2; ++n) xv[m][bj][n] = *(const GAS f32x4*)(xin + off + bj * 128 + n * 16);
                }
            }
#pragma unroll
            for (int m = 0; m < 4; ++m) {
                const size_t off = (size_t)(ai * 128 + wr * 64 + m * 16 + fr) * DM + col0;
#pragma unroll
                for (int bj = 0; bj < 2; ++bj)
#pragma unroll
                    for (int n = 0; n < 2; ++n) { const f32x4 o = xv[m][bj][n] + g4[bj][n] * acc[ai][bj][m][n];
                        if (xout_b) { u32x2 w; w.x = cvtpk(o[0], o[1]); w.y = cvtpk(o[2], o[3]); *(GAS u32x2*)(xob + off + bj * 128 + n * 16) = w; }
                        else *(GAS f32x4*)(xo + off + bj * 128 + n * 16) = o; }
            }
            __builtin_amdgcn_sched_group_barrier(0x020, 16, 0);
            asm volatile("" ::: "memory");
            __builtin_amdgcn_sched_barrier(0);
        }
    }
};

struct EpiIn {
    int layer;
    const float *qn_g, *kn_g, *dqn_g, *dkn_g;
    const float *r64c, *r64s, *r32c, *r32s;
    bf16_t *QG, *QD, *KG, *VG, *KD, *VD, *CB, *PB;
    float* out;
    __device__ __forceinline__ void operator()(const Acc& acc, const pg8::Unit& u, int wr, int wc, int fr, int fq, LAS unsigned char*) const {
        const TileInfo ti(u.pm);
        const int pn = u.pn;
        const int rbase = wr * 64 + fr;
        if (pn < 2 || (pn == 2 && wc < 2)) {
            const bool isq = pn < 2;
            const float* gsrc = (isq ? qn_g : kn_g) + 4 * fq;
            const int head = isq ? 4 * pn + wc : wc;
            f32x4 g4[2][2], rc[2], rs[2];
#pragma unroll
            for (int bj = 0; bj < 2; ++bj)
#pragma unroll
                for (int n = 0; n < 2; ++n) g4[bj][n] = *(const GAS f32x4*)(gsrc + 32 * bj + 16 * n);
#pragma unroll
            for (int ai = 0; ai < 2; ++ai) { const int pos = (ti.t0 >> 6) + 2 * ai + wr; rc[ai] = *(const GAS f32x4*)(r64c + pos * 16 + 4 * fq); rs[ai] = *(const GAS f32x4*)(r64s + pos * 16 + 4 * fq); }
            float ss[8];
#pragma unroll
            for (int ai = 0; ai < 2; ++ai)
#pragma unroll
                for (int m = 0; m < 4; ++m) { float t_ = 0.f;
#pragma unroll
                    for (int bj = 0; bj < 2; ++bj)
#pragma unroll
                        for (int n = 0; n < 2; ++n) { const f32x4 v = acc[ai][bj][m][n]; t_ += (v[0] * v[0] + v[1] * v[1]) + (v[2] * v[2] + v[3] * v[3]); }
                    ss[ai * 4 + m] = t_; }
#pragma unroll
            for (int i = 0; i < 8; ++i) ss[i] += __shfl_xor(ss[i], 16);
#pragma unroll
            for (int i = 0; i < 8; ++i) ss[i] += __shfl_xor(ss[i], 32);
#pragma unroll
            for (int mh = 0; mh < 2; ++mh) {
                f32x4 cc[2], cs[2];
#pragma unroll
                for (int mm = 0; mm < 2; ++mm) { const int pos = 16 * (2 * mh + mm) + fr; cc[mm] = *(const GAS f32x4*)(r64c + pos * 16 + 4 * fq); cs[mm] = *(const GAS f32x4*)(r64s + pos * 16 + 4 * fq); }
                if (mh == 0) __builtin_amdgcn_sched_group_barrier(0x020, 12, 0); else __builtin_amdgcn_sched_group_barrier(0x020, 4, 0);
#pragma unroll
                for (int mm = 0; mm < 2; ++mm)
#pragma unroll
                    for (int ai = 0; ai < 2; ++ai) {
                        const int m = 2 * mh + mm;
                        const int rt = ai * 128 + m * 16 + rbase; const int t = ti.t0 + rt;
                        const float rstd = rsqrtf(ss[ai * 4 + m] * (1.f / 64.f) + EPS);
                        bf16_t* dst = isq ? QG + ((size_t)u.pm * 256 + rt) * 512 + head * 64 + 8 * fq : KG + ((ti.R * 2 + (long)head * ti.S + t) * 64) + 8 * fq;
                        float* o = out + OUT_GK + ((size_t)(ti.seq * 4 + layer) * 256 + t) * 128 + head * 64 + 4 * fq;
#pragma unroll
                        for (int bj = 0; bj < 2; ++bj) {
                            f32x4 y0 = acc[ai][bj][m][0] * rstd * g4[bj][0], y1 = acc[ai][bj][m][1] * rstd * g4[bj][1];
                            if (!isq && !ti.lat) { *(GAS f32x4*)(o + 32 * bj) = y0; *(GAS f32x4*)(o + 32 * bj + 16) = y1; }
                            if (ti.lat) {
                                const f32x4 c4 = bj ? cc[mm] : rc[ai], s4 = bj ? cs[mm] : rs[ai];
                                const f32x4 o0 = y0 * c4 - y1 * s4, o1 = y1 * c4 + y0 * s4; y0 = o0; y1 = o1;
                            }
                            if (isq) { y0 = y0 * QSCALE_G; y1 = y1 * QSCALE_G; }
                            u32x4 w; w.x = cvtpk(y0[0], y0[1]); w.y = cvtpk(y0[2], y0[3]); w.z = cvtpk(y1[0], y1[1]); w.w = cvtpk(y1[2], y1[3]);
                            *(GAS u32x4*)(dst + 32 * bj) = w;
                        }
                    }
                asm volatile("" ::: "memory"); __builtin_amdgcn_sched_barrier(0);
            }
        } else if (pn == 2) {
            const int head = wc - 2;
#pragma unroll
            for (int ai = 0; ai < 2; ++ai)
#pragma unroll
                for (int m = 0; m < 4; ++m) {
                    const int rt = ai * 128 + m * 16 + rbase; const int t = ti.t0 + rt;
                    if (!ti.lat) {
                        float* o = out + OUT_GV + ((size_t)(ti.seq * 4 + layer) * 256 + t) * 128 + head * 64 + 8 * fq;
#pragma unroll
                        for (int bj = 0; bj < 2; ++bj) { *(GAS f32x4*)(o + 32 * bj) = acc[ai][bj][m][0]; *(GAS f32x4*)(o + 32 * bj + 4) = acc[ai][bj][m][1]; }
                    }
                    bf16_t* vp = VG + ((ti.R * 2 + (long)head * ti.S + t) * 64) + 8 * fq;
#pragma unroll
                    for (int bj = 0; bj < 2; ++bj) { const f32x4 a = acc[ai][bj][m][0], b = acc[ai][bj][m][1]; u32x4 w; w.x = cvtpk(a[0], a[1]); w.y = cvtpk(a[2], a[3]); w.z = cvtpk(b[0], b[1]); w.w = cvtpk(b[2], b[3]); *(GAS u32x4*)(vp + 32 * bj) = w; }
                }
        } else if (pn == 3) {
#pragma unroll
            for (int ai = 0; ai < 2; ++ai)
#pragma unroll
                for (int m = 0; m < 4; ++m) {
                    const size_t grow = (size_t)u.pm * 256 + ai * 128 + m * 16 + rbase;
                    bf16_t* p = CB + grow * 256 + 32 * wc + 8 * fq;
#pragma unroll
                    for (int bj = 0; bj < 2; ++bj) { const f32x4 a = acc[ai][bj][m][0], b = acc[ai][bj][m][1]; u32x4 w; w.x = cvtpk(a[0], a[1]); w.y = cvtpk(a[2], a[3]); w.z = cvtpk(b[0], b[1]); w.w = cvtpk(b[2], b[3]); *(GAS u32x4*)(p + 128 * bj) = w; }
                }
        } else if (pn < 6) {
#pragma unroll
            for (int ai = 0; ai < 2; ++ai)
#pragma unroll
                for (int m = 0; m < 4; ++m) {
                    const size_t grow = (size_t)u.pm * 256 + ai * 128 + m * 16 + rbase;
                    bf16_t* p = PB + grow * 256 + 128 * (pn - 4) + 32 * wc + 8 * fq;
                    const f32x4 a = acc[ai][0][m][0] * acc[ai][1][m][0], b = acc[ai][0][m][1] * acc[ai][1][m][1];
                    u32x4 w; w.x = cvtpk(a[0], a[1]); w.y = cvtpk(a[2], a[3]); w.z = cvtpk(b[0], b[1]); w.w = cvtpk(b[2], b[3]); *(GAS u32x4*)p = w;
                }
        } else if (pn < 8) {
            const bool isq = pn == 6;
            const float* gsrc = isq ? dqn_g : dkn_g;
            const int a_ax = fq >> 1, ib = 4 * (fq & 1);
            const float* gp = gsrc + 16 * a_ax + ib;
            const int head = wc;
            const f32x4 g0 = *(const GAS f32x4*)gp, g1 = *(const GAS f32x4*)(gp + 8);
            f32x4 tc[4], ts[4];
#pragma unroll
            for (int j = 0; j < 4; ++j) { const int pos = a_ax ? (16 * j + fr) : ((ti.t0 >> 6) + 2 * (j & 1) + wr); tc[j] = *(const GAS f32x4*)(r32c + pos * 8 + ib); ts[j] = *(const GAS f32x4*)(r32s + pos * 8 + ib); }
            __builtin_amdgcn_sched_group_barrier(0x020, 10, 0);
#pragma unroll
            for (int ai = 0; ai < 2; ++ai) {
                float ss[4][2];
#pragma unroll
                for (int m = 0; m < 4; ++m)
#pragma unroll
                    for (int bj = 0; bj < 2; ++bj) { float t_ = 0.f;
#pragma unroll
                        for (int n = 0; n < 2; ++n) { const f32x4 v = acc[ai][bj][m][n]; t_ += (v[0] * v[0] + v[1] * v[1]) + (v[2] * v[2] + v[3] * v[3]); }
                        ss[m][bj] = t_; }
#pragma unroll
                for (int i = 0; i < 4; ++i) { ss[i][0] += __shfl_xor(ss[i][0], 16); ss[i][1] += __shfl_xor(ss[i][1], 16); }
#pragma unroll
                for (int i = 0; i < 4; ++i) { ss[i][0] += __shfl_xor(ss[i][0], 32); ss[i][1] += __shfl_xor(ss[i][1], 32); }
#pragma unroll
                for (int m = 0; m < 4; ++m) {
                    const int rt = ai * 128 + m * 16 + rbase; const int t = ti.t0 + rt; const size_t grow = (size_t)u.pm * 256 + rt;
                    const f32x4 c4 = a_ax ? tc[m] : tc[ai], s4 = a_ax ? ts[m] : ts[ai];
#pragma unroll
                    for (int bj = 0; bj < 2; ++bj) {
                        const float rstd = rsqrtf(ss[m][bj] * (1.f / 32.f) + EPS);
                        f32x4 y0 = acc[ai][bj][m][0] * rstd * g0, y1 = acc[ai][bj][m][1] * rstd * g1;
                        if (!isq && !ti.lat) {
                            float* o = out + OUT_DK + ((size_t)(ti.seq * 4 + layer) * 256 + t) * 256 + head * 64 + bj * 32 + 16 * a_ax + ib;
                            *(GAS f32x4*)(o) = y0; *(GAS f32x4*)(o + 8) = y1;
                        }
                        if (ti.lat) { const f32x4 o0 = y0 * c4 - y1 * s4, o1 = y1 * c4 + y0 * s4; y0 = o0; y1 = o1; }
                        bf16_t* dst;
                        if (isq) { y0 = y0 * QSCALE_D; y1 = y1 * QSCALE_D; dst = QD + grow * 256 + head * 64 + bj * 32 + 16 * a_ax + 2 * ib; }
                        else dst = KD + ((ti.R * 8 + (long)(head * 2 + bj) * ti.S + t) * 32) + 16 * a_ax + 2 * ib;
                        u32x4 w; w.x = cvtpk(y0[0], y0[1]); w.y = cvtpk(y0[2], y0[3]); w.z = cvtpk(y1[0], y1[1]); w.w = cvtpk(y1[2], y1[3]);
                        *(GAS u32x4*)dst = w;
                    }
                }
                asm volatile("" ::: "memory"); __builtin_amdgcn_sched_barrier(0);
            }
        } else {
            const int head = wc;
#pragma unroll
            for (int ai = 0; ai < 2; ++ai)
#pragma unroll
                for (int m = 0; m < 4; ++m) {
                    const int rt = ai * 128 + m * 16 + rbase; const int t = ti.t0 + rt;
                    if (!ti.lat) {
                        float* o = out + OUT_DV + ((size_t)(ti.seq * 4 + layer) * 256 + t) * 256 + head * 64 + 8 * fq;
#pragma unroll
                        for (int bj = 0; bj < 2; ++bj) { *(GAS f32x4*)(o + 32 * bj) = acc[ai][bj][m][0]; *(GAS f32x4*)(o + 32 * bj + 4) = acc[ai][bj][m][1]; }
                    }
                    bf16_t* vp = VD + ((ti.R * 4 + (long)head * ti.S + t) * 64) + 8 * fq;
#pragma unroll
                    for (int bj = 0; bj < 2; ++bj) { const f32x4 a = acc[ai][bj][m][0], b = acc[ai][bj][m][1]; u32x4 w; w.x = cvtpk(a[0], a[1]); w.y = cvtpk(a[2], a[3]); w.z = cvtpk(b[0], b[1]); w.w = cvtpk(b[2], b[3]); *(GAS u32x4*)(vp + 32 * bj) = w; }
                }
        }
    }
};

__device__ __forceinline__ float dpp_ror1(float x) { return __int_as_float(__builtin_amdgcn_update_dpp(0, __float_as_int(x), 0x121, 0xf, 0xf, false)); }
__device__ __forceinline__ float dpp_ror15(float x) { return __int_as_float(__builtin_amdgcn_update_dpp(0, __float_as_int(x), 0x12F, 0xf, 0xf, false)); }
__device__ __forceinline__ float silu_f(float x) { return x * __builtin_amdgcn_rcpf(1.f + __builtin_amdgcn_exp2f(-x * LOG2E)); }
struct EpiUp {
    const float* cw; const float* cbias; bf16_t* F; float* EP; float* EA; float* EU;
    __device__ __forceinline__ void operator()(const Acc& acc, const pg8::Unit& u, int wr, int wc, int fr, int fq, LAS unsigned char* xlds) const {
        const TileInfo ti(u.pm);
        const int c0 = u.pn * 128 + wc * 32 + 8 * fq;
        LAS float* X = (LAS float*)xlds;
#pragma unroll
        for (int ai = 0; ai < 2; ++ai) {
            if (fr == 0) { LAS float* p = X + ((((ai * 2 + wr) * 4 + wc) * 2 + 0) * 4 + fq) * 8; *(LAS f32x4*)p = acc[ai][0][0][0]; *(LAS f32x4*)(p + 4) = acc[ai][0][0][1]; }
            if (fr == 15) { LAS float* p = X + ((((ai * 2 + wr) * 4 + wc) * 2 + 1) * 4 + fq) * 8; *(LAS f32x4*)p = acc[ai][0][3][0]; *(LAS f32x4*)(p + 4) = acc[ai][0][3][1]; }
        }
        asm volatile("s_waitcnt lgkmcnt(0)" ::: "memory"); __builtin_amdgcn_s_barrier(); asm volatile("" ::: "memory");
        f32x4 w0[2], w1[2], w2[2], bb[2];
#pragma unroll
        for (int n = 0; n < 2; ++n) { w0[n] = *(const GAS f32x4*)(cw + c0 + 4 * n); w1[n] = *(const GAS f32x4*)(cw + DFF + c0 + 4 * n); w2[n] = *(const GAS f32x4*)(cw + 2 * DFF + c0 + 4 * n); bb[n] = *(const GAS f32x4*)(cbias + c0 + 4 * n); }
        const bool has_prev = ti.lat && ti.t0 > 0, has_next = ti.lat && ti.t0 < 4096 - 256;
#pragma unroll
        for (int ai = 0; ai < 2; ++ai) {
            f32x4 pb[2] = {(f32x4){0.f, 0.f, 0.f, 0.f}, (f32x4){0.f, 0.f, 0.f, 0.f}}, nb[2] = {(f32x4){0.f, 0.f, 0.f, 0.f}, (f32x4){0.f, 0.f, 0.f, 0.f}};
            { const int seg = ai * 2 + wr;
              if (seg > 0) { const int ps = seg - 1; LAS float* p = X + ((((ps >> 1) * 2 + (ps & 1)) * 4 + wc) * 2 + 1) * 32 + fq * 8; pb[0] = *(LAS f32x4*)p; pb[1] = *(LAS f32x4*)(p + 4); }
              if (seg < 3) { const int ns = seg + 1; LAS float* p = X + ((((ns >> 1) * 2 + (ns & 1)) * 4 + wc) * 2 + 0) * 32 + fq * 8; nb[0] = *(LAS f32x4*)p; nb[1] = *(LAS f32x4*)(p + 4); } }
#pragma unroll
            for (int m = 0; m < 4; ++m) {
                const int rt = ai * 128 + wr * 64 + m * 16 + fr; const size_t grow = (size_t)u.pm * 256 + rt;
                f32x4 fo[2], cv[2];
#pragma unroll
                for (int n = 0; n < 2; ++n) {
                    const f32x4 a = acc[ai][0][m][n];
                    const f32x4 up = (m > 0) ? acc[ai][0][m > 0 ? m - 1 : 0][n] : pb[n];
                    const f32x4 dn = (m < 3) ? acc[ai][0][m < 3 ? m + 1 : 3][n] : nb[n];
                    f32x4 pv, nx;
#pragma unroll
                    for (int e = 0; e < 4; ++e) {
                        pv[e] = dpp_ror1(fr == 15 ? up[e] : a[e]);
                        nx[e] = dpp_ror15(fr == 0 ? dn[e] : a[e]);
                    }
                    const f32x4 c = w0[n] * pv + w1[n] * a + w2[n] * nx + bb[n];
                    cv[n] = c;
                    const f32x4 uu = acc[ai][1][m][n];
#pragma unroll
                    for (int e = 0; e < 4; ++e) fo[n][e] = silu_f(c[e]) * uu[e];
                }
                u32x4 w; w.x = cvtpk(fo[0][0], fo[0][1]); w.y = cvtpk(fo[0][2], fo[0][3]); w.z = cvtpk(fo[1][0], fo[1][1]); w.w = cvtpk(fo[1][2], fo[1][3]);
                *(GAS u32x4*)(F + grow * DFF + c0) = w;
                if (ai == 0 && m == 0) { if (has_prev && rt == 0) { const size_t eo = ((size_t)u.pm * 2 + 0) * DFF + c0;
                        *(GAS f32x4*)(EP + eo) = cv[0]; *(GAS f32x4*)(EP + eo + 4) = cv[1]; *(GAS f32x4*)(EA + eo) = acc[0][0][0][0]; *(GAS f32x4*)(EA + eo + 4) = acc[0][0][0][1]; *(GAS f32x4*)(EU + eo) = acc[0][1][0][0]; *(GAS f32x4*)(EU + eo + 4) = acc[0][1][0][1]; } }
                if (ai == 1 && m == 3) { if (has_next && rt == 255) { const size_t eo = ((size_t)u.pm * 2 + 1) * DFF + c0;
                        *(GAS f32x4*)(EP + eo) = cv[0]; *(GAS f32x4*)(EP + eo + 4) = cv[1]; *(GAS f32x4*)(EA + eo) = acc[1][0][3][0]; *(GAS f32x4*)(EA + eo + 4) = acc[1][0][3][1]; *(GAS f32x4*)(EU + eo) = acc[1][1][3][0]; *(GAS f32x4*)(EU + eo + 4) = acc[1][1][3][1]; } }
            }
        }
        asm volatile("s_waitcnt lgkmcnt(0)" ::: "memory"); __builtin_amdgcn_s_barrier(); asm volatile("" ::: "memory");
    }
};

typedef short v4i16_t __attribute__((ext_vector_type(4)));
__device__ __forceinline__ s16x4 vtr(LAS const char* p) { return __builtin_bit_cast(s16x4, __builtin_amdgcn_ds_read_tr16_b64_v4i16((LAS v4i16_t*)p)); }
__device__ __forceinline__ float xhalf_max(float m) { auto rr = __builtin_amdgcn_permlane32_swap(__float_as_uint(m), __float_as_uint(m), false, false); return fmaxf(__uint_as_float(rr[0]), __uint_as_float(rr[1])); }
__device__ __forceinline__ float xhalf_sum(float m) { auto rr = __builtin_amdgcn_permlane32_swap(__float_as_uint(m), __float_as_uint(m), false, false); return __uint_as_float(rr[0]) + __uint_as_float(rr[1]); }

constexpr int ATT_VS = 192;
constexpr float ATT_THR = 8.f;
#define MX3(a, b, c) __builtin_fmaxf(__builtin_fmaxf((a), (b)), (c))
template <int DQK, bool YORD>
__device__ __forceinline__ void flash_pass(const bf16_t* __restrict__ Qw, int qpitch, const bf16_t* __restrict__ Kg, const bf16_t* __restrict__ Vg, int NT, int tst,
                                           LAS char* lds, f32x16 (&o)[2], float& lsum) {
#define ATT_TI(T) (((T) + tst) < NT ? ((T) + tst) : ((T) + tst - NT))
    constexpr int KS = DQK * 2 + 16, KBUF = 64 * KS, VBUF = 64 * ATT_VS, NDS = DQK / 16;
    constexpr int KROWB = DQK * 2;
    const int tid = opaque_tid(), lane = tid & 63, r32 = lane & 31, h = lane >> 5;
    LAS char* Kb = lds; LAS char* Vb = lds + 2 * KBUF;
    bf16x8 qf[NDS];
#pragma unroll
    for (int ds = 0; ds < NDS; ++ds) qf[ds] = *(const GAS bf16x8*)(Qw + (size_t)r32 * qpitch + 16 * ds + 8 * h);
    const bool kload = (tid * 16) < 64 * KROWB;
    const int krow = (tid * 16) / KROWB, kcb = (tid * 16) % KROWB;
    const int kdst = krow * KS + kcb, vdst = (tid >> 3) * ATT_VS + (tid & 7) * 16;
    const char* kg = (const char*)Kg + tid * 16; const char* vg = (const char*)Vg + tid * 16;
    u32x4 kreg = {0, 0, 0, 0}, vreg;
    {
        u32x4 k1 = {0, 0, 0, 0};
        if (kload) { kreg = *(const GAS u32x4*)(kg + (size_t)ATT_TI(0) * 64 * KROWB); k1 = *(const GAS u32x4*)(kg + (size_t)ATT_TI(1) * 64 * KROWB); }
        vreg = *(const GAS u32x4*)(vg + (size_t)ATT_TI(0) * 64 * 128);
        if (kload) { *(LAS u32x4*)(Kb + kdst) = kreg; *(LAS u32x4*)(Kb + KBUF + kdst) = k1; }
        *(LAS u32x4*)(Vb + vdst) = vreg;
        *(LAS u32x4*)(Vb + 2 * VBUF + vdst) = (u32x4){0, 0, 0, 0};
    }
    __syncthreads();
    const int kfo = r32 * KS + h * 16;
    const int vfo = (4 * h + ((lane & 15) >> 2)) * ATT_VS + (((lane >> 4) & 1) * 16 + (lane & 3) * 4) * 2;
    f32x16 p0 = (f32x16){}, p1 = (f32x16){};
#pragma unroll
    for (int ds = 0; ds < NDS; ++ds) {
        const bf16x8 k0 = *(LAS const bf16x8*)(Kb + kfo + ds * 32), k1 = *(LAS const bf16x8*)(Kb + kfo + 32 * KS + ds * 32);
        p0 = __builtin_amdgcn_mfma_f32_32x32x16_bf16(k0, qf[ds], p0, 0, 0, 0);
        p1 = __builtin_amdgcn_mfma_f32_32x32x16_bf16(k1, qf[ds], p1, 0, 0, 0);
    }
    __syncthreads();
    float mref, l = 0.f;
    {
        float a = MX3(p0[0], p0[1], p1[0]), b = MX3(p0[2], p0[3], p1[1]); a = MX3(a, p1[2], p1[3]);
#pragma unroll
        for (int r = 4; r < 16; r += 4) { a = MX3(a, p0[r], p0[r + 1]); b = MX3(b, p0[r + 2], p0[r + 3]); a = MX3(a, p1[r], p1[r + 1]); b = MX3(b, p1[r + 2], p1[r + 3]); }
        mref = xhalf_max(fmaxf(a, b));
#pragma unroll
        for (int r = 0; r < 16; ++r) { p0[r] -= mref; p1[r] -= mref; }
    }
    f32x16 negm;
#pragma unroll
    for (int r = 0; r < 16; ++r) negm[r] = -mref;
    asm volatile("" : "+v"(negm));
    o[0] = (f32x16){}; o[1] = (f32x16){};
    bf16x8 pk[4] = {};
    int vs_prev = 2 * VBUF, vs_cur = 0, vs_next = VBUF;
#define ATT_MPART(N0, N1, T) do { \
        LAS const char* kb_ = Kb + ((((T) + 1) & 1) * KBUF) + kfo; LAS const char* vb_ = Vb + vs_prev + vfo; \
        bf16x8 kf_[2 * NDS]; s16x4 vl_[8], vh_[8]; \
        _Pragma("unroll") for (int ds = 0; ds < NDS; ++ds) { kf_[2 * ds] = *(LAS const bf16x8*)(kb_ + ds * 32); kf_[2 * ds + 1] = *(LAS const bf16x8*)(kb_ + 32 * KS + ds * 32); } \
        _Pragma("unroll") for (int s_ = 0; s_ < 4; ++s_) { _Pragma("unroll") for (int db_ = 0; db_ < 2; ++db_) { \
            vl_[2 * s_ + db_] = vtr(vb_ + (16 * s_) * ATT_VS + db_ * 64); vh_[2 * s_ + db_] = vtr(vb_ + (16 * s_ + 8) * ATT_VS + db_ * 64); } } \
        N0 = __builtin_amdgcn_mfma_f32_32x32x16_bf16(kf_[0], qf[0], negm, 0, 0, 0); N1 = __builtin_amdgcn_mfma_f32_32x32x16_bf16(kf_[1], qf[0], negm, 0, 0, 0); \
        _Pragma("unroll") for (int ds = 1; ds < NDS; ++ds) { \
            N0 = __builtin_amdgcn_mfma_f32_32x32x16_bf16(kf_[2 * ds], qf[ds], N0, 0, 0, 0); N1 = __builtin_amdgcn_mfma_f32_32x32x16_bf16(kf_[2 * ds + 1], qf[ds], N1, 0, 0, 0); } \
        _Pragma("unroll") for (int s_ = 0; s_ < 4; ++s_) { _Pragma("unroll") for (int db_ = 0; db_ < 2; ++db_) { \
            const bf16x8 vf_ = __builtin_shufflevector(vl_[2 * s_ + db_], vh_[2 * s_ + db_], 0, 1, 2, 3, 4, 5, 6, 7); \
            o[db_] = __builtin_amdgcn_mfma_f32_32x32x16_bf16(vf_, pk[s_], o[db_], 0, 0, 0); } } \
        __builtin_amdgcn_sched_group_barrier(0x100, 2 * NDS + 8, 0); __builtin_amdgcn_sched_group_barrier(0x008, 2 * NDS, 0); \
        __builtin_amdgcn_sched_group_barrier(0x100, 8, 0); __builtin_amdgcn_sched_group_barrier(0x008, 8, 0); } while (0)
#define ATT_VPART(P0, P1, N0, N1) do { \
        float a = MX3(P0[0], P0[1], P1[0]), b = MX3(P0[2], P0[3], P1[1]); a = MX3(a, P1[2], P1[3]); \
        _Pragma("unroll") for (int r = 4; r < 16; r += 4) { a = MX3(a, P0[r], P0[r + 1]); b = MX3(b, P0[r + 2], P0[r + 3]); a = MX3(a, P1[r], P1[r + 1]); b = MX3(b, P1[r + 2], P1[r + 3]); } \
        const float mt = xhalf_max(fmaxf(a, b)); \
        resc = __any(mt > ATT_THR); \
        if (__builtin_expect(resc, 0)) { \
            const float dl = fmaxf(mt, 0.f); mref += dl; fsc = __builtin_amdgcn_exp2f(-dl); l *= fsc; \
            _Pragma("unroll") for (int r = 0; r < 16; ++r) { P0[r] -= dl; P1[r] -= dl; } \
            if (!YORD) { _Pragma("unroll") for (int r = 0; r < 16; ++r) { N0[r] -= dl; N1[r] -= dl; o[0][r] *= fsc; o[1][r] *= fsc; } } \
            _Pragma("unroll") for (int r = 0; r < 16; ++r) negm[r] = -mref; \
            asm volatile("" : "+v"(negm)); } \
        float ps0 = 0.f, ps1 = 0.f; \
        _Pragma("unroll") for (int r = 0; r < 16; ++r) { P0[r] = __builtin_amdgcn_exp2f(P0[r]); P1[r] = __builtin_amdgcn_exp2f(P1[r]); ps0 += P0[r]; ps1 += P1[r]; } \
        l += ps0 + ps1; \
        _Pragma("unroll") for (int s = 0; s < 2; ++s) { u32x4 a4, b4; \
            a4.x = cvtpk(P0[8 * s + 0], P0[8 * s + 1]); a4.y = cvtpk(P0[8 * s + 2], P0[8 * s + 3]); a4.z = cvtpk(P0[8 * s + 4], P0[8 * s + 5]); a4.w = cvtpk(P0[8 * s + 6], P0[8 * s + 7]); \
            b4.x = cvtpk(P1[8 * s + 0], P1[8 * s + 1]); b4.y = cvtpk(P1[8 * s + 2], P1[8 * s + 3]); b4.z = cvtpk(P1[8 * s + 4], P1[8 * s + 5]); b4.w = cvtpk(P1[8 * s + 6], P1[8 * s + 7]); \
            pkn[s] = __builtin_bit_cast(bf16x8, a4); pkn[2 + s] = __builtin_bit_cast(bf16x8, b4); } } while (0)
#define ATT_STEP(P0, P1, N0, N1, T) do { \
        const bool more = (T) + 1 < NT, more2 = (T) + 2 < NT; \
        if (more2 && kload) kreg = *(const GAS u32x4*)(kg + (size_t)ATT_TI((T) + 2) * 64 * KROWB); \
        if (more) vreg = *(const GAS u32x4*)(vg + (size_t)ATT_TI((T) + 1) * 64 * 128); \
        float fsc = 1.f; bool resc; bf16x8 pkn[4]; \
        if (!YORD) { ATT_MPART(N0, N1, T); __builtin_amdgcn_sched_barrier(0); ATT_VPART(P0, P1, N0, N1); } \
        else { ATT_VPART(P0, P1, N0, N1); __builtin_amdgcn_sched_barrier(0); ATT_MPART(N0, N1, T); \
            if (__builtin_expect(resc, 0)) { _Pragma("unroll") for (int r = 0; r < 16; ++r) { o[0][r] *= fsc; o[1][r] *= fsc; } } } \
        _Pragma("unroll") for (int s = 0; s < 4; ++s) pk[s] = pkn[s]; \
        if (more2 && kload) *(LAS u32x4*)(Kb + ((T) & 1) * KBUF + kdst) = kreg; \
        if (more) *(LAS u32x4*)(Vb + vs_next + vdst) = vreg; \
        __syncthreads(); \
        vs_prev = vs_cur; vs_cur = vs_next; vs_next = (vs_next == 2 * VBUF) ? 0 : vs_next + VBUF; } while (0)
    f32x16 n0, n1;
    for (int t = 0; t < NT; t += 2) {
        ATT_STEP(p0, p1, n0, n1, t);
        ATT_STEP(n0, n1, p0, p1, t + 1);
    }
    {
        LAS const char* vb_ = Vb + vs_prev + vfo;
#pragma unroll
        for (int s_ = 0; s_ < 4; ++s_) {
#pragma unroll
            for (int db_ = 0; db_ < 2; ++db_) {
                const s16x4 lo_ = vtr(vb_ + (16 * s_) * ATT_VS + db_ * 64), hi_ = vtr(vb_ + (16 * s_ + 8) * ATT_VS + db_ * 64);
                const bf16x8 vf_ = __builtin_shufflevector(lo_, hi_, 0, 1, 2, 3, 4, 5, 6, 7);
                o[db_] = __builtin_amdgcn_mfma_f32_32x32x16_bf16(vf_, pk[s_], o[db_], 0, 0, 0);
            }
        }
    }
    __syncthreads();
#undef ATT_STEP
#undef ATT_TI
#undef ATT_VPART
#undef ATT_MPART
    lsum = xhalf_sum(l);
}

__device__ __forceinline__ void store_ot(const f32x16 (&o)[2], bf16_t* dst  , int h) {
#pragma unroll
    for (int db = 0; db < 2; ++db)
#pragma unroll
        for (int g = 0; g < 4; ++g) { u32x2 w; w.x = cvtpk(o[db][4 * g], o[db][4 * g + 1]); w.y = cvtpk(o[db][4 * g + 2], o[db][4 * g + 3]); *(GAS u32x2*)(dst + 32 * db + 8 * g + 4 * h) = w; }
}

#include <hip/hip_bf16.h>
namespace attn64 {
using bf16=__hip_bfloat16;
using bf16x8=__attribute__((ext_vector_type(8)))short;
using s16x4=__attribute__((ext_vector_type(4)))short;
using f32x16=__attribute__((ext_vector_type(16)))float;
using u32x4=__attribute__((ext_vector_type(4)))unsigned;
constexpr int D=64;
constexpr int NW=8,QBLK=32,QB=QBLK*NW,KVBLK=64;

__device__ __forceinline__ int crow(int r,int hi){return (r&3)+8*(r>>2)+4*hi;}
#define SBAR() __builtin_amdgcn_sched_barrier(0)
__device__ __forceinline__ void cmask(f32x16&p0,f32x16&p1,int jb,int qrel,int hi){
  const float NEG=-INFINITY; int kb=64*jb+4*hi;
  #pragma unroll
  for(int r=0;r<16;++r){int kv=kb+(r&3)+8*(r>>2); if(kv>qrel)p0[r]=NEG; if(kv+32>qrel)p1[r]=NEG;}
}

constexpr int NSLOT=3, SLOTB=8192;
constexpr int LDS_K=0, LDS_V=NSLOT*SLOTB, LDS_WS=2*NSLOT*SLOTB, LDS_OST=LDS_WS+NW*64*4, LDS_BYTES=LDS_OST+NW*4096;
constexpr float C2=0.125f*1.4426950408889634f;
__device__ __forceinline__ void glds16(const void*gsrc,unsigned lds_dst){unsigned keep;
  asm volatile("s_mov_b32 %0, m0\n\ts_mov_b32 m0, %2\n\ts_nop 0\n\tglobal_load_lds_dwordx4 %1, off\n\ts_mov_b32 m0, %0":"=&s"(keep):"v"(gsrc),"s"(lds_dst):"memory");}
__device__ __forceinline__ float max3f(float a,float b,float c){float r;asm("v_max3_f32 %0, %1, %2, %3":"=v"(r):"v"(a),"v"(b),"v"(c));return r;}
__device__ __forceinline__ float max2f(float a,float b){float r;asm("v_max_f32_e32 %0, %1, %2":"=v"(r):"v"(a),"v"(b));return r;}
__device__ __forceinline__ float fadd_s(float a,float b){float r;asm("v_add_f32_e32 %0, %1, %2":"=v"(r):"v"(a),"v"(b));return r;}
__device__ __forceinline__ float fsub_s(float a,float b){float r;asm("v_sub_f32_e32 %0, %1, %2":"=v"(r):"v"(a),"v"(b));return r;}
typedef float f32x2_t __attribute__((ext_vector_type(2))); typedef __bf16 bf16x2_t __attribute__((ext_vector_type(2)));
__device__ __forceinline__ unsigned cvtpk_s(float lo,float hi){f32x2_t v={lo,hi};bf16x2_t b=__builtin_convertvector(v,bf16x2_t);return __builtin_bit_cast(unsigned,b);}
#define WAIT_BAR(N) asm volatile("s_waitcnt vmcnt(" #N ") lgkmcnt(0)\n\ts_barrier":::"memory")

template<int NDS_> __device__ __forceinline__ void qkt(f32x16&p0,f32x16&p1,const char*Kslot,const bf16x8*qr,const f32x16&negm,int r32,int hi){
  const char*kb=Kslot+hi*1024+r32*16;
  #pragma unroll
  for(int d0=0;d0<NDS_;++d0){
    const bf16x8 b0=*reinterpret_cast<const bf16x8*>(kb+d0*2048);
    const bf16x8 b1=*reinterpret_cast<const bf16x8*>(kb+d0*2048+512);
    if(d0==0){p0=__builtin_amdgcn_mfma_f32_32x32x16_bf16(b0,qr[0],negm,0,0,0);p1=__builtin_amdgcn_mfma_f32_32x32x16_bf16(b1,qr[0],negm,0,0,0);}
    else{p0=__builtin_amdgcn_mfma_f32_32x32x16_bf16(b0,qr[d0],p0,0,0,0);p1=__builtin_amdgcn_mfma_f32_32x32x16_bf16(b1,qr[d0],p1,0,0,0);}}
}
typedef __attribute__((address_space(3))) const char* lds_cptr;
typedef short v4i16_t __attribute__((ext_vector_type(4)));
__device__ __forceinline__ void kload8(bf16x8*kf,lds_cptr kp){
  kf[0]=*(const __attribute__((address_space(3))) bf16x8*)(kp);      kf[1]=*(const __attribute__((address_space(3))) bf16x8*)(kp+512);
  kf[2]=*(const __attribute__((address_space(3))) bf16x8*)(kp+2048); kf[3]=*(const __attribute__((address_space(3))) bf16x8*)(kp+2560);
  kf[4]=*(const __attribute__((address_space(3))) bf16x8*)(kp+4096); kf[5]=*(const __attribute__((address_space(3))) bf16x8*)(kp+4608);
  kf[6]=*(const __attribute__((address_space(3))) bf16x8*)(kp+6144); kf[7]=*(const __attribute__((address_space(3))) bf16x8*)(kp+6656);
}
__device__ __forceinline__ void kload2(bf16x8*kf,lds_cptr kp,int j){ kf[2*j]=*(const __attribute__((address_space(3))) bf16x8*)(kp+j*2048); kf[2*j+1]=*(const __attribute__((address_space(3))) bf16x8*)(kp+j*2048+512); }
__device__ __forceinline__ s16x4 vtr(lds_cptr p){ return __builtin_bit_cast(s16x4,__builtin_amdgcn_ds_read_tr16_b64_v4i16((__attribute__((address_space(3))) v4i16_t*)p)); }
__device__ __forceinline__ float rowmax(const f32x16&p0,const f32x16&p1){
  float a=max3f(p0[0],p0[1],p1[0]),b=max3f(p0[2],p0[3],p1[1]);a=max3f(a,p1[2],p1[3]);
  #pragma unroll
  for(int r=4;r<16;r+=4){a=max3f(a,p0[r],p0[r+1]);b=max3f(b,p0[r+2],p0[r+3]);a=max3f(a,p1[r],p1[r+1]);b=max3f(b,p1[r+2],p1[r+3]);}
  const float m=max2f(a,b);
  auto rr=__builtin_amdgcn_permlane32_swap(__float_as_uint(m),__float_as_uint(m),false,false);
  return max2f(__uint_as_float(rr[0]),__uint_as_float(rr[1]));
}
__device__ __forceinline__ void pv(f32x16*o,int vb,bf16x8 pa0,bf16x8 pa1,bf16x8 pa2,bf16x8 pa3){
  #pragma unroll
  for(int d0=0;d0<2;++d0){s16x4 lo[4],hi[4];
    #pragma unroll
    for(int ks=0;ks<4;++ks){
      asm volatile("ds_read_b64_tr_b16 %0,%1 offset:%c2":"=&v"(lo[ks]):"v"(vb),"i"(d0*4096+ks*1024):"memory");
      asm volatile("ds_read_b64_tr_b16 %0,%1 offset:%c2":"=&v"(hi[ks]):"v"(vb),"i"(d0*4096+ks*1024+512):"memory");}
    asm volatile("s_waitcnt lgkmcnt(0)":::"memory");SBAR();
    #define PK(k) (bf16x8){lo[k][0],lo[k][1],lo[k][2],lo[k][3],hi[k][0],hi[k][1],hi[k][2],hi[k][3]}
    o[d0]=__builtin_amdgcn_mfma_f32_32x32x16_bf16(pa0,PK(0),o[d0],0,0,0);
    o[d0]=__builtin_amdgcn_mfma_f32_32x32x16_bf16(pa1,PK(1),o[d0],0,0,0);
    o[d0]=__builtin_amdgcn_mfma_f32_32x32x16_bf16(pa2,PK(2),o[d0],0,0,0);
    o[d0]=__builtin_amdgcn_mfma_f32_32x32x16_bf16(pa3,PK(3),o[d0],0,0,0);
    #undef PK
  }
}

#ifndef ATTN_STORE16
#define ATTN_STORE16(p,v) (*(GAS u32x4*)(p)=(v))
#endif
__device__ __forceinline__ void stage_store(const f32x16 (&o)[2],bf16*Ow,int op,char*shm,int wid,int lane,int r32,int hi){
  bf16*stg=(bf16*)(shm+LDS_OST)+wid*2048;
  #pragma unroll
  for(int r=0;r<16;++r){const int orow=crow(r,hi);
    #pragma unroll
    for(int d0=0;d0<2;++d0)stg[orow*64+d0*32+r32]=__float2bfloat16(o[d0][r]);}
  asm volatile("s_waitcnt lgkmcnt(0)":::"memory");
  #pragma unroll
  for(int i=0;i<4;++i){const int row=i*8+(lane>>3),ch=lane&7; const u32x4 v=*(const u32x4*)(stg+row*64+ch*8); ATTN_STORE16(Ow+(long)row*op+ch*8,v);}
}
template<int THRL,int MODE,int DQ> __device__ __forceinline__ void attn_unit(const bf16*Qw0,int qp,const bf16*__restrict__ Kh,int kp,const bf16*__restrict__ Vh,int vp,int NT,bf16*Ow0,int op,char*shm,f32x16 (&oret)[2]){
  constexpr int NDS=DQ/16;
  const int tid=opaque_tid(),lane=tid&63,r32=lane&31,hi=lane>>5; const int wid=__builtin_amdgcn_readfirstlane(tid>>6);
  const bf16*Qw=Qw0+(long)(wid*QBLK)*qp;
  const unsigned lds0=(unsigned)(uintptr_t)shm;
  float*wsf=(float*)(shm+LDS_WS)+wid*64;
  const int kch=(DQ==64)?wid:(wid&3);
  const bf16*ksrc=Kh+(long)lane*kp+kch*8;
  const bf16*vsrc=Vh+(long)(16*(wid&3)+(lane>>2))*vp+(wid>>2)*32+(lane&3)*8;
  const unsigned kdst=lds0+LDS_K+kch*1024, vdst=lds0+LDS_V+wid*1024;
  #define DMA_K(t,slot) glds16(ksrc+(long)(t)*KVBLK*kp,(unsigned)__builtin_amdgcn_readfirstlane(kdst+(slot)))
  #define DMA_V(t,slot) glds16(vsrc+(long)(t)*KVBLK*vp,(unsigned)__builtin_amdgcn_readfirstlane(vdst+(slot)))
  const int vb0=(int)(lds0+LDS_V)+((lane>>4)&1)*32+(lane&3)*8+(4*hi+((lane&15)>>2))*64;
  const char*Kbase=shm+LDS_K; bf16x8 kf[8];
  const lds_cptr shm3=(lds_cptr)shm; const lds_cptr kp0=shm3+LDS_K+hi*1024+r32*16; const lds_cptr vp0=shm3+LDS_V+((lane>>4)&1)*32+(lane&3)*8+(4*hi+((lane&15)>>2))*64;
  DMA_K(0,0);DMA_V(0,0);DMA_K(1,SLOTB);
  bf16x8 qr[4];
  #pragma unroll
  for(int d0=0;d0<NDS;++d0)qr[d0]=*(const GAS bf16x8*)(&Qw[(long)r32*qp+d0*16+hi*8]);
  float mhat=0.f,l_reg=0.f;f32x16 o[2];o[0]=f32x16{};o[1]=f32x16{};f32x16 negm=f32x16{};asm volatile("":"+v"(negm));
  #define CMASK(P0,P1,t) do{}while(0)
  bool resc=false;
  #define START(P0,P1) do{ const float rm=rowmax(P0,P1); resc=false; \
    { const float dl=rm; mhat=fadd_s(mhat,dl); \
      _Pragma("unroll") for(int r=0;r<16;++r){P0[r]=fsub_s(P0[r],dl);P1[r]=fsub_s(P1[r],dl);} \
      _Pragma("unroll") for(int r=0;r<16;++r)negm[r]=-mhat; asm volatile("":"+v"(negm)); } \
    _Pragma("unroll") for(int r=0;r<16;++r)P0[r]=__builtin_amdgcn_exp2f(P0[r]); }while(0)
  #define RESC() do{ if(resc){ asm volatile("s_waitcnt lgkmcnt(0)":::"memory"); \
      _Pragma("unroll") for(int d_=0;d_<2;++d_) _Pragma("unroll") for(int r=0;r<16;++r)o[d_][r]*=wsf[crow(r,hi)]; } }while(0)
  f32x16 pA0,pA1,pB0,pB1;
  int sl_prev=0,sl_cur=0,sl_next=SLOTB;
  #define ROT() do{sl_prev=sl_cur;sl_cur=sl_next;sl_next=(sl_next==(NSLOT-1)*SLOTB)?0:sl_next+SLOTB;}while(0)
  DMA_K(2,2*SLOTB);
  WAIT_BAR(3);
  qkt<NDS>(pA0,pA1,Kbase,qr,negm,r32,hi);asm volatile("s_nop 15\n\ts_nop 7":"+v"(pA0),"+v"(pA1));CMASK(pA0,pA1,0);
  START(pA0,pA1);
  _Pragma("unroll") for(int r=0;r<16;++r)pA1[r]=__builtin_amdgcn_exp2f(pA1[r]);
  WAIT_BAR(0);
  DMA_K(3,0);DMA_V(1,SLOTB);
  ROT();
  if constexpr(DQ==64) kload8(kf,kp0+sl_cur); else { kload2(kf,kp0+sl_cur,0); kload2(kf,kp0+sl_cur,1); }
  WAIT_BAR(2);
  s16x4 vlo[8],vhi[8]; u32x4 pw0,pw1,pw2,pw3;
  #define PKW(P,B) cvtpk_s(P[B],P[B+1])
  #define PAF(k) __builtin_bit_cast(bf16x8,pw##k)
  #define VFR(i) (bf16x8){vlo[i][0],vlo[i][1],vlo[i][2],vlo[i][3],vhi[i][0],vhi[i][1],vhi[i][2],vhi[i][3]}
  #define PIN(x) asm volatile("":"+v"(x))
  #define MX3(a,b,c) __builtin_fmaxf(__builtin_fmaxf((a),(b)),(c))
  #define GAPA(MF,A0,A1,A2,A3,W0,W1,PW) do{ MF; sacc+=A0; sacc+=A1; sacc+=A2; sacc+=A3; PIN(sacc); W0; W1; PIN(PW); SBAR(); }while(0)
  #define EX(v) __builtin_amdgcn_exp2f(v)
  #define GAPB(MF,X,B) do{ MF; X[B]=EX(X[B]); X[B+1]=EX(X[B+1]); X[B+2]=EX(X[B+2]); X[B+3]=EX(X[B+3]); PIN(X); SBAR(); }while(0)
  #define VRD(i) do{ vlo[i]=vtr(vp_+(((i)>>2)*4096+((i)&3)*1024)); vhi[i]=vtr(vp_+(((i)>>2)*4096+((i)&3)*1024+512)); }while(0)
  #define KRD(G,j) do{ if(G){ kload2(kf,kp0+sl_next,j); SBAR(); } }while(0)
  #define STEP(C0,C1,P0,P1,t,GK,GV,GL) do{ SBAR(); \
    const lds_cptr vp_=vp0+sl_prev; \
    VRD(0); SBAR(); float sacc=(P0[0]+P0[1]); \
    GAPA(C0=__builtin_amdgcn_mfma_f32_32x32x16_bf16(kf[0],qr[0],negm,0,0,0), P0[2],P0[3],P0[4],P0[5],     pw0[0]=PKW(P0,0), pw0[1]=PKW(P0,2), pw0); \
    VRD(4); SBAR(); GAPA(C1=__builtin_amdgcn_mfma_f32_32x32x16_bf16(kf[1],qr[0],negm,0,0,0), P0[6],P0[7],P0[8],P0[9],     pw0[2]=PKW(P0,4), pw0[3]=PKW(P0,6), pw0); \
    VRD(1); SBAR(); GAPA(C0=__builtin_amdgcn_mfma_f32_32x32x16_bf16(kf[2],qr[1],C0,0,0,0),   P0[10],P0[11],P0[12],P0[13], pw1[0]=PKW(P0,8), pw1[1]=PKW(P0,10), pw1); \
    VRD(5); SBAR(); GAPA(C1=__builtin_amdgcn_mfma_f32_32x32x16_bf16(kf[3],qr[1],C1,0,0,0),   P0[14],P0[15],P1[0],P1[1],   pw1[2]=PKW(P0,12),pw1[3]=PKW(P0,14), pw1); \
    VRD(2); SBAR(); GAPA(if constexpr(DQ==64) C0=__builtin_amdgcn_mfma_f32_32x32x16_bf16(kf[4],qr[2],C0,0,0,0),   P1[2],P1[3],P1[4],P1[5],     pw2[0]=PKW(P1,0), pw2[1]=PKW(P1,2), pw2); \
    VRD(6); SBAR(); GAPA(if constexpr(DQ==64) C1=__builtin_amdgcn_mfma_f32_32x32x16_bf16(kf[5],qr[2],C1,0,0,0),   P1[6],P1[7],P1[8],P1[9],     pw2[2]=PKW(P1,4), pw2[3]=PKW(P1,6), pw2); \
    VRD(3); SBAR(); GAPA(if constexpr(DQ==64) C0=__builtin_amdgcn_mfma_f32_32x32x16_bf16(kf[6],qr[3],C0,0,0,0),   P1[10],P1[11],P1[12],P1[13], pw3[0]=PKW(P1,8), pw3[1]=PKW(P1,10), pw3); \
    VRD(7); SBAR(); GAPA(if constexpr(DQ==64) C1=__builtin_amdgcn_mfma_f32_32x32x16_bf16(kf[7],qr[3],C1,0,0,0),   P1[14],P1[15],0.f,0.f,       pw3[2]=PKW(P1,12),pw3[3]=PKW(P1,14), pw3); \
    l_reg+=sacc; \
    if(GK){DMA_K((t)+3,sl_cur);} if(GV){DMA_V((t)+1,sl_next);} \
    CMASK(C0,C1,t); \
    { float a=MX3(C0[0],C0[1],C1[0]),b=MX3(C0[2],C0[3],C1[1]); a=MX3(a,C1[2],C1[3]); \
      _Pragma("unroll") for(int r=4;r<16;r+=4){a=MX3(a,C0[r],C0[r+1]);b=MX3(b,C0[r+2],C0[r+3]);a=MX3(a,C1[r],C1[r+1]);b=MX3(b,C1[r+2],C1[r+3]);} \
      float rm=__builtin_fmaxf(a,b); { auto rr=__builtin_amdgcn_permlane32_swap(__float_as_uint(rm),__float_as_uint(rm),false,false); rm=__builtin_fmaxf(__uint_as_float(rr[0]),__uint_as_float(rr[1])); } \
      resc=false; \
      if(__builtin_expect(__any(rm>(float)THRL),0)){ const float dl=__builtin_fmaxf(rm,0.f); mhat+=dl; \
        _Pragma("unroll") for(int r=0;r<16;++r){C0[r]-=dl;C1[r]-=dl;} \
        _Pragma("unroll") for(int r=0;r<16;++r)negm[r]=-mhat; asm volatile("":"+v"(negm)); \
        const float f=__builtin_amdgcn_exp2f(-dl); l_reg*=f; if(hi==0)wsf[r32]=f; resc=true; } } \
    SBAR(); \
    GAPB(o[0]=__builtin_amdgcn_mfma_f32_32x32x16_bf16(PAF(0),VFR(0),o[0],0,0,0), C0,0); \
    GAPB(o[1]=__builtin_amdgcn_mfma_f32_32x32x16_bf16(PAF(0),VFR(4),o[1],0,0,0), C0,4); \
    KRD(GL,0); GAPB(o[0]=__builtin_amdgcn_mfma_f32_32x32x16_bf16(PAF(1),VFR(1),o[0],0,0,0), C0,8); \
    KRD(GL,1); GAPB(o[1]=__builtin_amdgcn_mfma_f32_32x32x16_bf16(PAF(1),VFR(5),o[1],0,0,0), C0,12); \
    if constexpr(DQ==64) KRD(GL,2); GAPB(o[0]=__builtin_amdgcn_mfma_f32_32x32x16_bf16(PAF(2),VFR(2),o[0],0,0,0), C1,0); \
    if constexpr(DQ==64) KRD(GL,3); GAPB(o[1]=__builtin_amdgcn_mfma_f32_32x32x16_bf16(PAF(2),VFR(6),o[1],0,0,0), C1,4); \
    GAPB(o[0]=__builtin_amdgcn_mfma_f32_32x32x16_bf16(PAF(3),VFR(3),o[0],0,0,0), C1,8); \
    GAPB(o[1]=__builtin_amdgcn_mfma_f32_32x32x16_bf16(PAF(3),VFR(7),o[1],0,0,0), C1,12); \
    }while(0)
  int t=1;
  #undef CMASK
  #define CMASK(P0,P1,t) do{}while(0)
  for(;t+5<NT;t+=2){
    STEP(pB0,pB1,pA0,pA1,t,true,true,true);     WAIT_BAR(2); RESC(); ROT();
    STEP(pA0,pA1,pB0,pB1,t+1,true,true,true);   WAIT_BAR(2); RESC(); ROT();
  }
  #undef CMASK
  #define CMASK(P0,P1,t) do{}while(0)
  #define ENDW(tt) do{ if((tt)+3<NT){WAIT_BAR(2);} else if((tt)+2<NT){WAIT_BAR(1);} else {WAIT_BAR(0);} }while(0)
  for(;t+1<NT;t+=2){
    STEP(pB0,pB1,pA0,pA1,t,(t+3<NT),(t+1<NT),(t+1<NT));       ENDW(t);   RESC(); ROT();
    STEP(pA0,pA1,pB0,pB1,t+1,(t+4<NT),(t+2<NT),(t+2<NT));     ENDW(t+1); RESC(); ROT();
  }
  STEP(pB0,pB1,pA0,pA1,NT-1,false,false,false); RESC();
  { float sacc=pB0[0]+pB0[1]; _Pragma("unroll") for(int r=2;r<16;++r)sacc+=pB0[r]; _Pragma("unroll") for(int r=0;r<16;++r)sacc+=pB1[r]; l_reg+=sacc;
    pw0=(u32x4){PKW(pB0,0),PKW(pB0,2),PKW(pB0,4),PKW(pB0,6)};pw1=(u32x4){PKW(pB0,8),PKW(pB0,10),PKW(pB0,12),PKW(pB0,14)};pw2=(u32x4){PKW(pB1,0),PKW(pB1,2),PKW(pB1,4),PKW(pB1,6)};pw3=(u32x4){PKW(pB1,8),PKW(pB1,10),PKW(pB1,12),PKW(pB1,14)};
    SBAR(); pv(o,vb0+sl_cur,PAF(0),PAF(1),PAF(2),PAF(3)); }
  #undef PKW
  #undef PAF
  #undef VFR
  #undef PIN
  #undef MX3
  #undef GAPA
  #undef GAPB
  #undef EX
  #undef VRD
  #undef KRD
  #undef STEP
  #undef ENDW
  {auto rr=__builtin_amdgcn_permlane32_swap(__float_as_uint(l_reg),__float_as_uint(l_reg),false,false);l_reg=__uint_as_float(rr[0])+__uint_as_float(rr[1]);}
  if(hi==0)wsf[32+r32]=l_reg;asm volatile("s_waitcnt lgkmcnt(0)":::"memory");
  float rli[16];
  #pragma unroll
  for(int r=0;r<16;++r)rli[r]=__builtin_amdgcn_rcpf(wsf[32+crow(r,hi)]);
  #pragma unroll
  for(int r=0;r<16;++r){o[0][r]*=rli[r];o[1][r]*=rli[r];}
  if constexpr(MODE==0){ bf16*Ow=Ow0+(long)(wid*QBLK)*op; stage_store(o,Ow,op,shm,wid,lane,r32,hi); }
  else { oret[0]=o[0]; oret[1]=o[1]; }
  asm volatile("s_waitcnt lgkmcnt(0)\n\ts_barrier":::"memory");
  #undef DMA_K
  #undef DMA_V
  #undef CMASK
  #undef START
  #undef RESC
  #undef ROT
}
#undef SBAR
#undef WAIT_BAR
}

struct AttnArgs { const bf16_t *QG, *QD, *KG, *VG, *KD, *VD, *CB, *PB; bf16_t* MIX; const float* conv_w; const float* conv_b; const float* subln_g; float lam, lam_init; float* dscr; };

__device__ __forceinline__ void attn_gqa_unit(const AttnArgs& A, LAS char* lds, char* lds_generic, int lat, int seq, int qh, int qb) {
    const long R = lat ? 8192L + (long)SLAT * seq : 256L * seq; const int S = lat ? SLAT : 256;
    const size_t grow0 = (lat ? 8192 + (size_t)4096 * seq : (size_t)256 * seq) + 256 * qb;
    const int kvh = qh >> 2;
    int NT = S / 64; asm volatile("" : "+s"(NT));
    typedef attn64::bf16 abf;
    f32x16 dummy[2];
    attn64::attn_unit<8, 0, 64>((const abf*)(A.QG + grow0 * 512 + 64 * qh), 512, (const abf*)(A.KG + (R * 2 + (long)kvh * S) * 64), 64, (const abf*)(A.VG + (R * 2 + (long)kvh * S) * 64), 64, NT,
                                (abf*)(A.MIX + grow0 * 1024 + 64 * qh), 1024, lds_generic, dummy);
}
__device__ __forceinline__ void attn_diff_unit(const AttnArgs& A, LAS char* lds, char* lds_generic, int lat, int seq, int hd, int qb) {
    const int tid_ = opaque_tid(); const int wave = __builtin_amdgcn_readfirstlane(tid_ >> 6), lane = tid_ & 63, r32 = lane & 31, h = lane >> 5;
    const long R = lat ? 8192L + (long)SLAT * seq : 256L * seq; const int S = lat ? SLAT : 256;
    const size_t grow0 = (lat ? 8192 + (size_t)4096 * seq : (size_t)256 * seq) + 256 * qb;
    int NT = S / 64; asm volatile("" : "+s"(NT));
    typedef attn64::bf16 abf;
    const abf* V = (const abf*)(A.VD + (R * 4 + (long)hd * S) * 64);
    f32x16 oa[2], ob[2];
    attn64::attn_unit<8, 1, 32>((const abf*)(A.QD + grow0 * 256 + 64 * hd), 256, (const abf*)(A.KD + (R * 8 + (long)(hd * 2) * S) * 32), 32, V, 64, NT, (abf*)nullptr, 0, lds_generic, oa);
    GAS float* scr = (GAS float*)A.dscr + ((size_t)(blockIdx.x * 8 + wave) * 32) * 64 + lane;
#pragma unroll
    for (int d0 = 0; d0 < 2; ++d0)
#pragma unroll
        for (int r = 0; r < 16; ++r) scr[(d0 * 16 + r) * 64] = oa[d0][r];
    attn64::attn_unit<8, 1, 32>((const abf*)(A.QD + grow0 * 256 + 64 * hd + 32), 256, (const abf*)(A.KD + (R * 8 + (long)(hd * 2 + 1) * S) * 32), 32, V, 64, NT, (abf*)nullptr, 0, lds_generic, ob);
    float ss[16];
#pragma unroll
    for (int r = 0; r < 16; ++r) {
        const float v0 = scr[r * 64] - A.lam * ob[0][r], v1 = scr[(16 + r) * 64] - A.lam * ob[1][r];
        ob[0][r] = v0; ob[1][r] = v1; ss[r] = v0 * v0 + v1 * v1;
    }
#pragma unroll
    for (int o = 1; o < 32; o <<= 1)
#pragma unroll
        for (int r = 0; r < 16; ++r) ss[r] += __shfl_xor(ss[r], o);
    const float g0 = A.subln_g[r32], g1 = A.subln_g[32 + r32], sc = 1.f - A.lam_init;
#pragma unroll
    for (int r = 0; r < 16; ++r) { const float rstd = rsqrtf(ss[r] * (1.f / 64.f) + EPS) * sc; ob[0][r] *= rstd * g0; ob[1][r] *= rstd * g1; }
    attn64::stage_store(ob, (abf*)(A.MIX + (grow0 + 32 * wave) * 1024 + 768 + 64 * hd), 1024, lds_generic, wave, lane, r32, h);
}

__device__ __forceinline__ void attn_phase(const AttnArgs& A, LAS char* lds, char* lds_generic, int G) {
    for (int u = blockIdx.x; u < 2048; u += G) {
        if (u < 512) { const int b = u & 7, r = u >> 3; attn_diff_unit(A, lds, lds_generic, 1, b, r >> 4, r & 15); }
        else if (u < 1536) { const int v = u - 512, b = v & 7, r = v >> 3; attn_gqa_unit(A, lds, lds_generic, 1, b, r & 7, r >> 3); }
        else { const int v = u - 1536;
            if (v < 128) attn_diff_unit(A, lds, lds_generic, 0, v >> 2, v & 3, 0);
            else if (v < 256) { const int w = 2 * (v - 128); attn_gqa_unit(A, lds, lds_generic, 0, w >> 3, w & 7, 0); }
            else if (v >= 384) { const int w = 2 * (v - 384) + 1; attn_gqa_unit(A, lds, lds_generic, 0, w >> 3, w & 7, 0); } }
    }
    const int tid_c = opaque_tid();
    for (int idx = blockIdx.x * 512 + tid_c; idx < M_ALL * 32; idx += G * 512) {
        const int row = idx >> 5, c8 = (idx & 31) * 8;
        int t, S; if (row < M_CTX) { t = row & 255; S = 256; } else { t = (row - M_CTX) & 4095; S = 4096; }
        const u32x4 z = {0, 0, 0, 0};
        const u32x4 pc = *(const GAS u32x4*)(A.PB + (size_t)row * 256 + c8);
        const u32x4 pp = t > 0 ? *(const GAS u32x4*)(A.PB + (size_t)(row - 1) * 256 + c8) : z;
        const u32x4 pn = t < S - 1 ? *(const GAS u32x4*)(A.PB + (size_t)(row + 1) * 256 + c8) : z;
        const u32x4 cb = *(const GAS u32x4*)(A.CB + (size_t)row * 256 + c8);
        float res[8];
#pragma unroll
        for (int j = 0; j < 8; ++j) {
            const int sh = (j & 1) * 16;
            const float a = __uint_as_float(((pp[j >> 1] >> sh) & 0xffffu) << 16), b = __uint_as_float(((pc[j >> 1] >> sh) & 0xffffu) << 16), c = __uint_as_float(((pn[j >> 1] >> sh) & 0xffffu) << 16);
            const float g = __uint_as_float(((cb[j >> 1] >> sh) & 0xffffu) << 16);
            const int cc = c8 + j;
            res[j] = g * (A.conv_w[cc] * a + A.conv_w[256 + cc] * b + A.conv_w[512 + cc] * c + A.conv_b[cc]);
        }
        u32x4 w; w.x = cvtpk(res[0], res[1]); w.y = cvtpk(res[2], res[3]); w.z = cvtpk(res[4], res[5]); w.w = cvtpk(res[6], res[7]);
        *(GAS u32x4*)(A.MIX + (size_t)row * 1024 + 512 + c8) = w;
    }
}

__device__ __forceinline__ int sigma_map(int type, int i) {
    if (type == 1) return 8 * ((i >> 2) & 3) + 4 * (i >> 4) + (i & 3);
    if (type == 2) return 16 * ((i >> 3) & 1) + 8 * (i >> 4) + (i & 7);
    return i;
}
__device__ __forceinline__ void in_group(int g, int& Lbase, int& type) {
    const int pn = g >> 3, bj = (g >> 2) & 1, wc = g & 3;
    if (pn < 2) { Lbase = 64 * (4 * pn + wc) + 32 * bj; type = 0; }
    else if (pn == 2) { Lbase = (wc < 2 ? 512 + 64 * wc : 640 + 64 * (wc - 2)) + 32 * bj; type = wc < 2 ? 0 : 1; }
    else if (pn == 3) { Lbase = 768 + 128 * bj + 32 * wc; type = 1; }
    else if (pn < 6) { Lbase = 1024 + 256 * bj + 128 * (pn - 4) + 32 * wc; type = 1; }
    else if (pn < 8) { Lbase = (pn == 6 ? 1536 : 1792) + 64 * wc + 32 * bj; type = 2; }
    else { Lbase = 2048 + 64 * wc + 32 * bj; type = 1; }
}
__device__ __forceinline__ void transpose_item(const float* W, int K, int N, bf16_t* WT, int k0, int nphys0, int Lbase, int type, LAS float* scr, int lane) {
#pragma unroll 8
    for (int i = 0; i < 32; ++i) { const int kk = 2 * i + (lane >> 5); scr[kk * 33 + (lane & 31)] = ((const GAS float*)W)[(size_t)(k0 + kk) * N + Lbase + (lane & 31)]; }
    asm volatile("s_waitcnt lgkmcnt(0)" ::: "memory");
    const int c = lane & 7;
#pragma unroll
    for (int j = 0; j < 4; ++j) { const int n = (lane >> 3) + 8 * j; const LAS float* s = scr + (8 * c) * 33 + sigma_map(type, n);
        u32x4 o; o.x = cvtpk(s[0 * 33], s[1 * 33]); o.y = cvtpk(s[2 * 33], s[3 * 33]); o.z = cvtpk(s[4 * 33], s[5 * 33]); o.w = cvtpk(s[6 * 33], s[7 * 33]);
        *(GAS u32x4*)(WT + (size_t)(nphys0 + n) * K + k0 + 8 * c) = o; }
    asm volatile("s_waitcnt lgkmcnt(0)" ::: "memory");
}

struct Params {
    const float *x_prompt, *x_sample, *cache_gk, *cache_gv, *cache_dk, *cache_dv, *c, *c_ctx;
    const float *w_mod, *b_mod, *norm1_g, *w_in, *gqa_qn_g, *gqa_kn_g, *conv_w, *conv_b, *diff_qn_g, *diff_kn_g, *diff_lambda, *diff_subln_g, *w_out, *norm2_g, *ffn_up, *ffn_conv_w, *ffn_conv_b, *ffn_down;
    float* out; unsigned char* ws;
    float lam_init[4];
    int ph_lo, ph_hi;
};

__device__ __forceinline__ void prologue(const Params& P, LAS unsigned char* lds, int G) {
    const int tid = opaque_tid(), lane = tid & 63, wave = __builtin_amdgcn_readfirstlane(tid >> 6);
    float* MODS = (float*)(P.ws + WS_MODS); float* MISC = (float*)(P.ws + WS_MISC);
    if ((int)blockIdx.x < 384) {
        LAS float* sc = (LAS float*)lds;
        LAS float* part = (LAS float*)(lds + 49152);
        for (int i = tid; i < NCOND * 1024; i += 512) { const int ci = i >> 10, k = i & 1023; const float v = ci == 0 ? P.c_ctx[k] : P.c[(ci - 1) * 1024 + k]; sc[k * 12 + ci] = v / (1.f + __expf(-v)); }
        __syncthreads();
        for (int it = blockIdx.x; it < 384; it += G) {
            const int l = it / 96, col = (it % 96) * 64 + lane;
            const float* w = P.w_mod + (size_t)l * 1024 * 6144 + col;
            float acc[NCOND];
#pragma unroll
            for (int ci = 0; ci < NCOND; ++ci) acc[ci] = 0.f;
#pragma unroll 8
            for (int kk = 0; kk < 128; ++kk) { const int k = wave * 128 + kk; const float wv = ((const GAS float*)w)[(size_t)k * 6144];
                const f32x4 s0 = *(LAS f32x4*)(sc + k * 12), s1 = *(LAS f32x4*)(sc + k * 12 + 4); const float s8 = sc[k * 12 + 8];
                acc[0] += s0[0] * wv; acc[1] += s0[1] * wv; acc[2] += s0[2] * wv; acc[3] += s0[3] * wv; acc[4] += s1[0] * wv; acc[5] += s1[1] * wv; acc[6] += s1[2] * wv; acc[7] += s1[3] * wv; acc[8] += s8 * wv; }
#pragma unroll
            for (int ci = 0; ci < NCOND; ++ci) part[(wave * NCOND + ci) * 64 + lane] = acc[ci];
            __syncthreads();
            for (int i = tid; i < NCOND * 64; i += 512) { const int ci = i >> 6, cc = i & 63; float s = 0.f;
#pragma unroll
                for (int w8 = 0; w8 < 8; ++w8) s += part[(w8 * NCOND + ci) * 64 + cc];
                const int j = (it % 96) * 64 + cc; MODS[((size_t)l * NCOND + ci) * 6144 + j] = s + P.b_mod[l * 6144 + j]; }
            __syncthreads();
        }
    }
    if ((int)blockIdx.x == G - 1) {
        if (tid < 4) { const float* lf = P.diff_lambda + tid * 128; float s1 = 0.f, s2 = 0.f; for (int i = 0; i < 32; ++i) { s1 += lf[i] * lf[32 + i]; s2 += lf[64 + i] * lf[96 + i]; }
            MISC[MI_LAM + tid] = expf(s1) - expf(s2) + P.lam_init[tid]; }
        for (int i = tid; i < 1024; i += 512) { const int pos = i >> 4, idx = i & 15; const float fr = powf(10000.f, -(float)idx / 16.f); const float ang = (float)pos * fr; MISC[MI_R64C + i] = cosf(ang); MISC[MI_R64S + i] = sinf(ang); }
        for (int i = tid; i < 512; i += 512) { const int pos = i >> 3, idx = i & 7; const float fr = powf(10000.f, -(float)idx / 8.f); const float ang = (float)pos * fr; MISC[MI_R32C + i] = cosf(ang); MISC[MI_R32S + i] = sinf(ang); }
    }
    __syncthreads();
    LAS float* scr = (LAS float*)(lds + wave * 16384);
    const int gw = blockIdx.x * 8 + wave, NGW = G * 8;
    constexpr int I_IN = 16 * 72, I_OUT = 16 * 32, I_UP = 16 * 176, I_DN = 44 * 32, I_L = I_IN + I_OUT + I_UP + I_DN;
    for (int it = gw; it < DEPTH * I_L; it += NGW) {
        const int l = it / I_L; int r = it % I_L;
        if (r < I_IN) { const int kb = r / 72, g = r % 72; int Lb, ty; in_group(g, Lb, ty);
            transpose_item(P.w_in + (size_t)l * 1024 * INW, 1024, INW, (bf16_t*)(P.ws + WS_WIN) + (size_t)l * INW * 1024, kb * 64, g * 32, Lb, ty, scr, lane); continue; }
        r -= I_IN;
        if (r < I_OUT) { const int kb = r / 32, g = r % 32;
            transpose_item(P.w_out + (size_t)l * 1024 * 1024, 1024, 1024, (bf16_t*)(P.ws + WS_WOUT) + (size_t)l * 1024 * 1024, kb * 64, g * 32, g * 32, 0, scr, lane); continue; }
        r -= I_OUT;
        if (r < I_UP) { const int kb = r / 176, g = r % 176; const int pn = g >> 3, bj = (g >> 2) & 1, wc = g & 3;
            transpose_item(P.ffn_up + (size_t)l * 1024 * UPW, 1024, UPW, (bf16_t*)(P.ws + WS_WUP) + (size_t)l * UPW * 1024, kb * 64, g * 32, bj * DFF + 128 * pn + 32 * wc, 1, scr, lane); continue; }
        r -= I_UP;
        { const int kb = r / 32, g = r % 32;
            transpose_item(P.ffn_down + (size_t)l * DFF * 1024, DFF, 1024, (bf16_t*)(P.ws + WS_WDN) + (size_t)l * 1024 * DFF, kb * 64, g * 32, g * 32, 0, scr, lane); }
    }
}

__device__ __forceinline__ void norm_phase(const float* xin_ctx, const float* xin_lat, const bf16_t* xin_b  , const float* ng, const float* mods_l  , int sh_idx, bf16_t* XN, int G) {
    const int tid_ = opaque_tid(); const int lane = tid_ & 63, wave = __builtin_amdgcn_readfirstlane(tid_ >> 6);
    const int nw = G * 8, gw = blockIdx.x * 8 + wave;
    const int per = (M_ALL + nw - 1) / nw;
    const int r0 = gw * per, r1 = min(r0 + per, M_ALL);
    int cur_ci = -1; f32x4 Aa[4], Bb[4];
    f32x4 v[4], vn[4];
#define NORM_LOAD_ROW(R_) do { const int rr_ = (R_); \
        if (xin_b) { _Pragma("unroll") for (int jj = 0; jj < 2; ++jj) { const u32x4 q_ = *(const GAS u32x4*)(xin_b + (size_t)rr_ * DM + 8 * lane + 512 * jj); \
                vn[2 * jj] = (f32x4){__uint_as_float(q_.x << 16), __uint_as_float(q_.x & 0xffff0000u), __uint_as_float(q_.y << 16), __uint_as_float(q_.y & 0xffff0000u)}; \
                vn[2 * jj + 1] = (f32x4){__uint_as_float(q_.z << 16), __uint_as_float(q_.z & 0xffff0000u), __uint_as_float(q_.w << 16), __uint_as_float(q_.w & 0xffff0000u)}; } } \
        else { const float* xr_ = rr_ < M_CTX ? xin_ctx + (size_t)rr_ * DM : xin_lat + (size_t)(rr_ - M_CTX) * DM; \
            _Pragma("unroll") for (int jj = 0; jj < 2; ++jj) { vn[2 * jj] = *(const GAS f32x4*)(xr_ + 8 * lane + 512 * jj); vn[2 * jj + 1] = *(const GAS f32x4*)(xr_ + 8 * lane + 512 * jj + 4); } } } while (0)
    if (r0 < r1) NORM_LOAD_ROW(r0);
    for (int row = r0; row < r1; ++row) {
#pragma unroll
        for (int j = 0; j < 4; ++j) v[j] = vn[j];
        if (row + 1 < r1) NORM_LOAD_ROW(row + 1);
        const int ci = row < M_CTX ? 0 : 1 + ((row - M_CTX) >> 12);
        if (ci != cur_ci) { cur_ci = ci; const float* sh = mods_l + ci * 6144 + sh_idx * 1024; const float* sc = sh + 1024;
#pragma unroll
            for (int j = 0; j < 4; ++j) { const int c = 8 * lane + 512 * (j >> 1) + 4 * (j & 1); const f32x4 g4 = *(const GAS f32x4*)(ng + c), s4 = *(const GAS f32x4*)(sc + c); Aa[j] = g4 * (1.f + s4); Bb[j] = *(const GAS f32x4*)(sh + c); } }
        float s = 0.f;
#pragma unroll
        for (int j = 0; j < 4; ++j) s += (v[j][0] * v[j][0] + v[j][1] * v[j][1]) + (v[j][2] * v[j][2] + v[j][3] * v[j][3]);
#pragma unroll
        for (int o = 1; o < 64; o <<= 1) s += __shfl_xor(s, o);
        const float rstd = rsqrtf(s * (1.f / DM) + EPS);
#pragma unroll
        for (int jj = 0; jj < 2; ++jj) { const f32x4 y0 = v[2 * jj] * rstd * Aa[2 * jj] + Bb[2 * jj], y1 = v[2 * jj + 1] * rstd * Aa[2 * jj + 1] + Bb[2 * jj + 1];
            u32x4 w; w.x = cvtpk(y0[0], y0[1]); w.y = cvtpk(y0[2], y0[3]); w.z = cvtpk(y1[0], y1[1]); w.w = cvtpk(y1[2], y1[3]);
            *(GAS u32x4*)(XN + (size_t)row * DM + 8 * lane + 512 * jj) = w; }
    }
#undef NORM_LOAD_ROW
}

__device__ __forceinline__ void cache_phase(const Params& P, int l, int G) {
    bf16_t* KG = (bf16_t*)(P.ws + WS_KG); bf16_t* VG = (bf16_t*)(P.ws + WS_VG); bf16_t* KD = (bf16_t*)(P.ws + WS_KD); bf16_t* VD = (bf16_t*)(P.ws + WS_VD);
    const int tid_ = opaque_tid();
    for (int i = blockIdx.x * 512 + tid_; i < 65536; i += G * 512) {
        const int d4 = (i & 15) * 4, kvh = (i >> 4) & 1, p = (i >> 5) & 255, b = i >> 13;
        const size_t src = ((((size_t)b * 4 + l) * 256 + p) * 2 + kvh) * 64 + d4;
        const size_t dst = (((8192L + (long)SLAT * b) * 2 + (long)kvh * SLAT + 4096 + p) * 64);
        const int pk4 = (d4 & 32) | ((d4 & 12) << 1) | ((d4 & 16) >> 2);
        const f32x4 k = *(const GAS f32x4*)(P.cache_gk + src), v = *(const GAS f32x4*)(P.cache_gv + src);
        u32x2 wk, wv; wk.x = cvtpk(k[0], k[1]); wk.y = cvtpk(k[2], k[3]); wv.x = cvtpk(v[0], v[1]); wv.y = cvtpk(v[2], v[3]);
        *(GAS u32x2*)(KG + dst + pk4) = wk; *(GAS u32x2*)(VG + dst + d4) = wv;
    }
    for (int i = blockIdx.x * 512 + tid_; i < 131072; i += G * 512) {
        { const int d4 = (i & 7) * 4, hc = (i >> 3) & 7, p = (i >> 6) & 255, b = i >> 14;
          const size_t src = ((((size_t)b * 4 + l) * 256 + p) * 8 + hc) * 32 + d4;
          const size_t dst = (((8192L + (long)SLAT * b) * 8 + (long)hc * SLAT + 4096 + p) * 32) + ((d4 & 16) | ((d4 & 4) << 1) | ((d4 & 8) >> 1));
          const f32x4 k = *(const GAS f32x4*)(P.cache_dk + src); u32x2 w; w.x = cvtpk(k[0], k[1]); w.y = cvtpk(k[2], k[3]); *(GAS u32x2*)(KD + dst) = w; }
        { const int d4 = (i & 15) * 4, hh = (i >> 4) & 3, p = (i >> 6) & 255, b = i >> 14;
          const size_t src = ((((size_t)b * 4 + l) * 256 + p) * 4 + hh) * 64 + d4;
          const size_t dst = (((8192L + (long)SLAT * b) * 4 + (long)hh * SLAT + 4096 + p) * 64) + d4;
          const f32x4 v = *(const GAS f32x4*)(P.cache_dv + src); u32x2 w; w.x = cvtpk(v[0], v[1]); w.y = cvtpk(v[2], v[3]); *(GAS u32x2*)(VD + dst) = w; }
    }
}

__device__ __forceinline__ void fixup_own_panels(const pg8::StaticOrder& S, const float* cw, bf16_t* F, const float* EP, const float* EA, const float* EU) {
    const int tid_ = opaque_tid();
    pg8::Unit u;
    for (int i = 0; S.next(i, u); ++i) {
        const int pm = u.pm; if (pm < 32) continue;
        const int j = (pm - 32) & 15;
        for (int e = 0; e < 2; ++e) {
            if (e == 0 ? j == 0 : j == 15) continue;
            const size_t eb = ((size_t)pm * 2 + e) * DFF, nb = e == 0 ? ((size_t)(pm - 1) * 2 + 1) * DFF : ((size_t)(pm + 1) * 2 + 0) * DFF;
            const float* w = cw + (e == 0 ? 0 : 2 * DFF);
            const size_t row = (size_t)pm * 256 + (e ? 255 : 0);
            for (int c = tid_ * 2; c < DFF; c += 1024) {
                const f32x2 p = *(const GAS f32x2*)(EP + eb + c), a = *(const GAS f32x2*)(EA + nb + c), uu = *(const GAS f32x2*)(EU + eb + c), ww = *(const GAS f32x2*)(w + c);
                const float f0 = silu_f(p[0] + ww[0] * a[0]) * uu[0], f1 = silu_f(p[1] + ww[1] * a[1]) * uu[1];
                *(GAS unsigned*)(F + row * DFF + c) = cvtpk(f0, f1);
            }
        }
    }
    asm volatile("s_waitcnt vmcnt(0)" ::: "memory");
    __syncthreads();
}
__device__ __forceinline__ void fixup_phase(const float* cw, bf16_t* F, const float* EP, const float* EA, const float* EU, int G) {
    const int tid_ = opaque_tid();
    for (int i = blockIdx.x * 512 + tid_; i < 128 * 2 * DFF; i += G * 512) {
        const int c = i % DFF, e = (i / DFF) & 1, pm = 32 + i / (2 * DFF); const int j = (pm - 32) & 15;
        if (e == 0 ? j == 0 : j == 15) continue;
        const size_t eo = ((size_t)pm * 2 + e) * DFF + c;
        float conv;
        if (e == 0) conv = EP[eo] + cw[c] * EA[((size_t)(pm - 1) * 2 + 1) * DFF + c];
        else conv = EP[eo] + cw[2 * DFF + c] * EA[((size_t)(pm + 1) * 2 + 0) * DFF + c];
        const float f = silu_f(conv) * EU[eo];
        const size_t row = (size_t)pm * 256 + (e ? 255 : 0);
        F[row * DFF + c] = (bf16_t)(cvtpk(f, 0.f) & 0xffffu);
    }
}


#define XB_TMO      128
#define XB_XCNT(j)  (256  + 64 * (j))
#define XB_XSUB(j)  (1280 + 64 * (j))
#define XB_XGEN(j)  (2304 + 64 * (j))
#define XB_TOP      3328
#define XB_TOPGEN   3392
#define XCD_BAR_WORDS 3456
#define XB_SPIN_CAP (1u << 22)
__device__ __forceinline__ unsigned xb_ld(unsigned* p)              { return __hip_atomic_load(p, __ATOMIC_RELAXED, __HIP_MEMORY_SCOPE_AGENT); }
__device__ __forceinline__ unsigned xb_add(unsigned* p, unsigned v) { return __hip_atomic_fetch_add(p, v, __ATOMIC_RELAXED, __HIP_MEMORY_SCOPE_AGENT); }
__device__ __forceinline__ unsigned xb_xcc_id() { return (unsigned)__builtin_amdgcn_s_getreg((3 << 11) | 20) & 0xFu; }
#define XB_SPIN(cond, bar) do { unsigned _sp = 0; while (cond) { __builtin_amdgcn_s_sleep(1); \
    if ((++_sp & 255u) == 0u) { if (xb_ld(&(bar)[XB_TMO])) break; if (_sp > XB_SPIN_CAP) { atomicAdd(&(bar)[XB_TMO], 1u); break; } } } } while (0)
struct XcdBarrier { unsigned* bar; unsigned x; volatile LAS unsigned* st; };
__device__ __forceinline__ XcdBarrier xcd_barrier_post(unsigned* bar, volatile LAS unsigned* st) {
    XcdBarrier b; b.bar = bar; b.x = xb_xcc_id(); b.st = st;
    if (threadIdx.x == 0) (void)xb_add(&bar[XB_XCNT(b.x)], 1u);
    return b;
}
__device__ __forceinline__ void xcd_barrier_complete(unsigned* bar, unsigned x, unsigned& nloc, unsigned& nx) {
    const unsigned G = gridDim.x * gridDim.y * gridDim.z;
    unsigned sum, cnt, mine, sp = 0u;
    for (;;) {
        sum = 0u; cnt = 0u; mine = 0u;
#pragma unroll
        for (unsigned j = 0; j < 16; ++j) { const unsigned c = xb_ld(&bar[XB_XCNT(j)]); sum += c; cnt += (c > 0u) ? 1u : 0u; mine = (j == x) ? c : mine; }
        if (sum == G) break;
        __builtin_amdgcn_s_sleep(1);
        if ((++sp & 255u) == 0u) { if (xb_ld(&bar[XB_TMO])) break; if (sp > XB_SPIN_CAP) { atomicAdd(&bar[XB_TMO], 1u); break; } }
    }
    nloc = mine > 0u ? mine : 1u; nx = cnt > 0u ? cnt : 1u;
}
__device__ __forceinline__ void xcd_barrier(const XcdBarrier& b) {
    asm volatile("s_waitcnt vmcnt(0)" ::: "memory");
    __syncthreads();
    if (threadIdx.x == 0) {
        unsigned* bar = b.bar;
        __builtin_amdgcn_s_waitcnt(0);
        unsigned nloc = b.st[0], nx = b.st[1];
        if (nloc == 0u) { xcd_barrier_complete(bar, b.x, nloc, nx); b.st[0] = nloc; b.st[1] = nx; }
        const unsigned old = xb_add(&bar[XB_XSUB(b.x)], 1u);
        const unsigned gen = old / nloc;
        if (old + 1u == (gen + 1u) * nloc) {
            __builtin_amdgcn_fence(__ATOMIC_RELEASE, "agent");
            asm volatile("s_waitcnt vmcnt(0)" ::: "memory");
            const unsigned og = xb_add(&bar[XB_TOP], 1u);
            const unsigned tg = og / nx;
            if (og + 1u == (tg + 1u) * nx) xb_add(&bar[XB_TOPGEN], 1u);
            else XB_SPIN(xb_ld(&bar[XB_TOPGEN]) == tg, bar);
            __builtin_amdgcn_fence(__ATOMIC_ACQUIRE, "agent");
            xb_add(&bar[XB_XGEN(b.x)], 1u);
            asm volatile("s_waitcnt vmcnt(0)" ::: "memory");
        } else {
            XB_SPIN(xb_ld(&bar[XB_XGEN(b.x)]) == gen, bar);
            __builtin_amdgcn_fence(__ATOMIC_ACQUIRE, "agent");
            asm volatile("s_waitcnt vmcnt(0)" ::: "memory");
        }
    }
    __syncthreads();
}

__global__ void __launch_bounds__(512, 2) fwd_kernel(Params P) {
    extern __shared__ __attribute__((aligned(16))) unsigned char lds_raw[];
    LAS unsigned char* lds = (LAS unsigned char*)lds_raw;
    cg::grid_group grid = cg::this_grid();
    const int G = gridDim.x;
    volatile LAS unsigned* bst = (volatile LAS unsigned*)(lds + MISC_OFF);
    if (threadIdx.x < 2) bst[threadIdx.x] = 0u;
    __syncthreads();
    XcdBarrier bar = xcd_barrier_post((unsigned*)(P.ws + WS_CTL), bst);
    int ph = 0;
#define PHASE_BEGIN if (ph >= P.ph_lo && ph < P.ph_hi) { unsigned char* ws = P.ws; float* outp = P.out; asm volatile("" : "+s"(ws), "+s"(outp));
#define PHASE_END   if (ph + 1 < P.ph_hi) { if (ph == 0) grid.sync(); else xcd_barrier(bar); } } ++ph;
    PHASE_BEGIN
#ifndef SKIP_PRO
        prologue(P, lds, G);
#endif
    PHASE_END
    for (int l = 0; l < DEPTH; ++l) {
        PHASE_BEGIN
            const float* xin_ctx = l == 0 ? P.x_prompt : outp; const float* xin_lat = l == 0 ? P.x_sample : outp + (size_t)M_CTX * DM;
            norm_phase(P.x_prompt, P.x_sample, l == 0 ? (const bf16_t*)nullptr : (const bf16_t*)(ws + WS_XB), P.norm1_g + l * DM, (const float*)(ws + WS_MODS) + (size_t)l * NCOND * 6144, 0, (bf16_t*)(ws + WS_XN), G);
            cache_phase(P, l, G);
        PHASE_END
        PHASE_BEGIN {
            const float* MISC = (const float*)(ws + WS_MISC);
            pg8::Gemm g{(const bf16_t*)(ws + WS_XN), (const bf16_t*)(ws + WS_WIN) + (size_t)l * INW * 1024, M_ALL, INW, 1024}; pg8::StaticOrder S; S.init(M_ALL, INW, G, blockIdx.x);
            EpiIn E{l, P.gqa_qn_g + l * 64, P.gqa_kn_g + l * 64, P.diff_qn_g + l * 32, P.diff_kn_g + l * 32, MISC + MI_R64C, MISC + MI_R64S, MISC + MI_R32C, MISC + MI_R32S,
                    (bf16_t*)(ws + WS_QG), (bf16_t*)(ws + WS_QD), (bf16_t*)(ws + WS_KG), (bf16_t*)(ws + WS_VG), (bf16_t*)(ws + WS_KD), (bf16_t*)(ws + WS_VD), (bf16_t*)(ws + WS_CB), (bf16_t*)(ws + WS_PB), outp};
#ifndef SKIP_IN
            pg8::gemm_phase(lds, lds + XCH_OFF, g, S, E);
#endif
        } PHASE_END
        PHASE_BEGIN {
            const float* MISC = (const float*)(ws + WS_MISC);
            AttnArgs A{(const bf16_t*)(ws + WS_QG), (const bf16_t*)(ws + WS_QD), (const bf16_t*)(ws + WS_KG), (const bf16_t*)(ws + WS_VG), (const bf16_t*)(ws + WS_KD), (const bf16_t*)(ws + WS_VD),
                       (const bf16_t*)(ws + WS_CB), (const bf16_t*)(ws + WS_PB), (bf16_t*)(ws + WS_XN), P.conv_w + l * 768, P.conv_b + l * 256, P.diff_subln_g + l * 64, MISC[MI_LAM + l], P.lam_init[l], (float*)(ws + WS_DSCR)};
#ifndef SKIP_ATT
            attn_phase(A, (LAS char*)lds, (char*)lds_raw, G);
#endif
        } PHASE_END
        PHASE_BEGIN {
            const float* xin_ctx = l == 0 ? P.x_prompt : outp; const float* xin_lat = l == 0 ? P.x_sample : outp + (size_t)M_CTX * DM;
            pg8::Gemm g{(const bf16_t*)(ws + WS_XN), (const bf16_t*)(ws + WS_WOUT) + (size_t)l * 1024 * 1024, M_ALL, 1024, 1024}; pg8::StaticOrder S; S.init(M_ALL, 1024, G, blockIdx.x);
            EpiRes E{P.x_prompt, P.x_sample, outp, (const float*)(ws + WS_MODS) + (size_t)l * NCOND * 6144 + 2 * 1024, l == 0 ? (const bf16_t*)nullptr : (const bf16_t*)(ws + WS_XB), (bf16_t*)(ws + WS_XB)};
#ifndef SKIP_RES
            pg8::gemm_phase(lds, lds + XCH_OFF, g, S, E);
#endif
        } PHASE_END
        PHASE_BEGIN
            norm_phase(nullptr, nullptr, (const bf16_t*)(ws + WS_XB), P.norm2_g + l * DM, (const float*)(ws + WS_MODS) + (size_t)l * NCOND * 6144, 3, (bf16_t*)(ws + WS_XN), G);
        PHASE_END
        PHASE_BEGIN {
            float* EPb = (float*)(ws + WS_EDGE);
            pg8::Gemm g{(const bf16_t*)(ws + WS_XN), (const bf16_t*)(ws + WS_WUP) + (size_t)l * UPW * 1024, M_ALL, UPW, 1024}; pg8::StaticOrder S; S.init(M_ALL, UPW, G, blockIdx.x);
            EpiUp E{P.ffn_conv_w + (size_t)l * 3 * DFF, P.ffn_conv_b + (size_t)l * DFF, (bf16_t*)(ws + WS_U), EPb, EPb + EDGE_ELEMS, EPb + 2 * EDGE_ELEMS};
#ifndef SKIP_UP
            pg8::gemm_phase(lds, lds + XCH_OFF, g, S, E);
#endif
        } PHASE_END
        PHASE_BEGIN {
            pg8::Gemm g{(const bf16_t*)(ws + WS_U), (const bf16_t*)(ws + WS_WDN) + (size_t)l * 1024 * DFF, M_ALL, 1024, DFF}; pg8::StaticOrder S; S.init(M_ALL, 1024, G, blockIdx.x);
            { float* EPb = (float*)(ws + WS_EDGE); fixup_own_panels(S, P.ffn_conv_w + (size_t)l * 3 * DFF, (bf16_t*)(ws + WS_U), EPb, EPb + EDGE_ELEMS, EPb + 2 * EDGE_ELEMS); }
            EpiRes E{nullptr, nullptr, outp, (const float*)(ws + WS_MODS) + (size_t)l * NCOND * 6144 + 5 * 1024, (const bf16_t*)(ws + WS_XB), l + 1 < DEPTH ? (bf16_t*)(ws + WS_XB) : (bf16_t*)nullptr};
#ifndef SKIP_RES
            pg8::gemm_phase(lds, lds + XCH_OFF, g, S, E);
#endif
        } PHASE_END
    }
}

constexpr int N_PHASES = 1 + DEPTH * 7;
#ifndef N_LAUNCH_SPLIT
#define N_LAUNCH_SPLIT 0
#endif

extern "C" void kernel_launch(void* const* d_in, const int* in_sizes, int n_in, void* d_out, int out_size, void* d_ws, size_t ws_size, hipStream_t stream) {
    static int grid = 0;
    if (grid == 0) {
        if (n_in != 26 || ws_size < WS_END) { fprintf(stderr, "kernel_launch: unexpected n_in %d or ws_size %zu (< %zu)\n", n_in, ws_size, (size_t)WS_END); grid = -1; return; }
        int dev = 0, cus = 0, per_cu = 0;
        hipGetDevice(&dev); hipDeviceGetAttribute(&cus, hipDeviceAttributeMultiprocessorCount, dev);
        hipFuncSetAttribute((const void*)fwd_kernel, hipFuncAttributeMaxDynamicSharedMemorySize, LDS_BYTES);
        hipOccupancyMaxActiveBlocksPerMultiprocessor(&per_cu, (const void*)fwd_kernel, 512, LDS_BYTES);
        if (per_cu < 1) { fprintf(stderr, "kernel_launch: occupancy query gives %d\n", per_cu); per_cu = 1; }
        (void)hipGetLastError();
        grid = cus * 1;
    }
    if (grid < 0) return;
    Params p{};
    const float** pp = (const float**)&p;
    for (int i = 0; i < 26; ++i) pp[i] = (const float*)d_in[i];
    p.out = (float*)d_out; p.ws = (unsigned char*)d_ws;
    for (int l = 0; l < 4; ++l) p.lam_init[l] = (float)(0.8 - 0.6 * exp(-0.3 * (double)l));
#if N_LAUNCH_SPLIT
    for (int ph = 0; ph < N_PHASES; ++ph) { p.ph_lo = ph; p.ph_hi = ph + 1; hipLaunchKernelGGL(fwd_kernel, dim3(grid), dim3(512), LDS_BYTES, stream, p); }
#else
    p.ph_lo = 0; p.ph_hi = N_PHASES;
    if (hipMemsetAsync((char*)d_ws + WS_CTL, 0, CTL_ZERO_BYTES, stream) != hipSuccess) { fprintf(stderr, "kernel_launch: memset failed\n"); return; }
    void* args[] = {&p};
    hipError_t e = hipLaunchCooperativeKernel((const void*)fwd_kernel, dim3(grid), dim3(512), args, LDS_BYTES, stream);
    if (e != hipSuccess) fprintf(stderr, "cooperative launch failed: %s (grid %d)\n", hipGetErrorString(e), grid);
#endif
}
```

```cpp
#include <hip/hip_runtime.h>
#include <hip/hip_cooperative_groups.h>
#include <cstdio>
#include <cstdint>
#include <cmath>
namespace cg = cooperative_groups;

#define LAS __attribute__((address_space(3)))
#define GAS __attribute__((address_space(1)))
typedef unsigned short bf16_t;
typedef short bf16x8 __attribute__((ext_vector_type(8)));
typedef short s16x4 __attribute__((ext_vector_type(4)));
typedef float f32x4 __attribute__((ext_vector_type(4)));
typedef float f32x16 __attribute__((ext_vector_type(16)));
typedef unsigned u32x4 __attribute__((ext_vector_type(4)));
typedef unsigned u32x2 __attribute__((ext_vector_type(2)));
typedef float f32x2 __attribute__((ext_vector_type(2)));
typedef __bf16 bf16x2_t __attribute__((ext_vector_type(2)));

__device__ __forceinline__ unsigned cvtpk(float lo, float hi) { f32x2 v = {lo, hi}; bf16x2_t b = __builtin_convertvector(v, bf16x2_t); return __builtin_bit_cast(unsigned, b); }
__device__ __forceinline__ int opaque_tid() { int t = threadIdx.x; asm volatile("" : "+v"(t)); return t; }
__device__ __forceinline__ float bf2f(unsigned short u) { return __uint_as_float(((unsigned)u) << 16); }

constexpr int DM = 1024, DEPTH = 4, NCOND = 9;
constexpr int M_CTX = 8192, M_ALL = 40960, NTM = 160;
constexpr int INW = 2304, DFF = 2816, UPW = 5632;
constexpr int SLAT = 4352;
constexpr float EPS = 1e-6f;
constexpr float LOG2E = 1.4426950408889634f;
constexpr float QSCALE_G = 0.125f * LOG2E;
constexpr float QSCALE_D = 0.17677669529663687f * LOG2E;
constexpr size_t OUT_GK = 41943040, OUT_GV = OUT_GK + 4194304, OUT_DK = OUT_GV + 4194304, OUT_DV = OUT_DK + 8388608;
constexpr size_t MiB = 1u << 20;
constexpr size_t WS_MODS = 1 * MiB;
constexpr size_t WS_MISC = 2 * MiB;
constexpr size_t WS_EDGE = 3 * MiB;
constexpr size_t EDGE_ELEMS = (size_t)NTM * 2 * DFF;
constexpr size_t WS_WIN = 16 * MiB;
constexpr size_t WS_WOUT = 34 * MiB;
constexpr size_t WS_WUP = 42 * MiB;
constexpr size_t WS_WDN = 86 * MiB;
constexpr size_t WS_XN = 108 * MiB;
constexpr size_t WS_U = 188 * MiB;
constexpr size_t WS_QG = WS_U, WS_QD = WS_QG + (size_t)M_ALL * 512 * 2, WS_KG = WS_QD + (size_t)M_ALL * 256 * 2;
constexpr size_t KROWS = 8192 + 8 * SLAT;
constexpr size_t WS_VG = WS_KG + KROWS * 128 * 2, WS_KD = WS_VG + KROWS * 128 * 2, WS_VD = WS_KD + KROWS * 256 * 2;
constexpr size_t WS_CB = WS_VD + KROWS * 256 * 2, WS_PB = WS_CB + (size_t)M_ALL * 256 * 2, WS_UEND = WS_PB + (size_t)M_ALL * 256 * 2;
constexpr size_t WS_DSCR = WS_U + (size_t)M_ALL * DFF * 2;
constexpr size_t WS_XB = WS_DSCR + 16 * MiB;
constexpr size_t WS_END = WS_XB + (size_t)M_ALL * DM * 2;
static_assert(WS_UEND <= WS_DSCR, "union");
constexpr int MI_LAM = 0, MI_R64C = 64, MI_R64S = MI_R64C + 1024, MI_R32C = MI_R64S + 1024, MI_R32S = MI_R32C + 512;

constexpr int RING_BYTES = 131072, XCH_OFF = RING_BYTES, MISC_OFF = RING_BYTES + 4096, LDS_BYTES = RING_BYTES + 4096 + 256;
constexpr size_t WS_CTL = 0, CTL_ZERO_BYTES = 65536;

struct TileInfo {
    int lat, seq, t0, ci, S; long R;
    __device__ __forceinline__ TileInfo(int pm) {
        if (pm < 32) { lat = 0; seq = pm; t0 = 0; ci = 0; S = 256; R = 256L * pm; }
        else { const int b = (pm - 32) >> 4; lat = 1; seq = b; t0 = ((pm - 32) & 15) * 256; ci = 1 + b; S = SLAT; R = 8192L + (long)SLAT * b; }
    }
};

namespace pg8 {
constexpr int BM = 256, BK = 64, HALF = 128, HTB = HALF * BK * 2, NXCD = 8, WGM = 8;
__host__ __device__ __forceinline__ int lds_byte(int r, int c) { const int st = (r >> 4) * 2 + (c >> 5), rr = r & 15, cc = c & 31, ob = rr * 64 + cc * 2; return st * 1024 + (ob ^ (((ob >> 9) & 1) << 5)); }
__host__ __device__ __forceinline__ void stage_rc(int b, int& R, int& C) { const int st = b / 1024, sb = b % 1024, swz = sb ^ (((sb >> 9) & 1) << 5); R = (st >> 1) * 16 + swz / 64; C = (st & 1) * 32 + (swz % 64) / 2; }
struct Unit { int pm, pn; };
struct Gemm { const bf16_t* A; const bf16_t* Bt; int M, N, K; };
struct StaticOrder {
    int nM, nN, nwg, G, c;
    __device__ void init(int M, int N, int G_, int c_) { nM = M / BM; nN = N / BM; nwg = nM * nN; G = G_; c = c_; }
    __device__ bool next(int i, Unit& u) const {
        const long L = (long)i * G + c; if (L >= nwg) return false;
        int wgid = (int)L; { const int q = nwg / NXCD, r = nwg % NXCD, xcd = wgid % NXCD, off = wgid / NXCD; wgid = (xcd < r ? xcd * (q + 1) : r * (q + 1) + (xcd - r) * q) + off; }
        const int nig = WGM * nN, gid = wgid / nig, fm = gid * WGM, gsz = (nM - fm) < WGM ? (nM - fm) : WGM;
        u.pm = fm + ((wgid % nig) % gsz); u.pn = (wgid % nig) / gsz; return true;
    }
};
template <class Epi>
__device__ __forceinline__ void gemm_phase(LAS unsigned char* lds, LAS unsigned char* xlds, const Gemm g, const StaticOrder& S, const Epi& E) {
    const int tid = opaque_tid(), wid = __builtin_amdgcn_readfirstlane(tid >> 6), lane = tid & 63, wr = wid >> 2, wc = wid & 3, fr = lane & 15, fq = lane >> 4;
    const int K = g.K, nt = K / BK;
    unsigned voffA[2];
#pragma unroll
    for (int i = 0; i < 2; ++i) { int R, C; stage_rc(tid * 16 + i * 8192, R, C); voffA[i] = (unsigned)(R * K + C) * 2u; }
    const size_t kstep = (size_t)(BK * 2);
    const size_t hstep = (size_t)HALF * K * 2;
    const size_t tstep = 2 * hstep;
    const unsigned ldsw = (unsigned)wid * 1024u;
    const int aoff = lds_byte(wr * 64 + fr, fq * 8), boff = lds_byte(wc * 32 + fr, fq * 8);
#define PG8_SA(b, h) (((b) * 2 + (h)) * HTB)
#define PG8_SB(b, h) ((4 + (b) * 2 + (h)) * HTB)
#define PG8_STAGE(bufoff, gbase) do { _Pragma("unroll") for (int _i = 0; _i < 2; ++_i) \
        __builtin_amdgcn_global_load_lds((const unsigned*)((const char*)(gbase) + voffA[_i]), (LAS unsigned*)(lds + (bufoff) + ldsw + _i * 8192), 16, 0, 0); } while (0)
#define PG8_LDA(dst, b, h) do { _Pragma("unroll") for (int m = 0; m < 4; ++m) _Pragma("unroll") for (int k = 0; k < 2; ++k) dst[m][k] = *(const LAS bf16x8*)(lds + PG8_SA(b, h) + aoff + m * 2048 + k * 1024); } while (0)
#define PG8_LDB(dst, b, h) do { _Pragma("unroll") for (int n = 0; n < 2; ++n) _Pragma("unroll") for (int k = 0; k < 2; ++k) dst[n][k] = *(const LAS bf16x8*)(lds + PG8_SB(b, h) + boff + n * 2048 + k * 1024); } while (0)
#define PG8_MMA(ai, bj, At, Bt) do { __builtin_amdgcn_s_setprio(1); _Pragma("unroll") for (int m = 0; m < 4; ++m) _Pragma("unroll") for (int n = 0; n < 2; ++n) _Pragma("unroll") for (int k = 0; k < 2; ++k) \
        acc[ai][bj][m][n] = __builtin_amdgcn_mfma_f32_16x16x32_bf16(Bt[n][k], At[m][k], acc[ai][bj][m][n], 0, 0, 0); __builtin_amdgcn_s_setprio(0); } while (0)
#define PG8_WAIT_V(n) asm volatile("s_waitcnt vmcnt(" #n ")" ::: "memory")
#define PG8_WAIT_L(n) asm volatile("s_waitcnt lgkmcnt(" #n ")" ::: "memory")
#define PG8_BAR __builtin_amdgcn_s_barrier()
#define PG8_SCHED __builtin_amdgcn_sched_barrier(0)
    Unit cur, nxt; int ui = 0;
    if (!S.next(0, cur)) return;
    f32x4 acc[2][2][4][2];
#pragma unroll
    for (int a = 0; a < 2; ++a)
#pragma unroll
        for (int b = 0; b < 2; ++b)
#pragma unroll
            for (int m = 0; m < 4; ++m)
#pragma unroll
                for (int n = 0; n < 2; ++n) acc[a][b][m][n] = (f32x4){0.f, 0.f, 0.f, 0.f};
    bf16x8 At[4][2], B0[2][2], B1[2][2];
    const char* cA = (const char*)g.A + (size_t)cur.pm * tstep; const char* cB = (const char*)g.Bt + (size_t)cur.pn * tstep;
    PG8_STAGE(PG8_SB(0, 0), cB); PG8_STAGE(PG8_SB(0, 1), cB + hstep); PG8_STAGE(PG8_SA(0, 0), cA); PG8_STAGE(PG8_SA(0, 1), cA + hstep);
    if (wr == 1) PG8_BAR;
    PG8_WAIT_V(2); PG8_BAR;
    PG8_STAGE(PG8_SB(1, 0), cB + kstep); PG8_STAGE(PG8_SA(1, 0), cA + kstep); PG8_STAGE(PG8_SB(1, 1), cB + hstep + kstep);
    PG8_WAIT_V(6); PG8_BAR;
    for (;;) {
        const bool has_next = S.next(ui + 1, nxt);
        const char* nA = has_next ? (const char*)g.A + (size_t)nxt.pm * tstep : cA; const char* nB = has_next ? (const char*)g.Bt + (size_t)nxt.pn * tstep : cB;
        for (int t = 0; t < nt; t += 2) {
            const bool last = (t == nt - 2);
            const char* a1 = cA + (size_t)(t + 1) * kstep;
            const char* a2 = last ? nA : cA + (size_t)(t + 2) * kstep; const char* b2 = last ? nB : cB + (size_t)(t + 2) * kstep;
            const char* a3 = a2 + kstep; const char* b3 = b2 + kstep;
            PG8_LDB(B0, 0, 0); PG8_LDB(B1, 0, 1); PG8_SCHED; PG8_LDA(At, 0, 0); PG8_STAGE(PG8_SA(1, 1), a1 + hstep);
            PG8_WAIT_V(8); PG8_WAIT_L(0); PG8_BAR; PG8_MMA(0, 0, At, B0); PG8_MMA(0, 1, At, B1); PG8_BAR; PG8_SCHED;
            PG8_LDA(At, 0, 1); PG8_STAGE(PG8_SB(0, 0), b2); PG8_STAGE(PG8_SB(0, 1), b2 + hstep); PG8_STAGE(PG8_SA(0, 0), a2);
            PG8_WAIT_V(8); PG8_WAIT_L(0); PG8_BAR; PG8_MMA(1, 0, At, B0); PG8_MMA(1, 1, At, B1); PG8_BAR; PG8_SCHED;
            PG8_LDB(B0, 1, 0); PG8_LDB(B1, 1, 1); PG8_SCHED; PG8_LDA(At, 1, 0); PG8_STAGE(PG8_SA(0, 1), a2 + hstep);
            PG8_WAIT_V(8); PG8_WAIT_L(0); PG8_BAR; PG8_MMA(0, 0, At, B0); PG8_MMA(0, 1, At, B1); PG8_BAR; PG8_SCHED;
            PG8_LDA(At, 1, 1); PG8_STAGE(PG8_SB(1, 0), b3); PG8_STAGE(PG8_SB(1, 1), b3 + hstep); PG8_STAGE(PG8_SA(1, 0), a3);
            PG8_WAIT_V(8); PG8_WAIT_L(0); PG8_BAR; PG8_MMA(1, 0, At, B0); PG8_MMA(1, 1, At, B1); PG8_BAR; PG8_SCHED;
        }
        if (wr == 0) PG8_BAR;
        { int fr_ = fr, fq_ = fq; asm volatile("" : "+v"(fr_), "+v"(fq_)); E(acc, cur, wr, wc, fr_, fq_, xlds); }
        if (!has_next) break;
#pragma unroll
        for (int a = 0; a < 2; ++a)
#pragma unroll
            for (int b = 0; b < 2; ++b)
#pragma unroll
                for (int m = 0; m < 4; ++m)
#pragma unroll
                    for (int n = 0; n < 2; ++n) acc[a][b][m][n] = (f32x4){0.f, 0.f, 0.f, 0.f};
        cur = nxt; cA = nA; cB = nB; ++ui;
        if (wr == 1) PG8_BAR;
    }
    PG8_WAIT_V(0);
    PG8_BAR;
#undef PG8_SA
#undef PG8_SB
#undef PG8_STAGE
#undef PG8_LDA
#undef PG8_LDB
#undef PG8_MMA
#undef PG8_WAIT_V
#undef PG8_WAIT_L
#undef PG8_BAR
#undef PG8_SCHED
}
}

typedef f32x4 Acc[2][2][4][2];

struct EpiRes {
    const float* xin_ctx; const float* xin_lat; float* xout; const float* gate;
    const bf16_t* xin_b; bf16_t* xout_b;
    __device__ __forceinline__ void operator()(const Acc& acc, const pg8::Unit& u, int wr, int wc, int fr, int fq, LAS unsigned char*) const {
        const TileInfo ti(u.pm);
        const int col0 = u.pn * 256 + wc * 32 + 8 * fq;
        const float* gp = gate + ti.ci * 6144 + col0;
        f32x4 g4[2][2];
#pragma unroll
        for (int bj = 0; bj < 2; ++bj)
#pragma unroll
            for (int n = 0; n < 2; ++n) g4[bj][n] = *(const GAS f32x4*)(gp + bj * 128 + n * 4);
        const float* xin = ti.lat ? xin_lat + (size_t)(u.pm * 256 - M_CTX) * DM : xin_ctx + (size_t)(u.pm * 256) * DM;
        float* xo = xout + (size_t)(u.pm * 256) * DM;
        const bf16_t* xib = xin_b + (size_t)(u.pm * 256) * DM; bf16_t* xob = xout_b + (size_t)(u.pm * 256) * DM;
#pragma unroll
        for (int ai = 0; ai < 2; ++ai) {
            f32x4 xv[4][2][2];
            if (xin_b) {
                u32x4 rw[4][2];
#pragma unroll
                for (int m = 0; m < 4; ++m)
#pragma unroll
                    for (int bj = 0; bj < 2; ++bj) rw[m][bj] = *(const GAS u32x4*)(xib + (size_t)(ai * 128 + wr * 64 + m * 16 + fr) * DM + col0 + bj * 128);
#pragma unroll
                for (int m = 0; m < 4; ++m)
#pragma unroll
                    for (int bj = 0; bj < 2; ++bj) { const u32x4 r = rw[m][bj];
                        xv[m][bj][0] = (f32x4){__uint_as_float(r.x << 16), __uint_as_float(r.x & 0xffff0000u), __uint_as_float(r.y << 16), __uint_as_float(r.y & 0xffff0000u)};
                        xv[m][bj][1] = (f32x4){__uint_as_float(r.z << 16), __uint_as_float(r.z & 0xffff0000u), __uint_as_float(r.w << 16), __uint_as_float(r.w & 0xffff0000u)}; }
            } else {
#pragma unroll
                for (int m = 0; m < 4; ++m) {
                    const size_t off = (size_t)(ai * 128 + wr * 64 + m * 16 + fr) * DM + col0;
#pragma unroll
                    for (int bj = 0; bj < 2; ++bj)
#pragma unroll
                        for (int n = 0; n < 2; ++n) xv[m][bj][n] = *(const GAS f32x4*)(xin + off + bj * 128 + n * 4);
                }
            }
#pragma unroll
            for (int m = 0; m < 4; ++m) {
                const size_t off = (size_t)(ai * 128 + wr * 64 + m * 16 + fr) * DM + col0;
#pragma unroll
                for (int bj = 0; bj < 2; ++bj) {
                    const f32x4 o0 = xv[m][bj][0] + g4[bj][0] * acc[ai][bj][m][0], o1 = xv[m][bj][1] + g4[bj][1] * acc[ai][bj][m][1];
                    if (xout_b) { u32x4 w; w.x = cvtpk(o0[0], o0[1]); w.y = cvtpk(o0[2], o0[3]); w.z = cvtpk(o1[0], o1[1]); w.w = cvtpk(o1[2], o1[3]); *(GAS u32x4*)(xob + off + bj * 128) = w; }
                    else { *(GAS f32x4*)(xo + off + bj * 128) = o0; *(GAS f32x4*)(xo + off + bj * 128 + 4) = o1; }
                }
            }
            asm volatile("" ::: "memory");
            __builtin_amdgcn_sched_barrier(0);
        }
    }
};

struct EpiIn {
    int layer;
    const float *qn_g, *kn_g, *dqn_g, *dkn_g;
    const float *r64c, *r64s, *r32c, *r32s;
    bf16_t *QG, *QD, *KG, *VG, *KD, *VD, *CB, *PB;
    float* out;
    __device__ __forceinline__ void operator()(const Acc& acc, const pg8::Unit& u, int wr, int wc, int fr, int fq, LAS unsigned char*) const {
        const TileInfo ti(u.pm);
        const int pn = u.pn;
        const int rbase = wr * 64 + fr;
        if (pn < 2 || (pn == 2 && wc < 2)) {
            const bool isq = pn < 2;
            const float* gsrc = (isq ? qn_g : kn_g) + 4 * fq;
            const int head = isq ? 4 * pn + wc : wc;
            f32x4 g4[2][2], rc[2], rs[2];
#pragma unroll
            for (int bj = 0; bj < 2; ++bj)
#pragma unroll
                for (int n = 0; n < 2; ++n) g4[bj][n] = *(const GAS f32x4*)(gsrc + 32 * bj + 16 * n);
#pragma unroll
            for (int ai = 0; ai < 2; ++ai) { const int pos = (ti.t0 >> 6) + 2 * ai + wr; rc[ai] = *(const GAS f32x4*)(r64c + pos * 16 + 4 * fq); rs[ai] = *(const GAS f32x4*)(r64s + pos * 16 + 4 * fq); }
            float ss[8];
#pragma unroll
            for (int ai = 0; ai < 2; ++ai)
#pragma unroll
                for (int m = 0; m < 4; ++m) { float t_ = 0.f;
#pragma unroll
                    for (int bj = 0; bj < 2; ++bj)
#pragma unroll
                        for (int n = 0; n < 2; ++n) { const f32x4 v = acc[ai][bj][m][n]; t_ += (v[0] * v[0] + v[1] * v[1]) + (v[2] * v[2] + v[3] * v[3]); }
                    ss[ai * 4 + m] = t_; }
#pragma unroll
            for (int i = 0; i < 8; ++i) ss[i] += __shfl_xor(ss[i], 16);
#pragma unroll
            for (int i = 0; i < 8; ++i) ss[i] += __shfl_xor(ss[i], 32);
#pragma unroll
            for (int mh = 0; mh < 2; ++mh) {
                f32x4 cc[2], cs[2];
#pragma unroll
                for (int mm = 0; mm < 2; ++mm) { const int pos = 16 * (2 * mh + mm) + fr; cc[mm] = *(const GAS f32x4*)(r64c + pos * 16 + 4 * fq); cs[mm] = *(const GAS f32x4*)(r64s + pos * 16 + 4 * fq); }
                if (mh == 0) __builtin_amdgcn_sched_group_barrier(0x020, 12, 0); else __builtin_amdgcn_sched_group_barrier(0x020, 4, 0);
#pragma unroll
                for (int mm = 0; mm < 2; ++mm)
#pragma unroll
                    for (int ai = 0; ai < 2; ++ai) {
                        const int m = 2 * mh + mm;
                        const int rt = ai * 128 + m * 16 + rbase; const int t = ti.t0 + rt;
                        const float rstd = rsqrtf(ss[ai * 4 + m] * (1.f / 64.f) + EPS);
                        bf16_t* dst = isq ? QG + ((size_t)u.pm * 256 + rt) * 512 + head * 64 + 8 * fq : KG + ((ti.R * 2 + (long)head * ti.S + t) * 64) + 8 * fq;
                        float* o = out + OUT_GK + ((size_t)(ti.seq * 4 + layer) * 256 + t) * 128 + head * 64 + 4 * fq;
#pragma unroll
                        for (int bj = 0; bj < 2; ++bj) {
                            f32x4 y0 = acc[ai][bj][m][0] * rstd * g4[bj][0], y1 = acc[ai][bj][m][1] * rstd * g4[bj][1];
                            if (!isq && !ti.lat) { *(GAS f32x4*)(o + 32 * bj) = y0; *(GAS f32x4*)(o + 32 * bj + 16) = y1; }
                            if (ti.lat) {
                                const f32x4 c4 = bj ? cc[mm] : rc[ai], s4 = bj ? cs[mm] : rs[ai];
                                const f32x4 o0 = y0 * c4 - y1 * s4, o1 = y1 * c4 + y0 * s4; y0 = o0; y1 = o1;
                            }
                            if (isq) { y0 = y0 * QSCALE_G; y1 = y1 * QSCALE_G; }
                            u32x4 w; w.x = cvtpk(y0[0], y0[1]); w.y = cvtpk(y0[2], y0[3]); w.z = cvtpk(y1[0], y1[1]); w.w = cvtpk(y1[2], y1[3]);
                            *(GAS u32x4*)(dst + 32 * bj) = w;
                        }
                    }
                asm volatile("" ::: "memory"); __builtin_amdgcn_sched_barrier(0);
            }
        } else if (pn == 2) {
            const int head = wc - 2;
#pragma unroll
            for (int ai = 0; ai < 2; ++ai)
#pragma unroll
                for (int m = 0; m < 4; ++m) {
                    const int rt = ai * 128 + m * 16 + rbase; const int t = ti.t0 + rt;
                    if (!ti.lat) {
                        float* o = out + OUT_GV + ((size_t)(ti.seq * 4 + layer) * 256 + t) * 128 + head * 64 + 8 * fq;
#pragma unroll
                        for (int bj = 0; bj < 2; ++bj) { *(GAS f32x4*)(o + 32 * bj) = acc[ai][bj][m][0]; *(GAS f32x4*)(o + 32 * bj + 4) = acc[ai][bj][m][1]; }
                    }
                    bf16_t* vp = VG + ((ti.R * 2 + (long)head * ti.S + t) * 64) + 8 * fq;
#pragma unroll
                    for (int bj = 0; bj < 2; ++bj) { const f32x4 a = acc[ai][bj][m][0], b = acc[ai][bj][m][1]; u32x4 w; w.x = cvtpk(a[0], a[1]); w.y = cvtpk(a[2], a[3]); w.z = cvtpk(b[0], b[1]); w.w = cvtpk(b[2], b[3]); *(GAS u32x4*)(vp + 32 * bj) = w; }
                }
        } else if (pn == 3) {
#pragma unroll
            for (int ai = 0; ai < 2; ++ai)
#pragma unroll
                for (int m = 0; m < 4; ++m) {
                    const size_t grow = (size_t)u.pm * 256 + ai * 128 + m * 16 + rbase;
                    bf16_t* p = CB + grow * 256 + 32 * wc + 8 * fq;
#pragma unroll
                    for (int bj = 0; bj < 2; ++bj) { const f32x4 a = acc[ai][bj][m][0], b = acc[ai][bj][m][1]; u32x4 w; w.x = cvtpk(a[0], a[1]); w.y = cvtpk(a[2], a[3]); w.z = cvtpk(b[0], b[1]); w.w = cvtpk(b[2], b[3]); *(GAS u32x4*)(p + 128 * bj) = w; }
                }
        } else if (pn < 6) {
#pragma unroll
            for (int ai = 0; ai < 2; ++ai)
#pragma unroll
                for (int m = 0; m < 4; ++m) {
                    const size_t grow = (size_t)u.pm * 256 + ai * 128 + m * 16 + rbase;
                    bf16_t* p = PB + grow * 256 + 128 * (pn - 4) + 32 * wc + 8 * fq;
                    const f32x4 a = acc[ai][0][m][0] * acc[ai][1][m][0], b = acc[ai][0][m][1] * acc[ai][1][m][1];
                    u32x4 w; w.x = cvtpk(a[0], a[1]); w.y = cvtpk(a[2], a[3]); w.z = cvtpk(b[0], b[1]); w.w = cvtpk(b[2], b[3]); *(GAS u32x4*)p = w;
                }
        } else if (pn < 8) {
            const bool isq = pn == 6;
            const float* gsrc = isq ? dqn_g : dkn_g;
            const int a_ax = fq >> 1, ib = 4 * (fq & 1);
            const float* gp = gsrc + 16 * a_ax + ib;
            const int head = wc;
            const f32x4 g0 = *(const GAS f32x4*)gp, g1 = *(const GAS f32x4*)(gp + 8);
            f32x4 tc[4], ts[4];
#pragma unroll
            for (int j = 0; j < 4; ++j) { const int pos = a_ax ? (16 * j + fr) : ((ti.t0 >> 6) + 2 * (j & 1) + wr); tc[j] = *(const GAS f32x4*)(r32c + pos * 8 + ib); ts[j] = *(const GAS f32x4*)(r32s + pos * 8 + ib); }
            __builtin_amdgcn_sched_group_barrier(0x020, 10, 0);
#pragma unroll
            for (int ai = 0; ai < 2; ++ai) {
                float ss[4][2];
#pragma unroll
                for (int m = 0; m < 4; ++m)
#pragma unroll
                    for (int bj = 0; bj < 2; ++bj) { float t_ = 0.f;
#pragma unroll
                        for (int n = 0; n < 2; ++n) { const f32x4 v = acc[ai][bj][m][n]; t_ += (v[0] * v[0] + v[1] * v[1]) + (v[2] * v[2] + v[3] * v[3]); }
                        ss[m][bj] = t_; }
#pragma unroll
                for (int i = 0; i < 4; ++i) { ss[i][0] += __shfl_xor(ss[i][0], 16); ss[i][1] += __shfl_xor(ss[i][1], 16); }
#pragma unroll
                for (int i = 0; i < 4; ++i) { ss[i][0] += __shfl_xor(ss[i][0], 32); ss[i][1] += __shfl_xor(ss[i][1], 32); }
#pragma unroll
                for (int m = 0; m < 4; ++m) {
                    const int rt = ai * 128 + m * 16 + rbase; const int t = ti.t0 + rt; const size_t grow = (size_t)u.pm * 256 + rt;
                    const f32x4 c4 = a_ax ? tc[m] : tc[ai], s4 = a_ax ? ts[m] : ts[ai];
#pragma unroll
                    for (int bj = 0; bj < 2; ++bj) {
                        const float rstd = rsqrtf(ss[m][bj] * (1.f / 32.f) + EPS);
                        f32x4 y0 = acc[ai][bj][m][0] * rstd * g0, y1 = acc[ai][bj][m][1] * rstd * g1;
                        if (!isq && !ti.lat) {
                            float* o = out + OUT_DK + ((size_t)(ti.seq * 4 + layer) * 256 + t) * 256 + head * 64 + bj * 32 + 16 * a_ax + ib;
                            *(GAS f32x4*)(o) = y0; *(GAS f32x4*)(o + 8) = y1;
                        }
                        if (ti.lat) { const f32x4 o0 = y0 * c4 - y1 * s4, o1 = y1 * c4 + y0 * s4; y0 = o0; y1 = o1; }
                        bf16_t* dst;
                        if (isq) { y0 = y0 * QSCALE_D; y1 = y1 * QSCALE_D; dst = QD + grow * 256 + head * 64 + bj * 32 + 16 * a_ax + 2 * ib; }
                        else dst = KD + ((ti.R * 8 + (long)(head * 2 + bj) * ti.S + t) * 32) + 16 * a_ax + 2 * ib;
                        u32x4 w; w.x = cvtpk(y0[0], y0[1]); w.y = cvtpk(y0[2], y0[3]); w.z = cvtpk(y1[0], y1[1]); w.w = cvtpk(y1[2], y1[3]);
                        *(GAS u32x4*)dst = w;
                    }
                }
                asm volatile("" ::: "memory"); __builtin_amdgcn_sched_barrier(0);
            }
        } else {
            const int head = wc;
#pragma unroll
            for (int ai = 0; ai < 2; ++ai)
#pragma unroll
                for (int m = 0; m < 4; ++m) {
                    const int rt = ai * 128 + m * 16 + rbase; const int t = ti.t0 + rt;
                    if (!ti.lat) {
                        float* o = out + OUT_DV + ((size_t)(ti.seq * 4 + layer) * 256 + t) * 256 + head * 64 + 8 * fq;
#pragma unroll
                        for (int bj = 0; bj < 2; ++bj) { *(GAS f32x4*)(o + 32 * bj) = acc[ai][bj][m][0]; *(GAS f32x4*)(o + 32 * bj + 4) = acc[ai][bj][m][1]; }
                    }
                    bf16_t* vp = VD + ((ti.R * 4 + (long)head * ti.S + t) * 64) + 8 * fq;
#pragma unroll
                    for (int bj = 0; bj < 2; ++bj) { const f32x4 a = acc[ai][bj][m][0], b = acc[ai][bj][m][1]; u32x4 w; w.x = cvtpk(a[0], a[1]); w.y = cvtpk(a[2], a[3]); w.z = cvtpk(b[0], b[1]); w.w = cvtpk(b[2], b[3]); *(GAS u32x4*)(vp + 32 * bj) = w; }
                }
        }
    }
};

__device__ __forceinline__ float dpp_ror1(float x) { return __int_as_float(__builtin_amdgcn_update_dpp(0, __float_as_int(x), 0x121, 0xf, 0xf, false)); }
__device__ __forceinline__ float dpp_ror15(float x) { return __int_as_float(__builtin_amdgcn_update_dpp(0, __float_as_int(x), 0x12F, 0xf, 0xf, false)); }
__device__ __forceinline__ float silu_f(float x) { return x * __builtin_amdgcn_rcpf(1.f + __builtin_amdgcn_exp2f(-x * LOG2E)); }
struct EpiUp {
    const float* cw; const float* cbias; bf16_t* F; float* EP; float* EA; float* EU;
    __device__ __forceinline__ void operator()(const Acc& acc, const pg8::Unit& u, int wr, int wc, int fr, int fq, LAS unsigned char* xlds) const {
        const TileInfo ti(u.pm);
        const int c0 = u.pn * 128 + wc * 32 + 8 * fq;
        LAS float* X = (LAS float*)xlds;
#pragma unroll
        for (int ai = 0; ai < 2; ++ai) {
            if (fr == 0) { LAS float* p = X + ((((ai * 2 + wr) * 4 + wc) * 2 + 0) * 4 + fq) * 8; *(LAS f32x4*)p = acc[ai][0][0][0]; *(LAS f32x4*)(p + 4) = acc[ai][0][0][1]; }
            if (fr == 15) { LAS float* p = X + ((((ai * 2 + wr) * 4 + wc) * 2 + 1) * 4 + fq) * 8; *(LAS f32x4*)p = acc[ai][0][3][0]; *(LAS f32x4*)(p + 4) = acc[ai][0][3][1]; }
        }
        asm volatile("s_waitcnt lgkmcnt(0)" ::: "memory"); __builtin_amdgcn_s_barrier(); asm volatile("" ::: "memory");
        f32x4 w0[2], w1[2], w2[2], bb[2];
#pragma unroll
        for (int n = 0; n < 2; ++n) { w0[n] = *(const GAS f32x4*)(cw + c0 + 4 * n); w1[n] = *(const GAS f32x4*)(cw + DFF + c0 + 4 * n); w2[n] = *(const GAS f32x4*)(cw + 2 * DFF + c0 + 4 * n); bb[n] = *(const GAS f32x4*)(cbias + c0 + 4 * n); }
        const bool has_prev = ti.lat && ti.t0 > 0, has_next = ti.lat && ti.t0 < 4096 - 256;
#pragma unroll
        for (int ai = 0; ai < 2; ++ai) {
            f32x4 pb[2] = {(f32x4){0.f, 0.f, 0.f, 0.f}, (f32x4){0.f, 0.f, 0.f, 0.f}}, nb[2] = {(f32x4){0.f, 0.f, 0.f, 0.f}, (f32x4){0.f, 0.f, 0.f, 0.f}};
            { const int seg = ai * 2 + wr;
              if (seg > 0) { const int ps = seg - 1; LAS float* p = X + ((((ps >> 1) * 2 + (ps & 1)) * 4 + wc) * 2 + 1) * 32 + fq * 8; pb[0] = *(LAS f32x4*)p; pb[1] = *(LAS f32x4*)(p + 4); }
              if (seg < 3) { const int ns = seg + 1; LAS float* p = X + ((((ns >> 1) * 2 + (ns & 1)) * 4 + wc) * 2 + 0) * 32 + fq * 8; nb[0] = *(LAS f32x4*)p; nb[1] = *(LAS f32x4*)(p + 4); } }
#pragma unroll
            for (int m = 0; m < 4; ++m) {
                const int rt = ai * 128 + wr * 64 + m * 16 + fr; const size_t grow = (size_t)u.pm * 256 + rt;
                f32x4 fo[2], cv[2];
#pragma unroll
                for (int n = 0; n < 2; ++n) {
                    const f32x4 a = acc[ai][0][m][n];
                    const f32x4 up = (m > 0) ? acc[ai][0][m > 0 ? m - 1 : 0][n] : pb[n];
                    const f32x4 dn = (m < 3) ? acc[ai][0][m < 3 ? m + 1 : 3][n] : nb[n];
                    f32x4 pv, nx;
#pragma unroll
                    for (int e = 0; e < 4; ++e) {
                        pv[e] = dpp_ror1(fr == 15 ? up[e] : a[e]);
                        nx[e] = dpp_ror15(fr == 0 ? dn[e] : a[e]);
                    }
                    const f32x4 c = w0[n] * pv + w1[n] * a + w2[n] * nx + bb[n];
                    cv[n] = c;
                    const f32x4 uu = acc[ai][1][m][n];
#pragma unroll
                    for (int e = 0; e < 4; ++e) fo[n][e] = silu_f(c[e]) * uu[e];
                }
                u32x4 w; w.x = cvtpk(fo[0][0], fo[0][1]); w.y = cvtpk(fo[0][2], fo[0][3]); w.z = cvtpk(fo[1][0], fo[1][1]); w.w = cvtpk(fo[1][2], fo[1][3]);
                *(GAS u32x4*)(F + grow * DFF + c0) = w;
                if (ai == 0 && m == 0) { if (has_prev && rt == 0) { const size_t eo = ((size_t)u.pm * 2 + 0) * DFF + c0;
                        *(GAS f32x4*)(EP + eo) = cv[0]; *(GAS f32x4*)(EP + eo + 4) = cv[1]; *(GAS f32x4*)(EA + eo) = acc[0][0][0][0]; *(GAS f32x4*)(EA + eo + 4) = acc[0][0][0][1]; *(GAS f32x4*)(EU + eo) = acc[0][1][0][0]; *(GAS f32x4*)(EU + eo + 4) = acc[0][1][0][1]; } }
                if (ai == 1 && m == 3) { if (has_next && rt == 255) { const size_t eo = ((size_t)u.pm * 2 + 1) * DFF + c0;
                        *(GAS f32x4*)(EP + eo) = cv[0]; *(GAS f32x4*)(EP + eo + 4) = cv[1]; *(GAS f32x4*)(EA + eo) = acc[1][0][3][0]; *(GAS f32x4*)(EA + eo + 4) = acc[1][0][3][1]; *(GAS f32x4*)(EU + eo) = acc[1][1][3][0]; *(GAS f32x4*)(EU + eo + 4) = acc[1][1][3][1]; } }
            }
        }
        asm volatile("s_waitcnt lgkmcnt(0)" ::: "memory"); __builtin_amdgcn_s_barrier(); asm volatile("" ::: "memory");
    }
};

typedef short v4i16_t __attribute__((ext_vector_type(4)));
__device__ __forceinline__ s16x4 vtr(LAS const char* p) { return __builtin_bit_cast(s16x4, __builtin_amdgcn_ds_read_tr16_b64_v4i16((LAS v4i16_t*)p)); }
__device__ __forceinline__ float xhalf_max(float m) { auto rr = __builtin_amdgcn_permlane32_swap(__float_as_uint(m), __float_as_uint(m), false, false); return fmaxf(__uint_as_float(rr[0]), __uint_as_float(rr[1])); }
__device__ __forceinline__ float xhalf_sum(float m) { auto rr = __builtin_amdgcn_permlane32_swap(__float_as_uint(m), __float_as_uint(m), false, false); return __uint_as_float(rr[0]) + __uint_as_float(rr[1]); }

constexpr int ATT_VS = 192;
constexpr float ATT_THR = 8.f;
#define MX3(a, b, c) __builtin_fmaxf(__builtin_fmaxf((a), (b)), (c))
template <int DQK, bool YORD>
__device__ __forceinline__ void flash_pass(const bf16_t* __restrict__ Qw, int qpitch, const bf16_t* __restrict__ Kg, const bf16_t* __restrict__ Vg, int NT, int tst,
                                           LAS char* lds, f32x16 (&o)[2], float& lsum) {
#define ATT_TI(T) (((T) + tst) < NT ? ((T) + tst) : ((T) + tst - NT))
    constexpr int KS = DQK * 2 + 16, KBUF = 64 * KS, VBUF = 64 * ATT_VS, NDS = DQK / 16;
    constexpr int KROWB = DQK * 2;
    const int tid = opaque_tid(), lane = tid & 63, r32 = lane & 31, h = lane >> 5;
    LAS char* Kb = lds; LAS char* Vb = lds + 2 * KBUF;
    bf16x8 qf[NDS];
#pragma unroll
    for (int ds = 0; ds < NDS; ++ds) qf[ds] = *(const GAS bf16x8*)(Qw + (size_t)r32 * qpitch + 16 * ds + 8 * h);
    const bool kload = (tid * 16) < 64 * KROWB;
    const int krow = (tid * 16) / KROWB, kcb = (tid * 16) % KROWB;
    const int kdst = krow * KS + kcb, vdst = (tid >> 3) * ATT_VS + (tid & 7) * 16;
    const char* kg = (const char*)Kg + tid * 16; const char* vg = (const char*)Vg + tid * 16;
    u32x4 kreg = {0, 0, 0, 0}, vreg;
    {
        u32x4 k1 = {0, 0, 0, 0};
        if (kload) { kreg = *(const GAS u32x4*)(kg + (size_t)ATT_TI(0) * 64 * KROWB); k1 = *(const GAS u32x4*)(kg + (size_t)ATT_TI(1) * 64 * KROWB); }
        vreg = *(const GAS u32x4*)(vg + (size_t)ATT_TI(0) * 64 * 128);
        if (kload) { *(LAS u32x4*)(Kb + kdst) = kreg; *(LAS u32x4*)(Kb + KBUF + kdst) = k1; }
        *(LAS u32x4*)(Vb + vdst) = vreg;
        *(LAS u32x4*)(Vb + 2 * VBUF + vdst) = (u32x4){0, 0, 0, 0};
    }
    __syncthreads();
    const int kfo = r32 * KS + h * 16;
    const int vfo = (4 * h + ((lane & 15) >> 2)) * ATT_VS + (((lane >> 4) & 1) * 16 + (lane & 3) * 4) * 2;
    f32x16 p0 = (f32x16){}, p1 = (f32x16){};
#pragma unroll
    for (int ds = 0; ds < NDS; ++ds) {
        const bf16x8 k0 = *(LAS const bf16x8*)(Kb + kfo + ds * 32), k1 = *(LAS const bf16x8*)(Kb + kfo + 32 * KS + ds * 32);
        p0 = __builtin_amdgcn_mfma_f32_32x32x16_bf16(k0, qf[ds], p0, 0, 0, 0);
        p1 = __builtin_amdgcn_mfma_f32_32x32x16_bf16(k1, qf[ds], p1, 0, 0, 0);
    }
    __syncthreads();
    float mref, l = 0.f;
    {
        float a = MX3(p0[0], p0[1], p1[0]), b = MX3(p0[2], p0[3], p1[1]); a = MX3(a, p1[2], p1[3]);
#pragma unroll
        for (int r = 4; r < 16; r += 4) { a = MX3(a, p0[r], p0[r + 1]); b = MX3(b, p0[r + 2], p0[r + 3]); a = MX3(a, p1[r], p1[r + 1]); b = MX3(b, p1[r + 2], p1[r + 3]); }
        mref = xhalf_max(fmaxf(a, b));
#pragma unroll
        for (int r = 0; r < 16; ++r) { p0[r] -= mref; p1[r] -= mref; }
    }
    f32x16 negm;
#pragma unroll
    for (int r = 0; r < 16; ++r) negm[r] = -mref;
    asm volatile("" : "+v"(negm));
    o[0] = (f32x16){}; o[1] = (f32x16){};
    bf16x8 pk[4] = {};
    int vs_prev = 2 * VBUF, vs_cur = 0, vs_next = VBUF;
#define ATT_MPART(N0, N1, T) do { \
        LAS const char* kb_ = Kb + ((((T) + 1) & 1) * KBUF) + kfo; LAS const char* vb_ = Vb + vs_prev + vfo; \
        bf16x8 kf_[2 * NDS]; s16x4 vl_[8], vh_[8]; \
        _Pragma("unroll") for (int ds = 0; ds < NDS; ++ds) { kf_[2 * ds] = *(LAS const bf16x8*)(kb_ + ds * 32); kf_[2 * ds + 1] = *(LAS const bf16x8*)(kb_ + 32 * KS + ds * 32); } \
        _Pragma("unroll") for (int s_ = 0; s_ < 4; ++s_) { _Pragma("unroll") for (int db_ = 0; db_ < 2; ++db_) { \
            vl_[2 * s_ + db_] = vtr(vb_ + (16 * s_) * ATT_VS + db_ * 64); vh_[2 * s_ + db_] = vtr(vb_ + (16 * s_ + 8) * ATT_VS + db_ * 64); } } \
        N0 = __builtin_amdgcn_mfma_f32_32x32x16_bf16(kf_[0], qf[0], negm, 0, 0, 0); N1 = __builtin_amdgcn_mfma_f32_32x32x16_bf16(kf_[1], qf[0], negm, 0, 0, 0); \
        _Pragma("unroll") for (int ds = 1; ds < NDS; ++ds) { \
            N0 = __builtin_amdgcn_mfma_f32_32x32x16_bf16(kf_[2 * ds], qf[ds], N0, 0, 0, 0); N1 = __builtin_amdgcn_mfma_f32_32x32x16_bf16(kf_[2 * ds + 1], qf[ds], N1, 0, 0, 0); } \
        _Pragma("unroll") for (int s_ = 0; s_ < 4; ++s_) { _Pragma("unroll") for (int db_ = 0; db_ < 2; ++db_) { \
            const bf16x8 vf_ = __builtin_shufflevector(vl_[2 * s_ + db_], vh_[2 * s_ + db_], 0, 1, 2, 3, 4, 5, 6, 7); \
            o[db_] = __builtin_amdgcn_mfma_f32_32x32x16_bf16(vf_, pk[s_], o[db_], 0, 0, 0); } } \
        __builtin_amdgcn_sched_group_barrier(0x100, 2 * NDS + 8, 0); __builtin_amdgcn_sched_group_barrier(0x008, 2 * NDS, 0); \
        __builtin_amdgcn_sched_group_barrier(0x100, 8, 0); __builtin_amdgcn_sched_group_barrier(0x008, 8, 0); } while (0)
#define ATT_VPART(P0, P1, N0, N1) do { \
        float a = MX3(P0[0], P0[1], P1[0]), b = MX3(P0[2], P0[3], P1[1]); a = MX3(a, P1[2], P1[3]); \
        _Pragma("unroll") for (int r = 4; r < 16; r += 4) { a = MX3(a, P0[r], P0[r + 1]); b = MX3(b, P0[r + 2], P0[r + 3]); a = MX3(a, P1[r], P1[r + 1]); b = MX3(b, P1[r + 2], P1[r + 3]); } \
        const float mt = xhalf_max(fmaxf(a, b)); \
        resc = __any(mt > ATT_THR); \
        if (__builtin_expect(resc, 0)) { \
            const float dl = fmaxf(mt, 0.f); mref += dl; fsc = __builtin_amdgcn_exp2f(-dl); l *= fsc; \
            _Pragma("unroll") for (int r = 0; r < 16; ++r) { P0[r] -= dl; P1[r] -= dl; } \
            if (!YORD) { _Pragma("unroll") for (int r = 0; r < 16; ++r) { N0[r] -= dl; N1[r] -= dl; o[0][r] *= fsc; o[1][r] *= fsc; } } \
            _Pragma("unroll") for (int r = 0; r < 16; ++r) negm[r] = -mref; \
            asm volatile("" : "+v"(negm)); } \
        float ps0 = 0.f, ps1 = 0.f; \
        _Pragma("unroll") for (int r = 0; r < 16; ++r) { P0[r] = __builtin_amdgcn_exp2f(P0[r]); P1[r] = __builtin_amdgcn_exp2f(P1[r]); ps0 += P0[r]; ps1 += P1[r]; } \
        l += ps0 + ps1; \
        _Pragma("unroll") for (int s = 0; s < 2; ++s) { u32x4 a4, b4; \
            a4.x = cvtpk(P0[8 * s + 0], P0[8 * s + 1]); a4.y = cvtpk(P0[8 * s + 2], P0[8 * s + 3]); a4.z = cvtpk(P0[8 * s + 4], P0[8 * s + 5]); a4.w = cvtpk(P0[8 * s + 6], P0[8 * s + 7]); \
            b4.x = cvtpk(P1[8 * s + 0], P1[8 * s + 1]); b4.y = cvtpk(P1[8 * s + 2], P1[8 * s + 3]); b4.z = cvtpk(P1[8 * s + 4], P1[8 * s + 5]); b4.w = cvtpk(P1[8 * s + 6], P1[8 * s + 7]); \
            pkn[s] = __builtin_bit_cast(bf16x8, a4); pkn[2 + s] = __builtin_bit_cast(bf16x8, b4); } } while (0)
#define ATT_STEP(P0, P1, N0, N1, T) do { \
        const bool more = (T) + 1 < NT, more2 = (T) + 2 < NT; \
        if (more2 && kload) kreg = *(const GAS u32x4*)(kg + (size_t)ATT_TI((T) + 2) * 64 * KROWB); \
        if (more) vreg = *(const GAS u32x4*)(vg + (size_t)ATT_TI((T) + 1) * 64 * 128); \
        float fsc = 1.f; bool resc; bf16x8 pkn[4]; \
        if (!YORD) { ATT_MPART(N0, N1, T); __builtin_amdgcn_sched_barrier(0); ATT_VPART(P0, P1, N0, N1); } \
        else { ATT_VPART(P0, P1, N0, N1); __builtin_amdgcn_sched_barrier(0); ATT_MPART(N0, N1, T); \
            if (__builtin_expect(resc, 0)) { _Pragma("unroll") for (int r = 0; r < 16; ++r) { o[0][r] *= fsc; o[1][r] *= fsc; } } } \
        _Pragma("unroll") for (int s = 0; s < 4; ++s) pk[s] = pkn[s]; \
        if (more2 && kload) *(LAS u32x4*)(Kb + ((T) & 1) * KBUF + kdst) = kreg; \
        if (more) *(LAS u32x4*)(Vb + vs_next + vdst) = vreg; \
        __syncthreads(); \
        vs_prev = vs_cur; vs_cur = vs_next; vs_next = (vs_next == 2 * VBUF) ? 0 : vs_next + VBUF; } while (0)
    f32x16 n0, n1;
    for (int t = 0; t < NT; t += 2) {
        ATT_STEP(p0, p1, n0, n1, t);
        ATT_STEP(n0, n1, p0, p1, t + 1);
    }
    {
        LAS const char* vb_ = Vb + vs_prev + vfo;
#pragma unroll
        for (int s_ = 0; s_ < 4; ++s_) {
#pragma unroll
            for (int db_ = 0; db_ < 2; ++db_) {
                const s16x4 lo_ = vtr(vb_ + (16 * s_) * ATT_VS + db_ * 64), hi_ = vtr(vb_ + (16 * s_ + 8) * ATT_VS + db_ * 64);
                const bf16x8 vf_ = __builtin_shufflevector(lo_, hi_, 0, 1, 2, 3, 4, 5, 6, 7);
                o[db_] = __builtin_amdgcn_mfma_f32_32x32x16_bf16(vf_, pk[s_], o[db_], 0, 0, 0);
            }
        }
    }
    __syncthreads();
#undef ATT_STEP
#undef ATT_TI
#undef ATT_VPART
#undef ATT_MPART
    lsum = xhalf_sum(l);
}

__device__ __forceinline__ void store_ot(const f32x16 (&o)[2], bf16_t* dst  , int h) {
#pragma unroll
    for (int db = 0; db < 2; ++db)
#pragma unroll
        for (int g = 0; g < 4; ++g) { u32x2 w; w.x = cvtpk(o[db][4 * g], o[db][4 * g + 1]); w.y = cvtpk(o[db][4 * g + 2], o[db][4 * g + 3]); *(GAS u32x2*)(dst + 32 * db + 8 * g + 4 * h) = w; }
}

#include <hip/hip_bf16.h>
namespace attn64 {
using bf16=__hip_bfloat16;
using bf16x8=__attribute__((ext_vector_type(8)))short;
using s16x4=__attribute__((ext_vector_type(4)))short;
using f32x16=__attribute__((ext_vector_type(16)))float;
using u32x4=__attribute__((ext_vector_type(4)))unsigned;
constexpr int D=64;
constexpr int NW=8,QBLK=32,QB=QBLK*NW,KVBLK=64;

__device__ __forceinline__ int crow(int r,int hi){return (r&3)+8*(r>>2)+4*hi;}
#define SBAR() __builtin_amdgcn_sched_barrier(0)
__device__ __forceinline__ void cmask(f32x16&p0,f32x16&p1,int jb,int qrel,int hi){
  const float NEG=-INFINITY; int kb=64*jb+4*hi;
  #pragma unroll
  for(int r=0;r<16;++r){int kv=kb+(r&3)+8*(r>>2); if(kv>qrel)p0[r]=NEG; if(kv+32>qrel)p1[r]=NEG;}
}

constexpr int NSLOT=3, SLOTB=8192;
constexpr int LDS_K=0, LDS_V=NSLOT*SLOTB, LDS_WS=2*NSLOT*SLOTB, LDS_OST=LDS_WS+NW*64*4, LDS_BYTES=LDS_OST+NW*4096;
constexpr float C2=0.125f*1.4426950408889634f;
__device__ __forceinline__ void glds16(const void*gsrc,unsigned lds_dst){unsigned keep;
  asm volatile("s_mov_b32 %0, m0\n\ts_mov_b32 m0, %2\n\ts_nop 0\n\tglobal_load_lds_dwordx4 %1, off\n\ts_mov_b32 m0, %0":"=&s"(keep):"v"(gsrc),"s"(lds_dst):"memory");}
__device__ __forceinline__ float max3f(float a,float b,float c){float r;asm("v_max3_f32 %0, %1, %2, %3":"=v"(r):"v"(a),"v"(b),"v"(c));return r;}
__device__ __forceinline__ float max2f(float a,float b){float r;asm("v_max_f32_e32 %0, %1, %2":"=v"(r):"v"(a),"v"(b));return r;}
__device__ __forceinline__ float fadd_s(float a,float b){float r;asm("v_add_f32_e32 %0, %1, %2":"=v"(r):"v"(a),"v"(b));return r;}
__device__ __forceinline__ float fsub_s(float a,float b){float r;asm("v_sub_f32_e32 %0, %1, %2":"=v"(r):"v"(a),"v"(b));return r;}
typedef float f32x2_t __attribute__((ext_vector_type(2))); typedef __bf16 bf16x2_t __attribute__((ext_vector_type(2)));
__device__ __forceinline__ unsigned cvtpk_s(float lo,float hi){f32x2_t v={lo,hi};bf16x2_t b=__builtin_convertvector(v,bf16x2_t);return __builtin_bit_cast(unsigned,b);}
#define WAIT_BAR(N) asm volatile("s_waitcnt vmcnt(" #N ") lgkmcnt(0)\n\ts_barrier":::"memory")

template<int NDS_> __device__ __forceinline__ void qkt(f32x16&p0,f32x16&p1,const char*Kslot,const bf16x8*qr,const f32x16&negm,int r32,int hi){
  const char*kb=Kslot+hi*1024+r32*16;
  #pragma unroll
  for(int d0=0;d0<NDS_;++d0){
    const bf16x8 b0=*reinterpret_cast<const bf16x8*>(kb+d0*2048);
    const bf16x8 b1=*reinterpret_cast<const bf16x8*>(kb+d0*2048+512);
    if(d0==0){p0=__builtin_amdgcn_mfma_f32_32x32x16_bf16(b0,qr[0],negm,0,0,0);p1=__builtin_amdgcn_mfma_f32_32x32x16_bf16(b1,qr[0],negm,0,0,0);}
    else{p0=__builtin_amdgcn_mfma_f32_32x32x16_bf16(b0,qr[d0],p0,0,0,0);p1=__builtin_amdgcn_mfma_f32_32x32x16_bf16(b1,qr[d0],p1,0,0,0);}}
}
typedef __attribute__((address_space(3))) const char* lds_cptr;
typedef short v4i16_t __attribute__((ext_vector_type(4)));
__device__ __forceinline__ void kload8(bf16x8*kf,lds_cptr kp){
  kf[0]=*(const __attribute__((address_space(3))) bf16x8*)(kp);      kf[1]=*(const __attribute__((address_space(3))) bf16x8*)(kp+512);
  kf[2]=*(const __attribute__((address_space(3))) bf16x8*)(kp+2048); kf[3]=*(const __attribute__((address_space(3))) bf16x8*)(kp+2560);
  kf[4]=*(const __attribute__((address_space(3))) bf16x8*)(kp+4096); kf[5]=*(const __attribute__((address_space(3))) bf16x8*)(kp+4608);
  kf[6]=*(const __attribute__((address_space(3))) bf16x8*)(kp+6144); kf[7]=*(const __attribute__((address_space(3))) bf16x8*)(kp+6656);
}
__device__ __forceinline__ void kload2(bf16x8*kf,lds_cptr kp,int j){ kf[2*j]=*(const __attribute__((address_space(3))) bf16x8*)(kp+j*2048); kf[2*j+1]=*(const __attribute__((address_space(3))) bf16x8*)(kp+j*2048+512); }
__device__ __forceinline__ s16x4 vtr(lds_cptr p){ return __builtin_bit_cast(s16x4,__builtin_amdgcn_ds_read_tr16_b64_v4i16((__attribute__((address_space(3))) v4i16_t*)p)); }
__device__ __forceinline__ float rowmax(const f32x16&p0,const f32x16&p1){
  float a=max3f(p0[0],p0[1],p1[0]),b=max3f(p0[2],p0[3],p1[1]);a=max3f(a,p1[2],p1[3]);
  #pragma unroll
  for(int r=4;r<16;r+=4){a=max3f(a,p0[r],p0[r+1]);b=max3f(b,p0[r+2],p0[r+3]);a=max3f(a,p1[r],p1[r+1]);b=max3f(b,p1[r+2],p1[r+3]);}
  const float m=max2f(a,b);
  auto rr=__builtin_amdgcn_permlane32_swap(__float_as_uint(m),__float_as_uint(m),false,false);
  return max2f(__uint_as_float(rr[0]),__uint_as_float(rr[1]));
}
__device__ __forceinline__ void pv(f32x16*o,int vb,bf16x8 pa0,bf16x8 pa1,bf16x8 pa2,bf16x8 pa3){
  #pragma unroll
  for(int d0=0;d0<2;++d0){s16x4 lo[4],hi[4];
    #pragma unroll
    for(int ks=0;ks<4;++ks){
      asm volatile("ds_read_b64_tr_b16 %0,%1 offset:%c2":"=&v"(lo[ks]):"v"(vb),"i"(d0*4096+ks*1024):"memory");
      asm volatile("ds_read_b64_tr_b16 %0,%1 offset:%c2":"=&v"(hi[ks]):"v"(vb),"i"(d0*4096+ks*1024+512):"memory");}
    asm volatile("s_waitcnt lgkmcnt(0)":::"memory");SBAR();
    #define PK(k) (bf16x8){lo[k][0],lo[k][1],lo[k][2],lo[k][3],hi[k][0],hi[k][1],hi[k][2],hi[k][3]}
    o[d0]=__builtin_amdgcn_mfma_f32_32x32x16_bf16(pa0,PK(0),o[d0],0,0,0);
    o[d0]=__builtin_amdgcn_mfma_f32_32x32x16_bf16(pa1,PK(1),o[d0],0,0,0);
    o[d0]=__builtin_amdgcn_mfma_f32_32x32x16_bf16(pa2,PK(2),o[d0],0,0,0);
    o[d0]=__builtin_amdgcn_mfma_f32_32x32x16_bf16(pa3,PK(3),o[d0],0,0,0);
    #undef PK
  }
}

#ifndef ATTN_STORE16
#define ATTN_STORE16(p,v) (*(GAS u32x4*)(p)=(v))
#endif
__device__ __forceinline__ void stage_store(const f32x16 (&o)[2],bf16*Ow,int op,char*shm,int wid,int lane,int r32,int hi){
  bf16*stg=(bf16*)(shm+LDS_OST)+wid*2048;
  #pragma unroll
  for(int r=0;r<16;++r){const int orow=crow(r,hi);
    #pragma unroll
    for(int d0=0;d0<2;++d0)stg[orow*64+d0*32+r32]=__float2bfloat16(o[d0][r]);}
  asm volatile("s_waitcnt lgkmcnt(0)":::"memory");
  #pragma unroll
  for(int i=0;i<4;++i){const int row=i*8+(lane>>3),ch=lane&7; const u32x4 v=*(const u32x4*)(stg+row*64+ch*8); ATTN_STORE16(Ow+(long)row*op+ch*8,v);}
}
template<int THRL,int MODE,int DQ> __device__ __forceinline__ void attn_unit(const bf16*Qw0,int qp,const bf16*__restrict__ Kh,int kp,const bf16*__restrict__ Vh,int vp,int NT,bf16*Ow0,int op,char*shm,f32x16 (&oret)[2]){
  constexpr int NDS=DQ/16;
  const int tid=opaque_tid(),lane=tid&63,r32=lane&31,hi=lane>>5; const int wid=__builtin_amdgcn_readfirstlane(tid>>6);
  const bf16*Qw=Qw0+(long)(wid*QBLK)*qp;
  const unsigned lds0=(unsigned)(uintptr_t)shm;
  float*wsf=(float*)(shm+LDS_WS)+wid*64;
  const int kch=(DQ==64)?wid:(wid&3);
  const bf16*ksrc=Kh+(long)lane*kp+kch*8;
  const bf16*vsrc=Vh+(long)(16*(wid&3)+(lane>>2))*vp+(wid>>2)*32+(lane&3)*8;
  const unsigned kdst=lds0+LDS_K+kch*1024, vdst=lds0+LDS_V+wid*1024;
  #define DMA_K(t,slot) glds16(ksrc+(long)(t)*KVBLK*kp,(unsigned)__builtin_amdgcn_readfirstlane(kdst+(slot)))
  #define DMA_V(t,slot) glds16(vsrc+(long)(t)*KVBLK*vp,(unsigned)__builtin_amdgcn_readfirstlane(vdst+(slot)))
  const int vb0=(int)(lds0+LDS_V)+((lane>>4)&1)*32+(lane&3)*8+(4*hi+((lane&15)>>2))*64;
  const char*Kbase=shm+LDS_K; bf16x8 kf[8];
  const lds_cptr shm3=(lds_cptr)shm; const lds_cptr kp0=shm3+LDS_K+hi*1024+r32*16; const lds_cptr vp0=shm3+LDS_V+((lane>>4)&1)*32+(lane&3)*8+(4*hi+((lane&15)>>2))*64;
  DMA_K(0,0);DMA_V(0,0);DMA_K(1,SLOTB);
  bf16x8 qr[4];
  #pragma unroll
  for(int d0=0;d0<NDS;++d0)qr[d0]=*(const GAS bf16x8*)(&Qw[(long)r32*qp+d0*16+hi*8]);
  float mhat=0.f,l_reg=0.f;f32x16 o[2];o[0]=f32x16{};o[1]=f32x16{};f32x16 negm=f32x16{};asm volatile("":"+v"(negm));
  #define CMASK(P0,P1,t) do{}while(0)
  bool resc=false;
  #define START(P0,P1) do{ const float rm=rowmax(P0,P1); resc=false; \
    { const float dl=rm; mhat=fadd_s(mhat,dl); \
      _Pragma("unroll") for(int r=0;r<16;++r){P0[r]=fsub_s(P0[r],dl);P1[r]=fsub_s(P1[r],dl);} \
      _Pragma("unroll") for(int r=0;r<16;++r)negm[r]=-mhat; asm volatile("":"+v"(negm)); } \
    _Pragma("unroll") for(int r=0;r<16;++r)P0[r]=__builtin_amdgcn_exp2f(P0[r]); }while(0)
  #define RESC() do{ if(resc){ asm volatile("s_waitcnt lgkmcnt(0)":::"memory"); \
      _Pragma("unroll") for(int d_=0;d_<2;++d_) _Pragma("unroll") for(int r=0;r<16;++r)o[d_][r]*=wsf[crow(r,hi)]; } }while(0)
  f32x16 pA0,pA1,pB0,pB1;
  int sl_prev=0,sl_cur=0,sl_next=SLOTB;
  #define ROT() do{sl_prev=sl_cur;sl_cur=sl_next;sl_next=(sl_next==(NSLOT-1)*SLOTB)?0:sl_next+SLOTB;}while(0)
  DMA_K(2,2*SLOTB);
  WAIT_BAR(3);
  qkt<NDS>(pA0,pA1,Kbase,qr,negm,r32,hi);asm volatile("s_nop 15\n\ts_nop 7":"+v"(pA0),"+v"(pA1));CMASK(pA0,pA1,0);
  START(pA0,pA1);
  _Pragma("unroll") for(int r=0;r<16;++r)pA1[r]=__builtin_amdgcn_exp2f(pA1[r]);
  WAIT_BAR(0);
  DMA_K(3,0);DMA_V(1,SLOTB);
  ROT();
  if constexpr(DQ==64) kload8(kf,kp0+sl_cur); else { kload2(kf,kp0+sl_cur,0); kload2(kf,kp0+sl_cur,1); }
  WAIT_BAR(2);
  s16x4 vlo[8],vhi[8]; u32x4 pw0,pw1,pw2,pw3;
  #define PKW(P,B) cvtpk_s(P[B],P[B+1])
  #define PAF(k) __builtin_bit_cast(bf16x8,pw##k)
  #define VFR(i) (bf16x8){vlo[i][0],vlo[i][1],vlo[i][2],vlo[i][3],vhi[i][0],vhi[i][1],vhi[i][2],vhi[i][3]}
  #define PIN(x) asm volatile("":"+v"(x))
  #define MX3(a,b,c) __builtin_fmaxf(__builtin_fmaxf((a),(b)),(c))
  #define GAPA(MF,A0,A1,A2,A3,W0,W1,PW) do{ MF; sacc+=A0; sacc+=A1; sacc+=A2; sacc+=A3; PIN(sacc); W0; W1; PIN(PW); SBAR(); }while(0)
  #define EX(v) __builtin_amdgcn_exp2f(v)
  #define GAPB(MF,X,B) do{ MF; X[B]=EX(X[B]); X[B+1]=EX(X[B+1]); X[B+2]=EX(X[B+2]); X[B+3]=EX(X[B+3]); PIN(X); SBAR(); }while(0)
  #define VRD(i) do{ vlo[i]=vtr(vp_+(((i)>>2)*4096+((i)&3)*1024)); vhi[i]=vtr(vp_+(((i)>>2)*4096+((i)&3)*1024+512)); }while(0)
  #define KRD(G,j) do{ if(G){ kload2(kf,kp0+sl_next,j); SBAR(); } }while(0)
  #define STEP(C0,C1,P0,P1,t,GK,GV,GL) do{ SBAR(); \
    const lds_cptr vp_=vp0+sl_prev; \
    VRD(0); SBAR(); float sacc=(P0[0]+P0[1]); \
    GAPA(C0=__builtin_amdgcn_mfma_f32_32x32x16_bf16(kf[0],qr[0],negm,0,0,0), P0[2],P0[3],P0[4],P0[5],     pw0[0]=PKW(P0,0), pw0[1]=PKW(P0,2), pw0); \
    VRD(4); SBAR(); GAPA(C1=__builtin_amdgcn_mfma_f32_32x32x16_bf16(kf[1],qr[0],negm,0,0,0), P0[6],P0[7],P0[8],P0[9],     pw0[2]=PKW(P0,4), pw0[3]=PKW(P0,6), pw0); \
    VRD(1); SBAR(); GAPA(C0=__builtin_amdgcn_mfma_f32_32x32x16_bf16(kf[2],qr[1],C0,0,0,0),   P0[10],P0[11],P0[12],P0[13], pw1[0]=PKW(P0,8), pw1[1]=PKW(P0,10), pw1); \
    VRD(5); SBAR(); GAPA(C1=__builtin_amdgcn_mfma_f32_32x32x16_bf16(kf[3],qr[1],C1,0,0,0),   P0[14],P0[15],P1[0],P1[1],   pw1[2]=PKW(P0,12),pw1[3]=PKW(P0,14), pw1); \
    VRD(2); SBAR(); GAPA(if constexpr(DQ==64) C0=__builtin_amdgcn_mfma_f32_32x32x16_bf16(kf[4],qr[2],C0,0,0,0),   P1[2],P1[3],P1[4],P1[5],     pw2[0]=PKW(P1,0), pw2[1]=PKW(P1,2), pw2); \
    VRD(6); SBAR(); GAPA(if constexpr(DQ==64) C1=__builtin_amdgcn_mfma_f32_32x32x16_bf16(kf[5],qr[2],C1,0,0,0),   P1[6],P1[7],P1[8],P1[9],     pw2[2]=PKW(P1,4), pw2[3]=PKW(P1,6), pw2); \
    VRD(3); SBAR(); GAPA(if constexpr(DQ==64) C0=__builtin_amdgcn_mfma_f32_32x32x16_bf16(kf[6],qr[3],C0,0,0,0),   P1[10],P1[11],P1[12],P1[13], pw3[0]=PKW(P1,8), pw3[1]=PKW(P1,10), pw3); \
    VRD(7); SBAR(); GAPA(if constexpr(DQ==64) C1=__builtin_amdgcn_mfma_f32_32x32x16_bf16(kf[7],qr[3],C1,0,0,0),   P1[14],P1[15],0.f,0.f,       pw3[2]=PKW(P1,12),pw3[3]=PKW(P1,14), pw3); \
    l_reg+=sacc; \
    if(GK){DMA_K((t)+3,sl_cur);} if(GV){DMA_V((t)+1,sl_next);} \
    CMASK(C0,C1,t); \
    { float a=MX3(C0[0],C0[1],C1[0]),b=MX3(C0[2],C0[3],C1[1]); a=MX3(a,C1[2],C1[3]); \
      _Pragma("unroll") for(int r=4;r<16;r+=4){a=MX3(a,C0[r],C0[r+1]);b=MX3(b,C0[r+2],C0[r+3]);a=MX3(a,C1[r],C1[r+1]);b=MX3(b,C1[r+2],C1[r+3]);} \
      float rm=__builtin_fmaxf(a,b); { auto rr=__builtin_amdgcn_permlane32_swap(__float_as_uint(rm),__float_as_uint(rm),false,false); rm=__builtin_fmaxf(__uint_as_float(rr[0]),__uint_as_float(rr[1])); } \
      resc=false; \
      if(__builtin_expect(__any(rm>(float)THRL),0)){ const float dl=__builtin_fmaxf(rm,0.f); mhat+=dl; \
        _Pragma("unroll") for(int r=0;r<16;++r){C0[r]-=dl;C1[r]-=dl;} \
        _Pragma("unroll") for(int r=0;r<16;++r)negm[r]=-mhat; asm volatile("":"+v"(negm)); \
        const float f=__builtin_amdgcn_exp2f(-dl); l_reg*=f; if(hi==0)wsf[r32]=f; resc=true; } } \
    SBAR(); \
    GAPB(o[0]=__builtin_amdgcn_mfma_f32_32x32x16_bf16(PAF(0),VFR(0),o[0],0,0,0), C0,0); \
    GAPB(o[1]=__builtin_amdgcn_mfma_f32_32x32x16_bf16(PAF(0),VFR(4),o[1],0,0,0), C0,4); \
    KRD(GL,0); GAPB(o[0]=__builtin_amdgcn_mfma_f32_32x32x16_bf16(PAF(1),VFR(1),o[0],0,0,0), C0,8); \
    KRD(GL,1); GAPB(o[1]=__builtin_amdgcn_mfma_f32_32x32x16_bf16(PAF(1),VFR(5),o[1],0,0,0), C0,12); \
    if constexpr(DQ==64) KRD(GL,2); GAPB(o[0]=__builtin_amdgcn_mfma_f32_32x32x16_bf16(PAF(2),VFR(2),o[0],0,0,0), C1,0); \
    if constexpr(DQ==64) KRD(GL,3); GAPB(o[1]=__builtin_amdgcn_mfma_f32_32x32x16_bf16(PAF(2),VFR(6),o[1],0,0,0), C1,4); \
    GAPB(o[0]=__builtin_amdgcn_mfma_f32_32x32x16_bf16(PAF(3),VFR(3),o[0],0,0,0), C1,8); \
    GAPB(o[1]=__builtin_amdgcn_mfma_f32_32x32x16_bf16(PAF(3),VFR(7),o[1],0,0,0), C1,12); \
    }while(0)
  int t=1;
  #undef CMASK
  #define CMASK(P0,P1,t) do{}while(0)
  for(;t+5<NT;t+=2){
    STEP(pB0,pB1,pA0,pA1,t,true,true,true);     WAIT_BAR(2); RESC(); ROT();
    STEP(pA0,pA1,pB0,pB1,t+1,true,true,true);   WAIT_BAR(2); RESC(); ROT();
  }
  #undef CMASK
  #define CMASK(P0,P1,t) do{}while(0)
  #define ENDW(tt) do{ if((tt)+3<NT){WAIT_BAR(2);} else if((tt)+2<NT){WAIT_BAR(1);} else {WAIT_BAR(0);} }while(0)
  for(;t+1<NT;t+=2){
    STEP(pB0,pB1,pA0,pA1,t,(t+3<NT),(t+1<NT),(t+1<NT));       ENDW(t);   RESC(); ROT();
    STEP(pA0,pA1,pB0,pB1,t+1,(t+4<NT),(t+2<NT),(t+2<NT));     ENDW(t+1); RESC(); ROT();
  }
  STEP(pB0,pB1,pA0,pA1,NT-1,false,false,false); RESC();
  { float sacc=pB0[0]+pB0[1]; _Pragma("unroll") for(int r=2;r<16;++r)sacc+=pB0[r]; _Pragma("unroll") for(int r=0;r<16;++r)sacc+=pB1[r]; l_reg+=sacc;
    pw0=(u32x4){PKW(pB0,0),PKW(pB0,2),PKW(pB0,4),PKW(pB0,6)};pw1=(u32x4){PKW(pB0,8),PKW(pB0,10),PKW(pB0,12),PKW(pB0,14)};pw2=(u32x4){PKW(pB1,0),PKW(pB1,2),PKW(pB1,4),PKW(pB1,6)};pw3=(u32x4){PKW(pB1,8),PKW(pB1,10),PKW(pB1,12),PKW(pB1,14)};
    SBAR(); pv(o,vb0+sl_cur,PAF(0),PAF(1),PAF(2),PAF(3)); }
  #undef PKW
  #undef PAF
  #undef VFR
  #undef PIN
  #undef MX3
  #undef GAPA
  #undef GAPB
  #undef EX
  #undef VRD
  #undef KRD
  #undef STEP
  #undef ENDW
  {auto rr=__builtin_amdgcn_permlane32_swap(__float_as_uint(l_reg),__float_as_uint(l_reg),false,false);l_reg=__uint_as_float(rr[0])+__uint_as_float(rr[1]);}
  if(hi==0)wsf[32+r32]=l_reg;asm volatile("s_waitcnt lgkmcnt(0)":::"memory");
  float rli[16];
  #pragma unroll
  for(int r=0;r<16;++r)rli[r]=__builtin_amdgcn_rcpf(wsf[32+crow(r,hi)]);
  #pragma unroll
  for(int r=0;r<16;++r){o[0][r]*=rli[r];o[1][r]*=rli[r];}
  if constexpr(MODE==0){ bf16*Ow=Ow0+(long)(wid*QBLK)*op; stage_store(o,Ow,op,shm,wid,lane,r32,hi); }
  else { oret[0]=o[0]; oret[1]=o[1]; }
  asm volatile("s_waitcnt lgkmcnt(0)\n\ts_barrier":::"memory");
  #undef DMA_K
  #undef DMA_V
  #undef CMASK
  #undef START
  #undef RESC
  #undef ROT
}
#undef SBAR
#undef WAIT_BAR
}

struct AttnArgs { const bf16_t *QG, *QD, *KG, *VG, *KD, *VD, *CB, *PB; bf16_t* MIX; const float* conv_w; const float* conv_b; const float* subln_g; float lam, lam_init; float* dscr; };

__device__ __forceinline__ void attn_gqa_unit(const AttnArgs& A, LAS char* lds, char* lds_generic, int lat, int seq, int qh, int qb) {
    const long R = lat ? 8192L + (long)SLAT * seq : 256L * seq; const int S = lat ? SLAT : 256;
    const size_t grow0 = (lat ? 8192 + (size_t)4096 * seq : (size_t)256 * seq) + 256 * qb;
    const int kvh = qh >> 2;
    int NT = S / 64; asm volatile("" : "+s"(NT));
    typedef attn64::bf16 abf;
    f32x16 dummy[2];
    attn64::attn_unit<8, 0, 64>((const abf*)(A.QG + grow0 * 512 + 64 * qh), 512, (const abf*)(A.KG + (R * 2 + (long)kvh * S) * 64), 64, (const abf*)(A.VG + (R * 2 + (long)kvh * S) * 64), 64, NT,
                                (abf*)(A.MIX + grow0 * 1024 + 64 * qh), 1024, lds_generic, dummy);
}
__device__ __forceinline__ void attn_diff_unit(const AttnArgs& A, LAS char* lds, char* lds_generic, int lat, int seq, int hd, int qb) {
    const int tid_ = opaque_tid(); const int wave = __builtin_amdgcn_readfirstlane(tid_ >> 6), lane = tid_ & 63, r32 = lane & 31, h = lane >> 5;
    const long R = lat ? 8192L + (long)SLAT * seq : 256L * seq; const int S = lat ? SLAT : 256;
    const size_t grow0 = (lat ? 8192 + (size_t)4096 * seq : (size_t)256 * seq) + 256 * qb;
    int NT = S / 64; asm volatile("" : "+s"(NT));
    typedef attn64::bf16 abf;
    const abf* V = (const abf*)(A.VD + (R * 4 + (long)hd * S) * 64);
    f32x16 oa[2], ob[2];
    attn64::attn_unit<8, 1, 32>((const abf*)(A.QD + grow0 * 256 + 64 * hd), 256, (const abf*)(A.KD + (R * 8 + (long)(hd * 2) * S) * 32), 32, V, 64, NT, (abf*)nullptr, 0, lds_generic, oa);
    GAS float* scr = (GAS float*)A.dscr + ((size_t)(blockIdx.x * 8 + wave) * 32) * 64 + lane;
#pragma unroll
    for (int d0 = 0; d0 < 2; ++d0)
#pragma unroll
        for (int r = 0; r < 16; ++r) scr[(d0 * 16 + r) * 64] = oa[d0][r];
    attn64::attn_unit<8, 1, 32>((const abf*)(A.QD + grow0 * 256 + 64 * hd + 32), 256, (const abf*)(A.KD + (R * 8 + (long)(hd * 2 + 1) * S) * 32), 32, V, 64, NT, (abf*)nullptr, 0, lds_generic, ob);
    float ss[16];
#pragma unroll
    for (int r = 0; r < 16; ++r) {
        const float v0 = scr[r * 64] - A.lam * ob[0][r], v1 = scr[(16 + r) * 64] - A.lam * ob[1][r];
        ob[0][r] = v0; ob[1][r] = v1; ss[r] = v0 * v0 + v1 * v1;
    }
#pragma unroll
    for (int o = 1; o < 32; o <<= 1)
#pragma unroll
        for (int r = 0; r < 16; ++r) ss[r] += __shfl_xor(ss[r], o);
    const float g0 = A.subln_g[r32], g1 = A.subln_g[32 + r32], sc = 1.f - A.lam_init;
#pragma unroll
    for (int r = 0; r < 16; ++r) { const float rstd = rsqrtf(ss[r] * (1.f / 64.f) + EPS) * sc; ob[0][r] *= rstd * g0; ob[1][r] *= rstd * g1; }
    attn64::stage_store(ob, (abf*)(A.MIX + (grow0 + 32 * wave) * 1024 + 768 + 64 * hd), 1024, lds_generic, wave, lane, r32, h);
}

__device__ __forceinline__ void attn_phase(const AttnArgs& A, LAS char* lds, char* lds_generic, int G) {
    for (int u = blockIdx.x; u < 2048; u += G) {
        if (u < 512) { const int b = u & 7, r = u >> 3; attn_diff_unit(A, lds, lds_generic, 1, b, r >> 4, r & 15); }
        else if (u < 1536) { const int v = u - 512, b = v & 7, r = v >> 3; attn_gqa_unit(A, lds, lds_generic, 1, b, r & 7, r >> 3); }
        else { const int v = u - 1536;
            if (v < 128) attn_diff_unit(A, lds, lds_generic, 0, v >> 2, v & 3, 0);
            else if (v < 256) { const int w = 2 * (v - 128); attn_gqa_unit(A, lds, lds_generic, 0, w >> 3, w & 7, 0); }
            else if (v >= 384) { const int w = 2 * (v - 384) + 1; attn_gqa_unit(A, lds, lds_generic, 0, w >> 3, w & 7, 0); } }
    }
    const int tid_c = opaque_tid();
    for (int idx = blockIdx.x * 512 + tid_c; idx < M_ALL * 32; idx += G * 512) {
        const int row = idx >> 5, c8 = (idx & 31) * 8;
        int t, S; if (row < M_CTX) { t = row & 255; S = 256; } else { t = (row - M_CTX) & 4095; S = 4096; }
        const u32x4 z = {0, 0, 0, 0};
        const u32x4 pc = *(const GAS u32x4*)(A.PB + (size_t)row * 256 + c8);
        const u32x4 pp = t > 0 ? *(const GAS u32x4*)(A.PB + (size_t)(row - 1) * 256 + c8) : z;
        const u32x4 pn = t < S - 1 ? *(const GAS u32x4*)(A.PB + (size_t)(row + 1) * 256 + c8) : z;
        const u32x4 cb = *(const GAS u32x4*)(A.CB + (size_t)row * 256 + c8);
        float res[8];
#pragma unroll
        for (int j = 0; j < 8; ++j) {
            const int sh = (j & 1) * 16;
            const float a = __uint_as_float(((pp[j >> 1] >> sh) & 0xffffu) << 16), b = __uint_as_float(((pc[j >> 1] >> sh) & 0xffffu) << 16), c = __uint_as_float(((pn[j >> 1] >> sh) & 0xffffu) << 16);
            const float g = __uint_as_float(((cb[j >> 1] >> sh) & 0xffffu) << 16);
            const int cc = c8 + j;
            res[j] = g * (A.conv_w[cc] * a + A.conv_w[256 + cc] * b + A.conv_w[512 + cc] * c + A.conv_b[cc]);
        }
        u32x4 w; w.x = cvtpk(res[0], res[1]); w.y = cvtpk(res[2], res[3]); w.z = cvtpk(res[4], res[5]); w.w = cvtpk(res[6], res[7]);
        *(GAS u32x4*)(A.MIX + (size_t)row * 1024 + 512 + c8) = w;
    }
}

__device__ __forceinline__ int sigma_map(int type, int i) {
    if (type == 1) return 8 * ((i >> 2) & 3) + 4 * (i >> 4) + (i & 3);
    if (type == 2) return 16 * ((i >> 3) & 1) + 8 * (i >> 4) + (i & 7);
    return i;
}
__device__ __forceinline__ void in_group(int g, int& Lbase, int& type) {
    const int pn = g >> 3, bj = (g >> 2) & 1, wc = g & 3;
    if (pn < 2) { Lbase = 64 * (4 * pn + wc) + 32 * bj; type = 0; }
    else if (pn == 2) { Lbase = (wc < 2 ? 512 + 64 * wc : 640 + 64 * (wc - 2)) + 32 * bj; type = wc < 2 ? 0 : 1; }
    else if (pn == 3) { Lbase = 768 + 128 * bj + 32 * wc; type = 1; }
    else if (pn < 6) { Lbase = 1024 + 256 * bj + 128 * (pn - 4) + 32 * wc; type = 1; }
    else if (pn < 8) { Lbase = (pn == 6 ? 1536 : 1792) + 64 * wc + 32 * bj; type = 2; }
    else { Lbase = 2048 + 64 * wc + 32 * bj; type = 1; }
}
__device__ __forceinline__ void transpose_item(const float* W, int K, int N, bf16_t* WT, int k0, int nphys0, int Lbase, int type, LAS float* scr, int lane) {
#pragma unroll 8
    for (int i = 0; i < 32; ++i) { const int kk = 2 * i + (lane >> 5); scr[kk * 33 + (lane & 31)] = ((const GAS float*)W)[(size_t)(k0 + kk) * N + Lbase + (lane & 31)]; }
    asm volatile("s_waitcnt lgkmcnt(0)" ::: "memory");
    const int c = lane & 7;
#pragma unroll
    for (int j = 0; j < 4; ++j) { const int n = (lane >> 3) + 8 * j; const LAS float* s = scr + (8 * c) * 33 + sigma_map(type, n);
        u32x4 o; o.x = cvtpk(s[0 * 33], s[1 * 33]); o.y = cvtpk(s[2 * 33], s[3 * 33]); o.z = cvtpk(s[4 * 33], s[5 * 33]); o.w = cvtpk(s[6 * 33], s[7 * 33]);
        *(GAS u32x4*)(WT + (size_t)(nphys0 + n) * K + k0 + 8 * c) = o; }
    asm volatile("s_waitcnt lgkmcnt(0)" ::: "memory");
}

struct Params {
    const float *x_prompt, *x_sample, *cache_gk, *cache_gv, *cache_dk, *cache_dv, *c, *c_ctx;
    const float *w_mod, *b_mod, *norm1_g, *w_in, *gqa_qn_g, *gqa_kn_g, *conv_w, *conv_b, *diff_qn_g, *diff_kn_g, *diff_lambda, *diff_subln_g, *w_out, *norm2_g, *ffn_up, *ffn_conv_w, *ffn_conv_b, *ffn_down;
    float* out; unsigned char* ws;
    float lam_init[4];
    int ph_lo, ph_hi;
};

__device__ __forceinline__ void prologue(const Params& P, LAS unsigned char* lds, int G) {
    const int tid = opaque_tid(), lane = tid & 63, wave = __builtin_amdgcn_readfirstlane(tid >> 6);
    float* MODS = (float*)(P.ws + WS_MODS); float* MISC = (float*)(P.ws + WS_MISC);
    if ((int)blockIdx.x < 384) {
        LAS float* sc = (LAS float*)lds;
        LAS float* part = (LAS float*)(lds + 49152);
        for (int i = tid; i < NCOND * 1024; i += 512) { const int ci = i >> 10, k = i & 1023; const float v = ci == 0 ? P.c_ctx[k] : P.c[(ci - 1) * 1024 + k]; sc[k * 12 + ci] = v / (1.f + __expf(-v)); }
        __syncthreads();
        for (int it = blockIdx.x; it < 384; it += G) {
            const int l = it / 96, col = (it % 96) * 64 + lane;
            const float* w = P.w_mod + (size_t)l * 1024 * 6144 + col;
            float acc[NCOND];
#pragma unroll
            for (int ci = 0; ci < NCOND; ++ci) acc[ci] = 0.f;
#pragma unroll 8
            for (int kk = 0; kk < 128; ++kk) { const int k = wave * 128 + kk; const float wv = ((const GAS float*)w)[(size_t)k * 6144];
                const f32x4 s0 = *(LAS f32x4*)(sc + k * 12), s1 = *(LAS f32x4*)(sc + k * 12 + 4); const float s8 = sc[k * 12 + 8];
                acc[0] += s0[0] * wv; acc[1] += s0[1] * wv; acc[2] += s0[2] * wv; acc[3] += s0[3] * wv; acc[4] += s1[0] * wv; acc[5] += s1[1] * wv; acc[6] += s1[2] * wv; acc[7] += s1[3] * wv; acc[8] += s8 * wv; }
#pragma unroll
            for (int ci = 0; ci < NCOND; ++ci) part[(wave * NCOND + ci) * 64 + lane] = acc[ci];
            __syncthreads();
            for (int i = tid; i < NCOND * 64; i += 512) { const int ci = i >> 6, cc = i & 63; float s = 0.f;
#pragma unroll
                for (int w8 = 0; w8 < 8; ++w8) s += part[(w8 * NCOND + ci) * 64 + cc];
                const int j = (it % 96) * 64 + cc; MODS[((size_t)l * NCOND + ci) * 6144 + j] = s + P.b_mod[l * 6144 + j]; }
            __syncthreads();
        }
    }
    if ((int)blockIdx.x == G - 1) {
        if (tid < 4) { const float* lf = P.diff_lambda + tid * 128; float s1 = 0.f, s2 = 0.f; for (int i = 0; i < 32; ++i) { s1 += lf[i] * lf[32 + i]; s2 += lf[64 + i] * lf[96 + i]; }
            MISC[MI_LAM + tid] = expf(s1) - expf(s2) + P.lam_init[tid]; }
        for (int i = tid; i < 1024; i += 512) { const int pos = i >> 4, idx = i & 15; const float fr = powf(10000.f, -(float)idx / 16.f); const float ang = (float)pos * fr; MISC[MI_R64C + i] = cosf(ang); MISC[MI_R64S + i] = sinf(ang); }
        for (int i = tid; i < 512; i += 512) { const int pos = i >> 3, idx = i & 7; const float fr = powf(10000.f, -(float)idx / 8.f); const float ang = (float)pos * fr; MISC[MI_R32C + i] = cosf(ang); MISC[MI_R32S + i] = sinf(ang); }
    }
    __syncthreads();
    LAS float* scr = (LAS float*)(lds + wave * 16384);
    const int gw = blockIdx.x * 8 + wave, NGW = G * 8;
    constexpr int I_IN = 16 * 72, I_OUT = 16 * 32, I_UP = 16 * 176, I_DN = 44 * 32, I_L = I_IN + I_OUT + I_UP + I_DN;
    for (int it = gw; it < DEPTH * I_L; it += NGW) {
        const int l = it / I_L; int r = it % I_L;
        if (r < I_IN) { const int kb = r / 72, g = r % 72; int Lb, ty; in_group(g, Lb, ty);
            transpose_item(P.w_in + (size_t)l * 1024 * INW, 1024, INW, (bf16_t*)(P.ws + WS_WIN) + (size_t)l * INW * 1024, kb * 64, g * 32, Lb, ty, scr, lane); continue; }
        r -= I_IN;
        if (r < I_OUT) { const int kb = r / 32, g = r % 32;
            transpose_item(P.w_out + (size_t)l * 1024 * 1024, 1024, 1024, (bf16_t*)(P.ws + WS_WOUT) + (size_t)l * 1024 * 1024, kb * 64, g * 32, g * 32, 1, scr, lane); continue; }
        r -= I_OUT;
        if (r < I_UP) { const int kb = r / 176, g = r % 176; const int pn = g >> 3, bj = (g >> 2) & 1, wc = g & 3;
            transpose_item(P.ffn_up + (size_t)l * 1024 * UPW, 1024, UPW, (bf16_t*)(P.ws + WS_WUP) + (size_t)l * UPW * 1024, kb * 64, g * 32, bj * DFF + 128 * pn + 32 * wc, 1, scr, lane); continue; }
        r -= I_UP;
        { const int kb = r / 32, g = r % 32;
            transpose_item(P.ffn_down + (size_t)l * DFF * 1024, DFF, 1024, (bf16_t*)(P.ws + WS_WDN) + (size_t)l * 1024 * DFF, kb * 64, g * 32, g * 32, 1, scr, lane); }
    }
}

__device__ __forceinline__ void norm_phase(const float* xin_ctx, const float* xin_lat, const bf16_t* xin_b  , const float* ng, const float* mods_l  , int sh_idx, bf16_t* XN, int G) {
    const int tid_ = opaque_tid(); const int lane = tid_ & 63, wave = __builtin_amdgcn_readfirstlane(tid_ >> 6);
    const int nw = G * 8, gw = blockIdx.x * 8 + wave;
    const int per = (M_ALL + nw - 1) / nw;
    const int r0 = gw * per, r1 = min(r0 + per, M_ALL);
    int cur_ci = -1; f32x4 Aa[4], Bb[4];
    f32x4 v[4], vn[4];
#define NORM_LOAD_ROW(R_) do { const int rr_ = (R_); \
        if (xin_b) { _Pragma("unroll") for (int jj = 0; jj < 2; ++jj) { const u32x4 q_ = *(const GAS u32x4*)(xin_b + (size_t)rr_ * DM + 8 * lane + 512 * jj); \
                vn[2 * jj] = (f32x4){__uint_as_float(q_.x << 16), __uint_as_float(q_.x & 0xffff0000u), __uint_as_float(q_.y << 16), __uint_as_float(q_.y & 0xffff0000u)}; \
                vn[2 * jj + 1] = (f32x4){__uint_as_float(q_.z << 16), __uint_as_float(q_.z & 0xffff0000u), __uint_as_float(q_.w << 16), __uint_as_float(q_.w & 0xffff0000u)}; } } \
        else { const float* xr_ = rr_ < M_CTX ? xin_ctx + (size_t)rr_ * DM : xin_lat + (size_t)(rr_ - M_CTX) * DM; \
            _Pragma("unroll") for (int jj = 0; jj < 2; ++jj) { vn[2 * jj] = *(const GAS f32x4*)(xr_ + 8 * lane + 512 * jj); vn[2 * jj + 1] = *(const GAS f32x4*)(xr_ + 8 * lane + 512 * jj + 4); } } } while (0)
    if (r0 < r1) NORM_LOAD_ROW(r0);
    for (int row = r0; row < r1; ++row) {
#pragma unroll
        for (int j = 0; j < 4; ++j) v[j] = vn[j];
        if (row + 1 < r1) NORM_LOAD_ROW(row + 1);
        const int ci = row < M_CTX ? 0 : 1 + ((row - M_CTX) >> 12);
        if (ci != cur_ci) { cur_ci = ci; const float* sh = mods_l + ci * 6144 + sh_idx * 1024; const float* sc = sh + 1024;
#pragma unroll
            for (int j = 0; j < 4; ++j) { const int c = 8 * lane + 512 * (j >> 1) + 4 * (j & 1); const f32x4 g4 = *(const GAS f32x4*)(ng + c), s4 = *(const GAS f32x4*)(sc + c); Aa[j] = g4 * (1.f + s4); Bb[j] = *(const GAS f32x4*)(sh + c); } }
        float s = 0.f;
#pragma unroll
        for (int j = 0; j < 4; ++j) s += (v[j][0] * v[j][0] + v[j][1] * v[j][1]) + (v[j][2] * v[j][2] + v[j][3] * v[j][3]);
#pragma unroll
        for (int o = 1; o < 64; o <<= 1) s += __shfl_xor(s, o);
        const float rstd = rsqrtf(s * (1.f / DM) + EPS);
#pragma unroll
        for (int jj = 0; jj < 2; ++jj) { const f32x4 y0 = v[2 * jj] * rstd * Aa[2 * jj] + Bb[2 * jj], y1 = v[2 * jj + 1] * rstd * Aa[2 * jj + 1] + Bb[2 * jj + 1];
            u32x4 w; w.x = cvtpk(y0[0], y0[1]); w.y = cvtpk(y0[2], y0[3]); w.z = cvtpk(y1[0], y1[1]); w.w = cvtpk(y1[2], y1[3]);
            *(GAS u32x4*)(XN + (size_t)row * DM + 8 * lane + 512 * jj) = w; }
    }
#undef NORM_LOAD_ROW
}

__device__ __forceinline__ void cache_phase(const Params& P, int l, int G) {
    bf16_t* KG = (bf16_t*)(P.ws + WS_KG); bf16_t* VG = (bf16_t*)(P.ws + WS_VG); bf16_t* KD = (bf16_t*)(P.ws + WS_KD); bf16_t* VD = (bf16_t*)(P.ws + WS_VD);
    const int tid_ = opaque_tid();
    for (int i = blockIdx.x * 512 + tid_; i < 65536; i += G * 512) {
        const int d4 = (i & 15) * 4, kvh = (i >> 4) & 1, p = (i >> 5) & 255, b = i >> 13;
        const size_t src = ((((size_t)b * 4 + l) * 256 + p) * 2 + kvh) * 64 + d4;
        const size_t dst = (((8192L + (long)SLAT * b) * 2 + (long)kvh * SLAT + 4096 + p) * 64);
        const int pk4 = (d4 & 32) | ((d4 & 12) << 1) | ((d4 & 16) >> 2);
        const f32x4 k = *(const GAS f32x4*)(P.cache_gk + src), v = *(const GAS f32x4*)(P.cache_gv + src);
        u32x2 wk, wv; wk.x = cvtpk(k[0], k[1]); wk.y = cvtpk(k[2], k[3]); wv.x = cvtpk(v[0], v[1]); wv.y = cvtpk(v[2], v[3]);
        *(GAS u32x2*)(KG + dst + pk4) = wk; *(GAS u32x2*)(VG + dst + d4) = wv;
    }
    for (int i = blockIdx.x * 512 + tid_; i < 131072; i += G * 512) {
        { const int d4 = (i & 7) * 4, hc = (i >> 3) & 7, p = (i >> 6) & 255, b = i >> 14;
          const size_t src = ((((size_t)b * 4 + l) * 256 + p) * 8 + hc) * 32 + d4;
          const size_t dst = (((8192L + (long)SLAT * b) * 8 + (long)hc * SLAT + 4096 + p) * 32) + ((d4 & 16) | ((d4 & 4) << 1) | ((d4 & 8) >> 1));
          const f32x4 k = *(const GAS f32x4*)(P.cache_dk + src); u32x2 w; w.x = cvtpk(k[0], k[1]); w.y = cvtpk(k[2], k[3]); *(GAS u32x2*)(KD + dst) = w; }
        { const int d4 = (i & 15) * 4, hh = (i >> 4) & 3, p = (i >> 6) & 255, b = i >> 14;
          const size_t src = ((((size_t)b * 4 + l) * 256 + p) * 4 + hh) * 64 + d4;
          const size_t dst = (((8192L + (long)SLAT * b) * 4 + (long)hh * SLAT + 4096 + p) * 64) + d4;
          const f32x4 v = *(const GAS f32x4*)(P.cache_dv + src); u32x2 w; w.x = cvtpk(v[0], v[1]); w.y = cvtpk(v[2], v[3]); *(GAS u32x2*)(VD + dst) = w; }
    }
}

__device__ __forceinline__ void fixup_own_panels(const pg8::StaticOrder& S, const float* cw, bf16_t* F, const float* EP, const float* EA, const float* EU) {
    const int tid_ = opaque_tid();
    pg8::Unit u;
    for (int i = 0; S.next(i, u); ++i) {
        const int pm = u.pm; if (pm < 32) continue;
        const int j = (pm - 32) & 15;
        for (int e = 0; e < 2; ++e) {
            if (e == 0 ? j == 0 : j == 15) continue;
            const size_t eb = ((size_t)pm * 2 + e) * DFF, nb = e == 0 ? ((size_t)(pm - 1) * 2 + 1) * DFF : ((size_t)(pm + 1) * 2 + 0) * DFF;
            const float* w = cw + (e == 0 ? 0 : 2 * DFF);
            const size_t row = (size_t)pm * 256 + (e ? 255 : 0);
            for (int c = tid_ * 2; c < DFF; c += 1024) {
                const f32x2 p = *(const GAS f32x2*)(EP + eb + c), a = *(const GAS f32x2*)(EA + nb + c), uu = *(const GAS f32x2*)(EU + eb + c), ww = *(const GAS f32x2*)(w + c);
                const float f0 = silu_f(p[0] + ww[0] * a[0]) * uu[0], f1 = silu_f(p[1] + ww[1] * a[1]) * uu[1];
                *(GAS unsigned*)(F + row * DFF + c) = cvtpk(f0, f1);
            }
        }
    }
    asm volatile("s_waitcnt vmcnt(0)" ::: "memory");
    __syncthreads();
}
__device__ __forceinline__ void fixup_phase(const float* cw, bf16_t* F, const float* EP, const float* EA, const float* EU, int G) {
    const int tid_ = opaque_tid();
    for (int i = blockIdx.x * 512 + tid_; i < 128 * 2 * DFF; i += G * 512) {
        const int c = i % DFF, e = (i / DFF) & 1, pm = 32 + i / (2 * DFF); const int j = (pm - 32) & 15;
        if (e == 0 ? j == 0 : j == 15) continue;
        const size_t eo = ((size_t)pm * 2 + e) * DFF + c;
        float conv;
        if (e == 0) conv = EP[eo] + cw[c] * EA[((size_t)(pm - 1) * 2 + 1) * DFF + c];
        else conv = EP[eo] + cw[2 * DFF + c] * EA[((size_t)(pm + 1) * 2 + 0) * DFF + c];
        const float f = silu_f(conv) * EU[eo];
        const size_t row = (size_t)pm * 256 + (e ? 255 : 0);
        F[row * DFF + c] = (bf16_t)(cvtpk(f, 0.f) & 0xffffu);
    }
}


#define XB_TMO      128
#define XB_XCNT(j)  (256  + 64 * (j))
#define XB_XSUB(j)  (1280 + 64 * (j))
#define XB_XGEN(j)  (2304 + 64 * (j))
#define XB_TOP      3328
#define XB_TOPGEN   3392
#define XCD_BAR_WORDS 3456
#define XB_SPIN_CAP (1u << 22)
__device__ __forceinline__ unsigned xb_ld(unsigned* p)              { return __hip_atomic_load(p, __ATOMIC_RELAXED, __HIP_MEMORY_SCOPE_AGENT); }
__device__ __forceinline__ unsigned xb_add(unsigned* p, unsigned v) { return __hip_atomic_fetch_add(p, v, __ATOMIC_RELAXED, __HIP_MEMORY_SCOPE_AGENT); }
__device__ __forceinline__ unsigned xb_xcc_id() { return (unsigned)__builtin_amdgcn_s_getreg((3 << 11) | 20) & 0xFu; }
#define XB_SPIN(cond, bar) do { unsigned _sp = 0; while (cond) { __builtin_amdgcn_s_sleep(1); \
    if ((++_sp & 255u) == 0u) { if (xb_ld(&(bar)[XB_TMO])) break; if (_sp > XB_SPIN_CAP) { atomicAdd(&(bar)[XB_TMO], 1u); break; } } } } while (0)
struct XcdBarrier { unsigned* bar; unsigned x; volatile LAS unsigned* st; };
__device__ __forceinline__ XcdBarrier xcd_barrier_post(unsigned* bar, volatile LAS unsigned* st) {
    XcdBarrier b; b.bar = bar; b.x = xb_xcc_id(); b.st = st;
    if (threadIdx.x == 0) (void)xb_add(&bar[XB_XCNT(b.x)], 1u);
    return b;
}
__device__ __forceinline__ void xcd_barrier_complete(unsigned* bar, unsigned x, unsigned& nloc, unsigned& nx) {
    const unsigned G = gridDim.x * gridDim.y * gridDim.z;
    unsigned sum, cnt, mine, sp = 0u;
    for (;;) {
        sum = 0u; cnt = 0u; mine = 0u;
#pragma unroll
        for (unsigned j = 0; j < 16; ++j) { const unsigned c = xb_ld(&bar[XB_XCNT(j)]); sum += c; cnt += (c > 0u) ? 1u : 0u; mine = (j == x) ? c : mine; }
        if (sum == G) break;
        __builtin_amdgcn_s_sleep(1);
        if ((++sp & 255u) == 0u) { if (xb_ld(&bar[XB_TMO])) break; if (sp > XB_SPIN_CAP) { atomicAdd(&bar[XB_TMO], 1u); break; } }
    }
    nloc = mine > 0u ? mine : 1u; nx = cnt > 0u ? cnt : 1u;
}
__device__ __forceinline__ void xcd_barrier(const XcdBarrier& b) {
    asm volatile("s_waitcnt vmcnt(0)" ::: "memory");
    __syncthreads();
    if (threadIdx.x == 0) {
        unsigned* bar = b.bar;
        __builtin_amdgcn_s_waitcnt(0);
        unsigned nloc = b.st[0], nx = b.st[1];
        if (nloc == 0u) { xcd_barrier_complete(bar, b.x, nloc, nx); b.st[0] = nloc; b.st[1] = nx; }
        const unsigned old = xb_add(&bar[XB_XSUB(b.x)], 1u);
        const unsigned gen = old / nloc;
        if (old + 1u == (gen + 1u) * nloc) {
            __builtin_amdgcn_fence(__ATOMIC_RELEASE, "agent");
            asm volatile("s_waitcnt vmcnt(0)" ::: "memory");
            const unsigned og = xb_add(&bar[XB_TOP], 1u);
            const unsigned tg = og / nx;
            if (og + 1u == (tg + 1u) * nx) xb_add(&bar[XB_TOPGEN], 1u);
            else XB_SPIN(xb_ld(&bar[XB_TOPGEN]) == tg, bar);
            __builtin_amdgcn_fence(__ATOMIC_ACQUIRE, "agent");
            xb_add(&bar[XB_XGEN(b.x)], 1u);
            asm volatile("s_waitcnt vmcnt(0)" ::: "memory");
        } else {
            XB_SPIN(xb_ld(&bar[XB_XGEN(b.x)]) == gen, bar);
            __builtin_amdgcn_fence(__ATOMIC_ACQUIRE, "agent");
            asm volatile("s_waitcnt vmcnt(0)" ::: "memory");
        }
    }
    __syncthreads();
}

__global__ void __launch_bounds__(512, 2) fwd_kernel(Params P) {
    extern __shared__ __attribute__((aligned(16))) unsigned char lds_raw[];
    LAS unsigned char* lds = (LAS unsigned char*)lds_raw;
    cg::grid_group grid = cg::this_grid();
    const int G = gridDim.x;
    volatile LAS unsigned* bst = (volatile LAS unsigned*)(lds + MISC_OFF);
    if (threadIdx.x < 2) bst[threadIdx.x] = 0u;
    __syncthreads();
    XcdBarrier bar = xcd_barrier_post((unsigned*)(P.ws + WS_CTL), bst);
    int ph = 0;
#define PHASE_BEGIN if (ph >= P.ph_lo && ph < P.ph_hi) { unsigned char* ws = P.ws; float* outp = P.out; asm volatile("" : "+s"(ws), "+s"(outp));
#define PHASE_END   if (ph + 1 < P.ph_hi) { if (ph == 0) grid.sync(); else xcd_barrier(bar); } } ++ph;
    PHASE_BEGIN
#ifndef SKIP_PRO
        prologue(P, lds, G);
#endif
    PHASE_END
    for (int l = 0; l < DEPTH; ++l) {
        PHASE_BEGIN
            const float* xin_ctx = l == 0 ? P.x_prompt : outp; const float* xin_lat = l == 0 ? P.x_sample : outp + (size_t)M_CTX * DM;
            norm_phase(P.x_prompt, P.x_sample, l == 0 ? (const bf16_t*)nullptr : (const bf16_t*)(ws + WS_XB), P.norm1_g + l * DM, (const float*)(ws + WS_MODS) + (size_t)l * NCOND * 6144, 0, (bf16_t*)(ws + WS_XN), G);
            cache_phase(P, l, G);
        PHASE_END
        PHASE_BEGIN {
            const float* MISC = (const float*)(ws + WS_MISC);
            pg8::Gemm g{(const bf16_t*)(ws + WS_XN), (const bf16_t*)(ws + WS_WIN) + (size_t)l * INW * 1024, M_ALL, INW, 1024}; pg8::StaticOrder S; S.init(M_ALL, INW, G, blockIdx.x);
            EpiIn E{l, P.gqa_qn_g + l * 64, P.gqa_kn_g + l * 64, P.diff_qn_g + l * 32, P.diff_kn_g + l * 32, MISC + MI_R64C, MISC + MI_R64S, MISC + MI_R32C, MISC + MI_R32S,
                    (bf16_t*)(ws + WS_QG), (bf16_t*)(ws + WS_QD), (bf16_t*)(ws + WS_KG), (bf16_t*)(ws + WS_VG), (bf16_t*)(ws + WS_KD), (bf16_t*)(ws + WS_VD), (bf16_t*)(ws + WS_CB), (bf16_t*)(ws + WS_PB), outp};
#ifndef SKIP_IN
            pg8::gemm_phase(lds, lds + XCH_OFF, g, S, E);
#endif
        } PHASE_END
        PHASE_BEGIN {
            const float* MISC = (const float*)(ws + WS_MISC);
            AttnArgs A{(const bf16_t*)(ws + WS_QG), (const bf16_t*)(ws + WS_QD), (const bf16_t*)(ws + WS_KG), (const bf16_t*)(ws + WS_VG), (const bf16_t*)(ws + WS_KD), (const bf16_t*)(ws + WS_VD),
                       (const bf16_t*)(ws + WS_CB), (const bf16_t*)(ws + WS_PB), (bf16_t*)(ws + WS_XN), P.conv_w + l * 768, P.conv_b + l * 256, P.diff_subln_g + l * 64, MISC[MI_LAM + l], P.lam_init[l], (float*)(ws + WS_DSCR)};
#ifndef SKIP_ATT
            attn_phase(A, (LAS char*)lds, (char*)lds_raw, G);
#endif
        } PHASE_END
        PHASE_BEGIN {
            const float* xin_ctx = l == 0 ? P.x_prompt : outp; const float* xin_lat = l == 0 ? P.x_sample : outp + (size_t)M_CTX * DM;
            pg8::Gemm g{(const bf16_t*)(ws + WS_XN), (const bf16_t*)(ws + WS_WOUT) + (size_t)l * 1024 * 1024, M_ALL, 1024, 1024}; pg8::StaticOrder S; S.init(M_ALL, 1024, G, blockIdx.x);
            EpiRes E{P.x_prompt, P.x_sample, outp, (const float*)(ws + WS_MODS) + (size_t)l * NCOND * 6144 + 2 * 1024, l == 0 ? (const bf16_t*)nullptr : (const bf16_t*)(ws + WS_XB), (bf16_t*)(ws + WS_XB)};
#ifndef SKIP_RES
            pg8::gemm_phase(lds, lds + XCH_OFF, g, S, E);
#endif
        } PHASE_END
        PHASE_BEGIN
            norm_phase(nullptr, nullptr, (const bf16_t*)(ws + WS_XB), P.norm2_g + l * DM, (const float*)(ws + WS_MODS) + (size_t)l * NCOND * 6144, 3, (bf16_t*)(ws + WS_XN), G);
        PHASE_END
        PHASE_BEGIN {
            float* EPb = (float*)(ws + WS_EDGE);
            pg8::Gemm g{(const bf16_t*)(ws + WS_XN), (const bf16_t*)(ws + WS_WUP) + (size_t)l * UPW * 1024, M_ALL, UPW, 1024}; pg8::StaticOrder S; S.init(M_ALL, UPW, G, blockIdx.x);
            EpiUp E{P.ffn_conv_w + (size_t)l * 3 * DFF, P.ffn_conv_b + (size_t)l * DFF, (bf16_t*)(ws + WS_U), EPb, EPb + EDGE_ELEMS, EPb + 2 * EDGE_ELEMS};
#ifndef SKIP_UP
            pg8::gemm_phase(lds, lds + XCH_OFF, g, S, E);
#endif
        } PHASE_END
        PHASE_BEGIN {
            pg8::Gemm g{(const bf16_t*)(ws + WS_U), (const bf16_t*)(ws + WS_WDN) + (size_t)l * 1024 * DFF, M_ALL, 1024, DFF}; pg8::StaticOrder S; S.init(M_ALL, 1024, G, blockIdx.x);
            { float* EPb = (float*)(ws + WS_EDGE); fixup_own_panels(S, P.ffn_conv_w + (size_t)l * 3 * DFF, (bf16_t*)(ws + WS_U), EPb, EPb + EDGE_ELEMS, EPb + 2 * EDGE_ELEMS); }
            EpiRes E{nullptr, nullptr, outp, (const float*)(ws + WS_MODS) + (size_t)l * NCOND * 6144 + 5 * 1024, (const bf16_t*)(ws + WS_XB), l + 1 < DEPTH ? (bf16_t*)(ws + WS_XB) : (bf16_t*)nullptr};
#ifndef SKIP_RES
            pg8::gemm_phase(lds, lds + XCH_OFF, g, S, E);
#endif
        } PHASE_END
    }
}

constexpr int N_PHASES = 1 + DEPTH * 7;
#ifndef N_LAUNCH_SPLIT
#define N_LAUNCH_SPLIT 0
#endif

extern "C" void kernel_launch(void* const* d_in, const int* in_sizes, int n_in, void* d_out, int out_size, void* d_ws, size_t ws_size, hipStream_t stream) {
    static int grid = 0;
    if (grid == 0) {
        if (n_in != 26 || ws_size < WS_END) { fprintf(stderr, "kernel_launch: unexpected n_in %d or ws_size %zu (< %zu)\n", n_in, ws_size, (size_t)WS_END); grid = -1; return; }
        int dev = 0, cus = 0, per_cu = 0;
        hipGetDevice(&dev); hipDeviceGetAttribute(&cus, hipDeviceAttributeMultiprocessorCount, dev);
        hipFuncSetAttribute((const void*)fwd_kernel, hipFuncAttributeMaxDynamicSharedMemorySize, LDS_BYTES);
        hipOccupancyMaxActiveBlocksPerMultiprocessor(&per_cu, (const void*)fwd_kernel, 512, LDS_BYTES);
        if (per_cu < 1) { fprintf(stderr, "kernel_launch: occupancy query gives %d\n", per_cu); per_cu = 1; }
        (void)hipGetLastError();
        grid = cus * 1;
    }
    if (grid < 0) return;
    Params p{};
    const float** pp = (const float**)&p;
    for (int i = 0; i < 26; ++i) pp[i] = (const float*)d_in[i];
    p.out = (float*)d_out; p.ws = (unsigned char*)d_ws;
    for (int l = 0; l < 4; ++l) p.lam_init[l] = (float)(0.8 - 0.6 * exp(-0.3 * (double)l));
#if N_LAUNCH_SPLIT
    for (int ph = 0; ph < N_PHASES; ++ph) { p.ph_lo = ph; p.ph_hi = ph + 1; hipLaunchKernelGGL(fwd_kernel, dim3(grid), dim3(512), LDS_BYTES, stream, p); }
#else
    p.ph_lo = 0; p.ph_hi = N_PHASES;
    if (hipMemsetAsync((char*)d_ws + WS_CTL, 0, CTL_ZERO_BYTES, stream) != hipSuccess) { fprintf(stderr, "kernel_launch: memset failed\n"); return; }
    void* args[] = {&p};
    hipError_t e = hipLaunchCooperativeKernel((const void*)fwd_kernel, dim3(grid), dim3(512), args, LDS_BYTES, stream);
    if (e != hipSuccess) fprintf(stderr, "cooperative launch failed: %s (grid %d)\n", hipGetErrorString(e), grid);
#endif
}
```

```cpp
#include <hip/hip_runtime.h>
#include <hip/hip_cooperative_groups.h>
#include <cstdio>
#include <cstdint>
#include <cmath>
namespace cg = cooperative_groups;

#define LAS __attribute__((address_space(3)))
#define GAS __attribute__((address_space(1)))
typedef unsigned short bf16_t;
typedef short bf16x8 __attribute__((ext_vector_type(8)));
typedef short s16x4 __attribute__((ext_vector_type(4)));
typedef float f32x4 __attribute__((ext_vector_type(4)));
typedef float f32x16 __attribute__((ext_vector_type(16)));
typedef unsigned u32x4 __attribute__((ext_vector_type(4)));
typedef unsigned u32x2 __attribute__((ext_vector_type(2)));
typedef float f32x2 __attribute__((ext_vector_type(2)));
typedef __bf16 bf16x2_t __attribute__((ext_vector_type(2)));

__device__ __forceinline__ unsigned cvtpk(float lo, float hi) { f32x2 v = {lo, hi}; bf16x2_t b = __builtin_convertvector(v, bf16x2_t); return __builtin_bit_cast(unsigned, b); }
__device__ __forceinline__ int opaque_tid() { int t = threadIdx.x; asm volatile("" : "+v"(t)); return t; }
__device__ __forceinline__ float bf2f(unsigned short u) { return __uint_as_float(((unsigned)u) << 16); }

constexpr int DM = 1024, DEPTH = 4, NCOND = 9;
constexpr int M_CTX = 8192, M_ALL = 40960, NTM = 160;
constexpr int INW = 2304, DFF = 2816, UPW = 5632;
constexpr int SLAT = 4352;
constexpr float EPS = 1e-6f;
constexpr float LOG2E = 1.4426950408889634f;
constexpr float QSCALE_G = 0.125f * LOG2E;
constexpr float QSCALE_D = 0.17677669529663687f * LOG2E;
constexpr size_t OUT_GK = 41943040, OUT_GV = OUT_GK + 4194304, OUT_DK = OUT_GV + 4194304, OUT_DV = OUT_DK + 8388608;
constexpr size_t MiB = 1u << 20;
constexpr size_t WS_MODS = 1 * MiB;
constexpr size_t WS_MISC = 2 * MiB;
constexpr size_t WS_EDGE = 3 * MiB;
constexpr size_t EDGE_ELEMS = (size_t)NTM * 2 * DFF;
constexpr size_t WS_WIN = 16 * MiB;
constexpr size_t WS_WOUT = 34 * MiB;
constexpr size_t WS_WUP = 42 * MiB;
constexpr size_t WS_WDN = 86 * MiB;
constexpr size_t WS_XN = 108 * MiB;
constexpr size_t WS_U = 188 * MiB;
constexpr size_t WS_QG = WS_U, WS_QD = WS_QG + (size_t)M_ALL * 512 * 2, WS_KG = WS_QD + (size_t)M_ALL * 256 * 2;
constexpr size_t KROWS = 8192 + 8 * SLAT;
constexpr size_t WS_VG = WS_KG + KROWS * 128 * 2, WS_KD = WS_VG + KROWS * 128 * 2, WS_VD = WS_KD + KROWS * 256 * 2;
constexpr size_t WS_CB = WS_VD + KROWS * 256 * 2, WS_PB = WS_CB + (size_t)M_ALL * 256 * 2, WS_UEND = WS_PB + (size_t)M_ALL * 256 * 2;
constexpr size_t WS_DSCR = WS_U + (size_t)M_ALL * DFF * 2;
constexpr size_t WS_XB = WS_DSCR + 16 * MiB;
constexpr size_t WS_END = WS_XB + (size_t)M_ALL * DM * 2;
static_assert(WS_UEND <= WS_DSCR, "union");
constexpr int MI_LAM = 0, MI_R64C = 64, MI_R64S = MI_R64C + 1024, MI_R32C = MI_R64S + 1024, MI_R32S = MI_R32C + 512;

constexpr int RING_BYTES = 131072, XCH_OFF = RING_BYTES, MISC_OFF = RING_BYTES + 4096, LDS_BYTES = RING_BYTES + 4096 + 256;
constexpr size_t WS_CTL = 0, CTL_ZERO_BYTES = 65536;

struct TileInfo {
    int lat, seq, t0, ci, S; long R;
    __device__ __forceinline__ TileInfo(int pm) {
        if (pm < 32) { lat = 0; seq = pm; t0 = 0; ci = 0; S = 256; R = 256L * pm; }
        else { const int b = (pm - 32) >> 4; lat = 1; seq = b; t0 = ((pm - 32) & 15) * 256; ci = 1 + b; S = SLAT; R = 8192L + (long)SLAT * b; }
    }
};

namespace pg8 {
constexpr int BM = 256, BK = 64, HALF = 128, HTB = HALF * BK * 2, NXCD = 8, WGM = 8;
__host__ __device__ __forceinline__ int lds_byte(int r, int c) { const int st = (r >> 4) * 2 + (c >> 5), rr = r & 15, cc = c & 31, ob = rr * 64 + cc * 2; return st * 1024 + (ob ^ (((ob >> 9) & 1) << 5)); }
__host__ __device__ __forceinline__ void stage_rc(int b, int& R, int& C) { const int st = b / 1024, sb = b % 1024, swz = sb ^ (((sb >> 9) & 1) << 5); R = (st >> 1) * 16 + swz / 64; C = (st & 1) * 32 + (swz % 64) / 2; }
struct Unit { int pm, pn; };
struct Gemm { const bf16_t* A; const bf16_t* Bt; int M, N, K; };
struct StaticOrder {
    int nM, nN, nwg, G, c;
    __device__ void init(int M, int N, int G_, int c_) { nM = M / BM; nN = N / BM; nwg = nM * nN; G = G_; c = c_; }
    __device__ bool next(int i, Unit& u) const {
        const long L = (long)i * G + c; if (L >= nwg) return false;
        int wgid = (int)L; { const int q = nwg / NXCD, r = nwg % NXCD, xcd = wgid % NXCD, off = wgid / NXCD; wgid = (xcd < r ? xcd * (q + 1) : r * (q + 1) + (xcd - r) * q) + off; }
        const int nig = WGM * nN, gid = wgid / nig, fm = gid * WGM, gsz = (nM - fm) < WGM ? (nM - fm) : WGM;
        u.pm = fm + ((wgid % nig) % gsz); u.pn = (wgid % nig) / gsz; return true;
    }
};
template <class Epi>
__device__ __forceinline__ void gemm_phase(LAS unsigned char* lds, LAS unsigned char* xlds, const Gemm g, const StaticOrder& S, const Epi& E) {
    const int tid = opaque_tid(), wid = __builtin_amdgcn_readfirstlane(tid >> 6), lane = tid & 63, wr = wid >> 2, wc = wid & 3, fr = lane & 15, fq = lane >> 4;
    const int K = g.K, nt = K / BK;
    unsigned voffA[2];
#pragma unroll
    for (int i = 0; i < 2; ++i) { int R, C; stage_rc(tid * 16 + i * 8192, R, C); voffA[i] = (unsigned)(R * K + C) * 2u; }
    const size_t kstep = (size_t)(BK * 2);
    const size_t hstep = (size_t)HALF * K * 2;
    const size_t tstep = 2 * hstep;
    const unsigned ldsw = (unsigned)wid * 1024u;
    const int aoff = lds_byte(wr * 64 + fr, fq * 8), boff = lds_byte(wc * 32 + fr, fq * 8);
#define PG8_SA(b, h) (((b) * 2 + (h)) * HTB)
#define PG8_SB(b, h) ((4 + (b) * 2 + (h)) * HTB)
#define PG8_STAGE(bufoff, gbase) do { _Pragma("unroll") for (int _i = 0; _i < 2; ++_i) \
        __builtin_amdgcn_global_load_lds((const unsigned*)((const char*)(gbase) + voffA[_i]), (LAS unsigned*)(lds + (bufoff) + ldsw + _i * 8192), 16, 0, 0); } while (0)
#define PG8_LDA(dst, b, h) do { _Pragma("unroll") for (int m = 0; m < 4; ++m) _Pragma("unroll") for (int k = 0; k < 2; ++k) dst[m][k] = *(const LAS bf16x8*)(lds + PG8_SA(b, h) + aoff + m * 2048 + k * 1024); } while (0)
#define PG8_LDB(dst, b, h) do { _Pragma("unroll") for (int n = 0; n < 2; ++n) _Pragma("unroll") for (int k = 0; k < 2; ++k) dst[n][k] = *(const LAS bf16x8*)(lds + PG8_SB(b, h) + boff + n * 2048 + k * 1024); } while (0)
#define PG8_MMA(ai, bj, At, Bt) do { __builtin_amdgcn_s_setprio(1); _Pragma("unroll") for (int m = 0; m < 4; ++m) _Pragma("unroll") for (int n = 0; n < 2; ++n) _Pragma("unroll") for (int k = 0; k < 2; ++k) \
        acc[ai][bj][m][n] = __builtin_amdgcn_mfma_f32_16x16x32_bf16(Bt[n][k], At[m][k], acc[ai][bj][m][n], 0, 0, 0); __builtin_amdgcn_s_setprio(0); } while (0)
#define PG8_WAIT_V(n) asm volatile("s_waitcnt vmcnt(" #n ")" ::: "memory")
#define PG8_WAIT_L(n) asm volatile("s_waitcnt lgkmcnt(" #n ")" ::: "memory")
#define PG8_BAR __builtin_amdgcn_s_barrier()
#define PG8_SCHED __builtin_amdgcn_sched_barrier(0)
    Unit cur, nxt; int ui = 0;
    if (!S.next(0, cur)) return;
    f32x4 acc[2][2][4][2];
#pragma unroll
    for (int a = 0; a < 2; ++a)
#pragma unroll
        for (int b = 0; b < 2; ++b)
#pragma unroll
            for (int m = 0; m < 4; ++m)
#pragma unroll
                for (int n = 0; n < 2; ++n) acc[a][b][m][n] = (f32x4){0.f, 0.f, 0.f, 0.f};
    bf16x8 At[4][2], B0[2][2], B1[2][2];
    const char* cA = (const char*)g.A + (size_t)cur.pm * tstep; const char* cB = (const char*)g.Bt + (size_t)cur.pn * tstep;
    PG8_STAGE(PG8_SB(0, 0), cB); PG8_STAGE(PG8_SB(0, 1), cB + hstep); PG8_STAGE(PG8_SA(0, 0), cA); PG8_STAGE(PG8_SA(0, 1), cA + hstep);
    if (wr == 1) PG8_BAR;
    PG8_WAIT_V(2); PG8_BAR;
    PG8_STAGE(PG8_SB(1, 0), cB + kstep); PG8_STAGE(PG8_SA(1, 0), cA + kstep); PG8_STAGE(PG8_SB(1, 1), cB + hstep + kstep);
    PG8_WAIT_V(6); PG8_BAR;
    for (;;) {
        const bool has_next = S.next(ui + 1, nxt);
        const char* nA = has_next ? (const char*)g.A + (size_t)nxt.pm * tstep : cA; const char* nB = has_next ? (const char*)g.Bt + (size_t)nxt.pn * tstep : cB;
        for (int t = 0; t < nt; t += 2) {
            const bool last = (t == nt - 2);
            const char* a1 = cA + (size_t)(t + 1) * kstep;
            const char* a2 = last ? nA : cA + (size_t)(t + 2) * kstep; const char* b2 = last ? nB : cB + (size_t)(t + 2) * kstep;
            const char* a3 = a2 + kstep; const char* b3 = b2 + kstep;
            PG8_LDB(B0, 0, 0); PG8_LDB(B1, 0, 1); PG8_SCHED; PG8_LDA(At, 0, 0); PG8_STAGE(PG8_SA(1, 1), a1 + hstep);
            PG8_WAIT_V(8); PG8_WAIT_L(0); PG8_BAR; PG8_MMA(0, 0, At, B0); PG8_MMA(0, 1, At, B1); PG8_BAR; PG8_SCHED;
            PG8_LDA(At, 0, 1); PG8_STAGE(PG8_SB(0, 0), b2); PG8_STAGE(PG8_SB(0, 1), b2 + hstep); PG8_STAGE(PG8_SA(0, 0), a2);
            PG8_WAIT_V(8); PG8_WAIT_L(0); PG8_BAR; PG8_MMA(1, 0, At, B0); PG8_MMA(1, 1, At, B1); PG8_BAR; PG8_SCHED;
            PG8_LDB(B0, 1, 0); PG8_LDB(B1, 1, 1); PG8_SCHED; PG8_LDA(At, 1, 0); PG8_STAGE(PG8_SA(0, 1), a2 + hstep);
            PG8_WAIT_V(8); PG8_WAIT_L(0); PG8_BAR; PG8_MMA(0, 0, At, B0); PG8_MMA(0, 1, At, B1); PG8_BAR; PG8_SCHED;
            PG8_LDA(At, 1, 1); PG8_STAGE(PG8_SB(1, 0), b3); PG8_STAGE(PG8_SB(1, 1), b3 + hstep); PG8_STAGE(PG8_SA(1, 0), a3);
            PG8_WAIT_V(8); PG8_WAIT_L(0); PG8_BAR; PG8_MMA(1, 0, At, B0); PG8_MMA(1, 1, At, B1); PG8_BAR; PG8_SCHED;
        }
        if (wr == 0) PG8_BAR;
        { int fr_ = fr, fq_ = fq; asm volatile("" : "+v"(fr_), "+v"(fq_)); E(acc, cur, wr, wc, fr_, fq_, xlds); }
        if (!has_next) break;
#pragma unroll
        for (int a = 0; a < 2; ++a)
#pragma unroll
            for (int b = 0; b < 2; ++b)
#pragma unroll
                for (int m = 0; m < 4; ++m)
#pragma unroll
                    for (int n = 0; n < 2; ++n) acc[a][b][m][n] = (f32x4){0.f, 0.f, 0.f, 0.f};
        cur = nxt; cA = nA; cB = nB; ++ui;
        if (wr == 1) PG8_BAR;
    }
    PG8_WAIT_V(0);
    PG8_BAR;
#undef PG8_SA
#undef PG8_SB
#undef PG8_STAGE
#undef PG8_LDA
#undef PG8_LDB
#undef PG8_MMA
#undef PG8_WAIT_V
#undef PG8_WAIT_L
#undef PG8_BAR
#undef PG8_SCHED
}
}

typedef f32x4 Acc[2][2][4][2];

struct EpiRes {
    const float* xin_ctx; const float* xin_lat; float* xout; const float* gate;
    const bf16_t* xin_b; bf16_t* xout_b;
    __device__ __forceinline__ void operator()(const Acc& acc, const pg8::Unit& u, int wr, int wc, int fr, int fq, LAS unsigned char*) const {
        const TileInfo ti(u.pm);
        const int col0 = u.pn * 256 + wc * 32 + 8 * fq;
        const float* gp = gate + ti.ci * 6144 + col0;
        f32x4 g4[2][2];
#pragma unroll
        for (int bj = 0; bj < 2; ++bj)
#pragma unroll
            for (int n = 0; n < 2; ++n) g4[bj][n] = *(const GAS f32x4*)(gp + bj * 128 + n * 4);
        const float* xin = ti.lat ? xin_lat + (size_t)(u.pm * 256 - M_CTX) * DM : xin_ctx + (size_t)(u.pm * 256) * DM;
        float* xo = xout + (size_t)(u.pm * 256) * DM;
        const bf16_t* xib = xin_b + (size_t)(u.pm * 256) * DM; bf16_t* xob = xout_b + (size_t)(u.pm * 256) * DM;
#pragma unroll
        for (int ai = 0; ai < 2; ++ai) {
            f32x4 xv[4][2][2];
            if (xin_b) {
                u32x4 rw[4][2];
#pragma unroll
                for (int m = 0; m < 4; ++m)
#pragma unroll
                    for (int bj = 0; bj < 2; ++bj) rw[m][bj] = *(const GAS u32x4*)(xib + (size_t)(ai * 128 + wr * 64 + m * 16 + fr) * DM + col0 + bj * 128);
#pragma unroll
                for (int m = 0; m < 4; ++m)
#pragma unroll
                    for (int bj = 0; bj < 2; ++bj) { const u32x4 r = rw[m][bj];
                        xv[m][bj][0] = (f32x4){__uint_as_float(r.x << 16), __uint_as_float(r.x & 0xffff0000u), __uint_as_float(r.y << 16), __uint_as_float(r.y & 0xffff0000u)};
                        xv[m][bj][1] = (f32x4){__uint_as_float(r.z << 16), __uint_as_float(r.z & 0xffff0000u), __uint_as_float(r.w << 16), __uint_as_float(r.w & 0xffff0000u)}; }
            } else {
#pragma unroll
                for (int m = 0; m < 4; ++m) {
                    const size_t off = (size_t)(ai * 128 + wr * 64 + m * 16 + fr) * DM + col0;
#pragma unroll
                    for (int bj = 0; bj < 2; ++bj)
#pragma unroll
                        for (int n = 0; n < 2; ++n) xv[m][bj][n] = *(const GAS f32x4*)(xin + off + bj * 128 + n * 4);
                }
            }
#pragma unroll
            for (int m = 0; m < 4; ++m) {
                const size_t off = (size_t)(ai * 128 + wr * 64 + m * 16 + fr) * DM + col0;
#pragma unroll
                for (int bj = 0; bj < 2; ++bj) {
                    const f32x4 o0 = xv[m][bj][0] + g4[bj][0] * acc[ai][bj][m][0], o1 = xv[m][bj][1] + g4[bj][1] * acc[ai][bj][m][1];
                    if (xout_b) { u32x4 w; w.x = cvtpk(o0[0], o0[1]); w.y = cvtpk(o0[2], o0[3]); w.z = cvtpk(o1[0], o1[1]); w.w = cvtpk(o1[2], o1[3]); *(GAS u32x4*)(xob + off + bj * 128) = w; }
                    else { *(GAS f32x4*)(xo + off + bj * 128) = o0; *(GAS f32x4*)(xo + off + bj * 128 + 4) = o1; }
                }
            }
            asm volatile("" ::: "memory");
            __builtin_amdgcn_sched_barrier(0);
        }
    }
};

struct EpiIn {
    int layer;
    const float *qn_g, *kn_g, *dqn_g, *dkn_g;
    const float *r64c, *r64s, *r32c, *r32s;
    bf16_t *QG, *QD, *KG, *VG, *KD, *VD, *CB, *PB;
    float* out;
    __device__ __forceinline__ void operator()(const Acc& acc, const pg8::Unit& u, int wr, int wc, int fr, int fq, LAS unsigned char*) const {
        const TileInfo ti(u.pm);
        const int pn = u.pn;
        const int rbase = wr * 64 + fr;
        if (pn < 2 || (pn == 2 && wc < 2)) {
            const bool isq = pn < 2;
            const float* gsrc = (isq ? qn_g : kn_g) + 4 * fq;
            const int head = isq ? 4 * pn + wc : wc;
            f32x4 g4[2][2], rc[2], rs[2];
#pragma unroll
            for (int bj = 0; bj < 2; ++bj)
#pragma unroll
                for (int n = 0; n < 2; ++n) g4[bj][n] = *(const GAS f32x4*)(gsrc + 32 * bj + 16 * n);
#pragma unroll
            for (int ai = 0; ai < 2; ++ai) { const int pos = (ti.t0 >> 6) + 2 * ai + wr; rc[ai] = *(const GAS f32x4*)(r64c + pos * 16 + 4 * fq); rs[ai] = *(const GAS f32x4*)(r64s + pos * 16 + 4 * fq); }
            float ss[8];
#pragma unroll
            for (int ai = 0; ai < 2; ++ai)
#pragma unroll
                for (int m = 0; m < 4; ++m) { float t_ = 0.f;
#pragma unroll
                    for (int bj = 0; bj < 2; ++bj)
#pragma unroll
                        for (int n = 0; n < 2; ++n) { const f32x4 v = acc[ai][bj][m][n]; t_ += (v[0] * v[0] + v[1] * v[1]) + (v[2] * v[2] + v[3] * v[3]); }
                    ss[ai * 4 + m] = t_; }
#pragma unroll
            for (int i = 0; i < 8; ++i) ss[i] += __shfl_xor(ss[i], 16);
#pragma unroll
            for (int i = 0; i < 8; ++i) ss[i] += __shfl_xor(ss[i], 32);
#pragma unroll
            for (int mh = 0; mh < 2; ++mh) {
                f32x4 cc[2], cs[2];
#pragma unroll
                for (int mm = 0; mm < 2; ++mm) { const int pos = 16 * (2 * mh + mm) + fr; cc[mm] = *(const GAS f32x4*)(r64c + pos * 16 + 4 * fq); cs[mm] = *(const GAS f32x4*)(r64s + pos * 16 + 4 * fq); }
                if (mh == 0) __builtin_amdgcn_sched_group_barrier(0x020, 12, 0); else __builtin_amdgcn_sched_group_barrier(0x020, 4, 0);
#pragma unroll
                for (int mm = 0; mm < 2; ++mm)
#pragma unroll
                    for (int ai = 0; ai < 2; ++ai) {
                        const int m = 2 * mh + mm;
                        const int rt = ai * 128 + m * 16 + rbase; const int t = ti.t0 + rt;
                        const float rstd = rsqrtf(ss[ai * 4 + m] * (1.f / 64.f) + EPS);
                        bf16_t* dst = isq ? QG + ((size_t)u.pm * 256 + rt) * 512 + head * 64 + 8 * fq : KG + ((ti.R * 2 + (long)head * ti.S + t) * 64) + 8 * fq;
                        float* o = out + OUT_GK + ((size_t)(ti.seq * 4 + layer) * 256 + t) * 128 + head * 64 + 4 * fq;
#pragma unroll
                        for (int bj = 0; bj < 2; ++bj) {
                            f32x4 y0 = acc[ai][bj][m][0] * rstd * g4[bj][0], y1 = acc[ai][bj][m][1] * rstd * g4[bj][1];
                            if (!isq && !ti.lat) { *(GAS f32x4*)(o + 32 * bj) = y0; *(GAS f32x4*)(o + 32 * bj + 16) = y1; }
                            if (ti.lat) {
                                const f32x4 c4 = bj ? cc[mm] : rc[ai], s4 = bj ? cs[mm] : rs[ai];
                                const f32x4 o0 = y0 * c4 - y1 * s4, o1 = y1 * c4 + y0 * s4; y0 = o0; y1 = o1;
                            }
                            if (isq) { y0 = y0 * QSCALE_G; y1 = y1 * QSCALE_G; }
                            u32x4 w; w.x = cvtpk(y0[0], y0[1]); w.y = cvtpk(y0[2], y0[3]); w.z = cvtpk(y1[0], y1[1]); w.w = cvtpk(y1[2], y1[3]);
                            *(GAS u32x4*)(dst + 32 * bj) = w;
                        }
                    }
                asm volatile("" ::: "memory"); __builtin_amdgcn_sched_barrier(0);
            }
        } else if (pn == 2) {
            const int head = wc - 2;
#pragma unroll
            for (int ai = 0; ai < 2; ++ai)
#pragma unroll
                for (int m = 0; m < 4; ++m) {
                    const int rt = ai * 128 + m * 16 + rbase; const int t = ti.t0 + rt;
                    if (!ti.lat) {
                        float* o = out + OUT_GV + ((size_t)(ti.seq * 4 + layer) * 256 + t) * 128 + head * 64 + 8 * fq;
#pragma unroll
                        for (int bj = 0; bj < 2; ++bj) { *(GAS f32x4*)(o + 32 * bj) = acc[ai][bj][m][0]; *(GAS f32x4*)(o + 32 * bj + 4) = acc[ai][bj][m][1]; }
                    }
                    bf16_t* vp = VG + ((ti.R * 2 + (long)head * ti.S + t) * 64) + 8 * fq;
#pragma unroll
                    for (int bj = 0; bj < 2; ++bj) { const f32x4 a = acc[ai][bj][m][0], b = acc[ai][bj][m][1]; u32x4 w; w.x = cvtpk(a[0], a[1]); w.y = cvtpk(a[2], a[3]); w.z = cvtpk(b[0], b[1]); w.w = cvtpk(b[2], b[3]); *(GAS u32x4*)(vp + 32 * bj) = w; }
                }
        } else if (pn == 3) {
#pragma unroll
            for (int ai = 0; ai < 2; ++ai)
#pragma unroll
                for (int m = 0; m < 4; ++m) {
                    const size_t grow = (size_t)u.pm * 256 + ai * 128 + m * 16 + rbase;
                    bf16_t* p = CB + grow * 256 + 32 * wc + 8 * fq;
#pragma unroll
                    for (int bj = 0; bj < 2; ++bj) { const f32x4 a = acc[ai][bj][m][0], b = acc[ai][bj][m][1]; u32x4 w; w.x = cvtpk(a[0], a[1]); w.y = cvtpk(a[2], a[3]); w.z = cvtpk(b[0], b[1]); w.w = cvtpk(b[2], b[3]); *(GAS u32x4*)(p + 128 * bj) = w; }
                }
        } else if (pn < 6) {
#pragma unroll
            for (int ai = 0; ai < 2; ++ai)
#pragma unroll
                for (int m = 0; m < 4; ++m) {
                    const size_t grow = (size_t)u.pm * 256 + ai * 128 + m * 16 + rbase;
                    bf16_t* p = PB + grow * 256 + 128 * (pn - 4) + 32 * wc + 8 * fq;
                    const f32x4 a = acc[ai][0][m][0] * acc[ai][1][m][0], b = acc[ai][0][m][1] * acc[ai][1][m][1];
                    u32x4 w; w.x = cvtpk(a[0], a[1]); w.y = cvtpk(a[2], a[3]); w.z = cvtpk(b[0], b[1]); w.w = cvtpk(b[2], b[3]); *(GAS u32x4*)p = w;
                }
        } else if (pn < 8) {
            const bool isq = pn == 6;
            const float* gsrc = isq ? dqn_g : dkn_g;
            const int a_ax = fq >> 1, ib = 4 * (fq & 1);
            const float* gp = gsrc + 16 * a_ax + ib;
            const int head = wc;
            const f32x4 g0 = *(const GAS f32x4*)gp, g1 = *(const GAS f32x4*)(gp + 8);
            f32x4 tc[4], ts[4];
#pragma unroll
            for (int j = 0; j < 4; ++j) { const int pos = a_ax ? (16 * j + fr) : ((ti.t0 >> 6) + 2 * (j & 1) + wr); tc[j] = *(const GAS f32x4*)(r32c + pos * 8 + ib); ts[j] = *(const GAS f32x4*)(r32s + pos * 8 + ib); }
            __builtin_amdgcn_sched_group_barrier(0x020, 10, 0);
#pragma unroll
            for (int ai = 0; ai < 2; ++ai) {
                float ss[4][2];
#pragma unroll
                for (int m = 0; m < 4; ++m)
#pragma unroll
                    for (int bj = 0; bj < 2; ++bj) { float t_ = 0.f;
#pragma unroll
                        for (int n = 0; n < 2; ++n) { const f32x4 v = acc[ai][bj][m][n]; t_ += (v[0] * v[0] + v[1] * v[1]) + (v[2] * v[2] + v[3] * v[3]); }
                        ss[m][bj] = t_; }
#pragma unroll
                for (int i = 0; i < 4; ++i) { ss[i][0] += __shfl_xor(ss[i][0], 16); ss[i][1] += __shfl_xor(ss[i][1], 16); }
#pragma unroll
                for (int i = 0; i < 4; ++i) { ss[i][0] += __shfl_xor(ss[i][0], 32); ss[i][1] += __shfl_xor(ss[i][1], 32); }
#pragma unroll
                for (int m = 0; m < 4; ++m) {
                    const int rt = ai * 128 + m * 16 + rbase; const int t = ti.t0 + rt; const size_t grow = (size_t)u.pm * 256 + rt;
                    const f32x4 c4 = a_ax ? tc[m] : tc[ai], s4 = a_ax ? ts[m] : ts[ai];
#pragma unroll
                    for (int bj = 0; bj < 2; ++bj) {
                        const float rstd = rsqrtf(ss[m][bj] * (1.f / 32.f) + EPS);
                        f32x4 y0 = acc[ai][bj][m][0] * rstd * g0, y1 = acc[ai][bj][m][1] * rstd * g1;
                        if (!isq && !ti.lat) {
                            float* o = out + OUT_DK + ((size_t)(ti.seq * 4 + layer) * 256 + t) * 256 + head * 64 + bj * 32 + 16 * a_ax + ib;
                            *(GAS f32x4*)(o) = y0; *(GAS f32x4*)(o + 8) = y1;
                        }
                        if (ti.lat) { const f32x4 o0 = y0 * c4 - y1 * s4, o1 = y1 * c4 + y0 * s4; y0 = o0; y1 = o1; }
                        bf16_t* dst;
                        if (isq) { y0 = y0 * QSCALE_D; y1 = y1 * QSCALE_D; dst = QD + grow * 256 + head * 64 + bj * 32 + 16 * a_ax + 2 * ib; }
                        else dst = KD + ((ti.R * 8 + (long)(head * 2 + bj) * ti.S + t) * 32) + 16 * a_ax + 2 * ib;
                        u32x4 w; w.x = cvtpk(y0[0], y0[1]); w.y = cvtpk(y0[2], y0[3]); w.z = cvtpk(y1[0], y1[1]); w.w = cvtpk(y1[2], y1[3]);
                        *(GAS u32x4*)dst = w;
                    }
                }
                asm volatile("" ::: "memory"); __builtin_amdgcn_sched_barrier(0);
            }
        } else {
            const int head = wc;
#pragma unroll
            for (int ai = 0; ai < 2; ++ai)
#pragma unroll
                for (int m = 0; m < 4; ++m) {
                    const int rt = ai * 128 + m * 16 + rbase; const int t = ti.t0 + rt;
                    if (!ti.lat) {
                        float* o = out + OUT_DV + ((size_t)(ti.seq * 4 + layer) * 256 + t) * 256 + head * 64 + 8 * fq;
#pragma unroll
                        for (int bj = 0; bj < 2; ++bj) { *(GAS f32x4*)(o + 32 * bj) = acc[ai][bj][m][0]; *(GAS f32x4*)(o + 32 * bj + 4) = acc[ai][bj][m][1]; }
                    }
                    bf16_t* vp = VD + ((ti.R * 4 + (long)head * ti.S + t) * 64) + 8 * fq;
#pragma unroll
                    for (int bj = 0; bj < 2; ++bj) { const f32x4 a = acc[ai][bj][m][0], b = acc[ai][bj][m][1]; u32x4 w; w.x = cvtpk(a[0], a[1]); w.y = cvtpk(a[2], a[3]); w.z = cvtpk(b[0], b[1]); w.w = cvtpk(b[2], b[3]); *(GAS u32x4*)(vp + 32 * bj) = w; }
                }
        }
    }
};

__device__ __forceinline__ float dpp_ror1(float x) { return __int_as_float(__builtin_amdgcn_update_dpp(0, __float_as_int(x), 0x121, 0xf, 0xf, false)); }
__device__ __forceinline__ float dpp_ror15(float x) { return __int_as_float(__builtin_amdgcn_update_dpp(0, __float_as_int(x), 0x12F, 0xf, 0xf, false)); }
__device__ __forceinline__ float silu_f(float x) { return x * __builtin_amdgcn_rcpf(1.f + __builtin_amdgcn_exp2f(-x * LOG2E)); }
struct EpiUp {
    const float* cw; const float* cbias; bf16_t* F; float* EP; float* EA; float* EU;
    __device__ __forceinline__ void operator()(const Acc& acc, const pg8::Unit& u, int wr, int wc, int fr, int fq, LAS unsigned char* xlds) const {
        const TileInfo ti(u.pm);
        const int c0 = u.pn * 128 + wc * 32 + 8 * fq;
        LAS float* X = (LAS float*)xlds;
#pragma unroll
        for (int ai = 0; ai < 2; ++ai) {
            if (fr == 0) { LAS float* p = X + ((((ai * 2 + wr) * 4 + wc) * 2 + 0) * 4 + fq) * 8; *(LAS f32x4*)p = acc[ai][0][0][0]; *(LAS f32x4*)(p + 4) = acc[ai][0][0][1]; }
            if (fr == 15) { LAS float* p = X + ((((ai * 2 + wr) * 4 + wc) * 2 + 1) * 4 + fq) * 8; *(LAS f32x4*)p = acc[ai][0][3][0]; *(LAS f32x4*)(p + 4) = acc[ai][0][3][1]; }
        }
        asm volatile("s_waitcnt lgkmcnt(0)" ::: "memory"); __builtin_amdgcn_s_barrier(); asm volatile("" ::: "memory");
        f32x4 w0[2], w1[2], w2[2], bb[2];
#pragma unroll
        for (int n = 0; n < 2; ++n) { w0[n] = *(const GAS f32x4*)(cw + c0 + 4 * n); w1[n] = *(const GAS f32x4*)(cw + DFF + c0 + 4 * n); w2[n] = *(const GAS f32x4*)(cw + 2 * DFF + c0 + 4 * n); bb[n] = *(const GAS f32x4*)(cbias + c0 + 4 * n); }
        const bool has_prev = ti.lat && ti.t0 > 0, has_next = ti.lat && ti.t0 < 4096 - 256;
#pragma unroll
        for (int ai = 0; ai < 2; ++ai) {
            f32x4 pb[2] = {(f32x4){0.f, 0.f, 0.f, 0.f}, (f32x4){0.f, 0.f, 0.f, 0.f}}, nb[2] = {(f32x4){0.f, 0.f, 0.f, 0.f}, (f32x4){0.f, 0.f, 0.f, 0.f}};
            { const int seg = ai * 2 + wr;
              if (seg > 0) { const int ps = seg - 1; LAS float* p = X + ((((ps >> 1) * 2 + (ps & 1)) * 4 + wc) * 2 + 1) * 32 + fq * 8; pb[0] = *(LAS f32x4*)p; pb[1] = *(LAS f32x4*)(p + 4); }
              if (seg < 3) { const int ns = seg + 1; LAS float* p = X + ((((ns >> 1) * 2 + (ns & 1)) * 4 + wc) * 2 + 0) * 32 + fq * 8; nb[0] = *(LAS f32x4*)p; nb[1] = *(LAS f32x4*)(p + 4); } }
#pragma unroll
            for (int m = 0; m < 4; ++m) {
                const int rt = ai * 128 + wr * 64 + m * 16 + fr; const size_t grow = (size_t)u.pm * 256 + rt;
                f32x4 fo[2], cv[2];
#pragma unroll
                for (int n = 0; n < 2; ++n) {
                    const f32x4 a = acc[ai][0][m][n];
                    const f32x4 up = (m > 0) ? acc[ai][0][m > 0 ? m - 1 : 0][n] : pb[n];
                    const f32x4 dn = (m < 3) ? acc[ai][0][m < 3 ? m + 1 : 3][n] : nb[n];
                    f32x4 pv, nx;
#pragma unroll
                    for (int e = 0; e < 4; ++e) {
                        pv[e] = dpp_ror1(fr == 15 ? up[e] : a[e]);
                        nx[e] = dpp_ror15(fr == 0 ? dn[e] : a[e]);
                    }
                    const f32x4 c = w0[n] * pv + w1[n] * a + w2[n] * nx + bb[n];
                    cv[n] = c;
                    const f32x4 uu = acc[ai][1][m][n];
#pragma unroll
                    for (int e = 0; e < 4; ++e) fo[n][e] = silu_f(c[e]) * uu[e];
                }
                u32x4 w; w.x = cvtpk(fo[0][0], fo[0][1]); w.y = cvtpk(fo[0][2], fo[0][3]); w.z = cvtpk(fo[1][0], fo[1][1]); w.w = cvtpk(fo[1][2], fo[1][3]);
                *(GAS u32x4*)(F + grow * DFF + c0) = w;
                if (ai == 0 && m == 0) { if (has_prev && rt == 0) { const size_t eo = ((size_t)u.pm * 2 + 0) * DFF + c0;
                        *(GAS f32x4*)(EP + eo) = cv[0]; *(GAS f32x4*)(EP + eo + 4) = cv[1]; *(GAS f32x4*)(EA + eo) = acc[0][0][0][0]; *(GAS f32x4*)(EA + eo + 4) = acc[0][0][0][1]; *(GAS f32x4*)(EU + eo) = acc[0][1][0][0]; *(GAS f32x4*)(EU + eo + 4) = acc[0][1][0][1]; } }
                if (ai == 1 && m == 3) { if (has_next && rt == 255) { const size_t eo = ((size_t)u.pm * 2 + 1) * DFF + c0;
                        *(GAS f32x4*)(EP + eo) = cv[0]; *(GAS f32x4*)(EP + eo + 4) = cv[1]; *(GAS f32x4*)(EA + eo) = acc[1][0][3][0]; *(GAS f32x4*)(EA + eo + 4) = acc[1][0][3][1]; *(GAS f32x4*)(EU + eo) = acc[1][1][3][0]; *(GAS f32x4*)(EU + eo + 4) = acc[1][1][3][1]; } }
            }
        }
        asm volatile("s_waitcnt lgkmcnt(0)" ::: "memory"); __builtin_amdgcn_s_barrier(); asm volatile("" ::: "memory");
    }
};

typedef short v4i16_t __attribute__((ext_vector_type(4)));
__device__ __forceinline__ s16x4 vtr(LAS const char* p) { return __builtin_bit_cast(s16x4, __builtin_amdgcn_ds_read_tr16_b64_v4i16((LAS v4i16_t*)p)); }
__device__ __forceinline__ float xhalf_max(float m) { auto rr = __builtin_amdgcn_permlane32_swap(__float_as_uint(m), __float_as_uint(m), false, false); return fmaxf(__uint_as_float(rr[0]), __uint_as_float(rr[1])); }
__device__ __forceinline__ float xhalf_sum(float m) { auto rr = __builtin_amdgcn_permlane32_swap(__float_as_uint(m), __float_as_uint(m), false, false); return __uint_as_float(rr[0]) + __uint_as_float(rr[1]); }

constexpr int ATT_VS = 192;
constexpr float ATT_THR = 8.f;
#define MX3(a, b, c) __builtin_fmaxf(__builtin_fmaxf((a), (b)), (c))
template <int DQK, bool YORD>
__device__ __forceinline__ void flash_pass(const bf16_t* __restrict__ Qw, int qpitch, const bf16_t* __restrict__ Kg, const bf16_t* __restrict__ Vg, int NT, int tst,
                                           LAS char* lds, f32x16 (&o)[2], float& lsum) {
#define ATT_TI(T) (((T) + tst) < NT ? ((T) + tst) : ((T) + tst - NT))
    constexpr int KS = DQK * 2 + 16, KBUF = 64 * KS, VBUF = 64 * ATT_VS, NDS = DQK / 16;
    constexpr int KROWB = DQK * 2;
    const int tid = opaque_tid(), lane = tid & 63, r32 = lane & 31, h = lane >> 5;
    LAS char* Kb = lds; LAS char* Vb = lds + 2 * KBUF;
    bf16x8 qf[NDS];
#pragma unroll
    for (int ds = 0; ds < NDS; ++ds) qf[ds] = *(const GAS bf16x8*)(Qw + (size_t)r32 * qpitch + 16 * ds + 8 * h);
    const bool kload = (tid * 16) < 64 * KROWB;
    const int krow = (tid * 16) / KROWB, kcb = (tid * 16) % KROWB;
    const int kdst = krow * KS + kcb, vdst = (tid >> 3) * ATT_VS + (tid & 7) * 16;
    const char* kg = (const char*)Kg + tid * 16; const char* vg = (const char*)Vg + tid * 16;
    u32x4 kreg = {0, 0, 0, 0}, vreg;
    {
        u32x4 k1 = {0, 0, 0, 0};
        if (kload) { kreg = *(const GAS u32x4*)(kg + (size_t)ATT_TI(0) * 64 * KROWB); k1 = *(const GAS u32x4*)(kg + (size_t)ATT_TI(1) * 64 * KROWB); }
        vreg = *(const GAS u32x4*)(vg + (size_t)ATT_TI(0) * 64 * 128);
        if (kload) { *(LAS u32x4*)(Kb + kdst) = kreg; *(LAS u32x4*)(Kb + KBUF + kdst) = k1; }
        *(LAS u32x4*)(Vb + vdst) = vreg;
        *(LAS u32x4*)(Vb + 2 * VBUF + vdst) = (u32x4){0, 0, 0, 0};
    }
    __syncthreads();
    const int kfo = r32 * KS + h * 16;
    const int vfo = (4 * h + ((lane & 15) >> 2)) * ATT_VS + (((lane >> 4) & 1) * 16 + (lane & 3) * 4) * 2;
    f32x16 p0 = (f32x16){}, p1 = (f32x16){};
#pragma unroll
    for (int ds = 0; ds < NDS; ++ds) {
        const bf16x8 k0 = *(LAS const bf16x8*)(Kb + kfo + ds * 32), k1 = *(LAS const bf16x8*)(Kb + kfo + 32 * KS + ds * 32);
        p0 = __builtin_amdgcn_mfma_f32_32x32x16_bf16(k0, qf[ds], p0, 0, 0, 0);
        p1 = __builtin_amdgcn_mfma_f32_32x32x16_bf16(k1, qf[ds], p1, 0, 0, 0);
    }
    __syncthreads();
    float mref, l = 0.f;
    {
        float a = MX3(p0[0], p0[1], p1[0]), b = MX3(p0[2], p0[3], p1[1]); a = MX3(a, p1[2], p1[3]);
#pragma unroll
        for (int r = 4; r < 16; r += 4) { a = MX3(a, p0[r], p0[r + 1]); b = MX3(b, p0[r + 2], p0[r + 3]); a = MX3(a, p1[r], p1[r + 1]); b = MX3(b, p1[r + 2], p1[r + 3]); }
        mref = xhalf_max(fmaxf(a, b));
#pragma unroll
        for (int r = 0; r < 16; ++r) { p0[r] -= mref; p1[r] -= mref; }
    }
    f32x16 negm;
#pragma unroll
    for (int r = 0; r < 16; ++r) negm[r] = -mref;
    asm volatile("" : "+v"(negm));
    o[0] = (f32x16){}; o[1] = (f32x16){};
    bf16x8 pk[4] = {};
    int vs_prev = 2 * VBUF, vs_cur = 0, vs_next = VBUF;
#define ATT_MPART(N0, N1, T) do { \
        LAS const char* kb_ = Kb + ((((T) + 1) & 1) * KBUF) + kfo; LAS const char* vb_ = Vb + vs_prev + vfo; \
        bf16x8 kf_[2 * NDS]; s16x4 vl_[8], vh_[8]; \
        _Pragma("unroll") for (int ds = 0; ds < NDS; ++ds) { kf_[2 * ds] = *(LAS const bf16x8*)(kb_ + ds * 32); kf_[2 * ds + 1] = *(LAS const bf16x8*)(kb_ + 32 * KS + ds * 32); } \
        _Pragma("unroll") for (int s_ = 0; s_ < 4; ++s_) { _Pragma("unroll") for (int db_ = 0; db_ < 2; ++db_) { \
            vl_[2 * s_ + db_] = vtr(vb_ + (16 * s_) * ATT_VS + db_ * 64); vh_[2 * s_ + db_] = vtr(vb_ + (16 * s_ + 8) * ATT_VS + db_ * 64); } } \
        N0 = __builtin_amdgcn_mfma_f32_32x32x16_bf16(kf_[0], qf[0], negm, 0, 0, 0); N1 = __builtin_amdgcn_mfma_f32_32x32x16_bf16(kf_[1], qf[0], negm, 0, 0, 0); \
        _Pragma("unroll") for (int ds = 1; ds < NDS; ++ds) { \
            N0 = __builtin_amdgcn_mfma_f32_32x32x16_bf16(kf_[2 * ds], qf[ds], N0, 0, 0, 0); N1 = __builtin_amdgcn_mfma_f32_32x32x16_bf16(kf_[2 * ds + 1], qf[ds], N1, 0, 0, 0); } \
        _Pragma("unroll") for (int s_ = 0; s_ < 4; ++s_) { _Pragma("unroll") for (int db_ = 0; db_ < 2; ++db_) { \
            const bf16x8 vf_ = __builtin_shufflevector(vl_[2 * s_ + db_], vh_[2 * s_ + db_], 0, 1, 2, 3, 4, 5, 6, 7); \
            o[db_] = __builtin_amdgcn_mfma_f32_32x32x16_bf16(vf_, pk[s_], o[db_], 0, 0, 0); } } \
        __builtin_amdgcn_sched_group_barrier(0x100, 2 * NDS + 8, 0); __builtin_amdgcn_sched_group_barrier(0x008, 2 * NDS, 0); \
        __builtin_amdgcn_sched_group_barrier(0x100, 8, 0); __builtin_amdgcn_sched_group_barrier(0x008, 8, 0); } while (0)
#define ATT_VPART(P0, P1, N0, N1) do { \
        float a = MX3(P0[0], P0[1], P1[0]), b = MX3(P0[2], P0[3], P1[1]); a = MX3(a, P1[2], P1[3]); \
        _Pragma("unroll") for (int r = 4; r < 16; r += 4) { a = MX3(a, P0[r], P0[r + 1]); b = MX3(b, P0[r + 2], P0[r + 3]); a = MX3(a, P1[r], P1[r + 1]); b = MX3(b, P1[r + 2], P1[r + 3]); } \
        const float mt = xhalf_max(fmaxf(a, b)); \
        resc = __any(mt > ATT_THR); \
        if (__builtin_expect(resc, 0)) { \
            const float dl = fmaxf(mt, 0.f); mref += dl; fsc = __builtin_amdgcn_exp2f(-dl); l *= fsc; \
            _Pragma("unroll") for (int r = 0; r < 16; ++r) { P0[r] -= dl; P1[r] -= dl; } \
            if (!YORD) { _Pragma("unroll") for (int r = 0; r < 16; ++r) { N0[r] -= dl; N1[r] -= dl; o[0][r] *= fsc; o[1][r] *= fsc; } } \
            _Pragma("unroll") for (int r = 0; r < 16; ++r) negm[r] = -mref; \
            asm volatile("" : "+v"(negm)); } \
        float ps0 = 0.f, ps1 = 0.f; \
        _Pragma("unroll") for (int r = 0; r < 16; ++r) { P0[r] = __builtin_amdgcn_exp2f(P0[r]); P1[r] = __builtin_amdgcn_exp2f(P1[r]); ps0 += P0[r]; ps1 += P1[r]; } \
        l += ps0 + ps1; \
        _Pragma("unroll") for (int s = 0; s < 2; ++s) { u32x4 a4, b4; \
            a4.x = cvtpk(P0[8 * s + 0], P0[8 * s + 1]); a4.y = cvtpk(P0[8 * s + 2], P0[8 * s + 3]); a4.z = cvtpk(P0[8 * s + 4], P0[8 * s + 5]); a4.w = cvtpk(P0[8 * s + 6], P0[8 * s + 7]); \
            b4.x = cvtpk(P1[8 * s + 0], P1[8 * s + 1]); b4.y = cvtpk(P1[8 * s + 2], P1[8 * s + 3]); b4.z = cvtpk(P1[8 * s + 4], P1[8 * s + 5]); b4.w = cvtpk(P1[8 * s + 6], P1[8 * s + 7]); \
            pkn[s] = __builtin_bit_cast(bf16x8, a4); pkn[2 + s] = __builtin_bit_cast(bf16x8, b4); } } while (0)
#define ATT_STEP(P0, P1, N0, N1, T) do { \
        const bool more = (T) + 1 < NT, more2 = (T) + 2 < NT; \
        if (more2 && kload) kreg = *(const GAS u32x4*)(kg + (size_t)ATT_TI((T) + 2) * 64 * KROWB); \
        if (more) vreg = *(const GAS u32x4*)(vg + (size_t)ATT_TI((T) + 1) * 64 * 128); \
        float fsc = 1.f; bool resc; bf16x8 pkn[4]; \
        if (!YORD) { ATT_MPART(N0, N1, T); __builtin_amdgcn_sched_barrier(0); ATT_VPART(P0, P1, N0, N1); } \
        else { ATT_VPART(P0, P1, N0, N1); __builtin_amdgcn_sched_barrier(0); ATT_MPART(N0, N1, T); \
            if (__builtin_expect(resc, 0)) { _Pragma("unroll") for (int r = 0; r < 16; ++r) { o[0][r] *= fsc; o[1][r] *= fsc; } } } \
        _Pragma("unroll") for (int s = 0; s < 4; ++s) pk[s] = pkn[s]; \
        if (more2 && kload) *(LAS u32x4*)(Kb + ((T) & 1) * KBUF + kdst) = kreg; \
        if (more) *(LAS u32x4*)(Vb + vs_next + vdst) = vreg; \
        __syncthreads(); \
        vs_prev = vs_cur; vs_cur = vs_next; vs_next = (vs_next == 2 * VBUF) ? 0 : vs_next + VBUF; } while (0)
    f32x16 n0, n1;
    for (int t = 0; t < NT; t += 2) {
        ATT_STEP(p0, p1, n0, n1, t);
        ATT_STEP(n0, n1, p0, p1, t + 1);
    }
    {
        LAS const char* vb_ = Vb + vs_prev + vfo;
#pragma unroll
        for (int s_ = 0; s_ < 4; ++s_) {
#pragma unroll
            for (int db_ = 0; db_ < 2; ++db_) {
                const s16x4 lo_ = vtr(vb_ + (16 * s_) * ATT_VS + db_ * 64), hi_ = vtr(vb_ + (16 * s_ + 8) * ATT_VS + db_ * 64);
                const bf16x8 vf_ = __builtin_shufflevector(lo_, hi_, 0, 1, 2, 3, 4, 5, 6, 7);
                o[db_] = __builtin_amdgcn_mfma_f32_32x32x16_bf16(vf_, pk[s_], o[db_], 0, 0, 0);
            }
        }
    }
    __syncthreads();
#undef ATT_STEP
#undef ATT_TI
#undef ATT_VPART
#undef ATT_MPART
    lsum = xhalf_sum(l);
}

__device__ __forceinline__ void store_ot(const f32x16 (&o)[2], bf16_t* dst  , int h) {
#pragma unroll
    for (int db = 0; db < 2; ++db)
#pragma unroll
        for (int g = 0; g < 4; ++g) { u32x2 w; w.x = cvtpk(o[db][4 * g], o[db][4 * g + 1]); w.y = cvtpk(o[db][4 * g + 2], o[db][4 * g + 3]); *(GAS u32x2*)(dst + 32 * db + 8 * g + 4 * h) = w; }
}

#include <hip/hip_bf16.h>
namespace attn64 {
using bf16=__hip_bfloat16;
using bf16x8=__attribute__((ext_vector_type(8)))short;
using s16x4=__attribute__((ext_vector_type(4)))short;
using f32x16=__attribute__((ext_vector_type(16)))float;
using u32x4=__attribute__((ext_vector_type(4)))unsigned;
constexpr int D=64;
constexpr int NW=8,QBLK=32,QB=QBLK*NW,KVBLK=64;

__device__ __forceinline__ int crow(int r,int hi){return (r&3)+8*(r>>2)+4*hi;}
#define SBAR() __builtin_amdgcn_sched_barrier(0)
__device__ __forceinline__ void cmask(f32x16&p0,f32x16&p1,int jb,int qrel,int hi){
  const float NEG=-INFINITY; int kb=64*jb+4*hi;
  #pragma unroll
  for(int r=0;r<16;++r){int kv=kb+(r&3)+8*(r>>2); if(kv>qrel)p0[r]=NEG; if(kv+32>qrel)p1[r]=NEG;}
}

constexpr int NSLOT=3, SLOTB=8192;
constexpr int LDS_K=0, LDS_V=NSLOT*SLOTB, LDS_WS=2*NSLOT*SLOTB, LDS_OST=LDS_WS+NW*64*4, LDS_BYTES=LDS_OST+NW*4096;
constexpr float C2=0.125f*1.4426950408889634f;
__device__ __forceinline__ void glds16(const void*gsrc,unsigned lds_dst){unsigned keep;
  asm volatile("s_mov_b32 %0, m0\n\ts_mov_b32 m0, %2\n\ts_nop 0\n\tglobal_load_lds_dwordx4 %1, off\n\ts_mov_b32 m0, %0":"=&s"(keep):"v"(gsrc),"s"(lds_dst):"memory");}
__device__ __forceinline__ float max3f(float a,float b,float c){float r;asm("v_max3_f32 %0, %1, %2, %3":"=v"(r):"v"(a),"v"(b),"v"(c));return r;}
__device__ __forceinline__ float max2f(float a,float b){float r;asm("v_max_f32_e32 %0, %1, %2":"=v"(r):"v"(a),"v"(b));return r;}
__device__ __forceinline__ float fadd_s(float a,float b){float r;asm("v_add_f32_e32 %0, %1, %2":"=v"(r):"v"(a),"v"(b));return r;}
__device__ __forceinline__ float fsub_s(float a,float b){float r;asm("v_sub_f32_e32 %0, %1, %2":"=v"(r):"v"(a),"v"(b));return r;}
typedef float f32x2_t __attribute__((ext_vector_type(2))); typedef __bf16 bf16x2_t __attribute__((ext_vector_type(2)));
__device__ __forceinline__ unsigned cvtpk_s(float lo,float hi){f32x2_t v={lo,hi};bf16x2_t b=__builtin_convertvector(v,bf16x2_t);return __builtin_bit_cast(unsigned,b);}
#define WAIT_BAR(N) asm volatile("s_waitcnt vmcnt(" #N ") lgkmcnt(0)\n\ts_barrier":::"memory")

template<int NDS_> __device__ __forceinline__ void qkt(f32x16&p0,f32x16&p1,const char*Kslot,const bf16x8*qr,const f32x16&negm,int r32,int hi){
  const char*kb=Kslot+hi*1024+r32*16;
  #pragma unroll
  for(int d0=0;d0<NDS_;++d0){
    const bf16x8 b0=*reinterpret_cast<const bf16x8*>(kb+d0*2048);
    const bf16x8 b1=*reinterpret_cast<const bf16x8*>(kb+d0*2048+512);
    if(d0==0){p0=__builtin_amdgcn_mfma_f32_32x32x16_bf16(b0,qr[0],negm,0,0,0);p1=__builtin_amdgcn_mfma_f32_32x32x16_bf16(b1,qr[0],negm,0,0,0);}
    else{p0=__builtin_amdgcn_mfma_f32_32x32x16_bf16(b0,qr[d0],p0,0,0,0);p1=__builtin_amdgcn_mfma_f32_32x32x16_bf16(b1,qr[d0],p1,0,0,0);}}
}
typedef __attribute__((address_space(3))) const char* lds_cptr;
typedef short v4i16_t __attribute__((ext_vector_type(4)));
__device__ __forceinline__ void kload8(bf16x8*kf,lds_cptr kp){
  kf[0]=*(const __attribute__((address_space(3))) bf16x8*)(kp);      kf[1]=*(const __attribute__((address_space(3))) bf16x8*)(kp+512);
  kf[2]=*(const __attribute__((address_space(3))) bf16x8*)(kp+2048); kf[3]=*(const __attribute__((address_space(3))) bf16x8*)(kp+2560);
  kf[4]=*(const __attribute__((address_space(3))) bf16x8*)(kp+4096); kf[5]=*(const __attribute__((address_space(3))) bf16x8*)(kp+4608);
  kf[6]=*(const __attribute__((address_space(3))) bf16x8*)(kp+6144); kf[7]=*(const __attribute__((address_space(3))) bf16x8*)(kp+6656);
}
__device__ __forceinline__ void kload2(bf16x8*kf,lds_cptr kp,int j){ kf[2*j]=*(const __attribute__((address_space(3))) bf16x8*)(kp+j*2048); kf[2*j+1]=*(const __attribute__((address_space(3))) bf16x8*)(kp+j*2048+512); }
__device__ __forceinline__ s16x4 vtr(lds_cptr p){ return __builtin_bit_cast(s16x4,__builtin_amdgcn_ds_read_tr16_b64_v4i16((__attribute__((address_space(3))) v4i16_t*)p)); }
__device__ __forceinline__ float rowmax(const f32x16&p0,const f32x16&p1){
  float a=max3f(p0[0],p0[1],p1[0]),b=max3f(p0[2],p0[3],p1[1]);a=max3f(a,p1[2],p1[3]);
  #pragma unroll
  for(int r=4;r<16;r+=4){a=max3f(a,p0[r],p0[r+1]);b=max3f(b,p0[r+2],p0[r+3]);a=max3f(a,p1[r],p1[r+1]);b=max3f(b,p1[r+2],p1[r+3]);}
  const float m=max2f(a,b);
  auto rr=__builtin_amdgcn_permlane32_swap(__float_as_uint(m),__float_as_uint(m),false,false);
  return max2f(__uint_as_float(rr[0]),__uint_as_float(rr[1]));
}
__device__ __forceinline__ void pv(f32x16*o,int vb,bf16x8 pa0,bf16x8 pa1,bf16x8 pa2,bf16x8 pa3){
  #pragma unroll
  for(int d0=0;d0<2;++d0){s16x4 lo[4],hi[4];
    #pragma unroll
    for(int ks=0;ks<4;++ks){
      asm volatile("ds_read_b64_tr_b16 %0,%1 offset:%c2":"=&v"(lo[ks]):"v"(vb),"i"(d0*4096+ks*1024):"memory");
      asm volatile("ds_read_b64_tr_b16 %0,%1 offset:%c2":"=&v"(hi[ks]):"v"(vb),"i"(d0*4096+ks*1024+512):"memory");}
    asm volatile("s_waitcnt lgkmcnt(0)":::"memory");SBAR();
    #define PK(k) (bf16x8){lo[k][0],lo[k][1],lo[k][2],lo[k][3],hi[k][0],hi[k][1],hi[k][2],hi[k][3]}
    o[d0]=__builtin_amdgcn_mfma_f32_32x32x16_bf16(pa0,PK(0),o[d0],0,0,0);
    o[d0]=__builtin_amdgcn_mfma_f32_32x32x16_bf16(pa1,PK(1),o[d0],0,0,0);
    o[d0]=__builtin_amdgcn_mfma_f32_32x32x16_bf16(pa2,PK(2),o[d0],0,0,0);
    o[d0]=__builtin_amdgcn_mfma_f32_32x32x16_bf16(pa3,PK(3),o[d0],0,0,0);
    #undef PK
  }
}

#ifndef ATTN_STORE16
#define ATTN_STORE16(p,v) (*(GAS u32x4*)(p)=(v))
#endif
__device__ __forceinline__ void stage_store(const f32x16 (&o)[2],bf16*Ow,int op,char*shm,int wid,int lane,int r32,int hi){
  bf16*stg=(bf16*)(shm+LDS_OST)+wid*2048;
  #pragma unroll
  for(int r=0;r<16;++r){const int orow=crow(r,hi);
    #pragma unroll
    for(int d0=0;d0<2;++d0)stg[orow*64+d0*32+r32]=__float2bfloat16(o[d0][r]);}
  asm volatile("s_waitcnt lgkmcnt(0)":::"memory");
  #pragma unroll
  for(int i=0;i<4;++i){const int row=i*8+(lane>>3),ch=lane&7; const u32x4 v=*(const u32x4*)(stg+row*64+ch*8); ATTN_STORE16(Ow+(long)row*op+ch*8,v);}
}
template<int THRL,int MODE,int DQ> __device__ __forceinline__ void attn_unit(const bf16*Qw0,int qp,const bf16*__restrict__ Kh,int kp,const bf16*__restrict__ Vh,int vp,int NT,bf16*Ow0,int op,char*shm,f32x16 (&oret)[2]){
  constexpr int NDS=DQ/16;
  const int tid=opaque_tid(),lane=tid&63,r32=lane&31,hi=lane>>5; const int wid=__builtin_amdgcn_readfirstlane(tid>>6);
  const bf16*Qw=Qw0+(long)(wid*QBLK)*qp;
  const unsigned lds0=(unsigned)(uintptr_t)shm;
  float*wsf=(float*)(shm+LDS_WS)+wid*64;
  const int kch=(DQ==64)?wid:(wid&3);
  const bf16*ksrc=Kh+(long)lane*kp+kch*8;
  const bf16*vsrc=Vh+(long)(16*(wid&3)+(lane>>2))*vp+(wid>>2)*32+(lane&3)*8;
  const unsigned kdst=lds0+LDS_K+kch*1024, vdst=lds0+LDS_V+wid*1024;
  #define DMA_K(t,slot) glds16(ksrc+(long)(t)*KVBLK*kp,(unsigned)__builtin_amdgcn_readfirstlane(kdst+(slot)))
  #define DMA_V(t,slot) glds16(vsrc+(long)(t)*KVBLK*vp,(unsigned)__builtin_amdgcn_readfirstlane(vdst+(slot)))
  const int vb0=(int)(lds0+LDS_V)+((lane>>4)&1)*32+(lane&3)*8+(4*hi+((lane&15)>>2))*64;
  const char*Kbase=shm+LDS_K; bf16x8 kf[8];
  const lds_cptr shm3=(lds_cptr)shm; const lds_cptr kp0=shm3+LDS_K+hi*1024+r32*16; const lds_cptr vp0=shm3+LDS_V+((lane>>4)&1)*32+(lane&3)*8+(4*hi+((lane&15)>>2))*64;
  DMA_K(0,0);DMA_V(0,0);DMA_K(1,SLOTB);
  bf16x8 qr[4];
  #pragma unroll
  for(int d0=0;d0<NDS;++d0)qr[d0]=*(const GAS bf16x8*)(&Qw[(long)r32*qp+d0*16+hi*8]);
  float mhat=0.f,l_reg=0.f;f32x16 o[2];o[0]=f32x16{};o[1]=f32x16{};f32x16 negm=f32x16{};asm volatile("":"+v"(negm));
  #define CMASK(P0,P1,t) do{}while(0)
  bool resc=false;
  #define START(P0,P1) do{ const float rm=rowmax(P0,P1); resc=false; \
    { const float dl=rm; mhat=fadd_s(mhat,dl); \
      _Pragma("unroll") for(int r=0;r<16;++r){P0[r]=fsub_s(P0[r],dl);P1[r]=fsub_s(P1[r],dl);} \
      _Pragma("unroll") for(int r=0;r<16;++r)negm[r]=-mhat; asm volatile("":"+v"(negm)); } \
    _Pragma("unroll") for(int r=0;r<16;++r)P0[r]=__builtin_amdgcn_exp2f(P0[r]); }while(0)
  #define RESC() do{ if(resc){ asm volatile("s_waitcnt lgkmcnt(0)":::"memory"); \
      _Pragma("unroll") for(int d_=0;d_<2;++d_) _Pragma("unroll") for(int r=0;r<16;++r)o[d_][r]*=wsf[crow(r,hi)]; } }while(0)
  f32x16 pA0,pA1,pB0,pB1;
  int sl_prev=0,sl_cur=0,sl_next=SLOTB;
  #define ROT() do{sl_prev=sl_cur;sl_cur=sl_next;sl_next=(sl_next==(NSLOT-1)*SLOTB)?0:sl_next+SLOTB;}while(0)
  DMA_K(2,2*SLOTB);
  WAIT_BAR(3);
  qkt<NDS>(pA0,pA1,Kbase,qr,negm,r32,hi);asm volatile("s_nop 15\n\ts_nop 7":"+v"(pA0),"+v"(pA1));CMASK(pA0,pA1,0);
  START(pA0,pA1);
  _Pragma("unroll") for(int r=0;r<16;++r)pA1[r]=__builtin_amdgcn_exp2f(pA1[r]);
  WAIT_BAR(0);
  DMA_K(3,0);DMA_V(1,SLOTB);
  ROT();
  if constexpr(DQ==64) kload8(kf,kp0+sl_cur); else { kload2(kf,kp0+sl_cur,0); kload2(kf,kp0+sl_cur,1); }
  WAIT_BAR(2);
  s16x4 vlo[8],vhi[8]; u32x4 pw0,pw1,pw2,pw3;
  #define PKW(P,B) cvtpk_s(P[B],P[B+1])
  #define PAF(k) __builtin_bit_cast(bf16x8,pw##k)
  #define VFR(i) (bf16x8){vlo[i][0],vlo[i][1],vlo[i][2],vlo[i][3],vhi[i][0],vhi[i][1],vhi[i][2],vhi[i][3]}
  #define PIN(x) asm volatile("":"+v"(x))
  #define MX3(a,b,c) __builtin_fmaxf(__builtin_fmaxf((a),(b)),(c))
  #define GAPA(MF,A0,A1,A2,A3,W0,W1,PW) do{ MF; sacc+=A0; sacc+=A1; sacc+=A2; sacc+=A3; PIN(sacc); W0; W1; PIN(PW); SBAR(); }while(0)
  #define EX(v) __builtin_amdgcn_exp2f(v)
  #define GAPB(MF,X,B) do{ MF; X[B]=EX(X[B]); X[B+1]=EX(X[B+1]); X[B+2]=EX(X[B+2]); X[B+3]=EX(X[B+3]); PIN(X); SBAR(); }while(0)
  #define VRD(i) do{ vlo[i]=vtr(vp_+(((i)>>2)*4096+((i)&3)*1024)); vhi[i]=vtr(vp_+(((i)>>2)*4096+((i)&3)*1024+512)); }while(0)
  #define KRD(G,j) do{ if(G){ kload2(kf,kp0+sl_next,j); SBAR(); } }while(0)
  #define STEP(C0,C1,P0,P1,t,GK,GV,GL) do{ SBAR(); \
    const lds_cptr vp_=vp0+sl_prev; \
    VRD(0); SBAR(); float sacc=(P0[0]+P0[1]); \
    GAPA(C0=__builtin_amdgcn_mfma_f32_32x32x16_bf16(kf[0],qr[0],negm,0,0,0), P0[2],P0[3],P0[4],P0[5],     pw0[0]=PKW(P0,0), pw0[1]=PKW(P0,2), pw0); \
    VRD(4); SBAR(); GAPA(C1=__builtin_amdgcn_mfma_f32_32x32x16_bf16(kf[1],qr[0],negm,0,0,0), P0[6],P0[7],P0[8],P0[9],     pw0[2]=PKW(P0,4), pw0[3]=PKW(P0,6), pw0); \
    VRD(1); SBAR(); GAPA(C0=__builtin_amdgcn_mfma_f32_32x32x16_bf16(kf[2],qr[1],C0,0,0,0),   P0[10],P0[11],P0[12],P0[13], pw1[0]=PKW(P0,8), pw1[1]=PKW(P0,10), pw1); \
    VRD(5); SBAR(); GAPA(C1=__builtin_amdgcn_mfma_f32_32x32x16_bf16(kf[3],qr[1],C1,0,0,0),   P0[14],P0[15],P1[0],P1[1],   pw1[2]=PKW(P0,12),pw1[3]=PKW(P0,14), pw1); \
    VRD(2); SBAR(); GAPA(if constexpr(DQ==64) C0=__builtin_amdgcn_mfma_f32_32x32x16_bf16(kf[4],qr[2],C0,0,0,0),   P1[2],P1[3],P1[4],P1[5],     pw2[0]=PKW(P1,0), pw2[1]=PKW(P1,2), pw2); \
    VRD(6); SBAR(); GAPA(if constexpr(DQ==64) C1=__builtin_amdgcn_mfma_f32_32x32x16_bf16(kf[5],qr[2],C1,0,0,0),   P1[6],P1[7],P1[8],P1[9],     pw2[2]=PKW(P1,4), pw2[3]=PKW(P1,6), pw2); \
    VRD(3); SBAR(); GAPA(if constexpr(DQ==64) C0=__builtin_amdgcn_mfma_f32_32x32x16_bf16(kf[6],qr[3],C0,0,0,0),   P1[10],P1[11],P1[12],P1[13], pw3[0]=PKW(P1,8), pw3[1]=PKW(P1,10), pw3); \
    VRD(7); SBAR(); GAPA(if constexpr(DQ==64) C1=__builtin_amdgcn_mfma_f32_32x32x16_bf16(kf[7],qr[3],C1,0,0,0),   P1[14],P1[15],0.f,0.f,       pw3[2]=PKW(P1,12),pw3[3]=PKW(P1,14), pw3); \
    l_reg+=sacc; \
    if(GK){DMA_K((t)+3,sl_cur);} if(GV){DMA_V((t)+1,sl_next);} \
    CMASK(C0,C1,t); \
    { float a=MX3(C0[0],C0[1],C1[0]),b=MX3(C0[2],C0[3],C1[1]); a=MX3(a,C1[2],C1[3]); \
      _Pragma("unroll") for(int r=4;r<16;r+=4){a=MX3(a,C0[r],C0[r+1]);b=MX3(b,C0[r+2],C0[r+3]);a=MX3(a,C1[r],C1[r+1]);b=MX3(b,C1[r+2],C1[r+3]);} \
      float rm=__builtin_fmaxf(a,b); { auto rr=__builtin_amdgcn_permlane32_swap(__float_as_uint(rm),__float_as_uint(rm),false,false); rm=__builtin_fmaxf(__uint_as_float(rr[0]),__uint_as_float(rr[1])); } \
      resc=false; \
      if(__builtin_expect(__any(rm>(float)THRL),0)){ const float dl=__builtin_fmaxf(rm,0.f); mhat+=dl; \
        _Pragma("unroll") for(int r=0;r<16;++r){C0[r]-=dl;C1[r]-=dl;} \
        _Pragma("unroll") for(int r=0;r<16;++r)negm[r]=-mhat; asm volatile("":"+v"(negm)); \
        const float f=__builtin_amdgcn_exp2f(-dl); l_reg*=f; if(hi==0)wsf[r32]=f; resc=true; } } \
    SBAR(); \
    GAPB(o[0]=__builtin_amdgcn_mfma_f32_32x32x16_bf16(PAF(0),VFR(0),o[0],0,0,0), C0,0); \
    GAPB(o[1]=__builtin_amdgcn_mfma_f32_32x32x16_bf16(PAF(0),VFR(4),o[1],0,0,0), C0,4); \
    KRD(GL,0); GAPB(o[0]=__builtin_amdgcn_mfma_f32_32x32x16_bf16(PAF(1),VFR(1),o[0],0,0,0), C0,8); \
    KRD(GL,1); GAPB(o[1]=__builtin_amdgcn_mfma_f32_32x32x16_bf16(PAF(1),VFR(5),o[1],0,0,0), C0,12); \
    if constexpr(DQ==64) KRD(GL,2); GAPB(o[0]=__builtin_amdgcn_mfma_f32_32x32x16_bf16(PAF(2),VFR(2),o[0],0,0,0), C1,0); \
    if constexpr(DQ==64) KRD(GL,3); GAPB(o[1]=__builtin_amdgcn_mfma_f32_32x32x16_bf16(PAF(2),VFR(6),o[1],0,0,0), C1,4); \
    GAPB(o[0]=__builtin_amdgcn_mfma_f32_32x32x16_bf16(PAF(3),VFR(3),o[0],0,0,0), C1,8); \
    GAPB(o[1]=__builtin_amdgcn_mfma_f32_32x32x16_bf16(PAF(3),VFR(7),o[1],0,0,0), C1,12); \
    }while(0)
  int t=1;
  #undef CMASK
  #define CMASK(P0,P1,t) do{}while(0)
  for(;t+5<NT;t+=2){
    STEP(pB0,pB1,pA0,pA1,t,true,true,true);     WAIT_BAR(2); RESC(); ROT();
    STEP(pA0,pA1,pB0,pB1,t+1,true,true,true);   WAIT_BAR(2); RESC(); ROT();
  }
  #undef CMASK
  #define CMASK(P0,P1,t) do{}while(0)
  #define ENDW(tt) do{ if((tt)+3<NT){WAIT_BAR(2);} else if((tt)+2<NT){WAIT_BAR(1);} else {WAIT_BAR(0);} }while(0)
  for(;t+1<NT;t+=2){
    STEP(pB0,pB1,pA0,pA1,t,(t+3<NT),(t+1<NT),(t+1<NT));       ENDW(t);   RESC(); ROT();
    STEP(pA0,pA1,pB0,pB1,t+1,(t+4<NT),(t+2<NT),(t+2<NT));     ENDW(t+1); RESC(); ROT();
  }
  STEP(pB0,pB1,pA0,pA1,NT-1,false,false,false); RESC();
  { float sacc=pB0[0]+pB0[1]; _Pragma("unroll") for(int r=2;r<16;++r)sacc+=pB0[r]; _Pragma("unroll") for(int r=0;r<16;++r)sacc+=pB1[r]; l_reg+=sacc;
    pw0=(u32x4){PKW(pB0,0),PKW(pB0,2),PKW(pB0,4),PKW(pB0,6)};pw1=(u32x4){PKW(pB0,8),PKW(pB0,10),PKW(pB0,12),PKW(pB0,14)};pw2=(u32x4){PKW(pB1,0),PKW(pB1,2),PKW(pB1,4),PKW(pB1,6)};pw3=(u32x4){PKW(pB1,8),PKW(pB1,10),PKW(pB1,12),PKW(pB1,14)};
    SBAR(); pv(o,vb0+sl_cur,PAF(0),PAF(1),PAF(2),PAF(3)); }
  #undef PKW
  #undef PAF
  #undef VFR
  #undef PIN
  #undef MX3
  #undef GAPA
  #undef GAPB
  #undef EX
  #undef VRD
  #undef KRD
  #undef STEP
  #undef ENDW
  {auto rr=__builtin_amdgcn_permlane32_swap(__float_as_uint(l_reg),__float_as_uint(l_reg),false,false);l_reg=__uint_as_float(rr[0])+__uint_as_float(rr[1]);}
  if(hi==0)wsf[32+r32]=l_reg;asm volatile("s_waitcnt lgkmcnt(0)":::"memory");
  float rli[16];
  #pragma unroll
  for(int r=0;r<16;++r)rli[r]=__builtin_amdgcn_rcpf(wsf[32+crow(r,hi)]);
  #pragma unroll
  for(int r=0;r<16;++r){o[0][r]*=rli[r];o[1][r]*=rli[r];}
  if constexpr(MODE==0){ bf16*Ow=Ow0+(long)(wid*QBLK)*op; stage_store(o,Ow,op,shm,wid,lane,r32,hi); }
  else { oret[0]=o[0]; oret[1]=o[1]; }
  asm volatile("s_waitcnt lgkmcnt(0)\n\ts_barrier":::"memory");
  #undef DMA_K
  #undef DMA_V
  #undef CMASK
  #undef START
  #undef RESC
  #undef ROT
}
#undef SBAR
#undef WAIT_BAR
}

struct AttnArgs { const bf16_t *QG, *QD, *KG, *VG, *KD, *VD, *CB, *PB; bf16_t* MIX; const float* conv_w; const float* conv_b; const float* subln_g; float lam, lam_init; float* dscr; };

__device__ __forceinline__ void attn_gqa_unit(const AttnArgs& A, LAS char* lds, char* lds_generic, int lat, int seq, int qh, int qb) {
    const long R = lat ? 8192L + (long)SLAT * seq : 256L * seq; const int S = lat ? SLAT : 256;
    const size_t grow0 = (lat ? 8192 + (size_t)4096 * seq : (size_t)256 * seq) + 256 * qb;
    const int kvh = qh >> 2;
    int NT = S / 64; asm volatile("" : "+s"(NT));
    typedef attn64::bf16 abf;
    f32x16 dummy[2];
    attn64::attn_unit<8, 0, 64>((const abf*)(A.QG + grow0 * 512 + 64 * qh), 512, (const abf*)(A.KG + (R * 2 + (long)kvh * S) * 64), 64, (const abf*)(A.VG + (R * 2 + (long)kvh * S) * 64), 64, NT,
                                (abf*)(A.MIX + grow0 * 1024 + 64 * qh), 1024, lds_generic, dummy);
}
__device__ __forceinline__ void attn_diff_unit(const AttnArgs& A, LAS char* lds, char* lds_generic, int lat, int seq, int hd, int qb) {
    const int tid_ = opaque_tid(); const int wave = __builtin_amdgcn_readfirstlane(tid_ >> 6), lane = tid_ & 63, r32 = lane & 31, h = lane >> 5;
    const long R = lat ? 8192L + (long)SLAT * seq : 256L * seq; const int S = lat ? SLAT : 256;
    const size_t grow0 = (lat ? 8192 + (size_t)4096 * seq : (size_t)256 * seq) + 256 * qb;
    int NT = S / 64; asm volatile("" : "+s"(NT));
    typedef attn64::bf16 abf;
    const abf* V = (const abf*)(A.VD + (R * 4 + (long)hd * S) * 64);
    f32x16 oa[2], ob[2];
    attn64::attn_unit<8, 1, 32>((const abf*)(A.QD + grow0 * 256 + 64 * hd), 256, (const abf*)(A.KD + (R * 8 + (long)(hd * 2) * S) * 32), 32, V, 64, NT, (abf*)nullptr, 0, lds_generic, oa);
    GAS float* scr = (GAS float*)A.dscr + ((size_t)(blockIdx.x * 8 + wave) * 32) * 64 + lane;
#pragma unroll
    for (int d0 = 0; d0 < 2; ++d0)
#pragma unroll
        for (int r = 0; r < 16; ++r) scr[(d0 * 16 + r) * 64] = oa[d0][r];
    attn64::attn_unit<8, 1, 32>((const abf*)(A.QD + grow0 * 256 + 64 * hd + 32), 256, (const abf*)(A.KD + (R * 8 + (long)(hd * 2 + 1) * S) * 32), 32, V, 64, NT, (abf*)nullptr, 0, lds_generic, ob);
    float ss[16];
#pragma unroll
    for (int r = 0; r < 16; ++r) {
        const float v0 = scr[r * 64] - A.lam * ob[0][r], v1 = scr[(16 + r) * 64] - A.lam * ob[1][r];
        ob[0][r] = v0; ob[1][r] = v1; ss[r] = v0 * v0 + v1 * v1;
    }
#pragma unroll
    for (int o = 1; o < 32; o <<= 1)
#pragma unroll
        for (int r = 0; r < 16; ++r) ss[r] += __shfl_xor(ss[r], o);
    const float g0 = A.subln_g[r32], g1 = A.subln_g[32 + r32], sc = 1.f - A.lam_init;
#pragma unroll
    for (int r = 0; r < 16; ++r) { const float rstd = rsqrtf(ss[r] * (1.f / 64.f) + EPS) * sc; ob[0][r] *= rstd * g0; ob[1][r] *= rstd * g1; }
    attn64::stage_store(ob, (abf*)(A.MIX + (grow0 + 32 * wave) * 1024 + 768 + 64 * hd), 1024, lds_generic, wave, lane, r32, h);
}

__device__ __forceinline__ void attn_phase(const AttnArgs& A, LAS char* lds, char* lds_generic, int G) {
    for (int u = blockIdx.x; u < 2048; u += G) {
        if (u < 512) { const int b = u & 7, r = u >> 3; attn_diff_unit(A, lds, lds_generic, 1, b, r >> 4, r & 15); }
        else if (u < 1536) { const int v = u - 512, b = v & 7, r = v >> 3; attn_gqa_unit(A, lds, lds_generic, 1, b, r & 7, r >> 3); }
        else { const int v = u - 1536;
            if (v < 128) attn_diff_unit(A, lds, lds_generic, 0, v >> 2, v & 3, 0);
            else if (v < 256) { const int w = 2 * (v - 128); attn_gqa_unit(A, lds, lds_generic, 0, w >> 3, w & 7, 0); }
            else if (v >= 384) { const int w = 2 * (v - 384) + 1; attn_gqa_unit(A, lds, lds_generic, 0, w >> 3, w & 7, 0); } }
    }
    const int tid_c = opaque_tid();
    for (int idx = blockIdx.x * 512 + tid_c; idx < M_ALL * 32; idx += G * 512) {
        const int row = idx >> 5, c8 = (idx & 31) * 8;
        int t, S; if (row < M_CTX) { t = row & 255; S = 256; } else { t = (row - M_CTX) & 4095; S = 4096; }
        const u32x4 z = {0, 0, 0, 0};
        const u32x4 pc = *(const GAS u32x4*)(A.PB + (size_t)row * 256 + c8);
        const u32x4 pp = t > 0 ? *(const GAS u32x4*)(A.PB + (size_t)(row - 1) * 256 + c8) : z;
        const u32x4 pn = t < S - 1 ? *(const GAS u32x4*)(A.PB + (size_t)(row + 1) * 256 + c8) : z;
        const u32x4 cb = *(const GAS u32x4*)(A.CB + (size_t)row * 256 + c8);
        float res[8];
#pragma unroll
        for (int j = 0; j < 8; ++j) {
            const int sh = (j & 1) * 16;
            const float a = __uint_as_float(((pp[j >> 1] >> sh) & 0xffffu) << 16), b = __uint_as_float(((pc[j >> 1] >> sh) & 0xffffu) << 16), c = __uint_as_float(((pn[j >> 1] >> sh) & 0xffffu) << 16);
            const float g = __uint_as_float(((cb[j >> 1] >> sh) & 0xffffu) << 16);
            const int cc = c8 + j;
            res[j] = g * (A.conv_w[cc] * a + A.conv_w[256 + cc] * b + A.conv_w[512 + cc] * c + A.conv_b[cc]);
        }
        u32x4 w; w.x = cvtpk(res[0], res[1]); w.y = cvtpk(res[2], res[3]); w.z = cvtpk(res[4], res[5]); w.w = cvtpk(res[6], res[7]);
        *(GAS u32x4*)(A.MIX + (size_t)row * 1024 + 512 + c8) = w;
    }
}

__device__ __forceinline__ int sigma_map(int type, int i) {
    if (type == 1) return 8 * ((i >> 2) & 3) + 4 * (i >> 4) + (i & 3);
    if (type == 2) return 16 * ((i >> 3) & 1) + 8 * (i >> 4) + (i & 7);
    return i;
}
__device__ __forceinline__ void in_group(int g, int& Lbase, int& type) {
    const int pn = g >> 3, bj = (g >> 2) & 1, wc = g & 3;
    if (pn < 2) { Lbase = 64 * (4 * pn + wc) + 32 * bj; type = 0; }
    else if (pn == 2) { Lbase = (wc < 2 ? 512 + 64 * wc : 640 + 64 * (wc - 2)) + 32 * bj; type = wc < 2 ? 0 : 1; }
    else if (pn == 3) { Lbase = 768 + 128 * bj + 32 * wc; type = 1; }
    else if (pn < 6) { Lbase = 1024 + 256 * bj + 128 * (pn - 4) + 32 * wc; type = 1; }
    else if (pn < 8) { Lbase = (pn == 6 ? 1536 : 1792) + 64 * wc + 32 * bj; type = 2; }
    else { Lbase = 2048 + 64 * wc + 32 * bj; type = 1; }
}
__device__ __forceinline__ void transpose_item(const float* W, int K, int N, bf16_t* WT, int k0, int nphys0, int Lbase, int type, LAS float* scr, int lane) {
    {
        float wv[32];
#pragma unroll
        for (int i = 0; i < 32; ++i) wv[i] = ((const GAS float*)W)[(size_t)(k0 + 2 * i + (lane >> 5)) * N + Lbase + (lane & 31)];
#pragma unroll
        for (int i = 0; i < 32; ++i) scr[(2 * i + (lane >> 5)) * 33 + (lane & 31)] = wv[i];
        __builtin_amdgcn_sched_group_barrier(0x020, 32, 0);
    }
    asm volatile("s_waitcnt lgkmcnt(0)" ::: "memory");
    const int c = lane & 7;
#pragma unroll
    for (int j = 0; j < 4; ++j) { const int n = (lane >> 3) + 8 * j; const LAS float* s = scr + (8 * c) * 33 + sigma_map(type, n);
        u32x4 o; o.x = cvtpk(s[0 * 33], s[1 * 33]); o.y = cvtpk(s[2 * 33], s[3 * 33]); o.z = cvtpk(s[4 * 33], s[5 * 33]); o.w = cvtpk(s[6 * 33], s[7 * 33]);
        *(GAS u32x4*)(WT + (size_t)(nphys0 + n) * K + k0 + 8 * c) = o; }
    asm volatile("s_waitcnt lgkmcnt(0)" ::: "memory");
}

struct Params {
    const float *x_prompt, *x_sample, *cache_gk, *cache_gv, *cache_dk, *cache_dv, *c, *c_ctx;
    const float *w_mod, *b_mod, *norm1_g, *w_in, *gqa_qn_g, *gqa_kn_g, *conv_w, *conv_b, *diff_qn_g, *diff_kn_g, *diff_lambda, *diff_subln_g, *w_out, *norm2_g, *ffn_up, *ffn_conv_w, *ffn_conv_b, *ffn_down;
    float* out; unsigned char* ws;
    float lam_init[4];
    int ph_lo, ph_hi;
};

__device__ __forceinline__ void prologue(const Params& P, LAS unsigned char* lds, int G) {
    const int tid = opaque_tid(), lane = tid & 63, wave = __builtin_amdgcn_readfirstlane(tid >> 6);
    float* MODS = (float*)(P.ws + WS_MODS); float* MISC = (float*)(P.ws + WS_MISC);
    if ((int)blockIdx.x < 384) {
        LAS float* sc = (LAS float*)lds;
        LAS float* part = (LAS float*)(lds + 49152);
        for (int i = tid; i < NCOND * 1024; i += 512) { const int ci = i >> 10, k = i & 1023; const float v = ci == 0 ? P.c_ctx[k] : P.c[(ci - 1) * 1024 + k]; sc[k * 12 + ci] = v / (1.f + __expf(-v)); }
        __syncthreads();
        for (int it = blockIdx.x; it < 384; it += G) {
            const int l = it / 96, col = (it % 96) * 64 + lane;
            const float* w = P.w_mod + (size_t)l * 1024 * 6144 + col;
            float acc[NCOND];
#pragma unroll
            for (int ci = 0; ci < NCOND; ++ci) acc[ci] = 0.f;
#pragma unroll 8
            for (int kk = 0; kk < 128; ++kk) { const int k = wave * 128 + kk; const float wv = ((const GAS float*)w)[(size_t)k * 6144];
                const f32x4 s0 = *(LAS f32x4*)(sc + k * 12), s1 = *(LAS f32x4*)(sc + k * 12 + 4); const float s8 = sc[k * 12 + 8];
                acc[0] += s0[0] * wv; acc[1] += s0[1] * wv; acc[2] += s0[2] * wv; acc[3] += s0[3] * wv; acc[4] += s1[0] * wv; acc[5] += s1[1] * wv; acc[6] += s1[2] * wv; acc[7] += s1[3] * wv; acc[8] += s8 * wv; }
#pragma unroll
            for (int ci = 0; ci < NCOND; ++ci) part[(wave * NCOND + ci) * 64 + lane] = acc[ci];
            __syncthreads();
            for (int i = tid; i < NCOND * 64; i += 512) { const int ci = i >> 6, cc = i & 63; float s = 0.f;
#pragma unroll
                for (int w8 = 0; w8 < 8; ++w8) s += part[(w8 * NCOND + ci) * 64 + cc];
                const int j = (it % 96) * 64 + cc; MODS[((size_t)l * NCOND + ci) * 6144 + j] = s + P.b_mod[l * 6144 + j]; }
            __syncthreads();
        }
    }
    if ((int)blockIdx.x == G - 1) {
        if (tid < 4) { const float* lf = P.diff_lambda + tid * 128; float s1 = 0.f, s2 = 0.f; for (int i = 0; i < 32; ++i) { s1 += lf[i] * lf[32 + i]; s2 += lf[64 + i] * lf[96 + i]; }
            MISC[MI_LAM + tid] = expf(s1) - expf(s2) + P.lam_init[tid]; }
        for (int i = tid; i < 1024; i += 512) { const int pos = i >> 4, idx = i & 15; const float fr = powf(10000.f, -(float)idx / 16.f); const float ang = (float)pos * fr; MISC[MI_R64C + i] = cosf(ang); MISC[MI_R64S + i] = sinf(ang); }
        for (int i = tid; i < 512; i += 512) { const int pos = i >> 3, idx = i & 7; const float fr = powf(10000.f, -(float)idx / 8.f); const float ang = (float)pos * fr; MISC[MI_R32C + i] = cosf(ang); MISC[MI_R32S + i] = sinf(ang); }
    }
    __syncthreads();
    LAS float* scr = (LAS float*)(lds + wave * 16384);
    const int gw = blockIdx.x * 8 + wave, NGW = G * 8;
    constexpr int I_IN = 16 * 72, I_OUT = 16 * 32, I_UP = 16 * 176, I_DN = 44 * 32, I_L = I_IN + I_OUT + I_UP + I_DN;
    for (int it = gw; it < DEPTH * I_L; it += NGW) {
        const int l = it / I_L; int r = it % I_L;
        if (r < I_IN) { const int kb = r / 72, g = r % 72; int Lb, ty; in_group(g, Lb, ty);
            transpose_item(P.w_in + (size_t)l * 1024 * INW, 1024, INW, (bf16_t*)(P.ws + WS_WIN) + (size_t)l * INW * 1024, kb * 64, g * 32, Lb, ty, scr, lane); continue; }
        r -= I_IN;
        if (r < I_OUT) { const int kb = r / 32, g = r % 32;
            transpose_item(P.w_out + (size_t)l * 1024 * 1024, 1024, 1024, (bf16_t*)(P.ws + WS_WOUT) + (size_t)l * 1024 * 1024, kb * 64, g * 32, g * 32, 1, scr, lane); continue; }
        r -= I_OUT;
        if (r < I_UP) { const int kb = r / 176, g = r % 176; const int pn = g >> 3, bj = (g >> 2) & 1, wc = g & 3;
            transpose_item(P.ffn_up + (size_t)l * 1024 * UPW, 1024, UPW, (bf16_t*)(P.ws + WS_WUP) + (size_t)l * UPW * 1024, kb * 64, g * 32, bj * DFF + 128 * pn + 32 * wc, 1, scr, lane); continue; }
        r -= I_UP;
        { const int kb = r / 32, g = r % 32;
            transpose_item(P.ffn_down + (size_t)l * DFF * 1024, DFF, 1024, (bf16_t*)(P.ws + WS_WDN) + (size_t)l * 1024 * DFF, kb * 64, g * 32, g * 32, 1, scr, lane); }
    }
}

__device__ __forceinline__ void norm_phase(const float* xin_ctx, const float* xin_lat, const bf16_t* xin_b  , const float* ng, const float* mods_l  , int sh_idx, bf16_t* XN, int G) {
    const int tid_ = opaque_tid(); const int lane = tid_ & 63, wave = __builtin_amdgcn_readfirstlane(tid_ >> 6);
    const int nw = G * 8, gw = blockIdx.x * 8 + wave;
    const int per = (M_ALL + nw - 1) / nw;
    const int r0 = gw * per, r1 = min(r0 + per, M_ALL);
    int cur_ci = -1; f32x4 Aa[4], Bb[4];
    f32x4 v[4], vn[4];
#define NORM_LOAD_ROW(R_) do { const int rr_ = (R_); \
        if (xin_b) { _Pragma("unroll") for (int jj = 0; jj < 2; ++jj) { const u32x4 q_ = *(const GAS u32x4*)(xin_b + (size_t)rr_ * DM + 8 * lane + 512 * jj); \
                vn[2 * jj] = (f32x4){__uint_as_float(q_.x << 16), __uint_as_float(q_.x & 0xffff0000u), __uint_as_float(q_.y << 16), __uint_as_float(q_.y & 0xffff0000u)}; \
                vn[2 * jj + 1] = (f32x4){__uint_as_float(q_.z << 16), __uint_as_float(q_.z & 0xffff0000u), __uint_as_float(q_.w << 16), __uint_as_float(q_.w & 0xffff0000u)}; } } \
        else { const float* xr_ = rr_ < M_CTX ? xin_ctx + (size_t)rr_ * DM : xin_lat + (size_t)(rr_ - M_CTX) * DM; \
            _Pragma("unroll") for (int jj = 0; jj < 2; ++jj) { vn[2 * jj] = *(const GAS f32x4*)(xr_ + 8 * lane + 512 * jj); vn[2 * jj + 1] = *(const GAS f32x4*)(xr_ + 8 * lane + 512 * jj + 4); } } } while (0)
    if (r0 < r1) NORM_LOAD_ROW(r0);
    for (int row = r0; row < r1; ++row) {
#pragma unroll
        for (int j = 0; j < 4; ++j) v[j] = vn[j];
        if (row + 1 < r1) NORM_LOAD_ROW(row + 1);
        const int ci = row < M_CTX ? 0 : 1 + ((row - M_CTX) >> 12);
        if (ci != cur_ci) { cur_ci = ci; const float* sh = mods_l + ci * 6144 + sh_idx * 1024; const float* sc = sh + 1024;
#pragma unroll
            for (int j = 0; j < 4; ++j) { const int c = 8 * lane + 512 * (j >> 1) + 4 * (j & 1); const f32x4 g4 = *(const GAS f32x4*)(ng + c), s4 = *(const GAS f32x4*)(sc + c); Aa[j] = g4 * (1.f + s4); Bb[j] = *(const GAS f32x4*)(sh + c); } }
        float s = 0.f;
#pragma unroll
        for (int j = 0; j < 4; ++j) s += (v[j][0] * v[j][0] + v[j][1] * v[j][1]) + (v[j][2] * v[j][2] + v[j][3] * v[j][3]);
#pragma unroll
        for (int o = 1; o < 64; o <<= 1) s += __shfl_xor(s, o);
        const float rstd = rsqrtf(s * (1.f / DM) + EPS);
#pragma unroll
        for (int jj = 0; jj < 2; ++jj) { const f32x4 y0 = v[2 * jj] * rstd * Aa[2 * jj] + Bb[2 * jj], y1 = v[2 * jj + 1] * rstd * Aa[2 * jj + 1] + Bb[2 * jj + 1];
            u32x4 w; w.x = cvtpk(y0[0], y0[1]); w.y = cvtpk(y0[2], y0[3]); w.z = cvtpk(y1[0], y1[1]); w.w = cvtpk(y1[2], y1[3]);
            *(GAS u32x4*)(XN + (size_t)row * DM + 8 * lane + 512 * jj) = w; }
    }
#undef NORM_LOAD_ROW
}

__device__ __forceinline__ void cache_phase(const Params& P, int l, int G) {
    bf16_t* KG = (bf16_t*)(P.ws + WS_KG); bf16_t* VG = (bf16_t*)(P.ws + WS_VG); bf16_t* KD = (bf16_t*)(P.ws + WS_KD); bf16_t* VD = (bf16_t*)(P.ws + WS_VD);
    const int tid_ = opaque_tid();
    for (int i = blockIdx.x * 512 + tid_; i < 65536; i += G * 512) {
        const int d4 = (i & 15) * 4, kvh = (i >> 4) & 1, p = (i >> 5) & 255, b = i >> 13;
        const size_t src = ((((size_t)b * 4 + l) * 256 + p) * 2 + kvh) * 64 + d4;
        const size_t dst = (((8192L + (long)SLAT * b) * 2 + (long)kvh * SLAT + 4096 + p) * 64);
        const int pk4 = (d4 & 32) | ((d4 & 12) << 1) | ((d4 & 16) >> 2);
        const f32x4 k = *(const GAS f32x4*)(P.cache_gk + src), v = *(const GAS f32x4*)(P.cache_gv + src);
        u32x2 wk, wv; wk.x = cvtpk(k[0], k[1]); wk.y = cvtpk(k[2], k[3]); wv.x = cvtpk(v[0], v[1]); wv.y = cvtpk(v[2], v[3]);
        *(GAS u32x2*)(KG + dst + pk4) = wk; *(GAS u32x2*)(VG + dst + d4) = wv;
    }
    for (int i = blockIdx.x * 512 + tid_; i < 131072; i += G * 512) {
        { const int d4 = (i & 7) * 4, hc = (i >> 3) & 7, p = (i >> 6) & 255, b = i >> 14;
          const size_t src = ((((size_t)b * 4 + l) * 256 + p) * 8 + hc) * 32 + d4;
          const size_t dst = (((8192L + (long)SLAT * b) * 8 + (long)hc * SLAT + 4096 + p) * 32) + ((d4 & 16) | ((d4 & 4) << 1) | ((d4 & 8) >> 1));
          const f32x4 k = *(const GAS f32x4*)(P.cache_dk + src); u32x2 w; w.x = cvtpk(k[0], k[1]); w.y = cvtpk(k[2], k[3]); *(GAS u32x2*)(KD + dst) = w; }
        { const int d4 = (i & 15) * 4, hh = (i >> 4) & 3, p = (i >> 6) & 255, b = i >> 14;
          const size_t src = ((((size_t)b * 4 + l) * 256 + p) * 4 + hh) * 64 + d4;
          const size_t dst = (((8192L + (long)SLAT * b) * 4 + (long)hh * SLAT + 4096 + p) * 64) + d4;
          const f32x4 v = *(const GAS f32x4*)(P.cache_dv + src); u32x2 w; w.x = cvtpk(v[0], v[1]); w.y = cvtpk(v[2], v[3]); *(GAS u32x2*)(VD + dst) = w; }
    }
}

__device__ __forceinline__ void fixup_own_panels(const pg8::StaticOrder& S, const float* cw, bf16_t* F, const float* EP, const float* EA, const float* EU) {
    const int tid_ = opaque_tid();
    pg8::Unit u;
    for (int i = 0; S.next(i, u); ++i) {
        const int pm = u.pm; if (pm < 32) continue;
        const int j = (pm - 32) & 15;
        for (int e = 0; e < 2; ++e) {
            if (e == 0 ? j == 0 : j == 15) continue;
            const size_t eb = ((size_t)pm * 2 + e) * DFF, nb = e == 0 ? ((size_t)(pm - 1) * 2 + 1) * DFF : ((size_t)(pm + 1) * 2 + 0) * DFF;
            const float* w = cw + (e == 0 ? 0 : 2 * DFF);
            const size_t row = (size_t)pm * 256 + (e ? 255 : 0);
            for (int c = tid_ * 2; c < DFF; c += 1024) {
                const f32x2 p = *(const GAS f32x2*)(EP + eb + c), a = *(const GAS f32x2*)(EA + nb + c), uu = *(const GAS f32x2*)(EU + eb + c), ww = *(const GAS f32x2*)(w + c);
                const float f0 = silu_f(p[0] + ww[0] * a[0]) * uu[0], f1 = silu_f(p[1] + ww[1] * a[1]) * uu[1];
                *(GAS unsigned*)(F + row * DFF + c) = cvtpk(f0, f1);
            }
        }
    }
    asm volatile("s_waitcnt vmcnt(0)" ::: "memory");
    __syncthreads();
}
__device__ __forceinline__ void fixup_phase(const float* cw, bf16_t* F, const float* EP, const float* EA, const float* EU, int G) {
    const int tid_ = opaque_tid();
    for (int i = blockIdx.x * 512 + tid_; i < 128 * 2 * DFF; i += G * 512) {
        const int c = i % DFF, e = (i / DFF) & 1, pm = 32 + i / (2 * DFF); const int j = (pm - 32) & 15;
        if (e == 0 ? j == 0 : j == 15) continue;
        const size_t eo = ((size_t)pm * 2 + e) * DFF + c;
        float conv;
        if (e == 0) conv = EP[eo] + cw[c] * EA[((size_t)(pm - 1) * 2 + 1) * DFF + c];
        else conv = EP[eo] + cw[2 * DFF + c] * EA[((size_t)(pm + 1) * 2 + 0) * DFF + c];
        const float f = silu_f(conv) * EU[eo];
        const size_t row = (size_t)pm * 256 + (e ? 255 : 0);
        F[row * DFF + c] = (bf16_t)(cvtpk(f, 0.f) & 0xffffu);
    }
}


#define XB_TMO      128
#define XB_XCNT(j)  (256  + 64 * (j))
#define XB_XSUB(j)  (1280 + 64 * (j))
#define XB_XGEN(j)  (2304 + 64 * (j))
#define XB_TOP      3328
#define XB_TOPGEN   3392
#define XCD_BAR_WORDS 3456
#define XB_SPIN_CAP (1u << 22)
__device__ __forceinline__ unsigned xb_ld(unsigned* p)              { return __hip_atomic_load(p, __ATOMIC_RELAXED, __HIP_MEMORY_SCOPE_AGENT); }
__device__ __forceinline__ unsigned xb_add(unsigned* p, unsigned v) { return __hip_atomic_fetch_add(p, v, __ATOMIC_RELAXED, __HIP_MEMORY_SCOPE_AGENT); }
__device__ __forceinline__ unsigned xb_xcc_id() { return (unsigned)__builtin_amdgcn_s_getreg((3 << 11) | 20) & 0xFu; }
#define XB_SPIN(cond, bar) do { unsigned _sp = 0; while (cond) { __builtin_amdgcn_s_sleep(1); \
    if ((++_sp & 255u) == 0u) { if (xb_ld(&(bar)[XB_TMO])) break; if (_sp > XB_SPIN_CAP) { atomicAdd(&(bar)[XB_TMO], 1u); break; } } } } while (0)
struct XcdBarrier { unsigned* bar; unsigned x; volatile LAS unsigned* st; };
__device__ __forceinline__ XcdBarrier xcd_barrier_post(unsigned* bar, volatile LAS unsigned* st) {
    XcdBarrier b; b.bar = bar; b.x = xb_xcc_id(); b.st = st;
    if (threadIdx.x == 0) (void)xb_add(&bar[XB_XCNT(b.x)], 1u);
    return b;
}
__device__ __forceinline__ void xcd_barrier_complete(unsigned* bar, unsigned x, unsigned& nloc, unsigned& nx) {
    const unsigned G = gridDim.x * gridDim.y * gridDim.z;
    unsigned sum, cnt, mine, sp = 0u;
    for (;;) {
        sum = 0u; cnt = 0u; mine = 0u;
#pragma unroll
        for (unsigned j = 0; j < 16; ++j) { const unsigned c = xb_ld(&bar[XB_XCNT(j)]); sum += c; cnt += (c > 0u) ? 1u : 0u; mine = (j == x) ? c : mine; }
        if (sum == G) break;
        __builtin_amdgcn_s_sleep(1);
        if ((++sp & 255u) == 0u) { if (xb_ld(&bar[XB_TMO])) break; if (sp > XB_SPIN_CAP) { atomicAdd(&bar[XB_TMO], 1u); break; } }
    }
    nloc = mine > 0u ? mine : 1u; nx = cnt > 0u ? cnt : 1u;
}
__device__ __forceinline__ void xcd_barrier(const XcdBarrier& b) {
    asm volatile("s_waitcnt vmcnt(0)" ::: "memory");
    __syncthreads();
    if (threadIdx.x == 0) {
        unsigned* bar = b.bar;
        __builtin_amdgcn_s_waitcnt(0);
        unsigned nloc = b.st[0], nx = b.st[1];
        if (nloc == 0u) { xcd_barrier_complete(bar, b.x, nloc, nx); b.st[0] = nloc; b.st[1] = nx; }
        const unsigned old = xb_add(&bar[XB_XSUB(b.x)], 1u);
        const unsigned gen = old / nloc;
        if (old + 1u == (gen + 1u) * nloc) {
            __builtin_amdgcn_fence(__ATOMIC_RELEASE, "agent");
            asm volatile("s_waitcnt vmcnt(0)" ::: "memory");
            const unsigned og = xb_add(&bar[XB_TOP], 1u);
            const unsigned tg = og / nx;
            if (og + 1u == (tg + 1u) * nx) xb_add(&bar[XB_TOPGEN], 1u);
            else XB_SPIN(xb_ld(&bar[XB_TOPGEN]) == tg, bar);
            __builtin_amdgcn_fence(__ATOMIC_ACQUIRE, "agent");
            xb_add(&bar[XB_XGEN(b.x)], 1u);
            asm volatile("s_waitcnt vmcnt(0)" ::: "memory");
        } else {
            XB_SPIN(xb_ld(&bar[XB_XGEN(b.x)]) == gen, bar);
            __builtin_amdgcn_fence(__ATOMIC_ACQUIRE, "agent");
            asm volatile("s_waitcnt vmcnt(0)" ::: "memory");
        }
    }
    __syncthreads();
}

__global__ void __launch_bounds__(512, 2) fwd_kernel(Params P) {
    extern __shared__ __attribute__((aligned(16))) unsigned char lds_raw[];
    LAS unsigned char* lds = (LAS unsigned char*)lds_raw;
    cg::grid_group grid = cg::this_grid();
    const int G = gridDim.x;
    volatile LAS unsigned* bst = (volatile LAS unsigned*)(lds + MISC_OFF);
    if (threadIdx.x < 2) bst[threadIdx.x] = 0u;
    __syncthreads();
    XcdBarrier bar = xcd_barrier_post((unsigned*)(P.ws + WS_CTL), bst);
    int ph = 0;
#define PHASE_BEGIN if (ph >= P.ph_lo && ph < P.ph_hi) { unsigned char* ws = P.ws; float* outp = P.out; asm volatile("" : "+s"(ws), "+s"(outp));
#define PHASE_END   if (ph + 1 < P.ph_hi) { if (ph == 0) grid.sync(); else xcd_barrier(bar); } } ++ph;
    PHASE_BEGIN
#ifndef SKIP_PRO
        prologue(P, lds, G);
#endif
    PHASE_END
    for (int l = 0; l < DEPTH; ++l) {
        PHASE_BEGIN
            const float* xin_ctx = l == 0 ? P.x_prompt : outp; const float* xin_lat = l == 0 ? P.x_sample : outp + (size_t)M_CTX * DM;
            norm_phase(P.x_prompt, P.x_sample, l == 0 ? (const bf16_t*)nullptr : (const bf16_t*)(ws + WS_XB), P.norm1_g + l * DM, (const float*)(ws + WS_MODS) + (size_t)l * NCOND * 6144, 0, (bf16_t*)(ws + WS_XN), G);
            cache_phase(P, l, G);
        PHASE_END
        PHASE_BEGIN {
            const float* MISC = (const float*)(ws + WS_MISC);
            pg8::Gemm g{(const bf16_t*)(ws + WS_XN), (const bf16_t*)(ws + WS_WIN) + (size_t)l * INW * 1024, M_ALL, INW, 1024}; pg8::StaticOrder S; S.init(M_ALL, INW, G, blockIdx.x);
            EpiIn E{l, P.gqa_qn_g + l * 64, P.gqa_kn_g + l * 64, P.diff_qn_g + l * 32, P.diff_kn_g + l * 32, MISC + MI_R64C, MISC + MI_R64S, MISC + MI_R32C, MISC + MI_R32S,
                    (bf16_t*)(ws + WS_QG), (bf16_t*)(ws + WS_QD), (bf16_t*)(ws + WS_KG), (bf16_t*)(ws + WS_VG), (bf16_t*)(ws + WS_KD), (bf16_t*)(ws + WS_VD), (bf16_t*)(ws + WS_CB), (bf16_t*)(ws + WS_PB), outp};
#ifndef SKIP_IN
            pg8::gemm_phase(lds, lds + XCH_OFF, g, S, E);
#endif
        } PHASE_END
        PHASE_BEGIN {
            const float* MISC = (const float*)(ws + WS_MISC);
            AttnArgs A{(const bf16_t*)(ws + WS_QG), (const bf16_t*)(ws + WS_QD), (const bf16_t*)(ws + WS_KG), (const bf16_t*)(ws + WS_VG), (const bf16_t*)(ws + WS_KD), (const bf16_t*)(ws + WS_VD),
                       (const bf16_t*)(ws + WS_CB), (const bf16_t*)(ws + WS_PB), (bf16_t*)(ws + WS_XN), P.conv_w + l * 768, P.conv_b + l * 256, P.diff_subln_g + l * 64, MISC[MI_LAM + l], P.lam_init[l], (float*)(ws + WS_DSCR)};
#ifndef SKIP_ATT
            attn_phase(A, (LAS char*)lds, (char*)lds_raw, G);
#endif
        } PHASE_END
        PHASE_BEGIN {
            const float* xin_ctx = l == 0 ? P.x_prompt : outp; const float* xin_lat = l == 0 ? P.x_sample : outp + (size_t)M_CTX * DM;
            pg8::Gemm g{(const bf16_t*)(ws + WS_XN), (const bf16_t*)(ws + WS_WOUT) + (size_t)l * 1024 * 1024, M_ALL, 1024, 1024}; pg8::StaticOrder S; S.init(M_ALL, 1024, G, blockIdx.x);
            EpiRes E{P.x_prompt, P.x_sample, outp, (const float*)(ws + WS_MODS) + (size_t)l * NCOND * 6144 + 2 * 1024, l == 0 ? (const bf16_t*)nullptr : (const bf16_t*)(ws + WS_XB), (bf16_t*)(ws + WS_XB)};
#ifndef SKIP_RES
            pg8::gemm_phase(lds, lds + XCH_OFF, g, S, E);
#endif
        } PHASE_END
        PHASE_BEGIN
            norm_phase(nullptr, nullptr, (const bf16_t*)(ws + WS_XB), P.norm2_g + l * DM, (const float*)(ws + WS_MODS) + (size_t)l * NCOND * 6144, 3, (bf16_t*)(ws + WS_XN), G);
        PHASE_END
        PHASE_BEGIN {
            float* EPb = (float*)(ws + WS_EDGE);
            pg8::Gemm g{(const bf16_t*)(ws + WS_XN), (const bf16_t*)(ws + WS_WUP) + (size_t)l * UPW * 1024, M_ALL, UPW, 1024}; pg8::StaticOrder S; S.init(M_ALL, UPW, G, blockIdx.x);
            EpiUp E{P.ffn_conv_w + (size_t)l * 3 * DFF, P.ffn_conv_b + (size_t)l * DFF, (bf16_t*)(ws + WS_U), EPb, EPb + EDGE_ELEMS, EPb + 2 * EDGE_ELEMS};
#ifndef SKIP_UP
            pg8::gemm_phase(lds, lds + XCH_OFF, g, S, E);
#endif
        } PHASE_END
        PHASE_BEGIN {
            pg8::Gemm g{(const bf16_t*)(ws + WS_U), (const bf16_t*)(ws + WS_WDN) + (size_t)l * 1024 * DFF, M_ALL, 1024, DFF}; pg8::StaticOrder S; S.init(M_ALL, 1024, G, blockIdx.x);
            { float* EPb = (float*)(ws + WS_EDGE); fixup_own_panels(S, P.ffn_conv_w + (size_t)l * 3 * DFF, (bf16_t*)(ws + WS_U), EPb, EPb + EDGE_ELEMS, EPb + 2 * EDGE_ELEMS); }
            EpiRes E{nullptr, nullptr, outp, (const float*)(ws + WS_MODS) + (size_t)l * NCOND * 6144 + 5 * 1024, (const bf16_t*)(ws + WS_XB), l + 1 < DEPTH ? (bf16_t*)(ws + WS_XB) : (bf16_t*)nullptr};
#ifndef SKIP_RES
            pg8::gemm_phase(lds, lds + XCH_OFF, g, S, E);
#endif
        } PHASE_END
    }
}

constexpr int N_PHASES = 1 + DEPTH * 7;
#ifndef N_LAUNCH_SPLIT
#define N_LAUNCH_SPLIT 0
#endif

extern "C" void kernel_launch(void* const* d_in, const int* in_sizes, int n_in, void* d_out, int out_size, void* d_ws, size_t ws_size, hipStream_t stream) {
    static int grid = 0;
    if (grid == 0) {
        if (n_in != 26 || ws_size < WS_END) { fprintf(stderr, "kernel_launch: unexpected n_in %d or ws_size %zu (< %zu)\n", n_in, ws_size, (size_t)WS_END); grid = -1; return; }
        int dev = 0, cus = 0, per_cu = 0;
        hipGetDevice(&dev); hipDeviceGetAttribute(&cus, hipDeviceAttributeMultiprocessorCount, dev);
        hipFuncSetAttribute((const void*)fwd_kernel, hipFuncAttributeMaxDynamicSharedMemorySize, LDS_BYTES);
        hipOccupancyMaxActiveBlocksPerMultiprocessor(&per_cu, (const void*)fwd_kernel, 512, LDS_BYTES);
        if (per_cu < 1) { fprintf(stderr, "kernel_launch: occupancy query gives %d\n", per_cu); per_cu = 1; }
        (void)hipGetLastError();
        grid = cus * 1;
    }
    if (grid < 0) return;
    Params p{};
    const float** pp = (const float**)&p;
    for (int i = 0; i < 26; ++i) pp[i] = (const float*)d_in[i];
    p.out = (float*)d_out; p.ws = (unsigned char*)d_ws;
    for (int l = 0; l < 4; ++l) p.lam_init[l] = (float)(0.8 - 0.6 * exp(-0.3 * (double)l));
#if N_LAUNCH_SPLIT
    for (int ph = 0; ph < N_PHASES; ++ph) { p.ph_lo = ph; p.ph_hi = ph + 1; hipLaunchKernelGGL(fwd_kernel, dim3(grid), dim3(512), LDS_BYTES, stream, p); }
#else
    p.ph_lo = 0; p.ph_hi = N_PHASES;
    if (hipMemsetAsync((char*)d_ws + WS_CTL, 0, CTL_ZERO_BYTES, stream) != hipSuccess) { fprintf(stderr, "kernel_launch: memset failed\n"); return; }
    void* args[] = {&p};
    hipError_t e = hipLaunchCooperativeKernel((const void*)fwd_kernel, dim3(grid), dim3(512), args, LDS_BYTES, stream);
    if (e != hipSuccess) fprintf(stderr, "cooperative launch failed: %s (grid %d)\n", hipGetErrorString(e), grid);
#endif
}
```
